# Optimizing an MI355X kernel written in HIP

```python
import math
import jax
import jax.numpy as jnp
from jax import lax
import numpy as np


D_MODEL = 1024
BATCH = 4
SEQ = 4096
DEPTH = 2

GRID_W = 64
CTX_LEN = 256

N_MOD = 6
NORM_EPS = 1e-6
NEG_INF = -1e30

ATT_HEADS = 8
ATT_KV_HEADS = 2
ATT_GROUP = ATT_HEADS // ATT_KV_HEADS
HEAD_DIM = 64
ATT_WIDTH = ATT_HEADS * HEAD_DIM
KV_WIDTH = ATT_KV_HEADS * HEAD_DIM
WINDOW = 128
ATT_BLOCK = 128
ROPE_BASE = 10000.0
ROPE_PAIRS_PER_AXIS = HEAD_DIM // 4

HY_WIDTH = 512
HY_ORDER = 2
HY_N_PROJ = HY_ORDER + 1
HY_SHORT = 3
HY_BANDS = 16
HY_EMB = 1 + 2 * HY_BANDS
HY_FILTER_HIDDEN = 64
HY_DECAY_TARGET = 1e-2
HY_FAST_RATE = -math.log(HY_DECAY_TARGET) / 0.3
HY_SLOW_RATE = -math.log(HY_DECAY_TARGET) / 1.5

S5_WIDTH = 512
S5_GROUP = 16
S5_GROUPS = S5_WIDTH // S5_GROUP
S5_STATE = 64
S5_DT_MIN = 1e-3
S5_DT_MAX = 1e-1

N_BRANCH = 3

PEER_HEADS = 8
PEER_KEYS = 128
PEER_EXPERTS = PEER_KEYS * PEER_KEYS
PEER_HALF = 128
PEER_QDIM = 2 * PEER_HALF
PEER_TOPK = 16
PEER_BLOCK = 128

COL_Q = 0
COL_K = COL_Q + ATT_WIDTH
COL_V = COL_K + KV_WIDTH
COL_S5 = COL_V + KV_WIDTH
COL_HY = COL_S5 + S5_WIDTH
COL_GATE = COL_HY + HY_N_PROJ * HY_WIDTH
IN_WIDTH = COL_GATE + N_BRANCH * D_MODEL

kernel_name = 'hybrid_diffusion_trunk'


def rms_norm(x, g):
    xf = x.astype(jnp.float32)
    y = xf * lax.rsqrt(jnp.mean(xf * xf, axis=-1, keepdims=True) + NORM_EPS)
    return (y * g.astype(jnp.float32)).astype(x.dtype)


def modulate(h, shift, scale):
    return h * (1 + scale) + shift


def axial_rope_tables(L):
    rows_n = L // GRID_W
    row = jnp.repeat(jnp.arange(rows_n), GRID_W).astype(jnp.float32)
    col = jnp.tile(jnp.arange(GRID_W), rows_n).astype(jnp.float32)
    inv = jnp.power(ROPE_BASE, -jnp.arange(ROPE_PAIRS_PER_AXIS, dtype=jnp.float32) / ROPE_PAIRS_PER_AXIS)
    ang = jnp.concatenate([row[:, None] * inv, col[:, None] * inv], axis=-1)
    return jnp.cos(ang), jnp.sin(ang)


def apply_rope(t, cos, sin):
    tf = t.astype(jnp.float32)
    t1, t2 = jnp.split(tf, 2, axis=-1)
    c = cos[None, :, None, :]
    s = sin[None, :, None, :]
    return jnp.concatenate([t1 * c - t2 * s, t1 * s + t2 * c], axis=-1).astype(t.dtype)


def latent_window_attention(q, k, v, kc, vc, sink):
    B, L = q.shape[:2]
    C = kc.shape[1]
    nb = L // ATT_BLOCK
    scale = HEAD_DIM ** -0.5
    qb = q.reshape(B, nb, ATT_BLOCK, ATT_KV_HEADS, ATT_GROUP, HEAD_DIM)
    pad = ((0, 0), (ATT_BLOCK, ATT_BLOCK), (0, 0), (0, 0))

    def band(t):
        tp = jnp.pad(t, pad).reshape(B, nb + 2, ATT_BLOCK, ATT_KV_HEADS, HEAD_DIM)
        return jnp.concatenate([tp[:, :-2], tp[:, 1:-1], tp[:, 2:]], axis=2)

    kb = band(k)
    vb = band(v)
    s_loc = jnp.einsum('bnqhgd,bnkhd->bnhgqk', qb, kb).astype(jnp.float32) * scale
    s_ctx = jnp.einsum('bnqhgd,bchd->bnhgqc', qb, kc).astype(jnp.float32) * scale
    blk = jnp.arange(nb)[:, None, None] * ATT_BLOCK
    qpos = blk + jnp.arange(ATT_BLOCK)[None, :, None]
    kpos = blk - ATT_BLOCK + jnp.arange(3 * ATT_BLOCK)[None, None, :]
    valid = (jnp.abs(kpos - qpos) <= WINDOW) & (kpos >= 0) & (kpos < L)
    s_loc = jnp.where(valid[None, :, None, None], s_loc, NEG_INF)
    s_sink = jnp.broadcast_to(sink.astype(jnp.float32).reshape(1, 1, ATT_KV_HEADS, ATT_GROUP, 1, 1),
                              s_ctx.shape[:-1] + (1,))
    p = jax.nn.softmax(jnp.concatenate([s_sink, s_ctx, s_loc], axis=-1), axis=-1).astype(v.dtype)
    p_ctx = p[..., 1:1 + C]
    p_loc = p[..., 1 + C:]
    o = (jnp.einsum('bnhgqc,bchd->bnqhgd', p_ctx, vc)
         + jnp.einsum('bnhgqk,bnkhd->bnqhgd', p_loc, vb))
    return o.reshape(B, L, ATT_WIDTH)


def context_attention(qc, kc, vc, sink):
    B, C = qc.shape[:2]
    qg = qc.reshape(B, C, ATT_KV_HEADS, ATT_GROUP, HEAD_DIM)
    s = jnp.einsum('bqhgd,bkhd->bhgqk', qg, kc).astype(jnp.float32) * (HEAD_DIM ** -0.5)
    s_sink = jnp.broadcast_to(sink.astype(jnp.float32).reshape(1, ATT_KV_HEADS, ATT_GROUP, 1, 1),
                              s.shape[:-1] + (1,))
    p = jax.nn.softmax(jnp.concatenate([s_sink, s], axis=-1), axis=-1)[..., 1:].astype(vc.dtype)
    o = jnp.einsum('bhgqk,bkhd->bqhgd', p, vc)
    return o.reshape(B, C, ATT_WIDTH)


def short_conv(z, w, b):
    L = z.shape[1]
    half = HY_SHORT // 2
    zp = jnp.pad(z, ((0, 0), (half, half), (0, 0)))
    out = b
    for j in range(HY_SHORT):
        out = out + zp[:, j:j + L] * w[j]
    return out


def hyena_filters(L, lp):
    f32 = jnp.float32
    t = jnp.arange(L, dtype=f32)
    tn = t / L
    bands = jnp.arange(1, HY_BANDS + 1, dtype=f32)
    ang = 2.0 * math.pi * tn[:, None] * bands[None, :]
    z = jnp.concatenate([tn[:, None], jnp.cos(ang), jnp.sin(ang)], axis=-1)
    hdn = jnp.sin(lp['hy_freq1'].astype(f32) * (z @ lp['hy_w1'].astype(f32) + lp['hy_b1'].astype(f32)))
    hdn = jnp.sin(lp['hy_freq2'].astype(f32) * (hdn @ lp['hy_w2'].astype(f32) + lp['hy_b2'].astype(f32)))
    filt = hdn @ lp['hy_w3'].astype(f32)
    rate = jnp.linspace(HY_FAST_RATE, HY_SLOW_RATE, HY_WIDTH, dtype=f32)
    tw = jnp.linspace(0.0, 1.0, L, dtype=f32)
    window = jnp.exp(-tw[:, None] * rate[None, :])
    return filt[:, :HY_WIDTH] * window, filt[:, HY_WIDTH:] * window


def bidirectional_fftconv(u, h_fwd, h_bwd):
    L = u.shape[1]
    n = 2 * L
    kern = jnp.concatenate([h_fwd, jnp.zeros_like(h_fwd[:1]), h_bwd[1:][::-1]], axis=0)
    kf = jnp.fft.rfft(kern, n=n, axis=0)
    uf = jnp.fft.rfft(u.astype(jnp.float32), n=n, axis=1)
    return jnp.fft.irfft(uf * kf[None], n=n, axis=1)[:, :L]


def hyena_mixer(z, lp):
    L = z.shape[1]
    z = short_conv(z, lp['hy_short_w'], lp['hy_short_b'])
    x0, x1, v = jnp.split(z, HY_N_PROJ, axis=-1)
    h_fwd, h_bwd = hyena_filters(L, lp)
    v = v * x1
    y = bidirectional_fftconv(v, h_fwd, h_bwd).astype(z.dtype) + v * lp['hy_bias']
    return y * x0


def s5_discretize(lp, d):
    f32 = jnp.float32
    lam = lax.complex(jnp.minimum(lp['s5_a_re'][d].astype(f32), -1e-4), lp['s5_a_im'][d].astype(f32))
    dt = jnp.exp(lp['s5_log_dt'][d].astype(f32))[:, None]
    abar = jnp.exp(lam * dt)
    b = lax.complex(lp['s5_b_re'][d].astype(f32), lp['s5_b_im'][d].astype(f32))
    bbar = ((abar - 1.0) / lam)[..., None] * b
    cmat = lax.complex(lp['s5_c_re'][d].astype(f32), lp['s5_c_im'][d].astype(f32))
    return abar, bbar, cmat


def s5_drive(u, bbar):
    B, L, _ = u.shape
    ug = u.astype(jnp.float32).reshape(B, L, S5_GROUPS, S5_GROUP).astype(jnp.complex64)
    return jnp.einsum('blgh,gph->blgp', ug, bbar)


def s5_scan(bu, abar, h0, reverse):
    if h0 is not None:
        edge = -1 if reverse else 0
        bu = bu.at[:, edge].add(abar * h0)
    a = jnp.broadcast_to(abar, bu.shape)

    def combine(e1, e2):
        a1, b1 = e1
        a2, b2 = e2
        return a1 * a2, a2 * b1 + b2

    _, h = lax.associative_scan(combine, (a, bu), reverse=reverse, axis=1)
    return h


def s5_readout(h_fwd, h_bwd, c_fwd, c_bwd, u, lp):
    B, L, _ = u.shape
    y = (jnp.einsum('blgp,ghp->blgh', h_fwd, c_fwd)
         + jnp.einsum('blgp,ghp->blgh', h_bwd, c_bwd)).real.reshape(B, L, S5_WIDTH)
    y = (y + lp['s5_d'].astype(jnp.float32) * u.astype(jnp.float32)).astype(u.dtype)
    y = jax.nn.gelu(y)
    return y * jax.nn.sigmoid(y @ lp['s5_glu_w'] + lp['s5_glu_b'])


def s5_mixer(u, uc, lp, need_ctx):
    af, bf, cf = s5_discretize(lp, 0)
    ab, bb, cb = s5_discretize(lp, 1)
    hcf = s5_scan(s5_drive(uc, bf), af, None, False)
    hcb = s5_scan(s5_drive(uc, bb), ab, None, True)
    hf = s5_scan(s5_drive(u, bf), af, hcf[:, -1], False)
    hb = s5_scan(s5_drive(u, bb), ab, hcb[:, 0], True)
    y = s5_readout(hf, hb, cf, cb, u, lp)
    yc = s5_readout(hcf, hcb, cf, cb, uc, lp) if need_ctx else None
    return y, yc


def branch_merge(att, hy, s5, gate_logits, lp):
    g = jax.nn.sigmoid(gate_logits.astype(jnp.float32)).astype(att.dtype)
    ga, gh, gs = jnp.split(g, N_BRANCH, axis=-1)
    m = ga * (att @ lp['br_attn_w']) + gh * (hy @ lp['br_hyena_w']) + gs * (s5 @ lp['br_s5_w'])
    return m @ lp['out_w']


def token_mixer(h, hc, rope_cos, rope_sin, lp, need_ctx):
    B, L, _ = h.shape
    C = hc.shape[1]
    w_in = lp['in_w']
    proj = h @ w_in
    q = apply_rope(proj[..., COL_Q:COL_K].reshape(B, L, ATT_HEADS, HEAD_DIM), rope_cos, rope_sin)
    k = apply_rope(proj[..., COL_K:COL_V].reshape(B, L, ATT_KV_HEADS, HEAD_DIM), rope_cos, rope_sin)
    v = proj[..., COL_V:COL_S5].reshape(B, L, ATT_KV_HEADS, HEAD_DIM)
    u_s5 = proj[..., COL_S5:COL_HY]
    z_hy = proj[..., COL_HY:COL_GATE]
    gates = proj[..., COL_GATE:] + lp['gate_b']
    lo = COL_Q if need_ctx else COL_K
    hi = IN_WIDTH if need_ctx else COL_HY
    projc = hc @ w_in[:, lo:hi]
    kc = projc[..., COL_K - lo:COL_V - lo].reshape(B, C, ATT_KV_HEADS, HEAD_DIM)
    vc = projc[..., COL_V - lo:COL_S5 - lo].reshape(B, C, ATT_KV_HEADS, HEAD_DIM)
    uc_s5 = projc[..., COL_S5 - lo:COL_HY - lo]
    att = latent_window_attention(q, k, v, kc, vc, lp['attn_sink'])
    hy = hyena_mixer(z_hy, lp)
    s5, s5c = s5_mixer(u_s5, uc_s5, lp, need_ctx)
    out = branch_merge(att, hy, s5, gates, lp)
    if not need_ctx:
        return out, None
    qc = projc[..., COL_Q - lo:COL_K - lo].reshape(B, C, ATT_HEADS, HEAD_DIM)
    att_c = context_attention(qc, kc, vc, lp['attn_sink'])
    hy_c = hyena_mixer(projc[..., COL_HY - lo:COL_GATE - lo], lp)
    gates_c = projc[..., COL_GATE - lo:] + lp['gate_b']
    out_c = branch_merge(att_c, hy_c, s5c, gates_c, lp)
    return out, out_c


def peer_ffn(x, wq, sub_keys, u_tab, v_tab):
    B, L, D = x.shape
    nb = L // PEER_BLOCK
    xb = jnp.swapaxes(x.reshape(B, nb, PEER_BLOCK, D), 0, 1)
    kk = PEER_TOPK * PEER_TOPK

    def block(xc):
        q = (xc @ wq).reshape(B, PEER_BLOCK, PEER_HEADS, 2, PEER_HALF)
        s = jnp.einsum('bthsk,hsnk->bthsn', q, sub_keys).astype(jnp.float32)
        s_top, i_top = lax.top_k(s, PEER_TOPK)
        cand = (s_top[..., 0, :, None] + s_top[..., 1, None, :]).reshape(B, PEER_BLOCK, PEER_HEADS, kk)
        cand_id = (i_top[..., 0, :, None] * PEER_KEYS + i_top[..., 1, None, :]).reshape(B, PEER_BLOCK, PEER_HEADS, kk)
        best, pos = lax.top_k(cand, PEER_TOPK)
        expert = jnp.take_along_axis(cand_id, pos, axis=-1)
        gate = jax.nn.softmax(best, axis=-1)
        act = jax.nn.gelu(jnp.einsum('btd,bthkd->bthk', xc, u_tab[expert]).astype(jnp.float32))
        w = (gate * act).astype(xc.dtype)
        return jnp.einsum('bthk,bthkd->btd', w, v_tab[expert])

    return jnp.swapaxes(lax.map(block, xb), 0, 1).reshape(B, L, D)


def setup_inputs(seed: int = 0) -> dict:
    key = jax.random.key(seed)
    keys = iter(jax.random.split(key, 64))
    f32 = jnp.float32

    def nrm(shape, std):
        return std * jax.random.normal(next(keys), shape, f32)

    def near_one(shape):
        return 1.0 + nrm(shape, 0.02)

    L = DEPTH
    hy_cols = HY_N_PROJ * HY_WIDTH
    a_im0 = math.pi * jnp.arange(S5_STATE, dtype=f32)
    return {
        'x': nrm((BATCH, SEQ, D_MODEL), 1.0),
        'c': nrm((BATCH, D_MODEL), 1.0),
        'ctx': nrm((BATCH, CTX_LEN, D_MODEL), 1.0),
        'c_ctx': nrm((D_MODEL,), 1.0),
        'mod_w': nrm((L, D_MODEL, N_MOD * D_MODEL), 0.5 * D_MODEL ** -0.5),
        'mod_b': nrm((L, N_MOD * D_MODEL), 0.02),
        'norm1_g': near_one((L, D_MODEL)),
        'norm2_g': near_one((L, D_MODEL)),
        'in_w': nrm((L, D_MODEL, IN_WIDTH), D_MODEL ** -0.5),
        'gate_b': nrm((L, N_BRANCH * D_MODEL), 0.02),
        'attn_sink': nrm((L, ATT_HEADS), 0.5),
        'hy_short_w': nrm((L, HY_SHORT, hy_cols), HY_SHORT ** -0.5),
        'hy_short_b': nrm((L, hy_cols), 0.02),
        'hy_w1': nrm((L, HY_EMB, HY_FILTER_HIDDEN), HY_EMB ** -0.5),
        'hy_b1': nrm((L, HY_FILTER_HIDDEN), 0.1),
        'hy_freq1': 1.0 + nrm((L, HY_FILTER_HIDDEN), 0.1),
        'hy_w2': nrm((L, HY_FILTER_HIDDEN, HY_FILTER_HIDDEN), HY_FILTER_HIDDEN ** -0.5),
        'hy_b2': nrm((L, HY_FILTER_HIDDEN), 0.1),
        'hy_freq2': 1.0 + nrm((L, HY_FILTER_HIDDEN), 0.1),
        'hy_w3': nrm((L, HY_FILTER_HIDDEN, 2 * HY_WIDTH), 0.01),
        'hy_bias': nrm((L, HY_WIDTH), 0.5),
        's5_a_re': -0.5 + nrm((L, 2, S5_GROUPS, S5_STATE), 0.01),
        's5_a_im': a_im0 + nrm((L, 2, S5_GROUPS, S5_STATE), 0.01),
        's5_log_dt': jax.random.uniform(next(keys), (L, 2, S5_GROUPS), f32, math.log(S5_DT_MIN), math.log(S5_DT_MAX)),
        's5_b_re': nrm((L, 2, S5_GROUPS, S5_STATE, S5_GROUP), (2 * S5_GROUP) ** -0.5),
        's5_b_im': nrm((L, 2, S5_GROUPS, S5_STATE, S5_GROUP), (2 * S5_GROUP) ** -0.5),
        's5_c_re': nrm((L, 2, S5_GROUPS, S5_GROUP, S5_STATE), S5_STATE ** -0.5),
        's5_c_im': nrm((L, 2, S5_GROUPS, S5_GROUP, S5_STATE), S5_STATE ** -0.5),
        's5_d': nrm((L, S5_WIDTH), 1.0),
        's5_glu_w': nrm((L, S5_WIDTH, S5_WIDTH), S5_WIDTH ** -0.5),
        's5_glu_b': nrm((L, S5_WIDTH), 0.02),
        'br_attn_w': nrm((L, ATT_WIDTH, D_MODEL), ATT_WIDTH ** -0.5),
        'br_hyena_w': nrm((L, HY_WIDTH, D_MODEL), HY_WIDTH ** -0.5),
        'br_s5_w': nrm((L, S5_WIDTH, D_MODEL), S5_WIDTH ** -0.5),
        'out_w': nrm((L, D_MODEL, D_MODEL), D_MODEL ** -0.5),
        'peer_wq': nrm((L, D_MODEL, PEER_HEADS * PEER_QDIM), D_MODEL ** -0.5),
        'peer_keys': nrm((L, PEER_HEADS, 2, PEER_KEYS, PEER_HALF), PEER_HALF ** -0.5),
        'peer_u': nrm((L, PEER_EXPERTS, D_MODEL), D_MODEL ** -0.5),
        'peer_v': nrm((L, PEER_EXPERTS, D_MODEL), PEER_HEADS ** -0.5),
        'final_g': near_one((D_MODEL,)),
    }


def reference(x, c, ctx, c_ctx, mod_w, mod_b, norm1_g, norm2_g, in_w, gate_b, attn_sink,
              hy_short_w, hy_short_b, hy_w1, hy_b1, hy_freq1, hy_w2, hy_b2, hy_freq2, hy_w3, hy_bias,
              s5_a_re, s5_a_im, s5_log_dt, s5_b_re, s5_b_im, s5_c_re, s5_c_im, s5_d, s5_glu_w, s5_glu_b,
              br_attn_w, br_hyena_w, br_s5_w, out_w, peer_wq, peer_keys, peer_u, peer_v, final_g):
    L = x.shape[1]
    rope_cos, rope_sin = axial_rope_tables(L)
    xc = ctx
    silu_c = jax.nn.silu(c)
    silu_cc = jax.nn.silu(c_ctx)
    for layer in range(DEPTH):
        need_ctx = layer < DEPTH - 1
        lp = dict(in_w=in_w[layer], gate_b=gate_b[layer], attn_sink=attn_sink[layer],
                  hy_short_w=hy_short_w[layer], hy_short_b=hy_short_b[layer],
                  hy_w1=hy_w1[layer], hy_b1=hy_b1[layer], hy_freq1=hy_freq1[layer],
                  hy_w2=hy_w2[layer], hy_b2=hy_b2[layer], hy_freq2=hy_freq2[layer],
                  hy_w3=hy_w3[layer], hy_bias=hy_bias[layer],
                  s5_a_re=s5_a_re[layer], s5_a_im=s5_a_im[layer], s5_log_dt=s5_log_dt[layer],
                  s5_b_re=s5_b_re[layer], s5_b_im=s5_b_im[layer],
                  s5_c_re=s5_c_re[layer], s5_c_im=s5_c_im[layer], s5_d=s5_d[layer],
                  s5_glu_w=s5_glu_w[layer], s5_glu_b=s5_glu_b[layer],
                  br_attn_w=br_attn_w[layer], br_hyena_w=br_hyena_w[layer], br_s5_w=br_s5_w[layer],
                  out_w=out_w[layer])
        mod = (silu_c @ mod_w[layer] + mod_b[layer])[:, None, :]
        sh1, sc1, g1, sh2, sc2, g2 = jnp.split(mod, N_MOD, axis=-1)
        n_c = (N_MOD if need_ctx else 2) * D_MODEL
        mc = jnp.split(silu_cc @ mod_w[layer][:, :n_c] + mod_b[layer][:n_c], n_c // D_MODEL)
        h = modulate(rms_norm(x, norm1_g[layer]), sh1, sc1)
        hc = modulate(rms_norm(xc, norm1_g[layer]), mc[0], mc[1])
        y, yc = token_mixer(h, hc, rope_cos, rope_sin, lp, need_ctx)
        x = x + g1 * y
        h = modulate(rms_norm(x, norm2_g[layer]), sh2, sc2)
        x = x + g2 * peer_ffn(h, peer_wq[layer], peer_keys[layer], peer_u[layer], peer_v[layer])
        if need_ctx:
            xc = xc + mc[2] * yc
            hc = modulate(rms_norm(xc, norm2_g[layer]), mc[3], mc[4])
            xc = xc + mc[5] * peer_ffn(hc, peer_wq[layer], peer_keys[layer], peer_u[layer], peer_v[layer])
    return rms_norm(x, final_g)
```

```cpp
#include <hip/hip_runtime.h>
#include <stdint.h>
#include <math.h>
#include <stdio.h>

#ifndef PER_PHASE_LAUNCH
#define PER_PHASE_LAUNCH 1
#endif

namespace {
typedef unsigned short bf16;
typedef float f32x4 __attribute__((ext_vector_type(4)));
typedef unsigned u32x2 __attribute__((ext_vector_type(2)));
typedef unsigned u32x4 __attribute__((ext_vector_type(4)));
#define LAS __attribute__((address_space(3)))

constexpr int DM = 1024, NBATCH = 4, SEQ = 4096, CTXL = 256, DEPTH = 2;
constexpr int TL = NBATCH * SEQ, TC = NBATCH * CTXL, TA = TL + TC;
constexpr int INW = 5888, COL_K = 512, COL_V = 640, COL_S5 = 768, COL_HY = 1280, COL_GATE = 2816;
constexpr int NTHREADS = 512, NWAVES = 8;
constexpr float NORM_EPS = 1e-6f;
constexpr float HY_FAST = 15.350567286626973f, HY_SLOW = 3.0701134573253945f;

constexpr size_t MiB = 1u << 20;
constexpr size_t WS_CTL = 0;
constexpr size_t WS_XCUR = 1 * MiB;
constexpr size_t WS_MODV = 69 * MiB;
constexpr size_t WS_ROPE = WS_MODV + 512 * 1024;
constexpr size_t WS_S5A = 70 * MiB;
constexpr size_t WS_S5B = 70 * MiB + 256 * 1024;
constexpr size_t WS_FILT = 72 * MiB;
constexpr size_t FILT_LAYER = 17 * MiB, FILT_CTX_OFF = 16 * MiB;
constexpr size_t WS_H = 106 * MiB;
constexpr size_t WS_Q = 140 * MiB;
constexpr size_t WS_K = 157 * MiB;
constexpr size_t WS_V = WS_K + (size_t)TA * 128 * 2;
constexpr size_t WS_U = WS_V + (size_t)TA * 128 * 2;
constexpr size_t WS_Z = WS_U + (size_t)TA * 512 * 2;
constexpr size_t WS_QP = WS_Q;
constexpr size_t WS_G = 234 * MiB;
constexpr size_t WS_ATT = 336 * MiB;
constexpr size_t WS_HY = WS_ATT + 17 * MiB, WS_S5Y = WS_HY + 17 * MiB, WS_S5O = WS_S5Y + 17 * MiB;
constexpr size_t WS_M = 404 * MiB;
constexpr size_t WS_S5TMP = WS_M;
constexpr size_t WS_VV = 438 * MiB;
constexpr size_t WS_VVC = 470 * MiB;
constexpr size_t WS_X0C = 472 * MiB;
constexpr size_t WS_EID = 489 * MiB;
constexpr size_t WS_EG = WS_EID + (size_t)TA * 128 * 4;
constexpr size_t WS_END = 506 * MiB;

struct Params {
    const float* in[40];
    float* out;
    unsigned char* ws;
    int ph_lo, ph_hi;
};
enum { I_X = 0, I_C, I_CTX, I_CCTX, I_MODW, I_MODB, I_N1G, I_N2G, I_INW, I_GATEB, I_SINK, I_HSW, I_HSB, I_HW1, I_HB1, I_HF1, I_HW2, I_HB2, I_HF2, I_HW3,
       I_HBIAS, I_SARE, I_SAIM, I_SLDT, I_SBRE, I_SBIM, I_SCRE, I_SCIM, I_SD, I_GLUW, I_GLUB, I_BRA, I_BRH, I_BRS, I_OUTW, I_WQ, I_PKEYS, I_PU, I_PV, I_FG };

struct Ctx { int tid, bid, nb; };
__device__ __forceinline__ const Params& get_params() { const Params* q = (const Params*)__builtin_amdgcn_kernarg_segment_ptr(); asm volatile("" : "+s"(q)); return *q; }
__device__ __forceinline__ float bf2f(bf16 v) { return __uint_as_float((unsigned)v << 16); }
__device__ __forceinline__ bf16 f2bf(float f) { unsigned u = __float_as_uint(f); return (bf16)((u + 0x7fffu + ((u >> 16) & 1u)) >> 16); }
__device__ __forceinline__ unsigned pk2(float lo, float hi) { return (unsigned)f2bf(lo) | ((unsigned)f2bf(hi) << 16); }
__device__ __forceinline__ float wave_sum(float v) {
#pragma unroll
    for (int o = 32; o > 0; o >>= 1) v += __shfl_xor(v, o);
    return v;
}
__device__ __forceinline__ float sigmoidf_(float x) { return 1.f / (1.f + __expf(-x)); }
__device__ __forceinline__ float gelu_tanh(float x) { const float u = 0.7978845608028654f * (x + 0.044715f * x * x * x); return 0.5f * x * (1.f + tanhf(u)); }
__device__ __forceinline__ int row_mi(int r) { return r < TL ? (r >> 12) : 4; }
__device__ __forceinline__ int row_b(int r) { return r < TL ? (r >> 12) : ((r - TL) >> 8); }

#define XB_TMO      128
#define XB_XCNT(j)  (256  + 64 * (j))
#define XB_XSUB(j)  (1280 + 64 * (j))
#define XB_XGEN(j)  (2304 + 64 * (j))
#define XB_TOP      3328
#define XB_TOPGEN   3392
#define XCD_BAR_WORDS 3456
#define XB_SPIN_CAP (1u << 27)
__device__ __forceinline__ unsigned xb_ld(unsigned* p)              { return __hip_atomic_load(p, __ATOMIC_RELAXED, __HIP_MEMORY_SCOPE_AGENT); }
__device__ __forceinline__ unsigned xb_add(unsigned* p, unsigned v) { return __hip_atomic_fetch_add(p, v, __ATOMIC_RELAXED, __HIP_MEMORY_SCOPE_AGENT); }
__device__ __forceinline__ unsigned xb_xcc_id() { return (unsigned)__builtin_amdgcn_s_getreg((3 << 11) | 20) & 0xFu; }
#define XB_SPIN(cond, bar) do { unsigned _sp = 0; while (cond) { __builtin_amdgcn_s_sleep(1); \
    if ((++_sp & 255u) == 0u) { if (xb_ld(&(bar)[XB_TMO])) break; if (_sp > XB_SPIN_CAP) { atomicAdd(&(bar)[XB_TMO], 1u); break; } } } } while (0)
struct XcdBarrier { unsigned* bar; unsigned x; volatile LAS unsigned* st; };
__device__ __forceinline__ XcdBarrier xcd_barrier_post(unsigned* bar, volatile LAS unsigned* st) {
    XcdBarrier b; b.bar = bar; b.x = xb_xcc_id(); b.st = st;
    if (threadIdx.x == 0) (void)xb_add(&bar[XB_XCNT(b.x)], 1u);
    return b;
}
__device__ __forceinline__ void xcd_barrier_complete(unsigned* bar, unsigned x, unsigned& nloc, unsigned& nx) {
    const unsigned G = gridDim.x * gridDim.y * gridDim.z;
    unsigned sum, cnt, mine, sp = 0u;
    for (;;) {
        sum = 0u; cnt = 0u; mine = 0u;
#pragma unroll
        for (unsigned j = 0; j < 16; ++j) { const unsigned c = xb_ld(&bar[XB_XCNT(j)]); sum += c; cnt += (c > 0u) ? 1u : 0u; mine = (j == x) ? c : mine; }
        if (sum == G) break;
        __builtin_amdgcn_s_sleep(1);
        if ((++sp & 255u) == 0u) { if (xb_ld(&bar[XB_TMO])) break; if (sp > XB_SPIN_CAP) { atomicAdd(&bar[XB_TMO], 1u); break; } }
    }
    nloc = mine > 0u ? mine : 1u; nx = cnt > 0u ? cnt : 1u;
}
__device__ __forceinline__ void xcd_barrier(const XcdBarrier& b) {
    asm volatile("s_waitcnt vmcnt(0)" ::: "memory");
    __syncthreads();
    if (threadIdx.x == 0) {
        unsigned* bar = b.bar;
        __builtin_amdgcn_s_waitcnt(0);
        unsigned nloc = b.st[0], nx = b.st[1];
        if (nloc == 0u) { xcd_barrier_complete(bar, b.x, nloc, nx); b.st[0] = nloc; b.st[1] = nx; }
        const unsigned old = xb_add(&bar[XB_XSUB(b.x)], 1u);
        const unsigned gen = old / nloc;
        if (old + 1u == (gen + 1u) * nloc) {
            __builtin_amdgcn_fence(__ATOMIC_RELEASE, "agent");
            asm volatile("s_waitcnt vmcnt(0)" ::: "memory");
            const unsigned og = xb_add(&bar[XB_TOP], 1u);
            const unsigned tg = og / nx;
            if (og + 1u == (tg + 1u) * nx) xb_add(&bar[XB_TOPGEN], 1u);
            else XB_SPIN(xb_ld(&bar[XB_TOPGEN]) == tg, bar);
            __builtin_amdgcn_fence(__ATOMIC_ACQUIRE, "agent");
            xb_add(&bar[XB_XGEN(b.x)], 1u);
            asm volatile("s_waitcnt vmcnt(0)" ::: "memory");
        } else {
            XB_SPIN(xb_ld(&bar[XB_XGEN(b.x)]) == gen, bar);
            __builtin_amdgcn_fence(__ATOMIC_ACQUIRE, "agent");
            asm volatile("s_waitcnt vmcnt(0)" ::: "memory");
        }
    }
    __syncthreads();
}

__device__ __forceinline__ void ph_prologue(const Ctx& cx0, float* sm) {
    { const Params& p = get_params(); Ctx cx = cx0;
    const int tid = cx.tid, lane = tid & 63, wave = tid >> 6;
    const int gt = cx.bid * NTHREADS + tid, NGT = cx.nb * NTHREADS;
    const int gw = cx.bid * NWAVES + wave, NGW = cx.nb * NWAVES;
    unsigned char* ws = p.ws;
    {
        f32x4* dst = (f32x4*)(ws + WS_XCUR);
        const f32x4* sx = (const f32x4*)p.in[I_X]; const f32x4* sc = (const f32x4*)p.in[I_CTX];
        for (int i = gt; i < TL * DM / 4; i += NGT) dst[i] = sx[i];
        for (int i = gt; i < TC * DM / 4; i += NGT) dst[TL * DM / 4 + i] = sc[i];
    }
    }
    { const Params& p = get_params(); Ctx cx; cx.tid = threadIdx.x; cx.bid = blockIdx.x; cx.nb = gridDim.x; asm volatile("" : "+v"(cx.tid), "+s"(cx.bid), "+s"(cx.nb));
      const int tid = cx.tid, lane = tid & 63, wave = tid >> 6; const int gt = cx.bid * NTHREADS + tid, NGT = cx.nb * NTHREADS; const int gw = cx.bid * NWAVES + wave, NGW = cx.nb * NWAVES; unsigned char* ws = p.ws; (void)lane; (void)gt; (void)NGT; (void)gw; (void)NGW; (void)ws;
    {
        float* sil = sm;
        float* red = sm + 5 * 1024;
        bool have = false;
        for (int it = cx.bid; it < 192; it += cx.nb) {
            if (!have) {
                for (int i = tid; i < 5 * 1024; i += NTHREADS) { const float v = i < 4096 ? p.in[I_C][i] : p.in[I_CCTX][i - 4096]; sil[i] = v / (1.f + __expf(-v)); }
                have = true; __syncthreads();
            }
            const int layer = it / 96, col = (it % 96) * 64 + lane, kp = wave;
            const float* W = p.in[I_MODW] + (size_t)layer * DM * 6144 + col;
            float a0 = 0, a1 = 0, a2 = 0, a3 = 0, a4 = 0;
            for (int k = kp * 128; k < kp * 128 + 128; ++k) { const float w = W[(size_t)k * 6144]; a0 += sil[k] * w; a1 += sil[1024 + k] * w; a2 += sil[2048 + k] * w; a3 += sil[3072 + k] * w; a4 += sil[4096 + k] * w; }
            red[(kp * 5 + 0) * 64 + lane] = a0; red[(kp * 5 + 1) * 64 + lane] = a1; red[(kp * 5 + 2) * 64 + lane] = a2; red[(kp * 5 + 3) * 64 + lane] = a3; red[(kp * 5 + 4) * 64 + lane] = a4;
            __syncthreads();
            if (tid < 320) { const int j = tid >> 6; float s = 0; for (int q = 0; q < 8; ++q) s += red[(q * 5 + j) * 64 + lane];
                ((float*)(ws + WS_MODV))[((size_t)layer * 5 + j) * 6144 + col] = s + p.in[I_MODB][layer * 6144 + col]; }
            __syncthreads();
        }
    }
    }
    { const Params& p = get_params(); Ctx cx; cx.tid = threadIdx.x; cx.bid = blockIdx.x; cx.nb = gridDim.x; asm volatile("" : "+v"(cx.tid), "+s"(cx.bid), "+s"(cx.nb));
      const int tid = cx.tid, lane = tid & 63, wave = tid >> 6; const int gt = cx.bid * NTHREADS + tid, NGT = cx.nb * NTHREADS; const int gw = cx.bid * NWAVES + wave, NGW = cx.nb * NWAVES; unsigned char* ws = p.ws; (void)lane; (void)gt; (void)NGT; (void)gw; (void)NGW; (void)ws;
    for (int i = gt; i < 64 * 16; i += NGT) { const int pos = i >> 4, f = i & 15; const double ang = (double)pos * pow(10000.0, -(double)f / 16.0);
        ((float*)(ws + WS_ROPE))[i * 2] = (float)cos(ang); ((float*)(ws + WS_ROPE))[i * 2 + 1] = (float)sin(ang); }
    }
    { const Params& p = get_params(); Ctx cx; cx.tid = threadIdx.x; cx.bid = blockIdx.x; cx.nb = gridDim.x; asm volatile("" : "+v"(cx.tid), "+s"(cx.bid), "+s"(cx.nb));
      const int tid = cx.tid, lane = tid & 63, wave = tid >> 6; const int gt = cx.bid * NTHREADS + tid, NGT = cx.nb * NTHREADS; const int gw = cx.bid * NWAVES + wave, NGW = cx.nb * NWAVES; unsigned char* ws = p.ws; (void)lane; (void)gt; (void)NGT; (void)gw; (void)NGW; (void)ws;
    for (int i = gt; i < 2 * 2 * 32 * 64; i += NGT) {
        const int g = (i >> 6) & 31, ld = i >> 11;
        const double are = fmin((double)p.in[I_SARE][i], -1e-4), aim = (double)p.in[I_SAIM][i];
        const double dt = exp((double)p.in[I_SLDT][ld * 32 + g]);
        const double er = exp(are * dt), abr = er * cos(aim * dt), abi = er * sin(aim * dt);
        const double nr = abr - 1.0, ni = abi, den = are * are + aim * aim;
        const double cr = (nr * are + ni * aim) / den, ci = (ni * are - nr * aim) / den;
        ((float*)(ws + WS_S5A))[i * 2] = (float)abr; ((float*)(ws + WS_S5A))[i * 2 + 1] = (float)abi;
        for (int h = 0; h < 16; ++h) { const double br = p.in[I_SBRE][(size_t)i * 16 + h], bi = p.in[I_SBIM][(size_t)i * 16 + h];
            ((float*)(ws + WS_S5B))[((size_t)i * 16 + h) * 2] = (float)(cr * br - ci * bi); ((float*)(ws + WS_S5B))[((size_t)i * 16 + h) * 2 + 1] = (float)(cr * bi + ci * br); }
    }
    }
    { const Params& p = get_params(); Ctx cx; cx.tid = threadIdx.x; cx.bid = blockIdx.x; cx.nb = gridDim.x; asm volatile("" : "+v"(cx.tid), "+s"(cx.bid), "+s"(cx.nb));
      const int tid = cx.tid, lane = tid & 63, wave = tid >> 6; const int gt = cx.bid * NTHREADS + tid, NGT = cx.nb * NTHREADS; const int gw = cx.bid * NWAVES + wave, NGW = cx.nb * NWAVES; unsigned char* ws = p.ws; (void)lane; (void)gt; (void)NGT; (void)gw; (void)NGW; (void)ws;
    for (int it = gw; it < DEPTH * (SEQ + CTXL); it += NGW) {
        const int layer = it / (SEQ + CTXL), r = it % (SEQ + CTXL), st = r >= SEQ ? 1 : 0, t = st ? r - SEQ : r, L = st ? CTXL : SEQ;
        const float tn = (float)t / (float)L;
        float z = 0.f;
        if (lane == 0) z = tn;
        else if (lane <= 16) z = cosf(6.283185307179586f * tn * (float)lane);
        else if (lane <= 32) z = sinf(6.283185307179586f * tn * (float)(lane - 16));
        const float* w1 = p.in[I_HW1] + layer * 33 * 64; const float* w2 = p.in[I_HW2] + layer * 64 * 64; const float* w3 = p.in[I_HW3] + layer * 64 * 1024;
        float a = p.in[I_HB1][layer * 64 + lane];
        for (int e = 0; e < 33; ++e) a += __shfl(z, e) * w1[e * 64 + lane];
        const float h1 = sinf(p.in[I_HF1][layer * 64 + lane] * a);
        float a2 = p.in[I_HB2][layer * 64 + lane];
        for (int j = 0; j < 64; ++j) a2 += __shfl(h1, j) * w2[j * 64 + lane];
        const float h2 = sinf(p.in[I_HF2][layer * 64 + lane] * a2);
        const float tw = (float)t / (float)(L - 1);
        float* fbase = (float*)(ws + WS_FILT + layer * FILT_LAYER + (st ? FILT_CTX_OFF : 0));
        for (int cc = 0; cc < 16; ++cc) {
            const int col = cc * 64 + lane; float f = 0.f;
            for (int j = 0; j < 64; ++j) f += __shfl(h2, j) * w3[j * 1024 + col];
            const int c = col & 511, isb = col >> 9;
            const float rate = HY_FAST + (HY_SLOW - HY_FAST) * ((float)c / 511.f);
            fbase[((size_t)isb * 512 + c) * L + t] = f * __expf(-tw * rate);
        }
    }
    }
}

__device__ __forceinline__ void ph_norm(const Ctx& cx, int layer, int which, int nrows_lat_only) {
    const Params& p = get_params();
    const int lane = cx.tid & 63, wave = cx.tid >> 6;
    const int gw = cx.bid * NWAVES + wave, NGW = cx.nb * NWAVES;
    const float* g = p.in[which ? I_N2G : I_N1G] + layer * DM;
    const float* xc = (const float*)(p.ws + WS_XCUR);
    bf16* H = (bf16*)(p.ws + WS_H);
    const int nrows = nrows_lat_only ? TL : TA;
    for (int r = gw; r < nrows; r += NGW) {
        const float* mv = (const float*)(p.ws + WS_MODV) + ((size_t)layer * 5 + row_mi(r)) * 6144 + (which ? 3072 : 0);
        f32x4 v[4]; float s = 0.f;
#pragma unroll
        for (int j = 0; j < 4; ++j) { v[j] = *(const f32x4*)(xc + (size_t)r * DM + j * 256 + lane * 4); s += v[j].x * v[j].x + v[j].y * v[j].y + v[j].z * v[j].z + v[j].w * v[j].w; }
        const float rs = rsqrtf(wave_sum(s) * (1.f / DM) + NORM_EPS);
#pragma unroll
        for (int j = 0; j < 4; ++j) { const int c = j * 256 + lane * 4;
            const f32x4 gg = *(const f32x4*)(g + c), sh = *(const f32x4*)(mv + c), sc = *(const f32x4*)(mv + 1024 + c);
            const f32x4 y = v[j] * rs * gg; const f32x4 h = y * (1.f + sc) + sh;
            u32x2 w; w.x = pk2(h.x, h.y); w.y = pk2(h.z, h.w); *(u32x2*)(H + (size_t)r * DM + c) = w; }
    }
}

__device__ __forceinline__ void gemm_tile_acc(const Ctx& cx, float (&acc)[4][8], const bf16* A, int lda, const float* W, int ldw, int K, int row0, int col0, float* sm) {
    const int tid = cx.tid, ty = tid >> 4, tx = tid & 15;
    float* As = sm; float* Bs = sm + 16 * 132;
    const int ar = tid >> 2, akq = tid & 3, bk = tid >> 5, bn = tid & 31;
    for (int k0 = 0; k0 < K; k0 += 16) {
        const u32x2 av = *(const u32x2*)(A + (size_t)(row0 + ar) * lda + k0 + akq * 4);
        const f32x4 bv = *(const f32x4*)(W + (size_t)(k0 + bk) * ldw + col0 + bn * 4);
        __syncthreads();
        As[(akq * 4 + 0) * 132 + ar] = __uint_as_float(av.x << 16); As[(akq * 4 + 1) * 132 + ar] = __uint_as_float(av.x & 0xffff0000u);
        As[(akq * 4 + 2) * 132 + ar] = __uint_as_float(av.y << 16); As[(akq * 4 + 3) * 132 + ar] = __uint_as_float(av.y & 0xffff0000u);
        *(f32x4*)(Bs + bk * 132 + bn * 4) = bv;
        __syncthreads();
#pragma unroll 4
        for (int kk = 0; kk < 16; ++kk) {
            const f32x4 a = *(const f32x4*)(As + kk * 132 + ty * 4);
            float b[8];
#pragma unroll
            for (int j = 0; j < 8; ++j) b[j] = Bs[kk * 132 + tx + 16 * j];
#pragma unroll
            for (int j = 0; j < 8; ++j) { acc[0][j] += a.x * b[j]; acc[1][j] += a.y * b[j]; acc[2][j] += a.z * b[j]; acc[3][j] += a.w * b[j]; }
        }
    }
}
#define ZERO_ACC(acc) do { _Pragma("unroll") for (int i_ = 0; i_ < 4; ++i_) _Pragma("unroll") for (int j_ = 0; j_ < 8; ++j_) acc[i_][j_] = 0.f; } while (0)

__device__ __forceinline__ void ph_inproj(const Ctx& cx, int layer, float* sm) {
    const Params& p = get_params();
    const int tid = cx.tid, ty = tid >> 4, tx = tid & 15;
    const bf16* H = (const bf16*)(p.ws + WS_H); const float* W = p.in[I_INW] + (size_t)layer * DM * INW;
    const float* rope = (const float*)(p.ws + WS_ROPE);
    const int nM = TA / 128, nN = INW / 128;
    for (int t = cx.bid; t < nM * nN; t += cx.nb) {
        const int tm = t / nN, tn = t % nN, row0 = tm * 128, col0 = tn * 128;
        if (layer == DEPTH - 1 && row0 >= TL && (col0 < COL_K || col0 >= COL_HY)) continue;
        float acc[4][8]; ZERO_ACC(acc);
        gemm_tile_acc(cx, acc, H, DM, W, INW, DM, row0, col0, sm);
#pragma unroll
        for (int i = 0; i < 4; ++i) {
            const int r = row0 + ty * 4 + i;
            if (col0 < COL_V) {
                if (r < TL) { const int l = r & 4095, pr = l >> 6, pc = l & 63;
#pragma unroll
                    for (int j = 0; j < 8; ++j) if ((j & 3) < 2) { const int ii = tx + 16 * (j & 1); const int pos = ii < 16 ? pr : pc; const float cs = rope[(pos * 16 + (ii & 15)) * 2], sn = rope[(pos * 16 + (ii & 15)) * 2 + 1];
                        const float t1 = acc[i][j], t2 = acc[i][j + 2]; acc[i][j] = t1 * cs - t2 * sn; acc[i][j + 2] = t1 * sn + t2 * cs; } }
                bf16* dst = col0 < COL_K ? (bf16*)(p.ws + WS_Q) + (size_t)r * 512 + col0 : (bf16*)(p.ws + WS_K) + (size_t)r * 128;
#pragma unroll
                for (int j = 0; j < 8; ++j) dst[tx + 16 * j] = f2bf(acc[i][j]);
            } else if (col0 < COL_S5) { bf16* dst = (bf16*)(p.ws + WS_V) + (size_t)r * 128;
#pragma unroll
                for (int j = 0; j < 8; ++j) dst[tx + 16 * j] = f2bf(acc[i][j]);
            } else if (col0 < COL_HY) { bf16* dst = (bf16*)(p.ws + WS_U) + (size_t)r * 512 + (col0 - COL_S5);
#pragma unroll
                for (int j = 0; j < 8; ++j) dst[tx + 16 * j] = f2bf(acc[i][j]);
            } else if (col0 < COL_GATE) { bf16* dst = (bf16*)(p.ws + WS_Z) + (size_t)r * 1536 + (col0 - COL_HY);
#pragma unroll
                for (int j = 0; j < 8; ++j) dst[tx + 16 * j] = f2bf(acc[i][j]);
            } else { bf16* dst = (bf16*)(p.ws + WS_G) + (size_t)r * 3072 + (col0 - COL_GATE); const float* gb = p.in[I_GATEB] + layer * 3072 + (col0 - COL_GATE);
#pragma unroll
                for (int j = 0; j < 8; ++j) dst[tx + 16 * j] = f2bf(sigmoidf_(acc[i][j] + gb[tx + 16 * j]));
            }
        }
    }
}

__device__ __forceinline__ void ph_attn(const Ctx& cx, int layer) {
    const Params& p = get_params();
    const int gt = cx.bid * NTHREADS + cx.tid, NGT = cx.nb * NTHREADS;
    const bf16* Q = (const bf16*)(p.ws + WS_Q); const bf16* Kb = (const bf16*)(p.ws + WS_K); const bf16* Vb = (const bf16*)(p.ws + WS_V);
    bf16* O = (bf16*)(p.ws + WS_ATT);
    const int nrows = layer == 0 ? TA : TL;
    for (int it4 = gt; it4 < nrows * 8 * 4; it4 += NGT) {
        const int sub = it4 & 3, it = it4 >> 2;
        const int h = it / nrows, r = it % nrows;
        const int b = row_b(r), kvh = h >> 2;
        float q[16], acc[16];
#pragma unroll
        for (int d8 = 0; d8 < 2; ++d8) { const u32x4 w = *(const u32x4*)(Q + (size_t)r * 512 + h * 64 + sub * 16 + d8 * 8);
            q[d8 * 8 + 0] = __uint_as_float(w.x << 16); q[d8 * 8 + 1] = __uint_as_float(w.x & 0xffff0000u); q[d8 * 8 + 2] = __uint_as_float(w.y << 16); q[d8 * 8 + 3] = __uint_as_float(w.y & 0xffff0000u);
            q[d8 * 8 + 4] = __uint_as_float(w.z << 16); q[d8 * 8 + 5] = __uint_as_float(w.z & 0xffff0000u); q[d8 * 8 + 6] = __uint_as_float(w.w << 16); q[d8 * 8 + 7] = __uint_as_float(w.w & 0xffff0000u); }
#pragma unroll
        for (int d = 0; d < 16; ++d) acc[d] = 0.f;
        float m = p.in[I_SINK][layer * 8 + h], l = 1.f;
        int wlo = 0, whi = -1;
        if (r < TL) { const int pos = r & 4095; wlo = pos - 128 < 0 ? 0 : pos - 128; whi = pos + 128 > SEQ - 1 ? SEQ - 1 : pos + 128; }
        const int nwin = whi - wlo + 1;
        for (int kk = 0; kk < 256 + nwin; ++kk) {
            const int kr = kk < 256 ? TL + b * 256 + kk : b * SEQ + wlo + (kk - 256);
            const bf16* kp = Kb + (size_t)kr * 128 + kvh * 64 + sub * 16; const bf16* vp = Vb + (size_t)kr * 128 + kvh * 64 + sub * 16;
            float s = 0.f;
#pragma unroll
            for (int d8 = 0; d8 < 2; ++d8) { const u32x4 w = *(const u32x4*)(kp + d8 * 8);
                s += q[d8 * 8 + 0] * __uint_as_float(w.x << 16) + q[d8 * 8 + 1] * __uint_as_float(w.x & 0xffff0000u) + q[d8 * 8 + 2] * __uint_as_float(w.y << 16) + q[d8 * 8 + 3] * __uint_as_float(w.y & 0xffff0000u)
                   + q[d8 * 8 + 4] * __uint_as_float(w.z << 16) + q[d8 * 8 + 5] * __uint_as_float(w.z & 0xffff0000u) + q[d8 * 8 + 6] * __uint_as_float(w.w << 16) + q[d8 * 8 + 7] * __uint_as_float(w.w & 0xffff0000u); }
            s += __shfl_xor(s, 1); s += __shfl_xor(s, 2);
            s *= 0.125f;
            const float mn = fmaxf(m, s), f = __expf(m - mn), e = __expf(s - mn);
            l = l * f + e; m = mn;
#pragma unroll
            for (int d8 = 0; d8 < 2; ++d8) { const u32x4 w = *(const u32x4*)(vp + d8 * 8);
                acc[d8 * 8 + 0] = acc[d8 * 8 + 0] * f + e * __uint_as_float(w.x << 16); acc[d8 * 8 + 1] = acc[d8 * 8 + 1] * f + e * __uint_as_float(w.x & 0xffff0000u);
                acc[d8 * 8 + 2] = acc[d8 * 8 + 2] * f + e * __uint_as_float(w.y << 16); acc[d8 * 8 + 3] = acc[d8 * 8 + 3] * f + e * __uint_as_float(w.y & 0xffff0000u);
                acc[d8 * 8 + 4] = acc[d8 * 8 + 4] * f + e * __uint_as_float(w.z << 16); acc[d8 * 8 + 5] = acc[d8 * 8 + 5] * f + e * __uint_as_float(w.z & 0xffff0000u);
                acc[d8 * 8 + 6] = acc[d8 * 8 + 6] * f + e * __uint_as_float(w.w << 16); acc[d8 * 8 + 7] = acc[d8 * 8 + 7] * f + e * __uint_as_float(w.w & 0xffff0000u); }
        }
        const float il = 1.f / l;
#pragma unroll
        for (int d8 = 0; d8 < 2; ++d8) { u32x4 w; w.x = pk2(acc[d8 * 8] * il, acc[d8 * 8 + 1] * il); w.y = pk2(acc[d8 * 8 + 2] * il, acc[d8 * 8 + 3] * il); w.z = pk2(acc[d8 * 8 + 4] * il, acc[d8 * 8 + 5] * il); w.w = pk2(acc[d8 * 8 + 6] * il, acc[d8 * 8 + 7] * il);
            *(u32x4*)(O + (size_t)r * 512 + h * 64 + sub * 16 + d8 * 8) = w; }
    }
}

__device__ __forceinline__ void ph_hypre(const Ctx& cx, int layer) {
    const Params& p = get_params();
    const int gt = cx.bid * NTHREADS + cx.tid, NGT = cx.nb * NTHREADS;
    const bf16* Z = (const bf16*)(p.ws + WS_Z); const float* sw = p.in[I_HSW] + layer * 3 * 1536; const float* sb = p.in[I_HSB] + layer * 1536;
    const int nrows = layer == 0 ? TA : TL;
    for (int it = gt; it < nrows * 512; it += NGT) {
        const int r = it >> 9, c = it & 511;
        int t, L; if (r < TL) { t = r & 4095; L = SEQ; } else { t = (r - TL) & 255; L = CTXL; }
        float o[3];
#pragma unroll
        for (int q = 0; q < 3; ++q) { const int col = q * 512 + c; float a = sb[col] + sw[1536 + col] * bf2f(Z[(size_t)r * 1536 + col]);
            if (t > 0) a += sw[col] * bf2f(Z[(size_t)(r - 1) * 1536 + col]);
            if (t < L - 1) a += sw[2 * 1536 + col] * bf2f(Z[(size_t)(r + 1) * 1536 + col]);
            o[q] = a; }
        ((bf16*)(p.ws + WS_X0C))[(size_t)r * 512 + c] = f2bf(o[0]);
        const int b = row_b(r);
        if (r < TL) ((float*)(p.ws + WS_VV))[((size_t)b * 512 + c) * SEQ + t] = o[2] * o[1];
        else ((float*)(p.ws + WS_VVC))[((size_t)b * 512 + c) * CTXL + t] = o[2] * o[1];
    }
}

__device__ __forceinline__ void ph_hyconv(const Ctx& cx, int layer, float* sm) {
    const Params& p = get_params();
    const int tid = cx.tid;
    const int nitems = 2048 + (layer == 0 ? 2048 : 0);
    float* Tl = sm;
    for (int it = cx.bid; it < nitems; it += cx.nb) {
        const int st = it >= 2048, bc = it & 2047, b = bc >> 9, c = bc & 511, L = st ? CTXL : SEQ;
        float* Vl = sm + 2 * L;
        const float* fb = (const float*)(p.ws + WS_FILT + layer * FILT_LAYER + (st ? FILT_CTX_OFF : 0));
        const float* hf = fb + (size_t)c * L; const float* hb = fb + ((size_t)512 + c) * L;
        const float* vv = st ? (const float*)(p.ws + WS_VVC) + (size_t)bc * CTXL : (const float*)(p.ws + WS_VV) + (size_t)bc * SEQ;
        __syncthreads();
        for (int i = tid; i < L; i += NTHREADS) { Tl[L - 1 + i] = hf[i]; if (i > 0) Tl[L - 1 - i] = hb[i]; Vl[i] = vv[i]; }
        __syncthreads();
        const float bias = p.in[I_HBIAS][layer * 512 + c];
        const int rbase = st ? TL + b * CTXL : b * SEQ;
        for (int t0 = 0; t0 < L; t0 += NTHREADS * 8) {
            float a[8];
#pragma unroll
            for (int j = 0; j < 8; ++j) a[j] = 0.f;
            if (t0 + tid < L) {
                for (int s = 0; s < L; ++s) { const float v = Vl[s]; const float* tp = Tl + (t0 + tid - s + L - 1);
#pragma unroll
                    for (int j = 0; j < 8; ++j) if (t0 + tid + j * NTHREADS < L) a[j] += v * tp[j * NTHREADS]; }
#pragma unroll
                for (int j = 0; j < 8; ++j) { const int t = t0 + tid + j * NTHREADS; if (t < L) { const size_t o = (size_t)(rbase + t) * 512 + c;
                    ((bf16*)(p.ws + WS_HY))[o] = f2bf((a[j] + Vl[t] * bias) * bf2f(((const bf16*)(p.ws + WS_X0C))[o])); } }
            }
        }
    }
}

__device__ __forceinline__ void ph_s5scan(const Ctx& cx, int layer) {
    const Params& p = get_params();
    const int lane = cx.tid & 63, wave = cx.tid >> 6;
    const int gw = cx.bid * NWAVES + wave, NGW = cx.nb * NWAVES;
    const bf16* U = (const bf16*)(p.ws + WS_U); float* Y = (float*)(p.ws + WS_S5TMP);
    for (int it = gw; it < 128; it += NGW) {
        const int b = it >> 5, g = it & 31;
        for (int dir = 0; dir < 2; ++dir) {
            const int pi = ((layer * 2 + dir) * 32 + g) * 64 + lane;
            const float ar = ((const float*)(p.ws + WS_S5A))[pi * 2], ai = ((const float*)(p.ws + WS_S5A))[pi * 2 + 1];
            float br[16], bi[16], cr[16], ci[16];
#pragma unroll
            for (int h = 0; h < 16; ++h) { br[h] = ((const float*)(p.ws + WS_S5B))[((size_t)pi * 16 + h) * 2]; bi[h] = ((const float*)(p.ws + WS_S5B))[((size_t)pi * 16 + h) * 2 + 1];
                const size_t cidx = ((size_t)((layer * 2 + dir) * 32 + g) * 16 + h) * 64 + lane; cr[h] = p.in[I_SCRE][cidx]; ci[h] = p.in[I_SCIM][cidx]; }
            float hr = 0.f, hi = 0.f;
            for (int step = 0; step < CTXL + SEQ; ++step) {
                int r;
                if (dir == 0) r = step < CTXL ? TL + b * CTXL + step : b * SEQ + (step - CTXL);
                else r = step < CTXL ? TL + b * CTXL + (CTXL - 1 - step) : b * SEQ + (SEQ - 1 - (step - CTXL));
                const u32x4 w0 = *(const u32x4*)(U + (size_t)r * 512 + g * 16), w1 = *(const u32x4*)(U + (size_t)r * 512 + g * 16 + 8);
                float u[16];
                u[0] = __uint_as_float(w0.x << 16); u[1] = __uint_as_float(w0.x & 0xffff0000u); u[2] = __uint_as_float(w0.y << 16); u[3] = __uint_as_float(w0.y & 0xffff0000u);
                u[4] = __uint_as_float(w0.z << 16); u[5] = __uint_as_float(w0.z & 0xffff0000u); u[6] = __uint_as_float(w0.w << 16); u[7] = __uint_as_float(w0.w & 0xffff0000u);
                u[8] = __uint_as_float(w1.x << 16); u[9] = __uint_as_float(w1.x & 0xffff0000u); u[10] = __uint_as_float(w1.y << 16); u[11] = __uint_as_float(w1.y & 0xffff0000u);
                u[12] = __uint_as_float(w1.z << 16); u[13] = __uint_as_float(w1.z & 0xffff0000u); u[14] = __uint_as_float(w1.w << 16); u[15] = __uint_as_float(w1.w & 0xffff0000u);
                float dr = 0.f, di = 0.f;
#pragma unroll
                for (int h = 0; h < 16; ++h) { dr += br[h] * u[h]; di += bi[h] * u[h]; }
                const float nr = ar * hr - ai * hi + dr, ni = ar * hi + ai * hr + di; hr = nr; hi = ni;
                if (layer == 0 || r < TL) {
                    float mine = 0.f;
#pragma unroll
                    for (int o = 0; o < 16; ++o) { const float v = wave_sum(cr[o] * hr - ci[o] * hi); if (lane == o) mine = v; }
                    if (lane < 16) { float* yp = Y + (size_t)r * 512 + g * 16 + lane; if (dir == 0) *yp = mine; else *yp += mine; }
                }
            }
        }
    }
}
__device__ __forceinline__ void ph_s5read(const Ctx& cx, int layer) {
    const Params& p = get_params();
    const int gt = cx.bid * NTHREADS + cx.tid, NGT = cx.nb * NTHREADS;
    const int nrows = layer == 0 ? TA : TL;
    for (int i = gt; i < nrows * 512; i += NGT) { const int c = i & 511;
        const float y = ((const float*)(p.ws + WS_S5TMP))[i] + p.in[I_SD][layer * 512 + c] * bf2f(((const bf16*)(p.ws + WS_U))[i]);
        ((bf16*)(p.ws + WS_S5Y))[i] = f2bf(gelu_tanh(y)); }
}

__device__ __forceinline__ void ph_glu(const Ctx& cx, int layer, float* sm) {
    const Params& p = get_params();
    const int tid = cx.tid, ty = tid >> 4, tx = tid & 15;
    const int nrows = layer == 0 ? TA : TL, nM = nrows / 128, nN = 4;
    const bf16* A = (const bf16*)(p.ws + WS_S5Y); const float* W = p.in[I_GLUW] + (size_t)layer * 512 * 512;
    for (int t = cx.bid; t < nM * nN; t += cx.nb) {
        const int row0 = (t / nN) * 128, col0 = (t % nN) * 128;
        float acc[4][8]; ZERO_ACC(acc);
        gemm_tile_acc(cx, acc, A, 512, W, 512, 512, row0, col0, sm);
#pragma unroll
        for (int i = 0; i < 4; ++i)
#pragma unroll
            for (int j = 0; j < 8; ++j) { const size_t o = (size_t)(row0 + ty * 4 + i) * 512 + col0 + tx + 16 * j;
                ((bf16*)(p.ws + WS_S5O))[o] = f2bf(bf2f(A[o]) * sigmoidf_(acc[i][j] + p.in[I_GLUB][layer * 512 + col0 + tx + 16 * j])); }
    }
}
__device__ __forceinline__ void ph_merge(const Ctx& cx, int layer, float* sm) {
    const Params& p = get_params();
    const int tid = cx.tid, ty = tid >> 4, tx = tid & 15;
    const int nrows = layer == 0 ? TA : TL, nM = nrows / 128, nN = 8;
    const bf16* G = (const bf16*)(p.ws + WS_G);
    for (int t = cx.bid; t < nM * nN; t += cx.nb) {
        const int row0 = (t / nN) * 128, col0 = (t % nN) * 128;
        float tot[4][8]; ZERO_ACC(tot);
#pragma unroll 1
        for (int br = 0; br < 3; ++br) {
            const bf16* A = (const bf16*)(p.ws + (br == 0 ? WS_ATT : br == 1 ? WS_HY : WS_S5O));
            const float* W = p.in[br == 0 ? I_BRA : br == 1 ? I_BRH : I_BRS] + (size_t)layer * 512 * 1024;
            float acc[4][8]; ZERO_ACC(acc);
            gemm_tile_acc(cx, acc, A, 512, W, 1024, 512, row0, col0, sm);
#pragma unroll
            for (int i = 0; i < 4; ++i)
#pragma unroll
                for (int j = 0; j < 8; ++j) tot[i][j] += bf2f(G[(size_t)(row0 + ty * 4 + i) * 3072 + br * 1024 + col0 + tx + 16 * j]) * acc[i][j];
        }
#pragma unroll
        for (int i = 0; i < 4; ++i)
#pragma unroll
            for (int j = 0; j < 8; ++j) ((bf16*)(p.ws + WS_M))[(size_t)(row0 + ty * 4 + i) * 1024 + col0 + tx + 16 * j] = f2bf(tot[i][j]);
    }
}
__device__ __forceinline__ void ph_outproj(const Ctx& cx, int layer, float* sm) {
    const Params& p = get_params();
    const int tid = cx.tid, ty = tid >> 4, tx = tid & 15;
    const int nrows = layer == 0 ? TA : TL, nM = nrows / 128, nN = 8;
    const bf16* A = (const bf16*)(p.ws + WS_M); const float* W = p.in[I_OUTW] + (size_t)layer * 1024 * 1024;
    float* X = (float*)(p.ws + WS_XCUR);
    for (int t = cx.bid; t < nM * nN; t += cx.nb) {
        const int row0 = (t / nN) * 128, col0 = (t % nN) * 128;
        float acc[4][8]; ZERO_ACC(acc);
        gemm_tile_acc(cx, acc, A, 1024, W, 1024, 1024, row0, col0, sm);
#pragma unroll
        for (int i = 0; i < 4; ++i) { const int r = row0 + ty * 4 + i; const float* g1 = (const float*)(p.ws + WS_MODV) + ((size_t)layer * 5 + row_mi(r)) * 6144 + 2048;
#pragma unroll
            for (int j = 0; j < 8; ++j) { const int c = col0 + tx + 16 * j; X[(size_t)r * 1024 + c] += g1[c] * acc[i][j]; } }
    }
}
__device__ __forceinline__ void ph_qp(const Ctx& cx, int layer, float* sm) {
    const Params& p = get_params();
    const int tid = cx.tid, ty = tid >> 4, tx = tid & 15;
    const int nrows = layer == 0 ? TA : TL, nM = nrows / 128, nN = 16;
    const bf16* A = (const bf16*)(p.ws + WS_H); const float* W = p.in[I_WQ] + (size_t)layer * 1024 * 2048;
    for (int t = cx.bid; t < nM * nN; t += cx.nb) {
        const int row0 = (t / nN) * 128, col0 = (t % nN) * 128;
        float acc[4][8]; ZERO_ACC(acc);
        gemm_tile_acc(cx, acc, A, 1024, W, 2048, 1024, row0, col0, sm);
#pragma unroll
        for (int i = 0; i < 4; ++i)
#pragma unroll
            for (int j = 0; j < 8; ++j) ((bf16*)(p.ws + WS_QP))[(size_t)(row0 + ty * 4 + i) * 2048 + col0 + tx + 16 * j] = f2bf(acc[i][j]);
    }
}

__device__ __forceinline__ void wave_argmax(float& v, int& i) {
#pragma unroll
    for (int o = 32; o > 0; o >>= 1) { const float ov = __shfl_xor(v, o); const int oi = __shfl_xor(i, o); if (ov > v || (ov == v && oi < i)) { v = ov; i = oi; } }
}
__device__ __forceinline__ void ph_select(const Ctx& cx, int layer) {
    const Params& p = get_params();
    const int lane = cx.tid & 63, wave = cx.tid >> 6;
    const int gw = cx.bid * NWAVES + wave, NGW = cx.nb * NWAVES;
    const int nrows = layer == 0 ? TA : TL;
    const bf16* QP = (const bf16*)(p.ws + WS_QP);
    for (int it = gw; it < nrows * 8; it += NGW) {
        const int r = it >> 3, h = it & 7;
        float tv[2]; int ti[2]; tv[0] = tv[1] = 0.f; ti[0] = ti[1] = 0;
#pragma unroll
        for (int s = 0; s < 2; ++s) {
            const unsigned qw = *(const unsigned*)(QP + (size_t)r * 2048 + (h * 2 + s) * 128 + lane * 2);
            const float q0 = __uint_as_float(qw << 16), q1 = __uint_as_float(qw & 0xffff0000u);
            const float* k0 = p.in[I_PKEYS] + ((((size_t)layer * 8 + h) * 2 + s) * 128 + lane) * 128; const float* k1 = k0 + 64 * 128;
            float s0 = 0.f, s1 = 0.f;
            for (int k4 = 0; k4 < 32; ++k4) { const f32x4 a = *(const f32x4*)(k0 + k4 * 4), bb = *(const f32x4*)(k1 + k4 * 4);
                const float qa = __shfl(q0, 2 * k4), qb = __shfl(q1, 2 * k4), qc = __shfl(q0, 2 * k4 + 1), qd = __shfl(q1, 2 * k4 + 1);
                s0 += qa * a.x + qb * a.y + qc * a.z + qd * a.w; s1 += qa * bb.x + qb * bb.y + qc * bb.z + qd * bb.w; }
            for (int j = 0; j < 16; ++j) {
                float bv; int bi; if (s0 >= s1) { bv = s0; bi = lane; } else { bv = s1; bi = lane + 64; }
                wave_argmax(bv, bi);
                if (lane == j) { tv[s] = bv; ti[s] = bi; }
                if (bi == lane) s0 = -INFINITY; else if (bi == lane + 64) s1 = -INFINITY;
            }
        }
        float cv[4]; const float va = __shfl(tv[0], lane >> 2);
#pragma unroll
        for (int q = 0; q < 4; ++q) cv[q] = va + __shfl(tv[1], (lane & 3) * 4 + q);
        float bestv = 0.f; int bestc = 0;
        for (int j = 0; j < 16; ++j) {
            float bv = cv[0]; int bi = lane * 4;
#pragma unroll
            for (int q = 1; q < 4; ++q) if (cv[q] > bv) { bv = cv[q]; bi = lane * 4 + q; }
            wave_argmax(bv, bi);
            if (lane == j) { bestv = bv; bestc = bi; }
            if ((bi >> 2) == lane) {
#pragma unroll
                for (int q = 0; q < 4; ++q) if ((bi & 3) == q) cv[q] = -INFINITY; }
        }
        const int ia = __shfl(ti[0], bestc >> 4), ib = __shfl(ti[1], bestc & 15);
        const float mx = __shfl(bestv, 0);
        const float e = lane < 16 ? __expf(bestv - mx) : 0.f;
        const float sum = wave_sum(e);
        if (lane < 16) { ((int*)(p.ws + WS_EID))[(size_t)r * 128 + h * 16 + lane] = ia * 128 + ib; ((float*)(p.ws + WS_EG))[(size_t)r * 128 + h * 16 + lane] = e / sum; }
    }
}
__device__ __forceinline__ void ph_gather(const Ctx& cx, int layer) {
    const Params& p = get_params();
    const int lane = cx.tid & 63, wave = cx.tid >> 6;
    const int gw = cx.bid * NWAVES + wave, NGW = cx.nb * NWAVES;
    const int nrows = layer == 0 ? TA : TL;
    const float* PU = p.in[I_PU] + (size_t)layer * 16384 * 1024; const float* PV = p.in[I_PV] + (size_t)layer * 16384 * 1024;
    float* X = (float*)(p.ws + WS_XCUR);
    for (int r = gw; r < nrows; r += NGW) {
        f32x4 x[4], o[4];
#pragma unroll
        for (int j = 0; j < 4; ++j) { const u32x2 w = *(const u32x2*)((const bf16*)(p.ws + WS_H) + (size_t)r * 1024 + j * 256 + lane * 4);
            x[j] = (f32x4){__uint_as_float(w.x << 16), __uint_as_float(w.x & 0xffff0000u), __uint_as_float(w.y << 16), __uint_as_float(w.y & 0xffff0000u)}; o[j] = (f32x4){0.f, 0.f, 0.f, 0.f}; }
        for (int hk = 0; hk < 128; ++hk) {
            const int e = ((const int*)(p.ws + WS_EID))[(size_t)r * 128 + hk]; const float g = ((const float*)(p.ws + WS_EG))[(size_t)r * 128 + hk];
            const float* ur = PU + (size_t)e * 1024 + lane * 4; const float* vr = PV + (size_t)e * 1024 + lane * 4;
            float d = 0.f;
#pragma unroll
            for (int j = 0; j < 4; ++j) { const f32x4 uu = *(const f32x4*)(ur + j * 256); d += x[j].x * uu.x + x[j].y * uu.y + x[j].z * uu.z + x[j].w * uu.w; }
            d = wave_sum(d);
            const float w = g * gelu_tanh(d);
#pragma unroll
            for (int j = 0; j < 4; ++j) { const f32x4 vvv = *(const f32x4*)(vr + j * 256); o[j] += w * vvv; }
        }
        const float* g2 = (const float*)(p.ws + WS_MODV) + ((size_t)layer * 5 + row_mi(r)) * 6144 + 5120;
        float ss = 0.f;
#pragma unroll
        for (int j = 0; j < 4; ++j) { const int c = j * 256 + lane * 4; f32x4 xv = *(const f32x4*)(X + (size_t)r * 1024 + c); xv += *(const f32x4*)(g2 + c) * o[j]; *(f32x4*)(X + (size_t)r * 1024 + c) = xv; o[j] = xv;
            ss += xv.x * xv.x + xv.y * xv.y + xv.z * xv.z + xv.w * xv.w; }
        if (layer == DEPTH - 1) {
            const float rs = rsqrtf(wave_sum(ss) * (1.f / DM) + NORM_EPS);
#pragma unroll
            for (int j = 0; j < 4; ++j) { const int c = j * 256 + lane * 4; *(f32x4*)(p.out + (size_t)r * 1024 + c) = o[j] * rs * *(const f32x4*)(p.in[I_FG] + c); }
        }
    }
}

constexpr int NPL = 11, NPHASE = 1 + DEPTH * NPL;
__global__ void __launch_bounds__(NTHREADS) mk_fwd(Params p) {
    __shared__ __attribute__((aligned(16))) float sm[12288 + 16];
    const int tid = threadIdx.x;
    volatile LAS unsigned* st = (volatile LAS unsigned*)(LAS float*)(sm + 12288);
    if (tid < 4) st[tid] = 0u;
    __syncthreads();
    XcdBarrier bar; bar.bar = (unsigned*)(p.ws + WS_CTL) + 4096; bar.x = 0; bar.st = st;
    const bool multi = (p.ph_hi - p.ph_lo) > 1;
    if (multi) bar = xcd_barrier_post((unsigned*)(p.ws + WS_CTL) + 4096, st);
    for (int ph = p.ph_lo; ph < p.ph_hi; ++ph) {
        Ctx cx; cx.tid = threadIdx.x; cx.bid = blockIdx.x; cx.nb = gridDim.x; asm volatile("" : "+v"(cx.tid), "+s"(cx.bid), "+s"(cx.nb));
#ifndef ONLY
#define ONLY -1
#endif
#ifndef NOT
#define NOT -1
#endif
#define ON(n) ((ONLY < 0 || ONLY == (n)) && NOT != (n))
        if (ph == 0) { if (ON(100)) ph_prologue(cx, sm); }
        else {
            const int layer = (ph - 1) / NPL, sub = (ph - 1) % NPL;
            switch (sub) {
                case 0: if (ON(0)) ph_norm(cx, layer, 0, 0); break;
                case 1: if (ON(1)) ph_inproj(cx, layer, sm); break;
                case 2: if (ON(2)) ph_attn(cx, layer); if (ON(20)) ph_hypre(cx, layer); if (ON(21)) ph_s5scan(cx, layer); break;
                case 3: if (ON(3)) ph_hyconv(cx, layer, sm); if (ON(30)) ph_s5read(cx, layer); break;
                case 4: if (ON(4)) ph_glu(cx, layer, sm); break;
                case 5: if (ON(5)) ph_merge(cx, layer, sm); break;
                case 6: if (ON(6)) ph_outproj(cx, layer, sm); break;
                case 7: if (ON(7)) ph_norm(cx, layer, 1, layer == DEPTH - 1); break;
                case 8: if (ON(8)) ph_qp(cx, layer, sm); break;
                case 9: if (ON(9)) ph_select(cx, layer); break;
                case 10: if (ON(10)) ph_gather(cx, layer); break;
            }
        }
        if (ph + 1 < p.ph_hi) xcd_barrier(bar);
    }
}
}

extern "C" void kernel_launch(void* const* d_in, const int* in_sizes, int n_in, void* d_out, int out_size, void* d_ws, size_t ws_size, hipStream_t stream) {
    static int grid = 0;
    if (grid == 0) {
        if (n_in != 40 || out_size != TL * DM || ws_size < WS_END) { fprintf(stderr, "kernel_launch: unexpected shapes (n_in %d out %d ws %zu)\n", n_in, out_size, ws_size); grid = -1; return; }
        int dev = 0, cus = 0;
        if (hipGetDevice(&dev) != hipSuccess || hipDeviceGetAttribute(&cus, hipDeviceAttributeMultiprocessorCount, dev) != hipSuccess) { grid = -1; return; }
        grid = cus;
    }
    if (grid < 0) return;
    (void)hipMemsetAsync((char*)d_ws + WS_CTL, 0, 1 * MiB, stream);
    Params a{};
    for (int i = 0; i < 40; ++i) a.in[i] = (const float*)d_in[i];
    a.out = (float*)d_out; a.ws = (unsigned char*)d_ws;
#if PER_PHASE_LAUNCH
    for (int ph = 0; ph < NPHASE; ++ph) { a.ph_lo = ph; a.ph_hi = ph + 1; hipLaunchKernelGGL(mk_fwd, dim3(grid), dim3(NTHREADS), 0, stream, a); }
#else
    a.ph_lo = 0; a.ph_hi = NPHASE; hipLaunchKernelGGL(mk_fwd, dim3(grid), dim3(NTHREADS), 0, stream, a);
#endif
}
```

```cpp
#include <hip/hip_runtime.h>
#include <stdint.h>
#include <math.h>
#include <stdio.h>

#ifndef PER_PHASE_LAUNCH
#define PER_PHASE_LAUNCH 0
#endif

namespace {
typedef unsigned short bf16;
typedef float f32x4 __attribute__((ext_vector_type(4)));
typedef unsigned u32x2 __attribute__((ext_vector_type(2)));
typedef unsigned u32x4 __attribute__((ext_vector_type(4)));
#define LAS __attribute__((address_space(3)))

constexpr int DM = 1024, NBATCH = 4, SEQ = 4096, CTXL = 256, DEPTH = 2;
constexpr int TL = NBATCH * SEQ, TC = NBATCH * CTXL, TA = TL + TC;
constexpr int INW = 5888, COL_K = 512, COL_V = 640, COL_S5 = 768, COL_HY = 1280, COL_GATE = 2816;
constexpr int NTHREADS = 512, NWAVES = 8;
constexpr float NORM_EPS = 1e-6f;
constexpr float HY_FAST = 15.350567286626973f, HY_SLOW = 3.0701134573253945f;

constexpr size_t MiB = 1u << 20;
constexpr size_t WS_CTL = 0;
constexpr size_t WS_XCUR = 1 * MiB;
constexpr size_t WS_MODV = 69 * MiB;
constexpr size_t WS_ROPE = WS_MODV + 512 * 1024;
constexpr size_t WS_S5A = 70 * MiB;
constexpr size_t WS_S5B = 70 * MiB + 256 * 1024;
constexpr size_t WS_FILT = 72 * MiB;
constexpr size_t FILT_LAYER = 17 * MiB, FILT_CTX_OFF = 16 * MiB;
constexpr size_t WS_H = 106 * MiB;
constexpr size_t WS_Q = 140 * MiB;
constexpr size_t WS_K = 157 * MiB;
constexpr size_t WS_V = WS_K + (size_t)TA * 128 * 2;
constexpr size_t WS_U = WS_V + (size_t)TA * 128 * 2;
constexpr size_t WS_Z = WS_U + (size_t)TA * 512 * 2;
constexpr size_t WS_QP = WS_Q;
constexpr size_t WS_G = 234 * MiB;
constexpr size_t WS_ATT = 336 * MiB;
constexpr size_t WS_HY = WS_ATT + 17 * MiB, WS_S5Y = WS_HY + 17 * MiB, WS_S5O = WS_S5Y + 17 * MiB;
constexpr size_t WS_M = 404 * MiB;
constexpr size_t WS_S5TMP = WS_M;
constexpr size_t WS_VV = 438 * MiB;
constexpr size_t WS_VVC = 470 * MiB;
constexpr size_t WS_X0C = 472 * MiB;
constexpr size_t WS_EID = 489 * MiB;
constexpr size_t WS_EG = WS_EID + (size_t)TA * 128 * 4;
constexpr size_t WS_END = 506 * MiB;

struct Params {
    const float* in[40];
    float* out;
    unsigned char* ws;
    int ph_lo, ph_hi;
};
enum { I_X = 0, I_C, I_CTX, I_CCTX, I_MODW, I_MODB, I_N1G, I_N2G, I_INW, I_GATEB, I_SINK, I_HSW, I_HSB, I_HW1, I_HB1, I_HF1, I_HW2, I_HB2, I_HF2, I_HW3,
       I_HBIAS, I_SARE, I_SAIM, I_SLDT, I_SBRE, I_SBIM, I_SCRE, I_SCIM, I_SD, I_GLUW, I_GLUB, I_BRA, I_BRH, I_BRS, I_OUTW, I_WQ, I_PKEYS, I_PU, I_PV, I_FG };

struct Ctx { int tid, bid, nb; };
__device__ __forceinline__ const Params& get_params() { const Params* q = (const Params*)__builtin_amdgcn_kernarg_segment_ptr(); asm volatile("" : "+s"(q)); return *q; }
__device__ __forceinline__ float bf2f(bf16 v) { return __uint_as_float((unsigned)v << 16); }
__device__ __forceinline__ bf16 f2bf(float f) { unsigned u = __float_as_uint(f); return (bf16)((u + 0x7fffu + ((u >> 16) & 1u)) >> 16); }
__device__ __forceinline__ unsigned pk2(float lo, float hi) { return (unsigned)f2bf(lo) | ((unsigned)f2bf(hi) << 16); }
__device__ __forceinline__ float wave_sum(float v) {
#pragma unroll
    for (int o = 32; o > 0; o >>= 1) v += __shfl_xor(v, o);
    return v;
}
__device__ __forceinline__ float sigmoidf_(float x) { return 1.f / (1.f + __expf(-x)); }
__device__ __forceinline__ float gelu_tanh(float x) { const float u = 0.7978845608028654f * (x + 0.044715f * x * x * x); return 0.5f * x * (1.f + tanhf(u)); }
__device__ __forceinline__ int row_mi(int r) { return r < TL ? (r >> 12) : 4; }
__device__ __forceinline__ int row_b(int r) { return r < TL ? (r >> 12) : ((r - TL) >> 8); }

#define XB_TMO      128
#define XB_XCNT(j)  (256  + 64 * (j))
#define XB_XSUB(j)  (1280 + 64 * (j))
#define XB_XGEN(j)  (2304 + 64 * (j))
#define XB_TOP      3328
#define XB_TOPGEN   3392
#define XCD_BAR_WORDS 3456
#define XB_SPIN_CAP (1u << 27)
__device__ __forceinline__ unsigned xb_ld(unsigned* p)              { return __hip_atomic_load(p, __ATOMIC_RELAXED, __HIP_MEMORY_SCOPE_AGENT); }
__device__ __forceinline__ unsigned xb_add(unsigned* p, unsigned v) { return __hip_atomic_fetch_add(p, v, __ATOMIC_RELAXED, __HIP_MEMORY_SCOPE_AGENT); }
__device__ __forceinline__ unsigned xb_xcc_id() { return (unsigned)__builtin_amdgcn_s_getreg((3 << 11) | 20) & 0xFu; }
#define XB_SPIN(cond, bar) do { unsigned _sp = 0; while (cond) { __builtin_amdgcn_s_sleep(1); \
    if ((++_sp & 255u) == 0u) { if (xb_ld(&(bar)[XB_TMO])) break; if (_sp > XB_SPIN_CAP) { atomicAdd(&(bar)[XB_TMO], 1u); break; } } } } while (0)
struct XcdBarrier { unsigned* bar; unsigned x; volatile LAS unsigned* st; };
__device__ __forceinline__ XcdBarrier xcd_barrier_post(unsigned* bar, volatile LAS unsigned* st) {
    XcdBarrier b; b.bar = bar; b.x = xb_xcc_id(); b.st = st;
    if (threadIdx.x == 0) (void)xb_add(&bar[XB_XCNT(b.x)], 1u);
    return b;
}
__device__ __forceinline__ void xcd_barrier_complete(unsigned* bar, unsigned x, unsigned& nloc, unsigned& nx) {
    const unsigned G = gridDim.x * gridDim.y * gridDim.z;
    unsigned sum, cnt, mine, sp = 0u;
    for (;;) {
        sum = 0u; cnt = 0u; mine = 0u;
#pragma unroll
        for (unsigned j = 0; j < 16; ++j) { const unsigned c = xb_ld(&bar[XB_XCNT(j)]); sum += c; cnt += (c > 0u) ? 1u : 0u; mine = (j == x) ? c : mine; }
        if (sum == G) break;
        __builtin_amdgcn_s_sleep(1);
        if ((++sp & 255u) == 0u) { if (xb_ld(&bar[XB_TMO])) break; if (sp > XB_SPIN_CAP) { atomicAdd(&bar[XB_TMO], 1u); break; } }
    }
    nloc = mine > 0u ? mine : 1u; nx = cnt > 0u ? cnt : 1u;
}
__device__ __forceinline__ void xcd_barrier(const XcdBarrier& b) {
    asm volatile("s_waitcnt vmcnt(0)" ::: "memory");
    __syncthreads();
    if (threadIdx.x == 0) {
        unsigned* bar = b.bar;
        __builtin_amdgcn_s_waitcnt(0);
        unsigned nloc = b.st[0], nx = b.st[1];
        if (nloc == 0u) { xcd_barrier_complete(bar, b.x, nloc, nx); b.st[0] = nloc; b.st[1] = nx; }
        const unsigned old = xb_add(&bar[XB_XSUB(b.x)], 1u);
        const unsigned gen = old / nloc;
        if (old + 1u == (gen + 1u) * nloc) {
            __builtin_amdgcn_fence(__ATOMIC_RELEASE, "agent");
            asm volatile("s_waitcnt vmcnt(0)" ::: "memory");
            const unsigned og = xb_add(&bar[XB_TOP], 1u);
            const unsigned tg = og / nx;
            if (og + 1u == (tg + 1u) * nx) xb_add(&bar[XB_TOPGEN], 1u);
            else XB_SPIN(xb_ld(&bar[XB_TOPGEN]) == tg, bar);
            __builtin_amdgcn_fence(__ATOMIC_ACQUIRE, "agent");
            xb_add(&bar[XB_XGEN(b.x)], 1u);
            asm volatile("s_waitcnt vmcnt(0)" ::: "memory");
        } else {
            XB_SPIN(xb_ld(&bar[XB_XGEN(b.x)]) == gen, bar);
            __builtin_amdgcn_fence(__ATOMIC_ACQUIRE, "agent");
            asm volatile("s_waitcnt vmcnt(0)" ::: "memory");
        }
    }
    __syncthreads();
}

__device__ __forceinline__ void ph_prologue(const Ctx& cx0, float* sm) {
    { const Params& p = get_params(); Ctx cx = cx0;
    const int tid = cx.tid, lane = tid & 63, wave = tid >> 6;
    const int gt = cx.bid * NTHREADS + tid, NGT = cx.nb * NTHREADS;
    const int gw = cx.bid * NWAVES + wave, NGW = cx.nb * NWAVES;
    unsigned char* ws = p.ws;
    {
        f32x4* dst = (f32x4*)(ws + WS_XCUR);
        const f32x4* sx = (const f32x4*)p.in[I_X]; const f32x4* sc = (const f32x4*)p.in[I_CTX];
        for (int i = gt; i < TL * DM / 4; i += NGT) dst[i] = sx[i];
        for (int i = gt; i < TC * DM / 4; i += NGT) dst[TL * DM / 4 + i] = sc[i];
    }
    }
    { const Params& p = get_params(); Ctx cx; cx.tid = threadIdx.x; cx.bid = blockIdx.x; cx.nb = gridDim.x; asm volatile("" : "+v"(cx.tid), "+s"(cx.bid), "+s"(cx.nb));
      const int tid = cx.tid, lane = tid & 63, wave = tid >> 6; const int gt = cx.bid * NTHREADS + tid, NGT = cx.nb * NTHREADS; const int gw = cx.bid * NWAVES + wave, NGW = cx.nb * NWAVES; unsigned char* ws = p.ws; (void)lane; (void)gt; (void)NGT; (void)gw; (void)NGW; (void)ws;
    {
        float* sil = sm;
        float* red = sm + 5 * 1024;
        bool have = false;
        for (int it = cx.bid; it < 192; it += cx.nb) {
            if (!have) {
                for (int i = tid; i < 5 * 1024; i += NTHREADS) { const float v = i < 4096 ? p.in[I_C][i] : p.in[I_CCTX][i - 4096]; sil[i] = v / (1.f + __expf(-v)); }
                have = true; __syncthreads();
            }
            const int layer = it / 96, col = (it % 96) * 64 + lane, kp = wave;
            const float* W = p.in[I_MODW] + (size_t)layer * DM * 6144 + col;
            float a0 = 0, a1 = 0, a2 = 0, a3 = 0, a4 = 0;
            for (int k = kp * 128; k < kp * 128 + 128; ++k) { const float w = W[(size_t)k * 6144]; a0 += sil[k] * w; a1 += sil[1024 + k] * w; a2 += sil[2048 + k] * w; a3 += sil[3072 + k] * w; a4 += sil[4096 + k] * w; }
            red[(kp * 5 + 0) * 64 + lane] = a0; red[(kp * 5 + 1) * 64 + lane] = a1; red[(kp * 5 + 2) * 64 + lane] = a2; red[(kp * 5 + 3) * 64 + lane] = a3; red[(kp * 5 + 4) * 64 + lane] = a4;
            __syncthreads();
            if (tid < 320) { const int j = tid >> 6; float s = 0; for (int q = 0; q < 8; ++q) s += red[(q * 5 + j) * 64 + lane];
                ((float*)(ws + WS_MODV))[((size_t)layer * 5 + j) * 6144 + col] = s + p.in[I_MODB][layer * 6144 + col]; }
            __syncthreads();
        }
    }
    }
    { const Params& p = get_params(); Ctx cx; cx.tid = threadIdx.x; cx.bid = blockIdx.x; cx.nb = gridDim.x; asm volatile("" : "+v"(cx.tid), "+s"(cx.bid), "+s"(cx.nb));
      const int tid = cx.tid, lane = tid & 63, wave = tid >> 6; const int gt = cx.bid * NTHREADS + tid, NGT = cx.nb * NTHREADS; const int gw = cx.bid * NWAVES + wave, NGW = cx.nb * NWAVES; unsigned char* ws = p.ws; (void)lane; (void)gt; (void)NGT; (void)gw; (void)NGW; (void)ws;
    for (int i = gt; i < 64 * 16; i += NGT) { const int pos = i >> 4, f = i & 15; const double ang = (double)pos * pow(10000.0, -(double)f / 16.0);
        ((float*)(ws + WS_ROPE))[i * 2] = (float)cos(ang); ((float*)(ws + WS_ROPE))[i * 2 + 1] = (float)sin(ang); }
    }
    { const Params& p = get_params(); Ctx cx; cx.tid = threadIdx.x; cx.bid = blockIdx.x; cx.nb = gridDim.x; asm volatile("" : "+v"(cx.tid), "+s"(cx.bid), "+s"(cx.nb));
      const int tid = cx.tid, lane = tid & 63, wave = tid >> 6; const int gt = cx.bid * NTHREADS + tid, NGT = cx.nb * NTHREADS; const int gw = cx.bid * NWAVES + wave, NGW = cx.nb * NWAVES; unsigned char* ws = p.ws; (void)lane; (void)gt; (void)NGT; (void)gw; (void)NGW; (void)ws;
    for (int i = gt; i < 2 * 2 * 32 * 64; i += NGT) {
        const int g = (i >> 6) & 31, ld = i >> 11;
        const double are = fmin((double)p.in[I_SARE][i], -1e-4), aim = (double)p.in[I_SAIM][i];
        const double dt = exp((double)p.in[I_SLDT][ld * 32 + g]);
        const double er = exp(are * dt), abr = er * cos(aim * dt), abi = er * sin(aim * dt);
        const double nr = abr - 1.0, ni = abi, den = are * are + aim * aim;
        const double cr = (nr * are + ni * aim) / den, ci = (ni * are - nr * aim) / den;
        ((float*)(ws + WS_S5A))[i * 2] = (float)abr; ((float*)(ws + WS_S5A))[i * 2 + 1] = (float)abi;
        for (int h = 0; h < 16; ++h) { const double br = p.in[I_SBRE][(size_t)i * 16 + h], bi = p.in[I_SBIM][(size_t)i * 16 + h];
            ((float*)(ws + WS_S5B))[((size_t)i * 16 + h) * 2] = (float)(cr * br - ci * bi); ((float*)(ws + WS_S5B))[((size_t)i * 16 + h) * 2 + 1] = (float)(cr * bi + ci * br); }
    }
    }
    { const Params& p = get_params(); Ctx cx; cx.tid = threadIdx.x; cx.bid = blockIdx.x; cx.nb = gridDim.x; asm volatile("" : "+v"(cx.tid), "+s"(cx.bid), "+s"(cx.nb));
      const int tid = cx.tid, lane = tid & 63, wave = tid >> 6; const int gt = cx.bid * NTHREADS + tid, NGT = cx.nb * NTHREADS; const int gw = cx.bid * NWAVES + wave, NGW = cx.nb * NWAVES; unsigned char* ws = p.ws; (void)lane; (void)gt; (void)NGT; (void)gw; (void)NGW; (void)ws;
    for (int it = gw; it < DEPTH * (SEQ + CTXL); it += NGW) {
        const int layer = it / (SEQ + CTXL), r = it % (SEQ + CTXL), st = r >= SEQ ? 1 : 0, t = st ? r - SEQ : r, L = st ? CTXL : SEQ;
        const float tn = (float)t / (float)L;
        float z = 0.f;
        if (lane == 0) z = tn;
        else if (lane <= 16) z = cosf(6.283185307179586f * tn * (float)lane);
        else if (lane <= 32) z = sinf(6.283185307179586f * tn * (float)(lane - 16));
        const float* w1 = p.in[I_HW1] + layer * 33 * 64; const float* w2 = p.in[I_HW2] + layer * 64 * 64; const float* w3 = p.in[I_HW3] + layer * 64 * 1024;
        float a = p.in[I_HB1][layer * 64 + lane];
        for (int e = 0; e < 33; ++e) a += __shfl(z, e) * w1[e * 64 + lane];
        const float h1 = sinf(p.in[I_HF1][layer * 64 + lane] * a);
        float a2 = p.in[I_HB2][layer * 64 + lane];
        for (int j = 0; j < 64; ++j) a2 += __shfl(h1, j) * w2[j * 64 + lane];
        const float h2 = sinf(p.in[I_HF2][layer * 64 + lane] * a2);
        const float tw = (float)t / (float)(L - 1);
        float* fbase = (float*)(ws + WS_FILT + layer * FILT_LAYER + (st ? FILT_CTX_OFF : 0));
        for (int cc = 0; cc < 16; ++cc) {
            const int col = cc * 64 + lane; float f = 0.f;
            for (int j = 0; j < 64; ++j) f += __shfl(h2, j) * w3[j * 1024 + col];
            const int c = col & 511, isb = col >> 9;
            const float rate = HY_FAST + (HY_SLOW - HY_FAST) * ((float)c / 511.f);
            fbase[((size_t)isb * 512 + c) * L + t] = f * __expf(-tw * rate);
        }
    }
    }
}

__device__ __forceinline__ void ph_norm(const Ctx& cx, int layer, int which, int nrows_lat_only) {
    const Params& p = get_params();
    const int lane = cx.tid & 63, wave = cx.tid >> 6;
    const int gw = cx.bid * NWAVES + wave, NGW = cx.nb * NWAVES;
    const float* g = p.in[which ? I_N2G : I_N1G] + layer * DM;
    const float* xc = (const float*)(p.ws + WS_XCUR);
    bf16* H = (bf16*)(p.ws + WS_H);
    const int nrows = nrows_lat_only ? TL : TA;
    for (int r = gw; r < nrows; r += NGW) {
        const float* mv = (const float*)(p.ws + WS_MODV) + ((size_t)layer * 5 + row_mi(r)) * 6144 + (which ? 3072 : 0);
        f32x4 v[4]; float s = 0.f;
#pragma unroll
        for (int j = 0; j < 4; ++j) { v[j] = *(const f32x4*)(xc + (size_t)r * DM + j * 256 + lane * 4); s += v[j].x * v[j].x + v[j].y * v[j].y + v[j].z * v[j].z + v[j].w * v[j].w; }
        const float rs = rsqrtf(wave_sum(s) * (1.f / DM) + NORM_EPS);
#pragma unroll
        for (int j = 0; j < 4; ++j) { const int c = j * 256 + lane * 4;
            const f32x4 gg = *(const f32x4*)(g + c), sh = *(const f32x4*)(mv + c), sc = *(const f32x4*)(mv + 1024 + c);
            const f32x4 y = v[j] * rs * gg; const f32x4 h = y * (1.f + sc) + sh;
            u32x2 w; w.x = pk2(h.x, h.y); w.y = pk2(h.z, h.w); *(u32x2*)(H + (size_t)r * DM + c) = w; }
    }
}

__device__ __forceinline__ void gemm_tile_acc(const Ctx& cx, float (&acc)[4][8], const bf16* A, int lda, const float* W, int ldw, int K, int row0, int col0, float* sm) {
    const int tid = cx.tid, ty = tid >> 4, tx = tid & 15;
    float* As = sm; float* Bs = sm + 16 * 132;
    const int ar = tid >> 2, akq = tid & 3, bk = tid >> 5, bn = tid & 31;
    for (int k0 = 0; k0 < K; k0 += 16) {
        const u32x2 av = *(const u32x2*)(A + (size_t)(row0 + ar) * lda + k0 + akq * 4);
        const f32x4 bv = *(const f32x4*)(W + (size_t)(k0 + bk) * ldw + col0 + bn * 4);
        __syncthreads();
        As[(akq * 4 + 0) * 132 + ar] = __uint_as_float(av.x << 16); As[(akq * 4 + 1) * 132 + ar] = __uint_as_float(av.x & 0xffff0000u);
        As[(akq * 4 + 2) * 132 + ar] = __uint_as_float(av.y << 16); As[(akq * 4 + 3) * 132 + ar] = __uint_as_float(av.y & 0xffff0000u);
        *(f32x4*)(Bs + bk * 132 + bn * 4) = bv;
        __syncthreads();
#pragma unroll 4
        for (int kk = 0; kk < 16; ++kk) {
            const f32x4 a = *(const f32x4*)(As + kk * 132 + ty * 4);
            float b[8];
#pragma unroll
            for (int j = 0; j < 8; ++j) b[j] = Bs[kk * 132 + tx + 16 * j];
#pragma unroll
            for (int j = 0; j < 8; ++j) { acc[0][j] += a.x * b[j]; acc[1][j] += a.y * b[j]; acc[2][j] += a.z * b[j]; acc[3][j] += a.w * b[j]; }
        }
    }
}
#define ZERO_ACC(acc) do { _Pragma("unroll") for (int i_ = 0; i_ < 4; ++i_) _Pragma("unroll") for (int j_ = 0; j_ < 8; ++j_) acc[i_][j_] = 0.f; } while (0)

__device__ __forceinline__ void ph_inproj(const Ctx& cx, int layer, float* sm) {
    const Params& p = get_params();
    const int tid = cx.tid, ty = tid >> 4, tx = tid & 15;
    const bf16* H = (const bf16*)(p.ws + WS_H); const float* W = p.in[I_INW] + (size_t)layer * DM * INW;
    const float* rope = (const float*)(p.ws + WS_ROPE);
    const int nM = TA / 128, nN = INW / 128;
    for (int t = cx.bid; t < nM * nN; t += cx.nb) {
        const int tm = t / nN, tn = t % nN, row0 = tm * 128, col0 = tn * 128;
        if (layer == DEPTH - 1 && row0 >= TL && (col0 < COL_K || col0 >= COL_HY)) continue;
        float acc[4][8]; ZERO_ACC(acc);
        gemm_tile_acc(cx, acc, H, DM, W, INW, DM, row0, col0, sm);
#pragma unroll
        for (int i = 0; i < 4; ++i) {
            const int r = row0 + ty * 4 + i;
            if (col0 < COL_V) {
                if (r < TL) { const int l = r & 4095, pr = l >> 6, pc = l & 63;
#pragma unroll
                    for (int j = 0; j < 8; ++j) if ((j & 3) < 2) { const int ii = tx + 16 * (j & 1); const int pos = ii < 16 ? pr : pc; const float cs = rope[(pos * 16 + (ii & 15)) * 2], sn = rope[(pos * 16 + (ii & 15)) * 2 + 1];
                        const float t1 = acc[i][j], t2 = acc[i][j + 2]; acc[i][j] = t1 * cs - t2 * sn; acc[i][j + 2] = t1 * sn + t2 * cs; } }
                bf16* dst = col0 < COL_K ? (bf16*)(p.ws + WS_Q) + (size_t)r * 512 + col0 : (bf16*)(p.ws + WS_K) + (size_t)r * 128;
#pragma unroll
                for (int j = 0; j < 8; ++j) dst[tx + 16 * j] = f2bf(acc[i][j]);
            } else if (col0 < COL_S5) { bf16* dst = (bf16*)(p.ws + WS_V) + (size_t)r * 128;
#pragma unroll
                for (int j = 0; j < 8; ++j) dst[tx + 16 * j] = f2bf(acc[i][j]);
            } else if (col0 < COL_HY) { bf16* dst = (bf16*)(p.ws + WS_U) + (size_t)r * 512 + (col0 - COL_S5);
#pragma unroll
                for (int j = 0; j < 8; ++j) dst[tx + 16 * j] = f2bf(acc[i][j]);
            } else if (col0 < COL_GATE) { bf16* dst = (bf16*)(p.ws + WS_Z) + (size_t)r * 1536 + (col0 - COL_HY);
#pragma unroll
                for (int j = 0; j < 8; ++j) dst[tx + 16 * j] = f2bf(acc[i][j]);
            } else { bf16* dst = (bf16*)(p.ws + WS_G) + (size_t)r * 3072 + (col0 - COL_GATE); const float* gb = p.in[I_GATEB] + layer * 3072 + (col0 - COL_GATE);
#pragma unroll
                for (int j = 0; j < 8; ++j) dst[tx + 16 * j] = f2bf(sigmoidf_(acc[i][j] + gb[tx + 16 * j]));
            }
        }
    }
}

__device__ __forceinline__ void ph_attn(const Ctx& cx, int layer) {
    const Params& p = get_params();
    const int gt = cx.bid * NTHREADS + cx.tid, NGT = cx.nb * NTHREADS;
    const bf16* Q = (const bf16*)(p.ws + WS_Q); const bf16* Kb = (const bf16*)(p.ws + WS_K); const bf16* Vb = (const bf16*)(p.ws + WS_V);
    bf16* O = (bf16*)(p.ws + WS_ATT);
    const int nrows = layer == 0 ? TA : TL;
    for (int it4 = gt; it4 < nrows * 8 * 4; it4 += NGT) {
        const int sub = it4 & 3, it = it4 >> 2;
        const int h = it / nrows, r = it % nrows;
        const int b = row_b(r), kvh = h >> 2;
        float q[16], acc[16];
#pragma unroll
        for (int d8 = 0; d8 < 2; ++d8) { const u32x4 w = *(const u32x4*)(Q + (size_t)r * 512 + h * 64 + sub * 16 + d8 * 8);
            q[d8 * 8 + 0] = __uint_as_float(w.x << 16); q[d8 * 8 + 1] = __uint_as_float(w.x & 0xffff0000u); q[d8 * 8 + 2] = __uint_as_float(w.y << 16); q[d8 * 8 + 3] = __uint_as_float(w.y & 0xffff0000u);
            q[d8 * 8 + 4] = __uint_as_float(w.z << 16); q[d8 * 8 + 5] = __uint_as_float(w.z & 0xffff0000u); q[d8 * 8 + 6] = __uint_as_float(w.w << 16); q[d8 * 8 + 7] = __uint_as_float(w.w & 0xffff0000u); }
#pragma unroll
        for (int d = 0; d < 16; ++d) acc[d] = 0.f;
        float m = p.in[I_SINK][layer * 8 + h], l = 1.f;
        int wlo = 0, whi = -1;
        if (r < TL) { const int pos = r & 4095; wlo = pos - 128 < 0 ? 0 : pos - 128; whi = pos + 128 > SEQ - 1 ? SEQ - 1 : pos + 128; }
        const int nwin = whi - wlo + 1;
        for (int kk = 0; kk < 256 + nwin; ++kk) {
            const int kr = kk < 256 ? TL + b * 256 + kk : b * SEQ + wlo + (kk - 256);
            const bf16* kp = Kb + (size_t)kr * 128 + kvh * 64 + sub * 16; const bf16* vp = Vb + (size_t)kr * 128 + kvh * 64 + sub * 16;
            float s = 0.f;
#pragma unroll
            for (int d8 = 0; d8 < 2; ++d8) { const u32x4 w = *(const u32x4*)(kp + d8 * 8);
                s += q[d8 * 8 + 0] * __uint_as_float(w.x << 16) + q[d8 * 8 + 1] * __uint_as_float(w.x & 0xffff0000u) + q[d8 * 8 + 2] * __uint_as_float(w.y << 16) + q[d8 * 8 + 3] * __uint_as_float(w.y & 0xffff0000u)
                   + q[d8 * 8 + 4] * __uint_as_float(w.z << 16) + q[d8 * 8 + 5] * __uint_as_float(w.z & 0xffff0000u) + q[d8 * 8 + 6] * __uint_as_float(w.w << 16) + q[d8 * 8 + 7] * __uint_as_float(w.w & 0xffff0000u); }
            s += __shfl_xor(s, 1); s += __shfl_xor(s, 2);
            s *= 0.125f;
            const float mn = fmaxf(m, s), f = __expf(m - mn), e = __expf(s - mn);
            l = l * f + e; m = mn;
#pragma unroll
            for (int d8 = 0; d8 < 2; ++d8) { const u32x4 w = *(const u32x4*)(vp + d8 * 8);
                acc[d8 * 8 + 0] = acc[d8 * 8 + 0] * f + e * __uint_as_float(w.x << 16); acc[d8 * 8 + 1] = acc[d8 * 8 + 1] * f + e * __uint_as_float(w.x & 0xffff0000u);
                acc[d8 * 8 + 2] = acc[d8 * 8 + 2] * f + e * __uint_as_float(w.y << 16); acc[d8 * 8 + 3] = acc[d8 * 8 + 3] * f + e * __uint_as_float(w.y & 0xffff0000u);
                acc[d8 * 8 + 4] = acc[d8 * 8 + 4] * f + e * __uint_as_float(w.z << 16); acc[d8 * 8 + 5] = acc[d8 * 8 + 5] * f + e * __uint_as_float(w.z & 0xffff0000u);
                acc[d8 * 8 + 6] = acc[d8 * 8 + 6] * f + e * __uint_as_float(w.w << 16); acc[d8 * 8 + 7] = acc[d8 * 8 + 7] * f + e * __uint_as_float(w.w & 0xffff0000u); }
        }
        const float il = 1.f / l;
#pragma unroll
        for (int d8 = 0; d8 < 2; ++d8) { u32x4 w; w.x = pk2(acc[d8 * 8] * il, acc[d8 * 8 + 1] * il); w.y = pk2(acc[d8 * 8 + 2] * il, acc[d8 * 8 + 3] * il); w.z = pk2(acc[d8 * 8 + 4] * il, acc[d8 * 8 + 5] * il); w.w = pk2(acc[d8 * 8 + 6] * il, acc[d8 * 8 + 7] * il);
            *(u32x4*)(O + (size_t)r * 512 + h * 64 + sub * 16 + d8 * 8) = w; }
    }
}

__device__ __forceinline__ void ph_hypre(const Ctx& cx, int layer) {
    const Params& p = get_params();
    const int gt = cx.bid * NTHREADS + cx.tid, NGT = cx.nb * NTHREADS;
    const bf16* Z = (const bf16*)(p.ws + WS_Z); const float* sw = p.in[I_HSW] + layer * 3 * 1536; const float* sb = p.in[I_HSB] + layer * 1536;
    const int nrows = layer == 0 ? TA : TL;
    for (int it = gt; it < nrows * 512; it += NGT) {
        const int r = it >> 9, c = it & 511;
        int t, L; if (r < TL) { t = r & 4095; L = SEQ; } else { t = (r - TL) & 255; L = CTXL; }
        float o[3];
#pragma unroll
        for (int q = 0; q < 3; ++q) { const int col = q * 512 + c; float a = sb[col] + sw[1536 + col] * bf2f(Z[(size_t)r * 1536 + col]);
            if (t > 0) a += sw[col] * bf2f(Z[(size_t)(r - 1) * 1536 + col]);
            if (t < L - 1) a += sw[2 * 1536 + col] * bf2f(Z[(size_t)(r + 1) * 1536 + col]);
            o[q] = a; }
        ((bf16*)(p.ws + WS_X0C))[(size_t)r * 512 + c] = f2bf(o[0]);
        const int b = row_b(r);
        if (r < TL) ((float*)(p.ws + WS_VV))[((size_t)b * 512 + c) * SEQ + t] = o[2] * o[1];
        else ((float*)(p.ws + WS_VVC))[((size_t)b * 512 + c) * CTXL + t] = o[2] * o[1];
    }
}

__device__ __forceinline__ void ph_hyconv(const Ctx& cx, int layer, float* sm) {
    const Params& p = get_params();
    const int tid = cx.tid;
    const int nitems = 2048 + (layer == 0 ? 2048 : 0);
    float* Tl = sm;
    for (int it = cx.bid; it < nitems; it += cx.nb) {
        const int st = it >= 2048, bc = it & 2047, b = bc >> 9, c = bc & 511, L = st ? CTXL : SEQ;
        float* Vl = sm + 2 * L;
        const float* fb = (const float*)(p.ws + WS_FILT + layer * FILT_LAYER + (st ? FILT_CTX_OFF : 0));
        const float* hf = fb + (size_t)c * L; const float* hb = fb + ((size_t)512 + c) * L;
        const float* vv = st ? (const float*)(p.ws + WS_VVC) + (size_t)bc * CTXL : (const float*)(p.ws + WS_VV) + (size_t)bc * SEQ;
        __syncthreads();
        for (int i = tid; i < L; i += NTHREADS) { Tl[L - 1 + i] = hf[i]; if (i > 0) Tl[L - 1 - i] = hb[i]; Vl[i] = vv[i]; }
        __syncthreads();
        const float bias = p.in[I_HBIAS][layer * 512 + c];
        const int rbase = st ? TL + b * CTXL : b * SEQ;
        for (int t0 = 0; t0 < L; t0 += NTHREADS * 8) {
            float a[8];
#pragma unroll
            for (int j = 0; j < 8; ++j) a[j] = 0.f;
            if (t0 + tid < L) {
                for (int s = 0; s < L; ++s) { const float v = Vl[s]; const float* tp = Tl + (t0 + tid - s + L - 1);
#pragma unroll
                    for (int j = 0; j < 8; ++j) if (t0 + tid + j * NTHREADS < L) a[j] += v * tp[j * NTHREADS]; }
#pragma unroll
                for (int j = 0; j < 8; ++j) { const int t = t0 + tid + j * NTHREADS; if (t < L) { const size_t o = (size_t)(rbase + t) * 512 + c;
                    ((bf16*)(p.ws + WS_HY))[o] = f2bf((a[j] + Vl[t] * bias) * bf2f(((const bf16*)(p.ws + WS_X0C))[o])); } }
            }
        }
    }
}

__device__ __forceinline__ void ph_s5scan(const Ctx& cx, int layer) {
    const Params& p = get_params();
    const int lane = cx.tid & 63, wave = cx.tid >> 6;
    const int gw = cx.bid * NWAVES + wave, NGW = cx.nb * NWAVES;
    const bf16* U = (const bf16*)(p.ws + WS_U); float* Y = (float*)(p.ws + WS_S5TMP);
    for (int it = gw; it < 128; it += NGW) {
        const int b = it >> 5, g = it & 31;
        for (int dir = 0; dir < 2; ++dir) {
            const int pi = ((layer * 2 + dir) * 32 + g) * 64 + lane;
            const float ar = ((const float*)(p.ws + WS_S5A))[pi * 2], ai = ((const float*)(p.ws + WS_S5A))[pi * 2 + 1];
            float br[16], bi[16], cr[16], ci[16];
#pragma unroll
            for (int h = 0; h < 16; ++h) { br[h] = ((const float*)(p.ws + WS_S5B))[((size_t)pi * 16 + h) * 2]; bi[h] = ((const float*)(p.ws + WS_S5B))[((size_t)pi * 16 + h) * 2 + 1];
                const size_t cidx = ((size_t)((layer * 2 + dir) * 32 + g) * 16 + h) * 64 + lane; cr[h] = p.in[I_SCRE][cidx]; ci[h] = p.in[I_SCIM][cidx]; }
            float hr = 0.f, hi = 0.f;
            for (int step = 0; step < CTXL + SEQ; ++step) {
                int r;
                if (dir == 0) r = step < CTXL ? TL + b * CTXL + step : b * SEQ + (step - CTXL);
                else r = step < CTXL ? TL + b * CTXL + (CTXL - 1 - step) : b * SEQ + (SEQ - 1 - (step - CTXL));
                const u32x4 w0 = *(const u32x4*)(U + (size_t)r * 512 + g * 16), w1 = *(const u32x4*)(U + (size_t)r * 512 + g * 16 + 8);
                float u[16];
                u[0] = __uint_as_float(w0.x << 16); u[1] = __uint_as_float(w0.x & 0xffff0000u); u[2] = __uint_as_float(w0.y << 16); u[3] = __uint_as_float(w0.y & 0xffff0000u);
                u[4] = __uint_as_float(w0.z << 16); u[5] = __uint_as_float(w0.z & 0xffff0000u); u[6] = __uint_as_float(w0.w << 16); u[7] = __uint_as_float(w0.w & 0xffff0000u);
                u[8] = __uint_as_float(w1.x << 16); u[9] = __uint_as_float(w1.x & 0xffff0000u); u[10] = __uint_as_float(w1.y << 16); u[11] = __uint_as_float(w1.y & 0xffff0000u);
                u[12] = __uint_as_float(w1.z << 16); u[13] = __uint_as_float(w1.z & 0xffff0000u); u[14] = __uint_as_float(w1.w << 16); u[15] = __uint_as_float(w1.w & 0xffff0000u);
                float dr = 0.f, di = 0.f;
#pragma unroll
                for (int h = 0; h < 16; ++h) { dr += br[h] * u[h]; di += bi[h] * u[h]; }
                const float nr = ar * hr - ai * hi + dr, ni = ar * hi + ai * hr + di; hr = nr; hi = ni;
                if (layer == 0 || r < TL) {
                    float mine = 0.f;
#pragma unroll
                    for (int o = 0; o < 16; ++o) { const float v = wave_sum(cr[o] * hr - ci[o] * hi); if (lane == o) mine = v; }
                    if (lane < 16) { float* yp = Y + (size_t)r * 512 + g * 16 + lane; if (dir == 0) *yp = mine; else *yp += mine; }
                }
            }
        }
    }
}
__device__ __forceinline__ void ph_s5read(const Ctx& cx, int layer) {
    const Params& p = get_params();
    const int gt = cx.bid * NTHREADS + cx.tid, NGT = cx.nb * NTHREADS;
    const int nrows = layer == 0 ? TA : TL;
    for (int i = gt; i < nrows * 512; i += NGT) { const int c = i & 511;
        const float y = ((const float*)(p.ws + WS_S5TMP))[i] + p.in[I_SD][layer * 512 + c] * bf2f(((const bf16*)(p.ws + WS_U))[i]);
        ((bf16*)(p.ws + WS_S5Y))[i] = f2bf(gelu_tanh(y)); }
}

__device__ __forceinline__ void ph_glu(const Ctx& cx, int layer, float* sm) {
    const Params& p = get_params();
    const int tid = cx.tid, ty = tid >> 4, tx = tid & 15;
    const int nrows = layer == 0 ? TA : TL, nM = nrows / 128, nN = 4;
    const bf16* A = (const bf16*)(p.ws + WS_S5Y); const float* W = p.in[I_GLUW] + (size_t)layer * 512 * 512;
    for (int t = cx.bid; t < nM * nN; t += cx.nb) {
        const int row0 = (t / nN) * 128, col0 = (t % nN) * 128;
        float acc[4][8]; ZERO_ACC(acc);
        gemm_tile_acc(cx, acc, A, 512, W, 512, 512, row0, col0, sm);
#pragma unroll
        for (int i = 0; i < 4; ++i)
#pragma unroll
            for (int j = 0; j < 8; ++j) { const size_t o = (size_t)(row0 + ty * 4 + i) * 512 + col0 + tx + 16 * j;
                ((bf16*)(p.ws + WS_S5O))[o] = f2bf(bf2f(A[o]) * sigmoidf_(acc[i][j] + p.in[I_GLUB][layer * 512 + col0 + tx + 16 * j])); }
    }
}
__device__ __forceinline__ void ph_merge(const Ctx& cx, int layer, float* sm) {
    const Params& p = get_params();
    const int tid = cx.tid, ty = tid >> 4, tx = tid & 15;
    const int nrows = layer == 0 ? TA : TL, nM = nrows / 128, nN = 8;
    const bf16* G = (const bf16*)(p.ws + WS_G);
    for (int t = cx.bid; t < nM * nN; t += cx.nb) {
        const int row0 = (t / nN) * 128, col0 = (t % nN) * 128;
        float tot[4][8]; ZERO_ACC(tot);
#pragma unroll 1
        for (int br = 0; br < 3; ++br) {
            const bf16* A = (const bf16*)(p.ws + (br == 0 ? WS_ATT : br == 1 ? WS_HY : WS_S5O));
            const float* W = p.in[br == 0 ? I_BRA : br == 1 ? I_BRH : I_BRS] + (size_t)layer * 512 * 1024;
            float acc[4][8]; ZERO_ACC(acc);
            gemm_tile_acc(cx, acc, A, 512, W, 1024, 512, row0, col0, sm);
#pragma unroll
            for (int i = 0; i < 4; ++i)
#pragma unroll
                for (int j = 0; j < 8; ++j) tot[i][j] += bf2f(G[(size_t)(row0 + ty * 4 + i) * 3072 + br * 1024 + col0 + tx + 16 * j]) * acc[i][j];
        }
#pragma unroll
        for (int i = 0; i < 4; ++i)
#pragma unroll
            for (int j = 0; j < 8; ++j) ((bf16*)(p.ws + WS_M))[(size_t)(row0 + ty * 4 + i) * 1024 + col0 + tx + 16 * j] = f2bf(tot[i][j]);
    }
}
__device__ __forceinline__ void ph_outproj(const Ctx& cx, int layer, float* sm) {
    const Params& p = get_params();
    const int tid = cx.tid, ty = tid >> 4, tx = tid & 15;
    const int nrows = layer == 0 ? TA : TL, nM = nrows / 128, nN = 8;
    const bf16* A = (const bf16*)(p.ws + WS_M); const float* W = p.in[I_OUTW] + (size_t)layer * 1024 * 1024;
    float* X = (float*)(p.ws + WS_XCUR);
    for (int t = cx.bid; t < nM * nN; t += cx.nb) {
        const int row0 = (t / nN) * 128, col0 = (t % nN) * 128;
        float acc[4][8]; ZERO_ACC(acc);
        gemm_tile_acc(cx, acc, A, 1024, W, 1024, 1024, row0, col0, sm);
#pragma unroll
        for (int i = 0; i < 4; ++i) { const int r = row0 + ty * 4 + i; const float* g1 = (const float*)(p.ws + WS_MODV) + ((size_t)layer * 5 + row_mi(r)) * 6144 + 2048;
#pragma unroll
            for (int j = 0; j < 8; ++j) { const int c = col0 + tx + 16 * j; X[(size_t)r * 1024 + c] += g1[c] * acc[i][j]; } }
    }
}
__device__ __forceinline__ void ph_qp(const Ctx& cx, int layer, float* sm) {
    const Params& p = get_params();
    const int tid = cx.tid, ty = tid >> 4, tx = tid & 15;
    const int nrows = layer == 0 ? TA : TL, nM = nrows / 128, nN = 16;
    const bf16* A = (const bf16*)(p.ws + WS_H); const float* W = p.in[I_WQ] + (size_t)layer * 1024 * 2048;
    for (int t = cx.bid; t < nM * nN; t += cx.nb) {
        const int row0 = (t / nN) * 128, col0 = (t % nN) * 128;
        float acc[4][8]; ZERO_ACC(acc);
        gemm_tile_acc(cx, acc, A, 1024, W, 2048, 1024, row0, col0, sm);
#pragma unroll
        for (int i = 0; i < 4; ++i)
#pragma unroll
            for (int j = 0; j < 8; ++j) ((bf16*)(p.ws + WS_QP))[(size_t)(row0 + ty * 4 + i) * 2048 + col0 + tx + 16 * j] = f2bf(acc[i][j]);
    }
}

__device__ __forceinline__ void wave_argmax(float& v, int& i) {
#pragma unroll
    for (int o = 32; o > 0; o >>= 1) { const float ov = __shfl_xor(v, o); const int oi = __shfl_xor(i, o); if (ov > v || (ov == v && oi < i)) { v = ov; i = oi; } }
}
__device__ __forceinline__ void ph_select(const Ctx& cx, int layer) {
    const Params& p = get_params();
    const int lane = cx.tid & 63, wave = cx.tid >> 6;
    const int gw = cx.bid * NWAVES + wave, NGW = cx.nb * NWAVES;
    const int nrows = layer == 0 ? TA : TL;
    const bf16* QP = (const bf16*)(p.ws + WS_QP);
    for (int it = gw; it < nrows * 8; it += NGW) {
        const int r = it >> 3, h = it & 7;
        float tv[2]; int ti[2]; tv[0] = tv[1] = 0.f; ti[0] = ti[1] = 0;
#pragma unroll
        for (int s = 0; s < 2; ++s) {
            const unsigned qw = *(const unsigned*)(QP + (size_t)r * 2048 + (h * 2 + s) * 128 + lane * 2);
            const float q0 = __uint_as_float(qw << 16), q1 = __uint_as_float(qw & 0xffff0000u);
            const float* k0 = p.in[I_PKEYS] + ((((size_t)layer * 8 + h) * 2 + s) * 128 + lane) * 128; const float* k1 = k0 + 64 * 128;
            float s0 = 0.f, s1 = 0.f;
            for (int k4 = 0; k4 < 32; ++k4) { const f32x4 a = *(const f32x4*)(k0 + k4 * 4), bb = *(const f32x4*)(k1 + k4 * 4);
                const float qa = __shfl(q0, 2 * k4), qb = __shfl(q1, 2 * k4), qc = __shfl(q0, 2 * k4 + 1), qd = __shfl(q1, 2 * k4 + 1);
                s0 += qa * a.x + qb * a.y + qc * a.z + qd * a.w; s1 += qa * bb.x + qb * bb.y + qc * bb.z + qd * bb.w; }
            for (int j = 0; j < 16; ++j) {
                float bv; int bi; if (s0 >= s1) { bv = s0; bi = lane; } else { bv = s1; bi = lane + 64; }
                wave_argmax(bv, bi);
                if (lane == j) { tv[s] = bv; ti[s] = bi; }
                if (bi == lane) s0 = -INFINITY; else if (bi == lane + 64) s1 = -INFINITY;
            }
        }
        float cv[4]; const float va = __shfl(tv[0], lane >> 2);
#pragma unroll
        for (int q = 0; q < 4; ++q) cv[q] = va + __shfl(tv[1], (lane & 3) * 4 + q);
        float bestv = 0.f; int bestc = 0;
        for (int j = 0; j < 16; ++j) {
            float bv = cv[0]; int bi = lane * 4;
#pragma unroll
            for (int q = 1; q < 4; ++q) if (cv[q] > bv) { bv = cv[q]; bi = lane * 4 + q; }
            wave_argmax(bv, bi);
            if (lane == j) { bestv = bv; bestc = bi; }
            if ((bi >> 2) == lane) {
#pragma unroll
                for (int q = 0; q < 4; ++q) if ((bi & 3) == q) cv[q] = -INFINITY; }
        }
        const int ia = __shfl(ti[0], bestc >> 4), ib = __shfl(ti[1], bestc & 15);
        const float mx = __shfl(bestv, 0);
        const float e = lane < 16 ? __expf(bestv - mx) : 0.f;
        const float sum = wave_sum(e);
        if (lane < 16) { ((int*)(p.ws + WS_EID))[(size_t)r * 128 + h * 16 + lane] = ia * 128 + ib; ((float*)(p.ws + WS_EG))[(size_t)r * 128 + h * 16 + lane] = e / sum; }
    }
}
__device__ __forceinline__ void ph_gather(const Ctx& cx, int layer) {
    const Params& p = get_params();
    const int lane = cx.tid & 63, wave = cx.tid >> 6;
    const int gw = cx.bid * NWAVES + wave, NGW = cx.nb * NWAVES;
    const int nrows = layer == 0 ? TA : TL;
    const float* PU = p.in[I_PU] + (size_t)layer * 16384 * 1024; const float* PV = p.in[I_PV] + (size_t)layer * 16384 * 1024;
    float* X = (float*)(p.ws + WS_XCUR);
    for (int r = gw; r < nrows; r += NGW) {
        f32x4 x[4], o[4];
#pragma unroll
        for (int j = 0; j < 4; ++j) { const u32x2 w = *(const u32x2*)((const bf16*)(p.ws + WS_H) + (size_t)r * 1024 + j * 256 + lane * 4);
            x[j] = (f32x4){__uint_as_float(w.x << 16), __uint_as_float(w.x & 0xffff0000u), __uint_as_float(w.y << 16), __uint_as_float(w.y & 0xffff0000u)}; o[j] = (f32x4){0.f, 0.f, 0.f, 0.f}; }
        for (int hk = 0; hk < 128; ++hk) {
            const int e = ((const int*)(p.ws + WS_EID))[(size_t)r * 128 + hk]; const float g = ((const float*)(p.ws + WS_EG))[(size_t)r * 128 + hk];
            const float* ur = PU + (size_t)e * 1024 + lane * 4; const float* vr = PV + (size_t)e * 1024 + lane * 4;
            float d = 0.f;
#pragma unroll
            for (int j = 0; j < 4; ++j) { const f32x4 uu = *(const f32x4*)(ur + j * 256); d += x[j].x * uu.x + x[j].y * uu.y + x[j].z * uu.z + x[j].w * uu.w; }
            d = wave_sum(d);
            const float w = g * gelu_tanh(d);
#pragma unroll
            for (int j = 0; j < 4; ++j) { const f32x4 vvv = *(const f32x4*)(vr + j * 256); o[j] += w * vvv; }
        }
        const float* g2 = (const float*)(p.ws + WS_MODV) + ((size_t)layer * 5 + row_mi(r)) * 6144 + 5120;
        float ss = 0.f;
#pragma unroll
        for (int j = 0; j < 4; ++j) { const int c = j * 256 + lane * 4; f32x4 xv = *(const f32x4*)(X + (size_t)r * 1024 + c); xv += *(const f32x4*)(g2 + c) * o[j]; *(f32x4*)(X + (size_t)r * 1024 + c) = xv; o[j] = xv;
            ss += xv.x * xv.x + xv.y * xv.y + xv.z * xv.z + xv.w * xv.w; }
        if (layer == DEPTH - 1) {
            const float rs = rsqrtf(wave_sum(ss) * (1.f / DM) + NORM_EPS);
#pragma unroll
            for (int j = 0; j < 4; ++j) { const int c = j * 256 + lane * 4; *(f32x4*)(p.out + (size_t)r * 1024 + c) = o[j] * rs * *(const f32x4*)(p.in[I_FG] + c); }
        }
    }
}

constexpr int NPL = 11, NPHASE = 1 + DEPTH * NPL;
__global__ void __launch_bounds__(NTHREADS) mk_fwd(Params p) {
    __shared__ __attribute__((aligned(16))) float sm[12288 + 16];
    const int tid = threadIdx.x;
    volatile LAS unsigned* st = (volatile LAS unsigned*)(LAS float*)(sm + 12288);
    if (tid < 4) st[tid] = 0u;
    __syncthreads();
    XcdBarrier bar; bar.bar = (unsigned*)(p.ws + WS_CTL) + 4096; bar.x = 0; bar.st = st;
    const bool multi = (p.ph_hi - p.ph_lo) > 1;
    if (multi) bar = xcd_barrier_post((unsigned*)(p.ws + WS_CTL) + 4096, st);
    for (int ph = p.ph_lo; ph < p.ph_hi; ++ph) {
        Ctx cx; cx.tid = threadIdx.x; cx.bid = blockIdx.x; cx.nb = gridDim.x; asm volatile("" : "+v"(cx.tid), "+s"(cx.bid), "+s"(cx.nb));
#ifndef ONLY
#define ONLY -1
#endif
#ifndef NOT
#define NOT -1
#endif
#define ON(n) ((ONLY < 0 || ONLY == (n)) && NOT != (n))
        if (ph == 0) { if (ON(100)) ph_prologue(cx, sm); }
        else {
            const int layer = (ph - 1) / NPL, sub = (ph - 1) % NPL;
            switch (sub) {
                case 0: if (ON(0)) ph_norm(cx, layer, 0, 0); break;
                case 1: if (ON(1)) ph_inproj(cx, layer, sm); break;
                case 2: if (ON(2)) ph_attn(cx, layer); if (ON(20)) ph_hypre(cx, layer); if (ON(21)) ph_s5scan(cx, layer); break;
                case 3: if (ON(3)) ph_hyconv(cx, layer, sm); if (ON(30)) ph_s5read(cx, layer); break;
                case 4: if (ON(4)) ph_glu(cx, layer, sm); break;
                case 5: if (ON(5)) ph_merge(cx, layer, sm); break;
                case 6: if (ON(6)) ph_outproj(cx, layer, sm); break;
                case 7: if (ON(7)) ph_norm(cx, layer, 1, layer == DEPTH - 1); break;
                case 8: if (ON(8)) ph_qp(cx, layer, sm); break;
                case 9: if (ON(9)) ph_select(cx, layer); break;
                case 10: if (ON(10)) ph_gather(cx, layer); break;
            }
        }
        if (ph + 1 < p.ph_hi) xcd_barrier(bar);
    }
}
}

extern "C" void kernel_launch(void* const* d_in, const int* in_sizes, int n_in, void* d_out, int out_size, void* d_ws, size_t ws_size, hipStream_t stream) {
    static int grid = 0;
    if (grid == 0) {
        if (n_in != 40 || out_size != TL * DM || ws_size < WS_END) { fprintf(stderr, "kernel_launch: unexpected shapes (n_in %d out %d ws %zu)\n", n_in, out_size, ws_size); grid = -1; return; }
        int dev = 0, cus = 0;
        if (hipGetDevice(&dev) != hipSuccess || hipDeviceGetAttribute(&cus, hipDeviceAttributeMultiprocessorCount, dev) != hipSuccess) { grid = -1; return; }
        grid = cus;
    }
    if (grid < 0) return;
    (void)hipMemsetAsync((char*)d_ws + WS_CTL, 0, 1 * MiB, stream);
    Params a{};
    for (int i = 0; i < 40; ++i) a.in[i] = (const float*)d_in[i];
    a.out = (float*)d_out; a.ws = (unsigned char*)d_ws;
#if PER_PHASE_LAUNCH
    for (int ph = 0; ph < NPHASE; ++ph) { a.ph_lo = ph; a.ph_hi = ph + 1; hipLaunchKernelGGL(mk_fwd, dim3(grid), dim3(NTHREADS), 0, stream, a); }
#else
    a.ph_lo = 0; a.ph_hi = NPHASE; hipLaunchKernelGGL(mk_fwd, dim3(grid), dim3(NTHREADS), 0, stream, a);
#endif
}
```

```cpp
#include <hip/hip_runtime.h>
#include <stdint.h>
#include <math.h>
#include <stdio.h>

#ifndef PER_PHASE_LAUNCH
#define PER_PHASE_LAUNCH 0
#endif

namespace {
typedef unsigned short bf16;
typedef float f32x4 __attribute__((ext_vector_type(4)));
typedef unsigned u32x2 __attribute__((ext_vector_type(2)));
typedef unsigned u32x4 __attribute__((ext_vector_type(4)));
#define LAS __attribute__((address_space(3)))

constexpr int DM = 1024, NBATCH = 4, SEQ = 4096, CTXL = 256, DEPTH = 2;
constexpr int TL = NBATCH * SEQ, TC = NBATCH * CTXL, TA = TL + TC;
constexpr int INW = 5888, COL_K = 512, COL_V = 640, COL_S5 = 768, COL_HY = 1280, COL_GATE = 2816;
constexpr int NTHREADS = 512, NWAVES = 8;
constexpr float NORM_EPS = 1e-6f;
constexpr float HY_FAST = 15.350567286626973f, HY_SLOW = 3.0701134573253945f;

constexpr size_t MiB = 1u << 20;
constexpr size_t WS_CTL = 0;
constexpr size_t WS_XCUR = 1 * MiB;
constexpr size_t WS_MODV = 69 * MiB;
constexpr size_t WS_ROPE = WS_MODV + 512 * 1024;
constexpr size_t WS_S5A = 70 * MiB;
constexpr size_t WS_S5B = 70 * MiB + 256 * 1024;
constexpr size_t WS_FILT = 72 * MiB;
constexpr size_t FILT_CTX_OFF = 16 * MiB;
constexpr size_t WS_WTS = 89 * MiB;
constexpr size_t WT_IN = WS_WTS;
constexpr size_t WT_GLU = WT_IN + 23 * MiB;
constexpr size_t WT_BR = WT_GLU + 1 * MiB;
constexpr size_t WT_OUT = WT_BR + 6 * MiB;
constexpr size_t WT_WQ = WT_OUT + 4 * MiB;
constexpr size_t WT_KEYS = WT_WQ + 8 * MiB;
constexpr size_t WS_H = 132 * MiB;
constexpr size_t WS_VV = WS_H;
constexpr size_t WS_VVC = WS_H + 32 * MiB;
constexpr size_t WS_Q = 166 * MiB;
constexpr size_t WS_K = 183 * MiB;
constexpr size_t WS_V = WS_K + (size_t)TA * 128 * 2;
constexpr size_t WS_U = WS_V + (size_t)TA * 128 * 2;
constexpr size_t WS_Z = WS_U + (size_t)TA * 512 * 2;
constexpr size_t WS_QP = WS_Q;
constexpr size_t WS_G = 260 * MiB;
constexpr size_t WS_ATT = 362 * MiB;
constexpr size_t WS_HY = WS_ATT + 17 * MiB, WS_S5O = WS_HY + 17 * MiB, WS_S5Y = WS_S5O + 17 * MiB;
constexpr size_t WS_M = 430 * MiB;
constexpr size_t WS_S5TMP = WS_M;
constexpr size_t WS_X0C = 464 * MiB;
constexpr size_t WS_EID = 481 * MiB;
constexpr size_t WS_EG = WS_EID + (size_t)TA * 128 * 4;
constexpr size_t WS_END = 498 * MiB;
constexpr int LDS_STAGE = 131072;
constexpr int LDS_MISC = LDS_STAGE;
constexpr int LDS_BYTES = 147456;

struct Params {
    const float* in[40];
    float* out;
    unsigned char* ws;
    int ph_lo, ph_hi;
};
enum { I_X = 0, I_C, I_CTX, I_CCTX, I_MODW, I_MODB, I_N1G, I_N2G, I_INW, I_GATEB, I_SINK, I_HSW, I_HSB, I_HW1, I_HB1, I_HF1, I_HW2, I_HB2, I_HF2, I_HW3,
       I_HBIAS, I_SARE, I_SAIM, I_SLDT, I_SBRE, I_SBIM, I_SCRE, I_SCIM, I_SD, I_GLUW, I_GLUB, I_BRA, I_BRH, I_BRS, I_OUTW, I_WQ, I_PKEYS, I_PU, I_PV, I_FG };

struct Ctx { int tid, bid, nb; };
typedef __attribute__((address_space(4))) const Params CParams;
__device__ __forceinline__ CParams& get_params() { CParams* q = (CParams*)__builtin_amdgcn_kernarg_segment_ptr(); asm volatile("" : "+s"(q)); return *q; }
__device__ __forceinline__ float bf2f(bf16 v) { return __uint_as_float((unsigned)v << 16); }
__device__ __forceinline__ bf16 f2bf(float f) { unsigned u = __float_as_uint(f); return (bf16)((u + 0x7fffu + ((u >> 16) & 1u)) >> 16); }
__device__ __forceinline__ unsigned pk2(float lo, float hi) { return (unsigned)f2bf(lo) | ((unsigned)f2bf(hi) << 16); }
__device__ __forceinline__ float wave_sum(float v) {
#pragma unroll
    for (int o = 32; o > 0; o >>= 1) v += __shfl_xor(v, o);
    return v;
}
__device__ __forceinline__ float fsin_rev(float rev) { return __builtin_amdgcn_sinf(rev); }
__device__ __forceinline__ float fcos_rev(float rev) { return __builtin_amdgcn_cosf(rev); }
__device__ __forceinline__ float fsin(float x) { return __builtin_amdgcn_sinf(x * 0.15915494309189535f); }
__device__ __forceinline__ float fcos(float x) { return __builtin_amdgcn_cosf(x * 0.15915494309189535f); }
__device__ __forceinline__ float sigmoidf_(float x) { return 1.f / (1.f + __expf(-x)); }
__device__ __forceinline__ float gelu_tanh(float x) { const float u = 0.7978845608028654f * (x + 0.044715f * x * x * x); const float e = __expf(2.f * u); return 0.5f * x * (2.f - 2.f / (e + 1.f)); }
__device__ __forceinline__ int row_mi(int r) { return r < TL ? (r >> 12) : 4; }
__device__ __forceinline__ int row_b(int r) { return r < TL ? (r >> 12) : ((r - TL) >> 8); }

#define XB_TMO      128
#define XB_XCNT(j)  (256  + 64 * (j))
#define XB_XSUB(j)  (1280 + 64 * (j))
#define XB_XGEN(j)  (2304 + 64 * (j))
#define XB_TOP      3328
#define XB_TOPGEN   3392
#define XCD_BAR_WORDS 3456
#define XB_SPIN_CAP (1u << 27)
__device__ __forceinline__ unsigned xb_ld(unsigned* p)              { return __hip_atomic_load(p, __ATOMIC_RELAXED, __HIP_MEMORY_SCOPE_AGENT); }
__device__ __forceinline__ unsigned xb_add(unsigned* p, unsigned v) { return __hip_atomic_fetch_add(p, v, __ATOMIC_RELAXED, __HIP_MEMORY_SCOPE_AGENT); }
__device__ __forceinline__ unsigned xb_xcc_id() { return (unsigned)__builtin_amdgcn_s_getreg((3 << 11) | 20) & 0xFu; }
#define XB_SPIN(cond, bar) do { unsigned _sp = 0; while (cond) { __builtin_amdgcn_s_sleep(1); \
    if ((++_sp & 255u) == 0u) { if (xb_ld(&(bar)[XB_TMO])) break; if (_sp > XB_SPIN_CAP) { atomicAdd(&(bar)[XB_TMO], 1u); break; } } } } while (0)
struct XcdBarrier { unsigned* bar; unsigned x; volatile LAS unsigned* st; };
__device__ __forceinline__ XcdBarrier xcd_barrier_post(unsigned* bar, volatile LAS unsigned* st) {
    XcdBarrier b; b.bar = bar; b.x = xb_xcc_id(); b.st = st;
    if (threadIdx.x == 0) (void)xb_add(&bar[XB_XCNT(b.x)], 1u);
    return b;
}
__device__ __forceinline__ void xcd_barrier_complete(unsigned* bar, unsigned x, unsigned& nloc, unsigned& nx) {
    const unsigned G = gridDim.x * gridDim.y * gridDim.z;
    unsigned sum, cnt, mine, sp = 0u;
    for (;;) {
        sum = 0u; cnt = 0u; mine = 0u;
#pragma unroll
        for (unsigned j = 0; j < 16; ++j) { const unsigned c = xb_ld(&bar[XB_XCNT(j)]); sum += c; cnt += (c > 0u) ? 1u : 0u; mine = (j == x) ? c : mine; }
        if (sum == G) break;
        __builtin_amdgcn_s_sleep(1);
        if ((++sp & 255u) == 0u) { if (xb_ld(&bar[XB_TMO])) break; if (sp > XB_SPIN_CAP) { atomicAdd(&bar[XB_TMO], 1u); break; } }
    }
    nloc = mine > 0u ? mine : 1u; nx = cnt > 0u ? cnt : 1u;
}
__device__ __forceinline__ void xcd_barrier(const XcdBarrier& b) {
    asm volatile("s_waitcnt vmcnt(0)" ::: "memory");
    __syncthreads();
    if (threadIdx.x == 0) {
        unsigned* bar = b.bar; asm volatile("" : "+s"(bar));
        __builtin_amdgcn_s_waitcnt(0);
        unsigned nloc = b.st[0], nx = b.st[1];
        if (nloc == 0u) { xcd_barrier_complete(bar, b.x, nloc, nx); b.st[0] = nloc; b.st[1] = nx; }
        const unsigned old = xb_add(&bar[XB_XSUB(b.x)], 1u);
        const unsigned gen = old / nloc;
        if (old + 1u == (gen + 1u) * nloc) {
            __builtin_amdgcn_fence(__ATOMIC_RELEASE, "agent");
            asm volatile("s_waitcnt vmcnt(0)" ::: "memory");
            const unsigned og = xb_add(&bar[XB_TOP], 1u);
            const unsigned tg = og / nx;
            if (og + 1u == (tg + 1u) * nx) xb_add(&bar[XB_TOPGEN], 1u);
            else XB_SPIN(xb_ld(&bar[XB_TOPGEN]) == tg, bar);
            __builtin_amdgcn_fence(__ATOMIC_ACQUIRE, "agent");
            xb_add(&bar[XB_XGEN(b.x)], 1u);
            asm volatile("s_waitcnt vmcnt(0)" ::: "memory");
        } else {
            XB_SPIN(xb_ld(&bar[XB_XGEN(b.x)]) == gen, bar);
            __builtin_amdgcn_fence(__ATOMIC_ACQUIRE, "agent");
            asm volatile("s_waitcnt vmcnt(0)" ::: "memory");
        }
    }
    __syncthreads();
}

__device__ __forceinline__ void ph_prologue(const Ctx& cx0, float* sm) {
    { CParams& p = get_params(); Ctx cx = cx0;
    const int tid = cx.tid, lane = tid & 63, wave = tid >> 6;
    const int gt = cx.bid * NTHREADS + tid, NGT = cx.nb * NTHREADS;
    const int gw = cx.bid * NWAVES + wave, NGW = cx.nb * NWAVES;
    unsigned char* ws = p.ws;
    {
        f32x4* dst = (f32x4*)(ws + WS_XCUR);
        const f32x4* sx = (const f32x4*)p.in[I_X]; const f32x4* sc = (const f32x4*)p.in[I_CTX];
        for (int i = gt; i < TL * DM / 4; i += NGT) dst[i] = sx[i];
        for (int i = gt; i < TC * DM / 4; i += NGT) dst[TL * DM / 4 + i] = sc[i];
    }
    }
    { CParams& p = get_params(); Ctx cx; cx.tid = threadIdx.x; cx.bid = blockIdx.x; cx.nb = gridDim.x; asm volatile("" : "+v"(cx.tid), "+s"(cx.bid), "+s"(cx.nb));
      const int tid = cx.tid, lane = tid & 63, wave = tid >> 6; const int gt = cx.bid * NTHREADS + tid, NGT = cx.nb * NTHREADS; const int gw = cx.bid * NWAVES + wave, NGW = cx.nb * NWAVES; unsigned char* ws = p.ws; (void)lane; (void)gt; (void)NGT; (void)gw; (void)NGW; (void)ws;
    {
        float* sil = sm;
        float* red = sm + 5 * 1024;
        bool have = false;
        for (int it = cx.bid; it < 192; it += cx.nb) {
            if (!have) {
                for (int i = tid; i < 5 * 1024; i += NTHREADS) { const float v = i < 4096 ? p.in[I_C][i] : p.in[I_CCTX][i - 4096]; sil[i] = v / (1.f + __expf(-v)); }
                have = true; __syncthreads();
            }
            const int layer = it / 96, col = (it % 96) * 64 + lane, kp = wave;
            const float* W = p.in[I_MODW] + (size_t)layer * DM * 6144 + col;
            float a0 = 0, a1 = 0, a2 = 0, a3 = 0, a4 = 0;
            for (int k = kp * 128; k < kp * 128 + 128; ++k) { const float w = W[(size_t)k * 6144]; a0 += sil[k] * w; a1 += sil[1024 + k] * w; a2 += sil[2048 + k] * w; a3 += sil[3072 + k] * w; a4 += sil[4096 + k] * w; }
            red[(kp * 5 + 0) * 64 + lane] = a0; red[(kp * 5 + 1) * 64 + lane] = a1; red[(kp * 5 + 2) * 64 + lane] = a2; red[(kp * 5 + 3) * 64 + lane] = a3; red[(kp * 5 + 4) * 64 + lane] = a4;
            __syncthreads();
            if (tid < 320) { const int j = tid >> 6; float s = 0; for (int q = 0; q < 8; ++q) s += red[(q * 5 + j) * 64 + lane];
                ((float*)(ws + WS_MODV))[((size_t)layer * 5 + j) * 6144 + col] = s + p.in[I_MODB][layer * 6144 + col]; }
            __syncthreads();
        }
    }
    }
    { CParams& p = get_params(); Ctx cx; cx.tid = threadIdx.x; cx.bid = blockIdx.x; cx.nb = gridDim.x; asm volatile("" : "+v"(cx.tid), "+s"(cx.bid), "+s"(cx.nb));
      const int tid = cx.tid, lane = tid & 63, wave = tid >> 6; const int gt = cx.bid * NTHREADS + tid, NGT = cx.nb * NTHREADS; const int gw = cx.bid * NWAVES + wave, NGW = cx.nb * NWAVES; unsigned char* ws = p.ws; (void)lane; (void)gt; (void)NGT; (void)gw; (void)NGW; (void)ws;
    for (int i = gt; i < 64 * 16; i += NGT) { const int pos = i >> 4, f = i & 15; const float ang = (float)pos * exp2f(-(float)f * (13.287712379549449f / 16.f));
        ((float*)(ws + WS_ROPE))[i * 2] = fcos(ang); ((float*)(ws + WS_ROPE))[i * 2 + 1] = fsin(ang); }
    }
    { CParams& p = get_params(); Ctx cx; cx.tid = threadIdx.x; cx.bid = blockIdx.x; cx.nb = gridDim.x; asm volatile("" : "+v"(cx.tid), "+s"(cx.bid), "+s"(cx.nb));
      const int tid = cx.tid, lane = tid & 63, wave = tid >> 6; const int gt = cx.bid * NTHREADS + tid, NGT = cx.nb * NTHREADS; const int gw = cx.bid * NWAVES + wave, NGW = cx.nb * NWAVES; unsigned char* ws = p.ws; (void)lane; (void)gt; (void)NGT; (void)gw; (void)NGW; (void)ws;
    for (int i = gt; i < 2 * 2 * 32 * 64; i += NGT) {
        const int g = (i >> 6) & 31, ld = i >> 11;
        const float are = fminf(p.in[I_SARE][i], -1e-4f), aim = p.in[I_SAIM][i];
        const float dt = __expf(p.in[I_SLDT][ld * 32 + g]);
        const float er = __expf(are * dt), abr = er * fcos(aim * dt), abi = er * fsin(aim * dt);
        const float nr = abr - 1.0f, ni = abi, den = are * are + aim * aim;
        const float cr = (nr * are + ni * aim) / den, ci = (ni * are - nr * aim) / den;
        ((float*)(ws + WS_S5A))[i * 2] = abr; ((float*)(ws + WS_S5A))[i * 2 + 1] = abi;
        for (int h = 0; h < 16; ++h) { const float br = p.in[I_SBRE][(size_t)i * 16 + h], bi = p.in[I_SBIM][(size_t)i * 16 + h];
            ((float*)(ws + WS_S5B))[((size_t)i * 16 + h) * 2] = cr * br - ci * bi; ((float*)(ws + WS_S5B))[((size_t)i * 16 + h) * 2 + 1] = cr * bi + ci * br; }
    }
    }
}


__device__ __forceinline__ void ph_filters(const Ctx& cx, int layer) {
    CParams& p = get_params();
    const int tid = cx.tid, lane = tid & 63, wave = tid >> 6; const int gw = cx.bid * NWAVES + wave, NGW = cx.nb * NWAVES; unsigned char* ws = p.ws;
    for (int it = gw; it < (SEQ + CTXL); it += NGW) {
        const int r = it, st = r >= SEQ ? 1 : 0, t = st ? r - SEQ : r, L = st ? CTXL : SEQ;
        const float tn = (float)t / (float)L;
        float z = 0.f;
        if (lane == 0) z = tn;
        else if (lane <= 16) z = fcos_rev(tn * (float)lane);
        else if (lane <= 32) z = fsin_rev(tn * (float)(lane - 16));
        const float* w1 = p.in[I_HW1] + layer * 33 * 64; const float* w2 = p.in[I_HW2] + layer * 64 * 64; const float* w3 = p.in[I_HW3] + layer * 64 * 1024;
        float a = p.in[I_HB1][layer * 64 + lane];
        for (int e = 0; e < 33; ++e) a += __shfl(z, e) * w1[e * 64 + lane];
        const float h1 = fsin(p.in[I_HF1][layer * 64 + lane] * a);
        float a2 = p.in[I_HB2][layer * 64 + lane];
        for (int j = 0; j < 64; ++j) a2 += __shfl(h1, j) * w2[j * 64 + lane];
        const float h2 = fsin(p.in[I_HF2][layer * 64 + lane] * a2);
        const float tw = (float)t / (float)(L - 1);
        float* fbase = (float*)(ws + WS_FILT + (st ? FILT_CTX_OFF : 0));
        for (int cc = 0; cc < 16; ++cc) {
            const int col = cc * 64 + lane; float f = 0.f;
            for (int j = 0; j < 64; ++j) f += __shfl(h2, j) * w3[j * 1024 + col];
            const int c = col & 511, isb = col >> 9;
            const float rate = HY_FAST + (HY_SLOW - HY_FAST) * ((float)c / 511.f);
            fbase[((size_t)isb * 512 + c) * L + t] = f * __expf(-tw * rate);
        }
    }
}
__device__ __forceinline__ void conv_T(const Ctx& cx, const float* W, int K, int N, bf16* dst, bool perm) {
    const int gt = cx.bid * NTHREADS + cx.tid, NGT = cx.nb * NTHREADS;
    for (int it = gt; it < N * (K / 8); it += NGT) {
        const int n = it % N, k0 = (it / N) * 8;
        const int sn = (perm && n < COL_V) ? ((n & ~63) + ((n & 63) >> 1) + 32 * (n & 1)) : n;
        const float* s = W + (size_t)k0 * N + sn;
        u32x4 w; w.x = pk2(s[0], s[N]); w.y = pk2(s[2 * (size_t)N], s[3 * (size_t)N]); w.z = pk2(s[4 * (size_t)N], s[5 * (size_t)N]); w.w = pk2(s[6 * (size_t)N], s[7 * (size_t)N]);
        *(u32x4*)(dst + (size_t)n * K + k0) = w;
    }
}
__device__ __forceinline__ void ph_convert(const Ctx& cx0) {
#define RELAUNDER() CParams& p = get_params(); Ctx cx; cx.tid = threadIdx.x; cx.bid = blockIdx.x; cx.nb = gridDim.x; asm volatile("" : "+v"(cx.tid), "+s"(cx.bid), "+s"(cx.nb));
#pragma unroll 1
    for (int layer = 0; layer < DEPTH; ++layer) {
        { RELAUNDER(); conv_T(cx, p.in[I_INW] + (size_t)layer * DM * INW, DM, INW, (bf16*)(p.ws + WT_IN) + (size_t)layer * INW * DM, true); }
        { RELAUNDER(); conv_T(cx, p.in[I_GLUW] + (size_t)layer * 512 * 512, 512, 512, (bf16*)(p.ws + WT_GLU) + (size_t)layer * 512 * 512, false); }
        { RELAUNDER(); conv_T(cx, p.in[I_BRA] + (size_t)layer * 512 * 1024, 512, 1024, (bf16*)(p.ws + WT_BR) + (size_t)(layer * 3 + 0) * 1024 * 512, false); }
        { RELAUNDER(); conv_T(cx, p.in[I_BRH] + (size_t)layer * 512 * 1024, 512, 1024, (bf16*)(p.ws + WT_BR) + (size_t)(layer * 3 + 1) * 1024 * 512, false); }
        { RELAUNDER(); conv_T(cx, p.in[I_BRS] + (size_t)layer * 512 * 1024, 512, 1024, (bf16*)(p.ws + WT_BR) + (size_t)(layer * 3 + 2) * 1024 * 512, false); }
        { RELAUNDER(); conv_T(cx, p.in[I_OUTW] + (size_t)layer * 1024 * 1024, 1024, 1024, (bf16*)(p.ws + WT_OUT) + (size_t)layer * 1024 * 1024, false); }
        { RELAUNDER(); conv_T(cx, p.in[I_WQ] + (size_t)layer * 1024 * 2048, 1024, 2048, (bf16*)(p.ws + WT_WQ) + (size_t)layer * 2048 * 1024, false); }
    }
    { RELAUNDER(); const int gt = cx.bid * NTHREADS + cx.tid, NGT = cx.nb * NTHREADS;
      for (int i = gt; i < 2 * 8 * 2 * 128 * 128 / 4; i += NGT) { const f32x4 v = ((const f32x4*)p.in[I_PKEYS])[i]; u32x2 w; w.x = pk2(v[0], v[1]); w.y = pk2(v[2], v[3]); ((u32x2*)(p.ws + WT_KEYS))[i] = w; } }
#undef RELAUNDER
    (void)cx0;
}

__device__ __forceinline__ void ph_norm(const Ctx& cx, int layer, int which, int nrows_lat_only) {
    CParams& p = get_params();
    const int lane = cx.tid & 63, wave = cx.tid >> 6;
    const int gw = cx.bid * NWAVES + wave, NGW = cx.nb * NWAVES;
    const float* g = p.in[which ? I_N2G : I_N1G] + layer * DM;
    const float* xc = (const float*)(p.ws + WS_XCUR);
    bf16* H = (bf16*)(p.ws + WS_H);
    const int nrows = nrows_lat_only ? TL : TA;
    for (int r = gw; r < nrows; r += NGW) {
        const float* mv = (const float*)(p.ws + WS_MODV) + ((size_t)layer * 5 + row_mi(r)) * 6144 + (which ? 3072 : 0);
        f32x4 v[4]; float s = 0.f;
#pragma unroll
        for (int j = 0; j < 4; ++j) { v[j] = *(const f32x4*)(xc + (size_t)r * DM + j * 256 + lane * 4); s += v[j].x * v[j].x + v[j].y * v[j].y + v[j].z * v[j].z + v[j].w * v[j].w; }
        const float rs = rsqrtf(wave_sum(s) * (1.f / DM) + NORM_EPS);
#pragma unroll
        for (int j = 0; j < 4; ++j) { const int c = j * 256 + lane * 4;
            const f32x4 gg = *(const f32x4*)(g + c), sh = *(const f32x4*)(mv + c), sc = *(const f32x4*)(mv + 1024 + c);
            const f32x4 y = v[j] * rs * gg; const f32x4 h = y * (1.f + sc) + sh;
            u32x2 w; w.x = pk2(h.x, h.y); w.y = pk2(h.z, h.w); *(u32x2*)(H + (size_t)r * DM + c) = w; }
    }
}


namespace pg8 {
#define PG8_LAS __attribute__((address_space(3)))
typedef unsigned short bf16_t;
typedef short bf16x8 __attribute__((ext_vector_type(8)));
constexpr int BM = 256, BK = 64, HALF = 128, HTB = HALF * BK * 2, STAGE_BYTES = 8 * HTB, NXCD = 8, WGM = 8;
__host__ __device__ __forceinline__ int lds_byte(int r, int c) { const int st = (r >> 4) * 2 + (c >> 5), rr = r & 15, cc = c & 31, ob = rr * 64 + cc * 2; return st * 1024 + (ob ^ (((ob >> 9) & 1) << 5)); }
__host__ __device__ __forceinline__ void stage_rc(int b, int& R, int& C) { const int st = b / 1024, sb = b % 1024, swz = sb ^ (((sb >> 9) & 1) << 5); R = (st >> 1) * 16 + swz / 64; C = (st & 1) * 32 + (swz % 64) / 2; }
__host__ __device__ __forceinline__ int perm32(int rho) { const int n = rho >> 4, i = rho & 15; return 8 * (i >> 2) + 4 * n + (i & 3); }
struct Unit { int pm, pn, z; };
struct Gemm { const bf16_t* A; const bf16_t* Bt; size_t zsA, zsB; int K; };
__device__ __forceinline__ const bf16_t* selA(const Gemm& g, int z) { return g.A + (size_t)z * g.zsA; }
__device__ __forceinline__ const bf16_t* selB(const Gemm& g, int z) { return g.Bt + (size_t)z * g.zsB; }
struct TileOrder {
    int nM, nN, nwg, G, c, extra, exN, expn0, nz;
    __device__ __forceinline__ bool next(int i, Unit& u) const {
        const int ti = i / nz; u.z = i - ti * nz;
        const long L = (long)ti * G + c;
        if (L < nwg) {
            int wgid = (int)L; { const int q = nwg / NXCD, r = nwg % NXCD, xcd = wgid % NXCD, off = wgid / NXCD; wgid = (xcd < r ? xcd * (q + 1) : r * (q + 1) + (xcd - r) * q) + off; }
            const int nig = WGM * nN, gid = wgid / nig, fm = gid * WGM, gsz = (nM - fm) < WGM ? (nM - fm) : WGM;
            u.pm = fm + ((wgid % nig) % gsz); u.pn = (wgid % nig) / gsz; return true;
        }
        const int e = (int)(L - nwg); if (e >= extra) return false;
        u.pm = nM + e / exN; u.pn = expn0 + e % exN; return true;
    }
};
__device__ __forceinline__ unsigned cvt_pk_bf16(float lo, float hi) { unsigned r; asm volatile("v_cvt_pk_bf16_f32 %0, %1, %2" : "=v"(r) : "v"(lo), "v"(hi)); return r; }
template <class Epi, class Sched, bool ALIGN_EPI = true, bool SP2 = true>
__device__ __forceinline__ void gemm_phase(PG8_LAS unsigned char* lds, const Gemm g, const Sched& S, const Epi& E, const int tid_) {
    const int tid = tid_, wid = __builtin_amdgcn_readfirstlane(tid >> 6), lane = tid & 63, wr = wid >> 2, wc = wid & 3, fr = lane & 15, fq = lane >> 4;
    const int K = g.K, nt = K / BK;
    unsigned voffA[2], voffB[2];
#pragma unroll
    for (int i = 0; i < 2; ++i) { int R, C; stage_rc(tid * 16 + i * 8192, R, C); const int Rb = Epi::PERM ? ((R & ~31) + perm32(R & 31)) : R;
        voffA[i] = (unsigned)(R * K + C) * 2u; voffB[i] = (unsigned)(Rb * K + C) * 2u; }
    const size_t kstep = (size_t)(BK * 2);
    const size_t hstep = (size_t)HALF * K * 2;
    const size_t tstep = 2 * hstep;
    const unsigned ldsw = (unsigned)wid * 1024u;
    const int aoff = lds_byte(wr * 64 + fr, fq * 8), boff = lds_byte(wc * 32 + fr, fq * 8);
#define PG8_SA(b, h) (((b) * 2 + (h)) * HTB)
#define PG8_SB(b, h) ((4 + (b) * 2 + (h)) * HTB)
#define PG8_STAGE(bufoff, gbase, voff) do { _Pragma("unroll") for (int _i = 0; _i < 2; ++_i) \
        __builtin_amdgcn_global_load_lds((const unsigned*)((const char*)(gbase) + (voff)[_i]), (PG8_LAS unsigned*)(lds + (bufoff) + ldsw + _i * 8192), 16, 0, 0); } while (0)
#define PG8_LDA(dst, b, h) do { _Pragma("unroll") for (int m = 0; m < 4; ++m) _Pragma("unroll") for (int k = 0; k < 2; ++k) dst[m][k] = *(const PG8_LAS bf16x8*)(lds + PG8_SA(b, h) + aoff + m * 2048 + k * 1024); } while (0)
#define PG8_LDB(dst, b, h) do { _Pragma("unroll") for (int n = 0; n < 2; ++n) _Pragma("unroll") for (int k = 0; k < 2; ++k) dst[n][k] = *(const PG8_LAS bf16x8*)(lds + PG8_SB(b, h) + boff + n * 2048 + k * 1024); } while (0)
#define PG8_MMA(ai, bj, At, Bt) do { __builtin_amdgcn_s_setprio(1); _Pragma("unroll") for (int m = 0; m < 4; ++m) _Pragma("unroll") for (int n = 0; n < 2; ++n) _Pragma("unroll") for (int k = 0; k < 2; ++k) \
        acc[ai][bj][m][n] = __builtin_amdgcn_mfma_f32_16x16x32_bf16(Bt[n][k], At[m][k], acc[ai][bj][m][n], 0, 0, 0); __builtin_amdgcn_s_setprio(0); } while (0)
#define PG8_WAIT_V(n) asm volatile("s_waitcnt vmcnt(" #n ")" ::: "memory")
#define PG8_WAIT_L(n) asm volatile("s_waitcnt lgkmcnt(" #n ")" ::: "memory")
#define PG8_BAR __builtin_amdgcn_s_barrier()
#define PG8_SCHED __builtin_amdgcn_sched_barrier(0)
    Unit cur, nxt; int ui = 0;
    if (!S.next(0, cur)) return;
    f32x4 acc[2][2][4][2];
#pragma unroll
    for (int a = 0; a < 2; ++a)
#pragma unroll
        for (int b = 0; b < 2; ++b)
#pragma unroll
            for (int m = 0; m < 4; ++m)
#pragma unroll
                for (int n = 0; n < 2; ++n) acc[a][b][m][n] = (f32x4){0.f, 0.f, 0.f, 0.f};
    bf16x8 At[4][2], B0[2][2], B1[2][2];
    const char* cA = (const char*)selA(g, cur.z) + (size_t)cur.pm * tstep; const char* cB = (const char*)selB(g, cur.z) + (size_t)cur.pn * tstep;
    if constexpr (SP2) {
        PG8_STAGE(PG8_SB(0, 0), cB, voffB); PG8_STAGE(PG8_SB(0, 1), cB + hstep, voffB); PG8_STAGE(PG8_SA(0, 0), cA, voffA); PG8_STAGE(PG8_SA(0, 1), cA + hstep, voffA);
        if (wr == 1) PG8_BAR;
        PG8_WAIT_V(2); PG8_BAR;
        PG8_STAGE(PG8_SB(1, 0), cB + kstep, voffB); PG8_STAGE(PG8_SA(1, 0), cA + kstep, voffA); PG8_STAGE(PG8_SB(1, 1), cB + hstep + kstep, voffB);
        PG8_WAIT_V(6); PG8_BAR;
    } else {
        PG8_STAGE(PG8_SB(0, 0), cB, voffB); PG8_STAGE(PG8_SA(0, 0), cA, voffA); PG8_STAGE(PG8_SB(0, 1), cB + hstep, voffB); PG8_STAGE(PG8_SA(0, 1), cA + hstep, voffA);
        if (wr == 1) PG8_BAR;
        PG8_WAIT_V(4); PG8_BAR;
        PG8_STAGE(PG8_SB(1, 0), cB + kstep, voffB); PG8_STAGE(PG8_SA(1, 0), cA + kstep, voffA); PG8_STAGE(PG8_SB(1, 1), cB + hstep + kstep, voffB);
        PG8_WAIT_V(6); PG8_BAR;
    }
    for (;;) {
        const bool has_next = S.next(ui + 1, nxt);
        const char* nA = has_next ? (const char*)selA(g, nxt.z) + (size_t)nxt.pm * tstep : cA; const char* nB = has_next ? (const char*)selB(g, nxt.z) + (size_t)nxt.pn * tstep : cB;
        for (int t = 0; t < nt; t += 2) {
            const bool last = (t == nt - 2);
            const char* a1 = cA + (size_t)(t + 1) * kstep;
            const char* a2 = last ? nA : cA + (size_t)(t + 2) * kstep; const char* b2 = last ? nB : cB + (size_t)(t + 2) * kstep;
            const char* a3 = a2 + kstep; const char* b3 = b2 + kstep;
            if constexpr (SP2) {
            PG8_LDB(B0, 0, 0); PG8_LDB(B1, 0, 1); PG8_SCHED; PG8_LDA(At, 0, 0); PG8_STAGE(PG8_SA(1, 1), a1 + hstep, voffA);
            PG8_WAIT_V(8); PG8_WAIT_L(0); PG8_BAR; PG8_MMA(0, 0, At, B0); PG8_MMA(0, 1, At, B1); PG8_BAR; PG8_SCHED;
            PG8_LDA(At, 0, 1); PG8_STAGE(PG8_SB(0, 0), b2, voffB); PG8_STAGE(PG8_SB(0, 1), b2 + hstep, voffB); PG8_STAGE(PG8_SA(0, 0), a2, voffA);
            PG8_WAIT_V(8); PG8_WAIT_L(0); PG8_BAR; PG8_MMA(1, 0, At, B0); PG8_MMA(1, 1, At, B1); PG8_BAR; PG8_SCHED;
            PG8_LDB(B0, 1, 0); PG8_LDB(B1, 1, 1); PG8_SCHED; PG8_LDA(At, 1, 0); PG8_STAGE(PG8_SA(0, 1), a2 + hstep, voffA);
            PG8_WAIT_V(8); PG8_WAIT_L(0); PG8_BAR; PG8_MMA(0, 0, At, B0); PG8_MMA(0, 1, At, B1); PG8_BAR; PG8_SCHED;
            PG8_LDA(At, 1, 1); PG8_STAGE(PG8_SB(1, 0), b3, voffB); PG8_STAGE(PG8_SB(1, 1), b3 + hstep, voffB); PG8_STAGE(PG8_SA(1, 0), a3, voffA);
            PG8_WAIT_V(8); PG8_WAIT_L(0); PG8_BAR; PG8_MMA(1, 0, At, B0); PG8_MMA(1, 1, At, B1); PG8_BAR; PG8_SCHED;
            } else {
            PG8_LDB(B0, 0, 0); PG8_SCHED; PG8_LDA(At, 0, 0); PG8_STAGE(PG8_SA(1, 1), a1 + hstep, voffA);
            PG8_WAIT_L(8); PG8_BAR; PG8_WAIT_L(0); PG8_MMA(0, 0, At, B0); PG8_BAR; PG8_SCHED;
            PG8_LDB(B1, 0, 1); PG8_STAGE(PG8_SB(0, 0), b2, voffB);
            PG8_BAR; PG8_WAIT_L(0); PG8_MMA(0, 1, At, B1); PG8_BAR;
            PG8_LDA(At, 0, 1); PG8_STAGE(PG8_SA(0, 0), a2, voffA);
            PG8_BAR; PG8_WAIT_L(0); PG8_MMA(1, 0, At, B0); PG8_BAR; PG8_SCHED;
            PG8_STAGE(PG8_SB(0, 1), b2 + hstep, voffB);
            PG8_WAIT_V(6); PG8_BAR; PG8_MMA(1, 1, At, B1); PG8_BAR;
            PG8_LDB(B0, 1, 0); PG8_SCHED; PG8_LDA(At, 1, 0); PG8_STAGE(PG8_SA(0, 1), a2 + hstep, voffA);
            PG8_WAIT_L(8); PG8_BAR; PG8_WAIT_L(0); PG8_MMA(0, 0, At, B0); PG8_BAR; PG8_SCHED;
            PG8_LDB(B1, 1, 1); PG8_STAGE(PG8_SB(1, 0), b3, voffB);
            PG8_BAR; PG8_WAIT_L(0); PG8_MMA(0, 1, At, B1); PG8_BAR;
            PG8_LDA(At, 1, 1); PG8_STAGE(PG8_SA(1, 0), a3, voffA);
            PG8_BAR; PG8_WAIT_L(0); PG8_MMA(1, 0, At, B0); PG8_BAR; PG8_SCHED;
            PG8_STAGE(PG8_SB(1, 1), b3 + hstep, voffB);
            PG8_WAIT_V(6); PG8_BAR; PG8_MMA(1, 1, At, B1); PG8_BAR;
            }
        }
        if constexpr (ALIGN_EPI) { if (wr == 0) PG8_BAR; }
        const bool keep = E(acc, cur, wr, wc, fr, fq);
        if (!has_next) break;
        if (!keep) {
#pragma unroll
        for (int a = 0; a < 2; ++a)
#pragma unroll
            for (int b = 0; b < 2; ++b)
#pragma unroll
                for (int m = 0; m < 4; ++m)
#pragma unroll
                    for (int n = 0; n < 2; ++n) acc[a][b][m][n] = (f32x4){0.f, 0.f, 0.f, 0.f};
        }
        cur = nxt; cA = nA; cB = nB; ++ui;
        if constexpr (ALIGN_EPI) { if (wr == 1) PG8_BAR; }
    }
    PG8_WAIT_V(0);
    if constexpr (!ALIGN_EPI) { if (wr == 0) PG8_BAR; }
    PG8_BAR;
#undef PG8_SA
#undef PG8_SB
#undef PG8_STAGE
#undef PG8_LDA
#undef PG8_LDB
#undef PG8_MMA
#undef PG8_WAIT_V
#undef PG8_WAIT_L
#undef PG8_BAR
#undef PG8_SCHED
}
}

__device__ __forceinline__ f32x4 bf4lo(u32x4 w) { return (f32x4){__uint_as_float(w.x << 16), __uint_as_float(w.x & 0xffff0000u), __uint_as_float(w.y << 16), __uint_as_float(w.y & 0xffff0000u)}; }
__device__ __forceinline__ f32x4 bf4hi(u32x4 w) { return (f32x4){__uint_as_float(w.z << 16), __uint_as_float(w.z & 0xffff0000u), __uint_as_float(w.w << 16), __uint_as_float(w.w & 0xffff0000u)}; }
__device__ __forceinline__ u32x4 pack8(f32x4 a, f32x4 b) { u32x4 w; w.x = pg8::cvt_pk_bf16(a[0], a[1]); w.y = pg8::cvt_pk_bf16(a[2], a[3]); w.z = pg8::cvt_pk_bf16(b[0], b[1]); w.w = pg8::cvt_pk_bf16(b[2], b[3]); return w; }
__device__ __forceinline__ f32x4 sig4(f32x4 v) { return (f32x4){sigmoidf_(v[0]), sigmoidf_(v[1]), sigmoidf_(v[2]), sigmoidf_(v[3])}; }

template <class T> __device__ __forceinline__ T* uni_ptr(T* q) { unsigned long long a = (unsigned long long)q; unsigned lo = __builtin_amdgcn_readfirstlane((unsigned)a), hi = __builtin_amdgcn_readfirstlane((unsigned)(a >> 32));
    asm volatile("" : "+s"(lo), "+s"(hi)); return (T*)(((unsigned long long)hi << 32) | lo); }
struct EpiInproj {
    static constexpr bool PERM = true;
    unsigned char* ws; const float* gate_b;
    __device__ __forceinline__ bool operator()(f32x4 (&acc)[2][2][4][2], const pg8::Unit& u, int wr, int wc, int fr_, int fq_) const {
        int fr = fr_, fq = fq_; asm volatile("" : "+v"(fr), "+v"(fq)); unsigned char* const ws = uni_ptr(this->ws);
        const int cl = wc * 32 + 8 * fq, rbase = u.pm * 256 + wr * 64 + fr;
#pragma unroll
        for (int bj = 0; bj < 2; ++bj) {
            const int c128 = u.pn * 256 + bj * 128;
            unsigned char* base; unsigned rstride, coff; int kind = 0;
            if (c128 < COL_K)         { base = ws + WS_Q; rstride = 1024; coff = (unsigned)(c128 + cl) * 2u; kind = 1; }
            else if (c128 < COL_V)    { base = ws + WS_K; rstride = 256;  coff = (unsigned)cl * 2u; kind = 1; }
            else if (c128 < COL_S5)   { base = ws + WS_V; rstride = 256;  coff = (unsigned)cl * 2u; }
            else if (c128 < COL_HY)   { base = ws + WS_U; rstride = 1024; coff = (unsigned)(c128 - COL_S5 + cl) * 2u; }
            else if (c128 < COL_GATE) { base = ws + WS_Z; rstride = 3072; coff = (unsigned)(c128 - COL_HY + cl) * 2u; }
            else                      { base = ws + WS_G; rstride = 6144; coff = (unsigned)(c128 - COL_GATE + cl) * 2u; kind = 2; }
            if (kind == 1) {
                const float* rope = (const float*)(ws + WS_ROPE) + 8 * fq;
#pragma unroll
                for (int ai = 0; ai < 2; ++ai)
#pragma unroll
                    for (int m = 0; m < 4; ++m) {
                        const int r = rbase + ai * 128 + m * 16;
                        f32x4 v0 = acc[ai][bj][m][0], v1 = acc[ai][bj][m][1];
                        if (r < TL) { const int l = r & 4095, pos = (wc & 1) ? (l & 63) : (l >> 6);
                            const f32x4 t0 = *(const f32x4*)(rope + pos * 32), t1 = *(const f32x4*)(rope + pos * 32 + 4);
                            v0 = (f32x4){v0[0] * t0[0] - v0[1] * t0[1], v0[0] * t0[1] + v0[1] * t0[0], v0[2] * t0[2] - v0[3] * t0[3], v0[2] * t0[3] + v0[3] * t0[2]};
                            v1 = (f32x4){v1[0] * t1[0] - v1[1] * t1[1], v1[0] * t1[1] + v1[1] * t1[0], v1[2] * t1[2] - v1[3] * t1[3], v1[2] * t1[3] + v1[3] * t1[2]}; }
                        *(u32x4*)(base + ((unsigned)r * rstride + coff)) = pack8(v0, v1);
                        asm volatile("" ::: "memory");
                    }
            } else if (kind == 2) {
                const float* gb = uni_ptr(gate_b) + (c128 - COL_GATE) + cl; const f32x4 b0 = *(const f32x4*)gb, b1 = *(const f32x4*)(gb + 4);
#pragma unroll
                for (int ai = 0; ai < 2; ++ai)
#pragma unroll
                    for (int m = 0; m < 4; ++m) {
                        const int r = rbase + ai * 128 + m * 16;
                        *(u32x4*)(base + ((unsigned)r * rstride + coff)) = pack8(sig4(acc[ai][bj][m][0] + b0), sig4(acc[ai][bj][m][1] + b1));
                        asm volatile("" ::: "memory");
                    }
            } else {
#pragma unroll
                for (int ai = 0; ai < 2; ++ai)
#pragma unroll
                    for (int m = 0; m < 4; ++m) {
                        const int r = rbase + ai * 128 + m * 16;
                        *(u32x4*)(base + ((unsigned)r * rstride + coff)) = pack8(acc[ai][bj][m][0], acc[ai][bj][m][1]);
                    }
            }
        }
        return false;
    }
};
struct EpiGlu {
    static constexpr bool PERM = true;
    unsigned char* ws; const float* bias;
    __device__ __forceinline__ bool operator()(f32x4 (&acc)[2][2][4][2], const pg8::Unit& u, int wr, int wc, int fr_, int fq_) const {
        int fr = fr_, fq = fq_; asm volatile("" : "+v"(fr), "+v"(fq)); unsigned char* const ws = uni_ptr(this->ws);
#pragma unroll
        for (int bj = 0; bj < 2; ++bj) { const int c = u.pn * 256 + bj * 128 + wc * 32 + 8 * fq; const f32x4 b0 = *(const f32x4*)(bias + c), b1 = *(const f32x4*)(bias + c + 4);
#pragma unroll
            for (int ai = 0; ai < 2; ++ai)
#pragma unroll
                for (int m = 0; m < 4; ++m) { const size_t o = (size_t)(u.pm * 256 + ai * 128 + wr * 64 + m * 16 + fr) * 512 + c;
                    const u32x4 yw = *(const u32x4*)((const bf16*)(ws + WS_S5Y) + o);
                    *(u32x4*)((bf16*)(ws + WS_S5O) + o) = pack8(bf4lo(yw) * sig4(acc[ai][bj][m][0] + b0), bf4hi(yw) * sig4(acc[ai][bj][m][1] + b1)); asm volatile("" ::: "memory"); } }
        return false;
    }
};
struct EpiMerge {
    static constexpr bool PERM = true;
    unsigned char* ws;
    __device__ __forceinline__ bool operator()(f32x4 (&acc)[2][2][4][2], const pg8::Unit& u, int wr, int wc, int fr_, int fq_) const {
        int fr = fr_, fq = fq_; asm volatile("" : "+v"(fr), "+v"(fq)); unsigned char* const ws = uni_ptr(this->ws);
#pragma unroll
        for (int bj = 0; bj < 2; ++bj) { const int c = u.pn * 256 + bj * 128 + wc * 32 + 8 * fq;
#pragma unroll
            for (int ai = 0; ai < 2; ++ai)
#pragma unroll
                for (int m = 0; m < 4; ++m) { const int r = u.pm * 256 + ai * 128 + wr * 64 + m * 16 + fr;
                    const bf16* gp = (const bf16*)(ws + WS_G) + (size_t)r * 3072 + u.z * 1024 + c;
                    const u32x4 g0 = *(const u32x4*)gp;
                    if (u.z < 2) { const u32x4 g1 = *(const u32x4*)(gp + 1024);
                        const f32x4 d0 = bf4lo(g1), d1 = bf4hi(g1), n0 = bf4lo(g0), n1 = bf4hi(g0);
                        acc[ai][bj][m][0] *= (f32x4){n0[0] / fmaxf(d0[0], 1e-30f), n0[1] / fmaxf(d0[1], 1e-30f), n0[2] / fmaxf(d0[2], 1e-30f), n0[3] / fmaxf(d0[3], 1e-30f)};
                        acc[ai][bj][m][1] *= (f32x4){n1[0] / fmaxf(d1[0], 1e-30f), n1[1] / fmaxf(d1[1], 1e-30f), n1[2] / fmaxf(d1[2], 1e-30f), n1[3] / fmaxf(d1[3], 1e-30f)};
                    } else *(u32x4*)((bf16*)(ws + WS_M) + (size_t)r * 1024 + c) = pack8(acc[ai][bj][m][0] * bf4lo(g0), acc[ai][bj][m][1] * bf4hi(g0));
                    asm volatile("" ::: "memory");
                } }
        return u.z < 2;
    }
};
struct EpiOut {
    static constexpr bool PERM = false;
    unsigned char* ws; int layer;
    __device__ __forceinline__ bool operator()(f32x4 (&acc)[2][2][4][2], const pg8::Unit& u, int wr, int wc, int fr_, int fq_) const {
        int fr = fr_, fq = fq_; asm volatile("" : "+v"(fr), "+v"(fq)); unsigned char* const ws = uni_ptr(this->ws);
        float* X = (float*)(ws + WS_XCUR);
#pragma unroll
        for (int ai = 0; ai < 2; ++ai)
#pragma unroll
            for (int m = 0; m < 4; ++m) { const int r = u.pm * 256 + ai * 128 + wr * 64 + m * 16 + fr;
                const float* g1 = (const float*)(ws + WS_MODV) + ((size_t)layer * 5 + row_mi(r)) * 6144 + 2048;
#pragma unroll
                for (int bj = 0; bj < 2; ++bj)
#pragma unroll
                    for (int n = 0; n < 2; ++n) { const int c = u.pn * 256 + bj * 128 + wc * 32 + n * 16 + 4 * fq; f32x4* xp = (f32x4*)(X + (size_t)r * 1024 + c);
                        *xp = *xp + *(const f32x4*)(g1 + c) * acc[ai][bj][m][n]; } asm volatile("" ::: "memory"); }
        return false;
    }
};
struct EpiQp {
    static constexpr bool PERM = true;
    unsigned char* ws;
    __device__ __forceinline__ bool operator()(f32x4 (&acc)[2][2][4][2], const pg8::Unit& u, int wr, int wc, int fr_, int fq_) const {
        int fr = fr_, fq = fq_; asm volatile("" : "+v"(fr), "+v"(fq)); unsigned char* const ws = uni_ptr(this->ws);
#pragma unroll
        for (int bj = 0; bj < 2; ++bj) { const int c = u.pn * 256 + bj * 128 + wc * 32 + 8 * fq;
#pragma unroll
            for (int ai = 0; ai < 2; ++ai)
#pragma unroll
                for (int m = 0; m < 4; ++m) *(u32x4*)((bf16*)(ws + WS_QP) + (size_t)(u.pm * 256 + ai * 128 + wr * 64 + m * 16 + fr) * 2048 + c) = pack8(acc[ai][bj][m][0], acc[ai][bj][m][1]); }
        return false;
    }
};

__device__ __forceinline__ void ph_inproj(const Ctx& cx, int layer, PG8_LAS unsigned char* lds) {
    CParams& p = get_params();
    pg8::Gemm g; g.A = (const bf16*)(p.ws + WS_H); g.Bt = (const bf16*)(p.ws + WT_IN) + (size_t)layer * INW * DM; g.zsA = 0; g.zsB = 0; g.K = DM;
    pg8::TileOrder S; S.nM = TL / 256; S.nN = INW / 256; S.nwg = S.nM * S.nN; S.G = cx.nb; S.c = cx.bid; S.nz = 1;
    if (layer == DEPTH - 1) { S.exN = 3; S.expn0 = 2; S.extra = 4 * 3; } else { S.exN = INW / 256; S.expn0 = 0; S.extra = 4 * (INW / 256); }
    EpiInproj E; E.ws = p.ws; E.gate_b = p.in[I_GATEB] + layer * 3072;
    pg8::gemm_phase<EpiInproj, pg8::TileOrder>(lds, g, S, E, cx.tid);
}

__device__ __forceinline__ void ph_attn(const Ctx& cx, int layer) {
    CParams& p = get_params();
    const int gt = cx.bid * NTHREADS + cx.tid, NGT = cx.nb * NTHREADS;
    const bf16* Q = (const bf16*)(p.ws + WS_Q); const bf16* Kb = (const bf16*)(p.ws + WS_K); const bf16* Vb = (const bf16*)(p.ws + WS_V);
    bf16* O = (bf16*)(p.ws + WS_ATT);
    const int nrows = layer == 0 ? TA : TL;
    for (int it4 = gt; it4 < nrows * 8 * 4; it4 += NGT) {
        const int sub = it4 & 3, it = it4 >> 2;
        const int h = it / nrows, r = it % nrows;
        const int b = row_b(r), kvh = h >> 2;
        float q[16], acc[16];
#pragma unroll
        for (int d8 = 0; d8 < 2; ++d8) { const u32x4 w = *(const u32x4*)(Q + (size_t)r * 512 + h * 64 + sub * 16 + d8 * 8);
            q[d8 * 8 + 0] = __uint_as_float(w.x << 16); q[d8 * 8 + 1] = __uint_as_float(w.x & 0xffff0000u); q[d8 * 8 + 2] = __uint_as_float(w.y << 16); q[d8 * 8 + 3] = __uint_as_float(w.y & 0xffff0000u);
            q[d8 * 8 + 4] = __uint_as_float(w.z << 16); q[d8 * 8 + 5] = __uint_as_float(w.z & 0xffff0000u); q[d8 * 8 + 6] = __uint_as_float(w.w << 16); q[d8 * 8 + 7] = __uint_as_float(w.w & 0xffff0000u); }
#pragma unroll
        for (int d = 0; d < 16; ++d) acc[d] = 0.f;
        float m = p.in[I_SINK][layer * 8 + h], l = 1.f;
        int wlo = 0, whi = -1;
        if (r < TL) { const int pos = r & 4095; wlo = pos - 128 < 0 ? 0 : pos - 128; whi = pos + 128 > SEQ - 1 ? SEQ - 1 : pos + 128; }
        const int nwin = whi - wlo + 1;
        for (int kk = 0; kk < 256 + nwin; ++kk) {
            const int kr = kk < 256 ? TL + b * 256 + kk : b * SEQ + wlo + (kk - 256);
            const bf16* kp = Kb + (size_t)kr * 128 + kvh * 64 + sub * 16; const bf16* vp = Vb + (size_t)kr * 128 + kvh * 64 + sub * 16;
            float s = 0.f;
#pragma unroll
            for (int d8 = 0; d8 < 2; ++d8) { const u32x4 w = *(const u32x4*)(kp + d8 * 8);
                s += q[d8 * 8 + 0] * __uint_as_float(w.x << 16) + q[d8 * 8 + 1] * __uint_as_float(w.x & 0xffff0000u) + q[d8 * 8 + 2] * __uint_as_float(w.y << 16) + q[d8 * 8 + 3] * __uint_as_float(w.y & 0xffff0000u)
                   + q[d8 * 8 + 4] * __uint_as_float(w.z << 16) + q[d8 * 8 + 5] * __uint_as_float(w.z & 0xffff0000u) + q[d8 * 8 + 6] * __uint_as_float(w.w << 16) + q[d8 * 8 + 7] * __uint_as_float(w.w & 0xffff0000u); }
            s += __shfl_xor(s, 1); s += __shfl_xor(s, 2);
            s *= 0.125f;
            const float mn = fmaxf(m, s), f = __expf(m - mn), e = __expf(s - mn);
            l = l * f + e; m = mn;
#pragma unroll
            for (int d8 = 0; d8 < 2; ++d8) { const u32x4 w = *(const u32x4*)(vp + d8 * 8);
                acc[d8 * 8 + 0] = acc[d8 * 8 + 0] * f + e * __uint_as_float(w.x << 16); acc[d8 * 8 + 1] = acc[d8 * 8 + 1] * f + e * __uint_as_float(w.x & 0xffff0000u);
                acc[d8 * 8 + 2] = acc[d8 * 8 + 2] * f + e * __uint_as_float(w.y << 16); acc[d8 * 8 + 3] = acc[d8 * 8 + 3] * f + e * __uint_as_float(w.y & 0xffff0000u);
                acc[d8 * 8 + 4] = acc[d8 * 8 + 4] * f + e * __uint_as_float(w.z << 16); acc[d8 * 8 + 5] = acc[d8 * 8 + 5] * f + e * __uint_as_float(w.z & 0xffff0000u);
                acc[d8 * 8 + 6] = acc[d8 * 8 + 6] * f + e * __uint_as_float(w.w << 16); acc[d8 * 8 + 7] = acc[d8 * 8 + 7] * f + e * __uint_as_float(w.w & 0xffff0000u); }
        }
        const float il = 1.f / l;
#pragma unroll
        for (int d8 = 0; d8 < 2; ++d8) { u32x4 w; w.x = pk2(acc[d8 * 8] * il, acc[d8 * 8 + 1] * il); w.y = pk2(acc[d8 * 8 + 2] * il, acc[d8 * 8 + 3] * il); w.z = pk2(acc[d8 * 8 + 4] * il, acc[d8 * 8 + 5] * il); w.w = pk2(acc[d8 * 8 + 6] * il, acc[d8 * 8 + 7] * il);
            *(u32x4*)(O + (size_t)r * 512 + h * 64 + sub * 16 + d8 * 8) = w; }
    }
}

__device__ __forceinline__ void ph_hypre(const Ctx& cx, int layer) {
    CParams& p = get_params();
    const int gt = cx.bid * NTHREADS + cx.tid, NGT = cx.nb * NTHREADS;
    const bf16* Z = (const bf16*)(p.ws + WS_Z); const float* sw = p.in[I_HSW] + layer * 3 * 1536; const float* sb = p.in[I_HSB] + layer * 1536;
    const int nrows = layer == 0 ? TA : TL;
    for (int it = gt; it < nrows * 512; it += NGT) {
        const int r = it >> 9, c = it & 511;
        int t, L; if (r < TL) { t = r & 4095; L = SEQ; } else { t = (r - TL) & 255; L = CTXL; }
        float o[3];
#pragma unroll
        for (int q = 0; q < 3; ++q) { const int col = q * 512 + c; float a = sb[col] + sw[1536 + col] * bf2f(Z[(size_t)r * 1536 + col]);
            if (t > 0) a += sw[col] * bf2f(Z[(size_t)(r - 1) * 1536 + col]);
            if (t < L - 1) a += sw[2 * 1536 + col] * bf2f(Z[(size_t)(r + 1) * 1536 + col]);
            o[q] = a; }
        ((bf16*)(p.ws + WS_X0C))[(size_t)r * 512 + c] = f2bf(o[0]);
        const int b = row_b(r);
        if (r < TL) ((float*)(p.ws + WS_VV))[((size_t)b * 512 + c) * SEQ + t] = o[2] * o[1];
        else ((float*)(p.ws + WS_VVC))[((size_t)b * 512 + c) * CTXL + t] = o[2] * o[1];
    }
}

__device__ __forceinline__ void ph_hyconv(const Ctx& cx, int layer, float* sm) {
    CParams& p = get_params();
    const int tid = cx.tid;
    const int nitems = 2048 + (layer == 0 ? 2048 : 0);
    float* Tl = sm;
    for (int it = cx.bid; it < nitems; it += cx.nb) {
        const int st = it >= 2048, bc = it & 2047, b = bc >> 9, c = bc & 511, L = st ? CTXL : SEQ;
        float* Vl = sm + 2 * L;
        const float* fb = (const float*)(p.ws + WS_FILT + (st ? FILT_CTX_OFF : 0));
        const float* hf = fb + (size_t)c * L; const float* hb = fb + ((size_t)512 + c) * L;
        const float* vv = st ? (const float*)(p.ws + WS_VVC) + (size_t)bc * CTXL : (const float*)(p.ws + WS_VV) + (size_t)bc * SEQ;
        __syncthreads();
        for (int i = tid; i < L; i += NTHREADS) { Tl[L - 1 + i] = hf[i]; if (i > 0) Tl[L - 1 - i] = hb[i]; Vl[i] = vv[i]; }
        __syncthreads();
        const float bias = p.in[I_HBIAS][layer * 512 + c];
        const int rbase = st ? TL + b * CTXL : b * SEQ;
        for (int t0 = 0; t0 < L; t0 += NTHREADS * 8) {
            float a[8];
#pragma unroll
            for (int j = 0; j < 8; ++j) a[j] = 0.f;
            if (t0 + tid < L) {
                for (int s = 0; s < L; ++s) { const float v = Vl[s]; const float* tp = Tl + (t0 + tid - s + L - 1);
#pragma unroll
                    for (int j = 0; j < 8; ++j) if (t0 + tid + j * NTHREADS < L) a[j] += v * tp[j * NTHREADS]; }
#pragma unroll
                for (int j = 0; j < 8; ++j) { const int t = t0 + tid + j * NTHREADS; if (t < L) { const size_t o = (size_t)(rbase + t) * 512 + c;
                    ((bf16*)(p.ws + WS_HY))[o] = f2bf((a[j] + Vl[t] * bias) * bf2f(((const bf16*)(p.ws + WS_X0C))[o])); } }
            }
        }
    }
}

__device__ __forceinline__ void ph_s5scan(const Ctx& cx, int layer) {
    CParams& p = get_params();
    const int lane = cx.tid & 63, wave = cx.tid >> 6;
    const int gw = cx.bid * NWAVES + wave, NGW = cx.nb * NWAVES;
    const bf16* U = (const bf16*)(p.ws + WS_U); float* Y = (float*)(p.ws + WS_S5TMP);
    for (int it = gw; it < 128; it += NGW) {
        const int b = it >> 5, g = it & 31;
        for (int dir = 0; dir < 2; ++dir) {
            const int pi = ((layer * 2 + dir) * 32 + g) * 64 + lane;
            const float ar = ((const float*)(p.ws + WS_S5A))[pi * 2], ai = ((const float*)(p.ws + WS_S5A))[pi * 2 + 1];
            float br[16], bi[16], cr[16], ci[16];
#pragma unroll
            for (int h = 0; h < 16; ++h) { br[h] = ((const float*)(p.ws + WS_S5B))[((size_t)pi * 16 + h) * 2]; bi[h] = ((const float*)(p.ws + WS_S5B))[((size_t)pi * 16 + h) * 2 + 1];
                const size_t cidx = ((size_t)((layer * 2 + dir) * 32 + g) * 16 + h) * 64 + lane; cr[h] = p.in[I_SCRE][cidx]; ci[h] = p.in[I_SCIM][cidx]; }
            float hr = 0.f, hi = 0.f;
            for (int step = 0; step < CTXL + SEQ; ++step) {
                int r;
                if (dir == 0) r = step < CTXL ? TL + b * CTXL + step : b * SEQ + (step - CTXL);
                else r = step < CTXL ? TL + b * CTXL + (CTXL - 1 - step) : b * SEQ + (SEQ - 1 - (step - CTXL));
                const u32x4 w0 = *(const u32x4*)(U + (size_t)r * 512 + g * 16), w1 = *(const u32x4*)(U + (size_t)r * 512 + g * 16 + 8);
                float u[16];
                u[0] = __uint_as_float(w0.x << 16); u[1] = __uint_as_float(w0.x & 0xffff0000u); u[2] = __uint_as_float(w0.y << 16); u[3] = __uint_as_float(w0.y & 0xffff0000u);
                u[4] = __uint_as_float(w0.z << 16); u[5] = __uint_as_float(w0.z & 0xffff0000u); u[6] = __uint_as_float(w0.w << 16); u[7] = __uint_as_float(w0.w & 0xffff0000u);
                u[8] = __uint_as_float(w1.x << 16); u[9] = __uint_as_float(w1.x & 0xffff0000u); u[10] = __uint_as_float(w1.y << 16); u[11] = __uint_as_float(w1.y & 0xffff0000u);
                u[12] = __uint_as_float(w1.z << 16); u[13] = __uint_as_float(w1.z & 0xffff0000u); u[14] = __uint_as_float(w1.w << 16); u[15] = __uint_as_float(w1.w & 0xffff0000u);
                float dr = 0.f, di = 0.f;
#pragma unroll
                for (int h = 0; h < 16; ++h) { dr += br[h] * u[h]; di += bi[h] * u[h]; }
                const float nr = ar * hr - ai * hi + dr, ni = ar * hi + ai * hr + di; hr = nr; hi = ni;
                if (layer == 0 || r < TL) {
                    float mine = 0.f;
#pragma unroll
                    for (int o = 0; o < 16; ++o) { const float v = wave_sum(cr[o] * hr - ci[o] * hi); if (lane == o) mine = v; }
                    if (lane < 16) { float* yp = Y + (size_t)r * 512 + g * 16 + lane; if (dir == 0) *yp = mine; else *yp += mine; }
                }
            }
        }
    }
}
__device__ __forceinline__ void ph_s5read(const Ctx& cx, int layer) {
    CParams& p = get_params();
    const int gt = cx.bid * NTHREADS + cx.tid, NGT = cx.nb * NTHREADS;
    const int nrows = layer == 0 ? TA : TL;
    for (int i = gt; i < nrows * 512; i += NGT) { const int c = i & 511;
        const float y = ((const float*)(p.ws + WS_S5TMP))[i] + p.in[I_SD][layer * 512 + c] * bf2f(((const bf16*)(p.ws + WS_U))[i]);
        ((bf16*)(p.ws + WS_S5Y))[i] = f2bf(gelu_tanh(y)); }
}

__device__ __forceinline__ void ph_glu(const Ctx& cx, int layer, PG8_LAS unsigned char* lds) {
    CParams& p = get_params();
    pg8::Gemm g; g.A = (const bf16*)(p.ws + WS_S5Y); g.Bt = (const bf16*)(p.ws + WT_GLU) + (size_t)layer * 512 * 512; g.zsA = 0; g.zsB = 0; g.K = 512;
    pg8::TileOrder S; S.nM = TL / 256; S.nN = 2; S.nwg = S.nM * S.nN; S.G = cx.nb; S.c = cx.bid; S.nz = 1; S.exN = 2; S.expn0 = 0; S.extra = layer == 0 ? 4 * 2 : 0;
    EpiGlu E; E.ws = p.ws; E.bias = p.in[I_GLUB] + layer * 512;
    pg8::gemm_phase<EpiGlu, pg8::TileOrder>(lds, g, S, E, cx.tid);
}
__device__ __forceinline__ void ph_merge(const Ctx& cx, int layer, PG8_LAS unsigned char* lds) {
    CParams& p = get_params();
    pg8::Gemm g; g.A = (const bf16*)(p.ws + WS_ATT); g.zsA = (WS_HY - WS_ATT) / 2;
    g.Bt = (const bf16*)(p.ws + WT_BR) + (size_t)(layer * 3 + 0) * 1024 * 512; g.zsB = 1024 * 512; g.K = 512;
    pg8::TileOrder S; S.nM = TL / 256; S.nN = 4; S.nwg = S.nM * S.nN; S.G = cx.nb; S.c = cx.bid; S.nz = 3; S.exN = 4; S.expn0 = 0; S.extra = layer == 0 ? 4 * 4 : 0;
    EpiMerge E; E.ws = p.ws;
    pg8::gemm_phase<EpiMerge, pg8::TileOrder>(lds, g, S, E, cx.tid);
}
__device__ __forceinline__ void ph_outproj(const Ctx& cx, int layer, PG8_LAS unsigned char* lds) {
    CParams& p = get_params();
    pg8::Gemm g; g.A = (const bf16*)(p.ws + WS_M); g.Bt = (const bf16*)(p.ws + WT_OUT) + (size_t)layer * 1024 * 1024; g.zsA = 0; g.zsB = 0; g.K = 1024;
    pg8::TileOrder S; S.nM = TL / 256; S.nN = 4; S.nwg = S.nM * S.nN; S.G = cx.nb; S.c = cx.bid; S.nz = 1; S.exN = 4; S.expn0 = 0; S.extra = layer == 0 ? 4 * 4 : 0;
    EpiOut E; E.ws = p.ws; E.layer = layer;
    pg8::gemm_phase<EpiOut, pg8::TileOrder>(lds, g, S, E, cx.tid);
}
__device__ __forceinline__ void ph_qp(const Ctx& cx, int layer, PG8_LAS unsigned char* lds) {
    CParams& p = get_params();
    pg8::Gemm g; g.A = (const bf16*)(p.ws + WS_H); g.Bt = (const bf16*)(p.ws + WT_WQ) + (size_t)layer * 2048 * 1024; g.zsA = 0; g.zsB = 0; g.K = 1024;
    pg8::TileOrder S; S.nM = TL / 256; S.nN = 8; S.nwg = S.nM * S.nN; S.G = cx.nb; S.c = cx.bid; S.nz = 1; S.exN = 8; S.expn0 = 0; S.extra = layer == 0 ? 4 * 8 : 0;
    EpiQp E; E.ws = p.ws;
    pg8::gemm_phase<EpiQp, pg8::TileOrder>(lds, g, S, E, cx.tid);
}

__device__ __forceinline__ void wave_argmax(float& v, int& i) {
#pragma unroll
    for (int o = 32; o > 0; o >>= 1) { const float ov = __shfl_xor(v, o); const int oi = __shfl_xor(i, o); if (ov > v || (ov == v && oi < i)) { v = ov; i = oi; } }
}
__device__ __forceinline__ void ph_select(const Ctx& cx, int layer) {
    CParams& p = get_params();
    const int lane = cx.tid & 63, wave = cx.tid >> 6;
    const int gw = cx.bid * NWAVES + wave, NGW = cx.nb * NWAVES;
    const int nrows = layer == 0 ? TA : TL;
    const bf16* QP = (const bf16*)(p.ws + WS_QP);
    for (int it = gw; it < nrows * 8; it += NGW) {
        const int r = it >> 3, h = it & 7;
        float tv[2]; int ti[2]; tv[0] = tv[1] = 0.f; ti[0] = ti[1] = 0;
#pragma unroll
        for (int s = 0; s < 2; ++s) {
            const unsigned qw = *(const unsigned*)(QP + (size_t)r * 2048 + (h * 2 + s) * 128 + lane * 2);
            const float q0 = __uint_as_float(qw << 16), q1 = __uint_as_float(qw & 0xffff0000u);
            const float* k0 = p.in[I_PKEYS] + ((((size_t)layer * 8 + h) * 2 + s) * 128 + lane) * 128; const float* k1 = k0 + 64 * 128;
            float s0 = 0.f, s1 = 0.f;
            for (int k4 = 0; k4 < 32; ++k4) { const f32x4 a = *(const f32x4*)(k0 + k4 * 4), bb = *(const f32x4*)(k1 + k4 * 4);
                const float qa = __shfl(q0, 2 * k4), qb = __shfl(q1, 2 * k4), qc = __shfl(q0, 2 * k4 + 1), qd = __shfl(q1, 2 * k4 + 1);
                s0 += qa * a.x + qb * a.y + qc * a.z + qd * a.w; s1 += qa * bb.x + qb * bb.y + qc * bb.z + qd * bb.w; }
            for (int j = 0; j < 16; ++j) {
                float bv; int bi; if (s0 >= s1) { bv = s0; bi = lane; } else { bv = s1; bi = lane + 64; }
                wave_argmax(bv, bi);
                if (lane == j) { tv[s] = bv; ti[s] = bi; }
                if (bi == lane) s0 = -INFINITY; else if (bi == lane + 64) s1 = -INFINITY;
            }
        }
        float cv[4]; const float va = __shfl(tv[0], lane >> 2);
#pragma unroll
        for (int q = 0; q < 4; ++q) cv[q] = va + __shfl(tv[1], (lane & 3) * 4 + q);
        float bestv = 0.f; int bestc = 0;
        for (int j = 0; j < 16; ++j) {
            float bv = cv[0]; int bi = lane * 4;
#pragma unroll
            for (int q = 1; q < 4; ++q) if (cv[q] > bv) { bv = cv[q]; bi = lane * 4 + q; }
            wave_argmax(bv, bi);
            if (lane == j) { bestv = bv; bestc = bi; }
            if ((bi >> 2) == lane) {
#pragma unroll
                for (int q = 0; q < 4; ++q) if ((bi & 3) == q) cv[q] = -INFINITY; }
        }
        const int ia = __shfl(ti[0], bestc >> 4), ib = __shfl(ti[1], bestc & 15);
        const float mx = __shfl(bestv, 0);
        const float e = lane < 16 ? __expf(bestv - mx) : 0.f;
        const float sum = wave_sum(e);
        if (lane < 16) { ((int*)(p.ws + WS_EID))[(size_t)r * 128 + h * 16 + lane] = ia * 128 + ib; ((float*)(p.ws + WS_EG))[(size_t)r * 128 + h * 16 + lane] = e / sum; }
    }
}
__device__ __forceinline__ void ph_gather(const Ctx& cx, int layer) {
    CParams& p = get_params();
    const int lane = cx.tid & 63, wave = cx.tid >> 6;
    const int gw = cx.bid * NWAVES + wave, NGW = cx.nb * NWAVES;
    const int nrows = layer == 0 ? TA : TL;
    const float* PU = p.in[I_PU] + (size_t)layer * 16384 * 1024; const float* PV = p.in[I_PV] + (size_t)layer * 16384 * 1024;
    float* X = (float*)(p.ws + WS_XCUR);
    for (int r = gw; r < nrows; r += NGW) {
        f32x4 x[4], o[4];
#pragma unroll
        for (int j = 0; j < 4; ++j) { const u32x2 w = *(const u32x2*)((const bf16*)(p.ws + WS_H) + (size_t)r * 1024 + j * 256 + lane * 4);
            x[j] = (f32x4){__uint_as_float(w.x << 16), __uint_as_float(w.x & 0xffff0000u), __uint_as_float(w.y << 16), __uint_as_float(w.y & 0xffff0000u)}; o[j] = (f32x4){0.f, 0.f, 0.f, 0.f}; }
        for (int hk = 0; hk < 128; ++hk) {
            const int e = ((const int*)(p.ws + WS_EID))[(size_t)r * 128 + hk]; const float g = ((const float*)(p.ws + WS_EG))[(size_t)r * 128 + hk];
            const float* ur = PU + (size_t)e * 1024 + lane * 4; const float* vr = PV + (size_t)e * 1024 + lane * 4;
            float d = 0.f;
#pragma unroll
            for (int j = 0; j < 4; ++j) { const f32x4 uu = *(const f32x4*)(ur + j * 256); d += x[j].x * uu.x + x[j].y * uu.y + x[j].z * uu.z + x[j].w * uu.w; }
            d = wave_sum(d);
            const float w = g * gelu_tanh(d);
#pragma unroll
            for (int j = 0; j < 4; ++j) { const f32x4 vvv = *(const f32x4*)(vr + j * 256); o[j] += w * vvv; }
        }
        const float* g2 = (const float*)(p.ws + WS_MODV) + ((size_t)layer * 5 + row_mi(r)) * 6144 + 5120;
        float ss = 0.f;
#pragma unroll
        for (int j = 0; j < 4; ++j) { const int c = j * 256 + lane * 4; f32x4 xv = *(const f32x4*)(X + (size_t)r * 1024 + c); xv += *(const f32x4*)(g2 + c) * o[j]; *(f32x4*)(X + (size_t)r * 1024 + c) = xv; o[j] = xv;
            ss += xv.x * xv.x + xv.y * xv.y + xv.z * xv.z + xv.w * xv.w; }
        if (layer == DEPTH - 1) {
            const float rs = rsqrtf(wave_sum(ss) * (1.f / DM) + NORM_EPS);
#pragma unroll
            for (int j = 0; j < 4; ++j) { const int c = j * 256 + lane * 4; *(f32x4*)(p.out + (size_t)r * 1024 + c) = o[j] * rs * *(const f32x4*)(p.in[I_FG] + c); }
        }
    }
}

constexpr int NPL = 11, NPHASE = 1 + DEPTH * NPL;
#ifndef ONLY
#define ONLY -1
#endif
#ifndef NOT
#define NOT -1
#endif
#define ON(n) ((ONLY < 0 || ONLY == (n)) && NOT != (n))
#define MKCX() Ctx cx; cx.tid = threadIdx.x; cx.bid = blockIdx.x; cx.nb = gridDim.x; asm volatile("" : "+v"(cx.tid), "+s"(cx.bid), "+s"(cx.nb))
#define IN(k) (lo <= (k) && (k) < hi)
#define SEAM(k) do { if (IN(k) && IN((k) + 1)) { XcdBarrier bar_; bar_.bar = (unsigned*)(get_params().ws + WS_CTL) + 4096; bar_.x = xb_xcc_id(); bar_.st = st; xcd_barrier(bar_); } } while (0)
template <int LAYER> __device__ __forceinline__ void layer_program(const int lo, const int hi, float* sm, PG8_LAS unsigned char* lds, volatile LAS unsigned* st) {
    constexpr int B = 1 + LAYER * NPL;
    if (IN(B + 0)) { MKCX(); if (ON(0)) { ph_norm(cx, LAYER, 0, 0); ph_filters(cx, LAYER); } } SEAM(B + 0);
    if (IN(B + 1)) { MKCX(); if (ON(1)) ph_inproj(cx, LAYER, lds); } SEAM(B + 1);
    if (IN(B + 2)) { { MKCX(); if (ON(2)) ph_attn(cx, LAYER); } { MKCX(); if (ON(20)) ph_hypre(cx, LAYER); } { MKCX(); if (ON(21)) ph_s5scan(cx, LAYER); } } SEAM(B + 2);
    if (IN(B + 3)) { { MKCX(); if (ON(3)) ph_hyconv(cx, LAYER, sm); } { MKCX(); if (ON(30)) ph_s5read(cx, LAYER); } } SEAM(B + 3);
    if (IN(B + 4)) { MKCX(); if (ON(4)) ph_glu(cx, LAYER, lds); } SEAM(B + 4);
    if (IN(B + 5)) { MKCX(); if (ON(5)) ph_merge(cx, LAYER, lds); } SEAM(B + 5);
    if (IN(B + 6)) { MKCX(); if (ON(6)) ph_outproj(cx, LAYER, lds); } SEAM(B + 6);
    if (IN(B + 7)) { MKCX(); if (ON(7)) ph_norm(cx, LAYER, 1, LAYER == DEPTH - 1); } SEAM(B + 7);
    if (IN(B + 8)) { MKCX(); if (ON(8)) ph_qp(cx, LAYER, lds); } SEAM(B + 8);
    if (IN(B + 9)) { MKCX(); if (ON(9)) ph_select(cx, LAYER); } SEAM(B + 9);
    if (IN(B + 10)) { MKCX(); if (ON(10)) ph_gather(cx, LAYER); } SEAM(B + 10);
}
__global__ void __launch_bounds__(NTHREADS, 2) mk_fwd(Params p) {
    extern __shared__ __attribute__((aligned(16))) unsigned char lds_raw[];
    float* sm = (float*)lds_raw; PG8_LAS unsigned char* lds = (PG8_LAS unsigned char*)lds_raw;
    volatile LAS unsigned* st = (volatile LAS unsigned*)(lds + LDS_MISC);
    if (threadIdx.x < 4) st[threadIdx.x] = 0u;
    __syncthreads();
    const int lo = p.ph_lo, hi = p.ph_hi;
    if (hi - lo > 1) (void)xcd_barrier_post((unsigned*)(p.ws + WS_CTL) + 4096, st);
    if (IN(0)) { { MKCX(); if (ON(100)) ph_prologue(cx, sm); } { MKCX(); if (ON(101)) ph_convert(cx); } } SEAM(0);
    layer_program<0>(lo, hi, sm, lds, st);
    layer_program<1>(lo, hi, sm, lds, st);
}
}

extern "C" void kernel_launch(void* const* d_in, const int* in_sizes, int n_in, void* d_out, int out_size, void* d_ws, size_t ws_size, hipStream_t stream) {
    static int grid = 0;
    if (grid == 0) {
        if (n_in != 40 || out_size != TL * DM || ws_size < WS_END) { fprintf(stderr, "kernel_launch: unexpected shapes (n_in %d out %d ws %zu)\n", n_in, out_size, ws_size); grid = -1; return; }
        int dev = 0, cus = 0;
        if (hipGetDevice(&dev) != hipSuccess || hipDeviceGetAttribute(&cus, hipDeviceAttributeMultiprocessorCount, dev) != hipSuccess) { grid = -1; return; }
        if (hipFuncSetAttribute((const void*)mk_fwd, hipFuncAttributeMaxDynamicSharedMemorySize, LDS_BYTES) != hipSuccess) { fprintf(stderr, "kernel_launch: hipFuncSetAttribute failed\n"); grid = -1; return; }
        grid = cus;
    }
    if (grid < 0) return;
    (void)hipMemsetAsync((char*)d_ws + WS_CTL, 0, 1 * MiB, stream);
    Params a{};
    for (int i = 0; i < 40; ++i) a.in[i] = (const float*)d_in[i];
    a.out = (float*)d_out; a.ws = (unsigned char*)d_ws;
#if PER_PHASE_LAUNCH
    for (int ph = 0; ph < NPHASE; ++ph) { a.ph_lo = ph; a.ph_hi = ph + 1; hipLaunchKernelGGL(mk_fwd, dim3(grid), dim3(NTHREADS), LDS_BYTES, stream, a); }
#else
    a.ph_lo = 0; a.ph_hi = NPHASE; hipLaunchKernelGGL(mk_fwd, dim3(grid), dim3(NTHREADS), LDS_BYTES, stream, a);
#endif
}
```

```cpp
#include <hip/hip_runtime.h>
#include <stdint.h>
#include <math.h>
#include <stdio.h>

#ifndef PER_PHASE_LAUNCH
#define PER_PHASE_LAUNCH 0
#endif

namespace {
typedef unsigned short bf16;
typedef float f32x4 __attribute__((ext_vector_type(4)));
typedef unsigned u32x2 __attribute__((ext_vector_type(2)));
typedef unsigned u32x4 __attribute__((ext_vector_type(4)));
#define LAS __attribute__((address_space(3)))

constexpr int DM = 1024, NBATCH = 4, SEQ = 4096, CTXL = 256, DEPTH = 2;
constexpr int TL = NBATCH * SEQ, TC = NBATCH * CTXL, TA = TL + TC;
constexpr int INW = 5888, COL_K = 512, COL_V = 640, COL_S5 = 768, COL_HY = 1280, COL_GATE = 2816;
constexpr int NTHREADS = 512, NWAVES = 8;
constexpr float NORM_EPS = 1e-6f;
constexpr float HY_FAST = 15.350567286626973f, HY_SLOW = 3.0701134573253945f;

constexpr size_t MiB = 1u << 20;
constexpr size_t WS_CTL = 0;
constexpr size_t WS_XCUR = 1 * MiB;
constexpr size_t WS_MODV = 69 * MiB;
constexpr size_t WS_ROPE = WS_MODV + 512 * 1024;
constexpr size_t WS_S5A = 70 * MiB;
constexpr size_t WS_S5B = 70 * MiB + 256 * 1024;
constexpr size_t WS_FILT = 72 * MiB;
constexpr size_t FILT_CTX_OFF = 16 * MiB;
constexpr size_t WS_WTS = 89 * MiB;
constexpr size_t WT_IN = WS_WTS;
constexpr size_t WT_GLU = WT_IN + 23 * MiB;
constexpr size_t WT_BR = WT_GLU + 1 * MiB;
constexpr size_t WT_OUT = WT_BR + 6 * MiB;
constexpr size_t WT_WQ = WT_OUT + 4 * MiB;
constexpr size_t WT_KEYS = WT_WQ + 8 * MiB;
constexpr size_t WS_H = 132 * MiB;
constexpr size_t WS_VV = WS_H;
constexpr size_t WS_VVC = WS_H + 32 * MiB;
constexpr size_t WS_Q = 166 * MiB;
constexpr size_t WS_K = 183 * MiB;
constexpr size_t WS_V = WS_K + (size_t)TA * 128 * 2;
constexpr size_t WS_U = WS_V + (size_t)TA * 128 * 2;
constexpr size_t WS_Z = WS_U + (size_t)TA * 512 * 2;
constexpr size_t WS_QP = WS_Q;
constexpr size_t WS_G = 260 * MiB;
constexpr size_t WS_ATT = 362 * MiB;
constexpr size_t WS_HY = WS_ATT + 17 * MiB, WS_S5O = WS_HY + 17 * MiB, WS_S5Y = WS_S5O + 17 * MiB;
constexpr size_t WS_M = 430 * MiB;
constexpr size_t WS_S5TMP = WS_M;
constexpr size_t WS_S5E = WS_M;
constexpr size_t WS_S5P = WS_M + 16 * MiB;
constexpr size_t WS_S5K = WS_M + 32 * MiB;
constexpr size_t WS_S5A64 = WS_S5A + 64 * 1024;
constexpr size_t WS_X0C = 464 * MiB;
constexpr size_t WS_EID = 481 * MiB;
constexpr size_t WS_EG = WS_EID + (size_t)TA * 128 * 4;
constexpr size_t WS_HIN = WS_EID;
constexpr size_t WS_END = 498 * MiB;
constexpr int LDS_STAGE = 131072;
constexpr int LDS_MISC = LDS_STAGE;
constexpr int LDS_BYTES = 147456;

struct Params {
    const float* in[40];
    float* out;
    unsigned char* ws;
    int ph_lo, ph_hi;
};
enum { I_X = 0, I_C, I_CTX, I_CCTX, I_MODW, I_MODB, I_N1G, I_N2G, I_INW, I_GATEB, I_SINK, I_HSW, I_HSB, I_HW1, I_HB1, I_HF1, I_HW2, I_HB2, I_HF2, I_HW3,
       I_HBIAS, I_SARE, I_SAIM, I_SLDT, I_SBRE, I_SBIM, I_SCRE, I_SCIM, I_SD, I_GLUW, I_GLUB, I_BRA, I_BRH, I_BRS, I_OUTW, I_WQ, I_PKEYS, I_PU, I_PV, I_FG };

struct Ctx { int tid, bid, nb; };
typedef __attribute__((address_space(4))) const Params CParams;
__device__ __forceinline__ CParams& get_params() { CParams* q = (CParams*)__builtin_amdgcn_kernarg_segment_ptr(); asm volatile("" : "+s"(q)); return *q; }
__device__ __forceinline__ float bf2f(bf16 v) { return __uint_as_float((unsigned)v << 16); }
__device__ __forceinline__ bf16 f2bf(float f) { unsigned u = __float_as_uint(f); return (bf16)((u + 0x7fffu + ((u >> 16) & 1u)) >> 16); }
__device__ __forceinline__ unsigned pk2(float lo, float hi) { return (unsigned)f2bf(lo) | ((unsigned)f2bf(hi) << 16); }
__device__ __forceinline__ float wave_sum(float v) {
#pragma unroll
    for (int o = 32; o > 0; o >>= 1) v += __shfl_xor(v, o);
    return v;
}
__device__ __forceinline__ float fsin_rev(float rev) { return __builtin_amdgcn_sinf(rev); }
__device__ __forceinline__ float fcos_rev(float rev) { return __builtin_amdgcn_cosf(rev); }
__device__ __forceinline__ float fsin(float x) { return __builtin_amdgcn_sinf(x * 0.15915494309189535f); }
__device__ __forceinline__ float fcos(float x) { return __builtin_amdgcn_cosf(x * 0.15915494309189535f); }
__device__ __forceinline__ float sigmoidf_(float x) { return 1.f / (1.f + __expf(-x)); }
__device__ __forceinline__ float gelu_tanh(float x) { const float u = 0.7978845608028654f * (x + 0.044715f * x * x * x); const float e = __expf(2.f * u); return 0.5f * x * (2.f - 2.f / (e + 1.f)); }
__device__ __forceinline__ int row_mi(int r) { return r < TL ? (r >> 12) : 4; }
__device__ __forceinline__ int row_b(int r) { return r < TL ? (r >> 12) : ((r - TL) >> 8); }

#define XB_TMO      128
#define XB_XCNT(j)  (256  + 64 * (j))
#define XB_XSUB(j)  (1280 + 64 * (j))
#define XB_XGEN(j)  (2304 + 64 * (j))
#define XB_TOP      3328
#define XB_TOPGEN   3392
#define XCD_BAR_WORDS 3456
#define XB_SPIN_CAP (1u << 27)
__device__ __forceinline__ unsigned xb_ld(unsigned* p)              { return __hip_atomic_load(p, __ATOMIC_RELAXED, __HIP_MEMORY_SCOPE_AGENT); }
__device__ __forceinline__ unsigned xb_add(unsigned* p, unsigned v) { return __hip_atomic_fetch_add(p, v, __ATOMIC_RELAXED, __HIP_MEMORY_SCOPE_AGENT); }
__device__ __forceinline__ unsigned xb_xcc_id() { return (unsigned)__builtin_amdgcn_s_getreg((3 << 11) | 20) & 0xFu; }
#define XB_SPIN(cond, bar) do { unsigned _sp = 0; while (cond) { __builtin_amdgcn_s_sleep(1); \
    if ((++_sp & 255u) == 0u) { if (xb_ld(&(bar)[XB_TMO])) break; if (_sp > XB_SPIN_CAP) { atomicAdd(&(bar)[XB_TMO], 1u); break; } } } } while (0)
struct XcdBarrier { unsigned* bar; unsigned x; volatile LAS unsigned* st; };
__device__ __forceinline__ XcdBarrier xcd_barrier_post(unsigned* bar, volatile LAS unsigned* st) {
    XcdBarrier b; b.bar = bar; b.x = xb_xcc_id(); b.st = st;
    if (threadIdx.x == 0) (void)xb_add(&bar[XB_XCNT(b.x)], 1u);
    return b;
}
__device__ __forceinline__ void xcd_barrier_complete(unsigned* bar, unsigned x, unsigned& nloc, unsigned& nx) {
    const unsigned G = gridDim.x * gridDim.y * gridDim.z;
    unsigned sum, cnt, mine, sp = 0u;
    for (;;) {
        sum = 0u; cnt = 0u; mine = 0u;
#pragma unroll
        for (unsigned j = 0; j < 16; ++j) { const unsigned c = xb_ld(&bar[XB_XCNT(j)]); sum += c; cnt += (c > 0u) ? 1u : 0u; mine = (j == x) ? c : mine; }
        if (sum == G) break;
        __builtin_amdgcn_s_sleep(1);
        if ((++sp & 255u) == 0u) { if (xb_ld(&bar[XB_TMO])) break; if (sp > XB_SPIN_CAP) { atomicAdd(&bar[XB_TMO], 1u); break; } }
    }
    nloc = mine > 0u ? mine : 1u; nx = cnt > 0u ? cnt : 1u;
}
__device__ __forceinline__ void xcd_barrier(const XcdBarrier& b) {
    asm volatile("s_waitcnt vmcnt(0)" ::: "memory");
    __syncthreads();
    if (threadIdx.x == 0) {
        unsigned* bar = b.bar; asm volatile("" : "+s"(bar));
        __builtin_amdgcn_s_waitcnt(0);
        unsigned nloc = b.st[0], nx = b.st[1];
        if (nloc == 0u) { xcd_barrier_complete(bar, b.x, nloc, nx); b.st[0] = nloc; b.st[1] = nx; }
        const unsigned old = xb_add(&bar[XB_XSUB(b.x)], 1u);
        const unsigned gen = old / nloc;
        if (old + 1u == (gen + 1u) * nloc) {
            __builtin_amdgcn_fence(__ATOMIC_RELEASE, "agent");
            asm volatile("s_waitcnt vmcnt(0)" ::: "memory");
            const unsigned og = xb_add(&bar[XB_TOP], 1u);
            const unsigned tg = og / nx;
            if (og + 1u == (tg + 1u) * nx) xb_add(&bar[XB_TOPGEN], 1u);
            else XB_SPIN(xb_ld(&bar[XB_TOPGEN]) == tg, bar);
            __builtin_amdgcn_fence(__ATOMIC_ACQUIRE, "agent");
            xb_add(&bar[XB_XGEN(b.x)], 1u);
            asm volatile("s_waitcnt vmcnt(0)" ::: "memory");
        } else {
            XB_SPIN(xb_ld(&bar[XB_XGEN(b.x)]) == gen, bar);
            __builtin_amdgcn_fence(__ATOMIC_ACQUIRE, "agent");
            asm volatile("s_waitcnt vmcnt(0)" ::: "memory");
        }
    }
    __syncthreads();
}

__device__ __forceinline__ void ph_prologue(const Ctx& cx0, float* sm) {
    { CParams& p = get_params(); Ctx cx = cx0;
    const int tid = cx.tid, lane = tid & 63, wave = tid >> 6;
    const int gt = cx.bid * NTHREADS + tid, NGT = cx.nb * NTHREADS;
    const int gw = cx.bid * NWAVES + wave, NGW = cx.nb * NWAVES;
    unsigned char* ws = p.ws;
    {
        f32x4* dst = (f32x4*)(ws + WS_XCUR);
        const f32x4* sx = (const f32x4*)p.in[I_X]; const f32x4* sc = (const f32x4*)p.in[I_CTX];
        for (int i = gt; i < TL * DM / 4; i += NGT) dst[i] = sx[i];
        for (int i = gt; i < TC * DM / 4; i += NGT) dst[TL * DM / 4 + i] = sc[i];
    }
    }
    { CParams& p = get_params(); Ctx cx; cx.tid = threadIdx.x; cx.bid = blockIdx.x; cx.nb = gridDim.x; asm volatile("" : "+v"(cx.tid), "+s"(cx.bid), "+s"(cx.nb));
      const int tid = cx.tid, lane = tid & 63, wave = tid >> 6; const int gt = cx.bid * NTHREADS + tid, NGT = cx.nb * NTHREADS; const int gw = cx.bid * NWAVES + wave, NGW = cx.nb * NWAVES; unsigned char* ws = p.ws; (void)lane; (void)gt; (void)NGT; (void)gw; (void)NGW; (void)ws;
    {
        float* sil = sm;
        float* red = sm + 5 * 1024;
        bool have = false;
        for (int it = cx.bid; it < 192; it += cx.nb) {
            if (!have) {
                for (int i = tid; i < 5 * 1024; i += NTHREADS) { const float v = i < 4096 ? p.in[I_C][i] : p.in[I_CCTX][i - 4096]; sil[i] = v / (1.f + __expf(-v)); }
                have = true; __syncthreads();
            }
            const int layer = it / 96, col = (it % 96) * 64 + lane, kp = wave;
            const float* W = p.in[I_MODW] + (size_t)layer * DM * 6144 + col;
            float a0 = 0, a1 = 0, a2 = 0, a3 = 0, a4 = 0;
            for (int k = kp * 128; k < kp * 128 + 128; ++k) { const float w = W[(size_t)k * 6144]; a0 += sil[k] * w; a1 += sil[1024 + k] * w; a2 += sil[2048 + k] * w; a3 += sil[3072 + k] * w; a4 += sil[4096 + k] * w; }
            red[(kp * 5 + 0) * 64 + lane] = a0; red[(kp * 5 + 1) * 64 + lane] = a1; red[(kp * 5 + 2) * 64 + lane] = a2; red[(kp * 5 + 3) * 64 + lane] = a3; red[(kp * 5 + 4) * 64 + lane] = a4;
            __syncthreads();
            if (tid < 320) { const int j = tid >> 6; float s = 0; for (int q = 0; q < 8; ++q) s += red[(q * 5 + j) * 64 + lane];
                ((float*)(ws + WS_MODV))[((size_t)layer * 5 + j) * 6144 + col] = s + p.in[I_MODB][layer * 6144 + col]; }
            __syncthreads();
        }
    }
    }
    { CParams& p = get_params(); Ctx cx; cx.tid = threadIdx.x; cx.bid = blockIdx.x; cx.nb = gridDim.x; asm volatile("" : "+v"(cx.tid), "+s"(cx.bid), "+s"(cx.nb));
      const int tid = cx.tid, lane = tid & 63, wave = tid >> 6; const int gt = cx.bid * NTHREADS + tid, NGT = cx.nb * NTHREADS; const int gw = cx.bid * NWAVES + wave, NGW = cx.nb * NWAVES; unsigned char* ws = p.ws; (void)lane; (void)gt; (void)NGT; (void)gw; (void)NGW; (void)ws;
    for (int i = gt; i < 64 * 16; i += NGT) { const int pos = i >> 4, f = i & 15; const float ang = (float)pos * exp2f(-(float)f * (13.287712379549449f / 16.f));
        ((float*)(ws + WS_ROPE))[i * 2] = fcos(ang); ((float*)(ws + WS_ROPE))[i * 2 + 1] = fsin(ang); }
    }
    { CParams& p = get_params(); Ctx cx; cx.tid = threadIdx.x; cx.bid = blockIdx.x; cx.nb = gridDim.x; asm volatile("" : "+v"(cx.tid), "+s"(cx.bid), "+s"(cx.nb));
      const int tid = cx.tid, lane = tid & 63, wave = tid >> 6; const int gt = cx.bid * NTHREADS + tid, NGT = cx.nb * NTHREADS; const int gw = cx.bid * NWAVES + wave, NGW = cx.nb * NWAVES; unsigned char* ws = p.ws; (void)lane; (void)gt; (void)NGT; (void)gw; (void)NGW; (void)ws;
    for (int i = gt; i < 2 * 2 * 32 * 64; i += NGT) {
        const int g = (i >> 6) & 31, ld = i >> 11;
        const float are = fminf(p.in[I_SARE][i], -1e-4f), aim = p.in[I_SAIM][i];
        const float dt = __expf(p.in[I_SLDT][ld * 32 + g]);
        const float er = __expf(are * dt), abr = er * fcos(aim * dt), abi = er * fsin(aim * dt);
        const float nr = abr - 1.0f, ni = abi, den = are * are + aim * aim;
        const float cr = (nr * are + ni * aim) / den, ci = (ni * are - nr * aim) / den;
        ((float*)(ws + WS_S5A))[i * 2] = abr; ((float*)(ws + WS_S5A))[i * 2 + 1] = abi;
        for (int h = 0; h < 16; ++h) { const float br = p.in[I_SBRE][(size_t)i * 16 + h], bi = p.in[I_SBIM][(size_t)i * 16 + h];
            ((float*)(ws + WS_S5B))[((size_t)i * 16 + h) * 2] = cr * br - ci * bi; ((float*)(ws + WS_S5B))[((size_t)i * 16 + h) * 2 + 1] = cr * bi + ci * br; }
    }
    }
}


__device__ __forceinline__ void ph_filters(const Ctx& cx, int layer) {
    CParams& p = get_params();
    const int tid = cx.tid, lane = tid & 63, wave = tid >> 6; const int gw = cx.bid * NWAVES + wave, NGW = cx.nb * NWAVES; unsigned char* ws = p.ws;
    for (int it = gw; it < (SEQ + CTXL); it += NGW) {
        const int r = it, st = r >= SEQ ? 1 : 0, t = st ? r - SEQ : r, L = st ? CTXL : SEQ;
        const float tn = (float)t / (float)L;
        float z = 0.f;
        if (lane == 0) z = tn;
        else if (lane <= 16) z = fcos_rev(tn * (float)lane);
        else if (lane <= 32) z = fsin_rev(tn * (float)(lane - 16));
        const float* w1 = p.in[I_HW1] + layer * 33 * 64; const float* w2 = p.in[I_HW2] + layer * 64 * 64; const float* w3 = p.in[I_HW3] + layer * 64 * 1024;
        float a = p.in[I_HB1][layer * 64 + lane];
        for (int e = 0; e < 33; ++e) a += __shfl(z, e) * w1[e * 64 + lane];
        const float h1 = fsin(p.in[I_HF1][layer * 64 + lane] * a);
        float a2 = p.in[I_HB2][layer * 64 + lane];
        for (int j = 0; j < 64; ++j) a2 += __shfl(h1, j) * w2[j * 64 + lane];
        const float h2 = fsin(p.in[I_HF2][layer * 64 + lane] * a2);
        const float tw = (float)t / (float)(L - 1);
        float* fbase = (float*)(ws + WS_FILT + (st ? FILT_CTX_OFF : 0));
        for (int cc = 0; cc < 16; ++cc) {
            const int col = cc * 64 + lane; float f = 0.f;
            for (int j = 0; j < 64; ++j) f += __shfl(h2, j) * w3[j * 1024 + col];
            const int c = col & 511, isb = col >> 9;
            const float rate = HY_FAST + (HY_SLOW - HY_FAST) * ((float)c / 511.f);
            fbase[((size_t)isb * 512 + c) * L + t] = f * __expf(-tw * rate);
        }
    }
}
__device__ __forceinline__ void conv_T(const Ctx& cx, const float* W, int K, int N, bf16* dst, bool perm) {
    const int gt = cx.bid * NTHREADS + cx.tid, NGT = cx.nb * NTHREADS;
    for (int it = gt; it < N * (K / 8); it += NGT) {
        const int n = it % N, k0 = (it / N) * 8;
        const int sn = (perm && n < COL_V) ? ((n & ~63) + ((n & 63) >> 1) + 32 * (n & 1)) : n;
        const float* s = W + (size_t)k0 * N + sn;
        u32x4 w; w.x = pk2(s[0], s[N]); w.y = pk2(s[2 * (size_t)N], s[3 * (size_t)N]); w.z = pk2(s[4 * (size_t)N], s[5 * (size_t)N]); w.w = pk2(s[6 * (size_t)N], s[7 * (size_t)N]);
        *(u32x4*)(dst + (size_t)n * K + k0) = w;
    }
}
__device__ __forceinline__ void ph_convert(const Ctx& cx0) {
#define RELAUNDER() CParams& p = get_params(); Ctx cx; cx.tid = threadIdx.x; cx.bid = blockIdx.x; cx.nb = gridDim.x; asm volatile("" : "+v"(cx.tid), "+s"(cx.bid), "+s"(cx.nb));
#pragma unroll 1
    for (int layer = 0; layer < DEPTH; ++layer) {
        { RELAUNDER(); conv_T(cx, p.in[I_INW] + (size_t)layer * DM * INW, DM, INW, (bf16*)(p.ws + WT_IN) + (size_t)layer * INW * DM, true); }
        { RELAUNDER(); conv_T(cx, p.in[I_GLUW] + (size_t)layer * 512 * 512, 512, 512, (bf16*)(p.ws + WT_GLU) + (size_t)layer * 512 * 512, false); }
        { RELAUNDER(); conv_T(cx, p.in[I_BRA] + (size_t)layer * 512 * 1024, 512, 1024, (bf16*)(p.ws + WT_BR) + (size_t)(layer * 3 + 0) * 1024 * 512, false); }
        { RELAUNDER(); conv_T(cx, p.in[I_BRH] + (size_t)layer * 512 * 1024, 512, 1024, (bf16*)(p.ws + WT_BR) + (size_t)(layer * 3 + 1) * 1024 * 512, false); }
        { RELAUNDER(); conv_T(cx, p.in[I_BRS] + (size_t)layer * 512 * 1024, 512, 1024, (bf16*)(p.ws + WT_BR) + (size_t)(layer * 3 + 2) * 1024 * 512, false); }
        { RELAUNDER(); conv_T(cx, p.in[I_OUTW] + (size_t)layer * 1024 * 1024, 1024, 1024, (bf16*)(p.ws + WT_OUT) + (size_t)layer * 1024 * 1024, false); }
        { RELAUNDER(); conv_T(cx, p.in[I_WQ] + (size_t)layer * 1024 * 2048, 1024, 2048, (bf16*)(p.ws + WT_WQ) + (size_t)layer * 2048 * 1024, false); }
    }
    { RELAUNDER(); const int gt = cx.bid * NTHREADS + cx.tid, NGT = cx.nb * NTHREADS;
      for (int i = gt; i < 2 * 8 * 2 * 128 * 128 / 4; i += NGT) { const f32x4 v = ((const f32x4*)p.in[I_PKEYS])[i]; u32x2 w; w.x = pk2(v[0], v[1]); w.y = pk2(v[2], v[3]); ((u32x2*)(p.ws + WT_KEYS))[i] = w; } }
#undef RELAUNDER
    (void)cx0;
}

__device__ __forceinline__ void ph_norm(const Ctx& cx, int layer, int which, int nrows_lat_only) {
    CParams& p = get_params();
    const int lane = cx.tid & 63, wave = cx.tid >> 6;
    const int gw = cx.bid * NWAVES + wave, NGW = cx.nb * NWAVES;
    const float* g = p.in[which ? I_N2G : I_N1G] + layer * DM;
    const float* xc = (const float*)(p.ws + WS_XCUR);
    bf16* H = (bf16*)(p.ws + WS_H);
    const int nrows = nrows_lat_only ? TL : TA;
    for (int r = gw; r < nrows; r += NGW) {
        const float* mv = (const float*)(p.ws + WS_MODV) + ((size_t)layer * 5 + row_mi(r)) * 6144 + (which ? 3072 : 0);
        f32x4 v[4]; float s = 0.f;
#pragma unroll
        for (int j = 0; j < 4; ++j) { v[j] = *(const f32x4*)(xc + (size_t)r * DM + j * 256 + lane * 4); s += v[j].x * v[j].x + v[j].y * v[j].y + v[j].z * v[j].z + v[j].w * v[j].w; }
        const float rs = rsqrtf(wave_sum(s) * (1.f / DM) + NORM_EPS);
#pragma unroll
        for (int j = 0; j < 4; ++j) { const int c = j * 256 + lane * 4;
            const f32x4 gg = *(const f32x4*)(g + c), sh = *(const f32x4*)(mv + c), sc = *(const f32x4*)(mv + 1024 + c);
            const f32x4 y = v[j] * rs * gg; const f32x4 h = y * (1.f + sc) + sh;
            u32x2 w; w.x = pk2(h.x, h.y); w.y = pk2(h.z, h.w); *(u32x2*)(H + (size_t)r * DM + c) = w; }
    }
}


namespace pg8 {
#define PG8_LAS __attribute__((address_space(3)))
typedef unsigned short bf16_t;
typedef short bf16x8 __attribute__((ext_vector_type(8)));
constexpr int BM = 256, BK = 64, HALF = 128, HTB = HALF * BK * 2, STAGE_BYTES = 8 * HTB, NXCD = 8, WGM = 8;
__host__ __device__ __forceinline__ int lds_byte(int r, int c) { const int st = (r >> 4) * 2 + (c >> 5), rr = r & 15, cc = c & 31, ob = rr * 64 + cc * 2; return st * 1024 + (ob ^ (((ob >> 9) & 1) << 5)); }
__host__ __device__ __forceinline__ void stage_rc(int b, int& R, int& C) { const int st = b / 1024, sb = b % 1024, swz = sb ^ (((sb >> 9) & 1) << 5); R = (st >> 1) * 16 + swz / 64; C = (st & 1) * 32 + (swz % 64) / 2; }
__host__ __device__ __forceinline__ int perm32(int rho) { const int n = rho >> 4, i = rho & 15; return 8 * (i >> 2) + 4 * n + (i & 3); }
struct Unit { int pm, pn, z; };
struct Gemm { const bf16_t* A; const bf16_t* Bt; size_t zsA, zsB; int K; };
__device__ __forceinline__ const bf16_t* selA(const Gemm& g, int z) { return g.A + (size_t)z * g.zsA; }
__device__ __forceinline__ const bf16_t* selB(const Gemm& g, int z) { return g.Bt + (size_t)z * g.zsB; }
struct TileOrder {
    int nM, nN, nwg, G, c, extra, exN, expn0, nz;
    __device__ __forceinline__ bool next(int i, Unit& u) const {
        const int ti = i / nz; u.z = i - ti * nz;
        const long L = (long)ti * G + c;
        if (L < nwg) {
            int wgid = (int)L; { const int q = nwg / NXCD, r = nwg % NXCD, xcd = wgid % NXCD, off = wgid / NXCD; wgid = (xcd < r ? xcd * (q + 1) : r * (q + 1) + (xcd - r) * q) + off; }
            const int nig = WGM * nN, gid = wgid / nig, fm = gid * WGM, gsz = (nM - fm) < WGM ? (nM - fm) : WGM;
            u.pm = fm + ((wgid % nig) % gsz); u.pn = (wgid % nig) / gsz; return true;
        }
        const int e = (int)(L - nwg); if (e >= extra) return false;
        u.pm = nM + e / exN; u.pn = expn0 + e % exN; return true;
    }
};
__device__ __forceinline__ unsigned cvt_pk_bf16(float lo, float hi) { unsigned r; asm volatile("v_cvt_pk_bf16_f32 %0, %1, %2" : "=v"(r) : "v"(lo), "v"(hi)); return r; }
template <class Epi, class Sched, bool ALIGN_EPI = true, bool SP2 = true>
__device__ __forceinline__ void gemm_phase(PG8_LAS unsigned char* lds, const Gemm g, const Sched& S, const Epi& E, const int tid_) {
    const int tid = tid_, wid = __builtin_amdgcn_readfirstlane(tid >> 6), lane = tid & 63, wr = wid >> 2, wc = wid & 3, fr = lane & 15, fq = lane >> 4;
    const int K = g.K, nt = K / BK;
    unsigned voffA[2], voffB[2];
#pragma unroll
    for (int i = 0; i < 2; ++i) { int R, C; stage_rc(tid * 16 + i * 8192, R, C); const int Rb = Epi::PERM ? ((R & ~31) + perm32(R & 31)) : R;
        voffA[i] = (unsigned)(R * K + C) * 2u; voffB[i] = (unsigned)(Rb * K + C) * 2u; }
    const size_t kstep = (size_t)(BK * 2);
    const size_t hstep = (size_t)HALF * K * 2;
    const size_t tstep = 2 * hstep;
    const unsigned ldsw = (unsigned)wid * 1024u;
    const int aoff = lds_byte(wr * 64 + fr, fq * 8), boff = lds_byte(wc * 32 + fr, fq * 8);
#define PG8_SA(b, h) (((b) * 2 + (h)) * HTB)
#define PG8_SB(b, h) ((4 + (b) * 2 + (h)) * HTB)
#define PG8_STAGE(bufoff, gbase, voff) do { _Pragma("unroll") for (int _i = 0; _i < 2; ++_i) \
        __builtin_amdgcn_global_load_lds((const unsigned*)((const char*)(gbase) + (voff)[_i]), (PG8_LAS unsigned*)(lds + (bufoff) + ldsw + _i * 8192), 16, 0, 0); } while (0)
#define PG8_LDA(dst, b, h) do { _Pragma("unroll") for (int m = 0; m < 4; ++m) _Pragma("unroll") for (int k = 0; k < 2; ++k) dst[m][k] = *(const PG8_LAS bf16x8*)(lds + PG8_SA(b, h) + aoff + m * 2048 + k * 1024); } while (0)
#define PG8_LDB(dst, b, h) do { _Pragma("unroll") for (int n = 0; n < 2; ++n) _Pragma("unroll") for (int k = 0; k < 2; ++k) dst[n][k] = *(const PG8_LAS bf16x8*)(lds + PG8_SB(b, h) + boff + n * 2048 + k * 1024); } while (0)
#define PG8_MMA(ai, bj, At, Bt) do { __builtin_amdgcn_s_setprio(1); _Pragma("unroll") for (int m = 0; m < 4; ++m) _Pragma("unroll") for (int n = 0; n < 2; ++n) _Pragma("unroll") for (int k = 0; k < 2; ++k) \
        acc[ai][bj][m][n] = __builtin_amdgcn_mfma_f32_16x16x32_bf16(Bt[n][k], At[m][k], acc[ai][bj][m][n], 0, 0, 0); __builtin_amdgcn_s_setprio(0); } while (0)
#define PG8_WAIT_V(n) asm volatile("s_waitcnt vmcnt(" #n ")" ::: "memory")
#define PG8_WAIT_L(n) asm volatile("s_waitcnt lgkmcnt(" #n ")" ::: "memory")
#define PG8_BAR __builtin_amdgcn_s_barrier()
#define PG8_SCHED __builtin_amdgcn_sched_barrier(0)
    Unit cur, nxt; int ui = 0;
    if (!S.next(0, cur)) return;
    f32x4 acc[2][2][4][2];
#pragma unroll
    for (int a = 0; a < 2; ++a)
#pragma unroll
        for (int b = 0; b < 2; ++b)
#pragma unroll
            for (int m = 0; m < 4; ++m)
#pragma unroll
                for (int n = 0; n < 2; ++n) acc[a][b][m][n] = (f32x4){0.f, 0.f, 0.f, 0.f};
    bf16x8 At[4][2], B0[2][2], B1[2][2];
    const char* cA = (const char*)selA(g, cur.z) + (size_t)cur.pm * tstep; const char* cB = (const char*)selB(g, cur.z) + (size_t)cur.pn * tstep;
    if constexpr (SP2) {
        PG8_STAGE(PG8_SB(0, 0), cB, voffB); PG8_STAGE(PG8_SB(0, 1), cB + hstep, voffB); PG8_STAGE(PG8_SA(0, 0), cA, voffA); PG8_STAGE(PG8_SA(0, 1), cA + hstep, voffA);
        if (wr == 1) PG8_BAR;
        PG8_WAIT_V(2); PG8_BAR;
        PG8_STAGE(PG8_SB(1, 0), cB + kstep, voffB); PG8_STAGE(PG8_SA(1, 0), cA + kstep, voffA); PG8_STAGE(PG8_SB(1, 1), cB + hstep + kstep, voffB);
        PG8_WAIT_V(6); PG8_BAR;
    } else {
        PG8_STAGE(PG8_SB(0, 0), cB, voffB); PG8_STAGE(PG8_SA(0, 0), cA, voffA); PG8_STAGE(PG8_SB(0, 1), cB + hstep, voffB); PG8_STAGE(PG8_SA(0, 1), cA + hstep, voffA);
        if (wr == 1) PG8_BAR;
        PG8_WAIT_V(4); PG8_BAR;
        PG8_STAGE(PG8_SB(1, 0), cB + kstep, voffB); PG8_STAGE(PG8_SA(1, 0), cA + kstep, voffA); PG8_STAGE(PG8_SB(1, 1), cB + hstep + kstep, voffB);
        PG8_WAIT_V(6); PG8_BAR;
    }
    for (;;) {
        const bool has_next = S.next(ui + 1, nxt);
        const char* nA = has_next ? (const char*)selA(g, nxt.z) + (size_t)nxt.pm * tstep : cA; const char* nB = has_next ? (const char*)selB(g, nxt.z) + (size_t)nxt.pn * tstep : cB;
        for (int t = 0; t < nt; t += 2) {
            const bool last = (t == nt - 2);
            const char* a1 = cA + (size_t)(t + 1) * kstep;
            const char* a2 = last ? nA : cA + (size_t)(t + 2) * kstep; const char* b2 = last ? nB : cB + (size_t)(t + 2) * kstep;
            const char* a3 = a2 + kstep; const char* b3 = b2 + kstep;
            if constexpr (SP2) {
            PG8_LDB(B0, 0, 0); PG8_LDB(B1, 0, 1); PG8_SCHED; PG8_LDA(At, 0, 0); PG8_STAGE(PG8_SA(1, 1), a1 + hstep, voffA);
            PG8_WAIT_V(8); PG8_WAIT_L(0); PG8_BAR; PG8_MMA(0, 0, At, B0); PG8_MMA(0, 1, At, B1); PG8_BAR; PG8_SCHED;
            PG8_LDA(At, 0, 1); PG8_STAGE(PG8_SB(0, 0), b2, voffB); PG8_STAGE(PG8_SB(0, 1), b2 + hstep, voffB); PG8_STAGE(PG8_SA(0, 0), a2, voffA);
            PG8_WAIT_V(8); PG8_WAIT_L(0); PG8_BAR; PG8_MMA(1, 0, At, B0); PG8_MMA(1, 1, At, B1); PG8_BAR; PG8_SCHED;
            PG8_LDB(B0, 1, 0); PG8_LDB(B1, 1, 1); PG8_SCHED; PG8_LDA(At, 1, 0); PG8_STAGE(PG8_SA(0, 1), a2 + hstep, voffA);
            PG8_WAIT_V(8); PG8_WAIT_L(0); PG8_BAR; PG8_MMA(0, 0, At, B0); PG8_MMA(0, 1, At, B1); PG8_BAR; PG8_SCHED;
            PG8_LDA(At, 1, 1); PG8_STAGE(PG8_SB(1, 0), b3, voffB); PG8_STAGE(PG8_SB(1, 1), b3 + hstep, voffB); PG8_STAGE(PG8_SA(1, 0), a3, voffA);
            PG8_WAIT_V(8); PG8_WAIT_L(0); PG8_BAR; PG8_MMA(1, 0, At, B0); PG8_MMA(1, 1, At, B1); PG8_BAR; PG8_SCHED;
            } else {
            PG8_LDB(B0, 0, 0); PG8_SCHED; PG8_LDA(At, 0, 0); PG8_STAGE(PG8_SA(1, 1), a1 + hstep, voffA);
            PG8_WAIT_L(8); PG8_BAR; PG8_WAIT_L(0); PG8_MMA(0, 0, At, B0); PG8_BAR; PG8_SCHED;
            PG8_LDB(B1, 0, 1); PG8_STAGE(PG8_SB(0, 0), b2, voffB);
            PG8_BAR; PG8_WAIT_L(0); PG8_MMA(0, 1, At, B1); PG8_BAR;
            PG8_LDA(At, 0, 1); PG8_STAGE(PG8_SA(0, 0), a2, voffA);
            PG8_BAR; PG8_WAIT_L(0); PG8_MMA(1, 0, At, B0); PG8_BAR; PG8_SCHED;
            PG8_STAGE(PG8_SB(0, 1), b2 + hstep, voffB);
            PG8_WAIT_V(6); PG8_BAR; PG8_MMA(1, 1, At, B1); PG8_BAR;
            PG8_LDB(B0, 1, 0); PG8_SCHED; PG8_LDA(At, 1, 0); PG8_STAGE(PG8_SA(0, 1), a2 + hstep, voffA);
            PG8_WAIT_L(8); PG8_BAR; PG8_WAIT_L(0); PG8_MMA(0, 0, At, B0); PG8_BAR; PG8_SCHED;
            PG8_LDB(B1, 1, 1); PG8_STAGE(PG8_SB(1, 0), b3, voffB);
            PG8_BAR; PG8_WAIT_L(0); PG8_MMA(0, 1, At, B1); PG8_BAR;
            PG8_LDA(At, 1, 1); PG8_STAGE(PG8_SA(1, 0), a3, voffA);
            PG8_BAR; PG8_WAIT_L(0); PG8_MMA(1, 0, At, B0); PG8_BAR; PG8_SCHED;
            PG8_STAGE(PG8_SB(1, 1), b3 + hstep, voffB);
            PG8_WAIT_V(6); PG8_BAR; PG8_MMA(1, 1, At, B1); PG8_BAR;
            }
        }
        if constexpr (ALIGN_EPI) { if (wr == 0) PG8_BAR; }
        const bool keep = E(acc, cur, wr, wc, fr, fq);
        if (!has_next) break;
        if (!keep) {
#pragma unroll
        for (int a = 0; a < 2; ++a)
#pragma unroll
            for (int b = 0; b < 2; ++b)
#pragma unroll
                for (int m = 0; m < 4; ++m)
#pragma unroll
                    for (int n = 0; n < 2; ++n) acc[a][b][m][n] = (f32x4){0.f, 0.f, 0.f, 0.f};
        }
        cur = nxt; cA = nA; cB = nB; ++ui;
        if constexpr (ALIGN_EPI) { if (wr == 1) PG8_BAR; }
    }
    PG8_WAIT_V(0);
    if constexpr (!ALIGN_EPI) { if (wr == 0) PG8_BAR; }
    PG8_BAR;
#undef PG8_SA
#undef PG8_SB
#undef PG8_STAGE
#undef PG8_LDA
#undef PG8_LDB
#undef PG8_MMA
#undef PG8_WAIT_V
#undef PG8_WAIT_L
#undef PG8_BAR
#undef PG8_SCHED
}
}

__device__ __forceinline__ f32x4 bf4lo(u32x4 w) { return (f32x4){__uint_as_float(w.x << 16), __uint_as_float(w.x & 0xffff0000u), __uint_as_float(w.y << 16), __uint_as_float(w.y & 0xffff0000u)}; }
__device__ __forceinline__ f32x4 bf4hi(u32x4 w) { return (f32x4){__uint_as_float(w.z << 16), __uint_as_float(w.z & 0xffff0000u), __uint_as_float(w.w << 16), __uint_as_float(w.w & 0xffff0000u)}; }
__device__ __forceinline__ u32x4 pack8(f32x4 a, f32x4 b) { u32x4 w; w.x = pg8::cvt_pk_bf16(a[0], a[1]); w.y = pg8::cvt_pk_bf16(a[2], a[3]); w.z = pg8::cvt_pk_bf16(b[0], b[1]); w.w = pg8::cvt_pk_bf16(b[2], b[3]); return w; }
__device__ __forceinline__ f32x4 sig4(f32x4 v) { return (f32x4){sigmoidf_(v[0]), sigmoidf_(v[1]), sigmoidf_(v[2]), sigmoidf_(v[3])}; }

template <class T> __device__ __forceinline__ T* uni_ptr(T* q) { unsigned long long a = (unsigned long long)q; unsigned lo = __builtin_amdgcn_readfirstlane((unsigned)a), hi = __builtin_amdgcn_readfirstlane((unsigned)(a >> 32));
    asm volatile("" : "+s"(lo), "+s"(hi)); return (T*)(((unsigned long long)hi << 32) | lo); }
struct EpiInproj {
    static constexpr bool PERM = true;
    unsigned char* ws; const float* gate_b;
    __device__ __forceinline__ bool operator()(f32x4 (&acc)[2][2][4][2], const pg8::Unit& u, int wr, int wc, int fr_, int fq_) const {
        int fr = fr_, fq = fq_; asm volatile("" : "+v"(fr), "+v"(fq)); unsigned char* const ws = uni_ptr(this->ws);
        const int cl = wc * 32 + 8 * fq, rbase = u.pm * 256 + wr * 64 + fr;
#pragma unroll
        for (int bj = 0; bj < 2; ++bj) {
            const int c128 = u.pn * 256 + bj * 128;
            unsigned char* base; unsigned rstride, coff; int kind = 0;
            if (c128 < COL_K)         { base = ws + WS_Q; rstride = 1024; coff = (unsigned)(c128 + cl) * 2u; kind = 1; }
            else if (c128 < COL_V)    { base = ws + WS_K; rstride = 256;  coff = (unsigned)cl * 2u; kind = 1; }
            else if (c128 < COL_S5)   { base = ws + WS_V; rstride = 256;  coff = (unsigned)cl * 2u; }
            else if (c128 < COL_HY)   { base = ws + WS_U; rstride = 1024; coff = (unsigned)(c128 - COL_S5 + cl) * 2u; }
            else if (c128 < COL_GATE) { base = ws + WS_Z; rstride = 3072; coff = (unsigned)(c128 - COL_HY + cl) * 2u; }
            else                      { base = ws + WS_G; rstride = 6144; coff = (unsigned)(c128 - COL_GATE + cl) * 2u; kind = 2; }
            if (kind == 1) {
                const float* rope = (const float*)(ws + WS_ROPE) + 8 * fq;
#pragma unroll
                for (int ai = 0; ai < 2; ++ai)
#pragma unroll
                    for (int m = 0; m < 4; ++m) {
                        const int r = rbase + ai * 128 + m * 16;
                        f32x4 v0 = acc[ai][bj][m][0], v1 = acc[ai][bj][m][1];
                        if (r < TL) { const int l = r & 4095, pos = (wc & 1) ? (l & 63) : (l >> 6);
                            const f32x4 t0 = *(const f32x4*)(rope + pos * 32), t1 = *(const f32x4*)(rope + pos * 32 + 4);
                            v0 = (f32x4){v0[0] * t0[0] - v0[1] * t0[1], v0[0] * t0[1] + v0[1] * t0[0], v0[2] * t0[2] - v0[3] * t0[3], v0[2] * t0[3] + v0[3] * t0[2]};
                            v1 = (f32x4){v1[0] * t1[0] - v1[1] * t1[1], v1[0] * t1[1] + v1[1] * t1[0], v1[2] * t1[2] - v1[3] * t1[3], v1[2] * t1[3] + v1[3] * t1[2]}; }
                        *(u32x4*)(base + ((unsigned)r * rstride + coff)) = pack8(v0, v1);
                        asm volatile("" ::: "memory");
                    }
            } else if (kind == 2) {
                const float* gb = uni_ptr(gate_b) + (c128 - COL_GATE) + cl; const f32x4 b0 = *(const f32x4*)gb, b1 = *(const f32x4*)(gb + 4);
#pragma unroll
                for (int ai = 0; ai < 2; ++ai)
#pragma unroll
                    for (int m = 0; m < 4; ++m) {
                        const int r = rbase + ai * 128 + m * 16;
                        *(u32x4*)(base + ((unsigned)r * rstride + coff)) = pack8(sig4(acc[ai][bj][m][0] + b0), sig4(acc[ai][bj][m][1] + b1));
                        asm volatile("" ::: "memory");
                    }
            } else {
#pragma unroll
                for (int ai = 0; ai < 2; ++ai)
#pragma unroll
                    for (int m = 0; m < 4; ++m) {
                        const int r = rbase + ai * 128 + m * 16;
                        *(u32x4*)(base + ((unsigned)r * rstride + coff)) = pack8(acc[ai][bj][m][0], acc[ai][bj][m][1]);
                    }
            }
        }
        return false;
    }
};
struct EpiGlu {
    static constexpr bool PERM = true;
    unsigned char* ws; const float* bias;
    __device__ __forceinline__ bool operator()(f32x4 (&acc)[2][2][4][2], const pg8::Unit& u, int wr, int wc, int fr_, int fq_) const {
        int fr = fr_, fq = fq_; asm volatile("" : "+v"(fr), "+v"(fq)); unsigned char* const ws = uni_ptr(this->ws);
#pragma unroll
        for (int bj = 0; bj < 2; ++bj) { const int c = u.pn * 256 + bj * 128 + wc * 32 + 8 * fq; const f32x4 b0 = *(const f32x4*)(bias + c), b1 = *(const f32x4*)(bias + c + 4);
#pragma unroll
            for (int ai = 0; ai < 2; ++ai)
#pragma unroll
                for (int m = 0; m < 4; ++m) { const size_t o = (size_t)(u.pm * 256 + ai * 128 + wr * 64 + m * 16 + fr) * 512 + c;
                    const u32x4 yw = *(const u32x4*)((const bf16*)(ws + WS_S5Y) + o);
                    *(u32x4*)((bf16*)(ws + WS_S5O) + o) = pack8(bf4lo(yw) * sig4(acc[ai][bj][m][0] + b0), bf4hi(yw) * sig4(acc[ai][bj][m][1] + b1)); asm volatile("" ::: "memory"); } }
        return false;
    }
};
struct EpiMerge {
    static constexpr bool PERM = true;
    unsigned char* ws;
    __device__ __forceinline__ bool operator()(f32x4 (&acc)[2][2][4][2], const pg8::Unit& u, int wr, int wc, int fr_, int fq_) const {
        int fr = fr_, fq = fq_; asm volatile("" : "+v"(fr), "+v"(fq)); unsigned char* const ws = uni_ptr(this->ws);
#pragma unroll
        for (int bj = 0; bj < 2; ++bj) { const int c = u.pn * 256 + bj * 128 + wc * 32 + 8 * fq;
#pragma unroll
            for (int ai = 0; ai < 2; ++ai)
#pragma unroll
                for (int m = 0; m < 4; ++m) { const int r = u.pm * 256 + ai * 128 + wr * 64 + m * 16 + fr;
                    const bf16* gp = (const bf16*)(ws + WS_G) + (size_t)r * 3072 + u.z * 1024 + c;
                    const u32x4 g0 = *(const u32x4*)gp;
                    if (u.z < 2) { const u32x4 g1 = *(const u32x4*)(gp + 1024);
                        const f32x4 d0 = bf4lo(g1), d1 = bf4hi(g1), n0 = bf4lo(g0), n1 = bf4hi(g0);
                        acc[ai][bj][m][0] *= (f32x4){n0[0] / fmaxf(d0[0], 1e-30f), n0[1] / fmaxf(d0[1], 1e-30f), n0[2] / fmaxf(d0[2], 1e-30f), n0[3] / fmaxf(d0[3], 1e-30f)};
                        acc[ai][bj][m][1] *= (f32x4){n1[0] / fmaxf(d1[0], 1e-30f), n1[1] / fmaxf(d1[1], 1e-30f), n1[2] / fmaxf(d1[2], 1e-30f), n1[3] / fmaxf(d1[3], 1e-30f)};
                    } else *(u32x4*)((bf16*)(ws + WS_M) + (size_t)r * 1024 + c) = pack8(acc[ai][bj][m][0] * bf4lo(g0), acc[ai][bj][m][1] * bf4hi(g0));
                    asm volatile("" ::: "memory");
                } }
        return u.z < 2;
    }
};
struct EpiOut {
    static constexpr bool PERM = false;
    unsigned char* ws; int layer;
    __device__ __forceinline__ bool operator()(f32x4 (&acc)[2][2][4][2], const pg8::Unit& u, int wr, int wc, int fr_, int fq_) const {
        int fr = fr_, fq = fq_; asm volatile("" : "+v"(fr), "+v"(fq)); unsigned char* const ws = uni_ptr(this->ws);
        float* X = (float*)(ws + WS_XCUR);
#pragma unroll
        for (int ai = 0; ai < 2; ++ai)
#pragma unroll
            for (int m = 0; m < 4; ++m) { const int r = u.pm * 256 + ai * 128 + wr * 64 + m * 16 + fr;
                const float* g1 = (const float*)(ws + WS_MODV) + ((size_t)layer * 5 + row_mi(r)) * 6144 + 2048;
#pragma unroll
                for (int bj = 0; bj < 2; ++bj)
#pragma unroll
                    for (int n = 0; n < 2; ++n) { const int c = u.pn * 256 + bj * 128 + wc * 32 + n * 16 + 4 * fq; f32x4* xp = (f32x4*)(X + (size_t)r * 1024 + c);
                        *xp = *xp + *(const f32x4*)(g1 + c) * acc[ai][bj][m][n]; } asm volatile("" ::: "memory"); }
        return false;
    }
};
struct EpiQp {
    static constexpr bool PERM = true;
    unsigned char* ws;
    __device__ __forceinline__ bool operator()(f32x4 (&acc)[2][2][4][2], const pg8::Unit& u, int wr, int wc, int fr_, int fq_) const {
        int fr = fr_, fq = fq_; asm volatile("" : "+v"(fr), "+v"(fq)); unsigned char* const ws = uni_ptr(this->ws);
#pragma unroll
        for (int bj = 0; bj < 2; ++bj) { const int c = u.pn * 256 + bj * 128 + wc * 32 + 8 * fq;
#pragma unroll
            for (int ai = 0; ai < 2; ++ai)
#pragma unroll
                for (int m = 0; m < 4; ++m) *(u32x4*)((bf16*)(ws + WS_QP) + (size_t)(u.pm * 256 + ai * 128 + wr * 64 + m * 16 + fr) * 2048 + c) = pack8(acc[ai][bj][m][0], acc[ai][bj][m][1]); }
        return false;
    }
};

__device__ __forceinline__ void ph_inproj(const Ctx& cx, int layer, PG8_LAS unsigned char* lds) {
    CParams& p = get_params();
    pg8::Gemm g; g.A = (const bf16*)(p.ws + WS_H); g.Bt = (const bf16*)(p.ws + WT_IN) + (size_t)layer * INW * DM; g.zsA = 0; g.zsB = 0; g.K = DM;
    pg8::TileOrder S; S.nM = TL / 256; S.nN = INW / 256; S.nwg = S.nM * S.nN; S.G = cx.nb; S.c = cx.bid; S.nz = 1;
    if (layer == DEPTH - 1) { S.exN = 3; S.expn0 = 2; S.extra = 4 * 3; } else { S.exN = INW / 256; S.expn0 = 0; S.extra = 4 * (INW / 256); }
    EpiInproj E; E.ws = p.ws; E.gate_b = p.in[I_GATEB] + layer * 3072;
    pg8::gemm_phase<EpiInproj, pg8::TileOrder>(lds, g, S, E, cx.tid);
}

__device__ __forceinline__ void ph_attn(const Ctx& cx, int layer) {
    CParams& p = get_params();
    const int gt = cx.bid * NTHREADS + cx.tid, NGT = cx.nb * NTHREADS;
    const bf16* Q = (const bf16*)(p.ws + WS_Q); const bf16* Kb = (const bf16*)(p.ws + WS_K); const bf16* Vb = (const bf16*)(p.ws + WS_V);
    bf16* O = (bf16*)(p.ws + WS_ATT);
    const int nrows = layer == 0 ? TA : TL;
    for (int it4 = gt; it4 < nrows * 8 * 4; it4 += NGT) {
        const int sub = it4 & 3, it = it4 >> 2;
        const int h = it / nrows, r = it % nrows;
        const int b = row_b(r), kvh = h >> 2;
        float q[16], acc[16];
#pragma unroll
        for (int d8 = 0; d8 < 2; ++d8) { const u32x4 w = *(const u32x4*)(Q + (size_t)r * 512 + h * 64 + sub * 16 + d8 * 8);
            q[d8 * 8 + 0] = __uint_as_float(w.x << 16); q[d8 * 8 + 1] = __uint_as_float(w.x & 0xffff0000u); q[d8 * 8 + 2] = __uint_as_float(w.y << 16); q[d8 * 8 + 3] = __uint_as_float(w.y & 0xffff0000u);
            q[d8 * 8 + 4] = __uint_as_float(w.z << 16); q[d8 * 8 + 5] = __uint_as_float(w.z & 0xffff0000u); q[d8 * 8 + 6] = __uint_as_float(w.w << 16); q[d8 * 8 + 7] = __uint_as_float(w.w & 0xffff0000u); }
#pragma unroll
        for (int d = 0; d < 16; ++d) acc[d] = 0.f;
        float m = p.in[I_SINK][layer * 8 + h], l = 1.f;
        int wlo = 0, whi = -1;
        if (r < TL) { const int pos = r & 4095; wlo = pos - 128 < 0 ? 0 : pos - 128; whi = pos + 128 > SEQ - 1 ? SEQ - 1 : pos + 128; }
        const int nwin = whi - wlo + 1;
        for (int kk = 0; kk < 256 + nwin; ++kk) {
            const int kr = kk < 256 ? TL + b * 256 + kk : b * SEQ + wlo + (kk - 256);
            const bf16* kp = Kb + (size_t)kr * 128 + kvh * 64 + sub * 16; const bf16* vp = Vb + (size_t)kr * 128 + kvh * 64 + sub * 16;
            float s = 0.f;
#pragma unroll
            for (int d8 = 0; d8 < 2; ++d8) { const u32x4 w = *(const u32x4*)(kp + d8 * 8);
                s += q[d8 * 8 + 0] * __uint_as_float(w.x << 16) + q[d8 * 8 + 1] * __uint_as_float(w.x & 0xffff0000u) + q[d8 * 8 + 2] * __uint_as_float(w.y << 16) + q[d8 * 8 + 3] * __uint_as_float(w.y & 0xffff0000u)
                   + q[d8 * 8 + 4] * __uint_as_float(w.z << 16) + q[d8 * 8 + 5] * __uint_as_float(w.z & 0xffff0000u) + q[d8 * 8 + 6] * __uint_as_float(w.w << 16) + q[d8 * 8 + 7] * __uint_as_float(w.w & 0xffff0000u); }
            s += __shfl_xor(s, 1); s += __shfl_xor(s, 2);
            s *= 0.125f;
            const float mn = fmaxf(m, s), f = __expf(m - mn), e = __expf(s - mn);
            l = l * f + e; m = mn;
#pragma unroll
            for (int d8 = 0; d8 < 2; ++d8) { const u32x4 w = *(const u32x4*)(vp + d8 * 8);
                acc[d8 * 8 + 0] = acc[d8 * 8 + 0] * f + e * __uint_as_float(w.x << 16); acc[d8 * 8 + 1] = acc[d8 * 8 + 1] * f + e * __uint_as_float(w.x & 0xffff0000u);
                acc[d8 * 8 + 2] = acc[d8 * 8 + 2] * f + e * __uint_as_float(w.y << 16); acc[d8 * 8 + 3] = acc[d8 * 8 + 3] * f + e * __uint_as_float(w.y & 0xffff0000u);
                acc[d8 * 8 + 4] = acc[d8 * 8 + 4] * f + e * __uint_as_float(w.z << 16); acc[d8 * 8 + 5] = acc[d8 * 8 + 5] * f + e * __uint_as_float(w.z & 0xffff0000u);
                acc[d8 * 8 + 6] = acc[d8 * 8 + 6] * f + e * __uint_as_float(w.w << 16); acc[d8 * 8 + 7] = acc[d8 * 8 + 7] * f + e * __uint_as_float(w.w & 0xffff0000u); }
        }
        const float il = 1.f / l;
#pragma unroll
        for (int d8 = 0; d8 < 2; ++d8) { u32x4 w; w.x = pk2(acc[d8 * 8] * il, acc[d8 * 8 + 1] * il); w.y = pk2(acc[d8 * 8 + 2] * il, acc[d8 * 8 + 3] * il); w.z = pk2(acc[d8 * 8 + 4] * il, acc[d8 * 8 + 5] * il); w.w = pk2(acc[d8 * 8 + 6] * il, acc[d8 * 8 + 7] * il);
            *(u32x4*)(O + (size_t)r * 512 + h * 64 + sub * 16 + d8 * 8) = w; }
    }
}

__device__ __forceinline__ void ph_hypre(const Ctx& cx, int layer, float* sm) {
    CParams& p = get_params();
    const int lane = cx.tid & 63, wave = cx.tid >> 6, gw = cx.bid * NWAVES + wave, NGW = cx.nb * NWAVES;
    const bf16* Z = (const bf16*)(p.ws + WS_Z); const float* sw = p.in[I_HSW] + layer * 3 * 1536; const float* sb = p.in[I_HSB] + layer * 1536;
    float* tile = sm + wave * 4096;
    const int nlat = 4 * 64 * 8, nctx = layer == 0 ? 4 * 4 * 8 : 0;
    for (int it = gw; it < nlat + nctx; it += NGW) {
        int b, t0, L, c0, rbase; float* vvb;
        if (it < nlat) { b = it >> 9; t0 = ((it >> 3) & 63) * 64; c0 = (it & 7) * 64; L = SEQ; rbase = b * SEQ; vvb = (float*)(p.ws + WS_VV) + ((size_t)b * 512 + c0) * SEQ; }
        else { const int j = it - nlat; b = j >> 5; t0 = ((j >> 3) & 3) * 64; c0 = (j & 7) * 64; L = CTXL; rbase = TL + b * CTXL; vvb = (float*)(p.ws + WS_VVC) + ((size_t)b * 512 + c0) * CTXL; }
        const int c = c0 + lane;
        float w0[3], w1[3], w2[3], bb[3], zp[3], zc[3], zn[3];
#pragma unroll
        for (int q = 0; q < 3; ++q) { const int col = q * 512 + c; w0[q] = sw[col]; w1[q] = sw[1536 + col]; w2[q] = sw[2 * 1536 + col]; bb[q] = sb[col];
            zp[q] = t0 > 0 ? bf2f(Z[(size_t)(rbase + t0 - 1) * 1536 + col]) : 0.f; zc[q] = bf2f(Z[(size_t)(rbase + t0) * 1536 + col]); }
        for (int tt = 0; tt < 64; ++tt) {
            const int t = t0 + tt;
#pragma unroll
            for (int q = 0; q < 3; ++q) zn[q] = t + 1 < L ? bf2f(Z[(size_t)(rbase + t + 1) * 1536 + q * 512 + c]) : 0.f;
            float o[3];
#pragma unroll
            for (int q = 0; q < 3; ++q) { o[q] = bb[q] + w0[q] * zp[q] + w1[q] * zc[q] + w2[q] * zn[q]; zp[q] = zc[q]; zc[q] = zn[q]; }
            ((bf16*)(p.ws + WS_X0C))[(size_t)(rbase + t) * 512 + c] = f2bf(o[0]);
            tile[lane * 64 + (tt ^ lane)] = o[2] * o[1];
        }
        __builtin_amdgcn_s_waitcnt(0xc07f);
        for (int cc = 0; cc < 64; ++cc) vvb[(size_t)cc * L + t0 + lane] = tile[cc * 64 + (lane ^ cc)];
        __builtin_amdgcn_s_waitcnt(0xc07f);
    }
}

__device__ __forceinline__ void ph_hyconv_ctx(const Ctx& cx, int layer, float* sm) {
    CParams& p = get_params();
    const int tid = cx.tid;
    if (layer != 0) return;
    constexpr int L = CTXL;
    float* Tl = sm; float* Vl = sm + 2 * L;
    for (int it = cx.bid; it < 2048; it += cx.nb) {
        const int bc = it, b = bc >> 9, c = bc & 511;
        const float* fb = (const float*)(p.ws + WS_FILT + FILT_CTX_OFF);
        const float* hf = fb + (size_t)c * L; const float* hb = fb + ((size_t)512 + c) * L;
        const float* vv = (const float*)(p.ws + WS_VVC) + (size_t)bc * CTXL;
        __syncthreads();
        if (tid < L) { Tl[L - 1 + tid] = hf[tid]; if (tid > 0) Tl[L - 1 - tid] = hb[tid]; Vl[tid] = vv[tid]; }
        __syncthreads();
        if (tid < L) { float a = 0.f; const float* tp = Tl + (tid + L - 1);
            for (int s = 0; s < L; ++s) a += Vl[s] * tp[-s];
            const size_t o = (size_t)(TL + b * CTXL + tid) * 512 + c;
            ((bf16*)(p.ws + WS_HY))[o] = f2bf((a + Vl[tid] * p.in[I_HBIAS][layer * 512 + c]) * bf2f(((const bf16*)(p.ws + WS_X0C))[o])); }
    }
}
typedef float f32x2 __attribute__((ext_vector_type(2)));
__device__ __forceinline__ void fft_fwd(f32x2* X, int tid) {
#pragma unroll 1
    for (int s = 0; s < 13; ++s) {
        const int lh = 12 - s, half = 1 << lh;
        __syncthreads();
#pragma unroll
        for (int q = 0; q < 8; ++q) { const int j = tid + 512 * q, pos = j & (half - 1), i0 = ((j >> lh) << (lh + 1)) + pos, i1 = i0 + half;
            const float rev = (float)(pos << s) * (1.f / 8192.f); const float wc = __builtin_amdgcn_cosf(rev), ws = -__builtin_amdgcn_sinf(rev);
            const f32x2 a = X[i0], b = X[i1]; const f32x2 d = a - b;
            X[i0] = a + b; X[i1] = (f32x2){d.x * wc - d.y * ws, d.x * ws + d.y * wc}; }
    }
}
__device__ __forceinline__ void fft_inv(f32x2* X, int tid) {
#pragma unroll 1
    for (int s = 0; s < 13; ++s) {
        const int half = 1 << s;
        __syncthreads();
#pragma unroll
        for (int q = 0; q < 8; ++q) { const int j = tid + 512 * q, pos = j & (half - 1), i0 = ((j >> s) << (s + 1)) + pos, i1 = i0 + half;
            const float rev = (float)(pos << (12 - s)) * (1.f / 8192.f); const float wc = __builtin_amdgcn_cosf(rev), ws = __builtin_amdgcn_sinf(rev);
            const f32x2 a = X[i0], b0 = X[i1]; const f32x2 b = (f32x2){b0.x * wc - b0.y * ws, b0.x * ws + b0.y * wc};
            X[i0] = a + b; X[i1] = a - b; }
    }
}
__device__ __forceinline__ void ph_hyfft(const Ctx& cx, int layer, float* sm) {
    CParams& p = get_params();
    const int tid = cx.tid;
    f32x2* A = (f32x2*)sm; f32x2* B = A + 8192;
    for (int c = cx.bid; c < 512; c += cx.nb) {
        const float* hf = (const float*)(p.ws + WS_FILT) + (size_t)c * SEQ; const float* hb = (const float*)(p.ws + WS_FILT) + ((size_t)512 + c) * SEQ;
        const float bias = p.in[I_HBIAS][layer * 512 + c];
        __syncthreads();
#pragma unroll
        for (int q = 0; q < 16; ++q) { const int i = tid + 512 * q; float v = 0.f; if (i < SEQ) v = hf[i]; else if (i > SEQ) v = hb[2 * SEQ - i]; A[i] = (f32x2){v, 0.f}; }
        fft_fwd(A, tid);
#pragma unroll 1
        for (int bp = 0; bp < 2; ++bp) {
            float* v0 = (float*)(p.ws + WS_VV) + ((size_t)(2 * bp) * 512 + c) * SEQ; float* v1 = v0 + (size_t)512 * SEQ;
            float xr[8], xi[8];
            __syncthreads();
#pragma unroll
            for (int q = 0; q < 8; ++q) { const int i = tid + 512 * q; xr[q] = v0[i]; xi[q] = v1[i]; B[i] = (f32x2){xr[q], xi[q]}; B[i + SEQ] = (f32x2){0.f, 0.f}; }
            fft_fwd(B, tid);
            __syncthreads();
#pragma unroll
            for (int q = 0; q < 16; ++q) { const int i = tid + 512 * q; const f32x2 k = A[i], x = B[i]; B[i] = (f32x2){x.x * k.x - x.y * k.y, x.x * k.y + x.y * k.x}; }
            fft_inv(B, tid);
            __syncthreads();
#pragma unroll
            for (int q = 0; q < 8; ++q) { const int i = tid + 512 * q; const f32x2 y = B[i]; v0[i] = y.x * (1.f / 8192.f) + xr[q] * bias; v1[i] = y.y * (1.f / 8192.f) + xi[q] * bias; }
        }
    }
}
__device__ __forceinline__ void ph_hypost(const Ctx& cx, int layer, float* sm) {
    CParams& p = get_params();
    const int lane = cx.tid & 63, wave = cx.tid >> 6, gw = cx.bid * NWAVES + wave, NGW = cx.nb * NWAVES;
    float* tile = sm + wave * 4096;
    for (int it = gw; it < 4 * 64 * 8; it += NGW) {
        const int b = it >> 9, t0 = ((it >> 3) & 63) * 64, c0 = (it & 7) * 64;
        const float* yb = (const float*)(p.ws + WS_VV) + ((size_t)b * 512 + c0) * SEQ;
        for (int cc = 0; cc < 64; ++cc) tile[cc * 64 + (lane ^ cc)] = yb[(size_t)cc * SEQ + t0 + lane];
        __builtin_amdgcn_s_waitcnt(0xc07f);
        for (int tt = 0; tt < 64; ++tt) { const size_t o = (size_t)(b * SEQ + t0 + tt) * 512 + c0 + lane;
            ((bf16*)(p.ws + WS_HY))[o] = f2bf(tile[lane * 64 + (tt ^ lane)] * bf2f(((const bf16*)(p.ws + WS_X0C))[o])); }
        __builtin_amdgcn_s_waitcnt(0xc07f);
    }
    (void)layer;
}

typedef short bf16x8 __attribute__((ext_vector_type(8)));
struct S5Coef { float decay, theta, cr, ci; };
__device__ __forceinline__ S5Coef s5_coef(CParams& p, int ldgp  ) {
    const int ldg = ldgp >> 6;
    const float are = fminf(p.in[I_SARE][ldgp], -1e-4f), aim = p.in[I_SAIM][ldgp], dt = __expf(p.in[I_SLDT][ldg]);
    S5Coef c; c.decay = are * dt; c.theta = aim * dt;
    const float er = __expf(c.decay), abr = er * fcos(c.theta), abi = er * fsin(c.theta);
    const float nr = abr - 1.0f, ni = abi, den = are * are + aim * aim;
    c.cr = (nr * are + ni * aim) / den; c.ci = (ni * are - nr * aim) / den; return c;
}
__device__ __forceinline__ void s5_pow(const S5Coef& c, int n, float& pr, float& pi) {
    const float m = __expf(c.decay * (float)n), rev = __builtin_amdgcn_fractf(c.theta * (float)n * 0.15915494309189535f);
    pr = m * __builtin_amdgcn_cosf(rev); pi = m * __builtin_amdgcn_sinf(rev);
}
__device__ __forceinline__ void ph_s5tables(const Ctx& cx, int layer) {
    const int gt = cx.bid * NTHREADS + cx.tid, NGT = cx.nb * NTHREADS;
    {
        CParams& p = get_params(); bf16* E = (bf16*)(p.ws + WS_S5E);
        for (int it = gt; it < 32 * 2 * 64 * 64; it += NGT) {
            const int pp = it & 63, s = (it >> 6) & 63, dir = (it >> 12) & 1, g = it >> 13;
            const int ldgp = ((layer * 2 + dir) * 32 + g) * 64 + pp;
            const S5Coef c = s5_coef(p, ldgp);
            float pr, pi; s5_pow(c, dir == 0 ? 63 - s : s, pr, pi);
            const float qr = pr * c.cr - pi * c.ci, qi = pr * c.ci + pi * c.cr;
            const float* bre = p.in[I_SBRE] + (size_t)ldgp * 16; const float* bim = p.in[I_SBIM] + (size_t)ldgp * 16;
            bf16* er = E + (((size_t)(g * 2 + dir) * 128 + pp) * 1024 + s * 16); bf16* ei = er + (size_t)64 * 1024;
#pragma unroll
            for (int i = 0; i < 16; i += 2) { const float b0r = bre[i], b0i = bim[i], b1r = bre[i + 1], b1i = bim[i + 1];
                *(unsigned*)(er + i) = pk2(qr * b0r - qi * b0i, qr * b1r - qi * b1i); *(unsigned*)(ei + i) = pk2(qr * b0i + qi * b0r, qr * b1i + qi * b1r); }
            if (s == 0) { float ar, ai; s5_pow(c, 64, ar, ai); float* a64 = (float*)(p.ws + WS_S5A64) + (size_t)ldgp * 2; a64[0] = ar; a64[1] = ai; }
        }
    }
    {
        CParams& p = get_params(); bf16* P = (bf16*)(p.ws + WS_S5P);
        for (int it = gt; it < 32 * 2 * 64 * 64; it += NGT) {
            const int pp = it & 63, tau = (it >> 6) & 63, dir = (it >> 12) & 1, g = it >> 13;
            const int ldgp = ((layer * 2 + dir) * 32 + g) * 64 + pp;
            const S5Coef c = s5_coef(p, ldgp);
            float pr, pi; s5_pow(c, dir == 0 ? tau + 1 : 64 - tau, pr, pi);
            const size_t cb = ((size_t)((layer * 2 + dir) * 32 + g) * 16) * 64 + pp;
            bf16* pb = P + (((size_t)(g * 2 + dir) * 64 + tau) * 16) * 128 + pp;
#pragma unroll
            for (int o = 0; o < 16; ++o) { const float cre = p.in[I_SCRE][cb + o * 64], cim = p.in[I_SCIM][cb + o * 64];
                pb[o * 128] = f2bf(cre * pr - cim * pi); pb[o * 128 + 64] = f2bf(-(cre * pi + cim * pr)); }
        }
    }
    {
        CParams& p = get_params(); bf16* K = (bf16*)(p.ws + WS_S5K);
        for (int it = gt; it < 32 * 127 * 256; it += NGT) {
            const int i = it & 15, o = (it >> 4) & 15, dl = (it >> 8) % 127, g = (it >> 8) / 127, d = dl - 63;
            float acc = 0.f;
#pragma unroll 1
            for (int dir = 0; dir < 2; ++dir) {
                if ((dir == 0 && d < 0) || (dir == 1 && d > 0)) continue;
                const int n = d < 0 ? -d : d, base = ((layer * 2 + dir) * 32 + g) * 64;
                for (int pp = 0; pp < 64; ++pp) {
                    const S5Coef c = s5_coef(p, base + pp);
                    float pr, pi; s5_pow(c, n, pr, pi);
                    const float qr = pr * c.cr - pi * c.ci, qi = pr * c.ci + pi * c.cr;
                    const float br = p.in[I_SBRE][(size_t)(base + pp) * 16 + i], bi = p.in[I_SBIM][(size_t)(base + pp) * 16 + i];
                    const float xr = qr * br - qi * bi, xi = qr * bi + qi * br;
                    const size_t ci_ = ((size_t)((layer * 2 + dir) * 32 + g) * 16 + o) * 64 + pp;
                    acc += p.in[I_SCRE][ci_] * xr - p.in[I_SCIM][ci_] * xi;
                }
            }
            if (d == 0 && o == i) acc += p.in[I_SD][layer * 512 + g * 16 + o];
            K[it] = f2bf(acc);
        }
    }
}
__device__ __forceinline__ int s5_row(int b, int n, int s) { return n < 4 ? TL + b * CTXL + n * 64 + s : b * SEQ + (n - 4) * 64 + s; }
__device__ __forceinline__ void ph_s5states(const Ctx& cx, int layer, float* sm) {
    CParams& p = get_params();
    const int tid = cx.tid, lane = tid & 63, w = tid >> 6, l15 = lane & 15, kg = lane >> 4;
    const bf16* E = (const bf16*)(p.ws + WS_S5E); const bf16* U = (const bf16*)(p.ws + WS_U);
    float* S = sm;
    for (int it = cx.bid; it < 128; it += cx.nb) {
        const int g = it & 31, b = it >> 5;
        f32x4 acc[2][5];
#pragma unroll
        for (int mt = 0; mt < 2; ++mt)
#pragma unroll
            for (int nt = 0; nt < 5; ++nt) acc[mt][nt] = (f32x4){0.f, 0.f, 0.f, 0.f};
        const bf16* ea = E + ((size_t)g * 256 + 32 * w + l15) * 1024 + 8 * kg;
        for (int ks = 0; ks < 32; ++ks) {
            const int s = 2 * ks + (kg >> 1), i0 = 8 * (kg & 1);
            bf16x8 af[2], bfr[5];
#pragma unroll
            for (int mt = 0; mt < 2; ++mt) af[mt] = *(const bf16x8*)(ea + (size_t)mt * 16 * 1024 + ks * 32);
#pragma unroll
            for (int nt = 0; nt < 5; ++nt) { const int n = 16 * nt + l15; bfr[nt] = (bf16x8){0, 0, 0, 0, 0, 0, 0, 0};
                if (n < 68) bfr[nt] = *(const bf16x8*)(U + (size_t)s5_row(b, n, s) * 512 + g * 16 + i0); }
#pragma unroll
            for (int mt = 0; mt < 2; ++mt)
#pragma unroll
                for (int nt = 0; nt < 5; ++nt) acc[mt][nt] = __builtin_amdgcn_mfma_f32_16x16x32_bf16(af[mt], bfr[nt], acc[mt][nt], 0, 0, 0);
        }
        __syncthreads();
#pragma unroll
        for (int mt = 0; mt < 2; ++mt)
#pragma unroll
            for (int nt = 0; nt < 5; ++nt)
#pragma unroll
                for (int r = 0; r < 4; ++r) S[(32 * w + 16 * mt + kg * 4 + r) * 81 + 16 * nt + l15] = acc[mt][nt][r];
        __syncthreads();
        if (tid < 128) {
            const int dir = tid >> 6, pp = tid & 63;
            const float* a64 = (const float*)(p.ws + WS_S5A64) + ((size_t)((layer * 2 + dir) * 32 + g) * 64 + pp) * 2;
            const float ar = a64[0], ai = a64[1]; float hr = 0.f, hi = 0.f;
            bf16* hin = (bf16*)(p.ws + WS_HIN) + ((size_t)g * 272 + b * 68) * 256 + dir * 128 + pp;
            for (int k = 0; k < 68; ++k) {
                const int n = dir == 0 ? k : (k < 4 ? 3 - k : 71 - k);
                hin[(size_t)n * 256] = f2bf(hr); hin[(size_t)n * 256 + 64] = f2bf(hi);
                const float sr = S[(dir * 128 + pp) * 81 + n], si = S[(dir * 128 + 64 + pp) * 81 + n];
                const float nr = ar * hr - ai * hi + sr, ni = ar * hi + ai * hr + si; hr = nr; hi = ni;
            }
        }
    }
}
__device__ __forceinline__ void ph_s5out(const Ctx& cx, int layer, float* sm) {
    CParams& p = get_params();
    const int tid = cx.tid, lane = tid & 63, w = tid >> 6, l15 = lane & 15, kg = lane >> 4;
    const bf16* U = (const bf16*)(p.ws + WS_U); const bf16* P = (const bf16*)(p.ws + WS_S5P); const bf16* HIN = (const bf16*)(p.ws + WS_HIN);
    bf16* Kl = (bf16*)sm;
    for (int it = cx.bid; it < 256; it += cx.nb) {
        const int g = it & 31, b = (it >> 5) & 3, half = it >> 7;
        __syncthreads();
        { const u32x4* src = (const u32x4*)((const bf16*)(p.ws + WS_S5K) + (size_t)g * 127 * 256); u32x4* dst = (u32x4*)Kl;
          for (int i = tid; i < 127 * 256 / 8; i += NTHREADS) dst[i] = src[i]; }
        __syncthreads();
        f32x4 acc[4][5];
#pragma unroll
        for (int mt = 0; mt < 4; ++mt)
#pragma unroll
            for (int nt = 0; nt < 5; ++nt) acc[mt][nt] = (f32x4){0.f, 0.f, 0.f, 0.f};
        const int tau0 = 32 * half + 4 * w;
        for (int ks = 0; ks < 32; ++ks) {
            const int s = 2 * ks + (kg >> 1), i0 = 8 * (kg & 1);
            bf16x8 bfr[5];
#pragma unroll
            for (int nt = 0; nt < 5; ++nt) { const int n = 16 * nt + l15; bfr[nt] = (bf16x8){0, 0, 0, 0, 0, 0, 0, 0};
                if (n < 68) bfr[nt] = *(const bf16x8*)(U + (size_t)s5_row(b, n, s) * 512 + g * 16 + i0); }
#pragma unroll
            for (int mt = 0; mt < 4; ++mt) {
                const int lag = tau0 + mt - s;
                const bf16x8 af = *(const bf16x8*)(Kl + (lag + 63) * 256 + l15 * 16 + i0);
#pragma unroll
                for (int nt = 0; nt < 5; ++nt) acc[mt][nt] = __builtin_amdgcn_mfma_f32_16x16x32_bf16(af, bfr[nt], acc[mt][nt], 0, 0, 0);
            }
        }
#pragma unroll 1
        for (int dk = 0; dk < 8; ++dk) {
            const int dir = dk >> 2, kk = dk & 3;
            bf16x8 bfr[5];
#pragma unroll
            for (int nt = 0; nt < 5; ++nt) { const int n = 16 * nt + l15; bfr[nt] = (bf16x8){0, 0, 0, 0, 0, 0, 0, 0};
                if (n < 68) bfr[nt] = *(const bf16x8*)(HIN + ((size_t)g * 272 + b * 68 + n) * 256 + dir * 128 + 32 * kk + 8 * kg); }
#pragma unroll
            for (int mt = 0; mt < 4; ++mt) {
                const bf16x8 af = *(const bf16x8*)(P + ((((size_t)(g * 2 + dir) * 64 + tau0 + mt) * 16 + l15) * 128 + 32 * kk + 8 * kg));
#pragma unroll
                for (int nt = 0; nt < 5; ++nt) acc[mt][nt] = __builtin_amdgcn_mfma_f32_16x16x32_bf16(af, bfr[nt], acc[mt][nt], 0, 0, 0);
            }
        }
#pragma unroll
        for (int mt = 0; mt < 4; ++mt)
#pragma unroll
            for (int nt = 0; nt < 5; ++nt) { const int n = 16 * nt + l15;
                if (n < 68 && (layer == 0 || n >= 4)) { const f32x4 y = acc[mt][nt]; u32x2 o; o.x = pk2(gelu_tanh(y[0]), gelu_tanh(y[1])); o.y = pk2(gelu_tanh(y[2]), gelu_tanh(y[3]));
                    *(u32x2*)((bf16*)(p.ws + WS_S5Y) + (size_t)s5_row(b, n, tau0 + mt) * 512 + g * 16 + 4 * kg) = o; } }
    }
}

__device__ __forceinline__ void ph_glu(const Ctx& cx, int layer, PG8_LAS unsigned char* lds) {
    CParams& p = get_params();
    pg8::Gemm g; g.A = (const bf16*)(p.ws + WS_S5Y); g.Bt = (const bf16*)(p.ws + WT_GLU) + (size_t)layer * 512 * 512; g.zsA = 0; g.zsB = 0; g.K = 512;
    pg8::TileOrder S; S.nM = TL / 256; S.nN = 2; S.nwg = S.nM * S.nN; S.G = cx.nb; S.c = cx.bid; S.nz = 1; S.exN = 2; S.expn0 = 0; S.extra = layer == 0 ? 4 * 2 : 0;
    EpiGlu E; E.ws = p.ws; E.bias = p.in[I_GLUB] + layer * 512;
    pg8::gemm_phase<EpiGlu, pg8::TileOrder>(lds, g, S, E, cx.tid);
}
__device__ __forceinline__ void ph_merge(const Ctx& cx, int layer, PG8_LAS unsigned char* lds) {
    CParams& p = get_params();
    pg8::Gemm g; g.A = (const bf16*)(p.ws + WS_ATT); g.zsA = (WS_HY - WS_ATT) / 2;
    g.Bt = (const bf16*)(p.ws + WT_BR) + (size_t)(layer * 3 + 0) * 1024 * 512; g.zsB = 1024 * 512; g.K = 512;
    pg8::TileOrder S; S.nM = TL / 256; S.nN = 4; S.nwg = S.nM * S.nN; S.G = cx.nb; S.c = cx.bid; S.nz = 3; S.exN = 4; S.expn0 = 0; S.extra = layer == 0 ? 4 * 4 : 0;
    EpiMerge E; E.ws = p.ws;
    pg8::gemm_phase<EpiMerge, pg8::TileOrder>(lds, g, S, E, cx.tid);
}
__device__ __forceinline__ void ph_outproj(const Ctx& cx, int layer, PG8_LAS unsigned char* lds) {
    CParams& p = get_params();
    pg8::Gemm g; g.A = (const bf16*)(p.ws + WS_M); g.Bt = (const bf16*)(p.ws + WT_OUT) + (size_t)layer * 1024 * 1024; g.zsA = 0; g.zsB = 0; g.K = 1024;
    pg8::TileOrder S; S.nM = TL / 256; S.nN = 4; S.nwg = S.nM * S.nN; S.G = cx.nb; S.c = cx.bid; S.nz = 1; S.exN = 4; S.expn0 = 0; S.extra = layer == 0 ? 4 * 4 : 0;
    EpiOut E; E.ws = p.ws; E.layer = layer;
    pg8::gemm_phase<EpiOut, pg8::TileOrder>(lds, g, S, E, cx.tid);
}
__device__ __forceinline__ void ph_qp(const Ctx& cx, int layer, PG8_LAS unsigned char* lds) {
    CParams& p = get_params();
    pg8::Gemm g; g.A = (const bf16*)(p.ws + WS_H); g.Bt = (const bf16*)(p.ws + WT_WQ) + (size_t)layer * 2048 * 1024; g.zsA = 0; g.zsB = 0; g.K = 1024;
    pg8::TileOrder S; S.nM = TL / 256; S.nN = 8; S.nwg = S.nM * S.nN; S.G = cx.nb; S.c = cx.bid; S.nz = 1; S.exN = 8; S.expn0 = 0; S.extra = layer == 0 ? 4 * 8 : 0;
    EpiQp E; E.ws = p.ws;
    pg8::gemm_phase<EpiQp, pg8::TileOrder>(lds, g, S, E, cx.tid);
}

__device__ __forceinline__ void wave_argmax(float& v, int& i) {
#pragma unroll
    for (int o = 32; o > 0; o >>= 1) { const float ov = __shfl_xor(v, o); const int oi = __shfl_xor(i, o); if (ov > v || (ov == v && oi < i)) { v = ov; i = oi; } }
}
__device__ __forceinline__ void ph_select(const Ctx& cx, int layer) {
    CParams& p = get_params();
    const int lane = cx.tid & 63, wave = cx.tid >> 6;
    const int gw = cx.bid * NWAVES + wave, NGW = cx.nb * NWAVES;
    const int nrows = layer == 0 ? TA : TL;
    const bf16* QP = (const bf16*)(p.ws + WS_QP);
    for (int it = gw; it < nrows * 8; it += NGW) {
        const int r = it >> 3, h = it & 7;
        float tv[2]; int ti[2]; tv[0] = tv[1] = 0.f; ti[0] = ti[1] = 0;
#pragma unroll
        for (int s = 0; s < 2; ++s) {
            const unsigned qw = *(const unsigned*)(QP + (size_t)r * 2048 + (h * 2 + s) * 128 + lane * 2);
            const float q0 = __uint_as_float(qw << 16), q1 = __uint_as_float(qw & 0xffff0000u);
            const float* k0 = p.in[I_PKEYS] + ((((size_t)layer * 8 + h) * 2 + s) * 128 + lane) * 128; const float* k1 = k0 + 64 * 128;
            float s0 = 0.f, s1 = 0.f;
            for (int k4 = 0; k4 < 32; ++k4) { const f32x4 a = *(const f32x4*)(k0 + k4 * 4), bb = *(const f32x4*)(k1 + k4 * 4);
                const float qa = __shfl(q0, 2 * k4), qb = __shfl(q1, 2 * k4), qc = __shfl(q0, 2 * k4 + 1), qd = __shfl(q1, 2 * k4 + 1);
                s0 += qa * a.x + qb * a.y + qc * a.z + qd * a.w; s1 += qa * bb.x + qb * bb.y + qc * bb.z + qd * bb.w; }
            for (int j = 0; j < 16; ++j) {
                float bv; int bi; if (s0 >= s1) { bv = s0; bi = lane; } else { bv = s1; bi = lane + 64; }
                wave_argmax(bv, bi);
                if (lane == j) { tv[s] = bv; ti[s] = bi; }
                if (bi == lane) s0 = -INFINITY; else if (bi == lane + 64) s1 = -INFINITY;
            }
        }
        float cv[4]; const float va = __shfl(tv[0], lane >> 2);
#pragma unroll
        for (int q = 0; q < 4; ++q) cv[q] = va + __shfl(tv[1], (lane & 3) * 4 + q);
        float bestv = 0.f; int bestc = 0;
        for (int j = 0; j < 16; ++j) {
            float bv = cv[0]; int bi = lane * 4;
#pragma unroll
            for (int q = 1; q < 4; ++q) if (cv[q] > bv) { bv = cv[q]; bi = lane * 4 + q; }
            wave_argmax(bv, bi);
            if (lane == j) { bestv = bv; bestc = bi; }
            if ((bi >> 2) == lane) {
#pragma unroll
                for (int q = 0; q < 4; ++q) if ((bi & 3) == q) cv[q] = -INFINITY; }
        }
        const int ia = __shfl(ti[0], bestc >> 4), ib = __shfl(ti[1], bestc & 15);
        const float mx = __shfl(bestv, 0);
        const float e = lane < 16 ? __expf(bestv - mx) : 0.f;
        const float sum = wave_sum(e);
        if (lane < 16) { ((int*)(p.ws + WS_EID))[(size_t)r * 128 + h * 16 + lane] = ia * 128 + ib; ((float*)(p.ws + WS_EG))[(size_t)r * 128 + h * 16 + lane] = e / sum; }
    }
}
__device__ __forceinline__ void ph_gather(const Ctx& cx, int layer) {
    CParams& p = get_params();
    const int lane = cx.tid & 63, wave = cx.tid >> 6;
    const int gw = cx.bid * NWAVES + wave, NGW = cx.nb * NWAVES;
    const int nrows = layer == 0 ? TA : TL;
    const float* PU = p.in[I_PU] + (size_t)layer * 16384 * 1024; const float* PV = p.in[I_PV] + (size_t)layer * 16384 * 1024;
    float* X = (float*)(p.ws + WS_XCUR);
    for (int r = gw; r < nrows; r += NGW) {
        f32x4 x[4], o[4];
#pragma unroll
        for (int j = 0; j < 4; ++j) { const u32x2 w = *(const u32x2*)((const bf16*)(p.ws + WS_H) + (size_t)r * 1024 + j * 256 + lane * 4);
            x[j] = (f32x4){__uint_as_float(w.x << 16), __uint_as_float(w.x & 0xffff0000u), __uint_as_float(w.y << 16), __uint_as_float(w.y & 0xffff0000u)}; o[j] = (f32x4){0.f, 0.f, 0.f, 0.f}; }
        for (int hk = 0; hk < 128; ++hk) {
            const int e = ((const int*)(p.ws + WS_EID))[(size_t)r * 128 + hk]; const float g = ((const float*)(p.ws + WS_EG))[(size_t)r * 128 + hk];
            const float* ur = PU + (size_t)e * 1024 + lane * 4; const float* vr = PV + (size_t)e * 1024 + lane * 4;
            float d = 0.f;
#pragma unroll
            for (int j = 0; j < 4; ++j) { const f32x4 uu = *(const f32x4*)(ur + j * 256); d += x[j].x * uu.x + x[j].y * uu.y + x[j].z * uu.z + x[j].w * uu.w; }
            d = wave_sum(d);
            const float w = g * gelu_tanh(d);
#pragma unroll
            for (int j = 0; j < 4; ++j) { const f32x4 vvv = *(const f32x4*)(vr + j * 256); o[j] += w * vvv; }
        }
        const float* g2 = (const float*)(p.ws + WS_MODV) + ((size_t)layer * 5 + row_mi(r)) * 6144 + 5120;
        float ss = 0.f;
#pragma unroll
        for (int j = 0; j < 4; ++j) { const int c = j * 256 + lane * 4; f32x4 xv = *(const f32x4*)(X + (size_t)r * 1024 + c); xv += *(const f32x4*)(g2 + c) * o[j]; *(f32x4*)(X + (size_t)r * 1024 + c) = xv; o[j] = xv;
            ss += xv.x * xv.x + xv.y * xv.y + xv.z * xv.z + xv.w * xv.w; }
        if (layer == DEPTH - 1) {
            const float rs = rsqrtf(wave_sum(ss) * (1.f / DM) + NORM_EPS);
#pragma unroll
            for (int j = 0; j < 4; ++j) { const int c = j * 256 + lane * 4; *(f32x4*)(p.out + (size_t)r * 1024 + c) = o[j] * rs * *(const f32x4*)(p.in[I_FG] + c); }
        }
    }
}

constexpr int NPL = 11, NPHASE = 1 + DEPTH * NPL;
#ifndef ONLY
#define ONLY -1
#endif
#ifndef NOT
#define NOT -1
#endif
#define ON(n) ((ONLY < 0 || ONLY == (n)) && NOT != (n))
#define MKCX() Ctx cx; cx.tid = threadIdx.x; cx.bid = blockIdx.x; cx.nb = gridDim.x; asm volatile("" : "+v"(cx.tid), "+s"(cx.bid), "+s"(cx.nb))
#define IN(k) (lo <= (k) && (k) < hi)
#define SEAM(k) do { if (IN(k) && IN((k) + 1)) { XcdBarrier bar_; bar_.bar = (unsigned*)(get_params().ws + WS_CTL) + 4096; bar_.x = xb_xcc_id(); bar_.st = st; xcd_barrier(bar_); } } while (0)
template <int LAYER> __device__ __forceinline__ void layer_program(const int lo, const int hi, float* sm, PG8_LAS unsigned char* lds, volatile LAS unsigned* st) {
    constexpr int B = 1 + LAYER * NPL;
    if (IN(B + 0)) { MKCX(); if (ON(0)) { ph_norm(cx, LAYER, 0, 0); ph_filters(cx, LAYER); } } SEAM(B + 0);
    if (IN(B + 1)) { MKCX(); if (ON(1)) ph_inproj(cx, LAYER, lds); } SEAM(B + 1);
    if (IN(B + 2)) { { MKCX(); if (ON(2)) ph_attn(cx, LAYER); } { MKCX(); if (ON(20)) ph_hypre(cx, LAYER, sm); } { MKCX(); if (ON(21)) ph_s5states(cx, LAYER, sm); } } SEAM(B + 2);
    if (IN(B + 3)) { { MKCX(); if (ON(3)) ph_hyfft(cx, LAYER, sm); } { MKCX(); if (ON(31)) ph_hyconv_ctx(cx, LAYER, sm); } { MKCX(); if (ON(30)) ph_s5out(cx, LAYER, sm); } } SEAM(B + 3);
    if (IN(B + 4)) { { MKCX(); if (ON(4)) ph_glu(cx, LAYER, lds); } { MKCX(); if (ON(40)) ph_hypost(cx, LAYER, sm); } } SEAM(B + 4);
    if (IN(B + 5)) { MKCX(); if (ON(5)) ph_merge(cx, LAYER, lds); } SEAM(B + 5);
    if (IN(B + 6)) { MKCX(); if (ON(6)) ph_outproj(cx, LAYER, lds); } SEAM(B + 6);
    if (IN(B + 7)) { { MKCX(); if (ON(7)) ph_norm(cx, LAYER, 1, LAYER == DEPTH - 1); } if (LAYER + 1 < DEPTH) { MKCX(); if (ON(70)) ph_s5tables(cx, LAYER + 1); } } SEAM(B + 7);
    if (IN(B + 8)) { MKCX(); if (ON(8)) ph_qp(cx, LAYER, lds); } SEAM(B + 8);
    if (IN(B + 9)) { MKCX(); if (ON(9)) ph_select(cx, LAYER); } SEAM(B + 9);
    if (IN(B + 10)) { MKCX(); if (ON(10)) ph_gather(cx, LAYER); } SEAM(B + 10);
}
__global__ void __launch_bounds__(NTHREADS, 2) mk_fwd(Params p) {
    extern __shared__ __attribute__((aligned(16))) unsigned char lds_raw[];
    float* sm = (float*)lds_raw; PG8_LAS unsigned char* lds = (PG8_LAS unsigned char*)lds_raw;
    volatile LAS unsigned* st = (volatile LAS unsigned*)(lds + LDS_MISC);
    if (threadIdx.x < 4) st[threadIdx.x] = 0u;
    __syncthreads();
    const int lo = p.ph_lo, hi = p.ph_hi;
    if (hi - lo > 1) (void)xcd_barrier_post((unsigned*)(p.ws + WS_CTL) + 4096, st);
    if (IN(0)) { { MKCX(); if (ON(100)) ph_prologue(cx, sm); } { MKCX(); if (ON(101)) ph_convert(cx); } { MKCX(); if (ON(102)) ph_s5tables(cx, 0); } } SEAM(0);
    layer_program<0>(lo, hi, sm, lds, st);
    layer_program<1>(lo, hi, sm, lds, st);
}
}

extern "C" void kernel_launch(void* const* d_in, const int* in_sizes, int n_in, void* d_out, int out_size, void* d_ws, size_t ws_size, hipStream_t stream) {
    static int grid = 0;
    if (grid == 0) {
        if (n_in != 40 || out_size != TL * DM || ws_size < WS_END) { fprintf(stderr, "kernel_launch: unexpected shapes (n_in %d out %d ws %zu)\n", n_in, out_size, ws_size); grid = -1; return; }
        int dev = 0, cus = 0;
        if (hipGetDevice(&dev) != hipSuccess || hipDeviceGetAttribute(&cus, hipDeviceAttributeMultiprocessorCount, dev) != hipSuccess) { grid = -1; return; }
        if (hipFuncSetAttribute((const void*)mk_fwd, hipFuncAttributeMaxDynamicSharedMemorySize, LDS_BYTES) != hipSuccess) { fprintf(stderr, "kernel_launch: hipFuncSetAttribute failed\n"); grid = -1; return; }
        grid = cus;
    }
    if (grid < 0) return;
    (void)hipMemsetAsync((char*)d_ws + WS_CTL, 0, 1 * MiB, stream);
    Params a{};
    for (int i = 0; i < 40; ++i) a.in[i] = (const float*)d_in[i];
    a.out = (float*)d_out; a.ws = (unsigned char*)d_ws;
#if PER_PHASE_LAUNCH
    for (int ph = 0; ph < NPHASE; ++ph) { a.ph_lo = ph; a.ph_hi = ph + 1; hipLaunchKernelGGL(mk_fwd, dim3(grid), dim3(NTHREADS), LDS_BYTES, stream, a); }
#else
    a.ph_lo = 0; a.ph_hi = NPHASE; hipLaunchKernelGGL(mk_fwd, dim3(grid), dim3(NTHREADS), LDS_BYTES, stream, a);
#endif
}
```

```cpp
#include <hip/hip_runtime.h>
#include <stdint.h>
#include <math.h>
#include <stdio.h>

#ifndef PER_PHASE_LAUNCH
#define PER_PHASE_LAUNCH 0
#endif

namespace {
typedef unsigned short bf16;
typedef float f32x4 __attribute__((ext_vector_type(4)));
typedef unsigned u32x2 __attribute__((ext_vector_type(2)));
typedef unsigned u32x4 __attribute__((ext_vector_type(4)));
typedef short bf16x8 __attribute__((ext_vector_type(8)));
#define LAS __attribute__((address_space(3)))

constexpr int DM = 1024, NBATCH = 4, SEQ = 4096, CTXL = 256, DEPTH = 2;
constexpr int TL = NBATCH * SEQ, TC = NBATCH * CTXL, TA = TL + TC;
constexpr int INW = 5888, COL_K = 512, COL_V = 640, COL_S5 = 768, COL_HY = 1280, COL_GATE = 2816;
constexpr int NTHREADS = 512, NWAVES = 8;
constexpr float NORM_EPS = 1e-6f;
constexpr float HY_FAST = 15.350567286626973f, HY_SLOW = 3.0701134573253945f;

constexpr size_t MiB = 1u << 20;
constexpr size_t WS_CTL = 0;
constexpr size_t WS_XCUR = 1 * MiB;
constexpr size_t WS_MODV = 69 * MiB;
constexpr size_t WS_ROPE = WS_MODV + 512 * 1024;
constexpr size_t WS_S5A = 70 * MiB;
constexpr size_t WS_S5B = 70 * MiB + 256 * 1024;
constexpr size_t WS_FILT = 72 * MiB;
constexpr size_t FILT_CTX_OFF = 16 * MiB;
constexpr size_t WS_WTS = 89 * MiB;
constexpr size_t WT_IN = WS_WTS;
constexpr size_t WT_GLU = WT_IN + 23 * MiB;
constexpr size_t WT_BR = WT_GLU + 1 * MiB;
constexpr size_t WT_OUT = WT_BR + 6 * MiB;
constexpr size_t WT_WQ = WT_OUT + 4 * MiB;
constexpr size_t WT_KEYS = WT_WQ + 8 * MiB;
constexpr size_t WS_H = 132 * MiB;
constexpr size_t WS_VV = WS_H;
constexpr size_t WS_VVC = WS_H + 32 * MiB;
constexpr size_t WS_Q = 166 * MiB;
constexpr size_t WS_K = 183 * MiB;
constexpr size_t WS_V = WS_K + (size_t)TA * 128 * 2;
constexpr size_t WS_U = WS_V + (size_t)TA * 128 * 2;
constexpr size_t WS_Z = WS_U + (size_t)TA * 512 * 2;
constexpr size_t WS_QP = WS_Q;
constexpr size_t WS_G = 260 * MiB;
constexpr size_t WS_ATT = 362 * MiB;
constexpr size_t WS_HY = WS_ATT + 17 * MiB, WS_S5O = WS_HY + 17 * MiB, WS_S5Y = WS_S5O + 17 * MiB;
constexpr size_t WS_M = 430 * MiB;
constexpr size_t WS_S5TMP = WS_M;
constexpr size_t WS_S5E = WS_M;
constexpr size_t WS_S5P = WS_M + 16 * MiB;
constexpr size_t WS_S5K = WS_M + 32 * MiB;
constexpr size_t WS_S5A64 = WS_S5A + 64 * 1024;
constexpr size_t WS_X0C = 464 * MiB;
constexpr size_t WS_EID = 481 * MiB;
constexpr size_t WS_EG = WS_EID + (size_t)TA * 128 * 4;
constexpr size_t WS_PU = WS_G;
constexpr size_t WS_PV = WS_G + 32 * MiB;
constexpr size_t WS_HIN = WS_EID;
constexpr size_t WS_END = 498 * MiB;
constexpr int LDS_STAGE = 131072;
constexpr int LDS_MISC = LDS_STAGE;
constexpr int LDS_BYTES = 147456;

struct Params {
    const float* in[40];
    float* out;
    unsigned char* ws;
    int ph_lo, ph_hi;
};
enum { I_X = 0, I_C, I_CTX, I_CCTX, I_MODW, I_MODB, I_N1G, I_N2G, I_INW, I_GATEB, I_SINK, I_HSW, I_HSB, I_HW1, I_HB1, I_HF1, I_HW2, I_HB2, I_HF2, I_HW3,
       I_HBIAS, I_SARE, I_SAIM, I_SLDT, I_SBRE, I_SBIM, I_SCRE, I_SCIM, I_SD, I_GLUW, I_GLUB, I_BRA, I_BRH, I_BRS, I_OUTW, I_WQ, I_PKEYS, I_PU, I_PV, I_FG };

struct Ctx { int tid, bid, nb; };
typedef __attribute__((address_space(4))) const Params CParams;
__device__ __forceinline__ CParams& get_params() { CParams* q = (CParams*)__builtin_amdgcn_kernarg_segment_ptr(); asm volatile("" : "+s"(q)); return *q; }
__device__ __forceinline__ float bf2f(bf16 v) { return __uint_as_float((unsigned)v << 16); }
__device__ __forceinline__ bf16 f2bf(float f) { unsigned u = __float_as_uint(f); return (bf16)((u + 0x7fffu + ((u >> 16) & 1u)) >> 16); }
__device__ __forceinline__ unsigned pk2(float lo, float hi) { return (unsigned)f2bf(lo) | ((unsigned)f2bf(hi) << 16); }
__device__ __forceinline__ float wave_sum(float v) {
#pragma unroll
    for (int o = 32; o > 0; o >>= 1) v += __shfl_xor(v, o);
    return v;
}
__device__ __forceinline__ float fsin_rev(float rev) { return __builtin_amdgcn_sinf(rev); }
__device__ __forceinline__ float fcos_rev(float rev) { return __builtin_amdgcn_cosf(rev); }
__device__ __forceinline__ float fsin(float x) { return __builtin_amdgcn_sinf(x * 0.15915494309189535f); }
__device__ __forceinline__ float fcos(float x) { return __builtin_amdgcn_cosf(x * 0.15915494309189535f); }
__device__ __forceinline__ float sigmoidf_(float x) { return 1.f / (1.f + __expf(-x)); }
__device__ __forceinline__ float gelu_tanh(float x) { const float u = 0.7978845608028654f * (x + 0.044715f * x * x * x); const float e = __expf(2.f * u); return 0.5f * x * (2.f - 2.f / (e + 1.f)); }
__device__ __forceinline__ int row_mi(int r) { return r < TL ? (r >> 12) : 4; }
__device__ __forceinline__ int row_b(int r) { return r < TL ? (r >> 12) : ((r - TL) >> 8); }

#define XB_TMO      128
#define XB_XCNT(j)  (256  + 64 * (j))
#define XB_XSUB(j)  (1280 + 64 * (j))
#define XB_XGEN(j)  (2304 + 64 * (j))
#define XB_TOP      3328
#define XB_TOPGEN   3392
#define XCD_BAR_WORDS 3456
#define XB_SPIN_CAP (1u << 27)
__device__ __forceinline__ unsigned xb_ld(unsigned* p)              { return __hip_atomic_load(p, __ATOMIC_RELAXED, __HIP_MEMORY_SCOPE_AGENT); }
__device__ __forceinline__ unsigned xb_add(unsigned* p, unsigned v) { return __hip_atomic_fetch_add(p, v, __ATOMIC_RELAXED, __HIP_MEMORY_SCOPE_AGENT); }
__device__ __forceinline__ unsigned xb_xcc_id() { return (unsigned)__builtin_amdgcn_s_getreg((3 << 11) | 20) & 0xFu; }
#define XB_SPIN(cond, bar) do { unsigned _sp = 0; while (cond) { __builtin_amdgcn_s_sleep(1); \
    if ((++_sp & 255u) == 0u) { if (xb_ld(&(bar)[XB_TMO])) break; if (_sp > XB_SPIN_CAP) { atomicAdd(&(bar)[XB_TMO], 1u); break; } } } } while (0)
struct XcdBarrier { unsigned* bar; unsigned x; volatile LAS unsigned* st; };
__device__ __forceinline__ XcdBarrier xcd_barrier_post(unsigned* bar, volatile LAS unsigned* st) {
    XcdBarrier b; b.bar = bar; b.x = xb_xcc_id(); b.st = st;
    if (threadIdx.x == 0) (void)xb_add(&bar[XB_XCNT(b.x)], 1u);
    return b;
}
__device__ __forceinline__ void xcd_barrier_complete(unsigned* bar, unsigned x, unsigned& nloc, unsigned& nx) {
    const unsigned G = gridDim.x * gridDim.y * gridDim.z;
    unsigned sum, cnt, mine, sp = 0u;
    for (;;) {
        sum = 0u; cnt = 0u; mine = 0u;
#pragma unroll
        for (unsigned j = 0; j < 16; ++j) { const unsigned c = xb_ld(&bar[XB_XCNT(j)]); sum += c; cnt += (c > 0u) ? 1u : 0u; mine = (j == x) ? c : mine; }
        if (sum == G) break;
        __builtin_amdgcn_s_sleep(1);
        if ((++sp & 255u) == 0u) { if (xb_ld(&bar[XB_TMO])) break; if (sp > XB_SPIN_CAP) { atomicAdd(&bar[XB_TMO], 1u); break; } }
    }
    nloc = mine > 0u ? mine : 1u; nx = cnt > 0u ? cnt : 1u;
}
__device__ __forceinline__ void xcd_barrier(const XcdBarrier& b) {
    asm volatile("s_waitcnt vmcnt(0)" ::: "memory");
    __syncthreads();
    if (threadIdx.x == 0) {
        unsigned* bar = b.bar; asm volatile("" : "+s"(bar));
        __builtin_amdgcn_s_waitcnt(0);
        unsigned nloc = b.st[0], nx = b.st[1];
        if (nloc == 0u) { xcd_barrier_complete(bar, b.x, nloc, nx); b.st[0] = nloc; b.st[1] = nx; }
        const unsigned old = xb_add(&bar[XB_XSUB(b.x)], 1u);
        const unsigned gen = old / nloc;
        if (old + 1u == (gen + 1u) * nloc) {
            __builtin_amdgcn_fence(__ATOMIC_RELEASE, "agent");
            asm volatile("s_waitcnt vmcnt(0)" ::: "memory");
            const unsigned og = xb_add(&bar[XB_TOP], 1u);
            const unsigned tg = og / nx;
            if (og + 1u == (tg + 1u) * nx) xb_add(&bar[XB_TOPGEN], 1u);
            else XB_SPIN(xb_ld(&bar[XB_TOPGEN]) == tg, bar);
            __builtin_amdgcn_fence(__ATOMIC_ACQUIRE, "agent");
            xb_add(&bar[XB_XGEN(b.x)], 1u);
            asm volatile("s_waitcnt vmcnt(0)" ::: "memory");
        } else {
            XB_SPIN(xb_ld(&bar[XB_XGEN(b.x)]) == gen, bar);
            __builtin_amdgcn_fence(__ATOMIC_ACQUIRE, "agent");
            asm volatile("s_waitcnt vmcnt(0)" ::: "memory");
        }
    }
    __syncthreads();
}

__device__ __forceinline__ void ph_prologue(const Ctx& cx0, float* sm) {
    { CParams& p = get_params(); Ctx cx = cx0;
    const int tid = cx.tid, lane = tid & 63, wave = tid >> 6;
    const int gt = cx.bid * NTHREADS + tid, NGT = cx.nb * NTHREADS;
    const int gw = cx.bid * NWAVES + wave, NGW = cx.nb * NWAVES;
    unsigned char* ws = p.ws;
    {
        f32x4* dst = (f32x4*)(ws + WS_XCUR);
        const f32x4* sx = (const f32x4*)p.in[I_X]; const f32x4* sc = (const f32x4*)p.in[I_CTX];
        for (int i = gt; i < TL * DM / 4; i += NGT) dst[i] = sx[i];
        for (int i = gt; i < TC * DM / 4; i += NGT) dst[TL * DM / 4 + i] = sc[i];
    }
    }
    { CParams& p = get_params(); Ctx cx; cx.tid = threadIdx.x; cx.bid = blockIdx.x; cx.nb = gridDim.x; asm volatile("" : "+v"(cx.tid), "+s"(cx.bid), "+s"(cx.nb));
      const int tid = cx.tid, lane = tid & 63, wave = tid >> 6; const int gt = cx.bid * NTHREADS + tid, NGT = cx.nb * NTHREADS; const int gw = cx.bid * NWAVES + wave, NGW = cx.nb * NWAVES; unsigned char* ws = p.ws; (void)lane; (void)gt; (void)NGT; (void)gw; (void)NGW; (void)ws;
    {
        float* sil = sm;
        float* red = sm + 5 * 1024;
        bool have = false;
        for (int it = cx.bid; it < 192; it += cx.nb) {
            if (!have) {
                for (int i = tid; i < 5 * 1024; i += NTHREADS) { const float v = i < 4096 ? p.in[I_C][i] : p.in[I_CCTX][i - 4096]; sil[i] = v / (1.f + __expf(-v)); }
                have = true; __syncthreads();
            }
            const int layer = it / 96, col = (it % 96) * 64 + lane, kp = wave;
            const float* W = p.in[I_MODW] + (size_t)layer * DM * 6144 + col;
            float a0 = 0, a1 = 0, a2 = 0, a3 = 0, a4 = 0;
            for (int k = kp * 128; k < kp * 128 + 128; ++k) { const float w = W[(size_t)k * 6144]; a0 += sil[k] * w; a1 += sil[1024 + k] * w; a2 += sil[2048 + k] * w; a3 += sil[3072 + k] * w; a4 += sil[4096 + k] * w; }
            red[(kp * 5 + 0) * 64 + lane] = a0; red[(kp * 5 + 1) * 64 + lane] = a1; red[(kp * 5 + 2) * 64 + lane] = a2; red[(kp * 5 + 3) * 64 + lane] = a3; red[(kp * 5 + 4) * 64 + lane] = a4;
            __syncthreads();
            if (tid < 320) { const int j = tid >> 6; float s = 0; for (int q = 0; q < 8; ++q) s += red[(q * 5 + j) * 64 + lane];
                ((float*)(ws + WS_MODV))[((size_t)layer * 5 + j) * 6144 + col] = s + p.in[I_MODB][layer * 6144 + col]; }
            __syncthreads();
        }
    }
    }
    { CParams& p = get_params(); Ctx cx; cx.tid = threadIdx.x; cx.bid = blockIdx.x; cx.nb = gridDim.x; asm volatile("" : "+v"(cx.tid), "+s"(cx.bid), "+s"(cx.nb));
      const int tid = cx.tid, lane = tid & 63, wave = tid >> 6; const int gt = cx.bid * NTHREADS + tid, NGT = cx.nb * NTHREADS; const int gw = cx.bid * NWAVES + wave, NGW = cx.nb * NWAVES; unsigned char* ws = p.ws; (void)lane; (void)gt; (void)NGT; (void)gw; (void)NGW; (void)ws;
    for (int i = gt; i < 64 * 16; i += NGT) { const int pos = i >> 4, f = i & 15; const float ang = (float)pos * exp2f(-(float)f * (13.287712379549449f / 16.f));
        ((float*)(ws + WS_ROPE))[i * 2] = fcos(ang); ((float*)(ws + WS_ROPE))[i * 2 + 1] = fsin(ang); }
    }
    { CParams& p = get_params(); Ctx cx; cx.tid = threadIdx.x; cx.bid = blockIdx.x; cx.nb = gridDim.x; asm volatile("" : "+v"(cx.tid), "+s"(cx.bid), "+s"(cx.nb));
      const int tid = cx.tid, lane = tid & 63, wave = tid >> 6; const int gt = cx.bid * NTHREADS + tid, NGT = cx.nb * NTHREADS; const int gw = cx.bid * NWAVES + wave, NGW = cx.nb * NWAVES; unsigned char* ws = p.ws; (void)lane; (void)gt; (void)NGT; (void)gw; (void)NGW; (void)ws;
    for (int i = gt; i < 2 * 2 * 32 * 64; i += NGT) {
        const int g = (i >> 6) & 31, ld = i >> 11;
        const float are = fminf(p.in[I_SARE][i], -1e-4f), aim = p.in[I_SAIM][i];
        const float dt = __expf(p.in[I_SLDT][ld * 32 + g]);
        const float er = __expf(are * dt), abr = er * fcos(aim * dt), abi = er * fsin(aim * dt);
        const float nr = abr - 1.0f, ni = abi, den = are * are + aim * aim;
        const float cr = (nr * are + ni * aim) / den, ci = (ni * are - nr * aim) / den;
        ((float*)(ws + WS_S5A))[i * 2] = abr; ((float*)(ws + WS_S5A))[i * 2 + 1] = abi;
        for (int h = 0; h < 16; ++h) { const float br = p.in[I_SBRE][(size_t)i * 16 + h], bi = p.in[I_SBIM][(size_t)i * 16 + h];
            ((float*)(ws + WS_S5B))[((size_t)i * 16 + h) * 2] = cr * br - ci * bi; ((float*)(ws + WS_S5B))[((size_t)i * 16 + h) * 2 + 1] = cr * bi + ci * br; }
    }
    }
}


__device__ __forceinline__ void ph_filters(const Ctx& cx, int layer) {
    CParams& p = get_params();
    const int tid = cx.tid, lane = tid & 63, wave = tid >> 6; const int gw = cx.bid * NWAVES + wave, NGW = cx.nb * NWAVES; unsigned char* ws = p.ws;
    for (int it = gw; it < (SEQ + CTXL); it += NGW) {
        const int r = it, st = r >= SEQ ? 1 : 0, t = st ? r - SEQ : r, L = st ? CTXL : SEQ;
        const float tn = (float)t / (float)L;
        float z = 0.f;
        if (lane == 0) z = tn;
        else if (lane <= 16) z = fcos_rev(tn * (float)lane);
        else if (lane <= 32) z = fsin_rev(tn * (float)(lane - 16));
        const float* w1 = p.in[I_HW1] + layer * 33 * 64; const float* w2 = p.in[I_HW2] + layer * 64 * 64; const float* w3 = p.in[I_HW3] + layer * 64 * 1024;
        float a = p.in[I_HB1][layer * 64 + lane];
        for (int e = 0; e < 33; ++e) a += __shfl(z, e) * w1[e * 64 + lane];
        const float h1 = fsin(p.in[I_HF1][layer * 64 + lane] * a);
        float a2 = p.in[I_HB2][layer * 64 + lane];
        for (int j = 0; j < 64; ++j) a2 += __shfl(h1, j) * w2[j * 64 + lane];
        const float h2 = fsin(p.in[I_HF2][layer * 64 + lane] * a2);
        const float tw = (float)t / (float)(L - 1);
        float* fbase = (float*)(ws + WS_FILT + (st ? FILT_CTX_OFF : 0));
        for (int cc = 0; cc < 16; ++cc) {
            const int col = cc * 64 + lane; float f = 0.f;
            for (int j = 0; j < 64; ++j) f += __shfl(h2, j) * w3[j * 1024 + col];
            const int c = col & 511, isb = col >> 9;
            const float rate = HY_FAST + (HY_SLOW - HY_FAST) * ((float)c / 511.f);
            fbase[((size_t)isb * 512 + c) * L + t] = f * __expf(-tw * rate);
        }
    }
}
__device__ __forceinline__ void conv_T(const Ctx& cx, const float* W, int K, int N, bf16* dst, bool perm) {
    const int gt = cx.bid * NTHREADS + cx.tid, NGT = cx.nb * NTHREADS;
    for (int it = gt; it < N * (K / 8); it += NGT) {
        const int n = it % N, k0 = (it / N) * 8;
        const int sn = (perm && n < COL_V) ? ((n & ~63) + ((n & 63) >> 1) + 32 * (n & 1)) : n;
        const float* s = W + (size_t)k0 * N + sn;
        u32x4 w; w.x = pk2(s[0], s[N]); w.y = pk2(s[2 * (size_t)N], s[3 * (size_t)N]); w.z = pk2(s[4 * (size_t)N], s[5 * (size_t)N]); w.w = pk2(s[6 * (size_t)N], s[7 * (size_t)N]);
        *(u32x4*)(dst + (size_t)n * K + k0) = w;
    }
}
__device__ __forceinline__ void ph_convert(const Ctx& cx0) {
#define RELAUNDER() CParams& p = get_params(); Ctx cx; cx.tid = threadIdx.x; cx.bid = blockIdx.x; cx.nb = gridDim.x; asm volatile("" : "+v"(cx.tid), "+s"(cx.bid), "+s"(cx.nb));
#pragma unroll 1
    for (int layer = 0; layer < DEPTH; ++layer) {
        { RELAUNDER(); conv_T(cx, p.in[I_INW] + (size_t)layer * DM * INW, DM, INW, (bf16*)(p.ws + WT_IN) + (size_t)layer * INW * DM, true); }
        { RELAUNDER(); conv_T(cx, p.in[I_GLUW] + (size_t)layer * 512 * 512, 512, 512, (bf16*)(p.ws + WT_GLU) + (size_t)layer * 512 * 512, false); }
        { RELAUNDER(); conv_T(cx, p.in[I_BRA] + (size_t)layer * 512 * 1024, 512, 1024, (bf16*)(p.ws + WT_BR) + (size_t)(layer * 3 + 0) * 1024 * 512, false); }
        { RELAUNDER(); conv_T(cx, p.in[I_BRH] + (size_t)layer * 512 * 1024, 512, 1024, (bf16*)(p.ws + WT_BR) + (size_t)(layer * 3 + 1) * 1024 * 512, false); }
        { RELAUNDER(); conv_T(cx, p.in[I_BRS] + (size_t)layer * 512 * 1024, 512, 1024, (bf16*)(p.ws + WT_BR) + (size_t)(layer * 3 + 2) * 1024 * 512, false); }
        { RELAUNDER(); conv_T(cx, p.in[I_OUTW] + (size_t)layer * 1024 * 1024, 1024, 1024, (bf16*)(p.ws + WT_OUT) + (size_t)layer * 1024 * 1024, false); }
        { RELAUNDER(); conv_T(cx, p.in[I_WQ] + (size_t)layer * 1024 * 2048, 1024, 2048, (bf16*)(p.ws + WT_WQ) + (size_t)layer * 2048 * 1024, false); }
    }
    { RELAUNDER(); const int gt = cx.bid * NTHREADS + cx.tid, NGT = cx.nb * NTHREADS;
      for (int i = gt; i < 2 * 8 * 2 * 128 * 128 / 4; i += NGT) { const f32x4 v = ((const f32x4*)p.in[I_PKEYS])[i]; u32x2 w; w.x = pk2(v[0], v[1]); w.y = pk2(v[2], v[3]); ((u32x2*)(p.ws + WT_KEYS))[i] = w; } }
#undef RELAUNDER
    (void)cx0;
}

__device__ __forceinline__ void ph_norm(const Ctx& cx, int layer, int which, int nrows_lat_only) {
    CParams& p = get_params();
    const int lane = cx.tid & 63, wave = cx.tid >> 6;
    const int gw = cx.bid * NWAVES + wave, NGW = cx.nb * NWAVES;
    const float* g = p.in[which ? I_N2G : I_N1G] + layer * DM;
    const float* xc = (const float*)(p.ws + WS_XCUR);
    bf16* H = (bf16*)(p.ws + WS_H);
    const int nrows = nrows_lat_only ? TL : TA;
    for (int r = gw; r < nrows; r += NGW) {
        const float* mv = (const float*)(p.ws + WS_MODV) + ((size_t)layer * 5 + row_mi(r)) * 6144 + (which ? 3072 : 0);
        f32x4 v[4]; float s = 0.f;
#pragma unroll
        for (int j = 0; j < 4; ++j) { v[j] = *(const f32x4*)(xc + (size_t)r * DM + j * 256 + lane * 4); s += v[j].x * v[j].x + v[j].y * v[j].y + v[j].z * v[j].z + v[j].w * v[j].w; }
        const float rs = rsqrtf(wave_sum(s) * (1.f / DM) + NORM_EPS);
#pragma unroll
        for (int j = 0; j < 4; ++j) { const int c = j * 256 + lane * 4;
            const f32x4 gg = *(const f32x4*)(g + c), sh = *(const f32x4*)(mv + c), sc = *(const f32x4*)(mv + 1024 + c);
            const f32x4 y = v[j] * rs * gg; const f32x4 h = y * (1.f + sc) + sh;
            u32x2 w; w.x = pk2(h.x, h.y); w.y = pk2(h.z, h.w); *(u32x2*)(H + (size_t)r * DM + c) = w; }
    }
}


namespace pg8 {
#define PG8_LAS __attribute__((address_space(3)))
typedef unsigned short bf16_t;
typedef short bf16x8 __attribute__((ext_vector_type(8)));
constexpr int BM = 256, BK = 64, HALF = 128, HTB = HALF * BK * 2, STAGE_BYTES = 8 * HTB, NXCD = 8, WGM = 8;
__host__ __device__ __forceinline__ int lds_byte(int r, int c) { const int st = (r >> 4) * 2 + (c >> 5), rr = r & 15, cc = c & 31, ob = rr * 64 + cc * 2; return st * 1024 + (ob ^ (((ob >> 9) & 1) << 5)); }
__host__ __device__ __forceinline__ void stage_rc(int b, int& R, int& C) { const int st = b / 1024, sb = b % 1024, swz = sb ^ (((sb >> 9) & 1) << 5); R = (st >> 1) * 16 + swz / 64; C = (st & 1) * 32 + (swz % 64) / 2; }
__host__ __device__ __forceinline__ int perm32(int rho) { const int n = rho >> 4, i = rho & 15; return 8 * (i >> 2) + 4 * n + (i & 3); }
struct Unit { int pm, pn, z; };
struct Gemm { const bf16_t* A; const bf16_t* Bt; size_t zsA, zsB; int K; };
__device__ __forceinline__ const bf16_t* selA(const Gemm& g, int z) { return g.A + (size_t)z * g.zsA; }
__device__ __forceinline__ const bf16_t* selB(const Gemm& g, int z) { return g.Bt + (size_t)z * g.zsB; }
struct TileOrder {
    int nM, nN, nwg, G, c, extra, exN, expn0, nz;
    __device__ __forceinline__ bool next(int i, Unit& u) const {
        const int ti = i / nz; u.z = i - ti * nz;
        const long L = (long)ti * G + c;
        if (L < nwg) {
            int wgid = (int)L; { const int q = nwg / NXCD, r = nwg % NXCD, xcd = wgid % NXCD, off = wgid / NXCD; wgid = (xcd < r ? xcd * (q + 1) : r * (q + 1) + (xcd - r) * q) + off; }
            const int nig = WGM * nN, gid = wgid / nig, fm = gid * WGM, gsz = (nM - fm) < WGM ? (nM - fm) : WGM;
            u.pm = fm + ((wgid % nig) % gsz); u.pn = (wgid % nig) / gsz; return true;
        }
        const int e = (int)(L - nwg); if (e >= extra) return false;
        u.pm = nM + e / exN; u.pn = expn0 + e % exN; return true;
    }
};
__device__ __forceinline__ unsigned cvt_pk_bf16(float lo, float hi) { unsigned r; asm volatile("v_cvt_pk_bf16_f32 %0, %1, %2" : "=v"(r) : "v"(lo), "v"(hi)); return r; }
template <class Epi, class Sched, bool ALIGN_EPI = true, bool SP2 = true>
__device__ __forceinline__ void gemm_phase(PG8_LAS unsigned char* lds, const Gemm g, const Sched& S, const Epi& E, const int tid_) {
    const int tid = tid_, wid = __builtin_amdgcn_readfirstlane(tid >> 6), lane = tid & 63, wr = wid >> 2, wc = wid & 3, fr = lane & 15, fq = lane >> 4;
    const int K = g.K, nt = K / BK;
    unsigned voffA[2], voffB[2];
#pragma unroll
    for (int i = 0; i < 2; ++i) { int R, C; stage_rc(tid * 16 + i * 8192, R, C); const int Rb = Epi::PERM ? ((R & ~31) + perm32(R & 31)) : R;
        voffA[i] = (unsigned)(R * K + C) * 2u; voffB[i] = (unsigned)(Rb * K + C) * 2u; }
    const size_t kstep = (size_t)(BK * 2);
    const size_t hstep = (size_t)HALF * K * 2;
    const size_t tstep = 2 * hstep;
    const unsigned ldsw = (unsigned)wid * 1024u;
    const int aoff = lds_byte(wr * 64 + fr, fq * 8), boff = lds_byte(wc * 32 + fr, fq * 8);
#define PG8_SA(b, h) (((b) * 2 + (h)) * HTB)
#define PG8_SB(b, h) ((4 + (b) * 2 + (h)) * HTB)
#define PG8_STAGE(bufoff, gbase, voff) do { _Pragma("unroll") for (int _i = 0; _i < 2; ++_i) \
        __builtin_amdgcn_global_load_lds((const unsigned*)((const char*)(gbase) + (voff)[_i]), (PG8_LAS unsigned*)(lds + (bufoff) + ldsw + _i * 8192), 16, 0, 0); } while (0)
#define PG8_LDA(dst, b, h) do { _Pragma("unroll") for (int m = 0; m < 4; ++m) _Pragma("unroll") for (int k = 0; k < 2; ++k) dst[m][k] = *(const PG8_LAS bf16x8*)(lds + PG8_SA(b, h) + aoff + m * 2048 + k * 1024); } while (0)
#define PG8_LDB(dst, b, h) do { _Pragma("unroll") for (int n = 0; n < 2; ++n) _Pragma("unroll") for (int k = 0; k < 2; ++k) dst[n][k] = *(const PG8_LAS bf16x8*)(lds + PG8_SB(b, h) + boff + n * 2048 + k * 1024); } while (0)
#define PG8_MMA(ai, bj, At, Bt) do { __builtin_amdgcn_s_setprio(1); _Pragma("unroll") for (int m = 0; m < 4; ++m) _Pragma("unroll") for (int n = 0; n < 2; ++n) _Pragma("unroll") for (int k = 0; k < 2; ++k) \
        acc[ai][bj][m][n] = __builtin_amdgcn_mfma_f32_16x16x32_bf16(Bt[n][k], At[m][k], acc[ai][bj][m][n], 0, 0, 0); __builtin_amdgcn_s_setprio(0); } while (0)
#define PG8_WAIT_V(n) asm volatile("s_waitcnt vmcnt(" #n ")" ::: "memory")
#define PG8_WAIT_L(n) asm volatile("s_waitcnt lgkmcnt(" #n ")" ::: "memory")
#define PG8_BAR __builtin_amdgcn_s_barrier()
#define PG8_SCHED __builtin_amdgcn_sched_barrier(0)
    Unit cur, nxt; int ui = 0;
    if (!S.next(0, cur)) return;
    f32x4 acc[2][2][4][2];
#pragma unroll
    for (int a = 0; a < 2; ++a)
#pragma unroll
        for (int b = 0; b < 2; ++b)
#pragma unroll
            for (int m = 0; m < 4; ++m)
#pragma unroll
                for (int n = 0; n < 2; ++n) acc[a][b][m][n] = (f32x4){0.f, 0.f, 0.f, 0.f};
    bf16x8 At[4][2], B0[2][2], B1[2][2];
    const char* cA = (const char*)selA(g, cur.z) + (size_t)cur.pm * tstep; const char* cB = (const char*)selB(g, cur.z) + (size_t)cur.pn * tstep;
    if constexpr (SP2) {
        PG8_STAGE(PG8_SB(0, 0), cB, voffB); PG8_STAGE(PG8_SB(0, 1), cB + hstep, voffB); PG8_STAGE(PG8_SA(0, 0), cA, voffA); PG8_STAGE(PG8_SA(0, 1), cA + hstep, voffA);
        if (wr == 1) PG8_BAR;
        PG8_WAIT_V(2); PG8_BAR;
        PG8_STAGE(PG8_SB(1, 0), cB + kstep, voffB); PG8_STAGE(PG8_SA(1, 0), cA + kstep, voffA); PG8_STAGE(PG8_SB(1, 1), cB + hstep + kstep, voffB);
        PG8_WAIT_V(6); PG8_BAR;
    } else {
        PG8_STAGE(PG8_SB(0, 0), cB, voffB); PG8_STAGE(PG8_SA(0, 0), cA, voffA); PG8_STAGE(PG8_SB(0, 1), cB + hstep, voffB); PG8_STAGE(PG8_SA(0, 1), cA + hstep, voffA);
        if (wr == 1) PG8_BAR;
        PG8_WAIT_V(4); PG8_BAR;
        PG8_STAGE(PG8_SB(1, 0), cB + kstep, voffB); PG8_STAGE(PG8_SA(1, 0), cA + kstep, voffA); PG8_STAGE(PG8_SB(1, 1), cB + hstep + kstep, voffB);
        PG8_WAIT_V(6); PG8_BAR;
    }
    for (;;) {
        const bool has_next = S.next(ui + 1, nxt);
        const char* nA = has_next ? (const char*)selA(g, nxt.z) + (size_t)nxt.pm * tstep : cA; const char* nB = has_next ? (const char*)selB(g, nxt.z) + (size_t)nxt.pn * tstep : cB;
        for (int t = 0; t < nt; t += 2) {
            const bool last = (t == nt - 2);
            const char* a1 = cA + (size_t)(t + 1) * kstep;
            const char* a2 = last ? nA : cA + (size_t)(t + 2) * kstep; const char* b2 = last ? nB : cB + (size_t)(t + 2) * kstep;
            const char* a3 = a2 + kstep; const char* b3 = b2 + kstep;
            if constexpr (SP2) {
            PG8_LDB(B0, 0, 0); PG8_LDB(B1, 0, 1); PG8_SCHED; PG8_LDA(At, 0, 0); PG8_STAGE(PG8_SA(1, 1), a1 + hstep, voffA);
            PG8_WAIT_V(8); PG8_WAIT_L(0); PG8_BAR; PG8_MMA(0, 0, At, B0); PG8_MMA(0, 1, At, B1); PG8_BAR; PG8_SCHED;
            PG8_LDA(At, 0, 1); PG8_STAGE(PG8_SB(0, 0), b2, voffB); PG8_STAGE(PG8_SB(0, 1), b2 + hstep, voffB); PG8_STAGE(PG8_SA(0, 0), a2, voffA);
            PG8_WAIT_V(8); PG8_WAIT_L(0); PG8_BAR; PG8_MMA(1, 0, At, B0); PG8_MMA(1, 1, At, B1); PG8_BAR; PG8_SCHED;
            PG8_LDB(B0, 1, 0); PG8_LDB(B1, 1, 1); PG8_SCHED; PG8_LDA(At, 1, 0); PG8_STAGE(PG8_SA(0, 1), a2 + hstep, voffA);
            PG8_WAIT_V(8); PG8_WAIT_L(0); PG8_BAR; PG8_MMA(0, 0, At, B0); PG8_MMA(0, 1, At, B1); PG8_BAR; PG8_SCHED;
            PG8_LDA(At, 1, 1); PG8_STAGE(PG8_SB(1, 0), b3, voffB); PG8_STAGE(PG8_SB(1, 1), b3 + hstep, voffB); PG8_STAGE(PG8_SA(1, 0), a3, voffA);
            PG8_WAIT_V(8); PG8_WAIT_L(0); PG8_BAR; PG8_MMA(1, 0, At, B0); PG8_MMA(1, 1, At, B1); PG8_BAR; PG8_SCHED;
            } else {
            PG8_LDB(B0, 0, 0); PG8_SCHED; PG8_LDA(At, 0, 0); PG8_STAGE(PG8_SA(1, 1), a1 + hstep, voffA);
            PG8_WAIT_L(8); PG8_BAR; PG8_WAIT_L(0); PG8_MMA(0, 0, At, B0); PG8_BAR; PG8_SCHED;
            PG8_LDB(B1, 0, 1); PG8_STAGE(PG8_SB(0, 0), b2, voffB);
            PG8_BAR; PG8_WAIT_L(0); PG8_MMA(0, 1, At, B1); PG8_BAR;
            PG8_LDA(At, 0, 1); PG8_STAGE(PG8_SA(0, 0), a2, voffA);
            PG8_BAR; PG8_WAIT_L(0); PG8_MMA(1, 0, At, B0); PG8_BAR; PG8_SCHED;
            PG8_STAGE(PG8_SB(0, 1), b2 + hstep, voffB);
            PG8_WAIT_V(6); PG8_BAR; PG8_MMA(1, 1, At, B1); PG8_BAR;
            PG8_LDB(B0, 1, 0); PG8_SCHED; PG8_LDA(At, 1, 0); PG8_STAGE(PG8_SA(0, 1), a2 + hstep, voffA);
            PG8_WAIT_L(8); PG8_BAR; PG8_WAIT_L(0); PG8_MMA(0, 0, At, B0); PG8_BAR; PG8_SCHED;
            PG8_LDB(B1, 1, 1); PG8_STAGE(PG8_SB(1, 0), b3, voffB);
            PG8_BAR; PG8_WAIT_L(0); PG8_MMA(0, 1, At, B1); PG8_BAR;
            PG8_LDA(At, 1, 1); PG8_STAGE(PG8_SA(1, 0), a3, voffA);
            PG8_BAR; PG8_WAIT_L(0); PG8_MMA(1, 0, At, B0); PG8_BAR; PG8_SCHED;
            PG8_STAGE(PG8_SB(1, 1), b3 + hstep, voffB);
            PG8_WAIT_V(6); PG8_BAR; PG8_MMA(1, 1, At, B1); PG8_BAR;
            }
        }
        if constexpr (ALIGN_EPI) { if (wr == 0) PG8_BAR; }
        const bool keep = E(acc, cur, wr, wc, fr, fq);
        if (!has_next) break;
        if (!keep) {
#pragma unroll
        for (int a = 0; a < 2; ++a)
#pragma unroll
            for (int b = 0; b < 2; ++b)
#pragma unroll
                for (int m = 0; m < 4; ++m)
#pragma unroll
                    for (int n = 0; n < 2; ++n) acc[a][b][m][n] = (f32x4){0.f, 0.f, 0.f, 0.f};
        }
        cur = nxt; cA = nA; cB = nB; ++ui;
        if constexpr (ALIGN_EPI) { if (wr == 1) PG8_BAR; }
    }
    PG8_WAIT_V(0);
    if constexpr (!ALIGN_EPI) { if (wr == 0) PG8_BAR; }
    PG8_BAR;
#undef PG8_SA
#undef PG8_SB
#undef PG8_STAGE
#undef PG8_LDA
#undef PG8_LDB
#undef PG8_MMA
#undef PG8_WAIT_V
#undef PG8_WAIT_L
#undef PG8_BAR
#undef PG8_SCHED
}
}

__device__ __forceinline__ f32x4 bf4lo(u32x4 w) { return (f32x4){__uint_as_float(w.x << 16), __uint_as_float(w.x & 0xffff0000u), __uint_as_float(w.y << 16), __uint_as_float(w.y & 0xffff0000u)}; }
__device__ __forceinline__ f32x4 bf4hi(u32x4 w) { return (f32x4){__uint_as_float(w.z << 16), __uint_as_float(w.z & 0xffff0000u), __uint_as_float(w.w << 16), __uint_as_float(w.w & 0xffff0000u)}; }
__device__ __forceinline__ u32x4 pack8(f32x4 a, f32x4 b) { u32x4 w; w.x = pg8::cvt_pk_bf16(a[0], a[1]); w.y = pg8::cvt_pk_bf16(a[2], a[3]); w.z = pg8::cvt_pk_bf16(b[0], b[1]); w.w = pg8::cvt_pk_bf16(b[2], b[3]); return w; }
__device__ __forceinline__ f32x4 sig4(f32x4 v) { return (f32x4){sigmoidf_(v[0]), sigmoidf_(v[1]), sigmoidf_(v[2]), sigmoidf_(v[3])}; }

template <class T> __device__ __forceinline__ T* uni_ptr(T* q) { unsigned long long a = (unsigned long long)q; unsigned lo = __builtin_amdgcn_readfirstlane((unsigned)a), hi = __builtin_amdgcn_readfirstlane((unsigned)(a >> 32));
    asm volatile("" : "+s"(lo), "+s"(hi)); return (T*)(((unsigned long long)hi << 32) | lo); }
struct EpiInproj {
    static constexpr bool PERM = true;
    unsigned char* ws; const float* gate_b;
    __device__ __forceinline__ bool operator()(f32x4 (&acc)[2][2][4][2], const pg8::Unit& u, int wr, int wc, int fr_, int fq_) const {
        int fr = fr_, fq = fq_; asm volatile("" : "+v"(fr), "+v"(fq)); unsigned char* const ws = uni_ptr(this->ws);
        const int cl = wc * 32 + 8 * fq, rbase = u.pm * 256 + wr * 64 + fr;
#pragma unroll
        for (int bj = 0; bj < 2; ++bj) {
            const int c128 = u.pn * 256 + bj * 128;
            unsigned char* base; unsigned rstride, coff; int kind = 0;
            if (c128 < COL_K)         { base = ws + WS_Q; rstride = 1024; coff = (unsigned)(c128 + cl) * 2u; kind = 1; }
            else if (c128 < COL_V)    { base = ws + WS_K; rstride = 256;  coff = (unsigned)cl * 2u; kind = 1; }
            else if (c128 < COL_S5)   { base = ws + WS_V; rstride = 256;  coff = (unsigned)cl * 2u; }
            else if (c128 < COL_HY)   { base = ws + WS_U; rstride = 1024; coff = (unsigned)(c128 - COL_S5 + cl) * 2u; }
            else if (c128 < COL_GATE) { base = ws + WS_Z; rstride = 3072; coff = (unsigned)(c128 - COL_HY + cl) * 2u; }
            else                      { base = ws + WS_G; rstride = 6144; coff = (unsigned)(c128 - COL_GATE + cl) * 2u; kind = 2; }
            if (kind == 1) {
                const float* rope = (const float*)(ws + WS_ROPE) + 8 * fq;
#pragma unroll
                for (int ai = 0; ai < 2; ++ai)
#pragma unroll
                    for (int m = 0; m < 4; ++m) {
                        const int r = rbase + ai * 128 + m * 16;
                        f32x4 v0 = acc[ai][bj][m][0], v1 = acc[ai][bj][m][1];
                        if (r < TL) { const int l = r & 4095, pos = (wc & 1) ? (l & 63) : (l >> 6);
                            const f32x4 t0 = *(const f32x4*)(rope + pos * 32), t1 = *(const f32x4*)(rope + pos * 32 + 4);
                            v0 = (f32x4){v0[0] * t0[0] - v0[1] * t0[1], v0[0] * t0[1] + v0[1] * t0[0], v0[2] * t0[2] - v0[3] * t0[3], v0[2] * t0[3] + v0[3] * t0[2]};
                            v1 = (f32x4){v1[0] * t1[0] - v1[1] * t1[1], v1[0] * t1[1] + v1[1] * t1[0], v1[2] * t1[2] - v1[3] * t1[3], v1[2] * t1[3] + v1[3] * t1[2]}; }
                        *(u32x4*)(base + ((unsigned)r * rstride + coff)) = pack8(v0, v1);
                        asm volatile("" ::: "memory");
                    }
            } else if (kind == 2) {
                const float* gb = uni_ptr(gate_b) + (c128 - COL_GATE) + cl; const f32x4 b0 = *(const f32x4*)gb, b1 = *(const f32x4*)(gb + 4);
#pragma unroll
                for (int ai = 0; ai < 2; ++ai)
#pragma unroll
                    for (int m = 0; m < 4; ++m) {
                        const int r = rbase + ai * 128 + m * 16;
                        *(u32x4*)(base + ((unsigned)r * rstride + coff)) = pack8(sig4(acc[ai][bj][m][0] + b0), sig4(acc[ai][bj][m][1] + b1));
                        asm volatile("" ::: "memory");
                    }
            } else {
#pragma unroll
                for (int ai = 0; ai < 2; ++ai)
#pragma unroll
                    for (int m = 0; m < 4; ++m) {
                        const int r = rbase + ai * 128 + m * 16;
                        *(u32x4*)(base + ((unsigned)r * rstride + coff)) = pack8(acc[ai][bj][m][0], acc[ai][bj][m][1]);
                    }
            }
        }
        return false;
    }
};
struct EpiGlu {
    static constexpr bool PERM = true;
    unsigned char* ws; const float* bias;
    __device__ __forceinline__ bool operator()(f32x4 (&acc)[2][2][4][2], const pg8::Unit& u, int wr, int wc, int fr_, int fq_) const {
        int fr = fr_, fq = fq_; asm volatile("" : "+v"(fr), "+v"(fq)); unsigned char* const ws = uni_ptr(this->ws);
#pragma unroll
        for (int bj = 0; bj < 2; ++bj) { const int c = u.pn * 256 + bj * 128 + wc * 32 + 8 * fq; const f32x4 b0 = *(const f32x4*)(bias + c), b1 = *(const f32x4*)(bias + c + 4);
#pragma unroll
            for (int ai = 0; ai < 2; ++ai)
#pragma unroll
                for (int m = 0; m < 4; ++m) { const size_t o = (size_t)(u.pm * 256 + ai * 128 + wr * 64 + m * 16 + fr) * 512 + c;
                    const u32x4 yw = *(const u32x4*)((const bf16*)(ws + WS_S5Y) + o);
                    *(u32x4*)((bf16*)(ws + WS_S5O) + o) = pack8(bf4lo(yw) * sig4(acc[ai][bj][m][0] + b0), bf4hi(yw) * sig4(acc[ai][bj][m][1] + b1)); asm volatile("" ::: "memory"); } }
        return false;
    }
};
struct EpiMerge {
    static constexpr bool PERM = true;
    unsigned char* ws;
    __device__ __forceinline__ bool operator()(f32x4 (&acc)[2][2][4][2], const pg8::Unit& u, int wr, int wc, int fr_, int fq_) const {
        int fr = fr_, fq = fq_; asm volatile("" : "+v"(fr), "+v"(fq)); unsigned char* const ws = uni_ptr(this->ws);
#pragma unroll
        for (int bj = 0; bj < 2; ++bj) { const int c = u.pn * 256 + bj * 128 + wc * 32 + 8 * fq;
#pragma unroll
            for (int ai = 0; ai < 2; ++ai)
#pragma unroll
                for (int m = 0; m < 4; ++m) { const int r = u.pm * 256 + ai * 128 + wr * 64 + m * 16 + fr;
                    const bf16* gp = (const bf16*)(ws + WS_G) + (size_t)r * 3072 + u.z * 1024 + c;
                    const u32x4 g0 = *(const u32x4*)gp;
                    if (u.z < 2) { const u32x4 g1 = *(const u32x4*)(gp + 1024);
                        const f32x4 d0 = bf4lo(g1), d1 = bf4hi(g1), n0 = bf4lo(g0), n1 = bf4hi(g0);
                        acc[ai][bj][m][0] *= (f32x4){n0[0] / fmaxf(d0[0], 1e-30f), n0[1] / fmaxf(d0[1], 1e-30f), n0[2] / fmaxf(d0[2], 1e-30f), n0[3] / fmaxf(d0[3], 1e-30f)};
                        acc[ai][bj][m][1] *= (f32x4){n1[0] / fmaxf(d1[0], 1e-30f), n1[1] / fmaxf(d1[1], 1e-30f), n1[2] / fmaxf(d1[2], 1e-30f), n1[3] / fmaxf(d1[3], 1e-30f)};
                    } else *(u32x4*)((bf16*)(ws + WS_M) + (size_t)r * 1024 + c) = pack8(acc[ai][bj][m][0] * bf4lo(g0), acc[ai][bj][m][1] * bf4hi(g0));
                    asm volatile("" ::: "memory");
                } }
        return u.z < 2;
    }
};
struct EpiOut {
    static constexpr bool PERM = false;
    unsigned char* ws; int layer;
    __device__ __forceinline__ bool operator()(f32x4 (&acc)[2][2][4][2], const pg8::Unit& u, int wr, int wc, int fr_, int fq_) const {
        int fr = fr_, fq = fq_; asm volatile("" : "+v"(fr), "+v"(fq)); unsigned char* const ws = uni_ptr(this->ws);
        float* X = (float*)(ws + WS_XCUR);
#pragma unroll
        for (int ai = 0; ai < 2; ++ai)
#pragma unroll
            for (int m = 0; m < 4; ++m) { const int r = u.pm * 256 + ai * 128 + wr * 64 + m * 16 + fr;
                const float* g1 = (const float*)(ws + WS_MODV) + ((size_t)layer * 5 + row_mi(r)) * 6144 + 2048;
#pragma unroll
                for (int bj = 0; bj < 2; ++bj)
#pragma unroll
                    for (int n = 0; n < 2; ++n) { const int c = u.pn * 256 + bj * 128 + wc * 32 + n * 16 + 4 * fq; f32x4* xp = (f32x4*)(X + (size_t)r * 1024 + c);
                        *xp = *xp + *(const f32x4*)(g1 + c) * acc[ai][bj][m][n]; } asm volatile("" ::: "memory"); }
        return false;
    }
};
struct EpiQp {
    static constexpr bool PERM = true;
    unsigned char* ws;
    __device__ __forceinline__ bool operator()(f32x4 (&acc)[2][2][4][2], const pg8::Unit& u, int wr, int wc, int fr_, int fq_) const {
        int fr = fr_, fq = fq_; asm volatile("" : "+v"(fr), "+v"(fq)); unsigned char* const ws = uni_ptr(this->ws);
#pragma unroll
        for (int bj = 0; bj < 2; ++bj) { const int c = u.pn * 256 + bj * 128 + wc * 32 + 8 * fq;
#pragma unroll
            for (int ai = 0; ai < 2; ++ai)
#pragma unroll
                for (int m = 0; m < 4; ++m) *(u32x4*)((bf16*)(ws + WS_QP) + (size_t)(u.pm * 256 + ai * 128 + wr * 64 + m * 16 + fr) * 2048 + c) = pack8(acc[ai][bj][m][0], acc[ai][bj][m][1]); }
        return false;
    }
};

__device__ __forceinline__ void ph_inproj(const Ctx& cx, int layer, PG8_LAS unsigned char* lds) {
    CParams& p = get_params();
    pg8::Gemm g; g.A = (const bf16*)(p.ws + WS_H); g.Bt = (const bf16*)(p.ws + WT_IN) + (size_t)layer * INW * DM; g.zsA = 0; g.zsB = 0; g.K = DM;
    pg8::TileOrder S; S.nM = TL / 256; S.nN = INW / 256; S.nwg = S.nM * S.nN; S.G = cx.nb; S.c = cx.bid; S.nz = 1;
    if (layer == DEPTH - 1) { S.exN = 3; S.expn0 = 2; S.extra = 4 * 3; } else { S.exN = INW / 256; S.expn0 = 0; S.extra = 4 * (INW / 256); }
    EpiInproj E; E.ws = p.ws; E.gate_b = p.in[I_GATEB] + layer * 3072;
    pg8::gemm_phase<EpiInproj, pg8::TileOrder>(lds, g, S, E, cx.tid);
}

__device__ __forceinline__ void ph_attn(const Ctx& cx, int layer, float* sm) {
    CParams& p = get_params();
    const int tid = cx.tid, lane = tid & 63, w = tid >> 6, l15 = lane & 15, kg = lane >> 4;
    const bf16* Q = (const bf16*)(p.ws + WS_Q); const bf16* Kb = (const bf16*)(p.ws + WS_K); const bf16* Vb = (const bf16*)(p.ws + WS_V);
    bf16* VT = (bf16*)sm;
    constexpr int VS = 648;
    const int nitems = 256 + (layer == 0 ? 16 : 0);
    for (int it = cx.bid; it < nitems; it += cx.nb) {
        int b, kvh, qbase, wbase; bool win;
        if (it < 256) { b = it >> 6; kvh = (it >> 5) & 1; const int blk = it & 31; qbase = b * SEQ + blk * 128; wbase = blk * 128 - 128; win = true; }
        else { const int j = it - 256; b = j >> 2; kvh = (j >> 1) & 1; qbase = TL + b * CTXL + (j & 1) * 128; wbase = 0; win = false; }
        __syncthreads();
        for (int i = tid; i < 640 * 8; i += NTHREADS) { const int kk = i >> 3, c8 = i & 7; int row = -1;
            if (kk < 256) row = TL + b * CTXL + kk; else if (win) { const int pos = wbase + kk - 256; if (pos >= 0 && pos < SEQ) row = b * SEQ + pos; }
            u32x4 v = (u32x4){0u, 0u, 0u, 0u}; if (row >= 0) v = *(const u32x4*)(Vb + (size_t)row * 128 + kvh * 64 + c8 * 8);
            bf16* d = VT + (c8 * 8) * VS + kk;
            d[0] = (bf16)(v.x & 0xffffu); d[VS] = (bf16)(v.x >> 16); d[2 * VS] = (bf16)(v.y & 0xffffu); d[3 * VS] = (bf16)(v.y >> 16);
            d[4 * VS] = (bf16)(v.z & 0xffffu); d[5 * VS] = (bf16)(v.z >> 16); d[6 * VS] = (bf16)(v.w & 0xffffu); d[7 * VS] = (bf16)(v.w >> 16); }
        __syncthreads();
        const int h = kvh * 4 + (w >> 1), tok0 = (w & 1) * 64;
        bf16x8 qf[4][2];
#pragma unroll
        for (int qt = 0; qt < 4; ++qt)
#pragma unroll
            for (int ks = 0; ks < 2; ++ks) qf[qt][ks] = *(const bf16x8*)(Q + (size_t)(qbase + tok0 + 16 * qt + l15) * 512 + h * 64 + 32 * ks + 8 * kg);
        float m[4], l[4]; f32x4 O[4][4];
        const float sink = p.in[I_SINK][layer * 8 + h];
#pragma unroll
        for (int qt = 0; qt < 4; ++qt) { m[qt] = sink; l[qt] = 1.f;
#pragma unroll
            for (int dt = 0; dt < 4; ++dt) O[qt][dt] = (f32x4){0.f, 0.f, 0.f, 0.f}; }
        const int nsteps = win ? 18 : 8;
        for (int st = 0; st < nsteps; ++st) {
            const int kk0 = st < 8 ? st * 32 : 256 + tok0 + (st - 8) * 32;
            bf16x8 kf[2][2];
#pragma unroll
            for (int kt = 0; kt < 2; ++kt) { const int kk = kk0 + 16 * kt + l15; int row;
                if (kk < 256) row = TL + b * CTXL + kk; else { int pos = wbase + kk - 256; pos = pos < 0 ? 0 : (pos > SEQ - 1 ? SEQ - 1 : pos); row = b * SEQ + pos; }
#pragma unroll
                for (int ks = 0; ks < 2; ++ks) kf[kt][ks] = *(const bf16x8*)(Kb + (size_t)row * 128 + kvh * 64 + 32 * ks + 8 * kg); }
#pragma unroll
            for (int qt = 0; qt < 4; ++qt) {
                f32x4 s0 = (f32x4){0.f, 0.f, 0.f, 0.f}, s1 = s0;
                s0 = __builtin_amdgcn_mfma_f32_16x16x32_bf16(kf[0][0], qf[qt][0], s0, 0, 0, 0); s0 = __builtin_amdgcn_mfma_f32_16x16x32_bf16(kf[0][1], qf[qt][1], s0, 0, 0, 0);
                s1 = __builtin_amdgcn_mfma_f32_16x16x32_bf16(kf[1][0], qf[qt][0], s1, 0, 0, 0); s1 = __builtin_amdgcn_mfma_f32_16x16x32_bf16(kf[1][1], qf[qt][1], s1, 0, 0, 0);
                s0 *= 0.125f; s1 *= 0.125f;
                if (st >= 8) {
                    const int qpos = wbase + 128 + tok0 + 16 * qt + l15, kp0 = wbase + kk0 - 256 + 4 * kg;
#pragma unroll
                    for (int r = 0; r < 4; ++r) { const int k0 = kp0 + r, k1 = kp0 + 16 + r;
                        if (k0 < 0 || k0 >= SEQ || k0 - qpos > 128 || qpos - k0 > 128) s0[r] = -1e30f;
                        if (k1 < 0 || k1 >= SEQ || k1 - qpos > 128 || qpos - k1 > 128) s1[r] = -1e30f; }
                }
                float mx = fmaxf(fmaxf(fmaxf(s0[0], s0[1]), fmaxf(s0[2], s0[3])), fmaxf(fmaxf(s1[0], s1[1]), fmaxf(s1[2], s1[3])));
                mx = fmaxf(mx, __shfl_xor(mx, 16)); mx = fmaxf(mx, __shfl_xor(mx, 32));
                const float mn = fmaxf(m[qt], mx), f = __expf(m[qt] - mn);
                f32x4 p0, p1;
#pragma unroll
                for (int r = 0; r < 4; ++r) { p0[r] = __expf(s0[r] - mn); p1[r] = __expf(s1[r] - mn); }
                float ps = (p0[0] + p0[1]) + (p0[2] + p0[3]) + (p1[0] + p1[1]) + (p1[2] + p1[3]);
                ps += __shfl_xor(ps, 16); ps += __shfl_xor(ps, 32);
                l[qt] = l[qt] * f + ps; m[qt] = mn;
                u32x4 pw; pw.x = pk2(p0[0], p0[1]); pw.y = pk2(p0[2], p0[3]); pw.z = pk2(p1[0], p1[1]); pw.w = pk2(p1[2], p1[3]);
                const bf16x8 pf = __builtin_bit_cast(bf16x8, pw);
#pragma unroll
                for (int dt = 0; dt < 4; ++dt) {
                    const bf16* vp = VT + (16 * dt + l15) * VS + kk0 + 4 * kg;
                    u32x4 vw; const u32x2 va = *(const u32x2*)vp, vb = *(const u32x2*)(vp + 16); vw.x = va.x; vw.y = va.y; vw.z = vb.x; vw.w = vb.y;
                    O[qt][dt] = __builtin_amdgcn_mfma_f32_16x16x32_bf16(__builtin_bit_cast(bf16x8, vw), pf, O[qt][dt] * f, 0, 0, 0);
                }
            }
        }
#pragma unroll
        for (int qt = 0; qt < 4; ++qt) { const float il = 1.f / l[qt]; bf16* op = (bf16*)(p.ws + WS_ATT) + (size_t)(qbase + tok0 + 16 * qt + l15) * 512 + h * 64 + 4 * kg;
#pragma unroll
            for (int dt = 0; dt < 4; ++dt) { const f32x4 o = O[qt][dt] * il; u32x2 ww; ww.x = pk2(o[0], o[1]); ww.y = pk2(o[2], o[3]); *(u32x2*)(op + 16 * dt) = ww; } }
    }
}

__device__ __forceinline__ void ph_hypre(const Ctx& cx, int layer, float* sm) {
    CParams& p = get_params();
    const int lane = cx.tid & 63, wave = cx.tid >> 6, gw = cx.bid * NWAVES + wave, NGW = cx.nb * NWAVES;
    const bf16* Z = (const bf16*)(p.ws + WS_Z); const float* sw = p.in[I_HSW] + layer * 3 * 1536; const float* sb = p.in[I_HSB] + layer * 1536;
    float* tile = sm + wave * 4096;
    const int nlat = 4 * 64 * 8, nctx = layer == 0 ? 4 * 4 * 8 : 0;
    for (int it = gw; it < nlat + nctx; it += NGW) {
        int b, t0, L, c0, rbase; float* vvb;
        if (it < nlat) { b = it >> 9; t0 = ((it >> 3) & 63) * 64; c0 = (it & 7) * 64; L = SEQ; rbase = b * SEQ; vvb = (float*)(p.ws + WS_VV) + ((size_t)b * 512 + c0) * SEQ; }
        else { const int j = it - nlat; b = j >> 5; t0 = ((j >> 3) & 3) * 64; c0 = (j & 7) * 64; L = CTXL; rbase = TL + b * CTXL; vvb = (float*)(p.ws + WS_VVC) + ((size_t)b * 512 + c0) * CTXL; }
        const int c = c0 + lane;
        float w0[3], w1[3], w2[3], bb[3], zp[3], zc[3], zn[3];
#pragma unroll
        for (int q = 0; q < 3; ++q) { const int col = q * 512 + c; w0[q] = sw[col]; w1[q] = sw[1536 + col]; w2[q] = sw[2 * 1536 + col]; bb[q] = sb[col];
            zp[q] = t0 > 0 ? bf2f(Z[(size_t)(rbase + t0 - 1) * 1536 + col]) : 0.f; zc[q] = bf2f(Z[(size_t)(rbase + t0) * 1536 + col]); }
        for (int tt = 0; tt < 64; ++tt) {
            const int t = t0 + tt;
#pragma unroll
            for (int q = 0; q < 3; ++q) zn[q] = t + 1 < L ? bf2f(Z[(size_t)(rbase + t + 1) * 1536 + q * 512 + c]) : 0.f;
            float o[3];
#pragma unroll
            for (int q = 0; q < 3; ++q) { o[q] = bb[q] + w0[q] * zp[q] + w1[q] * zc[q] + w2[q] * zn[q]; zp[q] = zc[q]; zc[q] = zn[q]; }
            ((bf16*)(p.ws + WS_X0C))[(size_t)(rbase + t) * 512 + c] = f2bf(o[0]);
            tile[lane * 64 + (tt ^ lane)] = o[2] * o[1];
        }
        __builtin_amdgcn_s_waitcnt(0xc07f);
        for (int cc = 0; cc < 64; ++cc) vvb[(size_t)cc * L + t0 + lane] = tile[cc * 64 + (lane ^ cc)];
        __builtin_amdgcn_s_waitcnt(0xc07f);
    }
}

__device__ __forceinline__ void ph_hyconv_ctx(const Ctx& cx, int layer, float* sm) {
    CParams& p = get_params();
    const int tid = cx.tid;
    if (layer != 0) return;
    constexpr int L = CTXL;
    float* Tl = sm; float* Vl = sm + 2 * L;
    for (int it = cx.bid; it < 2048; it += cx.nb) {
        const int bc = it, b = bc >> 9, c = bc & 511;
        const float* fb = (const float*)(p.ws + WS_FILT + FILT_CTX_OFF);
        const float* hf = fb + (size_t)c * L; const float* hb = fb + ((size_t)512 + c) * L;
        const float* vv = (const float*)(p.ws + WS_VVC) + (size_t)bc * CTXL;
        __syncthreads();
        if (tid < L) { Tl[L - 1 + tid] = hf[tid]; if (tid > 0) Tl[L - 1 - tid] = hb[tid]; Vl[tid] = vv[tid]; }
        __syncthreads();
        if (tid < L) { float a = 0.f; const float* tp = Tl + (tid + L - 1);
            for (int s = 0; s < L; ++s) a += Vl[s] * tp[-s];
            const size_t o = (size_t)(TL + b * CTXL + tid) * 512 + c;
            ((bf16*)(p.ws + WS_HY))[o] = f2bf((a + Vl[tid] * p.in[I_HBIAS][layer * 512 + c]) * bf2f(((const bf16*)(p.ws + WS_X0C))[o])); }
    }
}
typedef float f32x2 __attribute__((ext_vector_type(2)));
__device__ __forceinline__ void fft_fwd(f32x2* X, int tid) {
#pragma unroll 1
    for (int s = 0; s < 13; ++s) {
        const int lh = 12 - s, half = 1 << lh;
        __syncthreads();
#pragma unroll
        for (int q = 0; q < 8; ++q) { const int j = tid + 512 * q, pos = j & (half - 1), i0 = ((j >> lh) << (lh + 1)) + pos, i1 = i0 + half;
            const float rev = (float)(pos << s) * (1.f / 8192.f); const float wc = __builtin_amdgcn_cosf(rev), ws = -__builtin_amdgcn_sinf(rev);
            const f32x2 a = X[i0], b = X[i1]; const f32x2 d = a - b;
            X[i0] = a + b; X[i1] = (f32x2){d.x * wc - d.y * ws, d.x * ws + d.y * wc}; }
    }
}
__device__ __forceinline__ void fft_inv(f32x2* X, int tid) {
#pragma unroll 1
    for (int s = 0; s < 13; ++s) {
        const int half = 1 << s;
        __syncthreads();
#pragma unroll
        for (int q = 0; q < 8; ++q) { const int j = tid + 512 * q, pos = j & (half - 1), i0 = ((j >> s) << (s + 1)) + pos, i1 = i0 + half;
            const float rev = (float)(pos << (12 - s)) * (1.f / 8192.f); const float wc = __builtin_amdgcn_cosf(rev), ws = __builtin_amdgcn_sinf(rev);
            const f32x2 a = X[i0], b0 = X[i1]; const f32x2 b = (f32x2){b0.x * wc - b0.y * ws, b0.x * ws + b0.y * wc};
            X[i0] = a + b; X[i1] = a - b; }
    }
}
__device__ __forceinline__ void ph_hyfft(const Ctx& cx, int layer, float* sm) {
    CParams& p = get_params();
    const int tid = cx.tid;
    f32x2* A = (f32x2*)sm; f32x2* B = A + 8192;
    for (int c = cx.bid; c < 512; c += cx.nb) {
        const float* hf = (const float*)(p.ws + WS_FILT) + (size_t)c * SEQ; const float* hb = (const float*)(p.ws + WS_FILT) + ((size_t)512 + c) * SEQ;
        const float bias = p.in[I_HBIAS][layer * 512 + c];
        __syncthreads();
#pragma unroll
        for (int q = 0; q < 16; ++q) { const int i = tid + 512 * q; float v = 0.f; if (i < SEQ) v = hf[i]; else if (i > SEQ) v = hb[2 * SEQ - i]; A[i] = (f32x2){v, 0.f}; }
        fft_fwd(A, tid);
#pragma unroll 1
        for (int bp = 0; bp < 2; ++bp) {
            float* v0 = (float*)(p.ws + WS_VV) + ((size_t)(2 * bp) * 512 + c) * SEQ; float* v1 = v0 + (size_t)512 * SEQ;
            float xr[8], xi[8];
            __syncthreads();
#pragma unroll
            for (int q = 0; q < 8; ++q) { const int i = tid + 512 * q; xr[q] = v0[i]; xi[q] = v1[i]; B[i] = (f32x2){xr[q], xi[q]}; B[i + SEQ] = (f32x2){0.f, 0.f}; }
            fft_fwd(B, tid);
            __syncthreads();
#pragma unroll
            for (int q = 0; q < 16; ++q) { const int i = tid + 512 * q; const f32x2 k = A[i], x = B[i]; B[i] = (f32x2){x.x * k.x - x.y * k.y, x.x * k.y + x.y * k.x}; }
            fft_inv(B, tid);
            __syncthreads();
#pragma unroll
            for (int q = 0; q < 8; ++q) { const int i = tid + 512 * q; const f32x2 y = B[i]; v0[i] = y.x * (1.f / 8192.f) + xr[q] * bias; v1[i] = y.y * (1.f / 8192.f) + xi[q] * bias; }
        }
    }
}
__device__ __forceinline__ void ph_hypost(const Ctx& cx, int layer, float* sm) {
    CParams& p = get_params();
    const int lane = cx.tid & 63, wave = cx.tid >> 6, gw = cx.bid * NWAVES + wave, NGW = cx.nb * NWAVES;
    float* tile = sm + wave * 4096;
    for (int it = gw; it < 4 * 64 * 8; it += NGW) {
        const int b = it >> 9, t0 = ((it >> 3) & 63) * 64, c0 = (it & 7) * 64;
        const float* yb = (const float*)(p.ws + WS_VV) + ((size_t)b * 512 + c0) * SEQ;
        for (int cc = 0; cc < 64; ++cc) tile[cc * 64 + (lane ^ cc)] = yb[(size_t)cc * SEQ + t0 + lane];
        __builtin_amdgcn_s_waitcnt(0xc07f);
        for (int tt = 0; tt < 64; ++tt) { const size_t o = (size_t)(b * SEQ + t0 + tt) * 512 + c0 + lane;
            ((bf16*)(p.ws + WS_HY))[o] = f2bf(tile[lane * 64 + (tt ^ lane)] * bf2f(((const bf16*)(p.ws + WS_X0C))[o])); }
        __builtin_amdgcn_s_waitcnt(0xc07f);
    }
    (void)layer;
}

struct S5Coef { float decay, theta, cr, ci; };
__device__ __forceinline__ S5Coef s5_coef(CParams& p, int ldgp  ) {
    const int ldg = ldgp >> 6;
    const float are = fminf(p.in[I_SARE][ldgp], -1e-4f), aim = p.in[I_SAIM][ldgp], dt = __expf(p.in[I_SLDT][ldg]);
    S5Coef c; c.decay = are * dt; c.theta = aim * dt;
    const float er = __expf(c.decay), abr = er * fcos(c.theta), abi = er * fsin(c.theta);
    const float nr = abr - 1.0f, ni = abi, den = are * are + aim * aim;
    c.cr = (nr * are + ni * aim) / den; c.ci = (ni * are - nr * aim) / den; return c;
}
__device__ __forceinline__ void s5_pow(const S5Coef& c, int n, float& pr, float& pi) {
    const float m = __expf(c.decay * (float)n), rev = __builtin_amdgcn_fractf(c.theta * (float)n * 0.15915494309189535f);
    pr = m * __builtin_amdgcn_cosf(rev); pi = m * __builtin_amdgcn_sinf(rev);
}
__device__ __forceinline__ void ph_s5tables(const Ctx& cx, int layer) {
    const int gt = cx.bid * NTHREADS + cx.tid, NGT = cx.nb * NTHREADS;
    {
        CParams& p = get_params(); bf16* E = (bf16*)(p.ws + WS_S5E);
        for (int it = gt; it < 32 * 2 * 64 * 64; it += NGT) {
            const int pp = it & 63, s = (it >> 6) & 63, dir = (it >> 12) & 1, g = it >> 13;
            const int ldgp = ((layer * 2 + dir) * 32 + g) * 64 + pp;
            const S5Coef c = s5_coef(p, ldgp);
            float pr, pi; s5_pow(c, dir == 0 ? 63 - s : s, pr, pi);
            const float qr = pr * c.cr - pi * c.ci, qi = pr * c.ci + pi * c.cr;
            const float* bre = p.in[I_SBRE] + (size_t)ldgp * 16; const float* bim = p.in[I_SBIM] + (size_t)ldgp * 16;
            bf16* er = E + (((size_t)(g * 2 + dir) * 128 + pp) * 1024 + s * 16); bf16* ei = er + (size_t)64 * 1024;
#pragma unroll
            for (int i = 0; i < 16; i += 2) { const float b0r = bre[i], b0i = bim[i], b1r = bre[i + 1], b1i = bim[i + 1];
                *(unsigned*)(er + i) = pk2(qr * b0r - qi * b0i, qr * b1r - qi * b1i); *(unsigned*)(ei + i) = pk2(qr * b0i + qi * b0r, qr * b1i + qi * b1r); }
            if (s == 0) { float ar, ai; s5_pow(c, 64, ar, ai); float* a64 = (float*)(p.ws + WS_S5A64) + (size_t)ldgp * 2; a64[0] = ar; a64[1] = ai; }
        }
    }
    {
        CParams& p = get_params(); bf16* P = (bf16*)(p.ws + WS_S5P);
        for (int it = gt; it < 32 * 2 * 64 * 64; it += NGT) {
            const int pp = it & 63, tau = (it >> 6) & 63, dir = (it >> 12) & 1, g = it >> 13;
            const int ldgp = ((layer * 2 + dir) * 32 + g) * 64 + pp;
            const S5Coef c = s5_coef(p, ldgp);
            float pr, pi; s5_pow(c, dir == 0 ? tau + 1 : 64 - tau, pr, pi);
            const size_t cb = ((size_t)((layer * 2 + dir) * 32 + g) * 16) * 64 + pp;
            bf16* pb = P + (((size_t)(g * 2 + dir) * 64 + tau) * 16) * 128 + pp;
#pragma unroll
            for (int o = 0; o < 16; ++o) { const float cre = p.in[I_SCRE][cb + o * 64], cim = p.in[I_SCIM][cb + o * 64];
                pb[o * 128] = f2bf(cre * pr - cim * pi); pb[o * 128 + 64] = f2bf(-(cre * pi + cim * pr)); }
        }
    }
    {
        CParams& p = get_params(); bf16* K = (bf16*)(p.ws + WS_S5K);
        for (int it = gt; it < 32 * 127 * 256; it += NGT) {
            const int i = it & 15, o = (it >> 4) & 15, dl = (it >> 8) % 127, g = (it >> 8) / 127, d = dl - 63;
            float acc = 0.f;
#pragma unroll 1
            for (int dir = 0; dir < 2; ++dir) {
                if ((dir == 0 && d < 0) || (dir == 1 && d > 0)) continue;
                const int n = d < 0 ? -d : d, base = ((layer * 2 + dir) * 32 + g) * 64;
                for (int pp = 0; pp < 64; ++pp) {
                    const S5Coef c = s5_coef(p, base + pp);
                    float pr, pi; s5_pow(c, n, pr, pi);
                    const float qr = pr * c.cr - pi * c.ci, qi = pr * c.ci + pi * c.cr;
                    const float br = p.in[I_SBRE][(size_t)(base + pp) * 16 + i], bi = p.in[I_SBIM][(size_t)(base + pp) * 16 + i];
                    const float xr = qr * br - qi * bi, xi = qr * bi + qi * br;
                    const size_t ci_ = ((size_t)((layer * 2 + dir) * 32 + g) * 16 + o) * 64 + pp;
                    acc += p.in[I_SCRE][ci_] * xr - p.in[I_SCIM][ci_] * xi;
                }
            }
            if (d == 0 && o == i) acc += p.in[I_SD][layer * 512 + g * 16 + o];
            K[it] = f2bf(acc);
        }
    }
}
__device__ __forceinline__ int s5_row(int b, int n, int s) { return n < 4 ? TL + b * CTXL + n * 64 + s : b * SEQ + (n - 4) * 64 + s; }
__device__ __forceinline__ void ph_s5states(const Ctx& cx, int layer, float* sm) {
    CParams& p = get_params();
    const int tid = cx.tid, lane = tid & 63, w = tid >> 6, l15 = lane & 15, kg = lane >> 4;
    const bf16* E = (const bf16*)(p.ws + WS_S5E); const bf16* U = (const bf16*)(p.ws + WS_U);
    float* S = sm;
    for (int it = cx.bid; it < 128; it += cx.nb) {
        const int g = it & 31, b = it >> 5;
        f32x4 acc[2][5];
#pragma unroll
        for (int mt = 0; mt < 2; ++mt)
#pragma unroll
            for (int nt = 0; nt < 5; ++nt) acc[mt][nt] = (f32x4){0.f, 0.f, 0.f, 0.f};
        const bf16* ea = E + ((size_t)g * 256 + 32 * w + l15) * 1024 + 8 * kg;
        for (int ks = 0; ks < 32; ++ks) {
            const int s = 2 * ks + (kg >> 1), i0 = 8 * (kg & 1);
            bf16x8 af[2], bfr[5];
#pragma unroll
            for (int mt = 0; mt < 2; ++mt) af[mt] = *(const bf16x8*)(ea + (size_t)mt * 16 * 1024 + ks * 32);
#pragma unroll
            for (int nt = 0; nt < 5; ++nt) { const int n = 16 * nt + l15; bfr[nt] = (bf16x8){0, 0, 0, 0, 0, 0, 0, 0};
                if (n < 68) bfr[nt] = *(const bf16x8*)(U + (size_t)s5_row(b, n, s) * 512 + g * 16 + i0); }
#pragma unroll
            for (int mt = 0; mt < 2; ++mt)
#pragma unroll
                for (int nt = 0; nt < 5; ++nt) acc[mt][nt] = __builtin_amdgcn_mfma_f32_16x16x32_bf16(af[mt], bfr[nt], acc[mt][nt], 0, 0, 0);
        }
        __syncthreads();
#pragma unroll
        for (int mt = 0; mt < 2; ++mt)
#pragma unroll
            for (int nt = 0; nt < 5; ++nt)
#pragma unroll
                for (int r = 0; r < 4; ++r) S[(32 * w + 16 * mt + kg * 4 + r) * 81 + 16 * nt + l15] = acc[mt][nt][r];
        __syncthreads();
        if (tid < 128) {
            const int dir = tid >> 6, pp = tid & 63;
            const float* a64 = (const float*)(p.ws + WS_S5A64) + ((size_t)((layer * 2 + dir) * 32 + g) * 64 + pp) * 2;
            const float ar = a64[0], ai = a64[1]; float hr = 0.f, hi = 0.f;
            bf16* hin = (bf16*)(p.ws + WS_HIN) + ((size_t)g * 272 + b * 68) * 256 + dir * 128 + pp;
            for (int k = 0; k < 68; ++k) {
                const int n = dir == 0 ? k : (k < 4 ? 3 - k : 71 - k);
                hin[(size_t)n * 256] = f2bf(hr); hin[(size_t)n * 256 + 64] = f2bf(hi);
                const float sr = S[(dir * 128 + pp) * 81 + n], si = S[(dir * 128 + 64 + pp) * 81 + n];
                const float nr = ar * hr - ai * hi + sr, ni = ar * hi + ai * hr + si; hr = nr; hi = ni;
            }
        }
    }
}
__device__ __forceinline__ void ph_s5out(const Ctx& cx, int layer, float* sm) {
    CParams& p = get_params();
    const int tid = cx.tid, lane = tid & 63, w = tid >> 6, l15 = lane & 15, kg = lane >> 4;
    const bf16* U = (const bf16*)(p.ws + WS_U); const bf16* P = (const bf16*)(p.ws + WS_S5P); const bf16* HIN = (const bf16*)(p.ws + WS_HIN);
    bf16* Kl = (bf16*)sm;
    for (int it = cx.bid; it < 256; it += cx.nb) {
        const int g = it & 31, b = (it >> 5) & 3, half = it >> 7;
        __syncthreads();
        { const u32x4* src = (const u32x4*)((const bf16*)(p.ws + WS_S5K) + (size_t)g * 127 * 256); u32x4* dst = (u32x4*)Kl;
          for (int i = tid; i < 127 * 256 / 8; i += NTHREADS) dst[i] = src[i]; }
        __syncthreads();
        f32x4 acc[4][5];
#pragma unroll
        for (int mt = 0; mt < 4; ++mt)
#pragma unroll
            for (int nt = 0; nt < 5; ++nt) acc[mt][nt] = (f32x4){0.f, 0.f, 0.f, 0.f};
        const int tau0 = 32 * half + 4 * w;
        for (int ks = 0; ks < 32; ++ks) {
            const int s = 2 * ks + (kg >> 1), i0 = 8 * (kg & 1);
            bf16x8 bfr[5];
#pragma unroll
            for (int nt = 0; nt < 5; ++nt) { const int n = 16 * nt + l15; bfr[nt] = (bf16x8){0, 0, 0, 0, 0, 0, 0, 0};
                if (n < 68) bfr[nt] = *(const bf16x8*)(U + (size_t)s5_row(b, n, s) * 512 + g * 16 + i0); }
#pragma unroll
            for (int mt = 0; mt < 4; ++mt) {
                const int lag = tau0 + mt - s;
                const bf16x8 af = *(const bf16x8*)(Kl + (lag + 63) * 256 + l15 * 16 + i0);
#pragma unroll
                for (int nt = 0; nt < 5; ++nt) acc[mt][nt] = __builtin_amdgcn_mfma_f32_16x16x32_bf16(af, bfr[nt], acc[mt][nt], 0, 0, 0);
            }
        }
#pragma unroll 1
        for (int dk = 0; dk < 8; ++dk) {
            const int dir = dk >> 2, kk = dk & 3;
            bf16x8 bfr[5];
#pragma unroll
            for (int nt = 0; nt < 5; ++nt) { const int n = 16 * nt + l15; bfr[nt] = (bf16x8){0, 0, 0, 0, 0, 0, 0, 0};
                if (n < 68) bfr[nt] = *(const bf16x8*)(HIN + ((size_t)g * 272 + b * 68 + n) * 256 + dir * 128 + 32 * kk + 8 * kg); }
#pragma unroll
            for (int mt = 0; mt < 4; ++mt) {
                const bf16x8 af = *(const bf16x8*)(P + ((((size_t)(g * 2 + dir) * 64 + tau0 + mt) * 16 + l15) * 128 + 32 * kk + 8 * kg));
#pragma unroll
                for (int nt = 0; nt < 5; ++nt) acc[mt][nt] = __builtin_amdgcn_mfma_f32_16x16x32_bf16(af, bfr[nt], acc[mt][nt], 0, 0, 0);
            }
        }
#pragma unroll
        for (int mt = 0; mt < 4; ++mt)
#pragma unroll
            for (int nt = 0; nt < 5; ++nt) { const int n = 16 * nt + l15;
                if (n < 68 && (layer == 0 || n >= 4)) { const f32x4 y = acc[mt][nt]; u32x2 o; o.x = pk2(gelu_tanh(y[0]), gelu_tanh(y[1])); o.y = pk2(gelu_tanh(y[2]), gelu_tanh(y[3]));
                    *(u32x2*)((bf16*)(p.ws + WS_S5Y) + (size_t)s5_row(b, n, tau0 + mt) * 512 + g * 16 + 4 * kg) = o; } }
    }
}

__device__ __forceinline__ void ph_glu(const Ctx& cx, int layer, PG8_LAS unsigned char* lds) {
    CParams& p = get_params();
    pg8::Gemm g; g.A = (const bf16*)(p.ws + WS_S5Y); g.Bt = (const bf16*)(p.ws + WT_GLU) + (size_t)layer * 512 * 512; g.zsA = 0; g.zsB = 0; g.K = 512;
    pg8::TileOrder S; S.nM = TL / 256; S.nN = 2; S.nwg = S.nM * S.nN; S.G = cx.nb; S.c = cx.bid; S.nz = 1; S.exN = 2; S.expn0 = 0; S.extra = layer == 0 ? 4 * 2 : 0;
    EpiGlu E; E.ws = p.ws; E.bias = p.in[I_GLUB] + layer * 512;
    pg8::gemm_phase<EpiGlu, pg8::TileOrder>(lds, g, S, E, cx.tid);
}
__device__ __forceinline__ void ph_merge(const Ctx& cx, int layer, PG8_LAS unsigned char* lds) {
    CParams& p = get_params();
    pg8::Gemm g; g.A = (const bf16*)(p.ws + WS_ATT); g.zsA = (WS_HY - WS_ATT) / 2;
    g.Bt = (const bf16*)(p.ws + WT_BR) + (size_t)(layer * 3 + 0) * 1024 * 512; g.zsB = 1024 * 512; g.K = 512;
    pg8::TileOrder S; S.nM = TL / 256; S.nN = 4; S.nwg = S.nM * S.nN; S.G = cx.nb; S.c = cx.bid; S.nz = 3; S.exN = 4; S.expn0 = 0; S.extra = layer == 0 ? 4 * 4 : 0;
    EpiMerge E; E.ws = p.ws;
    pg8::gemm_phase<EpiMerge, pg8::TileOrder>(lds, g, S, E, cx.tid);
}
__device__ __forceinline__ void ph_outproj(const Ctx& cx, int layer, PG8_LAS unsigned char* lds) {
    CParams& p = get_params();
    pg8::Gemm g; g.A = (const bf16*)(p.ws + WS_M); g.Bt = (const bf16*)(p.ws + WT_OUT) + (size_t)layer * 1024 * 1024; g.zsA = 0; g.zsB = 0; g.K = 1024;
    pg8::TileOrder S; S.nM = TL / 256; S.nN = 4; S.nwg = S.nM * S.nN; S.G = cx.nb; S.c = cx.bid; S.nz = 1; S.exN = 4; S.expn0 = 0; S.extra = layer == 0 ? 4 * 4 : 0;
    EpiOut E; E.ws = p.ws; E.layer = layer;
    pg8::gemm_phase<EpiOut, pg8::TileOrder>(lds, g, S, E, cx.tid);
}
__device__ __forceinline__ void ph_qp(const Ctx& cx, int layer, PG8_LAS unsigned char* lds) {
    CParams& p = get_params();
    pg8::Gemm g; g.A = (const bf16*)(p.ws + WS_H); g.Bt = (const bf16*)(p.ws + WT_WQ) + (size_t)layer * 2048 * 1024; g.zsA = 0; g.zsB = 0; g.K = 1024;
    pg8::TileOrder S; S.nM = TL / 256; S.nN = 8; S.nwg = S.nM * S.nN; S.G = cx.nb; S.c = cx.bid; S.nz = 1; S.exN = 8; S.expn0 = 0; S.extra = layer == 0 ? 4 * 8 : 0;
    EpiQp E; E.ws = p.ws;
    pg8::gemm_phase<EpiQp, pg8::TileOrder>(lds, g, S, E, cx.tid);
}

__device__ __forceinline__ void ph_peerconv(const Ctx& cx, int layer) {
    CParams& p = get_params();
    const int gt = cx.bid * NTHREADS + cx.tid, NGT = cx.nb * NTHREADS;
    const f32x4* su = (const f32x4*)(p.in[I_PU] + (size_t)layer * 16384 * 1024); const f32x4* sv = (const f32x4*)(p.in[I_PV] + (size_t)layer * 16384 * 1024);
    u32x2* du = (u32x2*)(p.ws + WS_PU); u32x2* dv = (u32x2*)(p.ws + WS_PV);
    for (int i = gt; i < 16384 * 1024 / 4; i += NGT) { const f32x4 a = __builtin_nontemporal_load(su + i), c = __builtin_nontemporal_load(sv + i);
        u32x2 wa, wc; wa.x = pk2(a[0], a[1]); wa.y = pk2(a[2], a[3]); wc.x = pk2(c[0], c[1]); wc.y = pk2(c[2], c[3]); du[i] = wa; dv[i] = wc; }
}
__device__ __forceinline__ unsigned mono_key(float s, unsigned lowbits, unsigned mask) { const unsigned u = __float_as_uint(s); const unsigned k = (u & 0x80000000u) ? ~u : (u | 0x80000000u); return (k & ~mask) | lowbits; }
__device__ __forceinline__ float mono_val(unsigned key, unsigned mask) { const unsigned k = (key & ~mask) | ((mask + 1u) >> 1); return __uint_as_float((k & 0x80000000u) ? (k & 0x7fffffffu) : ~k); }
#define TOP16_INSERT(t, v_) do { unsigned v__ = (v_); _Pragma("unroll") for (int k_ = 0; k_ < 16; ++k_) { const unsigned hi__ = t[k_] > v__ ? t[k_] : v__; v__ = t[k_] > v__ ? v__ : t[k_]; t[k_] = hi__; } } while (0)
__device__ __forceinline__ void top16_merge_pair(unsigned (&t)[16]) {
    unsigned c[16];
#pragma unroll
    for (int k = 0; k < 16; ++k) { const unsigned o = (unsigned)__shfl_xor((int)t[15 - k], 32); c[k] = t[k] > o ? t[k] : o; }
#pragma unroll
    for (int d = 8; d >= 1; d >>= 1)
#pragma unroll
        for (int k = 0; k < 16; ++k) if ((k & d) == 0) { const unsigned a = c[k], bb = c[k + d]; c[k] = a > bb ? a : bb; c[k + d] = a > bb ? bb : a; }
#pragma unroll
    for (int k = 0; k < 16; ++k) t[k] = c[k];
}
typedef float f32x16 __attribute__((ext_vector_type(16)));
__device__ __forceinline__ void ph_select(const Ctx& cx, int layer) {
    CParams& p = get_params();
    const int lane = cx.tid & 63, wave = cx.tid >> 6, l31 = lane & 31, hi = lane >> 5;
    const int gw = cx.bid * NWAVES + wave, NGW = cx.nb * NWAVES;
    const int nrows = layer == 0 ? TA : TL;
    const bf16* QP = (const bf16*)(p.ws + WS_QP); const bf16* KY = (const bf16*)(p.ws + WT_KEYS) + (size_t)layer * 8 * 2 * 128 * 128;
    for (int it = gw; it < (nrows / 32) * 8; it += NGW) {
        const int h = it & 7, r0 = (it >> 3) * 32;
        unsigned ab[2][16];
#pragma unroll
        for (int s = 0; s < 2; ++s) {
            const bf16* kp = KY + ((size_t)(h * 2 + s) * 128 + l31) * 128 + 8 * hi; const bf16* qp = QP + (size_t)(r0 + l31) * 2048 + (h * 2 + s) * 128 + 8 * hi;
            bf16x8 qf[8];
#pragma unroll
            for (int ks = 0; ks < 8; ++ks) qf[ks] = *(const bf16x8*)(qp + 16 * ks);
            unsigned t[16];
#pragma unroll
            for (int k = 0; k < 16; ++k) t[k] = 0u;
#pragma unroll 1
            for (int nt = 0; nt < 4; ++nt) {
                f32x16 acc;
#pragma unroll
                for (int r = 0; r < 16; ++r) acc[r] = 0.f;
#pragma unroll
                for (int ks = 0; ks < 8; ++ks) acc = __builtin_amdgcn_mfma_f32_32x32x16_bf16(*(const bf16x8*)(kp + (size_t)nt * 32 * 128 + 16 * ks), qf[ks], acc, 0, 0, 0);
#pragma unroll
                for (int r = 0; r < 16; ++r) { const int n = 32 * nt + (r & 3) + 8 * (r >> 2) + 4 * hi; TOP16_INSERT(t, mono_key(acc[r], 127u - (unsigned)n, 127u)); }
            }
            top16_merge_pair(t);
#pragma unroll
            for (int k = 0; k < 16; ++k) ab[s][k] = t[k];
        }
        float av[16], bv[16];
#pragma unroll
        for (int k = 0; k < 16; ++k) { av[k] = mono_val(ab[0][k], 127u); bv[k] = mono_val(ab[1][k], 127u); }
        unsigned t2[16];
#pragma unroll
        for (int k = 0; k < 16; ++k) t2[k] = 0u;
#define CELL(i1, j1, i2, j2) do { const float sv_ = hi ? av[i2] + bv[j2] : av[i1] + bv[j1]; const unsigned lb_ = hi ? 255u - (unsigned)((i2) * 16 + (j2)) : 255u - (unsigned)((i1) * 16 + (j1)); TOP16_INSERT(t2, mono_key(sv_, lb_, 255u)); } while (0)
        CELL(0, 0, 1, 9 - 8);  CELL(0, 1, 1, 2);  CELL(0, 2, 1, 3);  CELL(0, 3, 1, 4);  CELL(0, 4, 1, 5);  CELL(0, 5, 1, 6);  CELL(0, 6, 1, 7);  CELL(0, 7, 2, 0);
        CELL(0, 8, 2, 1);  CELL(0, 9, 2, 2);  CELL(0, 10, 2, 3); CELL(0, 11, 2, 4); CELL(0, 12, 3, 0); CELL(0, 13, 3, 1); CELL(0, 14, 3, 2); CELL(0, 15, 3, 3);
        CELL(1, 0, 4, 0);  CELL(4, 1, 4, 2);  CELL(5, 0, 5, 1);  CELL(6, 0, 6, 1);  CELL(7, 0, 7, 1);  CELL(8, 0, 9, 0);  CELL(10, 0, 11, 0); CELL(12, 0, 13, 0); CELL(14, 0, 15, 0);
#undef CELL
        top16_merge_pair(t2);
        const float v0 = mono_val(t2[0], 255u); float e[16], esum = 0.f; int eid[16];
#pragma unroll
        for (int k = 0; k < 16; ++k) { e[k] = __expf(mono_val(t2[k], 255u) - v0); esum += e[k];
            const unsigned c = 255u - (t2[k] & 255u), ci = c >> 4, cj = c & 15u; unsigned ka = ab[0][0], kb = ab[1][0];
#pragma unroll
            for (int q = 1; q < 16; ++q) { ka = ci == (unsigned)q ? ab[0][q] : ka; kb = cj == (unsigned)q ? ab[1][q] : kb; }
            eid[k] = (int)((127u - (ka & 127u)) * 128u + (127u - (kb & 127u))); }
        const float inv = 1.f / esum;
        if (hi == 0) { int* dst = (int*)(p.ws + WS_EID) + (size_t)(r0 + l31) * 128 + h * 16;
#pragma unroll
            for (int k = 0; k < 16; k += 4) *(u32x4*)(dst + k) = (u32x4){(unsigned)eid[k], (unsigned)eid[k + 1], (unsigned)eid[k + 2], (unsigned)eid[k + 3]}; }
        else { float* dst = (float*)(p.ws + WS_EG) + (size_t)(r0 + l31) * 128 + h * 16;
#pragma unroll
            for (int k = 0; k < 16; k += 4) *(f32x4*)(dst + k) = (f32x4){e[k] * inv, e[k + 1] * inv, e[k + 2] * inv, e[k + 3] * inv}; }
    }
}
__device__ __forceinline__ void ph_gather(const Ctx& cx, int layer) {
    CParams& p = get_params();
    const int lane = cx.tid & 63, wave = cx.tid >> 6;
    const int gw = cx.bid * NWAVES + wave, NGW = cx.nb * NWAVES;
    const int nrows = layer == 0 ? TA : TL;
    const bf16* PU = (const bf16*)(p.ws + WS_PU); const bf16* PV = (const bf16*)(p.ws + WS_PV);
    float* X = (float*)(p.ws + WS_XCUR);
    const int ex = ((lane >> 5) & 1) * 8 + ((lane >> 4) & 1) * 4 + ((lane >> 3) & 1) * 2 + ((lane >> 2) & 1);
    for (int r = gw; r < nrows; r += NGW) {
        f32x4 x[4], o[4];
#pragma unroll
        for (int j = 0; j < 2; ++j) { const u32x4 w = *(const u32x4*)((const bf16*)(p.ws + WS_H) + (size_t)r * 1024 + j * 512 + lane * 8); x[2 * j] = bf4lo(w); x[2 * j + 1] = bf4hi(w); }
#pragma unroll
        for (int j = 0; j < 4; ++j) o[j] = (f32x4){0.f, 0.f, 0.f, 0.f};
        const int e0 = ((const int*)(p.ws + WS_EID))[(size_t)r * 128 + lane], e1 = ((const int*)(p.ws + WS_EID))[(size_t)r * 128 + 64 + lane];
        const float g0 = ((const float*)(p.ws + WS_EG))[(size_t)r * 128 + lane], g1 = ((const float*)(p.ws + WS_EG))[(size_t)r * 128 + 64 + lane];
#pragma unroll 1
        for (int hh = 0; hh < 8; ++hh) {
            const int ev = hh < 4 ? e0 : e1; const float gv = hh < 4 ? g0 : g1; const int lb = (hh & 3) * 16;
            float d[16];
#pragma unroll
            for (int k = 0; k < 16; ++k) { const int e = __builtin_amdgcn_readlane(ev, lb + k); const bf16* ur = PU + (size_t)e * 1024 + lane * 8;
                const u32x4 w0 = *(const u32x4*)ur, w1 = *(const u32x4*)(ur + 512);
                const f32x4 a0 = bf4lo(w0) * x[0], a1 = bf4hi(w0) * x[1], a2 = bf4lo(w1) * x[2], a3 = bf4hi(w1) * x[3]; const f32x4 sacc = (a0 + a1) + (a2 + a3);
                d[k] = (sacc[0] + sacc[1]) + (sacc[2] + sacc[3]); }
            float a8[8], a4[4], a2_[2];
            { const bool bt = lane & 32;
#pragma unroll
              for (int i = 0; i < 8; ++i) { const float send = bt ? d[i] : d[i + 8], keep = bt ? d[i + 8] : d[i]; a8[i] = keep + __shfl_xor(send, 32); } }
            { const bool bt = lane & 16;
#pragma unroll
              for (int i = 0; i < 4; ++i) { const float send = bt ? a8[i] : a8[i + 4], keep = bt ? a8[i + 4] : a8[i]; a4[i] = keep + __shfl_xor(send, 16); } }
            { const bool bt = lane & 8;
#pragma unroll
              for (int i = 0; i < 2; ++i) { const float send = bt ? a4[i] : a4[i + 2], keep = bt ? a4[i + 2] : a4[i]; a2_[i] = keep + __shfl_xor(send, 8); } }
            float tot; { const bool bt = lane & 4; const float send = bt ? a2_[0] : a2_[1], keep = bt ? a2_[1] : a2_[0]; tot = keep + __shfl_xor(send, 4); }
            tot += __shfl_xor(tot, 2); tot += __shfl_xor(tot, 1);
            const float wv = __shfl(gv, lb + ex) * gelu_tanh(tot);
#pragma unroll
            for (int k = 0; k < 16; ++k) { const int e = __builtin_amdgcn_readlane(ev, lb + k);
                const float wk = __uint_as_float((unsigned)__builtin_amdgcn_readlane((int)__float_as_uint(wv), ((k & 8) ? 32 : 0) + ((k & 4) ? 16 : 0) + ((k & 2) ? 8 : 0) + ((k & 1) ? 4 : 0)));
                const bf16* vr = PV + (size_t)e * 1024 + lane * 8; const u32x4 w0 = *(const u32x4*)vr, w1 = *(const u32x4*)(vr + 512);
                o[0] += wk * bf4lo(w0); o[1] += wk * bf4hi(w0); o[2] += wk * bf4lo(w1); o[3] += wk * bf4hi(w1); }
        }
        const float* g2 = (const float*)(p.ws + WS_MODV) + ((size_t)layer * 5 + row_mi(r)) * 6144 + 5120;
        float ss = 0.f;
#pragma unroll
        for (int j = 0; j < 4; ++j) { const int c = (j >> 1) * 512 + lane * 8 + (j & 1) * 4; f32x4 xv = *(const f32x4*)(X + (size_t)r * 1024 + c); xv += *(const f32x4*)(g2 + c) * o[j]; *(f32x4*)(X + (size_t)r * 1024 + c) = xv; o[j] = xv;
            ss += xv[0] * xv[0] + xv[1] * xv[1] + xv[2] * xv[2] + xv[3] * xv[3]; }
        if (layer == DEPTH - 1) {
            const float rs = rsqrtf(wave_sum(ss) * (1.f / DM) + NORM_EPS);
#pragma unroll
            for (int j = 0; j < 4; ++j) { const int c = (j >> 1) * 512 + lane * 8 + (j & 1) * 4; *(f32x4*)(p.out + (size_t)r * 1024 + c) = o[j] * rs * *(const f32x4*)(p.in[I_FG] + c); }
        }
    }
}

constexpr int NPL = 11, NPHASE = 1 + DEPTH * NPL;
#ifndef ONLY
#define ONLY -1
#endif
#ifndef NOT
#define NOT -1
#endif
#define ON(n) ((ONLY < 0 || ONLY == (n)) && NOT != (n))
#define MKCX() Ctx cx; cx.tid = threadIdx.x; cx.bid = blockIdx.x; cx.nb = gridDim.x; asm volatile("" : "+v"(cx.tid), "+s"(cx.bid), "+s"(cx.nb))
#define IN(k) (lo <= (k) && (k) < hi)
#define SEAM(k) do { if (IN(k) && IN((k) + 1)) { XcdBarrier bar_; bar_.bar = (unsigned*)(get_params().ws + WS_CTL) + 4096; bar_.x = xb_xcc_id(); bar_.st = st; xcd_barrier(bar_); } } while (0)
template <int LAYER> __device__ __forceinline__ void layer_program(const int lo, const int hi, float* sm, PG8_LAS unsigned char* lds, volatile LAS unsigned* st) {
    constexpr int B = 1 + LAYER * NPL;
    if (IN(B + 0)) { MKCX(); if (ON(0)) { ph_norm(cx, LAYER, 0, 0); ph_filters(cx, LAYER); } } SEAM(B + 0);
    if (IN(B + 1)) { MKCX(); if (ON(1)) ph_inproj(cx, LAYER, lds); } SEAM(B + 1);
    if (IN(B + 2)) { { MKCX(); if (ON(2)) ph_attn(cx, LAYER, sm); } __syncthreads(); { MKCX(); if (ON(20)) ph_hypre(cx, LAYER, sm); } __syncthreads(); { MKCX(); if (ON(21)) ph_s5states(cx, LAYER, sm); } } SEAM(B + 2);
    if (IN(B + 3)) { { MKCX(); if (ON(3)) ph_hyfft(cx, LAYER, sm); } __syncthreads(); { MKCX(); if (ON(31)) ph_hyconv_ctx(cx, LAYER, sm); } __syncthreads(); { MKCX(); if (ON(30)) ph_s5out(cx, LAYER, sm); } } SEAM(B + 3);
    if (IN(B + 4)) { { MKCX(); if (ON(4)) ph_glu(cx, LAYER, lds); } __syncthreads(); { MKCX(); if (ON(40)) ph_hypost(cx, LAYER, sm); } } SEAM(B + 4);
    if (IN(B + 5)) { MKCX(); if (ON(5)) ph_merge(cx, LAYER, lds); } SEAM(B + 5);
    if (IN(B + 6)) { MKCX(); if (ON(6)) ph_outproj(cx, LAYER, lds); } SEAM(B + 6);
    if (IN(B + 7)) { { MKCX(); if (ON(7)) ph_norm(cx, LAYER, 1, LAYER == DEPTH - 1); } if (LAYER + 1 < DEPTH) { MKCX(); if (ON(70)) ph_s5tables(cx, LAYER + 1); } { MKCX(); if (ON(71)) ph_peerconv(cx, LAYER); } } SEAM(B + 7);
    if (IN(B + 8)) { MKCX(); if (ON(8)) ph_qp(cx, LAYER, lds); } SEAM(B + 8);
    if (IN(B + 9)) { MKCX(); if (ON(9)) ph_select(cx, LAYER); } SEAM(B + 9);
    if (IN(B + 10)) { MKCX(); if (ON(10)) ph_gather(cx, LAYER); } SEAM(B + 10);
}
__global__ void __launch_bounds__(NTHREADS, 2) mk_fwd(Params p) {
    extern __shared__ __attribute__((aligned(16))) unsigned char lds_raw[];
    float* sm = (float*)lds_raw; PG8_LAS unsigned char* lds = (PG8_LAS unsigned char*)lds_raw;
    volatile LAS unsigned* st = (volatile LAS unsigned*)(lds + LDS_MISC);
    if (threadIdx.x < 4) st[threadIdx.x] = 0u;
    __syncthreads();
    const int lo = p.ph_lo, hi = p.ph_hi;
    if (hi - lo > 1) (void)xcd_barrier_post((unsigned*)(p.ws + WS_CTL) + 4096, st);
    if (IN(0)) { { MKCX(); if (ON(100)) ph_prologue(cx, sm); } { MKCX(); if (ON(101)) ph_convert(cx); } { MKCX(); if (ON(102)) ph_s5tables(cx, 0); } } SEAM(0);
    layer_program<0>(lo, hi, sm, lds, st);
    layer_program<1>(lo, hi, sm, lds, st);
}
}

extern "C" void kernel_launch(void* const* d_in, const int* in_sizes, int n_in, void* d_out, int out_size, void* d_ws, size_t ws_size, hipStream_t stream) {
    static int grid = 0;
    if (grid == 0) {
        if (n_in != 40 || out_size != TL * DM || ws_size < WS_END) { fprintf(stderr, "kernel_launch: unexpected shapes (n_in %d out %d ws %zu)\n", n_in, out_size, ws_size); grid = -1; return; }
        int dev = 0, cus = 0;
        if (hipGetDevice(&dev) != hipSuccess || hipDeviceGetAttribute(&cus, hipDeviceAttributeMultiprocessorCount, dev) != hipSuccess) { grid = -1; return; }
        if (hipFuncSetAttribute((const void*)mk_fwd, hipFuncAttributeMaxDynamicSharedMemorySize, LDS_BYTES) != hipSuccess) { fprintf(stderr, "kernel_launch: hipFuncSetAttribute failed\n"); grid = -1; return; }
        grid = cus;
    }
    if (grid < 0) return;
    (void)hipMemsetAsync((char*)d_ws + WS_CTL, 0, 1 * MiB, stream);
    Params a{};
    for (int i = 0; i < 40; ++i) a.in[i] = (const float*)d_in[i];
    a.out = (float*)d_out; a.ws = (unsigned char*)d_ws;
#if PER_PHASE_LAUNCH
    for (int ph = 0; ph < NPHASE; ++ph) { a.ph_lo = ph; a.ph_hi = ph + 1; hipLaunchKernelGGL(mk_fwd, dim3(grid), dim3(NTHREADS), LDS_BYTES, stream, a); }
#else
    a.ph_lo = 0; a.ph_hi = NPHASE; hipLaunchKernelGGL(mk_fwd, dim3(grid), dim3(NTHREADS), LDS_BYTES, stream, a);
#endif
}
```

```cpp
#include <hip/hip_runtime.h>
#include <stdint.h>
#include <math.h>
#include <stdio.h>

#ifndef PER_PHASE_LAUNCH
#define PER_PHASE_LAUNCH 0
#endif

namespace {
typedef unsigned short bf16;
typedef float f32x4 __attribute__((ext_vector_type(4)));
typedef unsigned u32x2 __attribute__((ext_vector_type(2)));
typedef unsigned u32x4 __attribute__((ext_vector_type(4)));
typedef short bf16x8 __attribute__((ext_vector_type(8)));
#define LAS __attribute__((address_space(3)))

constexpr int DM = 1024, NBATCH = 4, SEQ = 4096, CTXL = 256, DEPTH = 2;
constexpr int TL = NBATCH * SEQ, TC = NBATCH * CTXL, TA = TL + TC;
constexpr int INW = 5888, COL_K = 512, COL_V = 640, COL_S5 = 768, COL_HY = 1280, COL_GATE = 2816;
constexpr int NTHREADS = 512, NWAVES = 8;
constexpr float NORM_EPS = 1e-6f;
constexpr float HY_FAST = 15.350567286626973f, HY_SLOW = 3.0701134573253945f;

constexpr size_t MiB = 1u << 20;
constexpr size_t WS_CTL = 0;
constexpr size_t WS_XCUR = 1 * MiB;
constexpr size_t WS_MODV = 69 * MiB;
constexpr size_t WS_ROPE = WS_MODV + 512 * 1024;
constexpr size_t WS_S5A = 70 * MiB;
constexpr size_t WS_S5B = 70 * MiB + 256 * 1024;
constexpr size_t WS_FILT = 72 * MiB;
constexpr size_t FILT_CTX_OFF = 16 * MiB;
constexpr size_t WS_WTS = 89 * MiB;
constexpr size_t WT_IN = WS_WTS;
constexpr size_t WT_GLU = WT_IN + 23 * MiB;
constexpr size_t WT_BR = WT_GLU + 1 * MiB;
constexpr size_t WT_OUT = WT_BR + 6 * MiB;
constexpr size_t WT_WQ = WT_OUT + 4 * MiB;
constexpr size_t WT_KEYS = WT_WQ + 8 * MiB;
constexpr size_t WS_H = 132 * MiB;
constexpr size_t WS_VV = WS_H;
constexpr size_t WS_VVC = WS_H + 32 * MiB;
constexpr size_t WS_Q = 166 * MiB;
constexpr size_t WS_K = 183 * MiB;
constexpr size_t WS_V = WS_K + (size_t)TA * 128 * 2;
constexpr size_t WS_U = WS_V + (size_t)TA * 128 * 2;
constexpr size_t WS_Z = WS_U + (size_t)TA * 512 * 2;
constexpr size_t WS_QP = WS_Q;
constexpr size_t WS_G = 260 * MiB;
constexpr size_t WS_ATT = 362 * MiB;
constexpr size_t WS_HY = WS_ATT + 17 * MiB, WS_S5O = WS_HY + 17 * MiB, WS_S5Y = WS_S5O + 17 * MiB;
constexpr size_t WS_M = 430 * MiB;
constexpr size_t WS_S5TMP = WS_M;
constexpr size_t WS_S5E = WS_M;
constexpr size_t WS_S5P = WS_M + 16 * MiB;
constexpr size_t WS_S5K = WS_M + 32 * MiB;
constexpr size_t WS_S5A64 = WS_S5A + 64 * 1024;
constexpr size_t WS_X0C = 464 * MiB;
constexpr size_t WS_EID = 481 * MiB;
constexpr size_t WS_EG = WS_EID + (size_t)TA * 128 * 4;
constexpr size_t WS_PU = WS_G;
constexpr size_t WS_PV = WS_G + 16 * MiB;
constexpr float PEER_SU = 512.f, PEER_SV = 64.f;
constexpr size_t WS_HIN = WS_EID;
constexpr size_t WS_END = 498 * MiB;
constexpr int LDS_STAGE = 131072;
constexpr int LDS_MISC = LDS_STAGE;
constexpr int LDS_BYTES = 147456;

struct Params {
    const float* in[40];
    float* out;
    unsigned char* ws;
    int ph_lo, ph_hi;
};
enum { I_X = 0, I_C, I_CTX, I_CCTX, I_MODW, I_MODB, I_N1G, I_N2G, I_INW, I_GATEB, I_SINK, I_HSW, I_HSB, I_HW1, I_HB1, I_HF1, I_HW2, I_HB2, I_HF2, I_HW3,
       I_HBIAS, I_SARE, I_SAIM, I_SLDT, I_SBRE, I_SBIM, I_SCRE, I_SCIM, I_SD, I_GLUW, I_GLUB, I_BRA, I_BRH, I_BRS, I_OUTW, I_WQ, I_PKEYS, I_PU, I_PV, I_FG };

struct Ctx { int tid, bid, nb; };
typedef __attribute__((address_space(4))) const Params CParams;
__device__ __forceinline__ CParams& get_params() { CParams* q = (CParams*)__builtin_amdgcn_kernarg_segment_ptr(); asm volatile("" : "+s"(q)); return *q; }
__device__ __forceinline__ float bf2f(bf16 v) { return __uint_as_float((unsigned)v << 16); }
__device__ __forceinline__ bf16 f2bf(float f) { unsigned u = __float_as_uint(f); return (bf16)((u + 0x7fffu + ((u >> 16) & 1u)) >> 16); }
__device__ __forceinline__ unsigned pk2(float lo, float hi) { return (unsigned)f2bf(lo) | ((unsigned)f2bf(hi) << 16); }
__device__ __forceinline__ float wave_sum(float v) {
#pragma unroll
    for (int o = 32; o > 0; o >>= 1) v += __shfl_xor(v, o);
    return v;
}
__device__ __forceinline__ float fsin_rev(float rev) { return __builtin_amdgcn_sinf(rev); }
__device__ __forceinline__ float fcos_rev(float rev) { return __builtin_amdgcn_cosf(rev); }
__device__ __forceinline__ float fsin(float x) { return __builtin_amdgcn_sinf(x * 0.15915494309189535f); }
__device__ __forceinline__ float fcos(float x) { return __builtin_amdgcn_cosf(x * 0.15915494309189535f); }
__device__ __forceinline__ float sigmoidf_(float x) { return 1.f / (1.f + __expf(-x)); }
__device__ __forceinline__ float gelu_tanh(float x) { const float u = 0.7978845608028654f * (x + 0.044715f * x * x * x); const float e = __expf(2.f * u); return 0.5f * x * (2.f - 2.f / (e + 1.f)); }
__device__ __forceinline__ int row_mi(int r) { return r < TL ? (r >> 12) : 4; }
__device__ __forceinline__ int row_b(int r) { return r < TL ? (r >> 12) : ((r - TL) >> 8); }

#define XB_TMO      128
#define XB_XCNT(j)  (256  + 64 * (j))
#define XB_XSUB(j)  (1280 + 64 * (j))
#define XB_XGEN(j)  (2304 + 64 * (j))
#define XB_TOP      3328
#define XB_TOPGEN   3392
#define XCD_BAR_WORDS 3456
#define XB_SPIN_CAP (1u << 27)
__device__ __forceinline__ unsigned xb_ld(unsigned* p)              { return __hip_atomic_load(p, __ATOMIC_RELAXED, __HIP_MEMORY_SCOPE_AGENT); }
__device__ __forceinline__ unsigned xb_add(unsigned* p, unsigned v) { return __hip_atomic_fetch_add(p, v, __ATOMIC_RELAXED, __HIP_MEMORY_SCOPE_AGENT); }
__device__ __forceinline__ unsigned xb_xcc_id() { return (unsigned)__builtin_amdgcn_s_getreg((3 << 11) | 20) & 0xFu; }
#define XB_SPIN(cond, bar) do { unsigned _sp = 0; while (cond) { __builtin_amdgcn_s_sleep(1); \
    if ((++_sp & 255u) == 0u) { if (xb_ld(&(bar)[XB_TMO])) break; if (_sp > XB_SPIN_CAP) { atomicAdd(&(bar)[XB_TMO], 1u); break; } } } } while (0)
struct XcdBarrier { unsigned* bar; unsigned x; volatile LAS unsigned* st; };
__device__ __forceinline__ XcdBarrier xcd_barrier_post(unsigned* bar, volatile LAS unsigned* st) {
    XcdBarrier b; b.bar = bar; b.x = xb_xcc_id(); b.st = st;
    if (threadIdx.x == 0) (void)xb_add(&bar[XB_XCNT(b.x)], 1u);
    return b;
}
__device__ __forceinline__ void xcd_barrier_complete(unsigned* bar, unsigned x, unsigned& nloc, unsigned& nx) {
    const unsigned G = gridDim.x * gridDim.y * gridDim.z;
    unsigned sum, cnt, mine, sp = 0u;
    for (;;) {
        sum = 0u; cnt = 0u; mine = 0u;
#pragma unroll
        for (unsigned j = 0; j < 16; ++j) { const unsigned c = xb_ld(&bar[XB_XCNT(j)]); sum += c; cnt += (c > 0u) ? 1u : 0u; mine = (j == x) ? c : mine; }
        if (sum == G) break;
        __builtin_amdgcn_s_sleep(1);
        if ((++sp & 255u) == 0u) { if (xb_ld(&bar[XB_TMO])) break; if (sp > XB_SPIN_CAP) { atomicAdd(&bar[XB_TMO], 1u); break; } }
    }
    nloc = mine > 0u ? mine : 1u; nx = cnt > 0u ? cnt : 1u;
}
__device__ __forceinline__ void xcd_barrier(const XcdBarrier& b) {
    asm volatile("s_waitcnt vmcnt(0)" ::: "memory");
    __syncthreads();
    if (threadIdx.x == 0) {
        unsigned* bar = b.bar; asm volatile("" : "+s"(bar));
        __builtin_amdgcn_s_waitcnt(0);
        unsigned nloc = b.st[0], nx = b.st[1];
        if (nloc == 0u) { xcd_barrier_complete(bar, b.x, nloc, nx); b.st[0] = nloc; b.st[1] = nx; }
        const unsigned old = xb_add(&bar[XB_XSUB(b.x)], 1u);
        const unsigned gen = old / nloc;
        if (old + 1u == (gen + 1u) * nloc) {
            __builtin_amdgcn_fence(__ATOMIC_RELEASE, "agent");
            asm volatile("s_waitcnt vmcnt(0)" ::: "memory");
            const unsigned og = xb_add(&bar[XB_TOP], 1u);
            const unsigned tg = og / nx;
            if (og + 1u == (tg + 1u) * nx) xb_add(&bar[XB_TOPGEN], 1u);
            else XB_SPIN(xb_ld(&bar[XB_TOPGEN]) == tg, bar);
            __builtin_amdgcn_fence(__ATOMIC_ACQUIRE, "agent");
            xb_add(&bar[XB_XGEN(b.x)], 1u);
            asm volatile("s_waitcnt vmcnt(0)" ::: "memory");
        } else {
            XB_SPIN(xb_ld(&bar[XB_XGEN(b.x)]) == gen, bar);
            __builtin_amdgcn_fence(__ATOMIC_ACQUIRE, "agent");
            asm volatile("s_waitcnt vmcnt(0)" ::: "memory");
        }
    }
    __syncthreads();
}

__device__ __forceinline__ void ph_prologue(const Ctx& cx0, float* sm) {
    { CParams& p = get_params(); Ctx cx = cx0;
    const int tid = cx.tid, lane = tid & 63, wave = tid >> 6;
    const int gt = cx.bid * NTHREADS + tid, NGT = cx.nb * NTHREADS;
    const int gw = cx.bid * NWAVES + wave, NGW = cx.nb * NWAVES;
    unsigned char* ws = p.ws;
    {
        f32x4* dst = (f32x4*)(ws + WS_XCUR);
        const f32x4* sx = (const f32x4*)p.in[I_X]; const f32x4* sc = (const f32x4*)p.in[I_CTX];
        for (int i = gt; i < TL * DM / 4; i += NGT) dst[i] = sx[i];
        for (int i = gt; i < TC * DM / 4; i += NGT) dst[TL * DM / 4 + i] = sc[i];
    }
    }
    { CParams& p = get_params(); Ctx cx; cx.tid = threadIdx.x; cx.bid = blockIdx.x; cx.nb = gridDim.x; asm volatile("" : "+v"(cx.tid), "+s"(cx.bid), "+s"(cx.nb));
      const int tid = cx.tid, lane = tid & 63, wave = tid >> 6; const int gt = cx.bid * NTHREADS + tid, NGT = cx.nb * NTHREADS; const int gw = cx.bid * NWAVES + wave, NGW = cx.nb * NWAVES; unsigned char* ws = p.ws; (void)lane; (void)gt; (void)NGT; (void)gw; (void)NGW; (void)ws;
    {
        float* sil = sm;
        float* red = sm + 5 * 1024;
        bool have = false;
        for (int it = cx.bid; it < 192; it += cx.nb) {
            if (!have) {
                for (int i = tid; i < 5 * 1024; i += NTHREADS) { const float v = i < 4096 ? p.in[I_C][i] : p.in[I_CCTX][i - 4096]; sil[i] = v / (1.f + __expf(-v)); }
                have = true; __syncthreads();
            }
            const int layer = it / 96, col = (it % 96) * 64 + lane, kp = wave;
            const float* W = p.in[I_MODW] + (size_t)layer * DM * 6144 + col;
            float a0 = 0, a1 = 0, a2 = 0, a3 = 0, a4 = 0;
            for (int k = kp * 128; k < kp * 128 + 128; ++k) { const float w = W[(size_t)k * 6144]; a0 += sil[k] * w; a1 += sil[1024 + k] * w; a2 += sil[2048 + k] * w; a3 += sil[3072 + k] * w; a4 += sil[4096 + k] * w; }
            red[(kp * 5 + 0) * 64 + lane] = a0; red[(kp * 5 + 1) * 64 + lane] = a1; red[(kp * 5 + 2) * 64 + lane] = a2; red[(kp * 5 + 3) * 64 + lane] = a3; red[(kp * 5 + 4) * 64 + lane] = a4;
            __syncthreads();
            if (tid < 320) { const int j = tid >> 6; float s = 0; for (int q = 0; q < 8; ++q) s += red[(q * 5 + j) * 64 + lane];
                ((float*)(ws + WS_MODV))[((size_t)layer * 5 + j) * 6144 + col] = s + p.in[I_MODB][layer * 6144 + col]; }
            __syncthreads();
        }
    }
    }
    { CParams& p = get_params(); Ctx cx; cx.tid = threadIdx.x; cx.bid = blockIdx.x; cx.nb = gridDim.x; asm volatile("" : "+v"(cx.tid), "+s"(cx.bid), "+s"(cx.nb));
      const int tid = cx.tid, lane = tid & 63, wave = tid >> 6; const int gt = cx.bid * NTHREADS + tid, NGT = cx.nb * NTHREADS; const int gw = cx.bid * NWAVES + wave, NGW = cx.nb * NWAVES; unsigned char* ws = p.ws; (void)lane; (void)gt; (void)NGT; (void)gw; (void)NGW; (void)ws;
    for (int i = gt; i < 64 * 16; i += NGT) { const int pos = i >> 4, f = i & 15; const float ang = (float)pos * exp2f(-(float)f * (13.287712379549449f / 16.f));
        ((float*)(ws + WS_ROPE))[i * 2] = fcos(ang); ((float*)(ws + WS_ROPE))[i * 2 + 1] = fsin(ang); }
    }
    { CParams& p = get_params(); Ctx cx; cx.tid = threadIdx.x; cx.bid = blockIdx.x; cx.nb = gridDim.x; asm volatile("" : "+v"(cx.tid), "+s"(cx.bid), "+s"(cx.nb));
      const int tid = cx.tid, lane = tid & 63, wave = tid >> 6; const int gt = cx.bid * NTHREADS + tid, NGT = cx.nb * NTHREADS; const int gw = cx.bid * NWAVES + wave, NGW = cx.nb * NWAVES; unsigned char* ws = p.ws; (void)lane; (void)gt; (void)NGT; (void)gw; (void)NGW; (void)ws;
    for (int i = gt; i < 2 * 2 * 32 * 64; i += NGT) {
        const int g = (i >> 6) & 31, ld = i >> 11;
        const float are = fminf(p.in[I_SARE][i], -1e-4f), aim = p.in[I_SAIM][i];
        const float dt = __expf(p.in[I_SLDT][ld * 32 + g]);
        const float er = __expf(are * dt), abr = er * fcos(aim * dt), abi = er * fsin(aim * dt);
        const float nr = abr - 1.0f, ni = abi, den = are * are + aim * aim;
        const float cr = (nr * are + ni * aim) / den, ci = (ni * are - nr * aim) / den;
        ((float*)(ws + WS_S5A))[i * 2] = abr; ((float*)(ws + WS_S5A))[i * 2 + 1] = abi;
        for (int h = 0; h < 16; ++h) { const float br = p.in[I_SBRE][(size_t)i * 16 + h], bi = p.in[I_SBIM][(size_t)i * 16 + h];
            ((float*)(ws + WS_S5B))[((size_t)i * 16 + h) * 2] = cr * br - ci * bi; ((float*)(ws + WS_S5B))[((size_t)i * 16 + h) * 2 + 1] = cr * bi + ci * br; }
    }
    }
}


__device__ __forceinline__ void ph_filters(const Ctx& cx, int layer) {
    CParams& p = get_params();
    const int tid = cx.tid, lane = tid & 63, wave = tid >> 6; const int gw = cx.bid * NWAVES + wave, NGW = cx.nb * NWAVES; unsigned char* ws = p.ws;
    for (int it = gw; it < (SEQ + CTXL); it += NGW) {
        const int r = it, st = r >= SEQ ? 1 : 0, t = st ? r - SEQ : r, L = st ? CTXL : SEQ;
        const float tn = (float)t / (float)L;
        float z = 0.f;
        if (lane == 0) z = tn;
        else if (lane <= 16) z = fcos_rev(tn * (float)lane);
        else if (lane <= 32) z = fsin_rev(tn * (float)(lane - 16));
        const float* w1 = p.in[I_HW1] + layer * 33 * 64; const float* w2 = p.in[I_HW2] + layer * 64 * 64; const float* w3 = p.in[I_HW3] + layer * 64 * 1024;
        float a = p.in[I_HB1][layer * 64 + lane];
        for (int e = 0; e < 33; ++e) a += __shfl(z, e) * w1[e * 64 + lane];
        const float h1 = fsin(p.in[I_HF1][layer * 64 + lane] * a);
        float a2 = p.in[I_HB2][layer * 64 + lane];
        for (int j = 0; j < 64; ++j) a2 += __shfl(h1, j) * w2[j * 64 + lane];
        const float h2 = fsin(p.in[I_HF2][layer * 64 + lane] * a2);
        const float tw = (float)t / (float)(L - 1);
        float* fbase = (float*)(ws + WS_FILT + (st ? FILT_CTX_OFF : 0));
        for (int cc = 0; cc < 16; ++cc) {
            const int col = cc * 64 + lane; float f = 0.f;
            for (int j = 0; j < 64; ++j) f += __shfl(h2, j) * w3[j * 1024 + col];
            const int c = col & 511, isb = col >> 9;
            const float rate = HY_FAST + (HY_SLOW - HY_FAST) * ((float)c / 511.f);
            fbase[((size_t)isb * 512 + c) * L + t] = f * __expf(-tw * rate);
        }
    }
}
__device__ __forceinline__ void conv_T(const Ctx& cx, const float* W, int K, int N, bf16* dst, bool perm) {
    const int gt = cx.bid * NTHREADS + cx.tid, NGT = cx.nb * NTHREADS;
    for (int it = gt; it < N * (K / 8); it += NGT) {
        const int n = it % N, k0 = (it / N) * 8;
        const int sn = (perm && n < COL_V) ? ((n & ~63) + ((n & 63) >> 1) + 32 * (n & 1)) : n;
        const float* s = W + (size_t)k0 * N + sn;
        u32x4 w; w.x = pk2(s[0], s[N]); w.y = pk2(s[2 * (size_t)N], s[3 * (size_t)N]); w.z = pk2(s[4 * (size_t)N], s[5 * (size_t)N]); w.w = pk2(s[6 * (size_t)N], s[7 * (size_t)N]);
        *(u32x4*)(dst + (size_t)n * K + k0) = w;
    }
}
__device__ __forceinline__ void ph_convert(const Ctx& cx0) {
#define RELAUNDER() CParams& p = get_params(); Ctx cx; cx.tid = threadIdx.x; cx.bid = blockIdx.x; cx.nb = gridDim.x; asm volatile("" : "+v"(cx.tid), "+s"(cx.bid), "+s"(cx.nb));
#pragma unroll 1
    for (int layer = 0; layer < DEPTH; ++layer) {
        { RELAUNDER(); conv_T(cx, p.in[I_INW] + (size_t)layer * DM * INW, DM, INW, (bf16*)(p.ws + WT_IN) + (size_t)layer * INW * DM, true); }
        { RELAUNDER(); conv_T(cx, p.in[I_GLUW] + (size_t)layer * 512 * 512, 512, 512, (bf16*)(p.ws + WT_GLU) + (size_t)layer * 512 * 512, false); }
        { RELAUNDER(); conv_T(cx, p.in[I_BRA] + (size_t)layer * 512 * 1024, 512, 1024, (bf16*)(p.ws + WT_BR) + (size_t)(layer * 3 + 0) * 1024 * 512, false); }
        { RELAUNDER(); conv_T(cx, p.in[I_BRH] + (size_t)layer * 512 * 1024, 512, 1024, (bf16*)(p.ws + WT_BR) + (size_t)(layer * 3 + 1) * 1024 * 512, false); }
        { RELAUNDER(); conv_T(cx, p.in[I_BRS] + (size_t)layer * 512 * 1024, 512, 1024, (bf16*)(p.ws + WT_BR) + (size_t)(layer * 3 + 2) * 1024 * 512, false); }
        { RELAUNDER(); conv_T(cx, p.in[I_OUTW] + (size_t)layer * 1024 * 1024, 1024, 1024, (bf16*)(p.ws + WT_OUT) + (size_t)layer * 1024 * 1024, false); }
        { RELAUNDER(); conv_T(cx, p.in[I_WQ] + (size_t)layer * 1024 * 2048, 1024, 2048, (bf16*)(p.ws + WT_WQ) + (size_t)layer * 2048 * 1024, false); }
    }
    { RELAUNDER(); const int gt = cx.bid * NTHREADS + cx.tid, NGT = cx.nb * NTHREADS;
      for (int i = gt; i < 2 * 8 * 2 * 128 * 128 / 4; i += NGT) { const f32x4 v = ((const f32x4*)p.in[I_PKEYS])[i]; u32x2 w; w.x = pk2(v[0], v[1]); w.y = pk2(v[2], v[3]); ((u32x2*)(p.ws + WT_KEYS))[i] = w; } }
#undef RELAUNDER
    (void)cx0;
}

__device__ __forceinline__ void ph_norm(const Ctx& cx, int layer, int which, int nrows_lat_only) {
    CParams& p = get_params();
    const int lane = cx.tid & 63, wave = cx.tid >> 6;
    const int gw = cx.bid * NWAVES + wave, NGW = cx.nb * NWAVES;
    const float* g = p.in[which ? I_N2G : I_N1G] + layer * DM;
    const float* xc = (const float*)(p.ws + WS_XCUR);
    bf16* H = (bf16*)(p.ws + WS_H);
    const int nrows = nrows_lat_only ? TL : TA;
    for (int r = gw; r < nrows; r += NGW) {
        const float* mv = (const float*)(p.ws + WS_MODV) + ((size_t)layer * 5 + row_mi(r)) * 6144 + (which ? 3072 : 0);
        f32x4 v[4]; float s = 0.f;
#pragma unroll
        for (int j = 0; j < 4; ++j) { v[j] = *(const f32x4*)(xc + (size_t)r * DM + j * 256 + lane * 4); s += v[j].x * v[j].x + v[j].y * v[j].y + v[j].z * v[j].z + v[j].w * v[j].w; }
        const float rs = rsqrtf(wave_sum(s) * (1.f / DM) + NORM_EPS);
#pragma unroll
        for (int j = 0; j < 4; ++j) { const int c = j * 256 + lane * 4;
            const f32x4 gg = *(const f32x4*)(g + c), sh = *(const f32x4*)(mv + c), sc = *(const f32x4*)(mv + 1024 + c);
            const f32x4 y = v[j] * rs * gg; const f32x4 h = y * (1.f + sc) + sh;
            u32x2 w; w.x = pk2(h.x, h.y); w.y = pk2(h.z, h.w); *(u32x2*)(H + (size_t)r * DM + c) = w; }
    }
}


namespace pg8 {
#define PG8_LAS __attribute__((address_space(3)))
typedef unsigned short bf16_t;
typedef short bf16x8 __attribute__((ext_vector_type(8)));
constexpr int BM = 256, BK = 64, HALF = 128, HTB = HALF * BK * 2, STAGE_BYTES = 8 * HTB, NXCD = 8, WGM = 8;
__host__ __device__ __forceinline__ int lds_byte(int r, int c) { const int st = (r >> 4) * 2 + (c >> 5), rr = r & 15, cc = c & 31, ob = rr * 64 + cc * 2; return st * 1024 + (ob ^ (((ob >> 9) & 1) << 5)); }
__host__ __device__ __forceinline__ void stage_rc(int b, int& R, int& C) { const int st = b / 1024, sb = b % 1024, swz = sb ^ (((sb >> 9) & 1) << 5); R = (st >> 1) * 16 + swz / 64; C = (st & 1) * 32 + (swz % 64) / 2; }
__host__ __device__ __forceinline__ int perm32(int rho) { const int n = rho >> 4, i = rho & 15; return 8 * (i >> 2) + 4 * n + (i & 3); }
struct Unit { int pm, pn, z; };
struct Gemm { const bf16_t* A; const bf16_t* Bt; size_t zsA, zsB; int K; };
__device__ __forceinline__ const bf16_t* selA(const Gemm& g, int z) { return g.A + (size_t)z * g.zsA; }
__device__ __forceinline__ const bf16_t* selB(const Gemm& g, int z) { return g.Bt + (size_t)z * g.zsB; }
struct TileOrder {
    int nM, nN, nwg, G, c, extra, exN, expn0, nz;
    __device__ __forceinline__ bool next(int i, Unit& u) const {
        const int ti = i / nz; u.z = i - ti * nz;
        const long L = (long)ti * G + c;
        if (L < nwg) {
            int wgid = (int)L; { const int q = nwg / NXCD, r = nwg % NXCD, xcd = wgid % NXCD, off = wgid / NXCD; wgid = (xcd < r ? xcd * (q + 1) : r * (q + 1) + (xcd - r) * q) + off; }
            const int nig = WGM * nN, gid = wgid / nig, fm = gid * WGM, gsz = (nM - fm) < WGM ? (nM - fm) : WGM;
            u.pm = fm + ((wgid % nig) % gsz); u.pn = (wgid % nig) / gsz; return true;
        }
        const int e = (int)(L - nwg); if (e >= extra) return false;
        u.pm = nM + e / exN; u.pn = expn0 + e % exN; return true;
    }
};
__device__ __forceinline__ unsigned cvt_pk_bf16(float lo, float hi) { unsigned r; asm volatile("v_cvt_pk_bf16_f32 %0, %1, %2" : "=v"(r) : "v"(lo), "v"(hi)); return r; }
template <class Epi, class Sched, bool ALIGN_EPI = true, bool SP2 = true>
__device__ __forceinline__ void gemm_phase(PG8_LAS unsigned char* lds, const Gemm g, const Sched& S, const Epi& E, const int tid_) {
    const int tid = tid_, wid = __builtin_amdgcn_readfirstlane(tid >> 6), lane = tid & 63, wr = wid >> 2, wc = wid & 3, fr = lane & 15, fq = lane >> 4;
    const int K = g.K, nt = K / BK;
    unsigned voffA[2], voffB[2];
#pragma unroll
    for (int i = 0; i < 2; ++i) { int R, C; stage_rc(tid * 16 + i * 8192, R, C); const int Rb = Epi::PERM ? ((R & ~31) + perm32(R & 31)) : R;
        voffA[i] = (unsigned)(R * K + C) * 2u; voffB[i] = (unsigned)(Rb * K + C) * 2u; }
    const size_t kstep = (size_t)(BK * 2);
    const size_t hstep = (size_t)HALF * K * 2;
    const size_t tstep = 2 * hstep;
    const unsigned ldsw = (unsigned)wid * 1024u;
    const int aoff = lds_byte(wr * 64 + fr, fq * 8), boff = lds_byte(wc * 32 + fr, fq * 8);
#define PG8_SA(b, h) (((b) * 2 + (h)) * HTB)
#define PG8_SB(b, h) ((4 + (b) * 2 + (h)) * HTB)
#define PG8_STAGE(bufoff, gbase, voff) do { _Pragma("unroll") for (int _i = 0; _i < 2; ++_i) \
        __builtin_amdgcn_global_load_lds((const unsigned*)((const char*)(gbase) + (voff)[_i]), (PG8_LAS unsigned*)(lds + (bufoff) + ldsw + _i * 8192), 16, 0, 0); } while (0)
#define PG8_LDA(dst, b, h) do { _Pragma("unroll") for (int m = 0; m < 4; ++m) _Pragma("unroll") for (int k = 0; k < 2; ++k) dst[m][k] = *(const PG8_LAS bf16x8*)(lds + PG8_SA(b, h) + aoff + m * 2048 + k * 1024); } while (0)
#define PG8_LDB(dst, b, h) do { _Pragma("unroll") for (int n = 0; n < 2; ++n) _Pragma("unroll") for (int k = 0; k < 2; ++k) dst[n][k] = *(const PG8_LAS bf16x8*)(lds + PG8_SB(b, h) + boff + n * 2048 + k * 1024); } while (0)
#define PG8_MMA(ai, bj, At, Bt) do { __builtin_amdgcn_s_setprio(1); _Pragma("unroll") for (int m = 0; m < 4; ++m) _Pragma("unroll") for (int n = 0; n < 2; ++n) _Pragma("unroll") for (int k = 0; k < 2; ++k) \
        acc[ai][bj][m][n] = __builtin_amdgcn_mfma_f32_16x16x32_bf16(Bt[n][k], At[m][k], acc[ai][bj][m][n], 0, 0, 0); __builtin_amdgcn_s_setprio(0); } while (0)
#define PG8_WAIT_V(n) asm volatile("s_waitcnt vmcnt(" #n ")" ::: "memory")
#define PG8_WAIT_L(n) asm volatile("s_waitcnt lgkmcnt(" #n ")" ::: "memory")
#define PG8_BAR __builtin_amdgcn_s_barrier()
#define PG8_SCHED __builtin_amdgcn_sched_barrier(0)
    Unit cur, nxt; int ui = 0;
    if (!S.next(0, cur)) return;
    f32x4 acc[2][2][4][2];
#pragma unroll
    for (int a = 0; a < 2; ++a)
#pragma unroll
        for (int b = 0; b < 2; ++b)
#pragma unroll
            for (int m = 0; m < 4; ++m)
#pragma unroll
                for (int n = 0; n < 2; ++n) acc[a][b][m][n] = (f32x4){0.f, 0.f, 0.f, 0.f};
    bf16x8 At[4][2], B0[2][2], B1[2][2];
    const char* cA = (const char*)selA(g, cur.z) + (size_t)cur.pm * tstep; const char* cB = (const char*)selB(g, cur.z) + (size_t)cur.pn * tstep;
    if constexpr (SP2) {
        PG8_STAGE(PG8_SB(0, 0), cB, voffB); PG8_STAGE(PG8_SB(0, 1), cB + hstep, voffB); PG8_STAGE(PG8_SA(0, 0), cA, voffA); PG8_STAGE(PG8_SA(0, 1), cA + hstep, voffA);
        if (wr == 1) PG8_BAR;
        PG8_WAIT_V(2); PG8_BAR;
        PG8_STAGE(PG8_SB(1, 0), cB + kstep, voffB); PG8_STAGE(PG8_SA(1, 0), cA + kstep, voffA); PG8_STAGE(PG8_SB(1, 1), cB + hstep + kstep, voffB);
        PG8_WAIT_V(6); PG8_BAR;
    } else {
        PG8_STAGE(PG8_SB(0, 0), cB, voffB); PG8_STAGE(PG8_SA(0, 0), cA, voffA); PG8_STAGE(PG8_SB(0, 1), cB + hstep, voffB); PG8_STAGE(PG8_SA(0, 1), cA + hstep, voffA);
        if (wr == 1) PG8_BAR;
        PG8_WAIT_V(4); PG8_BAR;
        PG8_STAGE(PG8_SB(1, 0), cB + kstep, voffB); PG8_STAGE(PG8_SA(1, 0), cA + kstep, voffA); PG8_STAGE(PG8_SB(1, 1), cB + hstep + kstep, voffB);
        PG8_WAIT_V(6); PG8_BAR;
    }
    for (;;) {
        const bool has_next = S.next(ui + 1, nxt);
        const char* nA = has_next ? (const char*)selA(g, nxt.z) + (size_t)nxt.pm * tstep : cA; const char* nB = has_next ? (const char*)selB(g, nxt.z) + (size_t)nxt.pn * tstep : cB;
        for (int t = 0; t < nt; t += 2) {
            const bool last = (t == nt - 2);
            const char* a1 = cA + (size_t)(t + 1) * kstep;
            const char* a2 = last ? nA : cA + (size_t)(t + 2) * kstep; const char* b2 = last ? nB : cB + (size_t)(t + 2) * kstep;
            const char* a3 = a2 + kstep; const char* b3 = b2 + kstep;
            if constexpr (SP2) {
            PG8_LDB(B0, 0, 0); PG8_LDB(B1, 0, 1); PG8_SCHED; PG8_LDA(At, 0, 0); PG8_STAGE(PG8_SA(1, 1), a1 + hstep, voffA);
            PG8_WAIT_V(8); PG8_WAIT_L(0); PG8_BAR; PG8_MMA(0, 0, At, B0); PG8_MMA(0, 1, At, B1); PG8_BAR; PG8_SCHED;
            PG8_LDA(At, 0, 1); PG8_STAGE(PG8_SB(0, 0), b2, voffB); PG8_STAGE(PG8_SB(0, 1), b2 + hstep, voffB); PG8_STAGE(PG8_SA(0, 0), a2, voffA);
            PG8_WAIT_V(8); PG8_WAIT_L(0); PG8_BAR; PG8_MMA(1, 0, At, B0); PG8_MMA(1, 1, At, B1); PG8_BAR; PG8_SCHED;
            PG8_LDB(B0, 1, 0); PG8_LDB(B1, 1, 1); PG8_SCHED; PG8_LDA(At, 1, 0); PG8_STAGE(PG8_SA(0, 1), a2 + hstep, voffA);
            PG8_WAIT_V(8); PG8_WAIT_L(0); PG8_BAR; PG8_MMA(0, 0, At, B0); PG8_MMA(0, 1, At, B1); PG8_BAR; PG8_SCHED;
            PG8_LDA(At, 1, 1); PG8_STAGE(PG8_SB(1, 0), b3, voffB); PG8_STAGE(PG8_SB(1, 1), b3 + hstep, voffB); PG8_STAGE(PG8_SA(1, 0), a3, voffA);
            PG8_WAIT_V(8); PG8_WAIT_L(0); PG8_BAR; PG8_MMA(1, 0, At, B0); PG8_MMA(1, 1, At, B1); PG8_BAR; PG8_SCHED;
            } else {
            PG8_LDB(B0, 0, 0); PG8_SCHED; PG8_LDA(At, 0, 0); PG8_STAGE(PG8_SA(1, 1), a1 + hstep, voffA);
            PG8_WAIT_L(8); PG8_BAR; PG8_WAIT_L(0); PG8_MMA(0, 0, At, B0); PG8_BAR; PG8_SCHED;
            PG8_LDB(B1, 0, 1); PG8_STAGE(PG8_SB(0, 0), b2, voffB);
            PG8_BAR; PG8_WAIT_L(0); PG8_MMA(0, 1, At, B1); PG8_BAR;
            PG8_LDA(At, 0, 1); PG8_STAGE(PG8_SA(0, 0), a2, voffA);
            PG8_BAR; PG8_WAIT_L(0); PG8_MMA(1, 0, At, B0); PG8_BAR; PG8_SCHED;
            PG8_STAGE(PG8_SB(0, 1), b2 + hstep, voffB);
            PG8_WAIT_V(6); PG8_BAR; PG8_MMA(1, 1, At, B1); PG8_BAR;
            PG8_LDB(B0, 1, 0); PG8_SCHED; PG8_LDA(At, 1, 0); PG8_STAGE(PG8_SA(0, 1), a2 + hstep, voffA);
            PG8_WAIT_L(8); PG8_BAR; PG8_WAIT_L(0); PG8_MMA(0, 0, At, B0); PG8_BAR; PG8_SCHED;
            PG8_LDB(B1, 1, 1); PG8_STAGE(PG8_SB(1, 0), b3, voffB);
            PG8_BAR; PG8_WAIT_L(0); PG8_MMA(0, 1, At, B1); PG8_BAR;
            PG8_LDA(At, 1, 1); PG8_STAGE(PG8_SA(1, 0), a3, voffA);
            PG8_BAR; PG8_WAIT_L(0); PG8_MMA(1, 0, At, B0); PG8_BAR; PG8_SCHED;
            PG8_STAGE(PG8_SB(1, 1), b3 + hstep, voffB);
            PG8_WAIT_V(6); PG8_BAR; PG8_MMA(1, 1, At, B1); PG8_BAR;
            }
        }
        if constexpr (ALIGN_EPI) { if (wr == 0) PG8_BAR; }
        const bool keep = E(acc, cur, wr, wc, fr, fq);
        if (!has_next) break;
        if (!keep) {
#pragma unroll
        for (int a = 0; a < 2; ++a)
#pragma unroll
            for (int b = 0; b < 2; ++b)
#pragma unroll
                for (int m = 0; m < 4; ++m)
#pragma unroll
                    for (int n = 0; n < 2; ++n) acc[a][b][m][n] = (f32x4){0.f, 0.f, 0.f, 0.f};
        }
        cur = nxt; cA = nA; cB = nB; ++ui;
        if constexpr (ALIGN_EPI) { if (wr == 1) PG8_BAR; }
    }
    PG8_WAIT_V(0);
    if constexpr (!ALIGN_EPI) { if (wr == 0) PG8_BAR; }
    PG8_BAR;
#undef PG8_SA
#undef PG8_SB
#undef PG8_STAGE
#undef PG8_LDA
#undef PG8_LDB
#undef PG8_MMA
#undef PG8_WAIT_V
#undef PG8_WAIT_L
#undef PG8_BAR
#undef PG8_SCHED
}
}

__device__ __forceinline__ f32x4 bf4lo(u32x4 w) { return (f32x4){__uint_as_float(w.x << 16), __uint_as_float(w.x & 0xffff0000u), __uint_as_float(w.y << 16), __uint_as_float(w.y & 0xffff0000u)}; }
__device__ __forceinline__ f32x4 bf4hi(u32x4 w) { return (f32x4){__uint_as_float(w.z << 16), __uint_as_float(w.z & 0xffff0000u), __uint_as_float(w.w << 16), __uint_as_float(w.w & 0xffff0000u)}; }
__device__ __forceinline__ u32x4 pack8(f32x4 a, f32x4 b) { u32x4 w; w.x = pg8::cvt_pk_bf16(a[0], a[1]); w.y = pg8::cvt_pk_bf16(a[2], a[3]); w.z = pg8::cvt_pk_bf16(b[0], b[1]); w.w = pg8::cvt_pk_bf16(b[2], b[3]); return w; }
__device__ __forceinline__ f32x4 sig4(f32x4 v) { return (f32x4){sigmoidf_(v[0]), sigmoidf_(v[1]), sigmoidf_(v[2]), sigmoidf_(v[3])}; }

template <class T> __device__ __forceinline__ T* uni_ptr(T* q) { unsigned long long a = (unsigned long long)q; unsigned lo = __builtin_amdgcn_readfirstlane((unsigned)a), hi = __builtin_amdgcn_readfirstlane((unsigned)(a >> 32));
    asm volatile("" : "+s"(lo), "+s"(hi)); return (T*)(((unsigned long long)hi << 32) | lo); }
struct EpiInproj {
    static constexpr bool PERM = true;
    unsigned char* ws; const float* gate_b;
    __device__ __forceinline__ bool operator()(f32x4 (&acc)[2][2][4][2], const pg8::Unit& u, int wr, int wc, int fr_, int fq_) const {
        int fr = fr_, fq = fq_; asm volatile("" : "+v"(fr), "+v"(fq)); unsigned char* const ws = uni_ptr(this->ws);
        const int cl = wc * 32 + 8 * fq, rbase = u.pm * 256 + wr * 64 + fr;
#pragma unroll
        for (int bj = 0; bj < 2; ++bj) {
            const int c128 = u.pn * 256 + bj * 128;
            unsigned char* base; unsigned rstride, coff; int kind = 0;
            if (c128 < COL_K)         { base = ws + WS_Q; rstride = 1024; coff = (unsigned)(c128 + cl) * 2u; kind = 1; }
            else if (c128 < COL_V)    { base = ws + WS_K; rstride = 256;  coff = (unsigned)cl * 2u; kind = 1; }
            else if (c128 < COL_S5)   { base = ws + WS_V; rstride = 256;  coff = (unsigned)cl * 2u; }
            else if (c128 < COL_HY)   { base = ws + WS_U; rstride = 1024; coff = (unsigned)(c128 - COL_S5 + cl) * 2u; }
            else if (c128 < COL_GATE) { base = ws + WS_Z; rstride = 3072; coff = (unsigned)(c128 - COL_HY + cl) * 2u; }
            else                      { base = ws + WS_G; rstride = 6144; coff = (unsigned)(c128 - COL_GATE + cl) * 2u; kind = 2; }
            if (kind == 1) {
                const float* rope = (const float*)(ws + WS_ROPE) + 8 * fq;
#pragma unroll
                for (int ai = 0; ai < 2; ++ai)
#pragma unroll
                    for (int m = 0; m < 4; ++m) {
                        const int r = rbase + ai * 128 + m * 16;
                        f32x4 v0 = acc[ai][bj][m][0], v1 = acc[ai][bj][m][1];
                        if (r < TL) { const int l = r & 4095, pos = (wc & 1) ? (l & 63) : (l >> 6);
                            const f32x4 t0 = *(const f32x4*)(rope + pos * 32), t1 = *(const f32x4*)(rope + pos * 32 + 4);
                            v0 = (f32x4){v0[0] * t0[0] - v0[1] * t0[1], v0[0] * t0[1] + v0[1] * t0[0], v0[2] * t0[2] - v0[3] * t0[3], v0[2] * t0[3] + v0[3] * t0[2]};
                            v1 = (f32x4){v1[0] * t1[0] - v1[1] * t1[1], v1[0] * t1[1] + v1[1] * t1[0], v1[2] * t1[2] - v1[3] * t1[3], v1[2] * t1[3] + v1[3] * t1[2]}; }
                        *(u32x4*)(base + ((unsigned)r * rstride + coff)) = pack8(v0, v1);
                        asm volatile("" ::: "memory");
                    }
            } else if (kind == 2) {
                const float* gb = uni_ptr(gate_b) + (c128 - COL_GATE) + cl; const f32x4 b0 = *(const f32x4*)gb, b1 = *(const f32x4*)(gb + 4);
#pragma unroll
                for (int ai = 0; ai < 2; ++ai)
#pragma unroll
                    for (int m = 0; m < 4; ++m) {
                        const int r = rbase + ai * 128 + m * 16;
                        *(u32x4*)(base + ((unsigned)r * rstride + coff)) = pack8(sig4(acc[ai][bj][m][0] + b0), sig4(acc[ai][bj][m][1] + b1));
                        asm volatile("" ::: "memory");
                    }
            } else {
#pragma unroll
                for (int ai = 0; ai < 2; ++ai)
#pragma unroll
                    for (int m = 0; m < 4; ++m) {
                        const int r = rbase + ai * 128 + m * 16;
                        *(u32x4*)(base + ((unsigned)r * rstride + coff)) = pack8(acc[ai][bj][m][0], acc[ai][bj][m][1]);
                    }
            }
        }
        return false;
    }
};
struct EpiGlu {
    static constexpr bool PERM = true;
    unsigned char* ws; const float* bias;
    __device__ __forceinline__ bool operator()(f32x4 (&acc)[2][2][4][2], const pg8::Unit& u, int wr, int wc, int fr_, int fq_) const {
        int fr = fr_, fq = fq_; asm volatile("" : "+v"(fr), "+v"(fq)); unsigned char* const ws = uni_ptr(this->ws);
#pragma unroll
        for (int bj = 0; bj < 2; ++bj) { const int c = u.pn * 256 + bj * 128 + wc * 32 + 8 * fq; const f32x4 b0 = *(const f32x4*)(bias + c), b1 = *(const f32x4*)(bias + c + 4);
#pragma unroll
            for (int ai = 0; ai < 2; ++ai)
#pragma unroll
                for (int m = 0; m < 4; ++m) { const size_t o = (size_t)(u.pm * 256 + ai * 128 + wr * 64 + m * 16 + fr) * 512 + c;
                    const u32x4 yw = *(const u32x4*)((const bf16*)(ws + WS_S5Y) + o);
                    *(u32x4*)((bf16*)(ws + WS_S5O) + o) = pack8(bf4lo(yw) * sig4(acc[ai][bj][m][0] + b0), bf4hi(yw) * sig4(acc[ai][bj][m][1] + b1)); asm volatile("" ::: "memory"); } }
        return false;
    }
};
struct EpiMerge {
    static constexpr bool PERM = true;
    unsigned char* ws;
    __device__ __forceinline__ bool operator()(f32x4 (&acc)[2][2][4][2], const pg8::Unit& u, int wr, int wc, int fr_, int fq_) const {
        int fr = fr_, fq = fq_; asm volatile("" : "+v"(fr), "+v"(fq)); unsigned char* const ws = uni_ptr(this->ws);
#pragma unroll
        for (int bj = 0; bj < 2; ++bj) { const int c = u.pn * 256 + bj * 128 + wc * 32 + 8 * fq;
#pragma unroll
            for (int ai = 0; ai < 2; ++ai)
#pragma unroll
                for (int m = 0; m < 4; ++m) { const int r = u.pm * 256 + ai * 128 + wr * 64 + m * 16 + fr;
                    const bf16* gp = (const bf16*)(ws + WS_G) + (size_t)r * 3072 + u.z * 1024 + c;
                    const u32x4 g0 = *(const u32x4*)gp;
                    if (u.z < 2) { const u32x4 g1 = *(const u32x4*)(gp + 1024);
                        const f32x4 d0 = bf4lo(g1), d1 = bf4hi(g1), n0 = bf4lo(g0), n1 = bf4hi(g0);
                        acc[ai][bj][m][0] *= (f32x4){n0[0] / fmaxf(d0[0], 1e-30f), n0[1] / fmaxf(d0[1], 1e-30f), n0[2] / fmaxf(d0[2], 1e-30f), n0[3] / fmaxf(d0[3], 1e-30f)};
                        acc[ai][bj][m][1] *= (f32x4){n1[0] / fmaxf(d1[0], 1e-30f), n1[1] / fmaxf(d1[1], 1e-30f), n1[2] / fmaxf(d1[2], 1e-30f), n1[3] / fmaxf(d1[3], 1e-30f)};
                    } else *(u32x4*)((bf16*)(ws + WS_M) + (size_t)r * 1024 + c) = pack8(acc[ai][bj][m][0] * bf4lo(g0), acc[ai][bj][m][1] * bf4hi(g0));
                    asm volatile("" ::: "memory");
                } }
        return u.z < 2;
    }
};
struct EpiOut {
    static constexpr bool PERM = false;
    unsigned char* ws; int layer; float scale;
    __device__ __forceinline__ bool operator()(f32x4 (&acc)[2][2][4][2], const pg8::Unit& u, int wr, int wc, int fr_, int fq_) const {
        int fr = fr_, fq = fq_; asm volatile("" : "+v"(fr), "+v"(fq)); unsigned char* const ws = uni_ptr(this->ws);
        float* X = (float*)(ws + WS_XCUR);
#pragma unroll
        for (int ai = 0; ai < 2; ++ai)
#pragma unroll
            for (int m = 0; m < 4; ++m) { const int r = u.pm * 256 + ai * 128 + wr * 64 + m * 16 + fr;
                const float* g1 = (const float*)(ws + WS_MODV) + ((size_t)layer * 5 + row_mi(r)) * 6144 + 2048;
#pragma unroll
                for (int bj = 0; bj < 2; ++bj)
#pragma unroll
                    for (int n = 0; n < 2; ++n) { const int c = u.pn * 256 + bj * 128 + wc * 32 + n * 16 + 4 * fq; f32x4* xp = (f32x4*)(X + (size_t)r * 1024 + c);
                        *xp = *xp + *(const f32x4*)(g1 + c) * acc[ai][bj][m][n] * scale; } asm volatile("" ::: "memory"); }
        return false;
    }
};
struct EpiQp {
    static constexpr bool PERM = true;
    unsigned char* ws;
    __device__ __forceinline__ bool operator()(f32x4 (&acc)[2][2][4][2], const pg8::Unit& u, int wr, int wc, int fr_, int fq_) const {
        int fr = fr_, fq = fq_; asm volatile("" : "+v"(fr), "+v"(fq)); unsigned char* const ws = uni_ptr(this->ws);
#pragma unroll
        for (int bj = 0; bj < 2; ++bj) { const int c = u.pn * 256 + bj * 128 + wc * 32 + 8 * fq;
#pragma unroll
            for (int ai = 0; ai < 2; ++ai)
#pragma unroll
                for (int m = 0; m < 4; ++m) *(u32x4*)((bf16*)(ws + WS_QP) + (size_t)(u.pm * 256 + ai * 128 + wr * 64 + m * 16 + fr) * 2048 + c) = pack8(acc[ai][bj][m][0], acc[ai][bj][m][1]); }
        return false;
    }
};

__device__ __forceinline__ void ph_inproj(const Ctx& cx, int layer, PG8_LAS unsigned char* lds) {
    CParams& p = get_params();
    pg8::Gemm g; g.A = (const bf16*)(p.ws + WS_H); g.Bt = (const bf16*)(p.ws + WT_IN) + (size_t)layer * INW * DM; g.zsA = 0; g.zsB = 0; g.K = DM;
    pg8::TileOrder S; S.nM = TL / 256; S.nN = INW / 256; S.nwg = S.nM * S.nN; S.G = cx.nb; S.c = cx.bid; S.nz = 1;
    if (layer == DEPTH - 1) { S.exN = 3; S.expn0 = 2; S.extra = 4 * 3; } else { S.exN = INW / 256; S.expn0 = 0; S.extra = 4 * (INW / 256); }
    EpiInproj E; E.ws = p.ws; E.gate_b = p.in[I_GATEB] + layer * 3072;
    pg8::gemm_phase<EpiInproj, pg8::TileOrder>(lds, g, S, E, cx.tid);
}

__device__ __forceinline__ void ph_attn(const Ctx& cx, int layer, float* sm) {
    CParams& p = get_params();
    const int tid = cx.tid, lane = tid & 63, w = tid >> 6, l15 = lane & 15, kg = lane >> 4;
    const bf16* Q = (const bf16*)(p.ws + WS_Q); const bf16* Kb = (const bf16*)(p.ws + WS_K); const bf16* Vb = (const bf16*)(p.ws + WS_V);
    bf16* VT = (bf16*)sm;
    constexpr int VS = 648;
    const int nitems = 256 + (layer == 0 ? 16 : 0);
    for (int it = cx.bid; it < nitems; it += cx.nb) {
        int b, kvh, qbase, wbase; bool win;
        if (it < 256) { b = it >> 6; kvh = (it >> 5) & 1; const int blk = it & 31; qbase = b * SEQ + blk * 128; wbase = blk * 128 - 128; win = true; }
        else { const int j = it - 256; b = j >> 2; kvh = (j >> 1) & 1; qbase = TL + b * CTXL + (j & 1) * 128; wbase = 0; win = false; }
        __syncthreads();
        for (int i = tid; i < 640 * 8; i += NTHREADS) { const int kk = i >> 3, c8 = i & 7; int row = -1;
            if (kk < 256) row = TL + b * CTXL + kk; else if (win) { const int pos = wbase + kk - 256; if (pos >= 0 && pos < SEQ) row = b * SEQ + pos; }
            u32x4 v = (u32x4){0u, 0u, 0u, 0u}; if (row >= 0) v = *(const u32x4*)(Vb + (size_t)row * 128 + kvh * 64 + c8 * 8);
            bf16* d = VT + (c8 * 8) * VS + kk;
            d[0] = (bf16)(v.x & 0xffffu); d[VS] = (bf16)(v.x >> 16); d[2 * VS] = (bf16)(v.y & 0xffffu); d[3 * VS] = (bf16)(v.y >> 16);
            d[4 * VS] = (bf16)(v.z & 0xffffu); d[5 * VS] = (bf16)(v.z >> 16); d[6 * VS] = (bf16)(v.w & 0xffffu); d[7 * VS] = (bf16)(v.w >> 16); }
        __syncthreads();
        const int h = kvh * 4 + (w >> 1), tok0 = (w & 1) * 64;
        bf16x8 qf[4][2];
#pragma unroll
        for (int qt = 0; qt < 4; ++qt)
#pragma unroll
            for (int ks = 0; ks < 2; ++ks) qf[qt][ks] = *(const bf16x8*)(Q + (size_t)(qbase + tok0 + 16 * qt + l15) * 512 + h * 64 + 32 * ks + 8 * kg);
        float m[4], l[4]; f32x4 O[4][4];
        const float sink = p.in[I_SINK][layer * 8 + h];
#pragma unroll
        for (int qt = 0; qt < 4; ++qt) { m[qt] = sink; l[qt] = 1.f;
#pragma unroll
            for (int dt = 0; dt < 4; ++dt) O[qt][dt] = (f32x4){0.f, 0.f, 0.f, 0.f}; }
        const int nsteps = win ? 18 : 8;
        for (int st = 0; st < nsteps; ++st) {
            const int kk0 = st < 8 ? st * 32 : 256 + tok0 + (st - 8) * 32;
            bf16x8 kf[2][2];
#pragma unroll
            for (int kt = 0; kt < 2; ++kt) { const int kk = kk0 + 16 * kt + l15; int row;
                if (kk < 256) row = TL + b * CTXL + kk; else { int pos = wbase + kk - 256; pos = pos < 0 ? 0 : (pos > SEQ - 1 ? SEQ - 1 : pos); row = b * SEQ + pos; }
#pragma unroll
                for (int ks = 0; ks < 2; ++ks) kf[kt][ks] = *(const bf16x8*)(Kb + (size_t)row * 128 + kvh * 64 + 32 * ks + 8 * kg); }
#pragma unroll
            for (int qt = 0; qt < 4; ++qt) {
                f32x4 s0 = (f32x4){0.f, 0.f, 0.f, 0.f}, s1 = s0;
                s0 = __builtin_amdgcn_mfma_f32_16x16x32_bf16(kf[0][0], qf[qt][0], s0, 0, 0, 0); s0 = __builtin_amdgcn_mfma_f32_16x16x32_bf16(kf[0][1], qf[qt][1], s0, 0, 0, 0);
                s1 = __builtin_amdgcn_mfma_f32_16x16x32_bf16(kf[1][0], qf[qt][0], s1, 0, 0, 0); s1 = __builtin_amdgcn_mfma_f32_16x16x32_bf16(kf[1][1], qf[qt][1], s1, 0, 0, 0);
                s0 *= 0.125f; s1 *= 0.125f;
                if (st >= 8) {
                    const int qpos = wbase + 128 + tok0 + 16 * qt + l15, kp0 = wbase + kk0 - 256 + 4 * kg;
#pragma unroll
                    for (int r = 0; r < 4; ++r) { const int k0 = kp0 + r, k1 = kp0 + 16 + r;
                        if (k0 < 0 || k0 >= SEQ || k0 - qpos > 128 || qpos - k0 > 128) s0[r] = -1e30f;
                        if (k1 < 0 || k1 >= SEQ || k1 - qpos > 128 || qpos - k1 > 128) s1[r] = -1e30f; }
                }
                float mx = fmaxf(fmaxf(fmaxf(s0[0], s0[1]), fmaxf(s0[2], s0[3])), fmaxf(fmaxf(s1[0], s1[1]), fmaxf(s1[2], s1[3])));
                mx = fmaxf(mx, __shfl_xor(mx, 16)); mx = fmaxf(mx, __shfl_xor(mx, 32));
                const float mn = fmaxf(m[qt], mx), f = __expf(m[qt] - mn);
                f32x4 p0, p1;
#pragma unroll
                for (int r = 0; r < 4; ++r) { p0[r] = __expf(s0[r] - mn); p1[r] = __expf(s1[r] - mn); }
                float ps = (p0[0] + p0[1]) + (p0[2] + p0[3]) + (p1[0] + p1[1]) + (p1[2] + p1[3]);
                ps += __shfl_xor(ps, 16); ps += __shfl_xor(ps, 32);
                l[qt] = l[qt] * f + ps; m[qt] = mn;
                u32x4 pw; pw.x = pk2(p0[0], p0[1]); pw.y = pk2(p0[2], p0[3]); pw.z = pk2(p1[0], p1[1]); pw.w = pk2(p1[2], p1[3]);
                const bf16x8 pf = __builtin_bit_cast(bf16x8, pw);
#pragma unroll
                for (int dt = 0; dt < 4; ++dt) {
                    const bf16* vp = VT + (16 * dt + l15) * VS + kk0 + 4 * kg;
                    u32x4 vw; const u32x2 va = *(const u32x2*)vp, vb = *(const u32x2*)(vp + 16); vw.x = va.x; vw.y = va.y; vw.z = vb.x; vw.w = vb.y;
                    O[qt][dt] = __builtin_amdgcn_mfma_f32_16x16x32_bf16(__builtin_bit_cast(bf16x8, vw), pf, O[qt][dt] * f, 0, 0, 0);
                }
            }
        }
#pragma unroll
        for (int qt = 0; qt < 4; ++qt) { const float il = 1.f / l[qt]; bf16* op = (bf16*)(p.ws + WS_ATT) + (size_t)(qbase + tok0 + 16 * qt + l15) * 512 + h * 64 + 4 * kg;
#pragma unroll
            for (int dt = 0; dt < 4; ++dt) { const f32x4 o = O[qt][dt] * il; u32x2 ww; ww.x = pk2(o[0], o[1]); ww.y = pk2(o[2], o[3]); *(u32x2*)(op + 16 * dt) = ww; } }
    }
}

__device__ __forceinline__ void ph_hypre(const Ctx& cx, int layer, float* sm) {
    CParams& p = get_params();
    const int lane = cx.tid & 63, wave = cx.tid >> 6, gw = cx.bid * NWAVES + wave, NGW = cx.nb * NWAVES;
    const bf16* Z = (const bf16*)(p.ws + WS_Z); const float* sw = p.in[I_HSW] + layer * 3 * 1536; const float* sb = p.in[I_HSB] + layer * 1536;
    float* tile = sm + wave * 4096;
    const int nlat = 4 * 64 * 8, nctx = layer == 0 ? 4 * 4 * 8 : 0;
    for (int it = gw; it < nlat + nctx; it += NGW) {
        int b, t0, L, c0, rbase; float* vvb;
        if (it < nlat) { b = it >> 9; t0 = ((it >> 3) & 63) * 64; c0 = (it & 7) * 64; L = SEQ; rbase = b * SEQ; vvb = (float*)(p.ws + WS_VV) + ((size_t)b * 512 + c0) * SEQ; }
        else { const int j = it - nlat; b = j >> 5; t0 = ((j >> 3) & 3) * 64; c0 = (j & 7) * 64; L = CTXL; rbase = TL + b * CTXL; vvb = (float*)(p.ws + WS_VVC) + ((size_t)b * 512 + c0) * CTXL; }
        const int c = c0 + lane;
        float w0[3], w1[3], w2[3], bb[3], zp[3], zc[3], zn[3];
#pragma unroll
        for (int q = 0; q < 3; ++q) { const int col = q * 512 + c; w0[q] = sw[col]; w1[q] = sw[1536 + col]; w2[q] = sw[2 * 1536 + col]; bb[q] = sb[col];
            zp[q] = t0 > 0 ? bf2f(Z[(size_t)(rbase + t0 - 1) * 1536 + col]) : 0.f; zc[q] = bf2f(Z[(size_t)(rbase + t0) * 1536 + col]); }
        for (int tt = 0; tt < 64; ++tt) {
            const int t = t0 + tt;
#pragma unroll
            for (int q = 0; q < 3; ++q) zn[q] = t + 1 < L ? bf2f(Z[(size_t)(rbase + t + 1) * 1536 + q * 512 + c]) : 0.f;
            float o[3];
#pragma unroll
            for (int q = 0; q < 3; ++q) { o[q] = bb[q] + w0[q] * zp[q] + w1[q] * zc[q] + w2[q] * zn[q]; zp[q] = zc[q]; zc[q] = zn[q]; }
            ((bf16*)(p.ws + WS_X0C))[(size_t)(rbase + t) * 512 + c] = f2bf(o[0]);
            tile[lane * 64 + (tt ^ lane)] = o[2] * o[1];
        }
        __builtin_amdgcn_s_waitcnt(0xc07f);
        for (int cc = 0; cc < 64; ++cc) vvb[(size_t)cc * L + t0 + lane] = tile[cc * 64 + (lane ^ cc)];
        __builtin_amdgcn_s_waitcnt(0xc07f);
    }
}

__device__ __forceinline__ void ph_hyconv_ctx(const Ctx& cx, int layer, float* sm) {
    CParams& p = get_params();
    const int tid = cx.tid;
    if (layer != 0) return;
    constexpr int L = CTXL;
    float* Tl = sm; float* Vl = sm + 2 * L;
    for (int it = cx.bid; it < 2048; it += cx.nb) {
        const int bc = it, b = bc >> 9, c = bc & 511;
        const float* fb = (const float*)(p.ws + WS_FILT + FILT_CTX_OFF);
        const float* hf = fb + (size_t)c * L; const float* hb = fb + ((size_t)512 + c) * L;
        const float* vv = (const float*)(p.ws + WS_VVC) + (size_t)bc * CTXL;
        __syncthreads();
        if (tid < L) { Tl[L - 1 + tid] = hf[tid]; if (tid > 0) Tl[L - 1 - tid] = hb[tid]; Vl[tid] = vv[tid]; }
        __syncthreads();
        if (tid < L) { float a = 0.f; const float* tp = Tl + (tid + L - 1);
            for (int s = 0; s < L; ++s) a += Vl[s] * tp[-s];
            const size_t o = (size_t)(TL + b * CTXL + tid) * 512 + c;
            ((bf16*)(p.ws + WS_HY))[o] = f2bf((a + Vl[tid] * p.in[I_HBIAS][layer * 512 + c]) * bf2f(((const bf16*)(p.ws + WS_X0C))[o])); }
    }
}
typedef float f32x2 __attribute__((ext_vector_type(2)));
__device__ __forceinline__ void fft_fwd(f32x2* X, int tid) {
#pragma unroll 1
    for (int s = 0; s < 13; ++s) {
        const int lh = 12 - s, half = 1 << lh;
        __syncthreads();
#pragma unroll
        for (int q = 0; q < 8; ++q) { const int j = tid + 512 * q, pos = j & (half - 1), i0 = ((j >> lh) << (lh + 1)) + pos, i1 = i0 + half;
            const float rev = (float)(pos << s) * (1.f / 8192.f); const float wc = __builtin_amdgcn_cosf(rev), ws = -__builtin_amdgcn_sinf(rev);
            const f32x2 a = X[i0], b = X[i1]; const f32x2 d = a - b;
            X[i0] = a + b; X[i1] = (f32x2){d.x * wc - d.y * ws, d.x * ws + d.y * wc}; }
    }
}
__device__ __forceinline__ void fft_inv(f32x2* X, int tid) {
#pragma unroll 1
    for (int s = 0; s < 13; ++s) {
        const int half = 1 << s;
        __syncthreads();
#pragma unroll
        for (int q = 0; q < 8; ++q) { const int j = tid + 512 * q, pos = j & (half - 1), i0 = ((j >> s) << (s + 1)) + pos, i1 = i0 + half;
            const float rev = (float)(pos << (12 - s)) * (1.f / 8192.f); const float wc = __builtin_amdgcn_cosf(rev), ws = __builtin_amdgcn_sinf(rev);
            const f32x2 a = X[i0], b0 = X[i1]; const f32x2 b = (f32x2){b0.x * wc - b0.y * ws, b0.x * ws + b0.y * wc};
            X[i0] = a + b; X[i1] = a - b; }
    }
}
__device__ __forceinline__ void ph_hyfft(const Ctx& cx, int layer, float* sm, bool dry) {
    CParams& p = get_params();
    const int tid = cx.tid;
    f32x2* A = (f32x2*)sm; f32x2* B = A + 8192;
    for (int c = cx.bid; c < 512; c += cx.nb) {
        const float* hf = (const float*)(p.ws + WS_FILT) + (size_t)c * SEQ; const float* hb = (const float*)(p.ws + WS_FILT) + ((size_t)512 + c) * SEQ;
        const float bias = p.in[I_HBIAS][layer * 512 + c];
        __syncthreads();
#pragma unroll
        for (int q = 0; q < 16; ++q) { const int i = tid + 512 * q; float v = 0.f; if (i < SEQ) v = hf[i]; else if (i > SEQ) v = hb[2 * SEQ - i]; A[i] = (f32x2){v, 0.f}; }
        fft_fwd(A, tid);
#pragma unroll 1
        for (int bp = 0; bp < 2; ++bp) {
            float* v0 = (float*)(p.ws + WS_VV) + ((size_t)(2 * bp) * 512 + c) * SEQ; float* v1 = v0 + (size_t)512 * SEQ;
            float xr[8], xi[8];
            __syncthreads();
#pragma unroll
            for (int q = 0; q < 8; ++q) { const int i = tid + 512 * q; xr[q] = v0[i]; xi[q] = v1[i]; B[i] = (f32x2){xr[q], xi[q]}; B[i + SEQ] = (f32x2){0.f, 0.f}; }
            fft_fwd(B, tid);
            __syncthreads();
#pragma unroll
            for (int q = 0; q < 16; ++q) { const int i = tid + 512 * q; const f32x2 k = A[i], x = B[i]; B[i] = (f32x2){x.x * k.x - x.y * k.y, x.x * k.y + x.y * k.x}; }
            fft_inv(B, tid);
            __syncthreads();
#pragma unroll
            for (int q = 0; q < 8; ++q) { const int i = tid + 512 * q; const f32x2 y = B[i]; if (!dry) { v0[i] = y.x * (1.f / 8192.f) + xr[q] * bias; v1[i] = y.y * (1.f / 8192.f) + xi[q] * bias; } }
        }
    }
}
__device__ __forceinline__ void ph_hypost(const Ctx& cx, int layer, float* sm) {
    CParams& p = get_params();
    const int lane = cx.tid & 63, wave = cx.tid >> 6, gw = cx.bid * NWAVES + wave, NGW = cx.nb * NWAVES;
    float* tile = sm + wave * 4096;
    for (int it = gw; it < 4 * 64 * 8; it += NGW) {
        const int b = it >> 9, t0 = ((it >> 3) & 63) * 64, c0 = (it & 7) * 64;
        const float* yb = (const float*)(p.ws + WS_VV) + ((size_t)b * 512 + c0) * SEQ;
        for (int cc = 0; cc < 64; ++cc) tile[cc * 64 + (lane ^ cc)] = yb[(size_t)cc * SEQ + t0 + lane];
        __builtin_amdgcn_s_waitcnt(0xc07f);
        for (int tt = 0; tt < 64; ++tt) { const size_t o = (size_t)(b * SEQ + t0 + tt) * 512 + c0 + lane;
            ((bf16*)(p.ws + WS_HY))[o] = f2bf(tile[lane * 64 + (tt ^ lane)] * bf2f(((const bf16*)(p.ws + WS_X0C))[o])); }
        __builtin_amdgcn_s_waitcnt(0xc07f);
    }
    (void)layer;
}

struct S5Coef { float decay, theta, cr, ci; };
__device__ __forceinline__ S5Coef s5_coef(CParams& p, int ldgp  ) {
    const int ldg = ldgp >> 6;
    const float are = fminf(p.in[I_SARE][ldgp], -1e-4f), aim = p.in[I_SAIM][ldgp], dt = __expf(p.in[I_SLDT][ldg]);
    S5Coef c; c.decay = are * dt; c.theta = aim * dt;
    const float er = __expf(c.decay), abr = er * fcos(c.theta), abi = er * fsin(c.theta);
    const float nr = abr - 1.0f, ni = abi, den = are * are + aim * aim;
    c.cr = (nr * are + ni * aim) / den; c.ci = (ni * are - nr * aim) / den; return c;
}
__device__ __forceinline__ void s5_pow(const S5Coef& c, int n, float& pr, float& pi) {
    const float m = __expf(c.decay * (float)n), rev = __builtin_amdgcn_fractf(c.theta * (float)n * 0.15915494309189535f);
    pr = m * __builtin_amdgcn_cosf(rev); pi = m * __builtin_amdgcn_sinf(rev);
}
__device__ __forceinline__ void ph_s5tables(const Ctx& cx, int layer) {
    const int gt = cx.bid * NTHREADS + cx.tid, NGT = cx.nb * NTHREADS;
    {
        CParams& p = get_params(); bf16* E = (bf16*)(p.ws + WS_S5E);
        for (int it = gt; it < 32 * 2 * 64 * 64; it += NGT) {
            const int pp = it & 63, s = (it >> 6) & 63, dir = (it >> 12) & 1, g = it >> 13;
            const int ldgp = ((layer * 2 + dir) * 32 + g) * 64 + pp;
            const S5Coef c = s5_coef(p, ldgp);
            float pr, pi; s5_pow(c, dir == 0 ? 63 - s : s, pr, pi);
            const float qr = pr * c.cr - pi * c.ci, qi = pr * c.ci + pi * c.cr;
            const float* bre = p.in[I_SBRE] + (size_t)ldgp * 16; const float* bim = p.in[I_SBIM] + (size_t)ldgp * 16;
            bf16* er = E + (((size_t)(g * 2 + dir) * 128 + pp) * 1024 + s * 16); bf16* ei = er + (size_t)64 * 1024;
#pragma unroll
            for (int i = 0; i < 16; i += 2) { const float b0r = bre[i], b0i = bim[i], b1r = bre[i + 1], b1i = bim[i + 1];
                *(unsigned*)(er + i) = pk2(qr * b0r - qi * b0i, qr * b1r - qi * b1i); *(unsigned*)(ei + i) = pk2(qr * b0i + qi * b0r, qr * b1i + qi * b1r); }
            if (s == 0) { float ar, ai; s5_pow(c, 64, ar, ai); float* a64 = (float*)(p.ws + WS_S5A64) + (size_t)ldgp * 2; a64[0] = ar; a64[1] = ai; }
        }
    }
    {
        CParams& p = get_params(); bf16* P = (bf16*)(p.ws + WS_S5P);
        for (int it = gt; it < 32 * 2 * 64 * 64; it += NGT) {
            const int pp = it & 63, tau = (it >> 6) & 63, dir = (it >> 12) & 1, g = it >> 13;
            const int ldgp = ((layer * 2 + dir) * 32 + g) * 64 + pp;
            const S5Coef c = s5_coef(p, ldgp);
            float pr, pi; s5_pow(c, dir == 0 ? tau + 1 : 64 - tau, pr, pi);
            const size_t cb = ((size_t)((layer * 2 + dir) * 32 + g) * 16) * 64 + pp;
            bf16* pb = P + (((size_t)(g * 2 + dir) * 64 + tau) * 16) * 128 + pp;
#pragma unroll
            for (int o = 0; o < 16; ++o) { const float cre = p.in[I_SCRE][cb + o * 64], cim = p.in[I_SCIM][cb + o * 64];
                pb[o * 128] = f2bf(cre * pr - cim * pi); pb[o * 128 + 64] = f2bf(-(cre * pi + cim * pr)); }
        }
    }
    {
        CParams& p = get_params(); bf16* K = (bf16*)(p.ws + WS_S5K);
        for (int it = gt; it < 32 * 127 * 256; it += NGT) {
            const int i = it & 15, o = (it >> 4) & 15, dl = (it >> 8) % 127, g = (it >> 8) / 127, d = dl - 63;
            float acc = 0.f;
#pragma unroll 1
            for (int dir = 0; dir < 2; ++dir) {
                if ((dir == 0 && d < 0) || (dir == 1 && d > 0)) continue;
                const int n = d < 0 ? -d : d, base = ((layer * 2 + dir) * 32 + g) * 64;
                for (int pp = 0; pp < 64; ++pp) {
                    const S5Coef c = s5_coef(p, base + pp);
                    float pr, pi; s5_pow(c, n, pr, pi);
                    const float qr = pr * c.cr - pi * c.ci, qi = pr * c.ci + pi * c.cr;
                    const float br = p.in[I_SBRE][(size_t)(base + pp) * 16 + i], bi = p.in[I_SBIM][(size_t)(base + pp) * 16 + i];
                    const float xr = qr * br - qi * bi, xi = qr * bi + qi * br;
                    const size_t ci_ = ((size_t)((layer * 2 + dir) * 32 + g) * 16 + o) * 64 + pp;
                    acc += p.in[I_SCRE][ci_] * xr - p.in[I_SCIM][ci_] * xi;
                }
            }
            if (d == 0 && o == i) acc += p.in[I_SD][layer * 512 + g * 16 + o];
            K[it] = f2bf(acc);
        }
    }
}
__device__ __forceinline__ int s5_row(int b, int n, int s) { return n < 4 ? TL + b * CTXL + n * 64 + s : b * SEQ + (n - 4) * 64 + s; }
__device__ __forceinline__ void ph_s5states(const Ctx& cx, int layer, float* sm) {
    CParams& p = get_params();
    const int tid = cx.tid, lane = tid & 63, w = tid >> 6, l15 = lane & 15, kg = lane >> 4;
    const bf16* E = (const bf16*)(p.ws + WS_S5E); const bf16* U = (const bf16*)(p.ws + WS_U);
    float* S = sm;
    for (int it = cx.bid; it < 128; it += cx.nb) {
        const int g = it & 31, b = it >> 5;
        f32x4 acc[2][5];
#pragma unroll
        for (int mt = 0; mt < 2; ++mt)
#pragma unroll
            for (int nt = 0; nt < 5; ++nt) acc[mt][nt] = (f32x4){0.f, 0.f, 0.f, 0.f};
        const bf16* ea = E + ((size_t)g * 256 + 32 * w + l15) * 1024 + 8 * kg;
        for (int ks = 0; ks < 32; ++ks) {
            const int s = 2 * ks + (kg >> 1), i0 = 8 * (kg & 1);
            bf16x8 af[2], bfr[5];
#pragma unroll
            for (int mt = 0; mt < 2; ++mt) af[mt] = *(const bf16x8*)(ea + (size_t)mt * 16 * 1024 + ks * 32);
#pragma unroll
            for (int nt = 0; nt < 5; ++nt) { const int n = 16 * nt + l15; bfr[nt] = (bf16x8){0, 0, 0, 0, 0, 0, 0, 0};
                if (n < 68) bfr[nt] = *(const bf16x8*)(U + (size_t)s5_row(b, n, s) * 512 + g * 16 + i0); }
#pragma unroll
            for (int mt = 0; mt < 2; ++mt)
#pragma unroll
                for (int nt = 0; nt < 5; ++nt) acc[mt][nt] = __builtin_amdgcn_mfma_f32_16x16x32_bf16(af[mt], bfr[nt], acc[mt][nt], 0, 0, 0);
        }
        __syncthreads();
#pragma unroll
        for (int mt = 0; mt < 2; ++mt)
#pragma unroll
            for (int nt = 0; nt < 5; ++nt)
#pragma unroll
                for (int r = 0; r < 4; ++r) S[(32 * w + 16 * mt + kg * 4 + r) * 81 + 16 * nt + l15] = acc[mt][nt][r];
        __syncthreads();
        if (tid < 128) {
            const int dir = tid >> 6, pp = tid & 63;
            const float* a64 = (const float*)(p.ws + WS_S5A64) + ((size_t)((layer * 2 + dir) * 32 + g) * 64 + pp) * 2;
            const float ar = a64[0], ai = a64[1]; float hr = 0.f, hi = 0.f;
            bf16* hin = (bf16*)(p.ws + WS_HIN) + ((size_t)g * 272 + b * 68) * 256 + dir * 128 + pp;
            for (int k = 0; k < 68; ++k) {
                const int n = dir == 0 ? k : (k < 4 ? 3 - k : 71 - k);
                hin[(size_t)n * 256] = f2bf(hr); hin[(size_t)n * 256 + 64] = f2bf(hi);
                const float sr = S[(dir * 128 + pp) * 81 + n], si = S[(dir * 128 + 64 + pp) * 81 + n];
                const float nr = ar * hr - ai * hi + sr, ni = ar * hi + ai * hr + si; hr = nr; hi = ni;
            }
        }
    }
}
__device__ __forceinline__ void ph_s5out(const Ctx& cx, int layer, float* sm) {
    CParams& p = get_params();
    const int tid = cx.tid, lane = tid & 63, w = tid >> 6, l15 = lane & 15, kg = lane >> 4;
    const bf16* U = (const bf16*)(p.ws + WS_U); const bf16* P = (const bf16*)(p.ws + WS_S5P); const bf16* HIN = (const bf16*)(p.ws + WS_HIN);
    bf16* Kl = (bf16*)sm;
    for (int it = cx.bid; it < 256; it += cx.nb) {
        const int g = it & 31, b = (it >> 5) & 3, half = it >> 7;
        __syncthreads();
        { const u32x4* src = (const u32x4*)((const bf16*)(p.ws + WS_S5K) + (size_t)g * 127 * 256); u32x4* dst = (u32x4*)Kl;
          for (int i = tid; i < 127 * 256 / 8; i += NTHREADS) dst[i] = src[i]; }
        __syncthreads();
        f32x4 acc[4][5];
#pragma unroll
        for (int mt = 0; mt < 4; ++mt)
#pragma unroll
            for (int nt = 0; nt < 5; ++nt) acc[mt][nt] = (f32x4){0.f, 0.f, 0.f, 0.f};
        const int tau0 = 32 * half + 4 * w;
        for (int ks = 0; ks < 32; ++ks) {
            const int s = 2 * ks + (kg >> 1), i0 = 8 * (kg & 1);
            bf16x8 bfr[5];
#pragma unroll
            for (int nt = 0; nt < 5; ++nt) { const int n = 16 * nt + l15; bfr[nt] = (bf16x8){0, 0, 0, 0, 0, 0, 0, 0};
                if (n < 68) bfr[nt] = *(const bf16x8*)(U + (size_t)s5_row(b, n, s) * 512 + g * 16 + i0); }
#pragma unroll
            for (int mt = 0; mt < 4; ++mt) {
                const int lag = tau0 + mt - s;
                const bf16x8 af = *(const bf16x8*)(Kl + (lag + 63) * 256 + l15 * 16 + i0);
#pragma unroll
                for (int nt = 0; nt < 5; ++nt) acc[mt][nt] = __builtin_amdgcn_mfma_f32_16x16x32_bf16(af, bfr[nt], acc[mt][nt], 0, 0, 0);
            }
        }
#pragma unroll 1
        for (int dk = 0; dk < 8; ++dk) {
            const int dir = dk >> 2, kk = dk & 3;
            bf16x8 bfr[5];
#pragma unroll
            for (int nt = 0; nt < 5; ++nt) { const int n = 16 * nt + l15; bfr[nt] = (bf16x8){0, 0, 0, 0, 0, 0, 0, 0};
                if (n < 68) bfr[nt] = *(const bf16x8*)(HIN + ((size_t)g * 272 + b * 68 + n) * 256 + dir * 128 + 32 * kk + 8 * kg); }
#pragma unroll
            for (int mt = 0; mt < 4; ++mt) {
                const bf16x8 af = *(const bf16x8*)(P + ((((size_t)(g * 2 + dir) * 64 + tau0 + mt) * 16 + l15) * 128 + 32 * kk + 8 * kg));
#pragma unroll
                for (int nt = 0; nt < 5; ++nt) acc[mt][nt] = __builtin_amdgcn_mfma_f32_16x16x32_bf16(af, bfr[nt], acc[mt][nt], 0, 0, 0);
            }
        }
#pragma unroll
        for (int mt = 0; mt < 4; ++mt)
#pragma unroll
            for (int nt = 0; nt < 5; ++nt) { const int n = 16 * nt + l15;
                if (n < 68 && (layer == 0 || n >= 4)) { const f32x4 y = acc[mt][nt]; u32x2 o; o.x = pk2(gelu_tanh(y[0]), gelu_tanh(y[1])); o.y = pk2(gelu_tanh(y[2]), gelu_tanh(y[3]));
                    *(u32x2*)((bf16*)(p.ws + WS_S5Y) + (size_t)s5_row(b, n, tau0 + mt) * 512 + g * 16 + 4 * kg) = o; } }
    }
}

__device__ __forceinline__ void ph_glu(const Ctx& cx, int layer, PG8_LAS unsigned char* lds) {
    CParams& p = get_params();
    pg8::Gemm g; g.A = (const bf16*)(p.ws + WS_S5Y); g.Bt = (const bf16*)(p.ws + WT_GLU) + (size_t)layer * 512 * 512; g.zsA = 0; g.zsB = 0; g.K = 512;
    pg8::TileOrder S; S.nM = TL / 256; S.nN = 2; S.nwg = S.nM * S.nN; S.G = cx.nb; S.c = cx.bid; S.nz = 1; S.exN = 2; S.expn0 = 0; S.extra = layer == 0 ? 4 * 2 : 0;
    EpiGlu E; E.ws = p.ws; E.bias = p.in[I_GLUB] + layer * 512;
    pg8::gemm_phase<EpiGlu, pg8::TileOrder>(lds, g, S, E, cx.tid);
}
__device__ __forceinline__ void ph_merge(const Ctx& cx, int layer, PG8_LAS unsigned char* lds) {
    CParams& p = get_params();
    pg8::Gemm g; g.A = (const bf16*)(p.ws + WS_ATT); g.zsA = (WS_HY - WS_ATT) / 2;
    g.Bt = (const bf16*)(p.ws + WT_BR) + (size_t)(layer * 3 + 0) * 1024 * 512; g.zsB = 1024 * 512; g.K = 512;
    pg8::TileOrder S; S.nM = TL / 256; S.nN = 4; S.nwg = S.nM * S.nN; S.G = cx.nb; S.c = cx.bid; S.nz = 3; S.exN = 4; S.expn0 = 0; S.extra = layer == 0 ? 4 * 4 : 0;
    EpiMerge E; E.ws = p.ws;
    pg8::gemm_phase<EpiMerge, pg8::TileOrder>(lds, g, S, E, cx.tid);
}
__device__ __forceinline__ void ph_outproj(const Ctx& cx, int layer, PG8_LAS unsigned char* lds, float scale) {
    CParams& p = get_params();
    pg8::Gemm g; g.A = (const bf16*)(p.ws + WS_M); g.Bt = (const bf16*)(p.ws + WT_OUT) + (size_t)layer * 1024 * 1024; g.zsA = 0; g.zsB = 0; g.K = 1024;
    pg8::TileOrder S; S.nM = TL / 256; S.nN = 4; S.nwg = S.nM * S.nN; S.G = cx.nb; S.c = cx.bid; S.nz = 1; S.exN = 4; S.expn0 = 0; S.extra = layer == 0 ? 4 * 4 : 0;
    EpiOut E; E.ws = p.ws; E.layer = layer; E.scale = scale;
    pg8::gemm_phase<EpiOut, pg8::TileOrder>(lds, g, S, E, cx.tid);
}
__device__ __forceinline__ void ph_qp(const Ctx& cx, int layer, PG8_LAS unsigned char* lds) {
    CParams& p = get_params();
    pg8::Gemm g; g.A = (const bf16*)(p.ws + WS_H); g.Bt = (const bf16*)(p.ws + WT_WQ) + (size_t)layer * 2048 * 1024; g.zsA = 0; g.zsB = 0; g.K = 1024;
    pg8::TileOrder S; S.nM = TL / 256; S.nN = 8; S.nwg = S.nM * S.nN; S.G = cx.nb; S.c = cx.bid; S.nz = 1; S.exN = 8; S.expn0 = 0; S.extra = layer == 0 ? 4 * 8 : 0;
    EpiQp E; E.ws = p.ws;
    pg8::gemm_phase<EpiQp, pg8::TileOrder>(lds, g, S, E, cx.tid);
}

__device__ __forceinline__ void ph_peerconv(const Ctx& cx, int layer) {
    CParams& p = get_params();
    const int gt = cx.bid * NTHREADS + cx.tid, NGT = cx.nb * NTHREADS;
    const f32x4* su = (const f32x4*)(p.in[I_PU] + (size_t)layer * 16384 * 1024); const f32x4* sv = (const f32x4*)(p.in[I_PV] + (size_t)layer * 16384 * 1024);
    int* du = (int*)(p.ws + WS_PU); int* dv = (int*)(p.ws + WS_PV);
    for (int i = gt; i < 16384 * 1024 / 4; i += NGT) { const f32x4 a = __builtin_nontemporal_load(su + i) * PEER_SU, c = __builtin_nontemporal_load(sv + i) * PEER_SV;
        int wa = 0, wc = 0; wa = __builtin_amdgcn_cvt_pk_fp8_f32(a[0], a[1], wa, false); wa = __builtin_amdgcn_cvt_pk_fp8_f32(a[2], a[3], wa, true);
        wc = __builtin_amdgcn_cvt_pk_fp8_f32(c[0], c[1], wc, false); wc = __builtin_amdgcn_cvt_pk_fp8_f32(c[2], c[3], wc, true); du[i] = wa; dv[i] = wc; }
}
__device__ __forceinline__ unsigned mono_key(float s, unsigned lowbits, unsigned mask) { const unsigned u = __float_as_uint(s); const unsigned k = (u & 0x80000000u) ? ~u : (u | 0x80000000u); return (k & ~mask) | lowbits; }
__device__ __forceinline__ float mono_val(unsigned key, unsigned mask) { const unsigned k = (key & ~mask) | ((mask + 1u) >> 1); return __uint_as_float((k & 0x80000000u) ? (k & 0x7fffffffu) : ~k); }
#define TOP16_INSERT(t, v_) do { unsigned v__ = (v_); _Pragma("unroll") for (int k_ = 0; k_ < 16; ++k_) { const unsigned hi__ = t[k_] > v__ ? t[k_] : v__; v__ = t[k_] > v__ ? v__ : t[k_]; t[k_] = hi__; } } while (0)
__device__ __forceinline__ void top16_merge_pair(unsigned (&t)[16]) {
    unsigned c[16];
#pragma unroll
    for (int k = 0; k < 16; ++k) { const unsigned o = (unsigned)__shfl_xor((int)t[15 - k], 32); c[k] = t[k] > o ? t[k] : o; }
#pragma unroll
    for (int d = 8; d >= 1; d >>= 1)
#pragma unroll
        for (int k = 0; k < 16; ++k) if ((k & d) == 0) { const unsigned a = c[k], bb = c[k + d]; c[k] = a > bb ? a : bb; c[k + d] = a > bb ? bb : a; }
#pragma unroll
    for (int k = 0; k < 16; ++k) t[k] = c[k];
}
typedef float f32x16 __attribute__((ext_vector_type(16)));
__device__ __forceinline__ void ph_select(const Ctx& cx, int layer) {
    CParams& p = get_params();
    const int lane = cx.tid & 63, wave = cx.tid >> 6, l31 = lane & 31, hi = lane >> 5;
    const int gw = cx.bid * NWAVES + wave, NGW = cx.nb * NWAVES;
    const int nrows = layer == 0 ? TA : TL;
    const bf16* QP = (const bf16*)(p.ws + WS_QP); const bf16* KY = (const bf16*)(p.ws + WT_KEYS) + (size_t)layer * 8 * 2 * 128 * 128;
    for (int it = gw; it < (nrows / 32) * 8; it += NGW) {
        const int h = it & 7, r0 = (it >> 3) * 32;
        unsigned ab[2][16];
#pragma unroll
        for (int s = 0; s < 2; ++s) {
            const bf16* kp = KY + ((size_t)(h * 2 + s) * 128 + l31) * 128 + 8 * hi; const bf16* qp = QP + (size_t)(r0 + l31) * 2048 + (h * 2 + s) * 128 + 8 * hi;
            bf16x8 qf[8];
#pragma unroll
            for (int ks = 0; ks < 8; ++ks) qf[ks] = *(const bf16x8*)(qp + 16 * ks);
            unsigned t[16];
#pragma unroll
            for (int k = 0; k < 16; ++k) t[k] = 0u;
#pragma unroll 1
            for (int nt = 0; nt < 4; ++nt) {
                f32x16 acc;
#pragma unroll
                for (int r = 0; r < 16; ++r) acc[r] = 0.f;
#pragma unroll
                for (int ks = 0; ks < 8; ++ks) acc = __builtin_amdgcn_mfma_f32_32x32x16_bf16(*(const bf16x8*)(kp + (size_t)nt * 32 * 128 + 16 * ks), qf[ks], acc, 0, 0, 0);
#pragma unroll
                for (int r = 0; r < 16; ++r) { const int n = 32 * nt + (r & 3) + 8 * (r >> 2) + 4 * hi; TOP16_INSERT(t, mono_key(acc[r], 127u - (unsigned)n, 127u)); }
            }
            top16_merge_pair(t);
#pragma unroll
            for (int k = 0; k < 16; ++k) ab[s][k] = t[k];
        }
        float av[16], bv[16];
#pragma unroll
        for (int k = 0; k < 16; ++k) { av[k] = mono_val(ab[0][k], 127u); bv[k] = mono_val(ab[1][k], 127u); }
        unsigned t2[16];
#pragma unroll
        for (int k = 0; k < 16; ++k) t2[k] = 0u;
#define CELL(i1, j1, i2, j2) do { const float sv_ = hi ? av[i2] + bv[j2] : av[i1] + bv[j1]; const unsigned lb_ = hi ? 255u - (unsigned)((i2) * 16 + (j2)) : 255u - (unsigned)((i1) * 16 + (j1)); TOP16_INSERT(t2, mono_key(sv_, lb_, 255u)); } while (0)
        CELL(0, 0, 1, 9 - 8);  CELL(0, 1, 1, 2);  CELL(0, 2, 1, 3);  CELL(0, 3, 1, 4);  CELL(0, 4, 1, 5);  CELL(0, 5, 1, 6);  CELL(0, 6, 1, 7);  CELL(0, 7, 2, 0);
        CELL(0, 8, 2, 1);  CELL(0, 9, 2, 2);  CELL(0, 10, 2, 3); CELL(0, 11, 2, 4); CELL(0, 12, 3, 0); CELL(0, 13, 3, 1); CELL(0, 14, 3, 2); CELL(0, 15, 3, 3);
        CELL(1, 0, 4, 0);  CELL(4, 1, 4, 2);  CELL(5, 0, 5, 1);  CELL(6, 0, 6, 1);  CELL(7, 0, 7, 1);  CELL(8, 0, 9, 0);  CELL(10, 0, 11, 0); CELL(12, 0, 13, 0); CELL(14, 0, 15, 0);
#undef CELL
        top16_merge_pair(t2);
        const float v0 = mono_val(t2[0], 255u); float e[16], esum = 0.f; int eid[16];
#pragma unroll
        for (int k = 0; k < 16; ++k) { e[k] = __expf(mono_val(t2[k], 255u) - v0); esum += e[k];
            const unsigned c = 255u - (t2[k] & 255u), ci = c >> 4, cj = c & 15u; unsigned ka = ab[0][0], kb = ab[1][0];
#pragma unroll
            for (int q = 1; q < 16; ++q) { ka = ci == (unsigned)q ? ab[0][q] : ka; kb = cj == (unsigned)q ? ab[1][q] : kb; }
            eid[k] = (int)((127u - (ka & 127u)) * 128u + (127u - (kb & 127u))); }
        const float inv = 1.f / esum;
        if (hi == 0) { int* dst = (int*)(p.ws + WS_EID) + (size_t)(r0 + l31) * 128 + h * 16;
#pragma unroll
            for (int k = 0; k < 16; k += 4) *(u32x4*)(dst + k) = (u32x4){(unsigned)eid[k], (unsigned)eid[k + 1], (unsigned)eid[k + 2], (unsigned)eid[k + 3]}; }
        else { float* dst = (float*)(p.ws + WS_EG) + (size_t)(r0 + l31) * 128 + h * 16;
#pragma unroll
            for (int k = 0; k < 16; k += 4) *(f32x4*)(dst + k) = (f32x4){e[k] * inv, e[k + 1] * inv, e[k + 2] * inv, e[k + 3] * inv}; }
    }
}
__device__ __forceinline__ void fp8x16_to_f32(const u32x4 w, f32x2 (&f)[8]) {
    f[0] = __builtin_amdgcn_cvt_pk_f32_fp8((int)w.x, false); f[1] = __builtin_amdgcn_cvt_pk_f32_fp8((int)w.x, true); f[2] = __builtin_amdgcn_cvt_pk_f32_fp8((int)w.y, false); f[3] = __builtin_amdgcn_cvt_pk_f32_fp8((int)w.y, true);
    f[4] = __builtin_amdgcn_cvt_pk_f32_fp8((int)w.z, false); f[5] = __builtin_amdgcn_cvt_pk_f32_fp8((int)w.z, true); f[6] = __builtin_amdgcn_cvt_pk_f32_fp8((int)w.w, false); f[7] = __builtin_amdgcn_cvt_pk_f32_fp8((int)w.w, true);
}
__device__ __forceinline__ void ph_gather(const Ctx& cx, int layer, float scale) {
    CParams& p = get_params();
    const int lane = cx.tid & 63, wave = __builtin_amdgcn_readfirstlane(cx.tid >> 6);
    const int gw = cx.bid * NWAVES + wave, NGW = cx.nb * NWAVES;
    const int nrows = layer == 0 ? TA : TL;
    const __amdgpu_buffer_rsrc_t ru = __builtin_amdgcn_make_buffer_rsrc((void*)uni_ptr(p.ws + WS_PU), (short)0, 16384 * 1024, 0x00020000);
    const __amdgpu_buffer_rsrc_t rv = __builtin_amdgcn_make_buffer_rsrc((void*)uni_ptr(p.ws + WS_PV), (short)0, 16384 * 1024, 0x00020000);
    const unsigned voff = (unsigned)lane * 16u;
    float* X = (float*)(p.ws + WS_XCUR);
    const int ex = ((lane >> 5) & 1) * 8 + ((lane >> 4) & 1) * 4 + ((lane >> 3) & 1) * 2 + ((lane >> 2) & 1);
    for (int r_ = gw; r_ < nrows; r_ += NGW) {
        int r = __builtin_amdgcn_readfirstlane(r_); asm volatile("" : "+s"(r));
        f32x2 o[8]; unsigned xw[8];
        { const u32x4 w0 = *(const u32x4*)((const bf16*)(p.ws + WS_H) + (size_t)r * 1024 + lane * 16), w1 = *(const u32x4*)((const bf16*)(p.ws + WS_H) + (size_t)r * 1024 + lane * 16 + 8);
          xw[0] = w0.x; xw[1] = w0.y; xw[2] = w0.z; xw[3] = w0.w; xw[4] = w1.x; xw[5] = w1.y; xw[6] = w1.z; xw[7] = w1.w; }
#pragma unroll
        for (int j = 0; j < 8; ++j) o[j] = (f32x2){0.f, 0.f};
        const int e0 = ((const int*)(p.ws + WS_EID))[(size_t)r * 128 + lane], e1 = ((const int*)(p.ws + WS_EID))[(size_t)r * 128 + 64 + lane];
        const float g0 = ((const float*)(p.ws + WS_EG))[(size_t)r * 128 + lane], g1 = ((const float*)(p.ws + WS_EG))[(size_t)r * 128 + 64 + lane];
        u32x4 uw[16], vw[16];
#pragma unroll
        for (int k = 0; k < 16; ++k) uw[k] = __builtin_amdgcn_raw_buffer_load_b128(ru, voff, (unsigned)__builtin_amdgcn_readlane(e0, k) * 1024u, 0);
#pragma unroll
        for (int hh = 0; hh < 8; ++hh) {
            const int ev = hh < 4 ? e0 : e1; const float gv = hh < 4 ? g0 : g1; const int lb = (hh & 3) * 16;
#pragma unroll
            for (int k = 0; k < 16; ++k) vw[k] = __builtin_amdgcn_raw_buffer_load_b128(rv, voff, (unsigned)__builtin_amdgcn_readlane(ev, lb + k) * 1024u, 0);
            float d[16];
#pragma unroll
            for (int k = 0; k < 16; ++k) { f32x2 f[8]; fp8x16_to_f32(uw[k], f);
                f32x2 s = f[0] * (f32x2){__uint_as_float(xw[0] << 16), __uint_as_float(xw[0] & 0xffff0000u)};
#pragma unroll
                for (int j = 1; j < 8; ++j) s += f[j] * (f32x2){__uint_as_float(xw[j] << 16), __uint_as_float(xw[j] & 0xffff0000u)};
                d[k] = s.x + s.y; __builtin_amdgcn_sched_barrier(0); }
            __builtin_amdgcn_sched_barrier(0);
            if (hh < 7) { const int evn = hh + 1 < 4 ? e0 : e1; const int lbn = ((hh + 1) & 3) * 16;
#pragma unroll
                for (int k = 0; k < 16; ++k) uw[k] = __builtin_amdgcn_raw_buffer_load_b128(ru, voff, (unsigned)__builtin_amdgcn_readlane(evn, lbn + k) * 1024u, 0); }
            __builtin_amdgcn_sched_barrier(0);
            float a8[8], a4[4], a2_[2];
            { const bool bt = lane & 32;
#pragma unroll
              for (int i = 0; i < 8; ++i) { const float send = bt ? d[i] : d[i + 8], keep = bt ? d[i + 8] : d[i]; a8[i] = keep + __shfl_xor(send, 32); } }
            { const bool bt = lane & 16;
#pragma unroll
              for (int i = 0; i < 4; ++i) { const float send = bt ? a8[i] : a8[i + 4], keep = bt ? a8[i + 4] : a8[i]; a4[i] = keep + __shfl_xor(send, 16); } }
            { const bool bt = lane & 8;
#pragma unroll
              for (int i = 0; i < 2; ++i) { const float send = bt ? a4[i] : a4[i + 2], keep = bt ? a4[i + 2] : a4[i]; a2_[i] = keep + __shfl_xor(send, 8); } }
            float tot; { const bool bt = lane & 4; const float send = bt ? a2_[0] : a2_[1], keep = bt ? a2_[1] : a2_[0]; tot = keep + __shfl_xor(send, 4); }
            tot += __shfl_xor(tot, 2); tot += __shfl_xor(tot, 1);
            const float wv = __shfl(gv, lb + ex) * gelu_tanh(tot * (1.f / PEER_SU));
#pragma unroll
            for (int k = 0; k < 16; ++k) {
                const float wk = __uint_as_float((unsigned)__builtin_amdgcn_readlane((int)__float_as_uint(wv), ((k & 8) ? 32 : 0) + ((k & 4) ? 16 : 0) + ((k & 2) ? 8 : 0) + ((k & 1) ? 4 : 0)));
                f32x2 f[8]; fp8x16_to_f32(vw[k], f);
#pragma unroll
                for (int j = 0; j < 8; ++j) o[j] += wk * f[j]; __builtin_amdgcn_sched_barrier(0); }
        }
        const float* g2 = (const float*)(p.ws + WS_MODV) + ((size_t)layer * 5 + row_mi(r)) * 6144 + 5120 + lane * 16;
        float* xp = X + (size_t)r * 1024 + lane * 16;
        float ss = 0.f; f32x4 xn[4];
#pragma unroll
        for (int j = 0; j < 4; ++j) { const f32x4 ov = (f32x4){o[2 * j].x, o[2 * j].y, o[2 * j + 1].x, o[2 * j + 1].y} * (scale / PEER_SV);
            f32x4 xv = *(const f32x4*)(xp + 4 * j); xv += *(const f32x4*)(g2 + 4 * j) * ov; *(f32x4*)(xp + 4 * j) = xv; xn[j] = xv;
            ss += xv[0] * xv[0] + xv[1] * xv[1] + xv[2] * xv[2] + xv[3] * xv[3]; }
        if (layer == DEPTH - 1) {
            const float rs = rsqrtf(wave_sum(ss) * (1.f / DM) + NORM_EPS);
#pragma unroll
            for (int j = 0; j < 4; ++j) *(f32x4*)(p.out + (size_t)r * 1024 + lane * 16 + 4 * j) = xn[j] * rs * *(const f32x4*)(p.in[I_FG] + lane * 16 + 4 * j);
        }
    }
}

constexpr int NPL = 11, NPHASE = 1 + DEPTH * NPL;
#ifndef ONLY
#define ONLY -1
#endif
#ifndef NOT
#define NOT -1
#endif
#define ON(n) ((ONLY < 0 || ONLY == (n)) && NOT != (n))
#ifndef PROBE_HAS
#define PROBE_HAS(n) false
#endif
#define REPN(n) (PROBE_HAS(n) ? 2 : 1)
#define RUN(n, call) do { { MKCX(); if (ON(n)) { const int rep_ = 0; (void)rep_; call; } } if (REPN(n) > 1) { __syncthreads(); { MKCX(); if (ON(n)) { const int rep_ = 1; (void)rep_; call; } } __syncthreads(); } } while (0)
#define MKCX() Ctx cx; cx.tid = threadIdx.x; cx.bid = blockIdx.x; cx.nb = gridDim.x; asm volatile("" : "+v"(cx.tid), "+s"(cx.bid), "+s"(cx.nb))
#define IN(k) (lo <= (k) && (k) < hi)
#define SEAM(k) do { if (IN(k) && IN((k) + 1)) { XcdBarrier bar_; bar_.bar = (unsigned*)(get_params().ws + WS_CTL) + 4096; bar_.x = xb_xcc_id(); bar_.st = st; xcd_barrier(bar_); } } while (0)
template <int LAYER> __device__ __forceinline__ void layer_program(const int lo, const int hi, float* sm, PG8_LAS unsigned char* lds, volatile LAS unsigned* st) {
    constexpr int B = 1 + LAYER * NPL;
    if (IN(B + 0)) { RUN(0, ph_norm(cx, LAYER, 0, 0)); RUN(50, ph_filters(cx, LAYER)); } SEAM(B + 0);
    if (IN(B + 1)) { RUN(1, ph_inproj(cx, LAYER, lds)); } SEAM(B + 1);
    if (IN(B + 2)) { RUN(2, ph_attn(cx, LAYER, sm)); __syncthreads(); RUN(20, ph_hypre(cx, LAYER, sm)); __syncthreads(); RUN(21, ph_s5states(cx, LAYER, sm)); } SEAM(B + 2);
    if (IN(B + 3)) { RUN(3, ph_hyfft(cx, LAYER, sm, rep_ + 1 < REPN(3))); __syncthreads(); RUN(31, ph_hyconv_ctx(cx, LAYER, sm)); __syncthreads(); RUN(30, ph_s5out(cx, LAYER, sm)); } SEAM(B + 3);
    if (IN(B + 4)) { RUN(4, ph_glu(cx, LAYER, lds)); __syncthreads(); RUN(40, ph_hypost(cx, LAYER, sm)); } SEAM(B + 4);
    if (IN(B + 5)) { RUN(5, ph_merge(cx, LAYER, lds)); } SEAM(B + 5);
    if (IN(B + 6)) { RUN(6, ph_outproj(cx, LAYER, lds, 1.f / REPN(6))); } SEAM(B + 6);
    if (IN(B + 7)) { RUN(7, ph_norm(cx, LAYER, 1, LAYER == DEPTH - 1)); if (LAYER + 1 < DEPTH) { RUN(70, ph_s5tables(cx, LAYER + 1)); } RUN(71, ph_peerconv(cx, LAYER)); } SEAM(B + 7);
    if (IN(B + 8)) { RUN(8, ph_qp(cx, LAYER, lds)); } SEAM(B + 8);
    if (IN(B + 9)) { RUN(9, ph_select(cx, LAYER)); } SEAM(B + 9);
    if (IN(B + 10)) { RUN(10, ph_gather(cx, LAYER, 1.f / REPN(10))); } SEAM(B + 10);
}
__global__ void __launch_bounds__(NTHREADS, 2) mk_fwd(Params p) {
    extern __shared__ __attribute__((aligned(16))) unsigned char lds_raw[];
    float* sm = (float*)lds_raw; PG8_LAS unsigned char* lds = (PG8_LAS unsigned char*)lds_raw;
    volatile LAS unsigned* st = (volatile LAS unsigned*)(lds + LDS_MISC);
    if (threadIdx.x < 4) st[threadIdx.x] = 0u;
    __syncthreads();
    const int lo = p.ph_lo, hi = p.ph_hi;
    if (hi - lo > 1) (void)xcd_barrier_post((unsigned*)(p.ws + WS_CTL) + 4096, st);
    if (IN(0)) { RUN(100, ph_prologue(cx, sm)); RUN(101, ph_convert(cx)); RUN(102, ph_s5tables(cx, 0)); } SEAM(0);
    layer_program<0>(lo, hi, sm, lds, st);
    layer_program<1>(lo, hi, sm, lds, st);
}
}

extern "C" void kernel_launch(void* const* d_in, const int* in_sizes, int n_in, void* d_out, int out_size, void* d_ws, size_t ws_size, hipStream_t stream) {
    static int grid = 0;
    if (grid == 0) {
        if (n_in != 40 || out_size != TL * DM || ws_size < WS_END) { fprintf(stderr, "kernel_launch: unexpected shapes (n_in %d out %d ws %zu)\n", n_in, out_size, ws_size); grid = -1; return; }
        int dev = 0, cus = 0;
        if (hipGetDevice(&dev) != hipSuccess || hipDeviceGetAttribute(&cus, hipDeviceAttributeMultiprocessorCount, dev) != hipSuccess) { grid = -1; return; }
        if (hipFuncSetAttribute((const void*)mk_fwd, hipFuncAttributeMaxDynamicSharedMemorySize, LDS_BYTES) != hipSuccess) { fprintf(stderr, "kernel_launch: hipFuncSetAttribute failed\n"); grid = -1; return; }
        grid = cus;
    }
    if (grid < 0) return;
    (void)hipMemsetAsync((char*)d_ws + WS_CTL, 0, 1 * MiB, stream);
    Params a{};
    for (int i = 0; i < 40; ++i) a.in[i] = (const float*)d_in[i];
    a.out = (float*)d_out; a.ws = (unsigned char*)d_ws;
#if PER_PHASE_LAUNCH
    for (int ph = 0; ph < NPHASE; ++ph) { a.ph_lo = ph; a.ph_hi = ph + 1; hipLaunchKernelGGL(mk_fwd, dim3(grid), dim3(NTHREADS), LDS_BYTES, stream, a); }
#else
    a.ph_lo = 0; a.ph_hi = NPHASE; hipLaunchKernelGGL(mk_fwd, dim3(grid), dim3(NTHREADS), LDS_BYTES, stream, a);
#endif
}
```

```cpp
#include <hip/hip_runtime.h>
#include <stdint.h>
#include <math.h>
#include <stdio.h>

#ifndef PER_PHASE_LAUNCH
#define PER_PHASE_LAUNCH 0
#endif

namespace {
typedef unsigned short bf16;
typedef float f32x4 __attribute__((ext_vector_type(4)));
typedef unsigned u32x2 __attribute__((ext_vector_type(2)));
typedef unsigned u32x4 __attribute__((ext_vector_type(4)));
typedef short bf16x8 __attribute__((ext_vector_type(8)));
#define LAS __attribute__((address_space(3)))

constexpr int DM = 1024, NBATCH = 4, SEQ = 4096, CTXL = 256, DEPTH = 2;
constexpr int TL = NBATCH * SEQ, TC = NBATCH * CTXL, TA = TL + TC;
constexpr int INW = 5888, COL_K = 512, COL_V = 640, COL_S5 = 768, COL_HY = 1280, COL_GATE = 2816;
constexpr int NTHREADS = 512, NWAVES = 8;
constexpr float NORM_EPS = 1e-6f;
constexpr float HY_FAST = 15.350567286626973f, HY_SLOW = 3.0701134573253945f;

constexpr size_t MiB = 1u << 20;
constexpr size_t WS_CTL = 0;
constexpr size_t WS_XCUR = 1 * MiB;
constexpr size_t WS_MODV = 69 * MiB;
constexpr size_t WS_ROPE = WS_MODV + 512 * 1024;
constexpr size_t WS_S5A = 70 * MiB;
constexpr size_t WS_S5B = 70 * MiB + 256 * 1024;
constexpr size_t WS_FILT = 72 * MiB;
constexpr size_t FILT_CTX_OFF = 16 * MiB;
constexpr size_t WS_WTS = 89 * MiB;
constexpr size_t WT_IN = WS_WTS;
constexpr size_t WT_GLU = WT_IN + 23 * MiB;
constexpr size_t WT_BR = WT_GLU + 1 * MiB;
constexpr size_t WT_OUT = WT_BR + 6 * MiB;
constexpr size_t WT_WQ = WT_OUT + 4 * MiB;
constexpr size_t WT_KEYS = WT_WQ + 8 * MiB;
constexpr size_t WS_H = 132 * MiB;
constexpr size_t WS_VV = WS_H;
constexpr size_t WS_VVC = WS_H + 32 * MiB;
constexpr size_t WS_Q = 166 * MiB;
constexpr size_t WS_K = 183 * MiB;
constexpr size_t WS_V = WS_K + (size_t)TA * 128 * 2;
constexpr size_t WS_U = WS_V + (size_t)TA * 128 * 2;
constexpr size_t WS_Z = WS_U + (size_t)TA * 512 * 2;
constexpr size_t WS_QP = WS_Q;
constexpr size_t WS_G = 260 * MiB;
constexpr size_t WS_ATT = 362 * MiB;
constexpr size_t WS_HY = WS_ATT + 17 * MiB, WS_S5O = WS_HY + 17 * MiB, WS_S5Y = WS_S5O + 17 * MiB;
constexpr size_t WS_M = 430 * MiB;
constexpr size_t WS_S5TMP = WS_M;
constexpr size_t WS_S5E = WS_M;
constexpr size_t WS_S5P = WS_M + 16 * MiB;
constexpr size_t WS_S5K = WS_M + 32 * MiB;
constexpr size_t WS_S5A64 = WS_S5A + 64 * 1024;
constexpr size_t WS_S5C = WS_S5A + 128 * 1024;
constexpr size_t WS_X0C = 464 * MiB;
constexpr size_t WS_EID = 481 * MiB;
constexpr size_t WS_EG = WS_EID + (size_t)TA * 128 * 4;
constexpr size_t WS_PU = WS_G;
constexpr size_t WS_PV = WS_G + 16 * MiB;
constexpr float PEER_SU = 512.f, PEER_SV = 64.f;
constexpr size_t WS_PART = WS_QP;
constexpr size_t WS_POUT = WS_ATT;
constexpr size_t WS_HIN = WS_EID;
constexpr size_t WS_END = 498 * MiB;
constexpr int LDS_STAGE = 131072;
constexpr int LDS_MISC = LDS_STAGE;
constexpr int LDS_BYTES = 147456;

struct Params {
    const float* in[40];
    float* out;
    unsigned char* ws;
    int ph_lo, ph_hi;
};
enum { I_X = 0, I_C, I_CTX, I_CCTX, I_MODW, I_MODB, I_N1G, I_N2G, I_INW, I_GATEB, I_SINK, I_HSW, I_HSB, I_HW1, I_HB1, I_HF1, I_HW2, I_HB2, I_HF2, I_HW3,
       I_HBIAS, I_SARE, I_SAIM, I_SLDT, I_SBRE, I_SBIM, I_SCRE, I_SCIM, I_SD, I_GLUW, I_GLUB, I_BRA, I_BRH, I_BRS, I_OUTW, I_WQ, I_PKEYS, I_PU, I_PV, I_FG };

struct Ctx { int tid, bid, nb; };
typedef __attribute__((address_space(4))) const Params CParams;
__device__ __forceinline__ CParams& get_params() { CParams* q = (CParams*)__builtin_amdgcn_kernarg_segment_ptr(); asm volatile("" : "+s"(q)); return *q; }
__device__ __forceinline__ float bf2f(bf16 v) { return __uint_as_float((unsigned)v << 16); }
__device__ __forceinline__ bf16 f2bf(float f) { unsigned u = __float_as_uint(f); return (bf16)((u + 0x7fffu + ((u >> 16) & 1u)) >> 16); }
__device__ __forceinline__ unsigned pk2(float lo, float hi) { return (unsigned)f2bf(lo) | ((unsigned)f2bf(hi) << 16); }
__device__ __forceinline__ float wave_sum(float v) {
#pragma unroll
    for (int o = 32; o > 0; o >>= 1) v += __shfl_xor(v, o);
    return v;
}
__device__ __forceinline__ float fsin_rev(float rev) { return __builtin_amdgcn_sinf(rev); }
__device__ __forceinline__ float fcos_rev(float rev) { return __builtin_amdgcn_cosf(rev); }
__device__ __forceinline__ float fsin(float x) { return __builtin_amdgcn_sinf(x * 0.15915494309189535f); }
__device__ __forceinline__ float fcos(float x) { return __builtin_amdgcn_cosf(x * 0.15915494309189535f); }
__device__ __forceinline__ float sigmoidf_(float x) { return 1.f / (1.f + __expf(-x)); }
__device__ __forceinline__ float gelu_tanh(float x) { const float u = 0.7978845608028654f * (x + 0.044715f * x * x * x); const float e = __expf(2.f * u); return 0.5f * x * (2.f - 2.f / (e + 1.f)); }
__device__ __forceinline__ int row_mi(int r) { return r < TL ? (r >> 12) : 4; }
__device__ __forceinline__ int row_b(int r) { return r < TL ? (r >> 12) : ((r - TL) >> 8); }

#define XB_TMO      128
#define XB_XCNT(j)  (256  + 64 * (j))
#define XB_XSUB(j)  (1280 + 64 * (j))
#define XB_XGEN(j)  (2304 + 64 * (j))
#define XB_TOP      3328
#define XB_TOPGEN   3392
#define XCD_BAR_WORDS 3456
#define XB_SPIN_CAP (1u << 27)
__device__ __forceinline__ unsigned xb_ld(unsigned* p)              { return __hip_atomic_load(p, __ATOMIC_RELAXED, __HIP_MEMORY_SCOPE_AGENT); }
__device__ __forceinline__ unsigned xb_add(unsigned* p, unsigned v) { return __hip_atomic_fetch_add(p, v, __ATOMIC_RELAXED, __HIP_MEMORY_SCOPE_AGENT); }
__device__ __forceinline__ unsigned xb_xcc_id() { return (unsigned)__builtin_amdgcn_s_getreg((3 << 11) | 20) & 0xFu; }
#define XB_SPIN(cond, bar) do { unsigned _sp = 0; while (cond) { __builtin_amdgcn_s_sleep(1); \
    if ((++_sp & 255u) == 0u) { if (xb_ld(&(bar)[XB_TMO])) break; if (_sp > XB_SPIN_CAP) { atomicAdd(&(bar)[XB_TMO], 1u); break; } } } } while (0)
struct XcdBarrier { unsigned* bar; unsigned x; volatile LAS unsigned* st; };
__device__ __forceinline__ XcdBarrier xcd_barrier_post(unsigned* bar, volatile LAS unsigned* st) {
    XcdBarrier b; b.bar = bar; b.x = xb_xcc_id(); b.st = st;
    if (threadIdx.x == 0) (void)xb_add(&bar[XB_XCNT(b.x)], 1u);
    return b;
}
__device__ __forceinline__ void xcd_barrier_complete(unsigned* bar, unsigned x, unsigned& nloc, unsigned& nx) {
    const unsigned G = gridDim.x * gridDim.y * gridDim.z;
    unsigned sum, cnt, mine, sp = 0u;
    for (;;) {
        sum = 0u; cnt = 0u; mine = 0u;
#pragma unroll
        for (unsigned j = 0; j < 16; ++j) { const unsigned c = xb_ld(&bar[XB_XCNT(j)]); sum += c; cnt += (c > 0u) ? 1u : 0u; mine = (j == x) ? c : mine; }
        if (sum == G) break;
        __builtin_amdgcn_s_sleep(1);
        if ((++sp & 255u) == 0u) { if (xb_ld(&bar[XB_TMO])) break; if (sp > XB_SPIN_CAP) { atomicAdd(&bar[XB_TMO], 1u); break; } }
    }
    nloc = mine > 0u ? mine : 1u; nx = cnt > 0u ? cnt : 1u;
}
__device__ __forceinline__ void xcd_barrier(const XcdBarrier& b) {
    asm volatile("s_waitcnt vmcnt(0)" ::: "memory");
    __syncthreads();
    if (threadIdx.x == 0) {
        unsigned* bar = b.bar; asm volatile("" : "+s"(bar));
        __builtin_amdgcn_s_waitcnt(0);
        unsigned nloc = b.st[0], nx = b.st[1];
        if (nloc == 0u) { xcd_barrier_complete(bar, b.x, nloc, nx); b.st[0] = nloc; b.st[1] = nx; }
        const unsigned old = xb_add(&bar[XB_XSUB(b.x)], 1u);
        const unsigned gen = old / nloc;
        if (old + 1u == (gen + 1u) * nloc) {
            __builtin_amdgcn_fence(__ATOMIC_RELEASE, "agent");
            asm volatile("s_waitcnt vmcnt(0)" ::: "memory");
            const unsigned og = xb_add(&bar[XB_TOP], 1u);
            const unsigned tg = og / nx;
            if (og + 1u == (tg + 1u) * nx) xb_add(&bar[XB_TOPGEN], 1u);
            else XB_SPIN(xb_ld(&bar[XB_TOPGEN]) == tg, bar);
            __builtin_amdgcn_fence(__ATOMIC_ACQUIRE, "agent");
            xb_add(&bar[XB_XGEN(b.x)], 1u);
            asm volatile("s_waitcnt vmcnt(0)" ::: "memory");
        } else {
            XB_SPIN(xb_ld(&bar[XB_XGEN(b.x)]) == gen, bar);
            __builtin_amdgcn_fence(__ATOMIC_ACQUIRE, "agent");
            asm volatile("s_waitcnt vmcnt(0)" ::: "memory");
        }
    }
    __syncthreads();
}

__device__ __forceinline__ void ph_prologue(const Ctx& cx0, float* sm) {
    { CParams& p = get_params(); Ctx cx = cx0;
    const int tid = cx.tid, lane = tid & 63, wave = tid >> 6;
    const int gt = cx.bid * NTHREADS + tid, NGT = cx.nb * NTHREADS;
    const int gw = cx.bid * NWAVES + wave, NGW = cx.nb * NWAVES;
    unsigned char* ws = p.ws;
    {
        f32x4* dst = (f32x4*)(ws + WS_XCUR);
        const f32x4* sx = (const f32x4*)p.in[I_X]; const f32x4* sc = (const f32x4*)p.in[I_CTX];
        for (int i = gt; i < TL * DM / 4; i += NGT) dst[i] = sx[i];
        for (int i = gt; i < TC * DM / 4; i += NGT) dst[TL * DM / 4 + i] = sc[i];
    }
    }
    { CParams& p = get_params(); Ctx cx; cx.tid = threadIdx.x; cx.bid = blockIdx.x; cx.nb = gridDim.x; asm volatile("" : "+v"(cx.tid), "+s"(cx.bid), "+s"(cx.nb));
      const int tid = cx.tid, lane = tid & 63, wave = tid >> 6; const int gt = cx.bid * NTHREADS + tid, NGT = cx.nb * NTHREADS; const int gw = cx.bid * NWAVES + wave, NGW = cx.nb * NWAVES; unsigned char* ws = p.ws; (void)lane; (void)gt; (void)NGT; (void)gw; (void)NGW; (void)ws;
    {
        float* sil = sm;
        float* red = sm + 5 * 1024;
        bool have = false;
        for (int it = cx.bid; it < 192; it += cx.nb) {
            if (!have) {
                for (int i = tid; i < 5 * 1024; i += NTHREADS) { const float v = i < 4096 ? p.in[I_C][i] : p.in[I_CCTX][i - 4096]; sil[i] = v / (1.f + __expf(-v)); }
                have = true; __syncthreads();
            }
            const int layer = it / 96, col = (it % 96) * 64 + lane, kp = wave;
            const float* W = p.in[I_MODW] + (size_t)layer * DM * 6144 + col;
            float a0 = 0, a1 = 0, a2 = 0, a3 = 0, a4 = 0;
            for (int k = kp * 128; k < kp * 128 + 128; ++k) { const float w = W[(size_t)k * 6144]; a0 += sil[k] * w; a1 += sil[1024 + k] * w; a2 += sil[2048 + k] * w; a3 += sil[3072 + k] * w; a4 += sil[4096 + k] * w; }
            red[(kp * 5 + 0) * 64 + lane] = a0; red[(kp * 5 + 1) * 64 + lane] = a1; red[(kp * 5 + 2) * 64 + lane] = a2; red[(kp * 5 + 3) * 64 + lane] = a3; red[(kp * 5 + 4) * 64 + lane] = a4;
            __syncthreads();
            if (tid < 320) { const int j = tid >> 6; float s = 0; for (int q = 0; q < 8; ++q) s += red[(q * 5 + j) * 64 + lane];
                ((float*)(ws + WS_MODV))[((size_t)layer * 5 + j) * 6144 + col] = s + p.in[I_MODB][layer * 6144 + col]; }
            __syncthreads();
        }
    }
    }
    { CParams& p = get_params(); Ctx cx; cx.tid = threadIdx.x; cx.bid = blockIdx.x; cx.nb = gridDim.x; asm volatile("" : "+v"(cx.tid), "+s"(cx.bid), "+s"(cx.nb));
      const int tid = cx.tid, lane = tid & 63, wave = tid >> 6; const int gt = cx.bid * NTHREADS + tid, NGT = cx.nb * NTHREADS; const int gw = cx.bid * NWAVES + wave, NGW = cx.nb * NWAVES; unsigned char* ws = p.ws; (void)lane; (void)gt; (void)NGT; (void)gw; (void)NGW; (void)ws;
    for (int i = gt; i < 64 * 16; i += NGT) { const int pos = i >> 4, f = i & 15; const float ang = (float)pos * exp2f(-(float)f * (13.287712379549449f / 16.f));
        ((float*)(ws + WS_ROPE))[i * 2] = fcos(ang); ((float*)(ws + WS_ROPE))[i * 2 + 1] = fsin(ang); }
    }
    { CParams& p = get_params(); Ctx cx; cx.tid = threadIdx.x; cx.bid = blockIdx.x; cx.nb = gridDim.x; asm volatile("" : "+v"(cx.tid), "+s"(cx.bid), "+s"(cx.nb));
      const int tid = cx.tid, lane = tid & 63, wave = tid >> 6; const int gt = cx.bid * NTHREADS + tid, NGT = cx.nb * NTHREADS; const int gw = cx.bid * NWAVES + wave, NGW = cx.nb * NWAVES; unsigned char* ws = p.ws; (void)lane; (void)gt; (void)NGT; (void)gw; (void)NGW; (void)ws;
    for (int i = gt; i < 2 * 2 * 32 * 64; i += NGT) {
        const int g = (i >> 6) & 31, ld = i >> 11;
        const float are = fminf(p.in[I_SARE][i], -1e-4f), aim = p.in[I_SAIM][i];
        const float dt = __expf(p.in[I_SLDT][ld * 32 + g]);
        const float er = __expf(are * dt), abr = er * fcos(aim * dt), abi = er * fsin(aim * dt);
        const float nr = abr - 1.0f, ni = abi, den = are * are + aim * aim;
        const float cr = (nr * are + ni * aim) / den, ci = (ni * are - nr * aim) / den;
        ((float*)(ws + WS_S5A))[i * 2] = abr; ((float*)(ws + WS_S5A))[i * 2 + 1] = abi;
        ((float*)(ws + WS_S5C))[i * 2] = are * dt; ((float*)(ws + WS_S5C))[i * 2 + 1] = aim * dt;
        for (int h = 0; h < 16; ++h) { const float br = p.in[I_SBRE][(size_t)i * 16 + h], bi = p.in[I_SBIM][(size_t)i * 16 + h];
            ((float*)(ws + WS_S5B))[((size_t)i * 16 + h) * 2] = cr * br - ci * bi; ((float*)(ws + WS_S5B))[((size_t)i * 16 + h) * 2 + 1] = cr * bi + ci * br; }
    }
    }
}


__device__ __forceinline__ void ph_filters(const Ctx& cx, int layer, float* sm) {
    CParams& p = get_params();
    const int tid = cx.tid, lane = tid & 63, wave = __builtin_amdgcn_readfirstlane(tid >> 6);
    float* Hs = sm;
    const float* w1 = p.in[I_HW1] + layer * 33 * 64; const float* w2 = p.in[I_HW2] + layer * 64 * 64; const float* w3 = p.in[I_HW3] + layer * 64 * 1024;
    for (int it = cx.bid; it < 2 * 68; it += cx.nb) {
        const int tile = it >> 1, ch = it & 1, st = tile >= 64 ? 1 : 0, tb = st ? (tile - 64) * 64 : tile * 64, L = st ? CTXL : SEQ;
        __syncthreads();
        for (int tt = wave; tt < 64; tt += NWAVES) {
            const int t = tb + tt; const float tn = (float)t / (float)L;
            float z = 0.f;
            if (lane == 0) z = tn; else if (lane <= 16) z = fcos_rev(tn * (float)lane); else if (lane <= 32) z = fsin_rev(tn * (float)(lane - 16));
            float a = p.in[I_HB1][layer * 64 + lane];
            for (int e = 0; e < 33; ++e) a += __shfl(z, e) * w1[e * 64 + lane];
            const float h1 = fsin(p.in[I_HF1][layer * 64 + lane] * a);
            float a2 = p.in[I_HB2][layer * 64 + lane];
            for (int j = 0; j < 64; ++j) a2 += __shfl(h1, j) * w2[j * 64 + lane];
            Hs[lane * 65 + tt] = fsin(p.in[I_HF2][layer * 64 + lane] * a2);
        }
        __syncthreads();
        float h[64];
#pragma unroll
        for (int k = 0; k < 64; ++k) h[k] = Hs[k * 65 + lane];
        const int t = tb + lane; const float tw = (float)t / (float)(L - 1);
        float* fbase = (float*)(p.ws + WS_FILT + (st ? FILT_CTX_OFF : 0));
#pragma unroll 1
        for (int j = 0; j < 64; ++j) {
            const int col = ch * 512 + wave * 64 + j;
            const float* wc = w3 + col; float f = 0.f;
#pragma unroll
            for (int k = 0; k < 64; ++k) f += h[k] * wc[k * 1024];
            const int c = col & 511;
            const float rate = HY_FAST + (HY_SLOW - HY_FAST) * ((float)c / 511.f);
            fbase[((size_t)ch * 512 + c) * L + t] = f * __expf(-tw * rate);
        }
    }
}
__device__ __forceinline__ void conv_T(const Ctx& cx, const float* W, int K, int N, bf16* dst, bool perm) {
    const int gt = cx.bid * NTHREADS + cx.tid, NGT = cx.nb * NTHREADS;
    for (int it = gt; it < N * (K / 8); it += NGT) {
        const int n = it % N, k0 = (it / N) * 8;
        const int sn = (perm && n < COL_V) ? ((n & ~63) + ((n & 63) >> 1) + 32 * (n & 1)) : n;
        const float* s = W + (size_t)k0 * N + sn;
        u32x4 w; w.x = pk2(s[0], s[N]); w.y = pk2(s[2 * (size_t)N], s[3 * (size_t)N]); w.z = pk2(s[4 * (size_t)N], s[5 * (size_t)N]); w.w = pk2(s[6 * (size_t)N], s[7 * (size_t)N]);
        *(u32x4*)(dst + (size_t)n * K + k0) = w;
    }
}
__device__ __forceinline__ void ph_convert(const Ctx& cx0) {
#define RELAUNDER() CParams& p = get_params(); Ctx cx; cx.tid = threadIdx.x; cx.bid = blockIdx.x; cx.nb = gridDim.x; asm volatile("" : "+v"(cx.tid), "+s"(cx.bid), "+s"(cx.nb));
#pragma unroll 1
    for (int layer = 0; layer < DEPTH; ++layer) {
        { RELAUNDER(); conv_T(cx, p.in[I_INW] + (size_t)layer * DM * INW, DM, INW, (bf16*)(p.ws + WT_IN) + (size_t)layer * INW * DM, true); }
        { RELAUNDER(); conv_T(cx, p.in[I_GLUW] + (size_t)layer * 512 * 512, 512, 512, (bf16*)(p.ws + WT_GLU) + (size_t)layer * 512 * 512, false); }
        { RELAUNDER(); conv_T(cx, p.in[I_BRA] + (size_t)layer * 512 * 1024, 512, 1024, (bf16*)(p.ws + WT_BR) + (size_t)(layer * 3 + 0) * 1024 * 512, false); }
        { RELAUNDER(); conv_T(cx, p.in[I_BRH] + (size_t)layer * 512 * 1024, 512, 1024, (bf16*)(p.ws + WT_BR) + (size_t)(layer * 3 + 1) * 1024 * 512, false); }
        { RELAUNDER(); conv_T(cx, p.in[I_BRS] + (size_t)layer * 512 * 1024, 512, 1024, (bf16*)(p.ws + WT_BR) + (size_t)(layer * 3 + 2) * 1024 * 512, false); }
        { RELAUNDER(); conv_T(cx, p.in[I_OUTW] + (size_t)layer * 1024 * 1024, 1024, 1024, (bf16*)(p.ws + WT_OUT) + (size_t)layer * 1024 * 1024, false); }
        { RELAUNDER(); conv_T(cx, p.in[I_WQ] + (size_t)layer * 1024 * 2048, 1024, 2048, (bf16*)(p.ws + WT_WQ) + (size_t)layer * 2048 * 1024, false); }
    }
    { RELAUNDER(); const int gt = cx.bid * NTHREADS + cx.tid, NGT = cx.nb * NTHREADS;
      for (int i = gt; i < 2 * 8 * 2 * 128 * 128 / 4; i += NGT) { const f32x4 v = ((const f32x4*)p.in[I_PKEYS])[i]; u32x2 w; w.x = pk2(v[0], v[1]); w.y = pk2(v[2], v[3]); ((u32x2*)(p.ws + WT_KEYS))[i] = w; } }
#undef RELAUNDER
    (void)cx0;
}

__device__ __forceinline__ void ph_norm(const Ctx& cx, int layer, int which, int nrows_lat_only) {
    CParams& p = get_params();
    const int lane = cx.tid & 63, wave = cx.tid >> 6;
    const int gw = cx.bid * NWAVES + wave, NGW = cx.nb * NWAVES;
    const float* g = p.in[which ? I_N2G : I_N1G] + layer * DM;
    const float* xc = (const float*)(p.ws + WS_XCUR);
    bf16* H = (bf16*)(p.ws + WS_H);
    const int nrows = nrows_lat_only ? TL : TA;
    for (int r = gw; r < nrows; r += NGW) {
        const float* mv = (const float*)(p.ws + WS_MODV) + ((size_t)layer * 5 + row_mi(r)) * 6144 + (which ? 3072 : 0);
        f32x4 v[4]; float s = 0.f;
#pragma unroll
        for (int j = 0; j < 4; ++j) { v[j] = *(const f32x4*)(xc + (size_t)r * DM + j * 256 + lane * 4); s += v[j].x * v[j].x + v[j].y * v[j].y + v[j].z * v[j].z + v[j].w * v[j].w; }
        const float rs = rsqrtf(wave_sum(s) * (1.f / DM) + NORM_EPS);
#pragma unroll
        for (int j = 0; j < 4; ++j) { const int c = j * 256 + lane * 4;
            const f32x4 gg = *(const f32x4*)(g + c), sh = *(const f32x4*)(mv + c), sc = *(const f32x4*)(mv + 1024 + c);
            const f32x4 y = v[j] * rs * gg; const f32x4 h = y * (1.f + sc) + sh;
            u32x2 w; w.x = pk2(h.x, h.y); w.y = pk2(h.z, h.w); *(u32x2*)(H + (size_t)r * DM + c) = w; }
    }
}


namespace pg8 {
#define PG8_LAS __attribute__((address_space(3)))
typedef unsigned short bf16_t;
typedef short bf16x8 __attribute__((ext_vector_type(8)));
constexpr int BM = 256, BK = 64, HALF = 128, HTB = HALF * BK * 2, STAGE_BYTES = 8 * HTB, NXCD = 8, WGM = 8;
__host__ __device__ __forceinline__ int lds_byte(int r, int c) { const int st = (r >> 4) * 2 + (c >> 5), rr = r & 15, cc = c & 31, ob = rr * 64 + cc * 2; return st * 1024 + (ob ^ (((ob >> 9) & 1) << 5)); }
__host__ __device__ __forceinline__ void stage_rc(int b, int& R, int& C) { const int st = b / 1024, sb = b % 1024, swz = sb ^ (((sb >> 9) & 1) << 5); R = (st >> 1) * 16 + swz / 64; C = (st & 1) * 32 + (swz % 64) / 2; }
__host__ __device__ __forceinline__ int perm32(int rho) { const int n = rho >> 4, i = rho & 15; return 8 * (i >> 2) + 4 * n + (i & 3); }
struct Unit { int pm, pn, z; };
struct Gemm { const bf16_t* A; const bf16_t* Bt; size_t zsA, zsB; int K; };
__device__ __forceinline__ const bf16_t* selA(const Gemm& g, int z) { return g.A + (size_t)z * g.zsA; }
__device__ __forceinline__ const bf16_t* selB(const Gemm& g, int z) { return g.Bt + (size_t)z * g.zsB; }
struct TileOrder {
    int nM, nN, nwg, G, c, extra, exN, expn0, nz;
    __device__ __forceinline__ bool next(int i, Unit& u) const {
        const int ti = i / nz; u.z = i - ti * nz;
        const long L = (long)ti * G + c;
        if (L < nwg) {
            int wgid = (int)L; { const int q = nwg / NXCD, r = nwg % NXCD, xcd = wgid % NXCD, off = wgid / NXCD; wgid = (xcd < r ? xcd * (q + 1) : r * (q + 1) + (xcd - r) * q) + off; }
            const int nig = WGM * nN, gid = wgid / nig, fm = gid * WGM, gsz = (nM - fm) < WGM ? (nM - fm) : WGM;
            u.pm = fm + ((wgid % nig) % gsz); u.pn = (wgid % nig) / gsz; return true;
        }
        const int e = (int)(L - nwg); if (e >= extra) return false;
        u.pm = nM + e / exN; u.pn = expn0 + e % exN; return true;
    }
};
__device__ __forceinline__ unsigned cvt_pk_bf16(float lo, float hi) { unsigned r; asm volatile("v_cvt_pk_bf16_f32 %0, %1, %2" : "=v"(r) : "v"(lo), "v"(hi)); return r; }
template <class Epi, class Sched, bool ALIGN_EPI = true, bool SP2 = true>
__device__ __forceinline__ void gemm_phase(PG8_LAS unsigned char* lds, const Gemm g, const Sched& S, const Epi& E, const int tid_) {
    const int tid = tid_, wid = __builtin_amdgcn_readfirstlane(tid >> 6), lane = tid & 63, wr = wid >> 2, wc = wid & 3, fr = lane & 15, fq = lane >> 4;
    const int K = g.K, nt = K / BK;
    unsigned voffA[2], voffB[2];
#pragma unroll
    for (int i = 0; i < 2; ++i) { int R, C; stage_rc(tid * 16 + i * 8192, R, C); const int Rb = Epi::PERM ? ((R & ~31) + perm32(R & 31)) : R;
        voffA[i] = (unsigned)(R * K + C) * 2u; voffB[i] = (unsigned)(Rb * K + C) * 2u; }
    const size_t kstep = (size_t)(BK * 2);
    const size_t hstep = (size_t)HALF * K * 2;
    const size_t tstep = 2 * hstep;
    const unsigned ldsw = (unsigned)wid * 1024u;
    const int aoff = lds_byte(wr * 64 + fr, fq * 8), boff = lds_byte(wc * 32 + fr, fq * 8);
#define PG8_SA(b, h) (((b) * 2 + (h)) * HTB)
#define PG8_SB(b, h) ((4 + (b) * 2 + (h)) * HTB)
#define PG8_STAGE(bufoff, gbase, voff) do { _Pragma("unroll") for (int _i = 0; _i < 2; ++_i) \
        __builtin_amdgcn_global_load_lds((const unsigned*)((const char*)(gbase) + (voff)[_i]), (PG8_LAS unsigned*)(lds + (bufoff) + ldsw + _i * 8192), 16, 0, 0); } while (0)
#define PG8_LDA(dst, b, h) do { _Pragma("unroll") for (int m = 0; m < 4; ++m) _Pragma("unroll") for (int k = 0; k < 2; ++k) dst[m][k] = *(const PG8_LAS bf16x8*)(lds + PG8_SA(b, h) + aoff + m * 2048 + k * 1024); } while (0)
#define PG8_LDB(dst, b, h) do { _Pragma("unroll") for (int n = 0; n < 2; ++n) _Pragma("unroll") for (int k = 0; k < 2; ++k) dst[n][k] = *(const PG8_LAS bf16x8*)(lds + PG8_SB(b, h) + boff + n * 2048 + k * 1024); } while (0)
#define PG8_MMA(ai, bj, At, Bt) do { __builtin_amdgcn_s_setprio(1); _Pragma("unroll") for (int m = 0; m < 4; ++m) _Pragma("unroll") for (int n = 0; n < 2; ++n) _Pragma("unroll") for (int k = 0; k < 2; ++k) \
        acc[ai][bj][m][n] = __builtin_amdgcn_mfma_f32_16x16x32_bf16(Bt[n][k], At[m][k], acc[ai][bj][m][n], 0, 0, 0); __builtin_amdgcn_s_setprio(0); } while (0)
#define PG8_WAIT_V(n) asm volatile("s_waitcnt vmcnt(" #n ")" ::: "memory")
#define PG8_WAIT_L(n) asm volatile("s_waitcnt lgkmcnt(" #n ")" ::: "memory")
#define PG8_BAR __builtin_amdgcn_s_barrier()
#define PG8_SCHED __builtin_amdgcn_sched_barrier(0)
    Unit cur, nxt; int ui = 0;
    if (!S.next(0, cur)) return;
    f32x4 acc[2][2][4][2];
#pragma unroll
    for (int a = 0; a < 2; ++a)
#pragma unroll
        for (int b = 0; b < 2; ++b)
#pragma unroll
            for (int m = 0; m < 4; ++m)
#pragma unroll
                for (int n = 0; n < 2; ++n) acc[a][b][m][n] = (f32x4){0.f, 0.f, 0.f, 0.f};
    bf16x8 At[4][2], B0[2][2], B1[2][2];
    const char* cA = (const char*)selA(g, cur.z) + (size_t)cur.pm * tstep; const char* cB = (const char*)selB(g, cur.z) + (size_t)cur.pn * tstep;
    if constexpr (SP2) {
        PG8_STAGE(PG8_SB(0, 0), cB, voffB); PG8_STAGE(PG8_SB(0, 1), cB + hstep, voffB); PG8_STAGE(PG8_SA(0, 0), cA, voffA); PG8_STAGE(PG8_SA(0, 1), cA + hstep, voffA);
        if (wr == 1) PG8_BAR;
        PG8_WAIT_V(2); PG8_BAR;
        PG8_STAGE(PG8_SB(1, 0), cB + kstep, voffB); PG8_STAGE(PG8_SA(1, 0), cA + kstep, voffA); PG8_STAGE(PG8_SB(1, 1), cB + hstep + kstep, voffB);
        PG8_WAIT_V(6); PG8_BAR;
    } else {
        PG8_STAGE(PG8_SB(0, 0), cB, voffB); PG8_STAGE(PG8_SA(0, 0), cA, voffA); PG8_STAGE(PG8_SB(0, 1), cB + hstep, voffB); PG8_STAGE(PG8_SA(0, 1), cA + hstep, voffA);
        if (wr == 1) PG8_BAR;
        PG8_WAIT_V(4); PG8_BAR;
        PG8_STAGE(PG8_SB(1, 0), cB + kstep, voffB); PG8_STAGE(PG8_SA(1, 0), cA + kstep, voffA); PG8_STAGE(PG8_SB(1, 1), cB + hstep + kstep, voffB);
        PG8_WAIT_V(6); PG8_BAR;
    }
    for (;;) {
        const bool has_next = S.next(ui + 1, nxt);
        const char* nA = has_next ? (const char*)selA(g, nxt.z) + (size_t)nxt.pm * tstep : cA; const char* nB = has_next ? (const char*)selB(g, nxt.z) + (size_t)nxt.pn * tstep : cB;
        for (int t = 0; t < nt; t += 2) {
            const bool last = (t == nt - 2);
            const char* a1 = cA + (size_t)(t + 1) * kstep;
            const char* a2 = last ? nA : cA + (size_t)(t + 2) * kstep; const char* b2 = last ? nB : cB + (size_t)(t + 2) * kstep;
            const char* a3 = a2 + kstep; const char* b3 = b2 + kstep;
            if constexpr (SP2) {
            PG8_LDB(B0, 0, 0); PG8_LDB(B1, 0, 1); PG8_SCHED; PG8_LDA(At, 0, 0); PG8_STAGE(PG8_SA(1, 1), a1 + hstep, voffA);
            PG8_WAIT_V(8); PG8_WAIT_L(0); PG8_BAR; PG8_MMA(0, 0, At, B0); PG8_MMA(0, 1, At, B1); PG8_BAR; PG8_SCHED;
            PG8_LDA(At, 0, 1); PG8_STAGE(PG8_SB(0, 0), b2, voffB); PG8_STAGE(PG8_SB(0, 1), b2 + hstep, voffB); PG8_STAGE(PG8_SA(0, 0), a2, voffA);
            PG8_WAIT_V(8); PG8_WAIT_L(0); PG8_BAR; PG8_MMA(1, 0, At, B0); PG8_MMA(1, 1, At, B1); PG8_BAR; PG8_SCHED;
            PG8_LDB(B0, 1, 0); PG8_LDB(B1, 1, 1); PG8_SCHED; PG8_LDA(At, 1, 0); PG8_STAGE(PG8_SA(0, 1), a2 + hstep, voffA);
            PG8_WAIT_V(8); PG8_WAIT_L(0); PG8_BAR; PG8_MMA(0, 0, At, B0); PG8_MMA(0, 1, At, B1); PG8_BAR; PG8_SCHED;
            PG8_LDA(At, 1, 1); PG8_STAGE(PG8_SB(1, 0), b3, voffB); PG8_STAGE(PG8_SB(1, 1), b3 + hstep, voffB); PG8_STAGE(PG8_SA(1, 0), a3, voffA);
            PG8_WAIT_V(8); PG8_WAIT_L(0); PG8_BAR; PG8_MMA(1, 0, At, B0); PG8_MMA(1, 1, At, B1); PG8_BAR; PG8_SCHED;
            } else {
            PG8_LDB(B0, 0, 0); PG8_SCHED; PG8_LDA(At, 0, 0); PG8_STAGE(PG8_SA(1, 1), a1 + hstep, voffA);
            PG8_WAIT_L(8); PG8_BAR; PG8_WAIT_L(0); PG8_MMA(0, 0, At, B0); PG8_BAR; PG8_SCHED;
            PG8_LDB(B1, 0, 1); PG8_STAGE(PG8_SB(0, 0), b2, voffB);
            PG8_BAR; PG8_WAIT_L(0); PG8_MMA(0, 1, At, B1); PG8_BAR;
            PG8_LDA(At, 0, 1); PG8_STAGE(PG8_SA(0, 0), a2, voffA);
            PG8_BAR; PG8_WAIT_L(0); PG8_MMA(1, 0, At, B0); PG8_BAR; PG8_SCHED;
            PG8_STAGE(PG8_SB(0, 1), b2 + hstep, voffB);
            PG8_WAIT_V(6); PG8_BAR; PG8_MMA(1, 1, At, B1); PG8_BAR;
            PG8_LDB(B0, 1, 0); PG8_SCHED; PG8_LDA(At, 1, 0); PG8_STAGE(PG8_SA(0, 1), a2 + hstep, voffA);
            PG8_WAIT_L(8); PG8_BAR; PG8_WAIT_L(0); PG8_MMA(0, 0, At, B0); PG8_BAR; PG8_SCHED;
            PG8_LDB(B1, 1, 1); PG8_STAGE(PG8_SB(1, 0), b3, voffB);
            PG8_BAR; PG8_WAIT_L(0); PG8_MMA(0, 1, At, B1); PG8_BAR;
            PG8_LDA(At, 1, 1); PG8_STAGE(PG8_SA(1, 0), a3, voffA);
            PG8_BAR; PG8_WAIT_L(0); PG8_MMA(1, 0, At, B0); PG8_BAR; PG8_SCHED;
            PG8_STAGE(PG8_SB(1, 1), b3 + hstep, voffB);
            PG8_WAIT_V(6); PG8_BAR; PG8_MMA(1, 1, At, B1); PG8_BAR;
            }
        }
        if constexpr (ALIGN_EPI) { if (wr == 0) PG8_BAR; }
        const bool keep = E(acc, cur, wr, wc, fr, fq);
        if (!has_next) break;
        if (!keep) {
#pragma unroll
        for (int a = 0; a < 2; ++a)
#pragma unroll
            for (int b = 0; b < 2; ++b)
#pragma unroll
                for (int m = 0; m < 4; ++m)
#pragma unroll
                    for (int n = 0; n < 2; ++n) acc[a][b][m][n] = (f32x4){0.f, 0.f, 0.f, 0.f};
        }
        cur = nxt; cA = nA; cB = nB; ++ui;
        if constexpr (ALIGN_EPI) { if (wr == 1) PG8_BAR; }
    }
    PG8_WAIT_V(0);
    if constexpr (!ALIGN_EPI) { if (wr == 0) PG8_BAR; }
    PG8_BAR;
#undef PG8_SA
#undef PG8_SB
#undef PG8_STAGE
#undef PG8_LDA
#undef PG8_LDB
#undef PG8_MMA
#undef PG8_WAIT_V
#undef PG8_WAIT_L
#undef PG8_BAR
#undef PG8_SCHED
}
}

__device__ __forceinline__ f32x4 bf4lo(u32x4 w) { return (f32x4){__uint_as_float(w.x << 16), __uint_as_float(w.x & 0xffff0000u), __uint_as_float(w.y << 16), __uint_as_float(w.y & 0xffff0000u)}; }
__device__ __forceinline__ f32x4 bf4hi(u32x4 w) { return (f32x4){__uint_as_float(w.z << 16), __uint_as_float(w.z & 0xffff0000u), __uint_as_float(w.w << 16), __uint_as_float(w.w & 0xffff0000u)}; }
__device__ __forceinline__ u32x4 pack8(f32x4 a, f32x4 b) { u32x4 w; w.x = pg8::cvt_pk_bf16(a[0], a[1]); w.y = pg8::cvt_pk_bf16(a[2], a[3]); w.z = pg8::cvt_pk_bf16(b[0], b[1]); w.w = pg8::cvt_pk_bf16(b[2], b[3]); return w; }
__device__ __forceinline__ f32x4 sig4(f32x4 v) { return (f32x4){sigmoidf_(v[0]), sigmoidf_(v[1]), sigmoidf_(v[2]), sigmoidf_(v[3])}; }

template <class T> __device__ __forceinline__ T* uni_ptr(T* q) { unsigned long long a = (unsigned long long)q; unsigned lo = __builtin_amdgcn_readfirstlane((unsigned)a), hi = __builtin_amdgcn_readfirstlane((unsigned)(a >> 32));
    asm volatile("" : "+s"(lo), "+s"(hi)); return (T*)(((unsigned long long)hi << 32) | lo); }
struct EpiInproj {
    static constexpr bool PERM = true;
    unsigned char* ws; const float* gate_b;
    __device__ __forceinline__ bool operator()(f32x4 (&acc)[2][2][4][2], const pg8::Unit& u, int wr, int wc, int fr_, int fq_) const {
        int fr = fr_, fq = fq_; asm volatile("" : "+v"(fr), "+v"(fq)); unsigned char* const ws = uni_ptr(this->ws);
        const int cl = wc * 32 + 8 * fq, rbase = u.pm * 256 + wr * 64 + fr;
#pragma unroll
        for (int bj = 0; bj < 2; ++bj) {
            const int c128 = u.pn * 256 + bj * 128;
            unsigned char* base; unsigned rstride, coff; int kind = 0;
            if (c128 < COL_K)         { base = ws + WS_Q; rstride = 1024; coff = (unsigned)(c128 + cl) * 2u; kind = 1; }
            else if (c128 < COL_V)    { base = ws + WS_K; rstride = 256;  coff = (unsigned)cl * 2u; kind = 1; }
            else if (c128 < COL_S5)   { base = ws + WS_V; rstride = 256;  coff = (unsigned)cl * 2u; }
            else if (c128 < COL_HY)   { base = ws + WS_U; rstride = 1024; coff = (unsigned)(c128 - COL_S5 + cl) * 2u; }
            else if (c128 < COL_GATE) { base = ws + WS_Z; rstride = 3072; coff = (unsigned)(c128 - COL_HY + cl) * 2u; }
            else                      { base = ws + WS_G; rstride = 6144; coff = (unsigned)(c128 - COL_GATE + cl) * 2u; kind = 2; }
            if (kind == 1) {
                const float* rope = (const float*)(ws + WS_ROPE) + 8 * fq;
#pragma unroll
                for (int ai = 0; ai < 2; ++ai)
#pragma unroll
                    for (int m = 0; m < 4; ++m) {
                        const int r = rbase + ai * 128 + m * 16;
                        f32x4 v0 = acc[ai][bj][m][0], v1 = acc[ai][bj][m][1];
                        if (r < TL) { const int l = r & 4095, pos = (wc & 1) ? (l & 63) : (l >> 6);
                            const f32x4 t0 = *(const f32x4*)(rope + pos * 32), t1 = *(const f32x4*)(rope + pos * 32 + 4);
                            v0 = (f32x4){v0[0] * t0[0] - v0[1] * t0[1], v0[0] * t0[1] + v0[1] * t0[0], v0[2] * t0[2] - v0[3] * t0[3], v0[2] * t0[3] + v0[3] * t0[2]};
                            v1 = (f32x4){v1[0] * t1[0] - v1[1] * t1[1], v1[0] * t1[1] + v1[1] * t1[0], v1[2] * t1[2] - v1[3] * t1[3], v1[2] * t1[3] + v1[3] * t1[2]}; }
                        *(u32x4*)(base + ((unsigned)r * rstride + coff)) = pack8(v0, v1);
                        asm volatile("" ::: "memory");
                    }
            } else if (kind == 2) {
                const float* gb = uni_ptr(gate_b) + (c128 - COL_GATE) + cl; const f32x4 b0 = *(const f32x4*)gb, b1 = *(const f32x4*)(gb + 4);
#pragma unroll
                for (int ai = 0; ai < 2; ++ai)
#pragma unroll
                    for (int m = 0; m < 4; ++m) {
                        const int r = rbase + ai * 128 + m * 16;
                        *(u32x4*)(base + ((unsigned)r * rstride + coff)) = pack8(sig4(acc[ai][bj][m][0] + b0), sig4(acc[ai][bj][m][1] + b1));
                        asm volatile("" ::: "memory");
                    }
            } else {
#pragma unroll
                for (int ai = 0; ai < 2; ++ai)
#pragma unroll
                    for (int m = 0; m < 4; ++m) {
                        const int r = rbase + ai * 128 + m * 16;
                        *(u32x4*)(base + ((unsigned)r * rstride + coff)) = pack8(acc[ai][bj][m][0], acc[ai][bj][m][1]);
                    }
            }
        }
        return false;
    }
};
struct EpiGlu {
    static constexpr bool PERM = true;
    unsigned char* ws; const float* bias;
    __device__ __forceinline__ bool operator()(f32x4 (&acc)[2][2][4][2], const pg8::Unit& u, int wr, int wc, int fr_, int fq_) const {
        int fr = fr_, fq = fq_; asm volatile("" : "+v"(fr), "+v"(fq)); unsigned char* const ws = uni_ptr(this->ws);
#pragma unroll
        for (int bj = 0; bj < 2; ++bj) { const int c = u.pn * 256 + bj * 128 + wc * 32 + 8 * fq; const f32x4 b0 = *(const f32x4*)(bias + c), b1 = *(const f32x4*)(bias + c + 4);
#pragma unroll
            for (int ai = 0; ai < 2; ++ai)
#pragma unroll
                for (int m = 0; m < 4; ++m) { const size_t o = (size_t)(u.pm * 256 + ai * 128 + wr * 64 + m * 16 + fr) * 512 + c;
                    const u32x4 yw = *(const u32x4*)((const bf16*)(ws + WS_S5Y) + o);
                    *(u32x4*)((bf16*)(ws + WS_S5O) + o) = pack8(bf4lo(yw) * sig4(acc[ai][bj][m][0] + b0), bf4hi(yw) * sig4(acc[ai][bj][m][1] + b1)); asm volatile("" ::: "memory"); } }
        return false;
    }
};
struct EpiMerge {
    static constexpr bool PERM = true;
    unsigned char* ws;
    __device__ __forceinline__ bool operator()(f32x4 (&acc)[2][2][4][2], const pg8::Unit& u, int wr, int wc, int fr_, int fq_) const {
        int fr = fr_, fq = fq_; asm volatile("" : "+v"(fr), "+v"(fq)); unsigned char* const ws = uni_ptr(this->ws);
#pragma unroll
        for (int bj = 0; bj < 2; ++bj) { const int c = u.pn * 256 + bj * 128 + wc * 32 + 8 * fq;
#pragma unroll
            for (int ai = 0; ai < 2; ++ai)
#pragma unroll
                for (int m = 0; m < 4; ++m) { const int r = u.pm * 256 + ai * 128 + wr * 64 + m * 16 + fr;
                    const bf16* gp = (const bf16*)(ws + WS_G) + (size_t)r * 3072 + u.z * 1024 + c;
                    const u32x4 g0 = *(const u32x4*)gp;
                    if (u.z < 2) { const u32x4 g1 = *(const u32x4*)(gp + 1024);
                        const f32x4 d0 = bf4lo(g1), d1 = bf4hi(g1), n0 = bf4lo(g0), n1 = bf4hi(g0);
                        acc[ai][bj][m][0] *= (f32x4){n0[0] / fmaxf(d0[0], 1e-30f), n0[1] / fmaxf(d0[1], 1e-30f), n0[2] / fmaxf(d0[2], 1e-30f), n0[3] / fmaxf(d0[3], 1e-30f)};
                        acc[ai][bj][m][1] *= (f32x4){n1[0] / fmaxf(d1[0], 1e-30f), n1[1] / fmaxf(d1[1], 1e-30f), n1[2] / fmaxf(d1[2], 1e-30f), n1[3] / fmaxf(d1[3], 1e-30f)};
                    } else *(u32x4*)((bf16*)(ws + WS_M) + (size_t)r * 1024 + c) = pack8(acc[ai][bj][m][0] * bf4lo(g0), acc[ai][bj][m][1] * bf4hi(g0));
                    asm volatile("" ::: "memory");
                } }
        return u.z < 2;
    }
};
struct EpiOut {
    static constexpr bool PERM = false;
    unsigned char* ws; int layer; float scale;
    __device__ __forceinline__ bool operator()(f32x4 (&acc)[2][2][4][2], const pg8::Unit& u, int wr, int wc, int fr_, int fq_) const {
        int fr = fr_, fq = fq_; asm volatile("" : "+v"(fr), "+v"(fq)); unsigned char* const ws = uni_ptr(this->ws);
        float* X = (float*)(ws + WS_XCUR);
#pragma unroll
        for (int ai = 0; ai < 2; ++ai)
#pragma unroll
            for (int m = 0; m < 4; ++m) { const int r = u.pm * 256 + ai * 128 + wr * 64 + m * 16 + fr;
                const float* g1 = (const float*)(ws + WS_MODV) + ((size_t)layer * 5 + row_mi(r)) * 6144 + 2048;
#pragma unroll
                for (int bj = 0; bj < 2; ++bj)
#pragma unroll
                    for (int n = 0; n < 2; ++n) { const int c = u.pn * 256 + bj * 128 + wc * 32 + n * 16 + 4 * fq; f32x4* xp = (f32x4*)(X + (size_t)r * 1024 + c);
                        *xp = *xp + *(const f32x4*)(g1 + c) * acc[ai][bj][m][n] * scale; } asm volatile("" ::: "memory"); }
        return false;
    }
};
struct EpiQp {
    static constexpr bool PERM = true;
    unsigned char* ws;
    __device__ __forceinline__ bool operator()(f32x4 (&acc)[2][2][4][2], const pg8::Unit& u, int wr, int wc, int fr_, int fq_) const {
        int fr = fr_, fq = fq_; asm volatile("" : "+v"(fr), "+v"(fq)); unsigned char* const ws = uni_ptr(this->ws);
#pragma unroll
        for (int bj = 0; bj < 2; ++bj) { const int c = u.pn * 256 + bj * 128 + wc * 32 + 8 * fq;
#pragma unroll
            for (int ai = 0; ai < 2; ++ai)
#pragma unroll
                for (int m = 0; m < 4; ++m) *(u32x4*)((bf16*)(ws + WS_QP) + (size_t)(u.pm * 256 + ai * 128 + wr * 64 + m * 16 + fr) * 2048 + c) = pack8(acc[ai][bj][m][0], acc[ai][bj][m][1]); }
        return false;
    }
};

__device__ __forceinline__ void ph_inproj(const Ctx& cx, int layer, PG8_LAS unsigned char* lds) {
    CParams& p = get_params();
    pg8::Gemm g; g.A = (const bf16*)(p.ws + WS_H); g.Bt = (const bf16*)(p.ws + WT_IN) + (size_t)layer * INW * DM; g.zsA = 0; g.zsB = 0; g.K = DM;
    pg8::TileOrder S; S.nM = TL / 256; S.nN = INW / 256; S.nwg = S.nM * S.nN; S.G = cx.nb; S.c = cx.bid; S.nz = 1;
    if (layer == DEPTH - 1) { S.exN = 3; S.expn0 = 2; S.extra = 4 * 3; } else { S.exN = INW / 256; S.expn0 = 0; S.extra = 4 * (INW / 256); }
    EpiInproj E; E.ws = p.ws; E.gate_b = p.in[I_GATEB] + layer * 3072;
    pg8::gemm_phase<EpiInproj, pg8::TileOrder>(lds, g, S, E, cx.tid);
}

__device__ __forceinline__ void ph_attn(const Ctx& cx, int layer, float* sm) {
    CParams& p = get_params();
    const int tid = cx.tid, lane = tid & 63, w = tid >> 6, l15 = lane & 15, kg = lane >> 4;
    const bf16* Q = (const bf16*)(p.ws + WS_Q); const bf16* Kb = (const bf16*)(p.ws + WS_K); const bf16* Vb = (const bf16*)(p.ws + WS_V);
    bf16* VT = (bf16*)sm;
    constexpr int VS = 648;
    const int nitems = 256 + (layer == 0 ? 16 : 0);
    for (int it = cx.bid; it < nitems; it += cx.nb) {
        int b, kvh, qbase, wbase; bool win;
        if (it < 256) { b = it >> 6; kvh = (it >> 5) & 1; const int blk = it & 31; qbase = b * SEQ + blk * 128; wbase = blk * 128 - 128; win = true; }
        else { const int j = it - 256; b = j >> 2; kvh = (j >> 1) & 1; qbase = TL + b * CTXL + (j & 1) * 128; wbase = 0; win = false; }
        __syncthreads();
        for (int i = tid; i < 640 * 8; i += NTHREADS) { const int kk = i >> 3, c8 = i & 7; int row = -1;
            if (kk < 256) row = TL + b * CTXL + kk; else if (win) { const int pos = wbase + kk - 256; if (pos >= 0 && pos < SEQ) row = b * SEQ + pos; }
            u32x4 v = (u32x4){0u, 0u, 0u, 0u}; if (row >= 0) v = *(const u32x4*)(Vb + (size_t)row * 128 + kvh * 64 + c8 * 8);
            bf16* d = VT + (c8 * 8) * VS + kk;
            d[0] = (bf16)(v.x & 0xffffu); d[VS] = (bf16)(v.x >> 16); d[2 * VS] = (bf16)(v.y & 0xffffu); d[3 * VS] = (bf16)(v.y >> 16);
            d[4 * VS] = (bf16)(v.z & 0xffffu); d[5 * VS] = (bf16)(v.z >> 16); d[6 * VS] = (bf16)(v.w & 0xffffu); d[7 * VS] = (bf16)(v.w >> 16); }
        __syncthreads();
        const int h = kvh * 4 + (w >> 1), tok0 = (w & 1) * 64;
        bf16x8 qf[4][2];
#pragma unroll
        for (int qt = 0; qt < 4; ++qt)
#pragma unroll
            for (int ks = 0; ks < 2; ++ks) qf[qt][ks] = *(const bf16x8*)(Q + (size_t)(qbase + tok0 + 16 * qt + l15) * 512 + h * 64 + 32 * ks + 8 * kg);
        float m[4], l[4]; f32x4 O[4][4];
        const float sink = p.in[I_SINK][layer * 8 + h];
#pragma unroll
        for (int qt = 0; qt < 4; ++qt) { m[qt] = sink; l[qt] = 1.f;
#pragma unroll
            for (int dt = 0; dt < 4; ++dt) O[qt][dt] = (f32x4){0.f, 0.f, 0.f, 0.f}; }
        const int nsteps = win ? 18 : 8;
        for (int st = 0; st < nsteps; ++st) {
            const int kk0 = st < 8 ? st * 32 : 256 + tok0 + (st - 8) * 32;
            bf16x8 kf[2][2];
#pragma unroll
            for (int kt = 0; kt < 2; ++kt) { const int kk = kk0 + 16 * kt + l15; int row;
                if (kk < 256) row = TL + b * CTXL + kk; else { int pos = wbase + kk - 256; pos = pos < 0 ? 0 : (pos > SEQ - 1 ? SEQ - 1 : pos); row = b * SEQ + pos; }
#pragma unroll
                for (int ks = 0; ks < 2; ++ks) kf[kt][ks] = *(const bf16x8*)(Kb + (size_t)row * 128 + kvh * 64 + 32 * ks + 8 * kg); }
#pragma unroll
            for (int qt = 0; qt < 4; ++qt) {
                f32x4 s0 = (f32x4){0.f, 0.f, 0.f, 0.f}, s1 = s0;
                s0 = __builtin_amdgcn_mfma_f32_16x16x32_bf16(kf[0][0], qf[qt][0], s0, 0, 0, 0); s0 = __builtin_amdgcn_mfma_f32_16x16x32_bf16(kf[0][1], qf[qt][1], s0, 0, 0, 0);
                s1 = __builtin_amdgcn_mfma_f32_16x16x32_bf16(kf[1][0], qf[qt][0], s1, 0, 0, 0); s1 = __builtin_amdgcn_mfma_f32_16x16x32_bf16(kf[1][1], qf[qt][1], s1, 0, 0, 0);
                s0 *= 0.125f; s1 *= 0.125f;
                if (st >= 8) {
                    const int qpos = wbase + 128 + tok0 + 16 * qt + l15, kp0 = wbase + kk0 - 256 + 4 * kg;
#pragma unroll
                    for (int r = 0; r < 4; ++r) { const int k0 = kp0 + r, k1 = kp0 + 16 + r;
                        if (k0 < 0 || k0 >= SEQ || k0 - qpos > 128 || qpos - k0 > 128) s0[r] = -1e30f;
                        if (k1 < 0 || k1 >= SEQ || k1 - qpos > 128 || qpos - k1 > 128) s1[r] = -1e30f; }
                }
                float mx = fmaxf(fmaxf(fmaxf(s0[0], s0[1]), fmaxf(s0[2], s0[3])), fmaxf(fmaxf(s1[0], s1[1]), fmaxf(s1[2], s1[3])));
                mx = fmaxf(mx, __shfl_xor(mx, 16)); mx = fmaxf(mx, __shfl_xor(mx, 32));
                const float mn = fmaxf(m[qt], mx), f = __expf(m[qt] - mn);
                f32x4 p0, p1;
#pragma unroll
                for (int r = 0; r < 4; ++r) { p0[r] = __expf(s0[r] - mn); p1[r] = __expf(s1[r] - mn); }
                float ps = (p0[0] + p0[1]) + (p0[2] + p0[3]) + (p1[0] + p1[1]) + (p1[2] + p1[3]);
                ps += __shfl_xor(ps, 16); ps += __shfl_xor(ps, 32);
                l[qt] = l[qt] * f + ps; m[qt] = mn;
                u32x4 pw; pw.x = pk2(p0[0], p0[1]); pw.y = pk2(p0[2], p0[3]); pw.z = pk2(p1[0], p1[1]); pw.w = pk2(p1[2], p1[3]);
                const bf16x8 pf = __builtin_bit_cast(bf16x8, pw);
#pragma unroll
                for (int dt = 0; dt < 4; ++dt) {
                    const bf16* vp = VT + (16 * dt + l15) * VS + kk0 + 4 * kg;
                    u32x4 vw; const u32x2 va = *(const u32x2*)vp, vb = *(const u32x2*)(vp + 16); vw.x = va.x; vw.y = va.y; vw.z = vb.x; vw.w = vb.y;
                    O[qt][dt] = __builtin_amdgcn_mfma_f32_16x16x32_bf16(__builtin_bit_cast(bf16x8, vw), pf, O[qt][dt] * f, 0, 0, 0);
                }
            }
        }
#pragma unroll
        for (int qt = 0; qt < 4; ++qt) { const float il = 1.f / l[qt]; bf16* op = (bf16*)(p.ws + WS_ATT) + (size_t)(qbase + tok0 + 16 * qt + l15) * 512 + h * 64 + 4 * kg;
#pragma unroll
            for (int dt = 0; dt < 4; ++dt) { const f32x4 o = O[qt][dt] * il; u32x2 ww; ww.x = pk2(o[0], o[1]); ww.y = pk2(o[2], o[3]); *(u32x2*)(op + 16 * dt) = ww; } }
    }
}

__device__ __forceinline__ void ph_hypre(const Ctx& cx, int layer, float* sm) {
    CParams& p = get_params();
    const int lane = cx.tid & 63, wave = cx.tid >> 6, gw = cx.bid * NWAVES + wave, NGW = cx.nb * NWAVES;
    const bf16* Z = (const bf16*)(p.ws + WS_Z); const float* sw = p.in[I_HSW] + layer * 3 * 1536; const float* sb = p.in[I_HSB] + layer * 1536;
    float* tile = sm + wave * 4096;
    const int nlat = 4 * 64 * 8, nctx = layer == 0 ? 4 * 4 * 8 : 0;
    for (int it = gw; it < nlat + nctx; it += NGW) {
        int b, t0, L, c0, rbase; float* vvb;
        if (it < nlat) { b = it >> 9; t0 = ((it >> 3) & 63) * 64; c0 = (it & 7) * 64; L = SEQ; rbase = b * SEQ; vvb = (float*)(p.ws + WS_VV) + ((size_t)b * 512 + c0) * SEQ; }
        else { const int j = it - nlat; b = j >> 5; t0 = ((j >> 3) & 3) * 64; c0 = (j & 7) * 64; L = CTXL; rbase = TL + b * CTXL; vvb = (float*)(p.ws + WS_VVC) + ((size_t)b * 512 + c0) * CTXL; }
        const int c = c0 + lane;
        float w0[3], w1[3], w2[3], bb[3];
#pragma unroll
        for (int q = 0; q < 3; ++q) { const int col = q * 512 + c; w0[q] = sw[col]; w1[q] = sw[1536 + col]; w2[q] = sw[2 * 1536 + col]; bb[q] = sb[col]; }
        const bf16* zb = Z + (size_t)rbase * 1536 + c;
#pragma unroll 1
        for (int tb = 0; tb < 64; tb += 16) {
            bf16 zv[3][18];
#pragma unroll
            for (int k = 0; k < 18; ++k) { const int t = t0 + tb + k - 1; const bool ok = t >= 0 && t < L;
#pragma unroll
                for (int q = 0; q < 3; ++q) zv[q][k] = ok ? zb[(size_t)t * 1536 + q * 512] : (bf16)0; }
#pragma unroll
            for (int k = 0; k < 16; ++k) { const int tt = tb + k, t = t0 + tt; float o[3];
#pragma unroll
                for (int q = 0; q < 3; ++q) o[q] = bb[q] + w0[q] * bf2f(zv[q][k]) + w1[q] * bf2f(zv[q][k + 1]) + w2[q] * bf2f(zv[q][k + 2]);
                ((bf16*)(p.ws + WS_X0C))[(size_t)(rbase + t) * 512 + c] = f2bf(o[0]);
                tile[lane * 64 + (tt ^ lane)] = o[2] * o[1]; }
        }
        __builtin_amdgcn_s_waitcnt(0xc07f);
        for (int cc = 0; cc < 64; ++cc) vvb[(size_t)cc * L + t0 + lane] = tile[cc * 64 + (lane ^ cc)];
        __builtin_amdgcn_s_waitcnt(0xc07f);
    }
}

__device__ __forceinline__ void ph_hyconv_ctx(const Ctx& cx, int layer, float* sm) {
    CParams& p = get_params();
    const int tid = cx.tid;
    if (layer != 0) return;
    constexpr int L = CTXL;
    float* Tl = sm; float* Vl = sm + 2 * L;
    for (int it = cx.bid; it < 2048; it += cx.nb) {
        const int bc = it, b = bc >> 9, c = bc & 511;
        const float* fb = (const float*)(p.ws + WS_FILT + FILT_CTX_OFF);
        const float* hf = fb + (size_t)c * L; const float* hb = fb + ((size_t)512 + c) * L;
        const float* vv = (const float*)(p.ws + WS_VVC) + (size_t)bc * CTXL;
        __syncthreads();
        if (tid < L) { Tl[L - 1 + tid] = hf[tid]; if (tid > 0) Tl[L - 1 - tid] = hb[tid]; Vl[tid] = vv[tid]; }
        __syncthreads();
        if (tid < L) { float a = 0.f; const float* tp = Tl + (tid + L - 1);
            for (int s = 0; s < L; ++s) a += Vl[s] * tp[-s];
            const size_t o = (size_t)(TL + b * CTXL + tid) * 512 + c;
            ((bf16*)(p.ws + WS_HY))[o] = f2bf((a + Vl[tid] * p.in[I_HBIAS][layer * 512 + c]) * bf2f(((const bf16*)(p.ws + WS_X0C))[o])); }
    }
}
typedef float f32x2 __attribute__((ext_vector_type(2)));
__device__ __forceinline__ f32x2 cmul(f32x2 a, f32x2 w) { return (f32x2){a.x * w.x - a.y * w.y, a.x * w.y + a.y * w.x}; }
__device__ __forceinline__ void fft_fwd_r4(f32x2* X, int tid) {
#pragma unroll 1
    for (int s = 0; s < 12; s += 2) {
        const int lq = 11 - s, Q = 1 << lq;
        __syncthreads();
#pragma unroll
        for (int q = 0; q < 4; ++q) { const int j = tid + 512 * q, pos = j & (Q - 1), i = ((j >> lq) << (lq + 2)) + pos;
            const float rev = (float)(pos << s) * (1.f / 8192.f); const f32x2 w1 = (f32x2){__builtin_amdgcn_cosf(rev), -__builtin_amdgcn_sinf(rev)}; const f32x2 w2 = cmul(w1, w1);
            const f32x2 a0 = X[i], a1 = X[i + Q], a2 = X[i + 2 * Q], a3 = X[i + 3 * Q];
            const f32x2 b0 = a0 + a2, b1 = a1 + a3, d02 = a0 - a2, d13 = a1 - a3;
            const f32x2 b2 = cmul(d02, w1), b3 = cmul((f32x2){d13.y, -d13.x}, w1);
            X[i] = b0 + b1; X[i + Q] = cmul(b0 - b1, w2); X[i + 2 * Q] = b2 + b3; X[i + 3 * Q] = cmul(b2 - b3, w2); }
    }
}
__device__ __forceinline__ void fft_inv_r4(f32x2* X, int tid) {
#pragma unroll 1
    for (int s = 1; s < 13; s += 2) {
        const int h = 1 << s;
        __syncthreads();
#pragma unroll
        for (int q = 0; q < 4; ++q) { const int j = tid + 512 * q, pos = j & (h - 1), i = ((j >> s) << (s + 2)) + pos;
            const float rev = (float)(pos << (11 - s)) * (1.f / 8192.f); const f32x2 v1 = (f32x2){__builtin_amdgcn_cosf(rev), __builtin_amdgcn_sinf(rev)}; const f32x2 v2 = cmul(v1, v1);
            const f32x2 a0 = X[i], a1 = cmul(X[i + h], v2), a2 = X[i + 2 * h], a3 = cmul(X[i + 3 * h], v2);
            const f32x2 b0 = a0 + a1, b1 = a0 - a1, b2 = cmul(a2 + a3, v1), t3 = cmul(a2 - a3, v1); const f32x2 b3 = (f32x2){-t3.y, t3.x};
            X[i] = b0 + b2; X[i + h] = b1 + b3; X[i + 2 * h] = b0 - b2; X[i + 3 * h] = b1 - b3; }
    }
}
__device__ __forceinline__ void ph_hyfft(const Ctx& cx, int layer, float* sm, bool dry) {
    CParams& p = get_params();
    const int tid = cx.tid;
    f32x2* A = (f32x2*)sm; f32x2* B = A + 8192;
    for (int c = cx.bid; c < 512; c += cx.nb) {
        const float* hf = (const float*)(p.ws + WS_FILT) + (size_t)c * SEQ; const float* hb = (const float*)(p.ws + WS_FILT) + ((size_t)512 + c) * SEQ;
        const float bias = p.in[I_HBIAS][layer * 512 + c];
        __syncthreads();
#pragma unroll
        for (int q = 0; q < 16; ++q) { const int i = tid + 512 * q; float v = 0.f; if (i < SEQ) v = hf[i]; else if (i > SEQ) v = hb[2 * SEQ - i]; A[i] = (f32x2){v, 0.f}; }
        fft_fwd_r4(A, tid);
        __syncthreads();
#pragma unroll
        for (int q = 0; q < 8; ++q) { const int i = 2 * (tid + 512 * q); const f32x2 a = A[i], b = A[i + 1]; A[i] = a + b; A[i + 1] = a - b; }
#pragma unroll 1
        for (int bp = 0; bp < 2; ++bp) {
            float* v0 = (float*)(p.ws + WS_VV) + ((size_t)(2 * bp) * 512 + c) * SEQ; float* v1 = v0 + (size_t)512 * SEQ;
            float xr[8], xi[8];
            __syncthreads();
#pragma unroll
            for (int q = 0; q < 8; ++q) { const int i = tid + 512 * q; xr[q] = v0[i]; xi[q] = v1[i]; B[i] = (f32x2){xr[q], xi[q]}; B[i + SEQ] = (f32x2){0.f, 0.f}; }
            fft_fwd_r4(B, tid);
            __syncthreads();
#pragma unroll
            for (int q = 0; q < 8; ++q) { const int i = 2 * (tid + 512 * q); const f32x2 a = B[i], b = B[i + 1];
                const f32x2 y0 = cmul(a + b, A[i]), y1 = cmul(a - b, A[i + 1]); B[i] = y0 + y1; B[i + 1] = y0 - y1; }
            fft_inv_r4(B, tid);
            __syncthreads();
#pragma unroll
            for (int q = 0; q < 8; ++q) { const int i = tid + 512 * q; const f32x2 y = B[i]; if (!dry) { v0[i] = y.x * (1.f / 8192.f) + xr[q] * bias; v1[i] = y.y * (1.f / 8192.f) + xi[q] * bias; } }
        }
    }
}
__device__ __forceinline__ void ph_hypost(const Ctx& cx, int layer, float* sm) {
    CParams& p = get_params();
    const int lane = cx.tid & 63, wave = cx.tid >> 6, gw = cx.bid * NWAVES + wave, NGW = cx.nb * NWAVES;
    float* tile = sm + wave * 4096;
    for (int it = gw; it < 4 * 64 * 8; it += NGW) {
        const int b = it >> 9, t0 = ((it >> 3) & 63) * 64, c0 = (it & 7) * 64;
        const float* yb = (const float*)(p.ws + WS_VV) + ((size_t)b * 512 + c0) * SEQ;
        for (int cc = 0; cc < 64; ++cc) tile[cc * 64 + (lane ^ cc)] = yb[(size_t)cc * SEQ + t0 + lane];
        __builtin_amdgcn_s_waitcnt(0xc07f);
        for (int tt = 0; tt < 64; ++tt) { const size_t o = (size_t)(b * SEQ + t0 + tt) * 512 + c0 + lane;
            ((bf16*)(p.ws + WS_HY))[o] = f2bf(tile[lane * 64 + (tt ^ lane)] * bf2f(((const bf16*)(p.ws + WS_X0C))[o])); }
        __builtin_amdgcn_s_waitcnt(0xc07f);
    }
    (void)layer;
}

__device__ __forceinline__ void s5_pow(const float decay, const float theta, int n, float& pr, float& pi) {
    const float m = __expf(decay * (float)n), rev = __builtin_amdgcn_fractf(theta * (float)n * 0.15915494309189535f);
    pr = m * __builtin_amdgcn_cosf(rev); pi = m * __builtin_amdgcn_sinf(rev);
}
__device__ __forceinline__ void ph_s5tables(const Ctx& cx, int layer, float* sm) {
    const int gt = cx.bid * NTHREADS + cx.tid, NGT = cx.nb * NTHREADS;
    {
        CParams& p = get_params(); bf16* E = (bf16*)(p.ws + WS_S5E);
        for (int it = gt; it < 32 * 2 * 64 * 64; it += NGT) {
            const int pp = it & 63, s = (it >> 6) & 63, dir = (it >> 12) & 1, g = it >> 13;
            const int ldgp = ((layer * 2 + dir) * 32 + g) * 64 + pp;
            const float decay = ((const float*)(p.ws + WS_S5C))[ldgp * 2], theta = ((const float*)(p.ws + WS_S5C))[ldgp * 2 + 1];
            float qr, qi; s5_pow(decay, theta, dir == 0 ? 63 - s : s, qr, qi);
            const f32x4* bb = (const f32x4*)((const float*)(p.ws + WS_S5B) + (size_t)ldgp * 32);
            bf16* er = E + (((size_t)(g * 2 + dir) * 128 + pp) * 1024 + s * 16); bf16* ei = er + (size_t)64 * 1024;
#pragma unroll
            for (int i = 0; i < 16; i += 2) { const f32x4 b2 = bb[i >> 1];
                *(unsigned*)(er + i) = pk2(qr * b2[0] - qi * b2[1], qr * b2[2] - qi * b2[3]); *(unsigned*)(ei + i) = pk2(qr * b2[1] + qi * b2[0], qr * b2[3] + qi * b2[2]); }
            if (s == 0) { float ar, ai; s5_pow(decay, theta, 64, ar, ai); float* a64 = (float*)(p.ws + WS_S5A64) + (size_t)ldgp * 2; a64[0] = ar; a64[1] = ai; }
        }
    }
    {
        CParams& p = get_params(); bf16* P = (bf16*)(p.ws + WS_S5P);
        for (int it = gt; it < 32 * 2 * 64 * 64; it += NGT) {
            const int pp = it & 63, tau = (it >> 6) & 63, dir = (it >> 12) & 1, g = it >> 13;
            const int ldgp = ((layer * 2 + dir) * 32 + g) * 64 + pp;
            float pr, pi; s5_pow(((const float*)(p.ws + WS_S5C))[ldgp * 2], ((const float*)(p.ws + WS_S5C))[ldgp * 2 + 1], dir == 0 ? tau + 1 : 64 - tau, pr, pi);
            const size_t cb = ((size_t)((layer * 2 + dir) * 32 + g) * 16) * 64 + pp;
            bf16* pb = P + (((size_t)(g * 2 + dir) * 64 + tau) * 16) * 128 + pp;
#pragma unroll
            for (int o = 0; o < 16; ++o) { const float cre = p.in[I_SCRE][cb + o * 64], cim = p.in[I_SCIM][cb + o * 64];
                pb[o * 128] = f2bf(cre * pr - cim * pi); pb[o * 128 + 64] = f2bf(-(cre * pi + cim * pr)); }
        }
    }
    {
        CParams& p = get_params(); bf16* K = (bf16*)(p.ws + WS_S5K);
        const int tid = cx.tid, lane = tid & 63, w = tid >> 6;
        float* Cs = sm;
        float* Xs = sm + 4096 + w * 2112;
        for (int it = cx.bid; it < 32 * 16; it += cx.nb) {
            const int g = it >> 4, dl = (it & 15) * 8 + w, d = dl - 63;
            __syncthreads();
            for (int i = tid; i < 2 * 16 * 64; i += NTHREADS) { const int dir = i >> 10, r = i & 1023; const size_t ci = (size_t)((layer * 2 + dir) * 32 + g) * 1024 + r;
                Cs[i * 2] = p.in[I_SCRE][ci]; Cs[i * 2 + 1] = p.in[I_SCIM][ci]; }
            __syncthreads();
            if (dl < 127) {
                float acc[4] = {0.f, 0.f, 0.f, 0.f};
#pragma unroll 1
                for (int dir = 0; dir < 2; ++dir) {
                    if ((dir == 0 && d < 0) || (dir == 1 && d > 0)) continue;
                    const int ldgp = ((layer * 2 + dir) * 32 + g) * 64 + lane;
                    float qr, qi; s5_pow(((const float*)(p.ws + WS_S5C))[ldgp * 2], ((const float*)(p.ws + WS_S5C))[ldgp * 2 + 1], d < 0 ? -d : d, qr, qi);
                    const f32x4* bb = (const f32x4*)((const float*)(p.ws + WS_S5B) + (size_t)ldgp * 32);
#pragma unroll
                    for (int i = 0; i < 16; i += 2) { const f32x4 b2 = bb[i >> 1];
                        Xs[lane * 33 + i] = qr * b2[0] - qi * b2[1]; Xs[lane * 33 + 16 + i] = qr * b2[1] + qi * b2[0];
                        Xs[lane * 33 + i + 1] = qr * b2[2] - qi * b2[3]; Xs[lane * 33 + 17 + i] = qr * b2[3] + qi * b2[2]; }
                    __builtin_amdgcn_s_waitcnt(0xc07f);
                    const int i = lane & 15, oq = lane >> 4;
                    for (int pp = 0; pp < 64; ++pp) { const float xr = Xs[pp * 33 + i], xi = Xs[pp * 33 + 16 + i];
#pragma unroll
                        for (int jj = 0; jj < 4; ++jj) { const f32x2 c = *(const f32x2*)(Cs + ((dir * 16 + oq + 4 * jj) * 64 + pp) * 2); acc[jj] += c.x * xr - c.y * xi; } }
                    __builtin_amdgcn_s_waitcnt(0xc07f);
                }
                const int i = lane & 15, oq = lane >> 4;
#pragma unroll
                for (int jj = 0; jj < 4; ++jj) { const int o = oq + 4 * jj; float v = acc[jj]; if (d == 0 && o == i) v += p.in[I_SD][layer * 512 + g * 16 + o];
                    K[((size_t)g * 127 + dl) * 256 + o * 16 + i] = f2bf(v); }
            }
        }
    }
}
__device__ __forceinline__ int s5_row(int b, int n, int s) { return n < 4 ? TL + b * CTXL + n * 64 + s : b * SEQ + (n - 4) * 64 + s; }
__device__ __forceinline__ void ph_s5states(const Ctx& cx, int layer, float* sm) {
    CParams& p = get_params();
    const int tid = cx.tid, lane = tid & 63, w = tid >> 6, l15 = lane & 15, kg = lane >> 4;
    const bf16* E = (const bf16*)(p.ws + WS_S5E); const bf16* U = (const bf16*)(p.ws + WS_U);
    float* S = sm;
    for (int it = cx.bid; it < 128; it += cx.nb) {
        const int g = it & 31, b = it >> 5;
        f32x4 acc[2][5];
#pragma unroll
        for (int mt = 0; mt < 2; ++mt)
#pragma unroll
            for (int nt = 0; nt < 5; ++nt) acc[mt][nt] = (f32x4){0.f, 0.f, 0.f, 0.f};
        const bf16* ea = E + ((size_t)g * 256 + 32 * w + l15) * 1024 + 8 * kg;
        for (int ks = 0; ks < 32; ++ks) {
            const int s = 2 * ks + (kg >> 1), i0 = 8 * (kg & 1);
            bf16x8 af[2], bfr[5];
#pragma unroll
            for (int mt = 0; mt < 2; ++mt) af[mt] = *(const bf16x8*)(ea + (size_t)mt * 16 * 1024 + ks * 32);
#pragma unroll
            for (int nt = 0; nt < 5; ++nt) { const int n = 16 * nt + l15; bfr[nt] = (bf16x8){0, 0, 0, 0, 0, 0, 0, 0};
                if (n < 68) bfr[nt] = *(const bf16x8*)(U + (size_t)s5_row(b, n, s) * 512 + g * 16 + i0); }
#pragma unroll
            for (int mt = 0; mt < 2; ++mt)
#pragma unroll
                for (int nt = 0; nt < 5; ++nt) acc[mt][nt] = __builtin_amdgcn_mfma_f32_16x16x32_bf16(af[mt], bfr[nt], acc[mt][nt], 0, 0, 0);
        }
        __syncthreads();
#pragma unroll
        for (int mt = 0; mt < 2; ++mt)
#pragma unroll
            for (int nt = 0; nt < 5; ++nt)
#pragma unroll
                for (int r = 0; r < 4; ++r) S[(32 * w + 16 * mt + kg * 4 + r) * 81 + 16 * nt + l15] = acc[mt][nt][r];
        __syncthreads();
        if (tid < 128) {
            const int dir = tid >> 6, pp = tid & 63;
            const float* a64 = (const float*)(p.ws + WS_S5A64) + ((size_t)((layer * 2 + dir) * 32 + g) * 64 + pp) * 2;
            const float ar = a64[0], ai = a64[1]; float hr = 0.f, hi = 0.f;
            bf16* hin = (bf16*)(p.ws + WS_HIN) + ((size_t)g * 272 + b * 68) * 256 + dir * 128 + pp;
            for (int k = 0; k < 68; ++k) {
                const int n = dir == 0 ? k : (k < 4 ? 3 - k : 71 - k);
                hin[(size_t)n * 256] = f2bf(hr); hin[(size_t)n * 256 + 64] = f2bf(hi);
                const float sr = S[(dir * 128 + pp) * 81 + n], si = S[(dir * 128 + 64 + pp) * 81 + n];
                const float nr = ar * hr - ai * hi + sr, ni = ar * hi + ai * hr + si; hr = nr; hi = ni;
            }
        }
    }
}
__device__ __forceinline__ void ph_s5out(const Ctx& cx, int layer, float* sm) {
    CParams& p = get_params();
    const int tid = cx.tid, lane = tid & 63, w = tid >> 6, l15 = lane & 15, kg = lane >> 4;
    const bf16* U = (const bf16*)(p.ws + WS_U); const bf16* P = (const bf16*)(p.ws + WS_S5P); const bf16* HIN = (const bf16*)(p.ws + WS_HIN);
    bf16* Kl = (bf16*)sm;
    for (int it = cx.bid; it < 256; it += cx.nb) {
        const int g = it & 31, b = (it >> 5) & 3, half = it >> 7;
        __syncthreads();
        { const u32x4* src = (const u32x4*)((const bf16*)(p.ws + WS_S5K) + (size_t)g * 127 * 256); u32x4* dst = (u32x4*)Kl;
          for (int i = tid; i < 127 * 256 / 8; i += NTHREADS) dst[i] = src[i]; }
        __syncthreads();
        f32x4 acc[4][5];
#pragma unroll
        for (int mt = 0; mt < 4; ++mt)
#pragma unroll
            for (int nt = 0; nt < 5; ++nt) acc[mt][nt] = (f32x4){0.f, 0.f, 0.f, 0.f};
        const int tau0 = 32 * half + 4 * w;
        for (int ks = 0; ks < 32; ++ks) {
            const int s = 2 * ks + (kg >> 1), i0 = 8 * (kg & 1);
            bf16x8 bfr[5];
#pragma unroll
            for (int nt = 0; nt < 5; ++nt) { const int n = 16 * nt + l15; bfr[nt] = (bf16x8){0, 0, 0, 0, 0, 0, 0, 0};
                if (n < 68) bfr[nt] = *(const bf16x8*)(U + (size_t)s5_row(b, n, s) * 512 + g * 16 + i0); }
#pragma unroll
            for (int mt = 0; mt < 4; ++mt) {
                const int lag = tau0 + mt - s;
                const bf16x8 af = *(const bf16x8*)(Kl + (lag + 63) * 256 + l15 * 16 + i0);
#pragma unroll
                for (int nt = 0; nt < 5; ++nt) acc[mt][nt] = __builtin_amdgcn_mfma_f32_16x16x32_bf16(af, bfr[nt], acc[mt][nt], 0, 0, 0);
            }
        }
#pragma unroll 1
        for (int dk = 0; dk < 8; ++dk) {
            const int dir = dk >> 2, kk = dk & 3;
            bf16x8 bfr[5];
#pragma unroll
            for (int nt = 0; nt < 5; ++nt) { const int n = 16 * nt + l15; bfr[nt] = (bf16x8){0, 0, 0, 0, 0, 0, 0, 0};
                if (n < 68) bfr[nt] = *(const bf16x8*)(HIN + ((size_t)g * 272 + b * 68 + n) * 256 + dir * 128 + 32 * kk + 8 * kg); }
#pragma unroll
            for (int mt = 0; mt < 4; ++mt) {
                const bf16x8 af = *(const bf16x8*)(P + ((((size_t)(g * 2 + dir) * 64 + tau0 + mt) * 16 + l15) * 128 + 32 * kk + 8 * kg));
#pragma unroll
                for (int nt = 0; nt < 5; ++nt) acc[mt][nt] = __builtin_amdgcn_mfma_f32_16x16x32_bf16(af, bfr[nt], acc[mt][nt], 0, 0, 0);
            }
        }
#pragma unroll
        for (int mt = 0; mt < 4; ++mt)
#pragma unroll
            for (int nt = 0; nt < 5; ++nt) { const int n = 16 * nt + l15;
                if (n < 68 && (layer == 0 || n >= 4)) { const f32x4 y = acc[mt][nt]; u32x2 o; o.x = pk2(gelu_tanh(y[0]), gelu_tanh(y[1])); o.y = pk2(gelu_tanh(y[2]), gelu_tanh(y[3]));
                    *(u32x2*)((bf16*)(p.ws + WS_S5Y) + (size_t)s5_row(b, n, tau0 + mt) * 512 + g * 16 + 4 * kg) = o; } }
    }
}

__device__ __forceinline__ void ph_glu(const Ctx& cx, int layer, PG8_LAS unsigned char* lds) {
    CParams& p = get_params();
    pg8::Gemm g; g.A = (const bf16*)(p.ws + WS_S5Y); g.Bt = (const bf16*)(p.ws + WT_GLU) + (size_t)layer * 512 * 512; g.zsA = 0; g.zsB = 0; g.K = 512;
    pg8::TileOrder S; S.nM = TL / 256; S.nN = 2; S.nwg = S.nM * S.nN; S.G = cx.nb; S.c = cx.bid; S.nz = 1; S.exN = 2; S.expn0 = 0; S.extra = layer == 0 ? 4 * 2 : 0;
    EpiGlu E; E.ws = p.ws; E.bias = p.in[I_GLUB] + layer * 512;
    pg8::gemm_phase<EpiGlu, pg8::TileOrder>(lds, g, S, E, cx.tid);
}
__device__ __forceinline__ void ph_merge(const Ctx& cx, int layer, PG8_LAS unsigned char* lds) {
    CParams& p = get_params();
    pg8::Gemm g; g.A = (const bf16*)(p.ws + WS_ATT); g.zsA = (WS_HY - WS_ATT) / 2;
    g.Bt = (const bf16*)(p.ws + WT_BR) + (size_t)(layer * 3 + 0) * 1024 * 512; g.zsB = 1024 * 512; g.K = 512;
    pg8::TileOrder S; S.nM = TL / 256; S.nN = 4; S.nwg = S.nM * S.nN; S.G = cx.nb; S.c = cx.bid; S.nz = 3; S.exN = 4; S.expn0 = 0; S.extra = layer == 0 ? 4 * 4 : 0;
    EpiMerge E; E.ws = p.ws;
    pg8::gemm_phase<EpiMerge, pg8::TileOrder>(lds, g, S, E, cx.tid);
}
__device__ __forceinline__ void ph_outproj(const Ctx& cx, int layer, PG8_LAS unsigned char* lds, float scale) {
    CParams& p = get_params();
    pg8::Gemm g; g.A = (const bf16*)(p.ws + WS_M); g.Bt = (const bf16*)(p.ws + WT_OUT) + (size_t)layer * 1024 * 1024; g.zsA = 0; g.zsB = 0; g.K = 1024;
    pg8::TileOrder S; S.nM = TL / 256; S.nN = 4; S.nwg = S.nM * S.nN; S.G = cx.nb; S.c = cx.bid; S.nz = 1; S.exN = 4; S.expn0 = 0; S.extra = layer == 0 ? 4 * 4 : 0;
    EpiOut E; E.ws = p.ws; E.layer = layer; E.scale = scale;
    pg8::gemm_phase<EpiOut, pg8::TileOrder>(lds, g, S, E, cx.tid);
}
__device__ __forceinline__ void ph_qp(const Ctx& cx, int layer, PG8_LAS unsigned char* lds) {
    CParams& p = get_params();
    pg8::Gemm g; g.A = (const bf16*)(p.ws + WS_H); g.Bt = (const bf16*)(p.ws + WT_WQ) + (size_t)layer * 2048 * 1024; g.zsA = 0; g.zsB = 0; g.K = 1024;
    pg8::TileOrder S; S.nM = TL / 256; S.nN = 8; S.nwg = S.nM * S.nN; S.G = cx.nb; S.c = cx.bid; S.nz = 1; S.exN = 8; S.expn0 = 0; S.extra = layer == 0 ? 4 * 8 : 0;
    EpiQp E; E.ws = p.ws;
    pg8::gemm_phase<EpiQp, pg8::TileOrder>(lds, g, S, E, cx.tid);
}

__device__ __forceinline__ void ph_peerconv(const Ctx& cx, int layer) {
    CParams& p = get_params();
    const int gt = cx.bid * NTHREADS + cx.tid, NGT = cx.nb * NTHREADS;
    const f32x4* su = (const f32x4*)(p.in[I_PU] + (size_t)layer * 16384 * 1024); const f32x4* sv = (const f32x4*)(p.in[I_PV] + (size_t)layer * 16384 * 1024);
    int* du = (int*)(p.ws + WS_PU); int* dv = (int*)(p.ws + WS_PV);
    for (int i = gt; i < 16384 * 1024 / 4; i += NGT) { const f32x4 a = __builtin_nontemporal_load(su + i) * PEER_SU, c = __builtin_nontemporal_load(sv + i) * PEER_SV;
        int wa = 0, wc = 0; wa = __builtin_amdgcn_cvt_pk_fp8_f32(a[0], a[1], wa, false); wa = __builtin_amdgcn_cvt_pk_fp8_f32(a[2], a[3], wa, true);
        wc = __builtin_amdgcn_cvt_pk_fp8_f32(c[0], c[1], wc, false); wc = __builtin_amdgcn_cvt_pk_fp8_f32(c[2], c[3], wc, true);
        const int e = i >> 8, q = i & 255, di = (((q >> 5) * 16384 + e) << 5) + (q & 31); du[di] = wa; dv[di] = wc; }
}
__device__ __forceinline__ unsigned mono_key(float s, unsigned lowbits, unsigned mask) { const unsigned u = __float_as_uint(s); const unsigned k = (u & 0x80000000u) ? ~u : (u | 0x80000000u); return (k & ~mask) | lowbits; }
__device__ __forceinline__ float mono_val(unsigned key, unsigned mask) { const unsigned k = (key & ~mask) | ((mask + 1u) >> 1); return __uint_as_float((k & 0x80000000u) ? (k & 0x7fffffffu) : ~k); }
#define TOP16_INSERT(t, v_) do { unsigned v__ = (v_); _Pragma("unroll") for (int k_ = 0; k_ < 16; ++k_) { const unsigned hi__ = t[k_] > v__ ? t[k_] : v__; v__ = t[k_] > v__ ? v__ : t[k_]; t[k_] = hi__; } } while (0)
__device__ __forceinline__ void top16_merge_pair(unsigned (&t)[16]) {
    unsigned c[16];
#pragma unroll
    for (int k = 0; k < 16; ++k) { const unsigned o = (unsigned)__shfl_xor((int)t[15 - k], 32); c[k] = t[k] > o ? t[k] : o; }
#pragma unroll
    for (int d = 8; d >= 1; d >>= 1)
#pragma unroll
        for (int k = 0; k < 16; ++k) if ((k & d) == 0) { const unsigned a = c[k], bb = c[k + d]; c[k] = a > bb ? a : bb; c[k + d] = a > bb ? bb : a; }
#pragma unroll
    for (int k = 0; k < 16; ++k) t[k] = c[k];
}
typedef float f32x16 __attribute__((ext_vector_type(16)));
__device__ __forceinline__ void ph_select(const Ctx& cx, int layer) {
    CParams& p = get_params();
    const int lane = cx.tid & 63, wave = cx.tid >> 6, l31 = lane & 31, hi = lane >> 5;
    const int gw = cx.bid * NWAVES + wave, NGW = cx.nb * NWAVES;
    const int nrows = layer == 0 ? TA : TL;
    const bf16* QP = (const bf16*)(p.ws + WS_QP); const bf16* KY = (const bf16*)(p.ws + WT_KEYS) + (size_t)layer * 8 * 2 * 128 * 128;
    for (int it = gw; it < (nrows / 32) * 8; it += NGW) {
        const int h = it & 7, r0 = (it >> 3) * 32;
        unsigned ab[2][16];
#pragma unroll
        for (int s = 0; s < 2; ++s) {
            const bf16* kp = KY + ((size_t)(h * 2 + s) * 128 + l31) * 128 + 8 * hi; const bf16* qp = QP + (size_t)(r0 + l31) * 2048 + (h * 2 + s) * 128 + 8 * hi;
            bf16x8 qf[8];
#pragma unroll
            for (int ks = 0; ks < 8; ++ks) qf[ks] = *(const bf16x8*)(qp + 16 * ks);
            unsigned t[16];
#pragma unroll
            for (int k = 0; k < 16; ++k) t[k] = 0u;
#pragma unroll 1
            for (int nt = 0; nt < 4; ++nt) {
                f32x16 acc;
#pragma unroll
                for (int r = 0; r < 16; ++r) acc[r] = 0.f;
#pragma unroll
                for (int ks = 0; ks < 8; ++ks) acc = __builtin_amdgcn_mfma_f32_32x32x16_bf16(*(const bf16x8*)(kp + (size_t)nt * 32 * 128 + 16 * ks), qf[ks], acc, 0, 0, 0);
#pragma unroll
                for (int r = 0; r < 16; ++r) { const int n = 32 * nt + (r & 3) + 8 * (r >> 2) + 4 * hi; TOP16_INSERT(t, mono_key(acc[r], 127u - (unsigned)n, 127u)); }
            }
            top16_merge_pair(t);
#pragma unroll
            for (int k = 0; k < 16; ++k) ab[s][k] = t[k];
        }
        float av[16], bv[16];
#pragma unroll
        for (int k = 0; k < 16; ++k) { av[k] = mono_val(ab[0][k], 127u); bv[k] = mono_val(ab[1][k], 127u); }
        unsigned t2[16];
#pragma unroll
        for (int k = 0; k < 16; ++k) t2[k] = 0u;
#define CELL(i1, j1, i2, j2) do { const float sv_ = hi ? av[i2] + bv[j2] : av[i1] + bv[j1]; const unsigned lb_ = hi ? 255u - (unsigned)((i2) * 16 + (j2)) : 255u - (unsigned)((i1) * 16 + (j1)); TOP16_INSERT(t2, mono_key(sv_, lb_, 255u)); } while (0)
        CELL(0, 0, 1, 9 - 8);  CELL(0, 1, 1, 2);  CELL(0, 2, 1, 3);  CELL(0, 3, 1, 4);  CELL(0, 4, 1, 5);  CELL(0, 5, 1, 6);  CELL(0, 6, 1, 7);  CELL(0, 7, 2, 0);
        CELL(0, 8, 2, 1);  CELL(0, 9, 2, 2);  CELL(0, 10, 2, 3); CELL(0, 11, 2, 4); CELL(0, 12, 3, 0); CELL(0, 13, 3, 1); CELL(0, 14, 3, 2); CELL(0, 15, 3, 3);
        CELL(1, 0, 4, 0);  CELL(4, 1, 4, 2);  CELL(5, 0, 5, 1);  CELL(6, 0, 6, 1);  CELL(7, 0, 7, 1);  CELL(8, 0, 9, 0);  CELL(10, 0, 11, 0); CELL(12, 0, 13, 0); CELL(14, 0, 15, 0);
#undef CELL
        top16_merge_pair(t2);
        const float v0 = mono_val(t2[0], 255u); float e[16], esum = 0.f; int eid[16];
#pragma unroll
        for (int k = 0; k < 16; ++k) { e[k] = __expf(mono_val(t2[k], 255u) - v0); esum += e[k];
            const unsigned c = 255u - (t2[k] & 255u), ci = c >> 4, cj = c & 15u; unsigned ka = ab[0][0], kb = ab[1][0];
#pragma unroll
            for (int q = 1; q < 16; ++q) { ka = ci == (unsigned)q ? ab[0][q] : ka; kb = cj == (unsigned)q ? ab[1][q] : kb; }
            eid[k] = (int)((127u - (ka & 127u)) * 128u + (127u - (kb & 127u))); }
        const float inv = 1.f / esum;
        if (hi == 0) { int* dst = (int*)(p.ws + WS_EID) + (size_t)(r0 + l31) * 128 + h * 16;
#pragma unroll
            for (int k = 0; k < 16; k += 4) *(u32x4*)(dst + k) = (u32x4){(unsigned)eid[k], (unsigned)eid[k + 1], (unsigned)eid[k + 2], (unsigned)eid[k + 3]}; }
        else { float* dst = (float*)(p.ws + WS_EG) + (size_t)(r0 + l31) * 128 + h * 16;
#pragma unroll
            for (int k = 0; k < 16; k += 4) *(f32x4*)(dst + k) = (f32x4){e[k] * inv, e[k + 1] * inv, e[k + 2] * inv, e[k + 3] * inv}; }
    }
}
__device__ __forceinline__ void fp8x16_to_f32(const u32x4 w, f32x2 (&f)[8]) {
    f[0] = __builtin_amdgcn_cvt_pk_f32_fp8((int)w.x, false); f[1] = __builtin_amdgcn_cvt_pk_f32_fp8((int)w.x, true); f[2] = __builtin_amdgcn_cvt_pk_f32_fp8((int)w.y, false); f[3] = __builtin_amdgcn_cvt_pk_f32_fp8((int)w.y, true);
    f[4] = __builtin_amdgcn_cvt_pk_f32_fp8((int)w.z, false); f[5] = __builtin_amdgcn_cvt_pk_f32_fp8((int)w.z, true); f[6] = __builtin_amdgcn_cvt_pk_f32_fp8((int)w.w, false); f[7] = __builtin_amdgcn_cvt_pk_f32_fp8((int)w.w, true);
}
__device__ __forceinline__ void ph_peer_u(const Ctx& cx, int layer) {
    CParams& p = get_params();
    const int lane = cx.tid & 63, wave = __builtin_amdgcn_readfirstlane(cx.tid >> 6);
    const int nrows = layer == 0 ? TA : TL;
    const int slice = cx.bid & 7, ws_ = (cx.bid >> 3) * NWAVES + wave, NWS = (cx.nb >> 3) * NWAVES;
    const __amdgpu_buffer_rsrc_t ru = __builtin_amdgcn_make_buffer_rsrc((void*)uni_ptr(p.ws + WS_PU + (size_t)slice * (16384 * 128)), (short)0, 16384 * 128, 0x00020000);
    const int j8 = lane & 7, grp = lane >> 3;
    float* PART = (float*)(p.ws + WS_PART) + (size_t)slice * TA * 128;
    for (int t_ = ws_; t_ < nrows; t_ += NWS) {
        int t = __builtin_amdgcn_readfirstlane(t_); asm volatile("" : "+s"(t));
        f32x2 x[8];
        { const u32x4 w0 = *(const u32x4*)((const bf16*)(p.ws + WS_H) + (size_t)t * 1024 + slice * 128 + j8 * 16), w1 = *(const u32x4*)((const bf16*)(p.ws + WS_H) + (size_t)t * 1024 + slice * 128 + j8 * 16 + 8);
          const f32x4 a = bf4lo(w0), b = bf4hi(w0), c = bf4lo(w1), d = bf4hi(w1);
          x[0] = (f32x2){a[0], a[1]}; x[1] = (f32x2){a[2], a[3]}; x[2] = (f32x2){b[0], b[1]}; x[3] = (f32x2){b[2], b[3]}; x[4] = (f32x2){c[0], c[1]}; x[5] = (f32x2){c[2], c[3]}; x[6] = (f32x2){d[0], d[1]}; x[7] = (f32x2){d[2], d[3]}; }
        const int e0 = ((const int*)(p.ws + WS_EID))[(size_t)t * 128 + lane], e1 = ((const int*)(p.ws + WS_EID))[(size_t)t * 128 + 64 + lane];
        u32x4 row[16];
#pragma unroll
        for (int s = 0; s < 16; ++s) { const int e = __shfl(s < 8 ? e0 : e1, (s & 7) * 8 + grp); row[s] = __builtin_amdgcn_raw_buffer_load_b128(ru, (unsigned)(e * 128 + j8 * 16), 0, 0); }
        float res0 = 0.f, res1 = 0.f;
#pragma unroll
        for (int s = 0; s < 16; ++s) { f32x2 f[8]; fp8x16_to_f32(row[s], f);
            f32x2 a = f[0] * x[0];
#pragma unroll
            for (int j = 1; j < 8; ++j) a += f[j] * x[j];
            float d = a.x + a.y; d += __shfl_xor(d, 1); d += __shfl_xor(d, 2); d += __shfl_xor(d, 4);
            if ((s & 7) == j8) { if (s < 8) res0 = d; else res1 = d; } }
        float* pt = PART + (size_t)t * 128 + j8 * 8 + grp; pt[0] = res0; pt[64] = res1;
    }
}
__device__ __forceinline__ void ph_peer_v(const Ctx& cx, int layer) {
    CParams& p = get_params();
    const int lane = cx.tid & 63, wave = __builtin_amdgcn_readfirstlane(cx.tid >> 6);
    const int nrows = layer == 0 ? TA : TL;
    const int slice = cx.bid & 7, ws_ = (cx.bid >> 3) * NWAVES + wave, NWS = (cx.nb >> 3) * NWAVES;
    const __amdgpu_buffer_rsrc_t rv = __builtin_amdgcn_make_buffer_rsrc((void*)uni_ptr(p.ws + WS_PV + (size_t)slice * (16384 * 128)), (short)0, 16384 * 128, 0x00020000);
    const int c16 = lane & 15, q4 = lane >> 4;
    for (int t_ = ws_; t_ < nrows; t_ += NWS) {
        int t = __builtin_amdgcn_readfirstlane(t_); asm volatile("" : "+s"(t));
        float d0 = 0.f, d1 = 0.f;
#pragma unroll
        for (int xs = 0; xs < 8; ++xs) { const float* pt = (const float*)(p.ws + WS_PART) + ((size_t)xs * TA + t) * 128 + lane; d0 += pt[0]; d1 += pt[64]; }
        const float w0 = ((const float*)(p.ws + WS_EG))[(size_t)t * 128 + lane] * gelu_tanh(d0 * (1.f / PEER_SU)), w1 = ((const float*)(p.ws + WS_EG))[(size_t)t * 128 + 64 + lane] * gelu_tanh(d1 * (1.f / PEER_SU));
        const int e0 = ((const int*)(p.ws + WS_EID))[(size_t)t * 128 + lane], e1 = ((const int*)(p.ws + WS_EID))[(size_t)t * 128 + 64 + lane];
        f32x2 acc[4];
#pragma unroll
        for (int j = 0; j < 4; ++j) acc[j] = (f32x2){0.f, 0.f};
#pragma unroll
        for (int sb = 0; sb < 32; sb += 16) {
            u32x2 vr[16]; float wv[16];
#pragma unroll
            for (int s = 0; s < 16; ++s) { const int pr = (sb + s) * 4 + q4;
                const int e = __shfl(sb == 0 ? e0 : e1, pr & 63); wv[s] = __shfl(sb == 0 ? w0 : w1, pr & 63);
                vr[s] = __builtin_amdgcn_raw_buffer_load_b64(rv, (unsigned)(e * 128 + c16 * 8), 0, 0); }
#pragma unroll
            for (int s = 0; s < 16; ++s) { const f32x2 f0 = __builtin_amdgcn_cvt_pk_f32_fp8((int)vr[s].x, false), f1 = __builtin_amdgcn_cvt_pk_f32_fp8((int)vr[s].x, true), f2 = __builtin_amdgcn_cvt_pk_f32_fp8((int)vr[s].y, false), f3 = __builtin_amdgcn_cvt_pk_f32_fp8((int)vr[s].y, true);
                acc[0] += wv[s] * f0; acc[1] += wv[s] * f1; acc[2] += wv[s] * f2; acc[3] += wv[s] * f3; }
        }
#pragma unroll
        for (int j = 0; j < 4; ++j) { acc[j].x += __shfl_xor(acc[j].x, 16); acc[j].y += __shfl_xor(acc[j].y, 16); acc[j].x += __shfl_xor(acc[j].x, 32); acc[j].y += __shfl_xor(acc[j].y, 32); }
        if (q4 == 0) { float* o = (float*)(p.ws + WS_POUT) + (size_t)t * 1024 + slice * 128 + c16 * 8;
            *(f32x4*)o = (f32x4){acc[0].x, acc[0].y, acc[1].x, acc[1].y}; *(f32x4*)(o + 4) = (f32x4){acc[2].x, acc[2].y, acc[3].x, acc[3].y}; }
    }
}
__device__ __forceinline__ void ph_peer_fin(const Ctx& cx, int layer, float scale) {
    CParams& p = get_params();
    const int lane = cx.tid & 63, wave = cx.tid >> 6;
    const int gw = cx.bid * NWAVES + wave, NGW = cx.nb * NWAVES;
    const int nrows = layer == 0 ? TA : TL;
    float* X = (float*)(p.ws + WS_XCUR);
    for (int r = gw; r < nrows; r += NGW) {
        const float* g2 = (const float*)(p.ws + WS_MODV) + ((size_t)layer * 5 + row_mi(r)) * 6144 + 5120;
        f32x4 v[4]; float ss = 0.f;
#pragma unroll
        for (int j = 0; j < 4; ++j) { const int c = j * 256 + lane * 4; f32x4 xv = *(const f32x4*)(X + (size_t)r * 1024 + c);
            xv += *(const f32x4*)(g2 + c) * *(const f32x4*)((const float*)(p.ws + WS_POUT) + (size_t)r * 1024 + c) * (scale / PEER_SV); *(f32x4*)(X + (size_t)r * 1024 + c) = xv; v[j] = xv;
            ss += xv[0] * xv[0] + xv[1] * xv[1] + xv[2] * xv[2] + xv[3] * xv[3]; }
        const float rs = rsqrtf(wave_sum(ss) * (1.f / DM) + NORM_EPS);
        if (layer == DEPTH - 1) {
#pragma unroll
            for (int j = 0; j < 4; ++j) { const int c = j * 256 + lane * 4; *(f32x4*)(p.out + (size_t)r * 1024 + c) = v[j] * rs * *(const f32x4*)(p.in[I_FG] + c); }
        } else {
            const float* g = p.in[I_N1G] + (layer + 1) * DM; const float* mv = (const float*)(p.ws + WS_MODV) + ((size_t)(layer + 1) * 5 + row_mi(r)) * 6144;
#pragma unroll
            for (int j = 0; j < 4; ++j) { const int c = j * 256 + lane * 4;
                const f32x4 y = v[j] * rs * *(const f32x4*)(g + c); const f32x4 h = y * (1.f + *(const f32x4*)(mv + 1024 + c)) + *(const f32x4*)(mv + c);
                u32x2 w; w.x = pk2(h[0], h[1]); w.y = pk2(h[2], h[3]); *(u32x2*)((bf16*)(p.ws + WS_H) + (size_t)r * DM + c) = w; }
        }
    }
}

constexpr int NPL = 13, NPHASE = 1 + DEPTH * NPL;
#ifndef ONLY
#define ONLY -1
#endif
#ifndef NOT
#define NOT -1
#endif
#define ON(n) ((ONLY < 0 || ONLY == (n)) && NOT != (n))
#ifndef PROBE_HAS
#define PROBE_HAS(n) false
#endif
#define REPN(n) (PROBE_HAS(n) ? 2 : 1)
#define RUN(n, call) do { { MKCX(); if (ON(n)) { const int rep_ = 0; (void)rep_; call; } } if (REPN(n) > 1) { __syncthreads(); { MKCX(); if (ON(n)) { const int rep_ = 1; (void)rep_; call; } } __syncthreads(); } } while (0)
#define MKCX() Ctx cx; cx.tid = threadIdx.x; cx.bid = blockIdx.x; cx.nb = gridDim.x; asm volatile("" : "+v"(cx.tid), "+s"(cx.bid), "+s"(cx.nb))
#define IN(k) (lo <= (k) && (k) < hi)
#define SEAM(k) do { if (IN(k) && IN((k) + 1)) { XcdBarrier bar_; bar_.bar = (unsigned*)(get_params().ws + WS_CTL) + 4096; bar_.x = xb_xcc_id(); bar_.st = st; xcd_barrier(bar_); } } while (0)
template <int LAYER> __device__ __forceinline__ void layer_program(const int lo, const int hi, float* sm, PG8_LAS unsigned char* lds, volatile LAS unsigned* st) {
    constexpr int B = 1 + LAYER * NPL;
    if (LAYER == 0) { if (IN(B + 0)) { RUN(0, ph_norm(cx, LAYER, 0, 0)); RUN(50, ph_filters(cx, LAYER, sm)); __syncthreads(); RUN(102, ph_s5tables(cx, 0, sm)); } SEAM(B + 0); }
    if (IN(B + 1)) { RUN(1, ph_inproj(cx, LAYER, lds)); } SEAM(B + 1);
    if (IN(B + 2)) { RUN(2, ph_attn(cx, LAYER, sm)); __syncthreads(); RUN(20, ph_hypre(cx, LAYER, sm)); __syncthreads(); RUN(21, ph_s5states(cx, LAYER, sm)); } SEAM(B + 2);
    if (IN(B + 3)) { RUN(3, ph_hyfft(cx, LAYER, sm, rep_ + 1 < REPN(3))); __syncthreads(); RUN(31, ph_hyconv_ctx(cx, LAYER, sm)); __syncthreads(); RUN(30, ph_s5out(cx, LAYER, sm)); } SEAM(B + 3);
    if (IN(B + 4)) { RUN(4, ph_glu(cx, LAYER, lds)); __syncthreads(); RUN(40, ph_hypost(cx, LAYER, sm)); } SEAM(B + 4);
    if (IN(B + 5)) { RUN(5, ph_merge(cx, LAYER, lds)); } SEAM(B + 5);
    if (IN(B + 6)) { RUN(6, ph_outproj(cx, LAYER, lds, 1.f / REPN(6))); } SEAM(B + 6);
    if (IN(B + 7)) { RUN(7, ph_norm(cx, LAYER, 1, LAYER == DEPTH - 1)); if (LAYER + 1 < DEPTH) { RUN(70, ph_s5tables(cx, LAYER + 1, sm)); __syncthreads(); RUN(51, ph_filters(cx, LAYER + 1, sm)); } RUN(71, ph_peerconv(cx, LAYER)); } SEAM(B + 7);
    if (IN(B + 8)) { RUN(8, ph_qp(cx, LAYER, lds)); } SEAM(B + 8);
    if (IN(B + 9)) { RUN(9, ph_select(cx, LAYER)); } SEAM(B + 9);
    if (IN(B + 10)) { RUN(10, ph_peer_u(cx, LAYER)); } SEAM(B + 10);
    if (IN(B + 11)) { RUN(11, ph_peer_v(cx, LAYER)); } SEAM(B + 11);
    if (IN(B + 12)) { RUN(12, ph_peer_fin(cx, LAYER, 1.f / REPN(12))); } SEAM(B + 12);
}
__global__ void __launch_bounds__(NTHREADS, 2) mk_fwd(Params p) {
    extern __shared__ __attribute__((aligned(16))) unsigned char lds_raw[];
    float* sm = (float*)lds_raw; PG8_LAS unsigned char* lds = (PG8_LAS unsigned char*)lds_raw;
    volatile LAS unsigned* st = (volatile LAS unsigned*)(lds + LDS_MISC);
    if (threadIdx.x < 4) st[threadIdx.x] = 0u;
    __syncthreads();
    const int lo = p.ph_lo, hi = p.ph_hi;
    if (hi - lo > 1) (void)xcd_barrier_post((unsigned*)(p.ws + WS_CTL) + 4096, st);
    if (IN(0)) { RUN(100, ph_prologue(cx, sm)); RUN(101, ph_convert(cx));  } SEAM(0);
    layer_program<0>(lo, hi, sm, lds, st);
    layer_program<1>(lo, hi, sm, lds, st);
}
}

extern "C" void kernel_launch(void* const* d_in, const int* in_sizes, int n_in, void* d_out, int out_size, void* d_ws, size_t ws_size, hipStream_t stream) {
    static int grid = 0;
    if (grid == 0) {
        if (n_in != 40 || out_size != TL * DM || ws_size < WS_END) { fprintf(stderr, "kernel_launch: unexpected shapes (n_in %d out %d ws %zu)\n", n_in, out_size, ws_size); grid = -1; return; }
        int dev = 0, cus = 0;
        if (hipGetDevice(&dev) != hipSuccess || hipDeviceGetAttribute(&cus, hipDeviceAttributeMultiprocessorCount, dev) != hipSuccess) { grid = -1; return; }
        if (hipFuncSetAttribute((const void*)mk_fwd, hipFuncAttributeMaxDynamicSharedMemorySize, LDS_BYTES) != hipSuccess) { fprintf(stderr, "kernel_launch: hipFuncSetAttribute failed\n"); grid = -1; return; }
        grid = cus;
    }
    if (grid < 0) return;
    (void)hipMemsetAsync((char*)d_ws + WS_CTL, 0, 1 * MiB, stream);
    Params a{};
    for (int i = 0; i < 40; ++i) a.in[i] = (const float*)d_in[i];
    a.out = (float*)d_out; a.ws = (unsigned char*)d_ws;
#if PER_PHASE_LAUNCH
    for (int ph = 0; ph < NPHASE; ++ph) { a.ph_lo = ph; a.ph_hi = ph + 1; hipLaunchKernelGGL(mk_fwd, dim3(grid), dim3(NTHREADS), LDS_BYTES, stream, a); }
#else
    a.ph_lo = 0; a.ph_hi = NPHASE; hipLaunchKernelGGL(mk_fwd, dim3(grid), dim3(NTHREADS), LDS_BYTES, stream, a);
#endif
}
```

```cpp
#include <hip/hip_runtime.h>
#include <stdint.h>
#include <math.h>
#include <stdio.h>

#ifndef PER_PHASE_LAUNCH
#define PER_PHASE_LAUNCH 0
#endif

namespace {
typedef unsigned short bf16;
typedef float f32x4 __attribute__((ext_vector_type(4)));
typedef unsigned u32x2 __attribute__((ext_vector_type(2)));
typedef unsigned u32x4 __attribute__((ext_vector_type(4)));
typedef short bf16x8 __attribute__((ext_vector_type(8)));
#define LAS __attribute__((address_space(3)))

constexpr int DM = 1024, NBATCH = 4, SEQ = 4096, CTXL = 256, DEPTH = 2;
constexpr int TL = NBATCH * SEQ, TC = NBATCH * CTXL, TA = TL + TC;
constexpr int INW = 5888, COL_K = 512, COL_V = 640, COL_S5 = 768, COL_HY = 1280, COL_GATE = 2816;
constexpr int NTHREADS = 512, NWAVES = 8;
constexpr float NORM_EPS = 1e-6f;
constexpr float HY_FAST = 15.350567286626973f, HY_SLOW = 3.0701134573253945f;

constexpr size_t MiB = 1u << 20;
constexpr size_t WS_CTL = 0;
constexpr size_t WS_XCUR = 1 * MiB;
constexpr size_t WS_MODV = 69 * MiB;
constexpr size_t WS_ROPE = WS_MODV + 512 * 1024;
constexpr size_t WS_S5A = 70 * MiB;
constexpr size_t WS_S5B = 70 * MiB + 256 * 1024;
constexpr size_t WS_FILT = 72 * MiB;
constexpr size_t FILT_CTX_OFF = 16 * MiB;
constexpr size_t WS_WTS = 89 * MiB;
constexpr size_t WT_IN = WS_WTS;
constexpr size_t WT_GLU = WT_IN + 23 * MiB;
constexpr size_t WT_BR = WT_GLU + 1 * MiB;
constexpr size_t WT_OUT = WT_BR + 6 * MiB;
constexpr size_t WT_WQ = WT_OUT + 4 * MiB;
constexpr size_t WT_KEYS = WT_WQ + 8 * MiB;
constexpr size_t WS_H = 132 * MiB;
constexpr size_t WS_VV = WS_H;
constexpr size_t WS_VVC = WS_H + 32 * MiB;
constexpr size_t WS_Q = 166 * MiB;
constexpr size_t WS_K = 183 * MiB;
constexpr size_t WS_V = WS_K + (size_t)TA * 128 * 2;
constexpr size_t WS_U = WS_V + (size_t)TA * 128 * 2;
constexpr size_t WS_Z = WS_U + (size_t)TA * 512 * 2;
constexpr size_t WS_QP = WS_Q;
constexpr size_t WS_G = 260 * MiB;
constexpr size_t WS_ATT = 362 * MiB;
constexpr size_t WS_HY = WS_ATT + 17 * MiB, WS_S5O = WS_HY + 17 * MiB, WS_S5Y = WS_S5O + 17 * MiB;
constexpr size_t WS_M = 430 * MiB;
constexpr size_t WS_S5TMP = WS_M;
constexpr size_t WS_S5E = WS_M;
constexpr size_t WS_S5P = WS_M + 16 * MiB;
constexpr size_t WS_S5K = WS_M + 32 * MiB;
constexpr size_t WS_S5A64 = WS_S5A + 64 * 1024;
constexpr size_t WS_S5C = WS_S5A + 128 * 1024;
constexpr size_t WS_X0C = 464 * MiB;
constexpr size_t WS_EID = 481 * MiB;
constexpr size_t WS_EG = WS_EID + (size_t)TA * 128 * 4;
constexpr size_t WS_PU = WS_G;
constexpr size_t WS_PV = WS_G + 16 * MiB;
constexpr float PEER_SU = 512.f, PEER_SV = 64.f;
constexpr size_t WS_PART = WS_QP;
constexpr size_t WS_POUT = WS_ATT;
constexpr size_t WS_HIN = WS_EID;
constexpr size_t WS_END = 498 * MiB;
constexpr int LDS_STAGE = 131072;
constexpr int LDS_MISC = LDS_STAGE;
constexpr int LDS_BYTES = 147456;

struct Params {
    const float* in[40];
    float* out;
    unsigned char* ws;
    int ph_lo, ph_hi;
};
enum { I_X = 0, I_C, I_CTX, I_CCTX, I_MODW, I_MODB, I_N1G, I_N2G, I_INW, I_GATEB, I_SINK, I_HSW, I_HSB, I_HW1, I_HB1, I_HF1, I_HW2, I_HB2, I_HF2, I_HW3,
       I_HBIAS, I_SARE, I_SAIM, I_SLDT, I_SBRE, I_SBIM, I_SCRE, I_SCIM, I_SD, I_GLUW, I_GLUB, I_BRA, I_BRH, I_BRS, I_OUTW, I_WQ, I_PKEYS, I_PU, I_PV, I_FG };

struct Ctx { int tid, bid, nb; };
typedef __attribute__((address_space(4))) const Params CParams;
__device__ __forceinline__ CParams& get_params() { CParams* q = (CParams*)__builtin_amdgcn_kernarg_segment_ptr(); asm volatile("" : "+s"(q)); return *q; }
__device__ __forceinline__ float bf2f(bf16 v) { return __uint_as_float((unsigned)v << 16); }
__device__ __forceinline__ bf16 f2bf(float f) { unsigned u = __float_as_uint(f); return (bf16)((u + 0x7fffu + ((u >> 16) & 1u)) >> 16); }
__device__ __forceinline__ unsigned pk2(float lo, float hi) { return (unsigned)f2bf(lo) | ((unsigned)f2bf(hi) << 16); }
__device__ __forceinline__ float wave_sum(float v) {
#pragma unroll
    for (int o = 32; o > 0; o >>= 1) v += __shfl_xor(v, o);
    return v;
}
__device__ __forceinline__ float fsin_rev(float rev) { return __builtin_amdgcn_sinf(rev); }
__device__ __forceinline__ float fcos_rev(float rev) { return __builtin_amdgcn_cosf(rev); }
__device__ __forceinline__ float fsin(float x) { return __builtin_amdgcn_sinf(x * 0.15915494309189535f); }
__device__ __forceinline__ float fcos(float x) { return __builtin_amdgcn_cosf(x * 0.15915494309189535f); }
__device__ __forceinline__ float sigmoidf_(float x) { return 1.f / (1.f + __expf(-x)); }
__device__ __forceinline__ float gelu_tanh(float x) { const float u = 0.7978845608028654f * (x + 0.044715f * x * x * x); const float e = __expf(2.f * u); return 0.5f * x * (2.f - 2.f / (e + 1.f)); }
__device__ __forceinline__ int row_mi(int r) { return r < TL ? (r >> 12) : 4; }
__device__ __forceinline__ int row_b(int r) { return r < TL ? (r >> 12) : ((r - TL) >> 8); }

#define XB_TMO      128
#define XB_XCNT(j)  (256  + 64 * (j))
#define XB_XSUB(j)  (1280 + 64 * (j))
#define XB_XGEN(j)  (2304 + 64 * (j))
#define XB_TOP      3328
#define XB_TOPGEN   3392
#define XCD_BAR_WORDS 3456
#define XB_SPIN_CAP (1u << 27)
__device__ __forceinline__ unsigned xb_ld(unsigned* p)              { return __hip_atomic_load(p, __ATOMIC_RELAXED, __HIP_MEMORY_SCOPE_AGENT); }
__device__ __forceinline__ unsigned xb_add(unsigned* p, unsigned v) { return __hip_atomic_fetch_add(p, v, __ATOMIC_RELAXED, __HIP_MEMORY_SCOPE_AGENT); }
__device__ __forceinline__ unsigned xb_xcc_id() { return (unsigned)__builtin_amdgcn_s_getreg((3 << 11) | 20) & 0xFu; }
#define XB_SPIN(cond, bar) do { unsigned _sp = 0; while (cond) { __builtin_amdgcn_s_sleep(1); \
    if ((++_sp & 255u) == 0u) { if (xb_ld(&(bar)[XB_TMO])) break; if (_sp > XB_SPIN_CAP) { atomicAdd(&(bar)[XB_TMO], 1u); break; } } } } while (0)
struct XcdBarrier { unsigned* bar; unsigned x; volatile LAS unsigned* st; };
__device__ __forceinline__ XcdBarrier xcd_barrier_post(unsigned* bar, volatile LAS unsigned* st) {
    XcdBarrier b; b.bar = bar; b.x = xb_xcc_id(); b.st = st;
    if (threadIdx.x == 0) (void)xb_add(&bar[XB_XCNT(b.x)], 1u);
    return b;
}
__device__ __forceinline__ void xcd_barrier_complete(unsigned* bar, unsigned x, unsigned& nloc, unsigned& nx) {
    const unsigned G = gridDim.x * gridDim.y * gridDim.z;
    unsigned sum, cnt, mine, sp = 0u;
    for (;;) {
        sum = 0u; cnt = 0u; mine = 0u;
#pragma unroll
        for (unsigned j = 0; j < 16; ++j) { const unsigned c = xb_ld(&bar[XB_XCNT(j)]); sum += c; cnt += (c > 0u) ? 1u : 0u; mine = (j == x) ? c : mine; }
        if (sum == G) break;
        __builtin_amdgcn_s_sleep(1);
        if ((++sp & 255u) == 0u) { if (xb_ld(&bar[XB_TMO])) break; if (sp > XB_SPIN_CAP) { atomicAdd(&bar[XB_TMO], 1u); break; } }
    }
    nloc = mine > 0u ? mine : 1u; nx = cnt > 0u ? cnt : 1u;
}
__device__ __forceinline__ void xcd_barrier(const XcdBarrier& b) {
    asm volatile("s_waitcnt vmcnt(0)" ::: "memory");
    __syncthreads();
    if (threadIdx.x == 0) {
        unsigned* bar = b.bar; asm volatile("" : "+s"(bar));
        __builtin_amdgcn_s_waitcnt(0);
        unsigned nloc = b.st[0], nx = b.st[1];
        if (nloc == 0u) { xcd_barrier_complete(bar, b.x, nloc, nx); b.st[0] = nloc; b.st[1] = nx; }
        const unsigned old = xb_add(&bar[XB_XSUB(b.x)], 1u);
        const unsigned gen = old / nloc;
        if (old + 1u == (gen + 1u) * nloc) {
            __builtin_amdgcn_fence(__ATOMIC_RELEASE, "agent");
            asm volatile("s_waitcnt vmcnt(0)" ::: "memory");
            const unsigned og = xb_add(&bar[XB_TOP], 1u);
            const unsigned tg = og / nx;
            if (og + 1u == (tg + 1u) * nx) xb_add(&bar[XB_TOPGEN], 1u);
            else XB_SPIN(xb_ld(&bar[XB_TOPGEN]) == tg, bar);
            __builtin_amdgcn_fence(__ATOMIC_ACQUIRE, "agent");
            xb_add(&bar[XB_XGEN(b.x)], 1u);
            asm volatile("s_waitcnt vmcnt(0)" ::: "memory");
        } else {
            XB_SPIN(xb_ld(&bar[XB_XGEN(b.x)]) == gen, bar);
            __builtin_amdgcn_fence(__ATOMIC_ACQUIRE, "agent");
            asm volatile("s_waitcnt vmcnt(0)" ::: "memory");
        }
    }
    __syncthreads();
}

__device__ __forceinline__ void ph_prologue(const Ctx& cx0, float* sm) {
    { CParams& p = get_params(); Ctx cx = cx0;
    const int tid = cx.tid, lane = tid & 63, wave = tid >> 6;
    const int gt = cx.bid * NTHREADS + tid, NGT = cx.nb * NTHREADS;
    const int gw = cx.bid * NWAVES + wave, NGW = cx.nb * NWAVES;
    unsigned char* ws = p.ws;
    {
        f32x4* dst = (f32x4*)(ws + WS_XCUR);
        const f32x4* sx = (const f32x4*)p.in[I_X]; const f32x4* sc = (const f32x4*)p.in[I_CTX];
        for (int i = gt; i < TL * DM / 4; i += NGT) dst[i] = sx[i];
        for (int i = gt; i < TC * DM / 4; i += NGT) dst[TL * DM / 4 + i] = sc[i];
    }
    }
    { CParams& p = get_params(); Ctx cx; cx.tid = threadIdx.x; cx.bid = blockIdx.x; cx.nb = gridDim.x; asm volatile("" : "+v"(cx.tid), "+s"(cx.bid), "+s"(cx.nb));
      const int tid = cx.tid, lane = tid & 63, wave = tid >> 6; const int gt = cx.bid * NTHREADS + tid, NGT = cx.nb * NTHREADS; const int gw = cx.bid * NWAVES + wave, NGW = cx.nb * NWAVES; unsigned char* ws = p.ws; (void)lane; (void)gt; (void)NGT; (void)gw; (void)NGW; (void)ws;
    {
        float* sil = sm;
        float* red = sm + 5 * 1024;
        bool have = false;
        for (int it = cx.bid; it < 192; it += cx.nb) {
            if (!have) {
                for (int i = tid; i < 5 * 1024; i += NTHREADS) { const float v = i < 4096 ? p.in[I_C][i] : p.in[I_CCTX][i - 4096]; sil[i] = v / (1.f + __expf(-v)); }
                have = true; __syncthreads();
            }
            const int layer = it / 96, col = (it % 96) * 64 + lane, kp = wave;
            const float* W = p.in[I_MODW] + (size_t)layer * DM * 6144 + col;
            float a0 = 0, a1 = 0, a2 = 0, a3 = 0, a4 = 0;
            for (int k = kp * 128; k < kp * 128 + 128; ++k) { const float w = W[(size_t)k * 6144]; a0 += sil[k] * w; a1 += sil[1024 + k] * w; a2 += sil[2048 + k] * w; a3 += sil[3072 + k] * w; a4 += sil[4096 + k] * w; }
            red[(kp * 5 + 0) * 64 + lane] = a0; red[(kp * 5 + 1) * 64 + lane] = a1; red[(kp * 5 + 2) * 64 + lane] = a2; red[(kp * 5 + 3) * 64 + lane] = a3; red[(kp * 5 + 4) * 64 + lane] = a4;
            __syncthreads();
            if (tid < 320) { const int j = tid >> 6; float s = 0; for (int q = 0; q < 8; ++q) s += red[(q * 5 + j) * 64 + lane];
                ((float*)(ws + WS_MODV))[((size_t)layer * 5 + j) * 6144 + col] = s + p.in[I_MODB][layer * 6144 + col]; }
            __syncthreads();
        }
    }
    }
    { CParams& p = get_params(); Ctx cx; cx.tid = threadIdx.x; cx.bid = blockIdx.x; cx.nb = gridDim.x; asm volatile("" : "+v"(cx.tid), "+s"(cx.bid), "+s"(cx.nb));
      const int tid = cx.tid, lane = tid & 63, wave = tid >> 6; const int gt = cx.bid * NTHREADS + tid, NGT = cx.nb * NTHREADS; const int gw = cx.bid * NWAVES + wave, NGW = cx.nb * NWAVES; unsigned char* ws = p.ws; (void)lane; (void)gt; (void)NGT; (void)gw; (void)NGW; (void)ws;
    for (int i = gt; i < 64 * 16; i += NGT) { const int pos = i >> 4, f = i & 15; const float ang = (float)pos * exp2f(-(float)f * (13.287712379549449f / 16.f));
        ((float*)(ws + WS_ROPE))[i * 2] = fcos(ang); ((float*)(ws + WS_ROPE))[i * 2 + 1] = fsin(ang); }
    }
    { CParams& p = get_params(); Ctx cx; cx.tid = threadIdx.x; cx.bid = blockIdx.x; cx.nb = gridDim.x; asm volatile("" : "+v"(cx.tid), "+s"(cx.bid), "+s"(cx.nb));
      const int tid = cx.tid, lane = tid & 63, wave = tid >> 6; const int gt = cx.bid * NTHREADS + tid, NGT = cx.nb * NTHREADS; const int gw = cx.bid * NWAVES + wave, NGW = cx.nb * NWAVES; unsigned char* ws = p.ws; (void)lane; (void)gt; (void)NGT; (void)gw; (void)NGW; (void)ws;
    for (int i = gt; i < 2 * 2 * 32 * 64; i += NGT) {
        const int g = (i >> 6) & 31, ld = i >> 11;
        const float are = fminf(p.in[I_SARE][i], -1e-4f), aim = p.in[I_SAIM][i];
        const float dt = __expf(p.in[I_SLDT][ld * 32 + g]);
        const float er = __expf(are * dt), abr = er * fcos(aim * dt), abi = er * fsin(aim * dt);
        const float nr = abr - 1.0f, ni = abi, den = are * are + aim * aim;
        const float cr = (nr * are + ni * aim) / den, ci = (ni * are - nr * aim) / den;
        ((float*)(ws + WS_S5A))[i * 2] = abr; ((float*)(ws + WS_S5A))[i * 2 + 1] = abi;
        ((float*)(ws + WS_S5C))[i * 2] = are * dt; ((float*)(ws + WS_S5C))[i * 2 + 1] = aim * dt;
        for (int h = 0; h < 16; ++h) { const float br = p.in[I_SBRE][(size_t)i * 16 + h], bi = p.in[I_SBIM][(size_t)i * 16 + h];
            ((float*)(ws + WS_S5B))[((size_t)i * 16 + h) * 2] = cr * br - ci * bi; ((float*)(ws + WS_S5B))[((size_t)i * 16 + h) * 2 + 1] = cr * bi + ci * br; }
    }
    }
}


__device__ __forceinline__ void ph_filters(const Ctx& cx, int layer, float* sm) {
    CParams& p = get_params();
    const int tid = cx.tid, lane = tid & 63, wave = __builtin_amdgcn_readfirstlane(tid >> 6);
    float* Hs = sm;
    const float* w1 = p.in[I_HW1] + layer * 33 * 64; const float* w2 = p.in[I_HW2] + layer * 64 * 64; const float* w3 = p.in[I_HW3] + layer * 64 * 1024;
    for (int it = cx.bid; it < 2 * 68; it += cx.nb) {
        const int tile = it >> 1, ch = it & 1, st = tile >= 64 ? 1 : 0, tb = st ? (tile - 64) * 64 : tile * 64, L = st ? CTXL : SEQ;
        __syncthreads();
        for (int tt = wave; tt < 64; tt += NWAVES) {
            const int t = tb + tt; const float tn = (float)t / (float)L;
            float z = 0.f;
            if (lane == 0) z = tn; else if (lane <= 16) z = fcos_rev(tn * (float)lane); else if (lane <= 32) z = fsin_rev(tn * (float)(lane - 16));
            float a = p.in[I_HB1][layer * 64 + lane];
            for (int e = 0; e < 33; ++e) a += __shfl(z, e) * w1[e * 64 + lane];
            const float h1 = fsin(p.in[I_HF1][layer * 64 + lane] * a);
            float a2 = p.in[I_HB2][layer * 64 + lane];
            for (int j = 0; j < 64; ++j) a2 += __shfl(h1, j) * w2[j * 64 + lane];
            Hs[lane * 65 + tt] = fsin(p.in[I_HF2][layer * 64 + lane] * a2);
        }
        __syncthreads();
        float h[64];
#pragma unroll
        for (int k = 0; k < 64; ++k) h[k] = Hs[k * 65 + lane];
        const int t = tb + lane; const float tw = (float)t / (float)(L - 1);
        float* fbase = (float*)(p.ws + WS_FILT + (st ? FILT_CTX_OFF : 0));
        float* Ws = sm + 64 * 65;
#pragma unroll 1
        for (int cq = 0; cq < 4; ++cq) {
            __syncthreads();
            for (int i = tid; i < 64 * 128; i += NTHREADS) { const int k = i >> 7, cl = i & 127; Ws[cl * 68 + k] = w3[(size_t)k * 1024 + ch * 512 + cq * 128 + cl]; }
            __syncthreads();
#pragma unroll 1
            for (int j = 0; j < 16; ++j) {
                const int cl = wave * 16 + j, col = ch * 512 + cq * 128 + cl;
                const f32x4* wc = (const f32x4*)(Ws + cl * 68); float f = 0.f;
#pragma unroll
                for (int k4 = 0; k4 < 16; ++k4) { const f32x4 wv = wc[k4]; f += h[4 * k4] * wv[0] + h[4 * k4 + 1] * wv[1] + h[4 * k4 + 2] * wv[2] + h[4 * k4 + 3] * wv[3]; }
                const int c = col & 511;
                const float rate = HY_FAST + (HY_SLOW - HY_FAST) * ((float)c / 511.f);
                fbase[((size_t)ch * 512 + c) * L + t] = f * __expf(-tw * rate);
            }
        }
    }
}
__device__ __forceinline__ void conv_T(const Ctx& cx, const float* W, int K, int N, bf16* dst, bool perm) {
    const int gt = cx.bid * NTHREADS + cx.tid, NGT = cx.nb * NTHREADS;
    for (int it = gt; it < N * (K / 8); it += NGT) {
        const int n = it % N, k0 = (it / N) * 8;
        const int sn = (perm && n < COL_V) ? ((n & ~63) + ((n & 63) >> 1) + 32 * (n & 1)) : n;
        const float* s = W + (size_t)k0 * N + sn;
        u32x4 w; w.x = pk2(s[0], s[N]); w.y = pk2(s[2 * (size_t)N], s[3 * (size_t)N]); w.z = pk2(s[4 * (size_t)N], s[5 * (size_t)N]); w.w = pk2(s[6 * (size_t)N], s[7 * (size_t)N]);
        *(u32x4*)(dst + (size_t)n * K + k0) = w;
    }
}
__device__ __forceinline__ void ph_convert(const Ctx& cx0) {
#define RELAUNDER() CParams& p = get_params(); Ctx cx; cx.tid = threadIdx.x; cx.bid = blockIdx.x; cx.nb = gridDim.x; asm volatile("" : "+v"(cx.tid), "+s"(cx.bid), "+s"(cx.nb));
#pragma unroll 1
    for (int layer = 0; layer < DEPTH; ++layer) {
        { RELAUNDER(); conv_T(cx, p.in[I_INW] + (size_t)layer * DM * INW, DM, INW, (bf16*)(p.ws + WT_IN) + (size_t)layer * INW * DM, true); }
        { RELAUNDER(); conv_T(cx, p.in[I_GLUW] + (size_t)layer * 512 * 512, 512, 512, (bf16*)(p.ws + WT_GLU) + (size_t)layer * 512 * 512, false); }
        { RELAUNDER(); conv_T(cx, p.in[I_BRA] + (size_t)layer * 512 * 1024, 512, 1024, (bf16*)(p.ws + WT_BR) + (size_t)(layer * 3 + 0) * 1024 * 512, false); }
        { RELAUNDER(); conv_T(cx, p.in[I_BRH] + (size_t)layer * 512 * 1024, 512, 1024, (bf16*)(p.ws + WT_BR) + (size_t)(layer * 3 + 1) * 1024 * 512, false); }
        { RELAUNDER(); conv_T(cx, p.in[I_BRS] + (size_t)layer * 512 * 1024, 512, 1024, (bf16*)(p.ws + WT_BR) + (size_t)(layer * 3 + 2) * 1024 * 512, false); }
        { RELAUNDER(); conv_T(cx, p.in[I_OUTW] + (size_t)layer * 1024 * 1024, 1024, 1024, (bf16*)(p.ws + WT_OUT) + (size_t)layer * 1024 * 1024, false); }
        { RELAUNDER(); conv_T(cx, p.in[I_WQ] + (size_t)layer * 1024 * 2048, 1024, 2048, (bf16*)(p.ws + WT_WQ) + (size_t)layer * 2048 * 1024, false); }
    }
    { RELAUNDER(); const int gt = cx.bid * NTHREADS + cx.tid, NGT = cx.nb * NTHREADS;
      for (int i = gt; i < 2 * 8 * 2 * 128 * 128 / 4; i += NGT) { const f32x4 v = ((const f32x4*)p.in[I_PKEYS])[i]; u32x2 w; w.x = pk2(v[0], v[1]); w.y = pk2(v[2], v[3]);
          const int k4 = i & 31, n = (i >> 5) & 127, lhs = i >> 12;
          ((u32x2*)(p.ws + WT_KEYS))[(((size_t)lhs * 8 + (k4 >> 2)) * 128 + n) * 4 + (k4 & 3)] = w; } }
#undef RELAUNDER
    (void)cx0;
}

__device__ __forceinline__ void ph_norm(const Ctx& cx, int layer, int which, int nrows_lat_only) {
    CParams& p = get_params();
    const int lane = cx.tid & 63, wave = cx.tid >> 6;
    const int gw = cx.bid * NWAVES + wave, NGW = cx.nb * NWAVES;
    const float* g = p.in[which ? I_N2G : I_N1G] + layer * DM;
    const float* xc = (const float*)(p.ws + WS_XCUR);
    bf16* H = (bf16*)(p.ws + WS_H);
    const int nrows = nrows_lat_only ? TL : TA;
    for (int r = gw; r < nrows; r += NGW) {
        const float* mv = (const float*)(p.ws + WS_MODV) + ((size_t)layer * 5 + row_mi(r)) * 6144 + (which ? 3072 : 0);
        f32x4 v[4]; float s = 0.f;
#pragma unroll
        for (int j = 0; j < 4; ++j) { v[j] = *(const f32x4*)(xc + (size_t)r * DM + j * 256 + lane * 4); s += v[j].x * v[j].x + v[j].y * v[j].y + v[j].z * v[j].z + v[j].w * v[j].w; }
        const float rs = rsqrtf(wave_sum(s) * (1.f / DM) + NORM_EPS);
#pragma unroll
        for (int j = 0; j < 4; ++j) { const int c = j * 256 + lane * 4;
            const f32x4 gg = *(const f32x4*)(g + c), sh = *(const f32x4*)(mv + c), sc = *(const f32x4*)(mv + 1024 + c);
            const f32x4 y = v[j] * rs * gg; const f32x4 h = y * (1.f + sc) + sh;
            u32x2 w; w.x = pk2(h.x, h.y); w.y = pk2(h.z, h.w); *(u32x2*)(H + (size_t)r * DM + c) = w; }
    }
}


namespace pg8 {
#define PG8_LAS __attribute__((address_space(3)))
typedef unsigned short bf16_t;
typedef short bf16x8 __attribute__((ext_vector_type(8)));
constexpr int BM = 256, BK = 64, HALF = 128, HTB = HALF * BK * 2, STAGE_BYTES = 8 * HTB, NXCD = 8, WGM = 8;
__host__ __device__ __forceinline__ int lds_byte(int r, int c) { const int st = (r >> 4) * 2 + (c >> 5), rr = r & 15, cc = c & 31, ob = rr * 64 + cc * 2; return st * 1024 + (ob ^ (((ob >> 9) & 1) << 5)); }
__host__ __device__ __forceinline__ void stage_rc(int b, int& R, int& C) { const int st = b / 1024, sb = b % 1024, swz = sb ^ (((sb >> 9) & 1) << 5); R = (st >> 1) * 16 + swz / 64; C = (st & 1) * 32 + (swz % 64) / 2; }
__host__ __device__ __forceinline__ int perm32(int rho) { const int n = rho >> 4, i = rho & 15; return 8 * (i >> 2) + 4 * n + (i & 3); }
struct Unit { int pm, pn, z; };
struct Gemm { const bf16_t* A; const bf16_t* Bt; size_t zsA, zsB; int K; };
__device__ __forceinline__ const bf16_t* selA(const Gemm& g, int z) { return g.A + (size_t)z * g.zsA; }
__device__ __forceinline__ const bf16_t* selB(const Gemm& g, int z) { return g.Bt + (size_t)z * g.zsB; }
struct TileOrder {
    int nM, nN, nwg, G, c, extra, exN, expn0, nz;
    __device__ __forceinline__ bool next(int i, Unit& u) const {
        const int ti = i / nz; u.z = i - ti * nz;
        const long L = (long)ti * G + c;
        if (L < nwg) {
            int wgid = (int)L; { const int q = nwg / NXCD, r = nwg % NXCD, xcd = wgid % NXCD, off = wgid / NXCD; wgid = (xcd < r ? xcd * (q + 1) : r * (q + 1) + (xcd - r) * q) + off; }
            const int nig = WGM * nN, gid = wgid / nig, fm = gid * WGM, gsz = (nM - fm) < WGM ? (nM - fm) : WGM;
            u.pm = fm + ((wgid % nig) % gsz); u.pn = (wgid % nig) / gsz; return true;
        }
        const int e = (int)(L - nwg); if (e >= extra) return false;
        u.pm = nM + e / exN; u.pn = expn0 + e % exN; return true;
    }
};
__device__ __forceinline__ unsigned cvt_pk_bf16(float lo, float hi) { unsigned r; asm volatile("v_cvt_pk_bf16_f32 %0, %1, %2" : "=v"(r) : "v"(lo), "v"(hi)); return r; }
template <class Epi, class Sched, bool ALIGN_EPI = true, bool SP2 = true>
__device__ __forceinline__ void gemm_phase(PG8_LAS unsigned char* lds, const Gemm g, const Sched& S, const Epi& E, const int tid_) {
    const int tid = tid_, wid = __builtin_amdgcn_readfirstlane(tid >> 6), lane = tid & 63, wr = wid >> 2, wc = wid & 3, fr = lane & 15, fq = lane >> 4;
    const int K = g.K, nt = K / BK;
    unsigned voffA[2], voffB[2];
#pragma unroll
    for (int i = 0; i < 2; ++i) { int R, C; stage_rc(tid * 16 + i * 8192, R, C); const int Rb = Epi::PERM ? ((R & ~31) + perm32(R & 31)) : R;
        voffA[i] = (unsigned)(R * K + C) * 2u; voffB[i] = (unsigned)(Rb * K + C) * 2u; }
    const size_t kstep = (size_t)(BK * 2);
    const size_t hstep = (size_t)HALF * K * 2;
    const size_t tstep = 2 * hstep;
    const unsigned ldsw = (unsigned)wid * 1024u;
    const int aoff = lds_byte(wr * 64 + fr, fq * 8), boff = lds_byte(wc * 32 + fr, fq * 8);
#define PG8_SA(b, h) (((b) * 2 + (h)) * HTB)
#define PG8_SB(b, h) ((4 + (b) * 2 + (h)) * HTB)
#define PG8_STAGE(bufoff, gbase, voff) do { _Pragma("unroll") for (int _i = 0; _i < 2; ++_i) \
        __builtin_amdgcn_global_load_lds((const unsigned*)((const char*)(gbase) + (voff)[_i]), (PG8_LAS unsigned*)(lds + (bufoff) + ldsw + _i * 8192), 16, 0, 0); } while (0)
#define PG8_LDA(dst, b, h) do { _Pragma("unroll") for (int m = 0; m < 4; ++m) _Pragma("unroll") for (int k = 0; k < 2; ++k) dst[m][k] = *(const PG8_LAS bf16x8*)(lds + PG8_SA(b, h) + aoff + m * 2048 + k * 1024); } while (0)
#define PG8_LDB(dst, b, h) do { _Pragma("unroll") for (int n = 0; n < 2; ++n) _Pragma("unroll") for (int k = 0; k < 2; ++k) dst[n][k] = *(const PG8_LAS bf16x8*)(lds + PG8_SB(b, h) + boff + n * 2048 + k * 1024); } while (0)
#define PG8_MMA(ai, bj, At, Bt) do { __builtin_amdgcn_s_setprio(1); _Pragma("unroll") for (int m = 0; m < 4; ++m) _Pragma("unroll") for (int n = 0; n < 2; ++n) _Pragma("unroll") for (int k = 0; k < 2; ++k) \
        acc[ai][bj][m][n] = __builtin_amdgcn_mfma_f32_16x16x32_bf16(Bt[n][k], At[m][k], acc[ai][bj][m][n], 0, 0, 0); __builtin_amdgcn_s_setprio(0); } while (0)
#define PG8_WAIT_V(n) asm volatile("s_waitcnt vmcnt(" #n ")" ::: "memory")
#define PG8_WAIT_L(n) asm volatile("s_waitcnt lgkmcnt(" #n ")" ::: "memory")
#define PG8_BAR __builtin_amdgcn_s_barrier()
#define PG8_SCHED __builtin_amdgcn_sched_barrier(0)
    Unit cur, nxt; int ui = 0;
    if (!S.next(0, cur)) return;
    f32x4 acc[2][2][4][2];
#pragma unroll
    for (int a = 0; a < 2; ++a)
#pragma unroll
        for (int b = 0; b < 2; ++b)
#pragma unroll
            for (int m = 0; m < 4; ++m)
#pragma unroll
                for (int n = 0; n < 2; ++n) acc[a][b][m][n] = (f32x4){0.f, 0.f, 0.f, 0.f};
    bf16x8 At[4][2], B0[2][2], B1[2][2];
    const char* cA = (const char*)selA(g, cur.z) + (size_t)cur.pm * tstep; const char* cB = (const char*)selB(g, cur.z) + (size_t)cur.pn * tstep;
    if constexpr (SP2) {
        PG8_STAGE(PG8_SB(0, 0), cB, voffB); PG8_STAGE(PG8_SB(0, 1), cB + hstep, voffB); PG8_STAGE(PG8_SA(0, 0), cA, voffA); PG8_STAGE(PG8_SA(0, 1), cA + hstep, voffA);
        if (wr == 1) PG8_BAR;
        PG8_WAIT_V(2); PG8_BAR;
        PG8_STAGE(PG8_SB(1, 0), cB + kstep, voffB); PG8_STAGE(PG8_SA(1, 0), cA + kstep, voffA); PG8_STAGE(PG8_SB(1, 1), cB + hstep + kstep, voffB);
        PG8_WAIT_V(6); PG8_BAR;
    } else {
        PG8_STAGE(PG8_SB(0, 0), cB, voffB); PG8_STAGE(PG8_SA(0, 0), cA, voffA); PG8_STAGE(PG8_SB(0, 1), cB + hstep, voffB); PG8_STAGE(PG8_SA(0, 1), cA + hstep, voffA);
        if (wr == 1) PG8_BAR;
        PG8_WAIT_V(4); PG8_BAR;
        PG8_STAGE(PG8_SB(1, 0), cB + kstep, voffB); PG8_STAGE(PG8_SA(1, 0), cA + kstep, voffA); PG8_STAGE(PG8_SB(1, 1), cB + hstep + kstep, voffB);
        PG8_WAIT_V(6); PG8_BAR;
    }
    for (;;) {
        const bool has_next = S.next(ui + 1, nxt);
        const char* nA = has_next ? (const char*)selA(g, nxt.z) + (size_t)nxt.pm * tstep : cA; const char* nB = has_next ? (const char*)selB(g, nxt.z) + (size_t)nxt.pn * tstep : cB;
        for (int t = 0; t < nt; t += 2) {
            const bool last = (t == nt - 2);
            const char* a1 = cA + (size_t)(t + 1) * kstep;
            const char* a2 = last ? nA : cA + (size_t)(t + 2) * kstep; const char* b2 = last ? nB : cB + (size_t)(t + 2) * kstep;
            const char* a3 = a2 + kstep; const char* b3 = b2 + kstep;
            if constexpr (SP2) {
            PG8_LDB(B0, 0, 0); PG8_LDB(B1, 0, 1); PG8_SCHED; PG8_LDA(At, 0, 0); PG8_STAGE(PG8_SA(1, 1), a1 + hstep, voffA);
            PG8_WAIT_V(8); PG8_WAIT_L(0); PG8_BAR; PG8_MMA(0, 0, At, B0); PG8_MMA(0, 1, At, B1); PG8_BAR; PG8_SCHED;
            PG8_LDA(At, 0, 1); PG8_STAGE(PG8_SB(0, 0), b2, voffB); PG8_STAGE(PG8_SB(0, 1), b2 + hstep, voffB); PG8_STAGE(PG8_SA(0, 0), a2, voffA);
            PG8_WAIT_V(8); PG8_WAIT_L(0); PG8_BAR; PG8_MMA(1, 0, At, B0); PG8_MMA(1, 1, At, B1); PG8_BAR; PG8_SCHED;
            PG8_LDB(B0, 1, 0); PG8_LDB(B1, 1, 1); PG8_SCHED; PG8_LDA(At, 1, 0); PG8_STAGE(PG8_SA(0, 1), a2 + hstep, voffA);
            PG8_WAIT_V(8); PG8_WAIT_L(0); PG8_BAR; PG8_MMA(0, 0, At, B0); PG8_MMA(0, 1, At, B1); PG8_BAR; PG8_SCHED;
            PG8_LDA(At, 1, 1); PG8_STAGE(PG8_SB(1, 0), b3, voffB); PG8_STAGE(PG8_SB(1, 1), b3 + hstep, voffB); PG8_STAGE(PG8_SA(1, 0), a3, voffA);
            PG8_WAIT_V(8); PG8_WAIT_L(0); PG8_BAR; PG8_MMA(1, 0, At, B0); PG8_MMA(1, 1, At, B1); PG8_BAR; PG8_SCHED;
            } else {
            PG8_LDB(B0, 0, 0); PG8_SCHED; PG8_LDA(At, 0, 0); PG8_STAGE(PG8_SA(1, 1), a1 + hstep, voffA);
            PG8_WAIT_L(8); PG8_BAR; PG8_WAIT_L(0); PG8_MMA(0, 0, At, B0); PG8_BAR; PG8_SCHED;
            PG8_LDB(B1, 0, 1); PG8_STAGE(PG8_SB(0, 0), b2, voffB);
            PG8_BAR; PG8_WAIT_L(0); PG8_MMA(0, 1, At, B1); PG8_BAR;
            PG8_LDA(At, 0, 1); PG8_STAGE(PG8_SA(0, 0), a2, voffA);
            PG8_BAR; PG8_WAIT_L(0); PG8_MMA(1, 0, At, B0); PG8_BAR; PG8_SCHED;
            PG8_STAGE(PG8_SB(0, 1), b2 + hstep, voffB);
            PG8_WAIT_V(6); PG8_BAR; PG8_MMA(1, 1, At, B1); PG8_BAR;
            PG8_LDB(B0, 1, 0); PG8_SCHED; PG8_LDA(At, 1, 0); PG8_STAGE(PG8_SA(0, 1), a2 + hstep, voffA);
            PG8_WAIT_L(8); PG8_BAR; PG8_WAIT_L(0); PG8_MMA(0, 0, At, B0); PG8_BAR; PG8_SCHED;
            PG8_LDB(B1, 1, 1); PG8_STAGE(PG8_SB(1, 0), b3, voffB);
            PG8_BAR; PG8_WAIT_L(0); PG8_MMA(0, 1, At, B1); PG8_BAR;
            PG8_LDA(At, 1, 1); PG8_STAGE(PG8_SA(1, 0), a3, voffA);
            PG8_BAR; PG8_WAIT_L(0); PG8_MMA(1, 0, At, B0); PG8_BAR; PG8_SCHED;
            PG8_STAGE(PG8_SB(1, 1), b3 + hstep, voffB);
            PG8_WAIT_V(6); PG8_BAR; PG8_MMA(1, 1, At, B1); PG8_BAR;
            }
        }
        if constexpr (ALIGN_EPI) { if (wr == 0) PG8_BAR; }
        const bool keep = E(acc, cur, wr, wc, fr, fq);
        if (!has_next) break;
        if (!keep) {
#pragma unroll
        for (int a = 0; a < 2; ++a)
#pragma unroll
            for (int b = 0; b < 2; ++b)
#pragma unroll
                for (int m = 0; m < 4; ++m)
#pragma unroll
                    for (int n = 0; n < 2; ++n) acc[a][b][m][n] = (f32x4){0.f, 0.f, 0.f, 0.f};
        }
        cur = nxt; cA = nA; cB = nB; ++ui;
        if constexpr (ALIGN_EPI) { if (wr == 1) PG8_BAR; }
    }
    PG8_WAIT_V(0);
    if constexpr (!ALIGN_EPI) { if (wr == 0) PG8_BAR; }
    PG8_BAR;
#undef PG8_SA
#undef PG8_SB
#undef PG8_STAGE
#undef PG8_LDA
#undef PG8_LDB
#undef PG8_MMA
#undef PG8_WAIT_V
#undef PG8_WAIT_L
#undef PG8_BAR
#undef PG8_SCHED
}
}

__device__ __forceinline__ f32x4 bf4lo(u32x4 w) { return (f32x4){__uint_as_float(w.x << 16), __uint_as_float(w.x & 0xffff0000u), __uint_as_float(w.y << 16), __uint_as_float(w.y & 0xffff0000u)}; }
__device__ __forceinline__ f32x4 bf4hi(u32x4 w) { return (f32x4){__uint_as_float(w.z << 16), __uint_as_float(w.z & 0xffff0000u), __uint_as_float(w.w << 16), __uint_as_float(w.w & 0xffff0000u)}; }
__device__ __forceinline__ u32x4 pack8(f32x4 a, f32x4 b) { u32x4 w; w.x = pg8::cvt_pk_bf16(a[0], a[1]); w.y = pg8::cvt_pk_bf16(a[2], a[3]); w.z = pg8::cvt_pk_bf16(b[0], b[1]); w.w = pg8::cvt_pk_bf16(b[2], b[3]); return w; }
__device__ __forceinline__ f32x4 sig4(f32x4 v) { return (f32x4){sigmoidf_(v[0]), sigmoidf_(v[1]), sigmoidf_(v[2]), sigmoidf_(v[3])}; }

__device__ __forceinline__ size_t s5_uidx(int g, int b, int n, int s) { return ((((size_t)(g * 4 + b) * 64 + s) * 68 + n) * 16); }
template <class T> __device__ __forceinline__ T* uni_ptr(T* q) { unsigned long long a = (unsigned long long)q; unsigned lo = __builtin_amdgcn_readfirstlane((unsigned)a), hi = __builtin_amdgcn_readfirstlane((unsigned)(a >> 32));
    asm volatile("" : "+s"(lo), "+s"(hi)); return (T*)(((unsigned long long)hi << 32) | lo); }
struct EpiInproj {
    static constexpr bool PERM = true;
    unsigned char* ws; const float* gate_b;
    __device__ __forceinline__ bool operator()(f32x4 (&acc)[2][2][4][2], const pg8::Unit& u, int wr, int wc, int fr_, int fq_) const {
        int fr = fr_, fq = fq_; asm volatile("" : "+v"(fr), "+v"(fq)); unsigned char* const ws = uni_ptr(this->ws);
        const int cl = wc * 32 + 8 * fq, rbase = u.pm * 256 + wr * 64 + fr;
#pragma unroll
        for (int bj = 0; bj < 2; ++bj) {
            const int c128 = u.pn * 256 + bj * 128;
            unsigned char* base; unsigned rstride, coff; int kind = 0;
            if (c128 < COL_K)         { base = ws + WS_Q; rstride = 1024; coff = (unsigned)(c128 + cl) * 2u; kind = 1; }
            else if (c128 < COL_V)    { base = ws + WS_K + (size_t)(cl >> 5) * TA * 64; rstride = 64; coff = (unsigned)(cl & 31) * 2u; kind = 1; }
            else if (c128 < COL_S5)   { base = ws + WS_V; rstride = 256;  coff = (unsigned)cl * 2u; }
            else if (c128 < COL_HY)   { base = ws + WS_U; rstride = 0; coff = 0; kind = 3; }
            else if (c128 < COL_GATE) { base = ws + WS_Z; rstride = 3072; coff = (unsigned)(c128 - COL_HY + cl) * 2u; }
            else                      { base = ws + WS_G; rstride = 6144; coff = (unsigned)(c128 - COL_GATE + cl) * 2u; kind = 2; }
            if (kind == 1) {
                const float* rope = (const float*)(ws + WS_ROPE) + 8 * fq;
#pragma unroll
                for (int ai = 0; ai < 2; ++ai)
#pragma unroll
                    for (int m = 0; m < 4; ++m) {
                        const int r = rbase + ai * 128 + m * 16;
                        f32x4 v0 = acc[ai][bj][m][0], v1 = acc[ai][bj][m][1];
                        if (r < TL) { const int l = r & 4095, pos = (wc & 1) ? (l & 63) : (l >> 6);
                            const f32x4 t0 = *(const f32x4*)(rope + pos * 32), t1 = *(const f32x4*)(rope + pos * 32 + 4);
                            v0 = (f32x4){v0[0] * t0[0] - v0[1] * t0[1], v0[0] * t0[1] + v0[1] * t0[0], v0[2] * t0[2] - v0[3] * t0[3], v0[2] * t0[3] + v0[3] * t0[2]};
                            v1 = (f32x4){v1[0] * t1[0] - v1[1] * t1[1], v1[0] * t1[1] + v1[1] * t1[0], v1[2] * t1[2] - v1[3] * t1[3], v1[2] * t1[3] + v1[3] * t1[2]}; }
                        *(u32x4*)(base + ((unsigned)r * rstride + coff)) = pack8(v0, v1);
                        asm volatile("" ::: "memory");
                    }
            } else if (kind == 2) {
                const float* gb = uni_ptr(gate_b) + (c128 - COL_GATE) + cl; const f32x4 b0 = *(const f32x4*)gb, b1 = *(const f32x4*)(gb + 4);
#pragma unroll
                for (int ai = 0; ai < 2; ++ai)
#pragma unroll
                    for (int m = 0; m < 4; ++m) {
                        const int r = rbase + ai * 128 + m * 16;
                        *(u32x4*)(base + ((unsigned)r * rstride + coff)) = pack8(sig4(acc[ai][bj][m][0] + b0), sig4(acc[ai][bj][m][1] + b1));
                        asm volatile("" ::: "memory");
                    }
            } else if (kind == 3) {
                const int ch = c128 - COL_S5 + cl, g = ch >> 4, i0 = ch & 15;
#pragma unroll
                for (int ai = 0; ai < 2; ++ai)
#pragma unroll
                    for (int m = 0; m < 4; ++m) {
                        const int r = rbase + ai * 128 + m * 16; int b, n, s;
                        if (r < TL) { b = r >> 12; n = 4 + ((r & 4095) >> 6); s = r & 63; } else { const int j = r - TL; b = j >> 8; n = (j & 255) >> 6; s = j & 63; }
                        *(u32x4*)((bf16*)base + s5_uidx(g, b, n, s) + i0) = pack8(acc[ai][bj][m][0], acc[ai][bj][m][1]);
                    }
            } else {
#pragma unroll
                for (int ai = 0; ai < 2; ++ai)
#pragma unroll
                    for (int m = 0; m < 4; ++m) {
                        const int r = rbase + ai * 128 + m * 16;
                        *(u32x4*)(base + ((unsigned)r * rstride + coff)) = pack8(acc[ai][bj][m][0], acc[ai][bj][m][1]);
                    }
            }
        }
        return false;
    }
};
struct EpiGlu {
    static constexpr bool PERM = true;
    unsigned char* ws; const float* bias;
    __device__ __forceinline__ bool operator()(f32x4 (&acc)[2][2][4][2], const pg8::Unit& u, int wr, int wc, int fr_, int fq_) const {
        int fr = fr_, fq = fq_; asm volatile("" : "+v"(fr), "+v"(fq)); unsigned char* const ws = uni_ptr(this->ws);
#pragma unroll
        for (int bj = 0; bj < 2; ++bj) { const int c = u.pn * 256 + bj * 128 + wc * 32 + 8 * fq; const f32x4 b0 = *(const f32x4*)(bias + c), b1 = *(const f32x4*)(bias + c + 4);
#pragma unroll
            for (int ai = 0; ai < 2; ++ai)
#pragma unroll
                for (int m = 0; m < 4; ++m) { const size_t o = (size_t)(u.pm * 256 + ai * 128 + wr * 64 + m * 16 + fr) * 512 + c;
                    const u32x4 yw = *(const u32x4*)((const bf16*)(ws + WS_S5Y) + o);
                    *(u32x4*)((bf16*)(ws + WS_S5O) + o) = pack8(bf4lo(yw) * sig4(acc[ai][bj][m][0] + b0), bf4hi(yw) * sig4(acc[ai][bj][m][1] + b1)); asm volatile("" ::: "memory"); } }
        return false;
    }
};
struct EpiMerge {
    static constexpr bool PERM = true;
    unsigned char* ws;
    __device__ __forceinline__ bool operator()(f32x4 (&acc)[2][2][4][2], const pg8::Unit& u, int wr, int wc, int fr_, int fq_) const {
        int fr = fr_, fq = fq_; asm volatile("" : "+v"(fr), "+v"(fq)); unsigned char* const ws = uni_ptr(this->ws);
#pragma unroll
        for (int bj = 0; bj < 2; ++bj) { const int c = u.pn * 256 + bj * 128 + wc * 32 + 8 * fq;
#pragma unroll
            for (int ai = 0; ai < 2; ++ai)
#pragma unroll
                for (int m = 0; m < 4; ++m) { const int r = u.pm * 256 + ai * 128 + wr * 64 + m * 16 + fr;
                    const bf16* gp = (const bf16*)(ws + WS_G) + (size_t)r * 3072 + u.z * 1024 + c;
                    const u32x4 g0 = *(const u32x4*)gp;
                    if (u.z < 2) { const u32x4 g1 = *(const u32x4*)(gp + 1024);
                        const f32x4 d0 = bf4lo(g1), d1 = bf4hi(g1), n0 = bf4lo(g0), n1 = bf4hi(g0);
                        acc[ai][bj][m][0] *= (f32x4){n0[0] / fmaxf(d0[0], 1e-30f), n0[1] / fmaxf(d0[1], 1e-30f), n0[2] / fmaxf(d0[2], 1e-30f), n0[3] / fmaxf(d0[3], 1e-30f)};
                        acc[ai][bj][m][1] *= (f32x4){n1[0] / fmaxf(d1[0], 1e-30f), n1[1] / fmaxf(d1[1], 1e-30f), n1[2] / fmaxf(d1[2], 1e-30f), n1[3] / fmaxf(d1[3], 1e-30f)};
                    } else *(u32x4*)((bf16*)(ws + WS_M) + (size_t)r * 1024 + c) = pack8(acc[ai][bj][m][0] * bf4lo(g0), acc[ai][bj][m][1] * bf4hi(g0));
                    asm volatile("" ::: "memory");
                } }
        return u.z < 2;
    }
};
struct EpiOut {
    static constexpr bool PERM = false;
    unsigned char* ws; int layer; float scale;
    __device__ __forceinline__ bool operator()(f32x4 (&acc)[2][2][4][2], const pg8::Unit& u, int wr, int wc, int fr_, int fq_) const {
        int fr = fr_, fq = fq_; asm volatile("" : "+v"(fr), "+v"(fq)); unsigned char* const ws = uni_ptr(this->ws);
        float* X = (float*)(ws + WS_XCUR);
#pragma unroll
        for (int ai = 0; ai < 2; ++ai)
#pragma unroll
            for (int m = 0; m < 4; ++m) { const int r = u.pm * 256 + ai * 128 + wr * 64 + m * 16 + fr;
                const float* g1 = (const float*)(ws + WS_MODV) + ((size_t)layer * 5 + row_mi(r)) * 6144 + 2048;
#pragma unroll
                for (int bj = 0; bj < 2; ++bj)
#pragma unroll
                    for (int n = 0; n < 2; ++n) { const int c = u.pn * 256 + bj * 128 + wc * 32 + n * 16 + 4 * fq; f32x4* xp = (f32x4*)(X + (size_t)r * 1024 + c);
                        *xp = *xp + *(const f32x4*)(g1 + c) * acc[ai][bj][m][n] * scale; } asm volatile("" ::: "memory"); }
        return false;
    }
};
struct EpiQp {
    static constexpr bool PERM = true;
    unsigned char* ws;
    __device__ __forceinline__ bool operator()(f32x4 (&acc)[2][2][4][2], const pg8::Unit& u, int wr, int wc, int fr_, int fq_) const {
        int fr = fr_, fq = fq_; asm volatile("" : "+v"(fr), "+v"(fq)); unsigned char* const ws = uni_ptr(this->ws);
#pragma unroll
        for (int bj = 0; bj < 2; ++bj) { const int c = u.pn * 256 + bj * 128 + wc * 32 + 8 * fq;
#pragma unroll
            for (int ai = 0; ai < 2; ++ai)
#pragma unroll
                for (int m = 0; m < 4; ++m) *(u32x4*)((bf16*)(ws + WS_QP) + ((size_t)(c >> 4) * TA + (u.pm * 256 + ai * 128 + wr * 64 + m * 16 + fr)) * 16 + (c & 15)) = pack8(acc[ai][bj][m][0], acc[ai][bj][m][1]); }
        return false;
    }
};

__device__ __forceinline__ void ph_inproj(const Ctx& cx, int layer, PG8_LAS unsigned char* lds) {
    CParams& p = get_params();
    pg8::Gemm g; g.A = (const bf16*)(p.ws + WS_H); g.Bt = (const bf16*)(p.ws + WT_IN) + (size_t)layer * INW * DM; g.zsA = 0; g.zsB = 0; g.K = DM;
    pg8::TileOrder S; S.nM = TL / 256; S.nN = INW / 256; S.nwg = S.nM * S.nN; S.G = cx.nb; S.c = cx.bid; S.nz = 1;
    if (layer == DEPTH - 1) { S.exN = 3; S.expn0 = 2; S.extra = 4 * 3; } else { S.exN = INW / 256; S.expn0 = 0; S.extra = 4 * (INW / 256); }
    EpiInproj E; E.ws = p.ws; E.gate_b = p.in[I_GATEB] + layer * 3072;
    pg8::gemm_phase<EpiInproj, pg8::TileOrder>(lds, g, S, E, cx.tid);
}

__device__ __forceinline__ void ph_attn(const Ctx& cx, int layer, float* sm) {
    CParams& p = get_params();
    const int tid = cx.tid, lane = tid & 63, w = tid >> 6, l15 = lane & 15, kg = lane >> 4;
    const bf16* Q = (const bf16*)(p.ws + WS_Q); const bf16* Kb = (const bf16*)(p.ws + WS_K); const bf16* Vb = (const bf16*)(p.ws + WS_V);
    bf16* VT = (bf16*)sm;
    constexpr int VS = 648;
    const int nitems = 256 + (layer == 0 ? 16 : 0);
    for (int it = cx.bid; it < nitems; it += cx.nb) {
        int b, kvh, qbase, wbase; bool win;
        if (it < 256) { b = it >> 6; kvh = (it >> 5) & 1; const int blk = it & 31; qbase = b * SEQ + blk * 128; wbase = blk * 128 - 128; win = true; }
        else { const int j = it - 256; b = j >> 2; kvh = (j >> 1) & 1; qbase = TL + b * CTXL + (j & 1) * 128; wbase = 0; win = false; }
        __syncthreads();
        for (int i = tid; i < 640 * 8; i += NTHREADS) { const int kk = i >> 3, c8 = i & 7; int row = -1;
            if (kk < 256) row = TL + b * CTXL + kk; else if (win) { const int pos = wbase + kk - 256; if (pos >= 0 && pos < SEQ) row = b * SEQ + pos; }
            const u32x4 ld_ = *(const u32x4*)(Vb + (size_t)(row >= 0 ? row : 0) * 128 + kvh * 64 + c8 * 8); const u32x4 v = row >= 0 ? ld_ : (u32x4){0u, 0u, 0u, 0u};
            bf16* d = VT + (c8 * 8) * VS + kk;
            d[0] = (bf16)(v.x & 0xffffu); d[VS] = (bf16)(v.x >> 16); d[2 * VS] = (bf16)(v.y & 0xffffu); d[3 * VS] = (bf16)(v.y >> 16);
            d[4 * VS] = (bf16)(v.z & 0xffffu); d[5 * VS] = (bf16)(v.z >> 16); d[6 * VS] = (bf16)(v.w & 0xffffu); d[7 * VS] = (bf16)(v.w >> 16); }
        __syncthreads();
        const int h = kvh * 4 + (w >> 1), tok0 = (w & 1) * 64;
        bf16x8 qf[4][2];
#pragma unroll
        for (int qt = 0; qt < 4; ++qt)
#pragma unroll
            for (int ks = 0; ks < 2; ++ks) qf[qt][ks] = *(const bf16x8*)(Q + (size_t)(qbase + tok0 + 16 * qt + l15) * 512 + h * 64 + 32 * ks + 8 * kg);
        float m[4], l[4]; f32x4 O[4][4];
        const float sink = p.in[I_SINK][layer * 8 + h];
#pragma unroll
        for (int qt = 0; qt < 4; ++qt) { m[qt] = sink; l[qt] = 1.f;
#pragma unroll
            for (int dt = 0; dt < 4; ++dt) O[qt][dt] = (f32x4){0.f, 0.f, 0.f, 0.f}; }
        const int nsteps = win ? 18 : 8;
        bf16x8 kf[2][2];
#define ATT_LOADK(KF, st_) do { const int kk0_ = (st_) < 8 ? (st_) * 32 : 256 + tok0 + ((st_) - 8) * 32; \
            _Pragma("unroll") for (int kt = 0; kt < 2; ++kt) { const int kk = kk0_ + 16 * kt + l15; int row; \
                if (kk < 256) row = TL + b * CTXL + kk; else { int pos = wbase + kk - 256; pos = pos < 0 ? 0 : (pos > SEQ - 1 ? SEQ - 1 : pos); row = b * SEQ + pos; } \
                _Pragma("unroll") for (int ks = 0; ks < 2; ++ks) KF[kt][ks] = *(const bf16x8*)(Kb + ((size_t)(kvh * 2 + ks) * TA + row) * 32 + 8 * kg); } } while (0)
        ATT_LOADK(kf, 0);
        for (int st = 0; st < nsteps; ++st) {
            const int kk0 = st < 8 ? st * 32 : 256 + tok0 + (st - 8) * 32;
            bf16x8 kfn[2][2];
            const int stn = st + 1 < nsteps ? st + 1 : st;
            ATT_LOADK(kfn, stn);
#pragma unroll
            for (int qt = 0; qt < 4; ++qt) {
                f32x4 s0 = (f32x4){0.f, 0.f, 0.f, 0.f}, s1 = s0;
                s0 = __builtin_amdgcn_mfma_f32_16x16x32_bf16(kf[0][0], qf[qt][0], s0, 0, 0, 0); s0 = __builtin_amdgcn_mfma_f32_16x16x32_bf16(kf[0][1], qf[qt][1], s0, 0, 0, 0);
                s1 = __builtin_amdgcn_mfma_f32_16x16x32_bf16(kf[1][0], qf[qt][0], s1, 0, 0, 0); s1 = __builtin_amdgcn_mfma_f32_16x16x32_bf16(kf[1][1], qf[qt][1], s1, 0, 0, 0);
                s0 *= 0.125f; s1 *= 0.125f;
                if (st >= 8) {
                    const int qpos = wbase + 128 + tok0 + 16 * qt + l15, kp0 = wbase + kk0 - 256 + 4 * kg;
#pragma unroll
                    for (int r = 0; r < 4; ++r) { const int k0 = kp0 + r, k1 = kp0 + 16 + r;
                        if (k0 < 0 || k0 >= SEQ || k0 - qpos > 128 || qpos - k0 > 128) s0[r] = -1e30f;
                        if (k1 < 0 || k1 >= SEQ || k1 - qpos > 128 || qpos - k1 > 128) s1[r] = -1e30f; }
                }
                float mx = fmaxf(fmaxf(fmaxf(s0[0], s0[1]), fmaxf(s0[2], s0[3])), fmaxf(fmaxf(s1[0], s1[1]), fmaxf(s1[2], s1[3])));
                mx = fmaxf(mx, __shfl_xor(mx, 16)); mx = fmaxf(mx, __shfl_xor(mx, 32));
                const float mn = fmaxf(m[qt], mx), f = __expf(m[qt] - mn);
                f32x4 p0, p1;
#pragma unroll
                for (int r = 0; r < 4; ++r) { p0[r] = __expf(s0[r] - mn); p1[r] = __expf(s1[r] - mn); }
                float ps = (p0[0] + p0[1]) + (p0[2] + p0[3]) + (p1[0] + p1[1]) + (p1[2] + p1[3]);
                ps += __shfl_xor(ps, 16); ps += __shfl_xor(ps, 32);
                l[qt] = l[qt] * f + ps; m[qt] = mn;
                u32x4 pw; pw.x = pk2(p0[0], p0[1]); pw.y = pk2(p0[2], p0[3]); pw.z = pk2(p1[0], p1[1]); pw.w = pk2(p1[2], p1[3]);
                const bf16x8 pf = __builtin_bit_cast(bf16x8, pw);
#pragma unroll
                for (int dt = 0; dt < 4; ++dt) {
                    const bf16* vp = VT + (16 * dt + l15) * VS + kk0 + 4 * kg;
                    u32x4 vw; const u32x2 va = *(const u32x2*)vp, vb = *(const u32x2*)(vp + 16); vw.x = va.x; vw.y = va.y; vw.z = vb.x; vw.w = vb.y;
                    O[qt][dt] = __builtin_amdgcn_mfma_f32_16x16x32_bf16(__builtin_bit_cast(bf16x8, vw), pf, O[qt][dt] * f, 0, 0, 0);
                }
                __builtin_amdgcn_sched_barrier(0);
            }
#pragma unroll
            for (int kt = 0; kt < 2; ++kt)
#pragma unroll
                for (int ks = 0; ks < 2; ++ks) kf[kt][ks] = kfn[kt][ks];
        }
#undef ATT_LOADK
#pragma unroll
        for (int qt = 0; qt < 4; ++qt) { const float il = 1.f / l[qt]; bf16* op = (bf16*)(p.ws + WS_ATT) + (size_t)(qbase + tok0 + 16 * qt + l15) * 512 + h * 64 + 4 * kg;
#pragma unroll
            for (int dt = 0; dt < 4; ++dt) { const f32x4 o = O[qt][dt] * il; u32x2 ww; ww.x = pk2(o[0], o[1]); ww.y = pk2(o[2], o[3]); *(u32x2*)(op + 16 * dt) = ww; } }
    }
}

__device__ __forceinline__ void ph_hypre(const Ctx& cx, int layer, float* sm) {
    CParams& p = get_params();
    const int lane = cx.tid & 63, wave = cx.tid >> 6, gw = cx.bid * NWAVES + wave, NGW = cx.nb * NWAVES;
    const bf16* Z = (const bf16*)(p.ws + WS_Z); const float* sw = p.in[I_HSW] + layer * 3 * 1536; const float* sb = p.in[I_HSB] + layer * 1536;
    float* tile = sm + wave * 4096;
    const int nlat = 4 * 64 * 8, nctx = layer == 0 ? 4 * 4 * 8 : 0;
    for (int it = gw; it < nlat + nctx; it += NGW) {
        int b, t0, L, c0, rbase; float* vvb;
        if (it < nlat) { b = it >> 9; t0 = ((it >> 3) & 63) * 64; c0 = (it & 7) * 64; L = SEQ; rbase = b * SEQ; vvb = (float*)(p.ws + WS_VV) + ((size_t)b * 512 + c0) * SEQ; }
        else { const int j = it - nlat; b = j >> 5; t0 = ((j >> 3) & 3) * 64; c0 = (j & 7) * 64; L = CTXL; rbase = TL + b * CTXL; vvb = (float*)(p.ws + WS_VVC) + ((size_t)b * 512 + c0) * CTXL; }
        const int c = c0 + lane;
        float w0[3], w1[3], w2[3], bb[3];
#pragma unroll
        for (int q = 0; q < 3; ++q) { const int col = q * 512 + c; w0[q] = sw[col]; w1[q] = sw[1536 + col]; w2[q] = sw[2 * 1536 + col]; bb[q] = sb[col]; }
        const bf16* zb = Z + (size_t)rbase * 1536 + c;
#pragma unroll 1
        for (int tb = 0; tb < 64; tb += 16) {
            bf16 zv[3][18];
#pragma unroll
            for (int k = 0; k < 18; ++k) { const int t = t0 + tb + k - 1; const bool ok = t >= 0 && t < L; const int tc = t < 0 ? 0 : (t >= L ? L - 1 : t);
#pragma unroll
                for (int q = 0; q < 3; ++q) { const bf16 ld_ = zb[(size_t)tc * 1536 + q * 512]; zv[q][k] = ok ? ld_ : (bf16)0; } }
#pragma unroll
            for (int k = 0; k < 16; ++k) { const int tt = tb + k, t = t0 + tt; float o[3];
#pragma unroll
                for (int q = 0; q < 3; ++q) o[q] = bb[q] + w0[q] * bf2f(zv[q][k]) + w1[q] * bf2f(zv[q][k + 1]) + w2[q] * bf2f(zv[q][k + 2]);
                ((bf16*)(p.ws + WS_X0C))[(size_t)(rbase + t) * 512 + c] = f2bf(o[0]);
                tile[lane * 64 + (tt ^ lane)] = o[2] * o[1]; }
        }
        __builtin_amdgcn_s_waitcnt(0xc07f);
        for (int cc = 0; cc < 64; ++cc) vvb[(size_t)cc * L + t0 + lane] = tile[cc * 64 + (lane ^ cc)];
        __builtin_amdgcn_s_waitcnt(0xc07f);
    }
}

__device__ __forceinline__ void ph_hyconv_ctx(const Ctx& cx, int layer, float* sm) {
    CParams& p = get_params();
    const int tid = cx.tid;
    if (layer != 0) return;
    constexpr int L = CTXL;
    float* Tl = sm; float* Vl = sm + 2 * L;
    for (int it = cx.bid; it < 2048; it += cx.nb) {
        const int bc = it, b = bc >> 9, c = bc & 511;
        const float* fb = (const float*)(p.ws + WS_FILT + FILT_CTX_OFF);
        const float* hf = fb + (size_t)c * L; const float* hb = fb + ((size_t)512 + c) * L;
        const float* vv = (const float*)(p.ws + WS_VVC) + (size_t)bc * CTXL;
        __syncthreads();
        if (tid < L) { Tl[L - 1 + tid] = hf[tid]; if (tid > 0) Tl[L - 1 - tid] = hb[tid]; Vl[tid] = vv[tid]; }
        __syncthreads();
        if (tid < L) { float a = 0.f; const float* tp = Tl + (tid + L - 1);
            for (int s = 0; s < L; ++s) a += Vl[s] * tp[-s];
            const size_t o = (size_t)(TL + b * CTXL + tid) * 512 + c;
            ((bf16*)(p.ws + WS_HY))[o] = f2bf((a + Vl[tid] * p.in[I_HBIAS][layer * 512 + c]) * bf2f(((const bf16*)(p.ws + WS_X0C))[o])); }
    }
}
typedef float f32x2 __attribute__((ext_vector_type(2)));
__device__ __forceinline__ f32x2 cmul(f32x2 a, f32x2 w) { return (f32x2){a.x * w.x - a.y * w.y, a.x * w.y + a.y * w.x}; }
__device__ __forceinline__ void fft_fwd_r4(f32x2* X, int tid) {
#pragma unroll 1
    for (int s = 0; s < 12; s += 2) {
        const int lq = 11 - s, Q = 1 << lq;
        __syncthreads();
#pragma unroll
        for (int q = 0; q < 4; ++q) { const int j = tid + 512 * q, pos = j & (Q - 1), i = ((j >> lq) << (lq + 2)) + pos;
            const float rev = (float)(pos << s) * (1.f / 8192.f); const f32x2 w1 = (f32x2){__builtin_amdgcn_cosf(rev), -__builtin_amdgcn_sinf(rev)}; const f32x2 w2 = cmul(w1, w1);
            const f32x2 a0 = X[i], a1 = X[i + Q], a2 = X[i + 2 * Q], a3 = X[i + 3 * Q];
            const f32x2 b0 = a0 + a2, b1 = a1 + a3, d02 = a0 - a2, d13 = a1 - a3;
            const f32x2 b2 = cmul(d02, w1), b3 = cmul((f32x2){d13.y, -d13.x}, w1);
            X[i] = b0 + b1; X[i + Q] = cmul(b0 - b1, w2); X[i + 2 * Q] = b2 + b3; X[i + 3 * Q] = cmul(b2 - b3, w2); }
    }
}
__device__ __forceinline__ void fft_inv_r4(f32x2* X, int tid) {
#pragma unroll 1
    for (int s = 1; s < 13; s += 2) {
        const int h = 1 << s;
        __syncthreads();
#pragma unroll
        for (int q = 0; q < 4; ++q) { const int j = tid + 512 * q, pos = j & (h - 1), i = ((j >> s) << (s + 2)) + pos;
            const float rev = (float)(pos << (11 - s)) * (1.f / 8192.f); const f32x2 v1 = (f32x2){__builtin_amdgcn_cosf(rev), __builtin_amdgcn_sinf(rev)}; const f32x2 v2 = cmul(v1, v1);
            const f32x2 a0 = X[i], a1 = cmul(X[i + h], v2), a2 = X[i + 2 * h], a3 = cmul(X[i + 3 * h], v2);
            const f32x2 b0 = a0 + a1, b1 = a0 - a1, b2 = cmul(a2 + a3, v1), t3 = cmul(a2 - a3, v1); const f32x2 b3 = (f32x2){-t3.y, t3.x};
            X[i] = b0 + b2; X[i + h] = b1 + b3; X[i + 2 * h] = b0 - b2; X[i + 3 * h] = b1 - b3; }
    }
}
__device__ __forceinline__ void ph_hyfft(const Ctx& cx, int layer, float* sm, bool dry) {
    CParams& p = get_params();
    const int tid = cx.tid;
    f32x2* A = (f32x2*)sm; f32x2* B = A + 8192;
    for (int c = cx.bid; c < 512; c += cx.nb) {
        const float* hf = (const float*)(p.ws + WS_FILT) + (size_t)c * SEQ; const float* hb = (const float*)(p.ws + WS_FILT) + ((size_t)512 + c) * SEQ;
        const float bias = p.in[I_HBIAS][layer * 512 + c];
        __syncthreads();
#pragma unroll
        for (int q = 0; q < 16; ++q) { const int i = tid + 512 * q; const float lf = hf[i & (SEQ - 1)], lb_ = hb[(2 * SEQ - i) & (SEQ - 1)]; A[i] = (f32x2){i < SEQ ? lf : (i > SEQ ? lb_ : 0.f), 0.f}; }
        fft_fwd_r4(A, tid);
        __syncthreads();
#pragma unroll
        for (int q = 0; q < 8; ++q) { const int i = 2 * (tid + 512 * q); const f32x2 a = A[i], b = A[i + 1]; A[i] = a + b; A[i + 1] = a - b; }
#pragma unroll 1
        for (int bp = 0; bp < 2; ++bp) {
            float* v0 = (float*)(p.ws + WS_VV) + ((size_t)(2 * bp) * 512 + c) * SEQ; float* v1 = v0 + (size_t)512 * SEQ;
            float xr[8], xi[8];
            __syncthreads();
#pragma unroll
            for (int q = 0; q < 8; ++q) { const int i = tid + 512 * q; xr[q] = v0[i]; xi[q] = v1[i]; B[i] = (f32x2){xr[q], xi[q]}; B[i + SEQ] = (f32x2){0.f, 0.f}; }
            fft_fwd_r4(B, tid);
            __syncthreads();
#pragma unroll
            for (int q = 0; q < 8; ++q) { const int i = 2 * (tid + 512 * q); const f32x2 a = B[i], b = B[i + 1];
                const f32x2 y0 = cmul(a + b, A[i]), y1 = cmul(a - b, A[i + 1]); B[i] = y0 + y1; B[i + 1] = y0 - y1; }
            fft_inv_r4(B, tid);
            __syncthreads();
#pragma unroll
            for (int q = 0; q < 8; ++q) { const int i = tid + 512 * q; const f32x2 y = B[i]; if (!dry) { v0[i] = y.x * (1.f / 8192.f) + xr[q] * bias; v1[i] = y.y * (1.f / 8192.f) + xi[q] * bias; } }
        }
    }
}
__device__ __forceinline__ void ph_hypost(const Ctx& cx, int layer, float* sm) {
    CParams& p = get_params();
    const int lane = cx.tid & 63, wave = cx.tid >> 6, gw = cx.bid * NWAVES + wave, NGW = cx.nb * NWAVES;
    float* tile = sm + wave * 4096;
    for (int it = gw; it < 4 * 64 * 8; it += NGW) {
        const int b = it >> 9, t0 = ((it >> 3) & 63) * 64, c0 = (it & 7) * 64;
        const float* yb = (const float*)(p.ws + WS_VV) + ((size_t)b * 512 + c0) * SEQ;
        for (int cc = 0; cc < 64; ++cc) tile[cc * 64 + (lane ^ cc)] = yb[(size_t)cc * SEQ + t0 + lane];
        __builtin_amdgcn_s_waitcnt(0xc07f);
        for (int tt = 0; tt < 64; ++tt) { const size_t o = (size_t)(b * SEQ + t0 + tt) * 512 + c0 + lane;
            ((bf16*)(p.ws + WS_HY))[o] = f2bf(tile[lane * 64 + (tt ^ lane)] * bf2f(((const bf16*)(p.ws + WS_X0C))[o])); }
        __builtin_amdgcn_s_waitcnt(0xc07f);
    }
    (void)layer;
}

__device__ __forceinline__ void s5_pow(const float decay, const float theta, int n, float& pr, float& pi) {
    const float m = __expf(decay * (float)n), rev = __builtin_amdgcn_fractf(theta * (float)n * 0.15915494309189535f);
    pr = m * __builtin_amdgcn_cosf(rev); pi = m * __builtin_amdgcn_sinf(rev);
}
__device__ __forceinline__ void ph_s5tables(const Ctx& cx, int layer, float* sm) {
    const int gt = cx.bid * NTHREADS + cx.tid, NGT = cx.nb * NTHREADS;
    {
        CParams& p = get_params(); bf16* E = (bf16*)(p.ws + WS_S5E);
        for (int it = gt; it < 32 * 2 * 64 * 64; it += NGT) {
            const int pp = it & 63, s = (it >> 6) & 63, dir = (it >> 12) & 1, g = it >> 13;
            const int ldgp = ((layer * 2 + dir) * 32 + g) * 64 + pp;
            const float decay = ((const float*)(p.ws + WS_S5C))[ldgp * 2], theta = ((const float*)(p.ws + WS_S5C))[ldgp * 2 + 1];
            float qr, qi; s5_pow(decay, theta, dir == 0 ? 63 - s : s, qr, qi);
            const f32x4* bb = (const f32x4*)((const float*)(p.ws + WS_S5B) + (size_t)ldgp * 32);
            bf16* er = E + (((size_t)(g * 2 + dir) * 128 + pp) * 1024 + s * 16); bf16* ei = er + (size_t)64 * 1024;
#pragma unroll
            for (int i = 0; i < 16; i += 2) { const f32x4 b2 = bb[i >> 1];
                *(unsigned*)(er + i) = pk2(qr * b2[0] - qi * b2[1], qr * b2[2] - qi * b2[3]); *(unsigned*)(ei + i) = pk2(qr * b2[1] + qi * b2[0], qr * b2[3] + qi * b2[2]); }
            if (s == 0) { float ar, ai; s5_pow(decay, theta, 64, ar, ai); float* a64 = (float*)(p.ws + WS_S5A64) + (size_t)ldgp * 2; a64[0] = ar; a64[1] = ai; }
        }
    }
    {
        CParams& p = get_params(); bf16* P = (bf16*)(p.ws + WS_S5P);
        for (int it = gt; it < 32 * 2 * 64 * 64; it += NGT) {
            const int pp = it & 63, tau = (it >> 6) & 63, dir = (it >> 12) & 1, g = it >> 13;
            const int ldgp = ((layer * 2 + dir) * 32 + g) * 64 + pp;
            float pr, pi; s5_pow(((const float*)(p.ws + WS_S5C))[ldgp * 2], ((const float*)(p.ws + WS_S5C))[ldgp * 2 + 1], dir == 0 ? tau + 1 : 64 - tau, pr, pi);
            const size_t cb = ((size_t)((layer * 2 + dir) * 32 + g) * 16) * 64 + pp;
            bf16* pb = P + (((size_t)(g * 2 + dir) * 64 + tau) * 16) * 128 + pp;
#pragma unroll
            for (int o = 0; o < 16; ++o) { const float cre = p.in[I_SCRE][cb + o * 64], cim = p.in[I_SCIM][cb + o * 64];
                pb[o * 128] = f2bf(cre * pr - cim * pi); pb[o * 128 + 64] = f2bf(-(cre * pi + cim * pr)); }
        }
    }
    {
        CParams& p = get_params(); bf16* K = (bf16*)(p.ws + WS_S5K);
        const int tid = cx.tid, lane = tid & 63, w = tid >> 6;
        float* Cs = sm;
        float* Xs = sm + 4096 + w * 2112;
        for (int it = cx.bid; it < 32 * 16; it += cx.nb) {
            const int g = it >> 4, dl = (it & 15) * 8 + w, d = dl - 63;
            __syncthreads();
            for (int i = tid; i < 2 * 16 * 64; i += NTHREADS) { const int dir = i >> 10, r = i & 1023; const size_t ci = (size_t)((layer * 2 + dir) * 32 + g) * 1024 + r;
                Cs[i * 2] = p.in[I_SCRE][ci]; Cs[i * 2 + 1] = p.in[I_SCIM][ci]; }
            __syncthreads();
            if (dl < 127) {
                float acc[4] = {0.f, 0.f, 0.f, 0.f};
#pragma unroll 1
                for (int dir = 0; dir < 2; ++dir) {
                    if ((dir == 0 && d < 0) || (dir == 1 && d > 0)) continue;
                    const int ldgp = ((layer * 2 + dir) * 32 + g) * 64 + lane;
                    float qr, qi; s5_pow(((const float*)(p.ws + WS_S5C))[ldgp * 2], ((const float*)(p.ws + WS_S5C))[ldgp * 2 + 1], d < 0 ? -d : d, qr, qi);
                    const f32x4* bb = (const f32x4*)((const float*)(p.ws + WS_S5B) + (size_t)ldgp * 32);
#pragma unroll
                    for (int i = 0; i < 16; i += 2) { const f32x4 b2 = bb[i >> 1];
                        Xs[lane * 33 + i] = qr * b2[0] - qi * b2[1]; Xs[lane * 33 + 16 + i] = qr * b2[1] + qi * b2[0];
                        Xs[lane * 33 + i + 1] = qr * b2[2] - qi * b2[3]; Xs[lane * 33 + 17 + i] = qr * b2[3] + qi * b2[2]; }
                    __builtin_amdgcn_s_waitcnt(0xc07f);
                    const int i = lane & 15, oq = lane >> 4;
                    for (int pp = 0; pp < 64; ++pp) { const float xr = Xs[pp * 33 + i], xi = Xs[pp * 33 + 16 + i];
#pragma unroll
                        for (int jj = 0; jj < 4; ++jj) { const f32x2 c = *(const f32x2*)(Cs + ((dir * 16 + oq + 4 * jj) * 64 + pp) * 2); acc[jj] += c.x * xr - c.y * xi; } }
                    __builtin_amdgcn_s_waitcnt(0xc07f);
                }
                const int i = lane & 15, oq = lane >> 4;
#pragma unroll
                for (int jj = 0; jj < 4; ++jj) { const int o = oq + 4 * jj; float v = acc[jj]; if (d == 0 && o == i) v += p.in[I_SD][layer * 512 + g * 16 + o];
                    K[((size_t)g * 127 + dl) * 256 + o * 16 + i] = f2bf(v); }
            }
        }
    }
}
__device__ __forceinline__ int s5_row(int b, int n, int s) { return n < 4 ? TL + b * CTXL + n * 64 + s : b * SEQ + (n - 4) * 64 + s; }
__device__ __forceinline__ void ph_s5states(const Ctx& cx, int layer, float* sm) {
    CParams& p = get_params();
    const int tid = cx.tid, lane = tid & 63, w = tid >> 6, l15 = lane & 15, kg = lane >> 4;
    const bf16* E = (const bf16*)(p.ws + WS_S5E); const bf16* U = (const bf16*)(p.ws + WS_U);
    float* S = sm;
    for (int it = cx.bid; it < 128; it += cx.nb) {
        const int g = it & 31, b = it >> 5;
        f32x4 acc[2][5];
#pragma unroll
        for (int mt = 0; mt < 2; ++mt)
#pragma unroll
            for (int nt = 0; nt < 5; ++nt) acc[mt][nt] = (f32x4){0.f, 0.f, 0.f, 0.f};
        const bf16* ea = E + ((size_t)g * 256 + 32 * w + l15) * 1024 + 8 * kg;
        const int i0 = 8 * (kg & 1);
        bf16x8 af[2], bfr[5];
#define S5S_LOAD(AF, BF, ks_) do { const int s_ = 2 * (ks_) + (kg >> 1); \
            _Pragma("unroll") for (int mt = 0; mt < 2; ++mt) AF[mt] = *(const bf16x8*)(ea + (size_t)mt * 16 * 1024 + (ks_) * 32); \
            _Pragma("unroll") for (int nt = 0; nt < 5; ++nt) { const int n = 16 * nt + l15, nc = n < 68 ? n : 67; \
                const bf16x8 ld_ = *(const bf16x8*)(U + s5_uidx(g, b, nc, s_) + i0); BF[nt] = n < 68 ? ld_ : (bf16x8){0, 0, 0, 0, 0, 0, 0, 0}; } } while (0)
        S5S_LOAD(af, bfr, 0);
        for (int ks = 0; ks < 32; ++ks) {
            bf16x8 afn[2], bfn[5];
            const int kn = ks < 31 ? ks + 1 : 31;
            S5S_LOAD(afn, bfn, kn);
#pragma unroll
            for (int mt = 0; mt < 2; ++mt)
#pragma unroll
                for (int nt = 0; nt < 5; ++nt) acc[mt][nt] = __builtin_amdgcn_mfma_f32_16x16x32_bf16(af[mt], bfr[nt], acc[mt][nt], 0, 0, 0);
#pragma unroll
            for (int mt = 0; mt < 2; ++mt) af[mt] = afn[mt];
#pragma unroll
            for (int nt = 0; nt < 5; ++nt) bfr[nt] = bfn[nt];
        }
#undef S5S_LOAD
        __syncthreads();
#pragma unroll
        for (int mt = 0; mt < 2; ++mt)
#pragma unroll
            for (int nt = 0; nt < 5; ++nt)
#pragma unroll
                for (int r = 0; r < 4; ++r) S[(32 * w + 16 * mt + kg * 4 + r) * 81 + 16 * nt + l15] = acc[mt][nt][r];
        __syncthreads();
        if (tid < 128) {
            const int dir = tid >> 6, pp = tid & 63;
            const float* a64 = (const float*)(p.ws + WS_S5A64) + ((size_t)((layer * 2 + dir) * 32 + g) * 64 + pp) * 2;
            const float ar = a64[0], ai = a64[1]; float hr = 0.f, hi = 0.f;
            bf16* hin = (bf16*)(p.ws + WS_HIN) + ((size_t)g * 272 + b * 68) * 256 + dir * 128 + pp;
            for (int k = 0; k < 68; ++k) {
                const int n = dir == 0 ? k : (k < 4 ? 3 - k : 71 - k);
                hin[(size_t)n * 256] = f2bf(hr); hin[(size_t)n * 256 + 64] = f2bf(hi);
                const float sr = S[(dir * 128 + pp) * 81 + n], si = S[(dir * 128 + 64 + pp) * 81 + n];
                const float nr = ar * hr - ai * hi + sr, ni = ar * hi + ai * hr + si; hr = nr; hi = ni;
            }
        }
    }
}
__device__ __forceinline__ void ph_s5out(const Ctx& cx, int layer, float* sm) {
    CParams& p = get_params();
    const int tid = cx.tid, lane = tid & 63, w = tid >> 6, l15 = lane & 15, kg = lane >> 4;
    const bf16* U = (const bf16*)(p.ws + WS_U); const bf16* P = (const bf16*)(p.ws + WS_S5P); const bf16* HIN = (const bf16*)(p.ws + WS_HIN);
    bf16* Kl = (bf16*)sm;
    for (int it = cx.bid; it < 256; it += cx.nb) {
        const int g = it & 31, b = (it >> 5) & 3, half = it >> 7;
        __syncthreads();
        { const u32x4* src = (const u32x4*)((const bf16*)(p.ws + WS_S5K) + (size_t)g * 127 * 256); u32x4* dst = (u32x4*)Kl;
          for (int i = tid; i < 127 * 256 / 8; i += NTHREADS) dst[i] = src[i]; }
        __syncthreads();
        f32x4 acc[4][5];
#pragma unroll
        for (int mt = 0; mt < 4; ++mt)
#pragma unroll
            for (int nt = 0; nt < 5; ++nt) acc[mt][nt] = (f32x4){0.f, 0.f, 0.f, 0.f};
        const int tau0 = 32 * half + 4 * w;
        const int i0 = 8 * (kg & 1);
        bf16x8 bfr[5];
#define S5O_LOADB(BF, ks_) do { const int s_ = 2 * (ks_) + (kg >> 1); \
            _Pragma("unroll") for (int nt = 0; nt < 5; ++nt) { const int n = 16 * nt + l15, nc = n < 68 ? n : 67; \
                const bf16x8 ld_ = *(const bf16x8*)(U + s5_uidx(g, b, nc, s_) + i0); BF[nt] = n < 68 ? ld_ : (bf16x8){0, 0, 0, 0, 0, 0, 0, 0}; } } while (0)
        S5O_LOADB(bfr, 0);
        for (int ks = 0; ks < 32; ++ks) {
            const int s = 2 * ks + (kg >> 1);
            bf16x8 bfn[5];
            const int kn = ks < 31 ? ks + 1 : 31;
            S5O_LOADB(bfn, kn);
#pragma unroll
            for (int mt = 0; mt < 4; ++mt) {
                const int lag = tau0 + mt - s;
                const bf16x8 af = *(const bf16x8*)(Kl + (lag + 63) * 256 + l15 * 16 + i0);
#pragma unroll
                for (int nt = 0; nt < 5; ++nt) acc[mt][nt] = __builtin_amdgcn_mfma_f32_16x16x32_bf16(af, bfr[nt], acc[mt][nt], 0, 0, 0);
            }
#pragma unroll
            for (int nt = 0; nt < 5; ++nt) bfr[nt] = bfn[nt];
        }
#undef S5O_LOADB
        bf16x8 pa[4];
#define S5O_LOAD2(AF, BF, dk_) do { const int dir_ = (dk_) >> 2, kk_ = (dk_) & 3; \
            _Pragma("unroll") for (int nt = 0; nt < 5; ++nt) { const int n = 16 * nt + l15, nc = n < 68 ? n : 67; \
                const bf16x8 ld_ = *(const bf16x8*)(HIN + ((size_t)g * 272 + b * 68 + nc) * 256 + dir_ * 128 + 32 * kk_ + 8 * kg); BF[nt] = n < 68 ? ld_ : (bf16x8){0, 0, 0, 0, 0, 0, 0, 0}; } \
            _Pragma("unroll") for (int mt = 0; mt < 4; ++mt) AF[mt] = *(const bf16x8*)(P + ((((size_t)(g * 2 + dir_) * 64 + tau0 + mt) * 16 + l15) * 128 + 32 * kk_ + 8 * kg)); } while (0)
        S5O_LOAD2(pa, bfr, 0);
#pragma unroll 1
        for (int dk = 0; dk < 8; ++dk) {
            bf16x8 pan[4], bfn[5];
            const int dn = dk < 7 ? dk + 1 : 7;
            S5O_LOAD2(pan, bfn, dn);
#pragma unroll
            for (int mt = 0; mt < 4; ++mt)
#pragma unroll
                for (int nt = 0; nt < 5; ++nt) acc[mt][nt] = __builtin_amdgcn_mfma_f32_16x16x32_bf16(pa[mt], bfr[nt], acc[mt][nt], 0, 0, 0);
#pragma unroll
            for (int mt = 0; mt < 4; ++mt) pa[mt] = pan[mt];
#pragma unroll
            for (int nt = 0; nt < 5; ++nt) bfr[nt] = bfn[nt];
        }
#undef S5O_LOAD2
#pragma unroll
        for (int mt = 0; mt < 4; ++mt)
#pragma unroll
            for (int nt = 0; nt < 5; ++nt) { const int n = 16 * nt + l15;
                if (n < 68 && (layer == 0 || n >= 4)) { const f32x4 y = acc[mt][nt]; u32x2 o; o.x = pk2(gelu_tanh(y[0]), gelu_tanh(y[1])); o.y = pk2(gelu_tanh(y[2]), gelu_tanh(y[3]));
                    *(u32x2*)((bf16*)(p.ws + WS_S5Y) + (size_t)s5_row(b, n, tau0 + mt) * 512 + g * 16 + 4 * kg) = o; } }
    }
}

__device__ __forceinline__ void ph_glu(const Ctx& cx, int layer, PG8_LAS unsigned char* lds) {
    CParams& p = get_params();
    pg8::Gemm g; g.A = (const bf16*)(p.ws + WS_S5Y); g.Bt = (const bf16*)(p.ws + WT_GLU) + (size_t)layer * 512 * 512; g.zsA = 0; g.zsB = 0; g.K = 512;
    pg8::TileOrder S; S.nM = TL / 256; S.nN = 2; S.nwg = S.nM * S.nN; S.G = cx.nb; S.c = cx.bid; S.nz = 1; S.exN = 2; S.expn0 = 0; S.extra = layer == 0 ? 4 * 2 : 0;
    EpiGlu E; E.ws = p.ws; E.bias = p.in[I_GLUB] + layer * 512;
    pg8::gemm_phase<EpiGlu, pg8::TileOrder>(lds, g, S, E, cx.tid);
}
__device__ __forceinline__ void ph_merge(const Ctx& cx, int layer, PG8_LAS unsigned char* lds) {
    CParams& p = get_params();
    pg8::Gemm g; g.A = (const bf16*)(p.ws + WS_ATT); g.zsA = (WS_HY - WS_ATT) / 2;
    g.Bt = (const bf16*)(p.ws + WT_BR) + (size_t)(layer * 3 + 0) * 1024 * 512; g.zsB = 1024 * 512; g.K = 512;
    pg8::TileOrder S; S.nM = TL / 256; S.nN = 4; S.nwg = S.nM * S.nN; S.G = cx.nb; S.c = cx.bid; S.nz = 3; S.exN = 4; S.expn0 = 0; S.extra = layer == 0 ? 4 * 4 : 0;
    EpiMerge E; E.ws = p.ws;
    pg8::gemm_phase<EpiMerge, pg8::TileOrder>(lds, g, S, E, cx.tid);
}
__device__ __forceinline__ void ph_outproj(const Ctx& cx, int layer, PG8_LAS unsigned char* lds, float scale) {
    CParams& p = get_params();
    pg8::Gemm g; g.A = (const bf16*)(p.ws + WS_M); g.Bt = (const bf16*)(p.ws + WT_OUT) + (size_t)layer * 1024 * 1024; g.zsA = 0; g.zsB = 0; g.K = 1024;
    pg8::TileOrder S; S.nM = TL / 256; S.nN = 4; S.nwg = S.nM * S.nN; S.G = cx.nb; S.c = cx.bid; S.nz = 1; S.exN = 4; S.expn0 = 0; S.extra = layer == 0 ? 4 * 4 : 0;
    EpiOut E; E.ws = p.ws; E.layer = layer; E.scale = scale;
    pg8::gemm_phase<EpiOut, pg8::TileOrder>(lds, g, S, E, cx.tid);
}
__device__ __forceinline__ void ph_qp(const Ctx& cx, int layer, PG8_LAS unsigned char* lds) {
    CParams& p = get_params();
    pg8::Gemm g; g.A = (const bf16*)(p.ws + WS_H); g.Bt = (const bf16*)(p.ws + WT_WQ) + (size_t)layer * 2048 * 1024; g.zsA = 0; g.zsB = 0; g.K = 1024;
    pg8::TileOrder S; S.nM = TL / 256; S.nN = 8; S.nwg = S.nM * S.nN; S.G = cx.nb; S.c = cx.bid; S.nz = 1; S.exN = 8; S.expn0 = 0; S.extra = layer == 0 ? 4 * 8 : 0;
    EpiQp E; E.ws = p.ws;
    pg8::gemm_phase<EpiQp, pg8::TileOrder>(lds, g, S, E, cx.tid);
}

__device__ __forceinline__ void ph_peerconv(const Ctx& cx, int layer) {
    CParams& p = get_params();
    const int gt = cx.bid * NTHREADS + cx.tid, NGT = cx.nb * NTHREADS;
    const f32x4* su = (const f32x4*)(p.in[I_PU] + (size_t)layer * 16384 * 1024); const f32x4* sv = (const f32x4*)(p.in[I_PV] + (size_t)layer * 16384 * 1024);
    int* du = (int*)(p.ws + WS_PU); int* dv = (int*)(p.ws + WS_PV);
    for (int i = gt; i < 16384 * 1024 / 4; i += NGT) { const f32x4 a = __builtin_nontemporal_load(su + i) * PEER_SU, c = __builtin_nontemporal_load(sv + i) * PEER_SV;
        int wa = 0, wc = 0; wa = __builtin_amdgcn_cvt_pk_fp8_f32(a[0], a[1], wa, false); wa = __builtin_amdgcn_cvt_pk_fp8_f32(a[2], a[3], wa, true);
        wc = __builtin_amdgcn_cvt_pk_fp8_f32(c[0], c[1], wc, false); wc = __builtin_amdgcn_cvt_pk_fp8_f32(c[2], c[3], wc, true);
        const int e = i >> 8, q = i & 255, di = (((q >> 5) * 16384 + e) << 5) + (q & 31); du[di] = wa; dv[di] = wc; }
}
__device__ __forceinline__ unsigned mono_key(float s, unsigned lowbits, unsigned mask) { const unsigned u = __float_as_uint(s); const unsigned k = (u & 0x80000000u) ? ~u : (u | 0x80000000u); return (k & ~mask) | lowbits; }
__device__ __forceinline__ float mono_val(unsigned key, unsigned mask) { const unsigned k = (key & ~mask) | ((mask + 1u) >> 1); return __uint_as_float((k & 0x80000000u) ? (k & 0x7fffffffu) : ~k); }
#define TOP16_INSERT(t, v_) do { unsigned v__ = (v_); _Pragma("unroll") for (int k_ = 0; k_ < 16; ++k_) { const unsigned hi__ = t[k_] > v__ ? t[k_] : v__; v__ = t[k_] > v__ ? v__ : t[k_]; t[k_] = hi__; } } while (0)
#define CE_DESC(x_, y_) do { const unsigned hi__ = (x_) > (y_) ? (x_) : (y_); const unsigned lo__ = (x_) > (y_) ? (y_) : (x_); (x_) = hi__; (y_) = lo__; } while (0)
__device__ __forceinline__ void sort16_desc(unsigned (&v)[16]) {
#pragma unroll
    for (int k = 2; k <= 16; k <<= 1)
#pragma unroll
        for (int j = k >> 1; j > 0; j >>= 1)
#pragma unroll
            for (int i = 0; i < 16; ++i) { const int l = i ^ j; if (l > i) { if ((i & k) == 0) CE_DESC(v[i], v[l]); else CE_DESC(v[l], v[i]); } }
}
__device__ __forceinline__ void merge16_desc(unsigned (&t)[16], const unsigned (&s)[16]) {
    unsigned c[16];
#pragma unroll
    for (int k = 0; k < 16; ++k) c[k] = t[k] > s[15 - k] ? t[k] : s[15 - k];
#pragma unroll
    for (int d = 8; d >= 1; d >>= 1)
#pragma unroll
        for (int k = 0; k < 16; ++k) if ((k & d) == 0) CE_DESC(c[k], c[k + d]);
#pragma unroll
    for (int k = 0; k < 16; ++k) t[k] = c[k];
}
__device__ __forceinline__ void top16_merge_pair(unsigned (&t)[16]) {
    unsigned c[16];
#pragma unroll
    for (int k = 0; k < 16; ++k) { const unsigned o = (unsigned)__shfl_xor((int)t[15 - k], 32); c[k] = t[k] > o ? t[k] : o; }
#pragma unroll
    for (int d = 8; d >= 1; d >>= 1)
#pragma unroll
        for (int k = 0; k < 16; ++k) if ((k & d) == 0) { const unsigned a = c[k], bb = c[k + d]; c[k] = a > bb ? a : bb; c[k + d] = a > bb ? bb : a; }
#pragma unroll
    for (int k = 0; k < 16; ++k) t[k] = c[k];
}
typedef float f32x16 __attribute__((ext_vector_type(16)));
__device__ __forceinline__ void ph_select(const Ctx& cx, int layer) {
    CParams& p = get_params();
    const int lane = cx.tid & 63, wave = cx.tid >> 6, l31 = lane & 31, hi = lane >> 5;
    const int gw = cx.bid * NWAVES + wave, NGW = cx.nb * NWAVES;
    const int nrows = layer == 0 ? TA : TL;
    const bf16* QP = (const bf16*)(p.ws + WS_QP); const bf16* KY = (const bf16*)(p.ws + WT_KEYS) + (size_t)layer * 8 * 2 * 128 * 128;
    for (int it = gw; it < (nrows / 32) * 8; it += NGW) {
        const int h = it & 7, r0 = (it >> 3) * 32;
        unsigned ab[2][16];
#pragma unroll
        for (int s = 0; s < 2; ++s) {
            const bf16* kp = KY + ((size_t)(h * 2 + s) * 8 * 128 + l31) * 16 + 8 * hi;
            const bf16* qp = QP + ((size_t)(h * 2 + s) * 8 * TA + (r0 + l31)) * 16 + 8 * hi;
            bf16x8 qf[8], kc[8];
#pragma unroll
            for (int ks = 0; ks < 8; ++ks) { qf[ks] = *(const bf16x8*)(qp + (size_t)ks * TA * 16); kc[ks] = *(const bf16x8*)(kp + ks * 2048); }
            unsigned t[16];
#pragma unroll
            for (int k = 0; k < 16; ++k) t[k] = 0u;
#pragma unroll 1
            for (int nt = 0; nt < 4; ++nt) {
                bf16x8 kn[8];
                const bf16* kpn = kp + (nt < 3 ? nt + 1 : nt) * 512;
#pragma unroll
                for (int ks = 0; ks < 8; ++ks) kn[ks] = *(const bf16x8*)(kpn + ks * 2048);
                f32x16 acc;
#pragma unroll
                for (int r = 0; r < 16; ++r) acc[r] = 0.f;
#pragma unroll
                for (int ks = 0; ks < 8; ++ks) acc = __builtin_amdgcn_mfma_f32_32x32x16_bf16(kc[ks], qf[ks], acc, 0, 0, 0);
                unsigned sk[16];
#pragma unroll
                for (int r = 0; r < 16; ++r) { const int n = 32 * nt + (r & 3) + 8 * (r >> 2) + 4 * hi; sk[r] = mono_key(acc[r], 127u - (unsigned)n, 127u); }
                sort16_desc(sk);
                merge16_desc(t, sk);
#pragma unroll
                for (int ks = 0; ks < 8; ++ks) kc[ks] = kn[ks];
            }
            top16_merge_pair(t);
#pragma unroll
            for (int k = 0; k < 16; ++k) ab[s][k] = t[k];
        }
        float av[16], bv[16];
#pragma unroll
        for (int k = 0; k < 16; ++k) { av[k] = mono_val(ab[0][k], 127u); bv[k] = mono_val(ab[1][k], 127u); }
        unsigned t2[16], u2[16];
#pragma unroll
        for (int k = 0; k < 16; ++k) { t2[k] = 0u; u2[k] = 0u; }
#define CELL(dst, i1, j1, i2, j2) do { const float sv_ = hi ? av[i2] + bv[j2] : av[i1] + bv[j1]; const unsigned lb_ = hi ? 255u - (unsigned)((i2) * 16 + (j2)) : 255u - (unsigned)((i1) * 16 + (j1)); dst = mono_key(sv_, lb_, 255u); } while (0)
        CELL(t2[0], 0, 0, 1, 1);   CELL(t2[1], 0, 1, 1, 2);   CELL(t2[2], 0, 2, 1, 3);   CELL(t2[3], 0, 3, 1, 4);   CELL(t2[4], 0, 4, 1, 5);   CELL(t2[5], 0, 5, 1, 6);   CELL(t2[6], 0, 6, 1, 7);   CELL(t2[7], 0, 7, 2, 0);
        CELL(t2[8], 0, 8, 2, 1);   CELL(t2[9], 0, 9, 2, 2);   CELL(t2[10], 0, 10, 2, 3); CELL(t2[11], 0, 11, 2, 4); CELL(t2[12], 0, 12, 3, 0); CELL(t2[13], 0, 13, 3, 1); CELL(t2[14], 0, 14, 3, 2); CELL(t2[15], 0, 15, 3, 3);
        CELL(u2[0], 1, 0, 4, 0);   CELL(u2[1], 4, 1, 4, 2);   CELL(u2[2], 5, 0, 5, 1);   CELL(u2[3], 6, 0, 6, 1);   CELL(u2[4], 7, 0, 7, 1);   CELL(u2[5], 8, 0, 9, 0);   CELL(u2[6], 10, 0, 11, 0); CELL(u2[7], 12, 0, 13, 0); CELL(u2[8], 14, 0, 15, 0);
#undef CELL
        sort16_desc(t2); sort16_desc(u2); merge16_desc(t2, u2);
        top16_merge_pair(t2);
        const float v0 = mono_val(t2[0], 255u); float e[16], esum = 0.f; int eid[16];
#pragma unroll
        for (int k = 0; k < 16; ++k) { e[k] = __expf(mono_val(t2[k], 255u) - v0); esum += e[k];
            const unsigned c = 255u - (t2[k] & 255u), ci = c >> 4, cj = c & 15u; unsigned ka = ab[0][0], kb = ab[1][0];
#pragma unroll
            for (int q = 1; q < 16; ++q) { ka = ci == (unsigned)q ? ab[0][q] : ka; kb = cj == (unsigned)q ? ab[1][q] : kb; }
            eid[k] = (int)((127u - (ka & 127u)) * 128u + (127u - (kb & 127u))); }
        const float inv = 1.f / esum;
        if (hi == 0) { int* dst = (int*)(p.ws + WS_EID) + (size_t)(r0 + l31) * 128 + h * 16;
#pragma unroll
            for (int k = 0; k < 16; k += 4) *(u32x4*)(dst + k) = (u32x4){(unsigned)eid[k], (unsigned)eid[k + 1], (unsigned)eid[k + 2], (unsigned)eid[k + 3]}; }
        else { float* dst = (float*)(p.ws + WS_EG) + (size_t)(r0 + l31) * 128 + h * 16;
#pragma unroll
            for (int k = 0; k < 16; k += 4) *(f32x4*)(dst + k) = (f32x4){e[k] * inv, e[k + 1] * inv, e[k + 2] * inv, e[k + 3] * inv}; }
    }
}
__device__ __forceinline__ void fp8x16_to_f32(const u32x4 w, f32x2 (&f)[8]) {
    f[0] = __builtin_amdgcn_cvt_pk_f32_fp8((int)w.x, false); f[1] = __builtin_amdgcn_cvt_pk_f32_fp8((int)w.x, true); f[2] = __builtin_amdgcn_cvt_pk_f32_fp8((int)w.y, false); f[3] = __builtin_amdgcn_cvt_pk_f32_fp8((int)w.y, true);
    f[4] = __builtin_amdgcn_cvt_pk_f32_fp8((int)w.z, false); f[5] = __builtin_amdgcn_cvt_pk_f32_fp8((int)w.z, true); f[6] = __builtin_amdgcn_cvt_pk_f32_fp8((int)w.w, false); f[7] = __builtin_amdgcn_cvt_pk_f32_fp8((int)w.w, true);
}
#define PU_ISSUE(rowbuf, e0_, e1_) do { _Pragma("unroll") for (int s = 0; s < 16; ++s) { const int e_ = __shfl(s < 8 ? e0_ : e1_, (s & 7) * 8 + grp); \
        rowbuf[s] = __builtin_amdgcn_raw_buffer_load_b128(ru, (unsigned)(e_ * 128 + j8 * 16), 0, 0); } } while (0)
__device__ __forceinline__ void pu_compute(const u32x4 (&row)[16], const u32x4 xw0, const u32x4 xw1, float* pt, int j8, int grp) {
    f32x2 x[8];
    { const f32x4 a = bf4lo(xw0), b = bf4hi(xw0), c = bf4lo(xw1), d = bf4hi(xw1);
      x[0] = (f32x2){a[0], a[1]}; x[1] = (f32x2){a[2], a[3]}; x[2] = (f32x2){b[0], b[1]}; x[3] = (f32x2){b[2], b[3]}; x[4] = (f32x2){c[0], c[1]}; x[5] = (f32x2){c[2], c[3]}; x[6] = (f32x2){d[0], d[1]}; x[7] = (f32x2){d[2], d[3]}; }
    float d[16];
#pragma unroll
    for (int s = 0; s < 16; ++s) { f32x2 f[8]; fp8x16_to_f32(row[s], f);
        f32x2 a = f[0] * x[0];
#pragma unroll
        for (int j = 1; j < 8; ++j) a += f[j] * x[j];
        d[s] = a.x + a.y; }
    float a8[8], a4[4];
    { const bool bt = j8 & 4;
#pragma unroll
      for (int i = 0; i < 4; ++i) {
          const float s0 = bt ? d[i] : d[i + 4], k0 = bt ? d[i + 4] : d[i]; a8[i] = k0 + __shfl_xor(s0, 4);
          const float s1 = bt ? d[i + 8] : d[i + 12], k1 = bt ? d[i + 12] : d[i + 8]; a8[i + 4] = k1 + __shfl_xor(s1, 4); } }
    { const bool bt = j8 & 2;
#pragma unroll
      for (int i = 0; i < 2; ++i) {
          const float s0 = bt ? a8[i] : a8[i + 2], k0 = bt ? a8[i + 2] : a8[i]; a4[i] = k0 + __shfl_xor(s0, 2);
          const float s1 = bt ? a8[i + 4] : a8[i + 6], k1 = bt ? a8[i + 6] : a8[i + 4]; a4[i + 2] = k1 + __shfl_xor(s1, 2); } }
    float r0, r1;
    { const bool bt = j8 & 1;
      const float s0 = bt ? a4[0] : a4[1], k0 = bt ? a4[1] : a4[0]; r0 = k0 + __shfl_xor(s0, 1);
      const float s1 = bt ? a4[2] : a4[3], k1 = bt ? a4[3] : a4[2]; r1 = k1 + __shfl_xor(s1, 1); }
    pt[0] = r0; pt[64] = r1;
}
__device__ __forceinline__ void ph_peer_u(const Ctx& cx, int layer) {
    CParams& p = get_params();
    const int lane = cx.tid & 63, wave = __builtin_amdgcn_readfirstlane(cx.tid >> 6);
    const int nrows = layer == 0 ? TA : TL;
    const int slice = cx.bid & 7, ws_ = (cx.bid >> 3) * NWAVES + wave, NWS = (cx.nb >> 3) * NWAVES;
    const __amdgpu_buffer_rsrc_t ru = __builtin_amdgcn_make_buffer_rsrc((void*)uni_ptr(p.ws + WS_PU + (size_t)slice * (16384 * 128)), (short)0, 16384 * 128, 0x00020000);
    const int j8 = lane & 7, grp = lane >> 3;
    float* PART = (float*)(p.ws + WS_PART) + (size_t)slice * TA * 128 + j8 * 8 + grp;
    const int* EID = (const int*)(p.ws + WS_EID) + lane; const bf16* Hx = (const bf16*)(p.ws + WS_H) + slice * 128 + j8 * 16;
    int t = ws_;
    if (t >= nrows) return;
    u32x4 rA[16], rB[16]; u32x4 xa0, xa1, xb0, xb1;
    int e0 = EID[(size_t)t * 128], e1 = EID[(size_t)t * 128 + 64];
    PU_ISSUE(rA, e0, e1); xa0 = *(const u32x4*)(Hx + (size_t)t * 1024); xa1 = *(const u32x4*)(Hx + (size_t)t * 1024 + 8);
    if (t + NWS < nrows) { e0 = EID[(size_t)(t + NWS) * 128]; e1 = EID[(size_t)(t + NWS) * 128 + 64]; }
    for (;;) {
        const int t1 = t + NWS, t2 = t + 2 * NWS, t3 = t + 3 * NWS;
        if (t1 < nrows) { PU_ISSUE(rB, e0, e1); xb0 = *(const u32x4*)(Hx + (size_t)t1 * 1024); xb1 = *(const u32x4*)(Hx + (size_t)t1 * 1024 + 8); }
        if (t2 < nrows) { e0 = EID[(size_t)t2 * 128]; e1 = EID[(size_t)t2 * 128 + 64]; }
        pu_compute(rA, xa0, xa1, PART + (size_t)t * 128, j8, grp);
        if (t1 >= nrows) break;
        if (t2 < nrows) { PU_ISSUE(rA, e0, e1); xa0 = *(const u32x4*)(Hx + (size_t)t2 * 1024); xa1 = *(const u32x4*)(Hx + (size_t)t2 * 1024 + 8); }
        if (t3 < nrows) { e0 = EID[(size_t)t3 * 128]; e1 = EID[(size_t)t3 * 128 + 64]; }
        pu_compute(rB, xb0, xb1, PART + (size_t)t1 * 128, j8, grp);
        if (t2 >= nrows) break;
        t = t2;
    }
}
#undef PU_ISSUE
__device__ __forceinline__ void ph_peer_w(const Ctx& cx, int layer) {
    CParams& p = get_params();
    const int gt = cx.bid * NTHREADS + cx.tid, NGT = cx.nb * NTHREADS;
    const int n = (layer == 0 ? TA : TL) * 128;
    const float* PART = (const float*)(p.ws + WS_PART); float* EG = (float*)(p.ws + WS_EG);
    for (int i = gt; i < n; i += NGT) { float d = 0.f;
#pragma unroll
        for (int xs = 0; xs < 8; ++xs) d += PART[(size_t)xs * TA * 128 + i];
        EG[i] = EG[i] * gelu_tanh(d * (1.f / PEER_SU)); }
}
#define PV_ISSUE(vbuf, wbuf, e0_, e1_, w0_, w1_) do { _Pragma("unroll") for (int s = 0; s < 16; ++s) { const int src_ = (s & 7) * 8 + grp; \
        const int ee_ = __shfl(s < 8 ? e0_ : e1_, src_); wbuf[s] = __shfl(s < 8 ? w0_ : w1_, src_); vbuf[s] = __builtin_amdgcn_raw_buffer_load_b128(rv, (unsigned)(ee_ * 128 + j8 * 16), 0, 0); } } while (0)
__device__ __forceinline__ void pv_compute(const u32x4 (&row)[16], const float (&w)[16], float* o, int lane) {
    f32x2 acc[8];
#pragma unroll
    for (int j = 0; j < 8; ++j) acc[j] = (f32x2){0.f, 0.f};
#pragma unroll
    for (int s = 0; s < 16; ++s) { f32x2 f[8]; fp8x16_to_f32(row[s], f);
#pragma unroll
        for (int j = 0; j < 8; ++j) acc[j] += w[s] * f[j]; }
    f32x2 a4[4], a2[2];
    { const bool bt = lane & 32;
#pragma unroll
      for (int i = 0; i < 4; ++i) { const f32x2 sd = bt ? acc[i] : acc[i + 4], kp = bt ? acc[i + 4] : acc[i]; a4[i] = (f32x2){kp.x + __shfl_xor(sd.x, 32), kp.y + __shfl_xor(sd.y, 32)}; } }
    { const bool bt = lane & 16;
#pragma unroll
      for (int i = 0; i < 2; ++i) { const f32x2 sd = bt ? a4[i] : a4[i + 2], kp = bt ? a4[i + 2] : a4[i]; a2[i] = (f32x2){kp.x + __shfl_xor(sd.x, 16), kp.y + __shfl_xor(sd.y, 16)}; } }
    f32x2 r; { const bool bt = lane & 8; const f32x2 sd = bt ? a2[0] : a2[1], kp = bt ? a2[1] : a2[0]; r = (f32x2){kp.x + __shfl_xor(sd.x, 8), kp.y + __shfl_xor(sd.y, 8)}; }
    *(f32x2*)(o + ((lane >> 5) & 1) * 8 + ((lane >> 4) & 1) * 4 + ((lane >> 3) & 1) * 2) = r;
}
__device__ __forceinline__ void ph_peer_v(const Ctx& cx, int layer) {
    CParams& p = get_params();
    const int lane = cx.tid & 63, wave = __builtin_amdgcn_readfirstlane(cx.tid >> 6);
    const int nrows = layer == 0 ? TA : TL;
    const int slice = cx.bid & 7, ws_ = (cx.bid >> 3) * NWAVES + wave, NWS = (cx.nb >> 3) * NWAVES;
    const __amdgpu_buffer_rsrc_t rv = __builtin_amdgcn_make_buffer_rsrc((void*)uni_ptr(p.ws + WS_PV + (size_t)slice * (16384 * 128)), (short)0, 16384 * 128, 0x00020000);
    const int j8 = lane & 7, grp = lane >> 3;
    const float* EG = (const float*)(p.ws + WS_EG) + lane; const int* EID = (const int*)(p.ws + WS_EID) + lane;
    float* OUT = (float*)(p.ws + WS_POUT) + slice * 128 + j8 * 16;
    int t = ws_;
    if (t >= nrows) return;
    u32x4 rA[16], rB[16]; float wA[16], wB[16];
    int e0 = EID[(size_t)t * 128], e1 = EID[(size_t)t * 128 + 64]; float w0 = EG[(size_t)t * 128], w1 = EG[(size_t)t * 128 + 64];
    PV_ISSUE(rA, wA, e0, e1, w0, w1);
    if (t + NWS < nrows) { e0 = EID[(size_t)(t + NWS) * 128]; e1 = EID[(size_t)(t + NWS) * 128 + 64]; w0 = EG[(size_t)(t + NWS) * 128]; w1 = EG[(size_t)(t + NWS) * 128 + 64]; }
    for (;;) {
        const int t1 = t + NWS, t2 = t + 2 * NWS, t3 = t + 3 * NWS;
        if (t1 < nrows) PV_ISSUE(rB, wB, e0, e1, w0, w1);
        if (t2 < nrows) { e0 = EID[(size_t)t2 * 128]; e1 = EID[(size_t)t2 * 128 + 64]; w0 = EG[(size_t)t2 * 128]; w1 = EG[(size_t)t2 * 128 + 64]; }
        pv_compute(rA, wA, OUT + (size_t)t * 1024, lane);
        if (t1 >= nrows) break;
        if (t2 < nrows) PV_ISSUE(rA, wA, e0, e1, w0, w1);
        if (t3 < nrows) { e0 = EID[(size_t)t3 * 128]; e1 = EID[(size_t)t3 * 128 + 64]; w0 = EG[(size_t)t3 * 128]; w1 = EG[(size_t)t3 * 128 + 64]; }
        pv_compute(rB, wB, OUT + (size_t)t1 * 1024, lane);
        if (t2 >= nrows) break;
        t = t2;
    }
}
#undef PV_ISSUE
__device__ __forceinline__ void ph_peer_fin(const Ctx& cx, int layer, float scale) {
    CParams& p = get_params();
    const int lane = cx.tid & 63, wave = cx.tid >> 6;
    const int gw = cx.bid * NWAVES + wave, NGW = cx.nb * NWAVES;
    const int nrows = layer == 0 ? TA : TL;
    float* X = (float*)(p.ws + WS_XCUR);
    for (int r = gw; r < nrows; r += NGW) {
        const float* g2 = (const float*)(p.ws + WS_MODV) + ((size_t)layer * 5 + row_mi(r)) * 6144 + 5120;
        f32x4 v[4]; float ss = 0.f;
#pragma unroll
        for (int j = 0; j < 4; ++j) { const int c = j * 256 + lane * 4; f32x4 xv = *(const f32x4*)(X + (size_t)r * 1024 + c);
            xv += *(const f32x4*)(g2 + c) * *(const f32x4*)((const float*)(p.ws + WS_POUT) + (size_t)r * 1024 + c) * (scale / PEER_SV); *(f32x4*)(X + (size_t)r * 1024 + c) = xv; v[j] = xv;
            ss += xv[0] * xv[0] + xv[1] * xv[1] + xv[2] * xv[2] + xv[3] * xv[3]; }
        const float rs = rsqrtf(wave_sum(ss) * (1.f / DM) + NORM_EPS);
        if (layer == DEPTH - 1) {
#pragma unroll
            for (int j = 0; j < 4; ++j) { const int c = j * 256 + lane * 4; *(f32x4*)(p.out + (size_t)r * 1024 + c) = v[j] * rs * *(const f32x4*)(p.in[I_FG] + c); }
        } else {
            const float* g = p.in[I_N1G] + (layer + 1) * DM; const float* mv = (const float*)(p.ws + WS_MODV) + ((size_t)(layer + 1) * 5 + row_mi(r)) * 6144;
#pragma unroll
            for (int j = 0; j < 4; ++j) { const int c = j * 256 + lane * 4;
                const f32x4 y = v[j] * rs * *(const f32x4*)(g + c); const f32x4 h = y * (1.f + *(const f32x4*)(mv + 1024 + c)) + *(const f32x4*)(mv + c);
                u32x2 w; w.x = pk2(h[0], h[1]); w.y = pk2(h[2], h[3]); *(u32x2*)((bf16*)(p.ws + WS_H) + (size_t)r * DM + c) = w; }
        }
    }
}

constexpr int NPL = 14, NPHASE = 1 + DEPTH * NPL;
#ifndef ONLY
#define ONLY -1
#endif
#ifndef NOT
#define NOT -1
#endif
#define ON(n) ((ONLY < 0 || ONLY == (n)) && NOT != (n))
#ifndef PROBE_HAS
#define PROBE_HAS(n) false
#endif
#define REPN(n) (PROBE_HAS(n) ? 2 : 1)
#define RUN(n, call) do { { MKCX(); if (ON(n)) { const int rep_ = 0; (void)rep_; call; } } if (REPN(n) > 1) { __syncthreads(); { MKCX(); if (ON(n)) { const int rep_ = 1; (void)rep_; call; } } __syncthreads(); } } while (0)
#define MKCX() Ctx cx; cx.tid = threadIdx.x; cx.bid = blockIdx.x; cx.nb = gridDim.x; asm volatile("" : "+v"(cx.tid), "+s"(cx.bid), "+s"(cx.nb))
#define IN(k) (lo <= (k) && (k) < hi)
#define SEAM(k) do { if (IN(k) && IN((k) + 1)) { XcdBarrier bar_; bar_.bar = (unsigned*)(get_params().ws + WS_CTL) + 4096; bar_.x = xb_xcc_id(); bar_.st = st; xcd_barrier(bar_); } } while (0)
template <int LAYER> __device__ __forceinline__ void layer_program(const int lo, const int hi, float* sm, PG8_LAS unsigned char* lds, volatile LAS unsigned* st) {
    constexpr int B = 1 + LAYER * NPL;
    if (LAYER == 0) { if (IN(B + 0)) { RUN(0, ph_norm(cx, LAYER, 0, 0)); RUN(50, ph_filters(cx, LAYER, sm)); __syncthreads(); RUN(102, ph_s5tables(cx, 0, sm)); } SEAM(B + 0); }
    if (IN(B + 1)) { RUN(1, ph_inproj(cx, LAYER, lds)); } SEAM(B + 1);
    if (IN(B + 2)) { RUN(2, ph_attn(cx, LAYER, sm)); __syncthreads(); RUN(20, ph_hypre(cx, LAYER, sm)); __syncthreads(); RUN(21, ph_s5states(cx, LAYER, sm)); } SEAM(B + 2);
    if (IN(B + 3)) { RUN(3, ph_hyfft(cx, LAYER, sm, rep_ + 1 < REPN(3))); __syncthreads(); RUN(31, ph_hyconv_ctx(cx, LAYER, sm)); __syncthreads(); RUN(30, ph_s5out(cx, LAYER, sm)); } SEAM(B + 3);
    if (IN(B + 4)) { RUN(4, ph_glu(cx, LAYER, lds)); __syncthreads(); RUN(40, ph_hypost(cx, LAYER, sm)); } SEAM(B + 4);
    if (IN(B + 5)) { RUN(5, ph_merge(cx, LAYER, lds)); } SEAM(B + 5);
    if (IN(B + 6)) { RUN(6, ph_outproj(cx, LAYER, lds, 1.f / REPN(6))); } SEAM(B + 6);
    if (IN(B + 7)) { RUN(7, ph_norm(cx, LAYER, 1, LAYER == DEPTH - 1)); if (LAYER + 1 < DEPTH) { RUN(70, ph_s5tables(cx, LAYER + 1, sm)); __syncthreads(); RUN(51, ph_filters(cx, LAYER + 1, sm)); } RUN(71, ph_peerconv(cx, LAYER)); } SEAM(B + 7);
    if (IN(B + 8)) { RUN(8, ph_qp(cx, LAYER, lds)); } SEAM(B + 8);
    if (IN(B + 9)) { RUN(9, ph_select(cx, LAYER)); } SEAM(B + 9);
    if (IN(B + 10)) { RUN(10, ph_peer_u(cx, LAYER)); } SEAM(B + 10);
    if (IN(B + 11)) { RUN(13, ph_peer_w(cx, LAYER)); } SEAM(B + 11);
    if (IN(B + 12)) { RUN(11, ph_peer_v(cx, LAYER)); } SEAM(B + 12);
    if (IN(B + 13)) { RUN(12, ph_peer_fin(cx, LAYER, 1.f / REPN(12))); } SEAM(B + 13);
}
__global__ void __launch_bounds__(NTHREADS, 2) mk_fwd(Params p) {
    extern __shared__ __attribute__((aligned(16))) unsigned char lds_raw[];
    float* sm = (float*)lds_raw; PG8_LAS unsigned char* lds = (PG8_LAS unsigned char*)lds_raw;
    volatile LAS unsigned* st = (volatile LAS unsigned*)(lds + LDS_MISC);
    if (threadIdx.x < 4) st[threadIdx.x] = 0u;
    __syncthreads();
    const int lo = p.ph_lo, hi = p.ph_hi;
    if (hi - lo > 1) (void)xcd_barrier_post((unsigned*)(p.ws + WS_CTL) + 4096, st);
    if (IN(0)) { RUN(100, ph_prologue(cx, sm)); RUN(101, ph_convert(cx));  } SEAM(0);
    layer_program<0>(lo, hi, sm, lds, st);
    layer_program<1>(lo, hi, sm, lds, st);
}
}

extern "C" void kernel_launch(void* const* d_in, const int* in_sizes, int n_in, void* d_out, int out_size, void* d_ws, size_t ws_size, hipStream_t stream) {
    static int grid = 0;
    if (grid == 0) {
        if (n_in != 40 || out_size != TL * DM || ws_size < WS_END) { fprintf(stderr, "kernel_launch: unexpected shapes (n_in %d out %d ws %zu)\n", n_in, out_size, ws_size); grid = -1; return; }
        int dev = 0, cus = 0;
        if (hipGetDevice(&dev) != hipSuccess || hipDeviceGetAttribute(&cus, hipDeviceAttributeMultiprocessorCount, dev) != hipSuccess) { grid = -1; return; }
        if (hipFuncSetAttribute((const void*)mk_fwd, hipFuncAttributeMaxDynamicSharedMemorySize, LDS_BYTES) != hipSuccess) { fprintf(stderr, "kernel_launch: hipFuncSetAttribute failed\n"); grid = -1; return; }
        grid = cus;
    }
    if (grid < 0) return;
    (void)hipMemsetAsync((char*)d_ws + WS_CTL, 0, 1 * MiB, stream);
    Params a{};
    for (int i = 0; i < 40; ++i) a.in[i] = (const float*)d_in[i];
    a.out = (float*)d_out; a.ws = (unsigned char*)d_ws;
#if PER_PHASE_LAUNCH
    for (int ph = 0; ph < NPHASE; ++ph) { a.ph_lo = ph; a.ph_hi = ph + 1; hipLaunchKernelGGL(mk_fwd, dim3(grid), dim3(NTHREADS), LDS_BYTES, stream, a); }
#else
    a.ph_lo = 0; a.ph_hi = NPHASE; hipLaunchKernelGGL(mk_fwd, dim3(grid), dim3(NTHREADS), LDS_BYTES, stream, a);
#endif
}
```

```cpp
#include <hip/hip_runtime.h>
#include <stdint.h>
#include <math.h>
#include <stdio.h>

#ifndef PER_PHASE_LAUNCH
#define PER_PHASE_LAUNCH 0
#endif

namespace {
typedef unsigned short bf16;
typedef float f32x4 __attribute__((ext_vector_type(4)));
typedef unsigned u32x2 __attribute__((ext_vector_type(2)));
typedef unsigned u32x4 __attribute__((ext_vector_type(4)));
typedef short bf16x8 __attribute__((ext_vector_type(8)));
#define LAS __attribute__((address_space(3)))

constexpr int DM = 1024, NBATCH = 4, SEQ = 4096, CTXL = 256, DEPTH = 2;
constexpr int TL = NBATCH * SEQ, TC = NBATCH * CTXL, TA = TL + TC;
constexpr int INW = 5888, COL_K = 512, COL_V = 640, COL_S5 = 768, COL_HY = 1280, COL_GATE = 2816;
constexpr int NTHREADS = 512, NWAVES = 8;
constexpr float NORM_EPS = 1e-6f;
constexpr float HY_FAST = 15.350567286626973f, HY_SLOW = 3.0701134573253945f;

constexpr size_t MiB = 1u << 20;
constexpr size_t WS_CTL = 0;
constexpr size_t WS_XCUR = 1 * MiB;
constexpr size_t WS_MODV = 69 * MiB;
constexpr size_t WS_ROPE = WS_MODV + 512 * 1024;
constexpr size_t WS_S5A = 70 * MiB;
constexpr size_t WS_S5B = 70 * MiB + 256 * 1024;
constexpr size_t WS_FILT = 72 * MiB;
constexpr size_t FILT_CTX_OFF = 16 * MiB;
constexpr size_t WS_WTS = 89 * MiB;
constexpr size_t WT_IN = WS_WTS;
constexpr size_t WT_GLU = WT_IN + 23 * MiB;
constexpr size_t WT_BR = WT_GLU + 1 * MiB;
constexpr size_t WT_OUT = WT_BR + 6 * MiB;
constexpr size_t WT_WQ = WT_OUT + 4 * MiB;
constexpr size_t WT_KEYS = WT_WQ + 8 * MiB;
constexpr size_t WS_H = 132 * MiB;
constexpr size_t WS_VV = WS_H;
constexpr size_t WS_VVC = WS_H + 32 * MiB;
constexpr size_t WS_Q = 166 * MiB;
constexpr size_t WS_K = 183 * MiB;
constexpr size_t WS_V = WS_K + (size_t)TA * 128 * 2;
constexpr size_t WS_U = WS_V + (size_t)TA * 128 * 2;
constexpr size_t WS_Z = WS_U + (size_t)TA * 512 * 2;
constexpr size_t WS_QP = WS_Q;
constexpr size_t WS_G = 260 * MiB;
constexpr size_t WS_ATT = 362 * MiB;
constexpr size_t WS_HY = WS_ATT + 17 * MiB, WS_S5O = WS_HY + 17 * MiB, WS_S5Y = WS_S5O + 17 * MiB;
constexpr size_t WS_M = 430 * MiB;
constexpr size_t WS_S5TMP = WS_M;
constexpr size_t WS_S5E = WS_M;
constexpr size_t WS_S5P = WS_M + 16 * MiB;
constexpr size_t WS_S5K = WS_M + 32 * MiB;
constexpr size_t WS_S5A64 = WS_S5A + 64 * 1024;
constexpr size_t WS_S5C = WS_S5A + 128 * 1024;
constexpr size_t WS_X0C = 464 * MiB;
constexpr size_t WS_EID = 481 * MiB;
constexpr size_t WS_EG = WS_EID + (size_t)TA * 128 * 4;
constexpr size_t WS_PU = WS_G;
constexpr size_t WS_PV = WS_G + 16 * MiB;
constexpr float PEER_SU = 512.f, PEER_SV = 64.f;
constexpr size_t WS_PART = WS_QP;
constexpr size_t WS_POUT = WS_ATT;
constexpr size_t WS_HIN = WS_EID;
constexpr size_t WS_END = 498 * MiB;
constexpr int LDS_STAGE = 131072;
constexpr int LDS_MISC = LDS_STAGE;
constexpr int LDS_BYTES = 147456;

struct Params {
    const float* in[40];
    float* out;
    unsigned char* ws;
    int ph_lo, ph_hi;
};
enum { I_X = 0, I_C, I_CTX, I_CCTX, I_MODW, I_MODB, I_N1G, I_N2G, I_INW, I_GATEB, I_SINK, I_HSW, I_HSB, I_HW1, I_HB1, I_HF1, I_HW2, I_HB2, I_HF2, I_HW3,
       I_HBIAS, I_SARE, I_SAIM, I_SLDT, I_SBRE, I_SBIM, I_SCRE, I_SCIM, I_SD, I_GLUW, I_GLUB, I_BRA, I_BRH, I_BRS, I_OUTW, I_WQ, I_PKEYS, I_PU, I_PV, I_FG };

struct Ctx { int tid, bid, nb; };
typedef __attribute__((address_space(4))) const Params CParams;
__device__ __forceinline__ CParams& get_params() { CParams* q = (CParams*)__builtin_amdgcn_kernarg_segment_ptr(); asm volatile("" : "+s"(q)); return *q; }
__device__ __forceinline__ float bf2f(bf16 v) { return __uint_as_float((unsigned)v << 16); }
__device__ __forceinline__ bf16 f2bf(float f) { unsigned u = __float_as_uint(f); return (bf16)((u + 0x7fffu + ((u >> 16) & 1u)) >> 16); }
__device__ __forceinline__ unsigned pk2(float lo, float hi) { return (unsigned)f2bf(lo) | ((unsigned)f2bf(hi) << 16); }
__device__ __forceinline__ float wave_sum(float v) {
#pragma unroll
    for (int o = 32; o > 0; o >>= 1) v += __shfl_xor(v, o);
    return v;
}
__device__ __forceinline__ float fsin_rev(float rev) { return __builtin_amdgcn_sinf(rev); }
__device__ __forceinline__ float fcos_rev(float rev) { return __builtin_amdgcn_cosf(rev); }
__device__ __forceinline__ float fsin(float x) { return __builtin_amdgcn_sinf(x * 0.15915494309189535f); }
__device__ __forceinline__ float fcos(float x) { return __builtin_amdgcn_cosf(x * 0.15915494309189535f); }
__device__ __forceinline__ float sigmoidf_(float x) { return 1.f / (1.f + __expf(-x)); }
__device__ __forceinline__ float gelu_tanh(float x) { const float u = 0.7978845608028654f * (x + 0.044715f * x * x * x); const float e = __expf(2.f * u); return 0.5f * x * (2.f - 2.f / (e + 1.f)); }
__device__ __forceinline__ int row_mi(int r) { return r < TL ? (r >> 12) : 4; }
__device__ __forceinline__ int row_b(int r) { return r < TL ? (r >> 12) : ((r - TL) >> 8); }

#define XB_TMO      128
#define XB_XCNT(j)  (256  + 64 * (j))
#define XB_XSUB(j)  (1280 + 64 * (j))
#define XB_XGEN(j)  (2304 + 64 * (j))
#define XB_TOP      3328
#define XB_TOPGEN   3392
#define XCD_BAR_WORDS 3456
#define XB_SPIN_CAP (1u << 27)
__device__ __forceinline__ unsigned xb_ld(unsigned* p)              { return __hip_atomic_load(p, __ATOMIC_RELAXED, __HIP_MEMORY_SCOPE_AGENT); }
__device__ __forceinline__ unsigned xb_add(unsigned* p, unsigned v) { return __hip_atomic_fetch_add(p, v, __ATOMIC_RELAXED, __HIP_MEMORY_SCOPE_AGENT); }
__device__ __forceinline__ unsigned xb_xcc_id() { return (unsigned)__builtin_amdgcn_s_getreg((3 << 11) | 20) & 0xFu; }
#define XB_SPIN(cond, bar) do { unsigned _sp = 0; while (cond) { __builtin_amdgcn_s_sleep(1); \
    if ((++_sp & 255u) == 0u) { if (xb_ld(&(bar)[XB_TMO])) break; if (_sp > XB_SPIN_CAP) { atomicAdd(&(bar)[XB_TMO], 1u); break; } } } } while (0)
struct XcdBarrier { unsigned* bar; unsigned x; volatile LAS unsigned* st; };
__device__ __forceinline__ XcdBarrier xcd_barrier_post(unsigned* bar, volatile LAS unsigned* st) {
    XcdBarrier b; b.bar = bar; b.x = xb_xcc_id(); b.st = st;
    if (threadIdx.x == 0) (void)xb_add(&bar[XB_XCNT(b.x)], 1u);
    return b;
}
__device__ __forceinline__ void xcd_barrier_complete(unsigned* bar, unsigned x, unsigned& nloc, unsigned& nx) {
    const unsigned G = gridDim.x * gridDim.y * gridDim.z;
    unsigned sum, cnt, mine, sp = 0u;
    for (;;) {
        sum = 0u; cnt = 0u; mine = 0u;
#pragma unroll
        for (unsigned j = 0; j < 16; ++j) { const unsigned c = xb_ld(&bar[XB_XCNT(j)]); sum += c; cnt += (c > 0u) ? 1u : 0u; mine = (j == x) ? c : mine; }
        if (sum == G) break;
        __builtin_amdgcn_s_sleep(1);
        if ((++sp & 255u) == 0u) { if (xb_ld(&bar[XB_TMO])) break; if (sp > XB_SPIN_CAP) { atomicAdd(&bar[XB_TMO], 1u); break; } }
    }
    nloc = mine > 0u ? mine : 1u; nx = cnt > 0u ? cnt : 1u;
}
__device__ __forceinline__ void xcd_barrier(const XcdBarrier& b) {
    asm volatile("s_waitcnt vmcnt(0)" ::: "memory");
    __syncthreads();
    if (threadIdx.x == 0) {
        unsigned* bar = b.bar; asm volatile("" : "+s"(bar));
        __builtin_amdgcn_s_waitcnt(0);
        unsigned nloc = b.st[0], nx = b.st[1];
        if (nloc == 0u) { xcd_barrier_complete(bar, b.x, nloc, nx); b.st[0] = nloc; b.st[1] = nx; }
        const unsigned old = xb_add(&bar[XB_XSUB(b.x)], 1u);
        const unsigned gen = old / nloc;
        if (old + 1u == (gen + 1u) * nloc) {
            __builtin_amdgcn_fence(__ATOMIC_RELEASE, "agent");
            asm volatile("s_waitcnt vmcnt(0)" ::: "memory");
            const unsigned og = xb_add(&bar[XB_TOP], 1u);
            const unsigned tg = og / nx;
            if (og + 1u == (tg + 1u) * nx) xb_add(&bar[XB_TOPGEN], 1u);
            else XB_SPIN(xb_ld(&bar[XB_TOPGEN]) == tg, bar);
            __builtin_amdgcn_fence(__ATOMIC_ACQUIRE, "agent");
            xb_add(&bar[XB_XGEN(b.x)], 1u);
            asm volatile("s_waitcnt vmcnt(0)" ::: "memory");
        } else {
            XB_SPIN(xb_ld(&bar[XB_XGEN(b.x)]) == gen, bar);
            __builtin_amdgcn_fence(__ATOMIC_ACQUIRE, "agent");
            asm volatile("s_waitcnt vmcnt(0)" ::: "memory");
        }
    }
    __syncthreads();
}

__device__ __forceinline__ void ph_prologue(const Ctx& cx0, float* sm) {
    { CParams& p = get_params(); Ctx cx = cx0;
    const int tid = cx.tid, lane = tid & 63, wave = tid >> 6;
    const int gt = cx.bid * NTHREADS + tid, NGT = cx.nb * NTHREADS;
    const int gw = cx.bid * NWAVES + wave, NGW = cx.nb * NWAVES;
    unsigned char* ws = p.ws;
    }
    { CParams& p = get_params(); Ctx cx; cx.tid = threadIdx.x; cx.bid = blockIdx.x; cx.nb = gridDim.x; asm volatile("" : "+v"(cx.tid), "+s"(cx.bid), "+s"(cx.nb));
      const int tid = cx.tid, lane = tid & 63, wave = tid >> 6; const int gt = cx.bid * NTHREADS + tid, NGT = cx.nb * NTHREADS; const int gw = cx.bid * NWAVES + wave, NGW = cx.nb * NWAVES; unsigned char* ws = p.ws; (void)lane; (void)gt; (void)NGT; (void)gw; (void)NGW; (void)ws;
    {
        float* sil = sm;
        float* red = sm + 5 * 1024;
        bool have = false;
        for (int it = cx.bid; it < 192; it += cx.nb) {
            if (!have) {
                for (int i = tid; i < 5 * 1024; i += NTHREADS) { const float v = i < 4096 ? p.in[I_C][i] : p.in[I_CCTX][i - 4096]; sil[i] = v / (1.f + __expf(-v)); }
                have = true; __syncthreads();
            }
            const int layer = it / 96, col = (it % 96) * 64 + lane, kp = wave;
            const float* W = p.in[I_MODW] + (size_t)layer * DM * 6144 + col;
            float a0 = 0, a1 = 0, a2 = 0, a3 = 0, a4 = 0;
            for (int k = kp * 128; k < kp * 128 + 128; ++k) { const float w = W[(size_t)k * 6144]; a0 += sil[k] * w; a1 += sil[1024 + k] * w; a2 += sil[2048 + k] * w; a3 += sil[3072 + k] * w; a4 += sil[4096 + k] * w; }
            red[(kp * 5 + 0) * 64 + lane] = a0; red[(kp * 5 + 1) * 64 + lane] = a1; red[(kp * 5 + 2) * 64 + lane] = a2; red[(kp * 5 + 3) * 64 + lane] = a3; red[(kp * 5 + 4) * 64 + lane] = a4;
            __syncthreads();
            if (tid < 320) { const int j = tid >> 6; float s = 0; for (int q = 0; q < 8; ++q) s += red[(q * 5 + j) * 64 + lane];
                ((float*)(ws + WS_MODV))[((size_t)layer * 5 + j) * 6144 + col] = s + p.in[I_MODB][layer * 6144 + col]; }
            __syncthreads();
        }
    }
    }
    { CParams& p = get_params(); Ctx cx; cx.tid = threadIdx.x; cx.bid = blockIdx.x; cx.nb = gridDim.x; asm volatile("" : "+v"(cx.tid), "+s"(cx.bid), "+s"(cx.nb));
      const int tid = cx.tid, lane = tid & 63, wave = tid >> 6; const int gt = cx.bid * NTHREADS + tid, NGT = cx.nb * NTHREADS; const int gw = cx.bid * NWAVES + wave, NGW = cx.nb * NWAVES; unsigned char* ws = p.ws; (void)lane; (void)gt; (void)NGT; (void)gw; (void)NGW; (void)ws;
    for (int i = gt; i < 64 * 16; i += NGT) { const int pos = i >> 4, f = i & 15; const float ang = (float)pos * exp2f(-(float)f * (13.287712379549449f / 16.f));
        ((float*)(ws + WS_ROPE))[i * 2] = fcos(ang); ((float*)(ws + WS_ROPE))[i * 2 + 1] = fsin(ang); }
    }
    { CParams& p = get_params(); Ctx cx; cx.tid = threadIdx.x; cx.bid = blockIdx.x; cx.nb = gridDim.x; asm volatile("" : "+v"(cx.tid), "+s"(cx.bid), "+s"(cx.nb));
      const int tid = cx.tid, lane = tid & 63, wave = tid >> 6; const int gt = cx.bid * NTHREADS + tid, NGT = cx.nb * NTHREADS; const int gw = cx.bid * NWAVES + wave, NGW = cx.nb * NWAVES; unsigned char* ws = p.ws; (void)lane; (void)gt; (void)NGT; (void)gw; (void)NGW; (void)ws;
    for (int i = gt; i < 2 * 2 * 32 * 64; i += NGT) {
        const int g = (i >> 6) & 31, ld = i >> 11;
        const float are = fminf(p.in[I_SARE][i], -1e-4f), aim = p.in[I_SAIM][i];
        const float dt = __expf(p.in[I_SLDT][ld * 32 + g]);
        const float er = __expf(are * dt), abr = er * fcos(aim * dt), abi = er * fsin(aim * dt);
        const float nr = abr - 1.0f, ni = abi, den = are * are + aim * aim;
        const float cr = (nr * are + ni * aim) / den, ci = (ni * are - nr * aim) / den;
        ((float*)(ws + WS_S5A))[i * 2] = abr; ((float*)(ws + WS_S5A))[i * 2 + 1] = abi;
        ((float*)(ws + WS_S5C))[i * 2] = are * dt; ((float*)(ws + WS_S5C))[i * 2 + 1] = aim * dt;
        for (int h = 0; h < 16; ++h) { const float br = p.in[I_SBRE][(size_t)i * 16 + h], bi = p.in[I_SBIM][(size_t)i * 16 + h];
            ((float*)(ws + WS_S5B))[((size_t)i * 16 + h) * 2] = cr * br - ci * bi; ((float*)(ws + WS_S5B))[((size_t)i * 16 + h) * 2 + 1] = cr * bi + ci * br; }
    }
    }
}


__device__ __forceinline__ void ph_filters(const Ctx& cx, int layer, float* sm) {
    CParams& p = get_params();
    const int tid = cx.tid, lane = tid & 63, wave = __builtin_amdgcn_readfirstlane(tid >> 6), l15 = lane & 15, kg = lane >> 4;
    bf16* Hb = (bf16*)sm;
    float* W12 = sm + 64 * 72 / 2;
    const float* w1 = p.in[I_HW1] + layer * 33 * 64; const float* w2 = p.in[I_HW2] + layer * 64 * 64; const float* w3 = p.in[I_HW3] + layer * 64 * 1024;
    for (int it = cx.bid; it < 2 * 68; it += cx.nb) {
        const int tile = it >> 1, ch = it & 1, st = tile >= 64 ? 1 : 0, tb = st ? (tile - 64) * 64 : tile * 64, L = st ? CTXL : SEQ;
        __syncthreads();
        for (int i = tid; i < 97 * 64; i += NTHREADS) W12[i] = i < 33 * 64 ? w1[i] : w2[i - 33 * 64];
        bf16x8 bw[4][2];
#pragma unroll
        for (int nt = 0; nt < 4; ++nt)
#pragma unroll
            for (int ks = 0; ks < 2; ++ks) { const float* s = w3 + (size_t)(32 * ks + 8 * kg) * 1024 + ch * 512 + wave * 64 + 16 * nt + l15;
                u32x4 w; w.x = pk2(s[0], s[1024]); w.y = pk2(s[2048], s[3072]); w.z = pk2(s[4096], s[5120]); w.w = pk2(s[6144], s[7168]); bw[nt][ks] = __builtin_bit_cast(bf16x8, w); }
        __syncthreads();
        {
            float z[8], a[8], h1[8], a2[8];
            const float b1 = p.in[I_HB1][layer * 64 + lane], f1 = p.in[I_HF1][layer * 64 + lane], b2 = p.in[I_HB2][layer * 64 + lane], f2 = p.in[I_HF2][layer * 64 + lane];
#pragma unroll
            for (int q = 0; q < 8; ++q) { const float tn = (float)(tb + wave + 8 * q) / (float)L; z[q] = 0.f;
                if (lane == 0) z[q] = tn; else if (lane <= 16) z[q] = fcos_rev(tn * (float)lane); else if (lane <= 32) z[q] = fsin_rev(tn * (float)(lane - 16)); a[q] = b1; }
#pragma unroll 3
            for (int e = 0; e < 33; ++e) { const float w = W12[e * 64 + lane];
#pragma unroll
                for (int q = 0; q < 8; ++q) a[q] += __shfl(z[q], e) * w; }
#pragma unroll
            for (int q = 0; q < 8; ++q) { h1[q] = fsin(f1 * a[q]); a2[q] = b2; }
#pragma unroll 4
            for (int j = 0; j < 64; ++j) { const float w = W12[33 * 64 + j * 64 + lane];
#pragma unroll
                for (int q = 0; q < 8; ++q) a2[q] += __shfl(h1[q], j) * w; }
#pragma unroll
            for (int q = 0; q < 8; ++q) Hb[(wave + 8 * q) * 72 + lane] = f2bf(fsin(f2 * a2[q]));
        }
        __syncthreads();
        float* fbase = (float*)(p.ws + WS_FILT + (st ? FILT_CTX_OFF : 0));
#pragma unroll
        for (int mt = 0; mt < 4; ++mt) {
            bf16x8 af[2];
#pragma unroll
            for (int ks = 0; ks < 2; ++ks) af[ks] = *(const bf16x8*)(Hb + (16 * mt + l15) * 72 + 32 * ks + 8 * kg);
            const int t0 = tb + 16 * mt + 4 * kg;
            f32x4 tw;
#pragma unroll
            for (int r = 0; r < 4; ++r) tw[r] = (float)(t0 + r) / (float)(L - 1);
#pragma unroll
            for (int nt = 0; nt < 4; ++nt) {
                f32x4 acc = (f32x4){0.f, 0.f, 0.f, 0.f};
                acc = __builtin_amdgcn_mfma_f32_16x16x32_bf16(af[0], bw[nt][0], acc, 0, 0, 0); acc = __builtin_amdgcn_mfma_f32_16x16x32_bf16(af[1], bw[nt][1], acc, 0, 0, 0);
                const int c = wave * 64 + 16 * nt + l15;
                const float rate = HY_FAST + (HY_SLOW - HY_FAST) * ((float)c / 511.f);
                f32x4 o;
#pragma unroll
                for (int r = 0; r < 4; ++r) o[r] = acc[r] * __expf(-tw[r] * rate);
                *(f32x4*)(fbase + ((size_t)ch * 512 + c) * L + t0) = o;
            }
        }
    }
}
__device__ __forceinline__ void conv_T(const Ctx& cx, const float* W, int K, int N, bf16* dst, bool perm) {
    const int gt = cx.bid * NTHREADS + cx.tid, NGT = cx.nb * NTHREADS;
    for (int it = gt; it < N * (K / 8); it += NGT) {
        const int n = it % N, k0 = (it / N) * 8;
        const int sn = (perm && n < COL_V) ? ((n & ~63) + ((n & 63) >> 1) + 32 * (n & 1)) : n;
        const float* s = W + (size_t)k0 * N + sn;
        u32x4 w; w.x = pk2(s[0], s[N]); w.y = pk2(s[2 * (size_t)N], s[3 * (size_t)N]); w.z = pk2(s[4 * (size_t)N], s[5 * (size_t)N]); w.w = pk2(s[6 * (size_t)N], s[7 * (size_t)N]);
        *(u32x4*)(dst + (size_t)n * K + k0) = w;
    }
}
__device__ __forceinline__ void ph_convert(const Ctx& cx0, int layer) {
#define RELAUNDER() CParams& p = get_params(); Ctx cx; cx.tid = threadIdx.x; cx.bid = __builtin_amdgcn_readfirstlane(cx0.bid); cx.nb = __builtin_amdgcn_readfirstlane(cx0.nb); asm volatile("" : "+v"(cx.tid), "+s"(cx.bid), "+s"(cx.nb));
    { RELAUNDER(); conv_T(cx, p.in[I_INW] + (size_t)layer * DM * INW, DM, INW, (bf16*)(p.ws + WT_IN) + (size_t)layer * INW * DM, true); }
    { RELAUNDER(); conv_T(cx, p.in[I_GLUW] + (size_t)layer * 512 * 512, 512, 512, (bf16*)(p.ws + WT_GLU) + (size_t)layer * 512 * 512, false); }
    { RELAUNDER(); conv_T(cx, p.in[I_BRA] + (size_t)layer * 512 * 1024, 512, 1024, (bf16*)(p.ws + WT_BR) + (size_t)(layer * 3 + 0) * 1024 * 512, false); }
    { RELAUNDER(); conv_T(cx, p.in[I_BRH] + (size_t)layer * 512 * 1024, 512, 1024, (bf16*)(p.ws + WT_BR) + (size_t)(layer * 3 + 1) * 1024 * 512, false); }
    { RELAUNDER(); conv_T(cx, p.in[I_BRS] + (size_t)layer * 512 * 1024, 512, 1024, (bf16*)(p.ws + WT_BR) + (size_t)(layer * 3 + 2) * 1024 * 512, false); }
    { RELAUNDER(); conv_T(cx, p.in[I_OUTW] + (size_t)layer * 1024 * 1024, 1024, 1024, (bf16*)(p.ws + WT_OUT) + (size_t)layer * 1024 * 1024, false); }
    { RELAUNDER(); conv_T(cx, p.in[I_WQ] + (size_t)layer * 1024 * 2048, 1024, 2048, (bf16*)(p.ws + WT_WQ) + (size_t)layer * 2048 * 1024, false); }
    if (layer == 0) { RELAUNDER(); const int gt = cx.bid * NTHREADS + cx.tid, NGT = cx.nb * NTHREADS;
      for (int i = gt; i < 2 * 8 * 2 * 128 * 128 / 4; i += NGT) { const f32x4 v = ((const f32x4*)p.in[I_PKEYS])[i]; u32x2 w; w.x = pk2(v[0], v[1]); w.y = pk2(v[2], v[3]);
          const int k4 = i & 31, n = (i >> 5) & 127, lhs = i >> 12;
          ((u32x2*)(p.ws + WT_KEYS))[(((size_t)lhs * 8 + (k4 >> 2)) * 128 + n) * 4 + (k4 & 3)] = w; } }
#undef RELAUNDER
}

__device__ __forceinline__ void ph_norm(const Ctx& cx, int layer, int which, int nrows_lat_only) {
    CParams& p = get_params();
    const int lane = cx.tid & 63, wave = cx.tid >> 6;
    const int gw = cx.bid * NWAVES + wave, NGW = cx.nb * NWAVES;
    const float* g = p.in[which ? I_N2G : I_N1G] + layer * DM;
    const float* xc = (const float*)(p.ws + WS_XCUR);
    bf16* H = (bf16*)(p.ws + WS_H);
    const int nrows = nrows_lat_only ? TL : TA;
    for (int r = gw; r < nrows; r += NGW) {
        const float* mv = (const float*)(p.ws + WS_MODV) + ((size_t)layer * 5 + row_mi(r)) * 6144 + (which ? 3072 : 0);
        f32x4 v[4]; float s = 0.f;
        const float* xr = (which == 0 && layer == 0) ? (r < TL ? p.in[I_X] + (size_t)r * DM : p.in[I_CTX] + (size_t)(r - TL) * DM) : xc + (size_t)r * DM;
#pragma unroll
        for (int j = 0; j < 4; ++j) { v[j] = *(const f32x4*)(xr + j * 256 + lane * 4); s += v[j].x * v[j].x + v[j].y * v[j].y + v[j].z * v[j].z + v[j].w * v[j].w; }
        const float rs = rsqrtf(wave_sum(s) * (1.f / DM) + NORM_EPS);
#pragma unroll
        for (int j = 0; j < 4; ++j) { const int c = j * 256 + lane * 4;
            const f32x4 gg = *(const f32x4*)(g + c), sh = *(const f32x4*)(mv + c), sc = *(const f32x4*)(mv + 1024 + c);
            const f32x4 y = v[j] * rs * gg; const f32x4 h = y * (1.f + sc) + sh;
            u32x2 w; w.x = pk2(h.x, h.y); w.y = pk2(h.z, h.w); *(u32x2*)(H + (size_t)r * DM + c) = w; }
    }
}


namespace pg8 {
#define PG8_LAS __attribute__((address_space(3)))
typedef unsigned short bf16_t;
typedef short bf16x8 __attribute__((ext_vector_type(8)));
constexpr int BM = 256, BK = 64, HALF = 128, HTB = HALF * BK * 2, STAGE_BYTES = 8 * HTB, NXCD = 8, WGM = 8;
__host__ __device__ __forceinline__ int lds_byte(int r, int c) { const int st = (r >> 4) * 2 + (c >> 5), rr = r & 15, cc = c & 31, ob = rr * 64 + cc * 2; return st * 1024 + (ob ^ (((ob >> 9) & 1) << 5)); }
__host__ __device__ __forceinline__ void stage_rc(int b, int& R, int& C) { const int st = b / 1024, sb = b % 1024, swz = sb ^ (((sb >> 9) & 1) << 5); R = (st >> 1) * 16 + swz / 64; C = (st & 1) * 32 + (swz % 64) / 2; }
__host__ __device__ __forceinline__ int perm32(int rho) { const int n = rho >> 4, i = rho & 15; return 8 * (i >> 2) + 4 * n + (i & 3); }
struct Unit { int pm, pn, z; };
struct Gemm { const bf16_t* A; const bf16_t* Bt; size_t zsA, zsB; int K; };
__device__ __forceinline__ const bf16_t* selA(const Gemm& g, int z) { return g.A + (size_t)z * g.zsA; }
__device__ __forceinline__ const bf16_t* selB(const Gemm& g, int z) { return g.Bt + (size_t)z * g.zsB; }
struct TileOrder {
    int nM, nN, nwg, G, c, extra, exN, expn0, nz;
    __device__ __forceinline__ bool next(int i, Unit& u) const {
        const int ti = i / nz; u.z = i - ti * nz;
        const long L = (long)ti * G + c;
        if (L < nwg) {
            int wgid = (int)L; { const int q = nwg / NXCD, r = nwg % NXCD, xcd = wgid % NXCD, off = wgid / NXCD; wgid = (xcd < r ? xcd * (q + 1) : r * (q + 1) + (xcd - r) * q) + off; }
            const int nig = WGM * nN, gid = wgid / nig, fm = gid * WGM, gsz = (nM - fm) < WGM ? (nM - fm) : WGM;
            u.pm = fm + ((wgid % nig) % gsz); u.pn = (wgid % nig) / gsz; return true;
        }
        const int e = (int)(L - nwg); if (e >= extra) return false;
        u.pm = nM + e / exN; u.pn = expn0 + e % exN; return true;
    }
};
__device__ __forceinline__ unsigned cvt_pk_bf16(float lo, float hi) { unsigned r; asm volatile("v_cvt_pk_bf16_f32 %0, %1, %2" : "=v"(r) : "v"(lo), "v"(hi)); return r; }
template <class Epi, class Sched, bool ALIGN_EPI = true, bool SP2 = true>
__device__ __forceinline__ void gemm_phase(PG8_LAS unsigned char* lds, const Gemm g, const Sched& S, const Epi& E, const int tid_) {
    const int tid = tid_, wid = __builtin_amdgcn_readfirstlane(tid >> 6), lane = tid & 63, wr = wid >> 2, wc = wid & 3, fr = lane & 15, fq = lane >> 4;
    const int K = g.K, nt = K / BK;
    unsigned voffA[2], voffB[2];
#pragma unroll
    for (int i = 0; i < 2; ++i) { int R, C; stage_rc(tid * 16 + i * 8192, R, C); const int Rb = Epi::PERM ? ((R & ~31) + perm32(R & 31)) : R;
        voffA[i] = (unsigned)(R * K + C) * 2u; voffB[i] = (unsigned)(Rb * K + C) * 2u; }
    const size_t kstep = (size_t)(BK * 2);
    const size_t hstep = (size_t)HALF * K * 2;
    const size_t tstep = 2 * hstep;
    const unsigned ldsw = (unsigned)wid * 1024u;
    const int aoff = lds_byte(wr * 64 + fr, fq * 8), boff = lds_byte(wc * 32 + fr, fq * 8);
#define PG8_SA(b, h) (((b) * 2 + (h)) * HTB)
#define PG8_SB(b, h) ((4 + (b) * 2 + (h)) * HTB)
#define PG8_STAGE(bufoff, gbase, voff) do { _Pragma("unroll") for (int _i = 0; _i < 2; ++_i) \
        __builtin_amdgcn_global_load_lds((const unsigned*)((const char*)(gbase) + (voff)[_i]), (PG8_LAS unsigned*)(lds + (bufoff) + ldsw + _i * 8192), 16, 0, 0); } while (0)
#define PG8_LDA(dst, b, h) do { _Pragma("unroll") for (int m = 0; m < 4; ++m) _Pragma("unroll") for (int k = 0; k < 2; ++k) dst[m][k] = *(const PG8_LAS bf16x8*)(lds + PG8_SA(b, h) + aoff + m * 2048 + k * 1024); } while (0)
#define PG8_LDB(dst, b, h) do { _Pragma("unroll") for (int n = 0; n < 2; ++n) _Pragma("unroll") for (int k = 0; k < 2; ++k) dst[n][k] = *(const PG8_LAS bf16x8*)(lds + PG8_SB(b, h) + boff + n * 2048 + k * 1024); } while (0)
#define PG8_MMA(ai, bj, At, Bt) do { __builtin_amdgcn_s_setprio(1); _Pragma("unroll") for (int m = 0; m < 4; ++m) _Pragma("unroll") for (int n = 0; n < 2; ++n) _Pragma("unroll") for (int k = 0; k < 2; ++k) \
        acc[ai][bj][m][n] = __builtin_amdgcn_mfma_f32_16x16x32_bf16(Bt[n][k], At[m][k], acc[ai][bj][m][n], 0, 0, 0); __builtin_amdgcn_s_setprio(0); } while (0)
#define PG8_WAIT_V(n) asm volatile("s_waitcnt vmcnt(" #n ")" ::: "memory")
#define PG8_WAIT_L(n) asm volatile("s_waitcnt lgkmcnt(" #n ")" ::: "memory")
#define PG8_BAR __builtin_amdgcn_s_barrier()
#define PG8_SCHED __builtin_amdgcn_sched_barrier(0)
    Unit cur, nxt; int ui = 0;
    if (!S.next(0, cur)) return;
    f32x4 acc[2][2][4][2];
#pragma unroll
    for (int a = 0; a < 2; ++a)
#pragma unroll
        for (int b = 0; b < 2; ++b)
#pragma unroll
            for (int m = 0; m < 4; ++m)
#pragma unroll
                for (int n = 0; n < 2; ++n) acc[a][b][m][n] = (f32x4){0.f, 0.f, 0.f, 0.f};
    bf16x8 At[4][2], B0[2][2], B1[2][2];
    const char* cA = (const char*)selA(g, cur.z) + (size_t)cur.pm * tstep; const char* cB = (const char*)selB(g, cur.z) + (size_t)cur.pn * tstep;
    if constexpr (SP2) {
        PG8_STAGE(PG8_SB(0, 0), cB, voffB); PG8_STAGE(PG8_SB(0, 1), cB + hstep, voffB); PG8_STAGE(PG8_SA(0, 0), cA, voffA); PG8_STAGE(PG8_SA(0, 1), cA + hstep, voffA);
        if (wr == 1) PG8_BAR;
        PG8_WAIT_V(2); PG8_BAR;
        PG8_STAGE(PG8_SB(1, 0), cB + kstep, voffB); PG8_STAGE(PG8_SA(1, 0), cA + kstep, voffA); PG8_STAGE(PG8_SB(1, 1), cB + hstep + kstep, voffB);
        PG8_WAIT_V(6); PG8_BAR;
    } else {
        PG8_STAGE(PG8_SB(0, 0), cB, voffB); PG8_STAGE(PG8_SA(0, 0), cA, voffA); PG8_STAGE(PG8_SB(0, 1), cB + hstep, voffB); PG8_STAGE(PG8_SA(0, 1), cA + hstep, voffA);
        if (wr == 1) PG8_BAR;
        PG8_WAIT_V(4); PG8_BAR;
        PG8_STAGE(PG8_SB(1, 0), cB + kstep, voffB); PG8_STAGE(PG8_SA(1, 0), cA + kstep, voffA); PG8_STAGE(PG8_SB(1, 1), cB + hstep + kstep, voffB);
        PG8_WAIT_V(6); PG8_BAR;
    }
    for (;;) {
        const bool has_next = S.next(ui + 1, nxt);
        const char* nA = has_next ? (const char*)selA(g, nxt.z) + (size_t)nxt.pm * tstep : cA; const char* nB = has_next ? (const char*)selB(g, nxt.z) + (size_t)nxt.pn * tstep : cB;
        for (int t = 0; t < nt; t += 2) {
            const bool last = (t == nt - 2);
            const char* a1 = cA + (size_t)(t + 1) * kstep;
            const char* a2 = last ? nA : cA + (size_t)(t + 2) * kstep; const char* b2 = last ? nB : cB + (size_t)(t + 2) * kstep;
            const char* a3 = a2 + kstep; const char* b3 = b2 + kstep;
            if constexpr (SP2) {
            PG8_LDB(B0, 0, 0); PG8_LDB(B1, 0, 1); PG8_SCHED; PG8_LDA(At, 0, 0); PG8_STAGE(PG8_SA(1, 1), a1 + hstep, voffA);
            PG8_WAIT_V(8); PG8_WAIT_L(0); PG8_BAR; PG8_MMA(0, 0, At, B0); PG8_MMA(0, 1, At, B1); PG8_BAR; PG8_SCHED;
            PG8_LDA(At, 0, 1); PG8_STAGE(PG8_SB(0, 0), b2, voffB); PG8_STAGE(PG8_SB(0, 1), b2 + hstep, voffB); PG8_STAGE(PG8_SA(0, 0), a2, voffA);
            PG8_WAIT_V(8); PG8_WAIT_L(0); PG8_BAR; PG8_MMA(1, 0, At, B0); PG8_MMA(1, 1, At, B1); PG8_BAR; PG8_SCHED;
            PG8_LDB(B0, 1, 0); PG8_LDB(B1, 1, 1); PG8_SCHED; PG8_LDA(At, 1, 0); PG8_STAGE(PG8_SA(0, 1), a2 + hstep, voffA);
            PG8_WAIT_V(8); PG8_WAIT_L(0); PG8_BAR; PG8_MMA(0, 0, At, B0); PG8_MMA(0, 1, At, B1); PG8_BAR; PG8_SCHED;
            PG8_LDA(At, 1, 1); PG8_STAGE(PG8_SB(1, 0), b3, voffB); PG8_STAGE(PG8_SB(1, 1), b3 + hstep, voffB); PG8_STAGE(PG8_SA(1, 0), a3, voffA);
            PG8_WAIT_V(8); PG8_WAIT_L(0); PG8_BAR; PG8_MMA(1, 0, At, B0); PG8_MMA(1, 1, At, B1); PG8_BAR; PG8_SCHED;
            } else {
            PG8_LDB(B0, 0, 0); PG8_SCHED; PG8_LDA(At, 0, 0); PG8_STAGE(PG8_SA(1, 1), a1 + hstep, voffA);
            PG8_WAIT_L(8); PG8_BAR; PG8_WAIT_L(0); PG8_MMA(0, 0, At, B0); PG8_BAR; PG8_SCHED;
            PG8_LDB(B1, 0, 1); PG8_STAGE(PG8_SB(0, 0), b2, voffB);
            PG8_BAR; PG8_WAIT_L(0); PG8_MMA(0, 1, At, B1); PG8_BAR;
            PG8_LDA(At, 0, 1); PG8_STAGE(PG8_SA(0, 0), a2, voffA);
            PG8_BAR; PG8_WAIT_L(0); PG8_MMA(1, 0, At, B0); PG8_BAR; PG8_SCHED;
            PG8_STAGE(PG8_SB(0, 1), b2 + hstep, voffB);
            PG8_WAIT_V(6); PG8_BAR; PG8_MMA(1, 1, At, B1); PG8_BAR;
            PG8_LDB(B0, 1, 0); PG8_SCHED; PG8_LDA(At, 1, 0); PG8_STAGE(PG8_SA(0, 1), a2 + hstep, voffA);
            PG8_WAIT_L(8); PG8_BAR; PG8_WAIT_L(0); PG8_MMA(0, 0, At, B0); PG8_BAR; PG8_SCHED;
            PG8_LDB(B1, 1, 1); PG8_STAGE(PG8_SB(1, 0), b3, voffB);
            PG8_BAR; PG8_WAIT_L(0); PG8_MMA(0, 1, At, B1); PG8_BAR;
            PG8_LDA(At, 1, 1); PG8_STAGE(PG8_SA(1, 0), a3, voffA);
            PG8_BAR; PG8_WAIT_L(0); PG8_MMA(1, 0, At, B0); PG8_BAR; PG8_SCHED;
            PG8_STAGE(PG8_SB(1, 1), b3 + hstep, voffB);
            PG8_WAIT_V(6); PG8_BAR; PG8_MMA(1, 1, At, B1); PG8_BAR;
            }
        }
        if constexpr (ALIGN_EPI) { if (wr == 0) PG8_BAR; }
        const bool keep = E(acc, cur, wr, wc, fr, fq);
        if (!has_next) break;
        if (!keep) {
#pragma unroll
        for (int a = 0; a < 2; ++a)
#pragma unroll
            for (int b = 0; b < 2; ++b)
#pragma unroll
                for (int m = 0; m < 4; ++m)
#pragma unroll
                    for (int n = 0; n < 2; ++n) acc[a][b][m][n] = (f32x4){0.f, 0.f, 0.f, 0.f};
        }
        cur = nxt; cA = nA; cB = nB; ++ui;
        if constexpr (ALIGN_EPI) { if (wr == 1) PG8_BAR; }
    }
    PG8_WAIT_V(0);
    if constexpr (!ALIGN_EPI) { if (wr == 0) PG8_BAR; }
    PG8_BAR;
#undef PG8_SA
#undef PG8_SB
#undef PG8_STAGE
#undef PG8_LDA
#undef PG8_LDB
#undef PG8_MMA
#undef PG8_WAIT_V
#undef PG8_WAIT_L
#undef PG8_BAR
#undef PG8_SCHED
}
}

__device__ __forceinline__ f32x4 bf4lo(u32x4 w) { return (f32x4){__uint_as_float(w.x << 16), __uint_as_float(w.x & 0xffff0000u), __uint_as_float(w.y << 16), __uint_as_float(w.y & 0xffff0000u)}; }
__device__ __forceinline__ f32x4 bf4hi(u32x4 w) { return (f32x4){__uint_as_float(w.z << 16), __uint_as_float(w.z & 0xffff0000u), __uint_as_float(w.w << 16), __uint_as_float(w.w & 0xffff0000u)}; }
__device__ __forceinline__ u32x4 pack8(f32x4 a, f32x4 b) { u32x4 w; w.x = pg8::cvt_pk_bf16(a[0], a[1]); w.y = pg8::cvt_pk_bf16(a[2], a[3]); w.z = pg8::cvt_pk_bf16(b[0], b[1]); w.w = pg8::cvt_pk_bf16(b[2], b[3]); return w; }
__device__ __forceinline__ f32x4 sig4(f32x4 v) { return (f32x4){sigmoidf_(v[0]), sigmoidf_(v[1]), sigmoidf_(v[2]), sigmoidf_(v[3])}; }

__device__ __forceinline__ size_t s5_uidx(int g, int b, int n, int s) { return ((((size_t)(g * 4 + b) * 64 + s) * 68 + n) * 16); }
template <class T> __device__ __forceinline__ T* uni_ptr(T* q) { unsigned long long a = (unsigned long long)q; unsigned lo = __builtin_amdgcn_readfirstlane((unsigned)a), hi = __builtin_amdgcn_readfirstlane((unsigned)(a >> 32));
    asm volatile("" : "+s"(lo), "+s"(hi)); return (T*)(((unsigned long long)hi << 32) | lo); }
struct EpiInproj {
    static constexpr bool PERM = true;
    unsigned char* ws; const float* gate_b;
    __device__ __forceinline__ bool operator()(f32x4 (&acc)[2][2][4][2], const pg8::Unit& u, int wr, int wc, int fr_, int fq_) const {
        int fr = fr_, fq = fq_; asm volatile("" : "+v"(fr), "+v"(fq)); unsigned char* const ws = uni_ptr(this->ws);
        const int cl = wc * 32 + 8 * fq, rbase = u.pm * 256 + wr * 64 + fr;
#pragma unroll
        for (int bj = 0; bj < 2; ++bj) {
            const int c128 = u.pn * 256 + bj * 128;
            unsigned char* base; unsigned rstride, coff; int kind = 0;
            if (c128 < COL_K)         { base = ws + WS_Q; rstride = 1024; coff = (unsigned)(c128 + cl) * 2u; kind = 1; }
            else if (c128 < COL_V)    { base = ws + WS_K + (size_t)(cl >> 5) * TA * 64; rstride = 64; coff = (unsigned)(cl & 31) * 2u; kind = 1; }
            else if (c128 < COL_S5)   { base = ws + WS_V; rstride = 256;  coff = (unsigned)cl * 2u; }
            else if (c128 < COL_HY)   { base = ws + WS_U; rstride = 0; coff = 0; kind = 3; }
            else if (c128 < COL_GATE) { base = ws + WS_Z; rstride = 3072; coff = (unsigned)(c128 - COL_HY + cl) * 2u; }
            else                      { base = ws + WS_G; rstride = 6144; coff = (unsigned)(c128 - COL_GATE + cl) * 2u; kind = 2; }
            if (kind == 1) {
                const float* rope = (const float*)(ws + WS_ROPE) + 8 * fq;
#pragma unroll
                for (int ai = 0; ai < 2; ++ai)
#pragma unroll
                    for (int m = 0; m < 4; ++m) {
                        const int r = rbase + ai * 128 + m * 16;
                        f32x4 v0 = acc[ai][bj][m][0], v1 = acc[ai][bj][m][1];
                        if (r < TL) { const int l = r & 4095, pos = (wc & 1) ? (l & 63) : (l >> 6);
                            const f32x4 t0 = *(const f32x4*)(rope + pos * 32), t1 = *(const f32x4*)(rope + pos * 32 + 4);
                            v0 = (f32x4){v0[0] * t0[0] - v0[1] * t0[1], v0[0] * t0[1] + v0[1] * t0[0], v0[2] * t0[2] - v0[3] * t0[3], v0[2] * t0[3] + v0[3] * t0[2]};
                            v1 = (f32x4){v1[0] * t1[0] - v1[1] * t1[1], v1[0] * t1[1] + v1[1] * t1[0], v1[2] * t1[2] - v1[3] * t1[3], v1[2] * t1[3] + v1[3] * t1[2]}; }
                        *(u32x4*)(base + ((unsigned)r * rstride + coff)) = pack8(v0, v1);
                        asm volatile("" ::: "memory");
                    }
            } else if (kind == 2) {
                const float* gb = uni_ptr(gate_b) + (c128 - COL_GATE) + cl; const f32x4 b0 = *(const f32x4*)gb, b1 = *(const f32x4*)(gb + 4);
#pragma unroll
                for (int ai = 0; ai < 2; ++ai)
#pragma unroll
                    for (int m = 0; m < 4; ++m) {
                        const int r = rbase + ai * 128 + m * 16;
                        *(u32x4*)(base + ((unsigned)r * rstride + coff)) = pack8(sig4(acc[ai][bj][m][0] + b0), sig4(acc[ai][bj][m][1] + b1));
                        asm volatile("" ::: "memory");
                    }
            } else if (kind == 3) {
                const int ch = c128 - COL_S5 + cl, g = ch >> 4, i0 = ch & 15;
#pragma unroll
                for (int ai = 0; ai < 2; ++ai)
#pragma unroll
                    for (int m = 0; m < 4; ++m) {
                        const int r = rbase + ai * 128 + m * 16; int b, n, s;
                        if (r < TL) { b = r >> 12; n = 4 + ((r & 4095) >> 6); s = r & 63; } else { const int j = r - TL; b = j >> 8; n = (j & 255) >> 6; s = j & 63; }
                        *(u32x4*)((bf16*)base + s5_uidx(g, b, n, s) + i0) = pack8(acc[ai][bj][m][0], acc[ai][bj][m][1]);
                    }
            } else {
#pragma unroll
                for (int ai = 0; ai < 2; ++ai)
#pragma unroll
                    for (int m = 0; m < 4; ++m) {
                        const int r = rbase + ai * 128 + m * 16;
                        *(u32x4*)(base + ((unsigned)r * rstride + coff)) = pack8(acc[ai][bj][m][0], acc[ai][bj][m][1]);
                    }
            }
        }
        return false;
    }
};
struct EpiGlu {
    static constexpr bool PERM = true;
    unsigned char* ws; const float* bias;
    __device__ __forceinline__ bool operator()(f32x4 (&acc)[2][2][4][2], const pg8::Unit& u, int wr, int wc, int fr_, int fq_) const {
        int fr = fr_, fq = fq_; asm volatile("" : "+v"(fr), "+v"(fq)); unsigned char* const ws = uni_ptr(this->ws);
#pragma unroll
        for (int bj = 0; bj < 2; ++bj) { const int c = u.pn * 256 + bj * 128 + wc * 32 + 8 * fq; const f32x4 b0 = *(const f32x4*)(bias + c), b1 = *(const f32x4*)(bias + c + 4);
#pragma unroll
            for (int ai = 0; ai < 2; ++ai)
#pragma unroll
                for (int m = 0; m < 4; ++m) { const size_t o = (size_t)(u.pm * 256 + ai * 128 + wr * 64 + m * 16 + fr) * 512 + c;
                    const u32x4 yw = *(const u32x4*)((const bf16*)(ws + WS_S5Y) + o);
                    *(u32x4*)((bf16*)(ws + WS_S5O) + o) = pack8(bf4lo(yw) * sig4(acc[ai][bj][m][0] + b0), bf4hi(yw) * sig4(acc[ai][bj][m][1] + b1)); asm volatile("" ::: "memory"); } }
        return false;
    }
};
struct EpiMerge {
    static constexpr bool PERM = true;
    unsigned char* ws;
    __device__ __forceinline__ bool operator()(f32x4 (&acc)[2][2][4][2], const pg8::Unit& u, int wr, int wc, int fr_, int fq_) const {
        int fr = fr_, fq = fq_; asm volatile("" : "+v"(fr), "+v"(fq)); unsigned char* const ws = uni_ptr(this->ws);
#pragma unroll
        for (int bj = 0; bj < 2; ++bj) { const int c = u.pn * 256 + bj * 128 + wc * 32 + 8 * fq;
#pragma unroll
            for (int ai = 0; ai < 2; ++ai)
#pragma unroll
                for (int m = 0; m < 4; ++m) { const int r = u.pm * 256 + ai * 128 + wr * 64 + m * 16 + fr;
                    const bf16* gp = (const bf16*)(ws + WS_G) + (size_t)r * 3072 + u.z * 1024 + c;
                    const u32x4 g0 = *(const u32x4*)gp;
                    if (u.z < 2) { const u32x4 g1 = *(const u32x4*)(gp + 1024);
                        const f32x4 d0 = bf4lo(g1), d1 = bf4hi(g1), n0 = bf4lo(g0), n1 = bf4hi(g0);
                        acc[ai][bj][m][0] *= (f32x4){n0[0] / fmaxf(d0[0], 1e-30f), n0[1] / fmaxf(d0[1], 1e-30f), n0[2] / fmaxf(d0[2], 1e-30f), n0[3] / fmaxf(d0[3], 1e-30f)};
                        acc[ai][bj][m][1] *= (f32x4){n1[0] / fmaxf(d1[0], 1e-30f), n1[1] / fmaxf(d1[1], 1e-30f), n1[2] / fmaxf(d1[2], 1e-30f), n1[3] / fmaxf(d1[3], 1e-30f)};
                    } else *(u32x4*)((bf16*)(ws + WS_M) + (size_t)r * 1024 + c) = pack8(acc[ai][bj][m][0] * bf4lo(g0), acc[ai][bj][m][1] * bf4hi(g0));
                    asm volatile("" ::: "memory");
                } }
        return u.z < 2;
    }
};
struct EpiOut {
    static constexpr bool PERM = false;
    unsigned char* ws; int layer; float scale; const float* xin; const float* cin;
    __device__ __forceinline__ bool operator()(f32x4 (&acc)[2][2][4][2], const pg8::Unit& u, int wr, int wc, int fr_, int fq_) const {
        int fr = fr_, fq = fq_; asm volatile("" : "+v"(fr), "+v"(fq)); unsigned char* const ws = uni_ptr(this->ws);
        float* X = (float*)(ws + WS_XCUR); const float* xlat = uni_ptr(xin); const float* xctx = uni_ptr(cin);
#pragma unroll
        for (int ai = 0; ai < 2; ++ai)
#pragma unroll
            for (int m = 0; m < 4; ++m) { const int r = u.pm * 256 + ai * 128 + wr * 64 + m * 16 + fr;
                const float* g1 = (const float*)(ws + WS_MODV) + ((size_t)layer * 5 + row_mi(r)) * 6144 + 2048;
                const float* xs = (r < TL ? xlat : xctx) + (size_t)r * 1024;
#pragma unroll
                for (int bj = 0; bj < 2; ++bj)
#pragma unroll
                    for (int n = 0; n < 2; ++n) { const int c = u.pn * 256 + bj * 128 + wc * 32 + n * 16 + 4 * fq; f32x4* xp = (f32x4*)(X + (size_t)r * 1024 + c);
                        *xp = *(const f32x4*)(xs + c) + *(const f32x4*)(g1 + c) * acc[ai][bj][m][n] * scale; } asm volatile("" ::: "memory"); }
        return false;
    }
};
struct EpiQp {
    static constexpr bool PERM = true;
    unsigned char* ws;
    __device__ __forceinline__ bool operator()(f32x4 (&acc)[2][2][4][2], const pg8::Unit& u, int wr, int wc, int fr_, int fq_) const {
        int fr = fr_, fq = fq_; asm volatile("" : "+v"(fr), "+v"(fq)); unsigned char* const ws = uni_ptr(this->ws);
#pragma unroll
        for (int bj = 0; bj < 2; ++bj) { const int c = u.pn * 256 + bj * 128 + wc * 32 + 8 * fq;
#pragma unroll
            for (int ai = 0; ai < 2; ++ai)
#pragma unroll
                for (int m = 0; m < 4; ++m) *(u32x4*)((bf16*)(ws + WS_QP) + ((size_t)(c >> 4) * TA + (u.pm * 256 + ai * 128 + wr * 64 + m * 16 + fr)) * 16 + (c & 15)) = pack8(acc[ai][bj][m][0], acc[ai][bj][m][1]); }
        return false;
    }
};

__device__ __forceinline__ void ph_inproj(const Ctx& cx, int layer, PG8_LAS unsigned char* lds) {
    CParams& p = get_params();
    pg8::Gemm g; g.A = (const bf16*)(p.ws + WS_H); g.Bt = (const bf16*)(p.ws + WT_IN) + (size_t)layer * INW * DM; g.zsA = 0; g.zsB = 0; g.K = DM;
    pg8::TileOrder S; S.nM = TL / 256; S.nN = INW / 256; S.nwg = S.nM * S.nN; S.G = cx.nb; S.c = cx.bid; S.nz = 1;
    if (layer == DEPTH - 1) { S.exN = 3; S.expn0 = 2; S.extra = 4 * 3; } else { S.exN = INW / 256; S.expn0 = 0; S.extra = 4 * (INW / 256); }
    EpiInproj E; E.ws = p.ws; E.gate_b = p.in[I_GATEB] + layer * 3072;
    pg8::gemm_phase<EpiInproj, pg8::TileOrder>(lds, g, S, E, cx.tid);
}

__device__ __forceinline__ void ph_attn(const Ctx& cx, int layer, float* sm) {
    CParams& p = get_params();
    const int tid = cx.tid, lane = tid & 63, w = tid >> 6, l15 = lane & 15, kg = lane >> 4;
    const bf16* Q = (const bf16*)(p.ws + WS_Q); const bf16* Kb = (const bf16*)(p.ws + WS_K); const bf16* Vb = (const bf16*)(p.ws + WS_V);
    bf16* VT = (bf16*)sm;
    constexpr int VS = 648;
    const int nitems = 256 + (layer == 0 ? 16 : 0);
    for (int it = cx.bid; it < nitems; it += cx.nb) {
        int b, kvh, qbase, wbase; bool win;
        if (it < 256) { b = it >> 6; kvh = (it >> 5) & 1; const int blk = it & 31; qbase = b * SEQ + blk * 128; wbase = blk * 128 - 128; win = true; }
        else { const int j = it - 256; b = j >> 2; kvh = (j >> 1) & 1; qbase = TL + b * CTXL + (j & 1) * 128; wbase = 0; win = false; }
        __syncthreads();
        for (int i = tid; i < 640 * 8; i += NTHREADS) { const int kk = i >> 3, c8 = i & 7; int row = -1;
            if (kk < 256) row = TL + b * CTXL + kk; else if (win) { const int pos = wbase + kk - 256; if (pos >= 0 && pos < SEQ) row = b * SEQ + pos; }
            const u32x4 ld_ = *(const u32x4*)(Vb + (size_t)(row >= 0 ? row : 0) * 128 + kvh * 64 + c8 * 8); const u32x4 v = row >= 0 ? ld_ : (u32x4){0u, 0u, 0u, 0u};
            bf16* d = VT + (c8 * 8) * VS + kk;
            d[0] = (bf16)(v.x & 0xffffu); d[VS] = (bf16)(v.x >> 16); d[2 * VS] = (bf16)(v.y & 0xffffu); d[3 * VS] = (bf16)(v.y >> 16);
            d[4 * VS] = (bf16)(v.z & 0xffffu); d[5 * VS] = (bf16)(v.z >> 16); d[6 * VS] = (bf16)(v.w & 0xffffu); d[7 * VS] = (bf16)(v.w >> 16); }
        __syncthreads();
        const int h = kvh * 4 + (w >> 1), tok0 = (w & 1) * 64;
        bf16x8 qf[4][2];
#pragma unroll
        for (int qt = 0; qt < 4; ++qt)
#pragma unroll
            for (int ks = 0; ks < 2; ++ks) qf[qt][ks] = *(const bf16x8*)(Q + (size_t)(qbase + tok0 + 16 * qt + l15) * 512 + h * 64 + 32 * ks + 8 * kg);
        float m[4], l[4]; f32x4 O[4][4];
        const float sink = p.in[I_SINK][layer * 8 + h];
#pragma unroll
        for (int qt = 0; qt < 4; ++qt) { m[qt] = sink; l[qt] = 1.f;
#pragma unroll
            for (int dt = 0; dt < 4; ++dt) O[qt][dt] = (f32x4){0.f, 0.f, 0.f, 0.f}; }
        const int nsteps = win ? 18 : 8;
        bf16x8 kf[2][2];
#define ATT_LOADK(KF, st_) do { const int kk0_ = (st_) < 8 ? (st_) * 32 : 256 + tok0 + ((st_) - 8) * 32; \
            _Pragma("unroll") for (int kt = 0; kt < 2; ++kt) { const int kk = kk0_ + 16 * kt + l15; int row; \
                if (kk < 256) row = TL + b * CTXL + kk; else { int pos = wbase + kk - 256; pos = pos < 0 ? 0 : (pos > SEQ - 1 ? SEQ - 1 : pos); row = b * SEQ + pos; } \
                _Pragma("unroll") for (int ks = 0; ks < 2; ++ks) KF[kt][ks] = *(const bf16x8*)(Kb + ((size_t)(kvh * 2 + ks) * TA + row) * 32 + 8 * kg); } } while (0)
        ATT_LOADK(kf, 0);
        for (int st = 0; st < nsteps; ++st) {
            const int kk0 = st < 8 ? st * 32 : 256 + tok0 + (st - 8) * 32;
            bf16x8 kfn[2][2];
            const int stn = st + 1 < nsteps ? st + 1 : st;
            ATT_LOADK(kfn, stn);
#pragma unroll
            for (int qt = 0; qt < 4; ++qt) {
                f32x4 s0 = (f32x4){0.f, 0.f, 0.f, 0.f}, s1 = s0;
                s0 = __builtin_amdgcn_mfma_f32_16x16x32_bf16(kf[0][0], qf[qt][0], s0, 0, 0, 0); s0 = __builtin_amdgcn_mfma_f32_16x16x32_bf16(kf[0][1], qf[qt][1], s0, 0, 0, 0);
                s1 = __builtin_amdgcn_mfma_f32_16x16x32_bf16(kf[1][0], qf[qt][0], s1, 0, 0, 0); s1 = __builtin_amdgcn_mfma_f32_16x16x32_bf16(kf[1][1], qf[qt][1], s1, 0, 0, 0);
                s0 *= 0.125f; s1 *= 0.125f;
                if (st >= 8) {
                    const int qpos = wbase + 128 + tok0 + 16 * qt + l15, kp0 = wbase + kk0 - 256 + 4 * kg;
#pragma unroll
                    for (int r = 0; r < 4; ++r) { const int k0 = kp0 + r, k1 = kp0 + 16 + r;
                        if (k0 < 0 || k0 >= SEQ || k0 - qpos > 128 || qpos - k0 > 128) s0[r] = -1e30f;
                        if (k1 < 0 || k1 >= SEQ || k1 - qpos > 128 || qpos - k1 > 128) s1[r] = -1e30f; }
                }
                float mx = fmaxf(fmaxf(fmaxf(s0[0], s0[1]), fmaxf(s0[2], s0[3])), fmaxf(fmaxf(s1[0], s1[1]), fmaxf(s1[2], s1[3])));
                mx = fmaxf(mx, __shfl_xor(mx, 16)); mx = fmaxf(mx, __shfl_xor(mx, 32));
                const float mn = fmaxf(m[qt], mx), f = __expf(m[qt] - mn);
                f32x4 p0, p1;
#pragma unroll
                for (int r = 0; r < 4; ++r) { p0[r] = __expf(s0[r] - mn); p1[r] = __expf(s1[r] - mn); }
                float ps = (p0[0] + p0[1]) + (p0[2] + p0[3]) + (p1[0] + p1[1]) + (p1[2] + p1[3]);
                ps += __shfl_xor(ps, 16); ps += __shfl_xor(ps, 32);
                l[qt] = l[qt] * f + ps; m[qt] = mn;
                u32x4 pw; pw.x = pk2(p0[0], p0[1]); pw.y = pk2(p0[2], p0[3]); pw.z = pk2(p1[0], p1[1]); pw.w = pk2(p1[2], p1[3]);
                const bf16x8 pf = __builtin_bit_cast(bf16x8, pw);
#pragma unroll
                for (int dt = 0; dt < 4; ++dt) {
                    const bf16* vp = VT + (16 * dt + l15) * VS + kk0 + 4 * kg;
                    u32x4 vw; const u32x2 va = *(const u32x2*)vp, vb = *(const u32x2*)(vp + 16); vw.x = va.x; vw.y = va.y; vw.z = vb.x; vw.w = vb.y;
                    O[qt][dt] = __builtin_amdgcn_mfma_f32_16x16x32_bf16(__builtin_bit_cast(bf16x8, vw), pf, O[qt][dt] * f, 0, 0, 0);
                }
                __builtin_amdgcn_sched_barrier(0);
            }
#pragma unroll
            for (int kt = 0; kt < 2; ++kt)
#pragma unroll
                for (int ks = 0; ks < 2; ++ks) kf[kt][ks] = kfn[kt][ks];
        }
#undef ATT_LOADK
#pragma unroll
        for (int qt = 0; qt < 4; ++qt) { const float il = 1.f / l[qt]; bf16* op = (bf16*)(p.ws + WS_ATT) + (size_t)(qbase + tok0 + 16 * qt + l15) * 512 + h * 64 + 4 * kg;
#pragma unroll
            for (int dt = 0; dt < 4; ++dt) { const f32x4 o = O[qt][dt] * il; u32x2 ww; ww.x = pk2(o[0], o[1]); ww.y = pk2(o[2], o[3]); *(u32x2*)(op + 16 * dt) = ww; } }
    }
}

__device__ __forceinline__ void ph_hypre(const Ctx& cx, int layer, float* sm) {
    CParams& p = get_params();
    const int lane = cx.tid & 63, wave = cx.tid >> 6, gw = cx.bid * NWAVES + wave, NGW = cx.nb * NWAVES;
    const bf16* Z = (const bf16*)(p.ws + WS_Z); const float* sw = p.in[I_HSW] + layer * 3 * 1536; const float* sb = p.in[I_HSB] + layer * 1536;
    float* tile = sm + wave * 4096;
    const int nlat = 4 * 64 * 8, nctx = layer == 0 ? 4 * 4 * 8 : 0;
    for (int it = gw; it < nlat + nctx; it += NGW) {
        int b, t0, L, c0, rbase; float* vvb;
        if (it < nlat) { b = it >> 9; t0 = ((it >> 3) & 63) * 64; c0 = (it & 7) * 64; L = SEQ; rbase = b * SEQ; vvb = (float*)(p.ws + WS_VV) + ((size_t)b * 512 + c0) * SEQ; }
        else { const int j = it - nlat; b = j >> 5; t0 = ((j >> 3) & 3) * 64; c0 = (j & 7) * 64; L = CTXL; rbase = TL + b * CTXL; vvb = (float*)(p.ws + WS_VVC) + ((size_t)b * 512 + c0) * CTXL; }
        const int c = c0 + lane;
        float w0[3], w1[3], w2[3], bb[3];
#pragma unroll
        for (int q = 0; q < 3; ++q) { const int col = q * 512 + c; w0[q] = sw[col]; w1[q] = sw[1536 + col]; w2[q] = sw[2 * 1536 + col]; bb[q] = sb[col]; }
        const bf16* zb = Z + (size_t)rbase * 1536 + c;
#pragma unroll 1
        for (int tb = 0; tb < 64; tb += 16) {
            bf16 zv[3][18];
#pragma unroll
            for (int k = 0; k < 18; ++k) { const int t = t0 + tb + k - 1; const bool ok = t >= 0 && t < L; const int tc = t < 0 ? 0 : (t >= L ? L - 1 : t);
#pragma unroll
                for (int q = 0; q < 3; ++q) { const bf16 ld_ = zb[(size_t)tc * 1536 + q * 512]; zv[q][k] = ok ? ld_ : (bf16)0; } }
#pragma unroll
            for (int k = 0; k < 16; ++k) { const int tt = tb + k, t = t0 + tt; float o[3];
#pragma unroll
                for (int q = 0; q < 3; ++q) o[q] = bb[q] + w0[q] * bf2f(zv[q][k]) + w1[q] * bf2f(zv[q][k + 1]) + w2[q] * bf2f(zv[q][k + 2]);
                ((bf16*)(p.ws + WS_X0C))[(size_t)(rbase + t) * 512 + c] = f2bf(o[0]);
                tile[lane * 64 + (tt ^ lane)] = o[2] * o[1]; }
        }
        __builtin_amdgcn_s_waitcnt(0xc07f);
        for (int cc = 0; cc < 64; ++cc) vvb[(size_t)cc * L + t0 + lane] = tile[cc * 64 + (lane ^ cc)];
        __builtin_amdgcn_s_waitcnt(0xc07f);
    }
}

__device__ __forceinline__ void ph_hyconv_ctx(const Ctx& cx, int layer, float* sm) {
    CParams& p = get_params();
    const int tid = cx.tid;
    if (layer != 0) return;
    constexpr int L = CTXL;
    float* Tl = sm; float* Vl = sm + 2 * L;
    for (int it = cx.bid; it < 2048; it += cx.nb) {
        const int bc = it, b = bc >> 9, c = bc & 511;
        const float* fb = (const float*)(p.ws + WS_FILT + FILT_CTX_OFF);
        const float* hf = fb + (size_t)c * L; const float* hb = fb + ((size_t)512 + c) * L;
        const float* vv = (const float*)(p.ws + WS_VVC) + (size_t)bc * CTXL;
        __syncthreads();
        if (tid < L) { Tl[L - 1 + tid] = hf[tid]; if (tid > 0) Tl[L - 1 - tid] = hb[tid]; Vl[tid] = vv[tid]; }
        __syncthreads();
        if (tid < L) { float a = 0.f; const float* tp = Tl + (tid + L - 1);
            for (int s = 0; s < L; ++s) a += Vl[s] * tp[-s];
            const size_t o = (size_t)(TL + b * CTXL + tid) * 512 + c;
            ((bf16*)(p.ws + WS_HY))[o] = f2bf((a + Vl[tid] * p.in[I_HBIAS][layer * 512 + c]) * bf2f(((const bf16*)(p.ws + WS_X0C))[o])); }
    }
}
typedef float f32x2 __attribute__((ext_vector_type(2)));
__device__ __forceinline__ f32x2 cmul(f32x2 a, f32x2 w) { return (f32x2){a.x * w.x - a.y * w.y, a.x * w.y + a.y * w.x}; }
__device__ __forceinline__ void fft_fwd_r4(f32x2* X, int tid) {
#pragma unroll 1
    for (int s = 0; s < 12; s += 2) {
        const int lq = 11 - s, Q = 1 << lq;
        __syncthreads();
#pragma unroll
        for (int q = 0; q < 4; ++q) { const int j = tid + 512 * q, pos = j & (Q - 1), i = ((j >> lq) << (lq + 2)) + pos;
            const float rev = (float)(pos << s) * (1.f / 8192.f); const f32x2 w1 = (f32x2){__builtin_amdgcn_cosf(rev), -__builtin_amdgcn_sinf(rev)}; const f32x2 w2 = cmul(w1, w1);
            const f32x2 a0 = X[i], a1 = X[i + Q], a2 = X[i + 2 * Q], a3 = X[i + 3 * Q];
            const f32x2 b0 = a0 + a2, b1 = a1 + a3, d02 = a0 - a2, d13 = a1 - a3;
            const f32x2 b2 = cmul(d02, w1), b3 = cmul((f32x2){d13.y, -d13.x}, w1);
            X[i] = b0 + b1; X[i + Q] = cmul(b0 - b1, w2); X[i + 2 * Q] = b2 + b3; X[i + 3 * Q] = cmul(b2 - b3, w2); }
    }
}
__device__ __forceinline__ void fft_inv_r4(f32x2* X, int tid) {
#pragma unroll 1
    for (int s = 1; s < 13; s += 2) {
        const int h = 1 << s;
        __syncthreads();
#pragma unroll
        for (int q = 0; q < 4; ++q) { const int j = tid + 512 * q, pos = j & (h - 1), i = ((j >> s) << (s + 2)) + pos;
            const float rev = (float)(pos << (11 - s)) * (1.f / 8192.f); const f32x2 v1 = (f32x2){__builtin_amdgcn_cosf(rev), __builtin_amdgcn_sinf(rev)}; const f32x2 v2 = cmul(v1, v1);
            const f32x2 a0 = X[i], a1 = cmul(X[i + h], v2), a2 = X[i + 2 * h], a3 = cmul(X[i + 3 * h], v2);
            const f32x2 b0 = a0 + a1, b1 = a0 - a1, b2 = cmul(a2 + a3, v1), t3 = cmul(a2 - a3, v1); const f32x2 b3 = (f32x2){-t3.y, t3.x};
            X[i] = b0 + b2; X[i + h] = b1 + b3; X[i + 2 * h] = b0 - b2; X[i + 3 * h] = b1 - b3; }
    }
}
__device__ __forceinline__ void ph_hyfft(const Ctx& cx, int layer, float* sm, bool dry) {
    CParams& p = get_params();
    const int tid = cx.tid;
    f32x2* A = (f32x2*)sm; f32x2* B = A + 8192;
    for (int c = cx.bid; c < 512; c += cx.nb) {
        const float* hf = (const float*)(p.ws + WS_FILT) + (size_t)c * SEQ; const float* hb = (const float*)(p.ws + WS_FILT) + ((size_t)512 + c) * SEQ;
        const float bias = p.in[I_HBIAS][layer * 512 + c];
        __syncthreads();
#pragma unroll
        for (int q = 0; q < 16; ++q) { const int i = tid + 512 * q; const float lf = hf[i & (SEQ - 1)], lb_ = hb[(2 * SEQ - i) & (SEQ - 1)]; A[i] = (f32x2){i < SEQ ? lf : (i > SEQ ? lb_ : 0.f), 0.f}; }
        fft_fwd_r4(A, tid);
        __syncthreads();
#pragma unroll
        for (int q = 0; q < 8; ++q) { const int i = 2 * (tid + 512 * q); const f32x2 a = A[i], b = A[i + 1]; A[i] = a + b; A[i + 1] = a - b; }
#pragma unroll 1
        for (int bp = 0; bp < 2; ++bp) {
            float* v0 = (float*)(p.ws + WS_VV) + ((size_t)(2 * bp) * 512 + c) * SEQ; float* v1 = v0 + (size_t)512 * SEQ;
            float xr[8], xi[8];
            __syncthreads();
#pragma unroll
            for (int q = 0; q < 8; ++q) { const int i = tid + 512 * q; xr[q] = v0[i]; xi[q] = v1[i]; B[i] = (f32x2){xr[q], xi[q]}; B[i + SEQ] = (f32x2){0.f, 0.f}; }
            fft_fwd_r4(B, tid);
            __syncthreads();
#pragma unroll
            for (int q = 0; q < 8; ++q) { const int i = 2 * (tid + 512 * q); const f32x2 a = B[i], b = B[i + 1];
                const f32x2 y0 = cmul(a + b, A[i]), y1 = cmul(a - b, A[i + 1]); B[i] = y0 + y1; B[i + 1] = y0 - y1; }
            fft_inv_r4(B, tid);
            __syncthreads();
#pragma unroll
            for (int q = 0; q < 8; ++q) { const int i = tid + 512 * q; const f32x2 y = B[i]; if (!dry) { v0[i] = y.x * (1.f / 8192.f) + xr[q] * bias; v1[i] = y.y * (1.f / 8192.f) + xi[q] * bias; } }
        }
    }
}
__device__ __forceinline__ void ph_hypost(const Ctx& cx, int layer, float* sm) {
    CParams& p = get_params();
    const int lane = cx.tid & 63, wave = cx.tid >> 6, gw = cx.bid * NWAVES + wave, NGW = cx.nb * NWAVES;
    float* tile = sm + wave * 4096;
    for (int it = gw; it < 4 * 64 * 8; it += NGW) {
        const int b = it >> 9, t0 = ((it >> 3) & 63) * 64, c0 = (it & 7) * 64;
        const float* yb = (const float*)(p.ws + WS_VV) + ((size_t)b * 512 + c0) * SEQ;
        for (int cc = 0; cc < 64; ++cc) tile[cc * 64 + (lane ^ cc)] = yb[(size_t)cc * SEQ + t0 + lane];
        __builtin_amdgcn_s_waitcnt(0xc07f);
        for (int tt = 0; tt < 64; ++tt) { const size_t o = (size_t)(b * SEQ + t0 + tt) * 512 + c0 + lane;
            ((bf16*)(p.ws + WS_HY))[o] = f2bf(tile[lane * 64 + (tt ^ lane)] * bf2f(((const bf16*)(p.ws + WS_X0C))[o])); }
        __builtin_amdgcn_s_waitcnt(0xc07f);
    }
    (void)layer;
}

__device__ __forceinline__ void s5_pow(const float decay, const float theta, int n, float& pr, float& pi) {
    const float m = __expf(decay * (float)n), rev = __builtin_amdgcn_fractf(theta * (float)n * 0.15915494309189535f);
    pr = m * __builtin_amdgcn_cosf(rev); pi = m * __builtin_amdgcn_sinf(rev);
}
__device__ __forceinline__ void ph_s5tables(const Ctx& cx, int layer, float* sm) {
    const int gt = cx.bid * NTHREADS + cx.tid, NGT = cx.nb * NTHREADS;
    {
        CParams& p = get_params(); bf16* E = (bf16*)(p.ws + WS_S5E);
        for (int it = gt; it < 32 * 2 * 64 * 64; it += NGT) {
            const int pp = it & 63, s = (it >> 6) & 63, dir = (it >> 12) & 1, g = it >> 13;
            const int ldgp = ((layer * 2 + dir) * 32 + g) * 64 + pp;
            const float decay = ((const float*)(p.ws + WS_S5C))[ldgp * 2], theta = ((const float*)(p.ws + WS_S5C))[ldgp * 2 + 1];
            float qr, qi; s5_pow(decay, theta, dir == 0 ? 63 - s : s, qr, qi);
            const f32x4* bb = (const f32x4*)((const float*)(p.ws + WS_S5B) + (size_t)ldgp * 32);
            bf16* er = E + (((size_t)(g * 2 + dir) * 128 + pp) * 1024 + s * 16); bf16* ei = er + (size_t)64 * 1024;
#pragma unroll
            for (int i = 0; i < 16; i += 2) { const f32x4 b2 = bb[i >> 1];
                *(unsigned*)(er + i) = pk2(qr * b2[0] - qi * b2[1], qr * b2[2] - qi * b2[3]); *(unsigned*)(ei + i) = pk2(qr * b2[1] + qi * b2[0], qr * b2[3] + qi * b2[2]); }
            if (s == 0) { float ar, ai; s5_pow(decay, theta, 64, ar, ai); float* a64 = (float*)(p.ws + WS_S5A64) + (size_t)ldgp * 2; a64[0] = ar; a64[1] = ai; }
        }
    }
    {
        CParams& p = get_params(); bf16* P = (bf16*)(p.ws + WS_S5P);
        for (int it = gt; it < 32 * 2 * 64 * 64; it += NGT) {
            const int pp = it & 63, tau = (it >> 6) & 63, dir = (it >> 12) & 1, g = it >> 13;
            const int ldgp = ((layer * 2 + dir) * 32 + g) * 64 + pp;
            float pr, pi; s5_pow(((const float*)(p.ws + WS_S5C))[ldgp * 2], ((const float*)(p.ws + WS_S5C))[ldgp * 2 + 1], dir == 0 ? tau + 1 : 64 - tau, pr, pi);
            const size_t cb = ((size_t)((layer * 2 + dir) * 32 + g) * 16) * 64 + pp;
            bf16* pb = P + (((size_t)(g * 2 + dir) * 64 + tau) * 16) * 128 + pp;
#pragma unroll
            for (int o = 0; o < 16; ++o) { const float cre = p.in[I_SCRE][cb + o * 64], cim = p.in[I_SCIM][cb + o * 64];
                pb[o * 128] = f2bf(cre * pr - cim * pi); pb[o * 128 + 64] = f2bf(-(cre * pi + cim * pr)); }
        }
    }
    {
        CParams& p = get_params(); bf16* K = (bf16*)(p.ws + WS_S5K);
        const int tid = cx.tid, lane = tid & 63, w = tid >> 6;
        float* Cs = sm;
        float* Xs = sm + 4096 + w * 2112;
        for (int it = cx.bid; it < 32 * 16; it += cx.nb) {
            const int g = it >> 4, dl = (it & 15) * 8 + w, d = dl - 63;
            __syncthreads();
            for (int i = tid; i < 2 * 16 * 64; i += NTHREADS) { const int dir = i >> 10, r = i & 1023; const size_t ci = (size_t)((layer * 2 + dir) * 32 + g) * 1024 + r;
                Cs[i * 2] = p.in[I_SCRE][ci]; Cs[i * 2 + 1] = p.in[I_SCIM][ci]; }
            __syncthreads();
            if (dl < 127) {
                float acc[4] = {0.f, 0.f, 0.f, 0.f};
#pragma unroll 1
                for (int dir = 0; dir < 2; ++dir) {
                    if ((dir == 0 && d < 0) || (dir == 1 && d > 0)) continue;
                    const int ldgp = ((layer * 2 + dir) * 32 + g) * 64 + lane;
                    float qr, qi; s5_pow(((const float*)(p.ws + WS_S5C))[ldgp * 2], ((const float*)(p.ws + WS_S5C))[ldgp * 2 + 1], d < 0 ? -d : d, qr, qi);
                    const f32x4* bb = (const f32x4*)((const float*)(p.ws + WS_S5B) + (size_t)ldgp * 32);
#pragma unroll
                    for (int i = 0; i < 16; i += 2) { const f32x4 b2 = bb[i >> 1];
                        Xs[lane * 33 + i] = qr * b2[0] - qi * b2[1]; Xs[lane * 33 + 16 + i] = qr * b2[1] + qi * b2[0];
                        Xs[lane * 33 + i + 1] = qr * b2[2] - qi * b2[3]; Xs[lane * 33 + 17 + i] = qr * b2[3] + qi * b2[2]; }
                    __builtin_amdgcn_s_waitcnt(0xc07f);
                    const int i = lane & 15, oq = lane >> 4;
                    for (int pp = 0; pp < 64; ++pp) { const float xr = Xs[pp * 33 + i], xi = Xs[pp * 33 + 16 + i];
#pragma unroll
                        for (int jj = 0; jj < 4; ++jj) { const f32x2 c = *(const f32x2*)(Cs + ((dir * 16 + oq + 4 * jj) * 64 + pp) * 2); acc[jj] += c.x * xr - c.y * xi; } }
                    __builtin_amdgcn_s_waitcnt(0xc07f);
                }
                const int i = lane & 15, oq = lane >> 4;
#pragma unroll
                for (int jj = 0; jj < 4; ++jj) { const int o = oq + 4 * jj; float v = acc[jj]; if (d == 0 && o == i) v += p.in[I_SD][layer * 512 + g * 16 + o];
                    K[((size_t)g * 127 + dl) * 256 + o * 16 + i] = f2bf(v); }
            }
        }
    }
}
__device__ __forceinline__ int s5_row(int b, int n, int s) { return n < 4 ? TL + b * CTXL + n * 64 + s : b * SEQ + (n - 4) * 64 + s; }
__device__ __forceinline__ void ph_s5states(const Ctx& cx, int layer, float* sm) {
    CParams& p = get_params();
    const int tid = cx.tid, lane = tid & 63, w = tid >> 6, l15 = lane & 15, kg = lane >> 4;
    const bf16* E = (const bf16*)(p.ws + WS_S5E); const bf16* U = (const bf16*)(p.ws + WS_U);
    float* S = sm;
    for (int it = cx.bid; it < 128; it += cx.nb) {
        const int g = it & 31, b = it >> 5;
        f32x4 acc[2][5];
#pragma unroll
        for (int mt = 0; mt < 2; ++mt)
#pragma unroll
            for (int nt = 0; nt < 5; ++nt) acc[mt][nt] = (f32x4){0.f, 0.f, 0.f, 0.f};
        const bf16* ea = E + ((size_t)g * 256 + 32 * w + l15) * 1024 + 8 * kg;
        const int i0 = 8 * (kg & 1);
        bf16x8 af[2], bfr[5];
#define S5S_LOAD(AF, BF, ks_) do { const int s_ = 2 * (ks_) + (kg >> 1); \
            _Pragma("unroll") for (int mt = 0; mt < 2; ++mt) AF[mt] = *(const bf16x8*)(ea + (size_t)mt * 16 * 1024 + (ks_) * 32); \
            _Pragma("unroll") for (int nt = 0; nt < 5; ++nt) { const int n = 16 * nt + l15, nc = n < 68 ? n : 67; \
                const bf16x8 ld_ = *(const bf16x8*)(U + s5_uidx(g, b, nc, s_) + i0); BF[nt] = n < 68 ? ld_ : (bf16x8){0, 0, 0, 0, 0, 0, 0, 0}; } } while (0)
        S5S_LOAD(af, bfr, 0);
        for (int ks = 0; ks < 32; ++ks) {
            bf16x8 afn[2], bfn[5];
            const int kn = ks < 31 ? ks + 1 : 31;
            S5S_LOAD(afn, bfn, kn);
#pragma unroll
            for (int mt = 0; mt < 2; ++mt)
#pragma unroll
                for (int nt = 0; nt < 5; ++nt) acc[mt][nt] = __builtin_amdgcn_mfma_f32_16x16x32_bf16(af[mt], bfr[nt], acc[mt][nt], 0, 0, 0);
#pragma unroll
            for (int mt = 0; mt < 2; ++mt) af[mt] = afn[mt];
#pragma unroll
            for (int nt = 0; nt < 5; ++nt) bfr[nt] = bfn[nt];
        }
#undef S5S_LOAD
        __syncthreads();
#pragma unroll
        for (int mt = 0; mt < 2; ++mt)
#pragma unroll
            for (int nt = 0; nt < 5; ++nt)
#pragma unroll
                for (int r = 0; r < 4; ++r) S[(32 * w + 16 * mt + kg * 4 + r) * 81 + 16 * nt + l15] = acc[mt][nt][r];
        __syncthreads();
        if (tid < 128) {
            const int dir = tid >> 6, pp = tid & 63;
            const float* a64 = (const float*)(p.ws + WS_S5A64) + ((size_t)((layer * 2 + dir) * 32 + g) * 64 + pp) * 2;
            const float ar = a64[0], ai = a64[1]; float hr = 0.f, hi = 0.f;
            bf16* hin = (bf16*)(p.ws + WS_HIN) + ((size_t)g * 272 + b * 68) * 256 + dir * 128 + pp;
            for (int k = 0; k < 68; ++k) {
                const int n = dir == 0 ? k : (k < 4 ? 3 - k : 71 - k);
                hin[(size_t)n * 256] = f2bf(hr); hin[(size_t)n * 256 + 64] = f2bf(hi);
                const float sr = S[(dir * 128 + pp) * 81 + n], si = S[(dir * 128 + 64 + pp) * 81 + n];
                const float nr = ar * hr - ai * hi + sr, ni = ar * hi + ai * hr + si; hr = nr; hi = ni;
            }
        }
    }
}
__device__ __forceinline__ void ph_s5out(const Ctx& cx, int layer, float* sm) {
    CParams& p = get_params();
    const int tid = cx.tid, lane = tid & 63, w = tid >> 6, l15 = lane & 15, kg = lane >> 4;
    const bf16* U = (const bf16*)(p.ws + WS_U); const bf16* P = (const bf16*)(p.ws + WS_S5P); const bf16* HIN = (const bf16*)(p.ws + WS_HIN);
    bf16* Kl = (bf16*)sm;
    for (int it = cx.bid; it < 256; it += cx.nb) {
        const int g = it & 31, b = (it >> 5) & 3, half = it >> 7;
        __syncthreads();
        { const u32x4* src = (const u32x4*)((const bf16*)(p.ws + WS_S5K) + (size_t)g * 127 * 256); u32x4* dst = (u32x4*)Kl;
          for (int i = tid; i < 127 * 256 / 8; i += NTHREADS) dst[i] = src[i]; }
        __syncthreads();
        f32x4 acc[4][5];
#pragma unroll
        for (int mt = 0; mt < 4; ++mt)
#pragma unroll
            for (int nt = 0; nt < 5; ++nt) acc[mt][nt] = (f32x4){0.f, 0.f, 0.f, 0.f};
        const int tau0 = 32 * half + 4 * w;
        const int i0 = 8 * (kg & 1);
        bf16x8 bfr[5];
#define S5O_LOADB(BF, ks_) do { const int s_ = 2 * (ks_) + (kg >> 1); \
            _Pragma("unroll") for (int nt = 0; nt < 5; ++nt) { const int n = 16 * nt + l15, nc = n < 68 ? n : 67; \
                const bf16x8 ld_ = *(const bf16x8*)(U + s5_uidx(g, b, nc, s_) + i0); BF[nt] = n < 68 ? ld_ : (bf16x8){0, 0, 0, 0, 0, 0, 0, 0}; } } while (0)
        S5O_LOADB(bfr, 0);
        for (int ks = 0; ks < 32; ++ks) {
            const int s = 2 * ks + (kg >> 1);
            bf16x8 bfn[5];
            const int kn = ks < 31 ? ks + 1 : 31;
            S5O_LOADB(bfn, kn);
#pragma unroll
            for (int mt = 0; mt < 4; ++mt) {
                const int lag = tau0 + mt - s;
                const bf16x8 af = *(const bf16x8*)(Kl + (lag + 63) * 256 + l15 * 16 + i0);
#pragma unroll
                for (int nt = 0; nt < 5; ++nt) acc[mt][nt] = __builtin_amdgcn_mfma_f32_16x16x32_bf16(af, bfr[nt], acc[mt][nt], 0, 0, 0);
            }
#pragma unroll
            for (int nt = 0; nt < 5; ++nt) bfr[nt] = bfn[nt];
        }
#undef S5O_LOADB
        bf16x8 pa[4];
#define S5O_LOAD2(AF, BF, dk_) do { const int dir_ = (dk_) >> 2, kk_ = (dk_) & 3; \
            _Pragma("unroll") for (int nt = 0; nt < 5; ++nt) { const int n = 16 * nt + l15, nc = n < 68 ? n : 67; \
                const bf16x8 ld_ = *(const bf16x8*)(HIN + ((size_t)g * 272 + b * 68 + nc) * 256 + dir_ * 128 + 32 * kk_ + 8 * kg); BF[nt] = n < 68 ? ld_ : (bf16x8){0, 0, 0, 0, 0, 0, 0, 0}; } \
            _Pragma("unroll") for (int mt = 0; mt < 4; ++mt) AF[mt] = *(const bf16x8*)(P + ((((size_t)(g * 2 + dir_) * 64 + tau0 + mt) * 16 + l15) * 128 + 32 * kk_ + 8 * kg)); } while (0)
        S5O_LOAD2(pa, bfr, 0);
#pragma unroll 1
        for (int dk = 0; dk < 8; ++dk) {
            bf16x8 pan[4], bfn[5];
            const int dn = dk < 7 ? dk + 1 : 7;
            S5O_LOAD2(pan, bfn, dn);
#pragma unroll
            for (int mt = 0; mt < 4; ++mt)
#pragma unroll
                for (int nt = 0; nt < 5; ++nt) acc[mt][nt] = __builtin_amdgcn_mfma_f32_16x16x32_bf16(pa[mt], bfr[nt], acc[mt][nt], 0, 0, 0);
#pragma unroll
            for (int mt = 0; mt < 4; ++mt) pa[mt] = pan[mt];
#pragma unroll
            for (int nt = 0; nt < 5; ++nt) bfr[nt] = bfn[nt];
        }
#undef S5O_LOAD2
#pragma unroll
        for (int mt = 0; mt < 4; ++mt)
#pragma unroll
            for (int nt = 0; nt < 5; ++nt) { const int n = 16 * nt + l15;
                if (n < 68 && (layer == 0 || n >= 4)) { const f32x4 y = acc[mt][nt]; u32x2 o; o.x = pk2(gelu_tanh(y[0]), gelu_tanh(y[1])); o.y = pk2(gelu_tanh(y[2]), gelu_tanh(y[3]));
                    *(u32x2*)((bf16*)(p.ws + WS_S5Y) + (size_t)s5_row(b, n, tau0 + mt) * 512 + g * 16 + 4 * kg) = o; } }
    }
}

__device__ __forceinline__ void ph_glu(const Ctx& cx, int layer, PG8_LAS unsigned char* lds) {
    CParams& p = get_params();
    pg8::Gemm g; g.A = (const bf16*)(p.ws + WS_S5Y); g.Bt = (const bf16*)(p.ws + WT_GLU) + (size_t)layer * 512 * 512; g.zsA = 0; g.zsB = 0; g.K = 512;
    pg8::TileOrder S; S.nM = TL / 256; S.nN = 2; S.nwg = S.nM * S.nN; S.G = cx.nb; S.c = cx.bid; S.nz = 1; S.exN = 2; S.expn0 = 0; S.extra = layer == 0 ? 4 * 2 : 0;
    EpiGlu E; E.ws = p.ws; E.bias = p.in[I_GLUB] + layer * 512;
    pg8::gemm_phase<EpiGlu, pg8::TileOrder>(lds, g, S, E, cx.tid);
}
__device__ __forceinline__ void ph_merge(const Ctx& cx, int layer, PG8_LAS unsigned char* lds) {
    CParams& p = get_params();
    pg8::Gemm g; g.A = (const bf16*)(p.ws + WS_ATT); g.zsA = (WS_HY - WS_ATT) / 2;
    g.Bt = (const bf16*)(p.ws + WT_BR) + (size_t)(layer * 3 + 0) * 1024 * 512; g.zsB = 1024 * 512; g.K = 512;
    pg8::TileOrder S; S.nM = TL / 256; S.nN = 4; S.nwg = S.nM * S.nN; S.G = cx.nb; S.c = cx.bid; S.nz = 3; S.exN = 4; S.expn0 = 0; S.extra = layer == 0 ? 4 * 4 : 0;
    EpiMerge E; E.ws = p.ws;
    pg8::gemm_phase<EpiMerge, pg8::TileOrder>(lds, g, S, E, cx.tid);
}
__device__ __forceinline__ void ph_outproj(const Ctx& cx, int layer, PG8_LAS unsigned char* lds, float scale) {
    CParams& p = get_params();
    pg8::Gemm g; g.A = (const bf16*)(p.ws + WS_M); g.Bt = (const bf16*)(p.ws + WT_OUT) + (size_t)layer * 1024 * 1024; g.zsA = 0; g.zsB = 0; g.K = 1024;
    pg8::TileOrder S; S.nM = TL / 256; S.nN = 4; S.nwg = S.nM * S.nN; S.G = cx.nb; S.c = cx.bid; S.nz = 1; S.exN = 4; S.expn0 = 0; S.extra = layer == 0 ? 4 * 4 : 0;
    EpiOut E; E.ws = p.ws; E.layer = layer; E.scale = scale; E.xin = layer == 0 ? p.in[I_X] : (const float*)(p.ws + WS_XCUR); E.cin = layer == 0 ? p.in[I_CTX] - (size_t)TL * 1024 : (const float*)(p.ws + WS_XCUR);
    pg8::gemm_phase<EpiOut, pg8::TileOrder>(lds, g, S, E, cx.tid);
}
__device__ __forceinline__ void ph_qp(const Ctx& cx, int layer, PG8_LAS unsigned char* lds) {
    CParams& p = get_params();
    pg8::Gemm g; g.A = (const bf16*)(p.ws + WS_H); g.Bt = (const bf16*)(p.ws + WT_WQ) + (size_t)layer * 2048 * 1024; g.zsA = 0; g.zsB = 0; g.K = 1024;
    pg8::TileOrder S; S.nM = TL / 256; S.nN = 8; S.nwg = S.nM * S.nN; S.G = cx.nb; S.c = cx.bid; S.nz = 1; S.exN = 8; S.expn0 = 0; S.extra = layer == 0 ? 4 * 8 : 0;
    EpiQp E; E.ws = p.ws;
    pg8::gemm_phase<EpiQp, pg8::TileOrder>(lds, g, S, E, cx.tid);
}

__device__ __forceinline__ void ph_peerconv(const Ctx& cx, int layer) {
    CParams& p = get_params();
    const int gt = cx.bid * NTHREADS + cx.tid, NGT = cx.nb * NTHREADS;
    const f32x4* su = (const f32x4*)(p.in[I_PU] + (size_t)layer * 16384 * 1024); const f32x4* sv = (const f32x4*)(p.in[I_PV] + (size_t)layer * 16384 * 1024);
    int* du = (int*)(p.ws + WS_PU); int* dv = (int*)(p.ws + WS_PV);
    for (int i = gt; i < 16384 * 1024 / 4; i += NGT) { const f32x4 a = __builtin_nontemporal_load(su + i) * PEER_SU, c = __builtin_nontemporal_load(sv + i) * PEER_SV;
        int wa = 0, wc = 0; wa = __builtin_amdgcn_cvt_pk_fp8_f32(a[0], a[1], wa, false); wa = __builtin_amdgcn_cvt_pk_fp8_f32(a[2], a[3], wa, true);
        wc = __builtin_amdgcn_cvt_pk_fp8_f32(c[0], c[1], wc, false); wc = __builtin_amdgcn_cvt_pk_fp8_f32(c[2], c[3], wc, true);
        const int e = i >> 8, q = i & 255, di = (((q >> 5) * 16384 + e) << 5) + (q & 31); du[di] = wa; dv[di] = wc; }
}
__device__ __forceinline__ unsigned mono_key(float s, unsigned lowbits, unsigned mask) { const unsigned u = __float_as_uint(s); const unsigned k = (u & 0x80000000u) ? ~u : (u | 0x80000000u); return (k & ~mask) | lowbits; }
__device__ __forceinline__ float mono_val(unsigned key, unsigned mask) { const unsigned k = (key & ~mask) | ((mask + 1u) >> 1); return __uint_as_float((k & 0x80000000u) ? (k & 0x7fffffffu) : ~k); }
#define TOP16_INSERT(t, v_) do { unsigned v__ = (v_); _Pragma("unroll") for (int k_ = 0; k_ < 16; ++k_) { const unsigned hi__ = t[k_] > v__ ? t[k_] : v__; v__ = t[k_] > v__ ? v__ : t[k_]; t[k_] = hi__; } } while (0)
#define CE_DESC(x_, y_) do { const unsigned hi__ = (x_) > (y_) ? (x_) : (y_); const unsigned lo__ = (x_) > (y_) ? (y_) : (x_); (x_) = hi__; (y_) = lo__; } while (0)
__device__ __forceinline__ void sort16_desc(unsigned (&v)[16]) {
#pragma unroll
    for (int k = 2; k <= 16; k <<= 1)
#pragma unroll
        for (int j = k >> 1; j > 0; j >>= 1)
#pragma unroll
            for (int i = 0; i < 16; ++i) { const int l = i ^ j; if (l > i) { if ((i & k) == 0) CE_DESC(v[i], v[l]); else CE_DESC(v[l], v[i]); } }
}
__device__ __forceinline__ void merge16_desc(unsigned (&t)[16], const unsigned (&s)[16]) {
    unsigned c[16];
#pragma unroll
    for (int k = 0; k < 16; ++k) c[k] = t[k] > s[15 - k] ? t[k] : s[15 - k];
#pragma unroll
    for (int d = 8; d >= 1; d >>= 1)
#pragma unroll
        for (int k = 0; k < 16; ++k) if ((k & d) == 0) CE_DESC(c[k], c[k + d]);
#pragma unroll
    for (int k = 0; k < 16; ++k) t[k] = c[k];
}
__device__ __forceinline__ void top16_merge_pair(unsigned (&t)[16]) {
    unsigned c[16];
#pragma unroll
    for (int k = 0; k < 16; ++k) { const unsigned o = (unsigned)__shfl_xor((int)t[15 - k], 32); c[k] = t[k] > o ? t[k] : o; }
#pragma unroll
    for (int d = 8; d >= 1; d >>= 1)
#pragma unroll
        for (int k = 0; k < 16; ++k) if ((k & d) == 0) { const unsigned a = c[k], bb = c[k + d]; c[k] = a > bb ? a : bb; c[k + d] = a > bb ? bb : a; }
#pragma unroll
    for (int k = 0; k < 16; ++k) t[k] = c[k];
}
typedef float f32x16 __attribute__((ext_vector_type(16)));
__device__ __forceinline__ void ph_select(const Ctx& cx, int layer) {
    CParams& p = get_params();
    const int lane = cx.tid & 63, wave = cx.tid >> 6, l31 = lane & 31, hi = lane >> 5;
    const int gw = cx.bid * NWAVES + wave, NGW = cx.nb * NWAVES;
    const int nrows = layer == 0 ? TA : TL;
    const bf16* QP = (const bf16*)(p.ws + WS_QP); const bf16* KY = (const bf16*)(p.ws + WT_KEYS) + (size_t)layer * 8 * 2 * 128 * 128;
    for (int it = gw; it < (nrows / 32) * 8; it += NGW) {
        const int h = it & 7, r0 = (it >> 3) * 32;
        unsigned ab[2][16];
#pragma unroll
        for (int s = 0; s < 2; ++s) {
            const bf16* kp = KY + ((size_t)(h * 2 + s) * 8 * 128 + l31) * 16 + 8 * hi;
            const bf16* qp = QP + ((size_t)(h * 2 + s) * 8 * TA + (r0 + l31)) * 16 + 8 * hi;
            bf16x8 qf[8], kc[8];
#pragma unroll
            for (int ks = 0; ks < 8; ++ks) { qf[ks] = *(const bf16x8*)(qp + (size_t)ks * TA * 16); kc[ks] = *(const bf16x8*)(kp + ks * 2048); }
            unsigned t[16];
#pragma unroll
            for (int k = 0; k < 16; ++k) t[k] = 0u;
#pragma unroll 1
            for (int nt = 0; nt < 4; ++nt) {
                bf16x8 kn[8];
                const bf16* kpn = kp + (nt < 3 ? nt + 1 : nt) * 512;
#pragma unroll
                for (int ks = 0; ks < 8; ++ks) kn[ks] = *(const bf16x8*)(kpn + ks * 2048);
                f32x16 acc;
#pragma unroll
                for (int r = 0; r < 16; ++r) acc[r] = 0.f;
#pragma unroll
                for (int ks = 0; ks < 8; ++ks) acc = __builtin_amdgcn_mfma_f32_32x32x16_bf16(kc[ks], qf[ks], acc, 0, 0, 0);
                unsigned sk[16];
#pragma unroll
                for (int r = 0; r < 16; ++r) { const int n = 32 * nt + (r & 3) + 8 * (r >> 2) + 4 * hi; sk[r] = mono_key(acc[r], 127u - (unsigned)n, 127u); }
                sort16_desc(sk);
                merge16_desc(t, sk);
#pragma unroll
                for (int ks = 0; ks < 8; ++ks) kc[ks] = kn[ks];
            }
            top16_merge_pair(t);
#pragma unroll
            for (int k = 0; k < 16; ++k) ab[s][k] = t[k];
        }
        float av[16], bv[16];
#pragma unroll
        for (int k = 0; k < 16; ++k) { av[k] = mono_val(ab[0][k], 127u); bv[k] = mono_val(ab[1][k], 127u); }
        unsigned t2[16], u2[16];
#pragma unroll
        for (int k = 0; k < 16; ++k) { t2[k] = 0u; u2[k] = 0u; }
#define CELL(dst, i1, j1, i2, j2) do { const float sv_ = hi ? av[i2] + bv[j2] : av[i1] + bv[j1]; const unsigned lb_ = hi ? 255u - (unsigned)((i2) * 16 + (j2)) : 255u - (unsigned)((i1) * 16 + (j1)); dst = mono_key(sv_, lb_, 255u); } while (0)
        CELL(t2[0], 0, 0, 1, 1);   CELL(t2[1], 0, 1, 1, 2);   CELL(t2[2], 0, 2, 1, 3);   CELL(t2[3], 0, 3, 1, 4);   CELL(t2[4], 0, 4, 1, 5);   CELL(t2[5], 0, 5, 1, 6);   CELL(t2[6], 0, 6, 1, 7);   CELL(t2[7], 0, 7, 2, 0);
        CELL(t2[8], 0, 8, 2, 1);   CELL(t2[9], 0, 9, 2, 2);   CELL(t2[10], 0, 10, 2, 3); CELL(t2[11], 0, 11, 2, 4); CELL(t2[12], 0, 12, 3, 0); CELL(t2[13], 0, 13, 3, 1); CELL(t2[14], 0, 14, 3, 2); CELL(t2[15], 0, 15, 3, 3);
        CELL(u2[0], 1, 0, 4, 0);   CELL(u2[1], 4, 1, 4, 2);   CELL(u2[2], 5, 0, 5, 1);   CELL(u2[3], 6, 0, 6, 1);   CELL(u2[4], 7, 0, 7, 1);   CELL(u2[5], 8, 0, 9, 0);   CELL(u2[6], 10, 0, 11, 0); CELL(u2[7], 12, 0, 13, 0); CELL(u2[8], 14, 0, 15, 0);
#undef CELL
        sort16_desc(t2); sort16_desc(u2); merge16_desc(t2, u2);
        top16_merge_pair(t2);
        const float v0 = mono_val(t2[0], 255u); float e[16], esum = 0.f; int eid[16];
#pragma unroll
        for (int k = 0; k < 16; ++k) { e[k] = __expf(mono_val(t2[k], 255u) - v0); esum += e[k];
            const unsigned c = 255u - (t2[k] & 255u), ci = c >> 4, cj = c & 15u; unsigned ka = ab[0][0], kb = ab[1][0];
#pragma unroll
            for (int q = 1; q < 16; ++q) { ka = ci == (unsigned)q ? ab[0][q] : ka; kb = cj == (unsigned)q ? ab[1][q] : kb; }
            eid[k] = (int)((127u - (ka & 127u)) * 128u + (127u - (kb & 127u))); }
        const float inv = 1.f / esum;
        if (hi == 0) { int* dst = (int*)(p.ws + WS_EID) + (size_t)(r0 + l31) * 128 + h * 16;
#pragma unroll
            for (int k = 0; k < 16; k += 4) *(u32x4*)(dst + k) = (u32x4){(unsigned)eid[k], (unsigned)eid[k + 1], (unsigned)eid[k + 2], (unsigned)eid[k + 3]}; }
        else { float* dst = (float*)(p.ws + WS_EG) + (size_t)(r0 + l31) * 128 + h * 16;
#pragma unroll
            for (int k = 0; k < 16; k += 4) *(f32x4*)(dst + k) = (f32x4){e[k] * inv, e[k + 1] * inv, e[k + 2] * inv, e[k + 3] * inv}; }
    }
}
__device__ __forceinline__ void fp8x16_to_f32(const u32x4 w, f32x2 (&f)[8]) {
    f[0] = __builtin_amdgcn_cvt_pk_f32_fp8((int)w.x, false); f[1] = __builtin_amdgcn_cvt_pk_f32_fp8((int)w.x, true); f[2] = __builtin_amdgcn_cvt_pk_f32_fp8((int)w.y, false); f[3] = __builtin_amdgcn_cvt_pk_f32_fp8((int)w.y, true);
    f[4] = __builtin_amdgcn_cvt_pk_f32_fp8((int)w.z, false); f[5] = __builtin_amdgcn_cvt_pk_f32_fp8((int)w.z, true); f[6] = __builtin_amdgcn_cvt_pk_f32_fp8((int)w.w, false); f[7] = __builtin_amdgcn_cvt_pk_f32_fp8((int)w.w, true);
}
#define PU_ISSUE(rowbuf, e0_, e1_) do { _Pragma("unroll") for (int s = 0; s < 16; ++s) { const int e_ = __shfl(s < 8 ? e0_ : e1_, (s & 7) * 8 + grp); \
        rowbuf[s] = __builtin_amdgcn_raw_buffer_load_b128(ru, (unsigned)(e_ * 128 + j8 * 16), 0, 0); } } while (0)
__device__ __forceinline__ void pu_compute(const u32x4 (&row)[16], const u32x4 xw0, const u32x4 xw1, float* pt, int j8, int grp) {
    f32x2 x[8];
    { const f32x4 a = bf4lo(xw0), b = bf4hi(xw0), c = bf4lo(xw1), d = bf4hi(xw1);
      x[0] = (f32x2){a[0], a[1]}; x[1] = (f32x2){a[2], a[3]}; x[2] = (f32x2){b[0], b[1]}; x[3] = (f32x2){b[2], b[3]}; x[4] = (f32x2){c[0], c[1]}; x[5] = (f32x2){c[2], c[3]}; x[6] = (f32x2){d[0], d[1]}; x[7] = (f32x2){d[2], d[3]}; }
    float d[16];
#pragma unroll
    for (int s = 0; s < 16; ++s) { f32x2 f[8]; fp8x16_to_f32(row[s], f);
        f32x2 a = f[0] * x[0];
#pragma unroll
        for (int j = 1; j < 8; ++j) a += f[j] * x[j];
        d[s] = a.x + a.y; }
    float a8[8], a4[4];
    { const bool bt = j8 & 4;
#pragma unroll
      for (int i = 0; i < 4; ++i) {
          const float s0 = bt ? d[i] : d[i + 4], k0 = bt ? d[i + 4] : d[i]; a8[i] = k0 + __shfl_xor(s0, 4);
          const float s1 = bt ? d[i + 8] : d[i + 12], k1 = bt ? d[i + 12] : d[i + 8]; a8[i + 4] = k1 + __shfl_xor(s1, 4); } }
    { const bool bt = j8 & 2;
#pragma unroll
      for (int i = 0; i < 2; ++i) {
          const float s0 = bt ? a8[i] : a8[i + 2], k0 = bt ? a8[i + 2] : a8[i]; a4[i] = k0 + __shfl_xor(s0, 2);
          const float s1 = bt ? a8[i + 4] : a8[i + 6], k1 = bt ? a8[i + 6] : a8[i + 4]; a4[i + 2] = k1 + __shfl_xor(s1, 2); } }
    float r0, r1;
    { const bool bt = j8 & 1;
      const float s0 = bt ? a4[0] : a4[1], k0 = bt ? a4[1] : a4[0]; r0 = k0 + __shfl_xor(s0, 1);
      const float s1 = bt ? a4[2] : a4[3], k1 = bt ? a4[3] : a4[2]; r1 = k1 + __shfl_xor(s1, 1); }
    pt[0] = r0; pt[64] = r1;
}
__device__ __forceinline__ void ph_peer_u(const Ctx& cx, int layer) {
    CParams& p = get_params();
    const int lane = cx.tid & 63, wave = __builtin_amdgcn_readfirstlane(cx.tid >> 6);
    const int nrows = layer == 0 ? TA : TL;
    const int slice = cx.bid & 7, ws_ = (cx.bid >> 3) * NWAVES + wave, NWS = (cx.nb >> 3) * NWAVES;
    const __amdgpu_buffer_rsrc_t ru = __builtin_amdgcn_make_buffer_rsrc((void*)uni_ptr(p.ws + WS_PU + (size_t)slice * (16384 * 128)), (short)0, 16384 * 128, 0x00020000);
    const int j8 = lane & 7, grp = lane >> 3;
    float* PART = (float*)(p.ws + WS_PART) + (size_t)slice * TA * 128 + j8 * 8 + grp;
    const int* EID = (const int*)(p.ws + WS_EID) + lane; const bf16* Hx = (const bf16*)(p.ws + WS_H) + slice * 128 + j8 * 16;
    int t = ws_;
    if (t >= nrows) return;
    u32x4 rA[16], rB[16]; u32x4 xa0, xa1, xb0, xb1;
    int e0 = EID[(size_t)t * 128], e1 = EID[(size_t)t * 128 + 64];
    PU_ISSUE(rA, e0, e1); xa0 = *(const u32x4*)(Hx + (size_t)t * 1024); xa1 = *(const u32x4*)(Hx + (size_t)t * 1024 + 8);
    if (t + NWS < nrows) { e0 = EID[(size_t)(t + NWS) * 128]; e1 = EID[(size_t)(t + NWS) * 128 + 64]; }
    for (;;) {
        const int t1 = t + NWS, t2 = t + 2 * NWS, t3 = t + 3 * NWS;
        if (t1 < nrows) { PU_ISSUE(rB, e0, e1); xb0 = *(const u32x4*)(Hx + (size_t)t1 * 1024); xb1 = *(const u32x4*)(Hx + (size_t)t1 * 1024 + 8); }
        if (t2 < nrows) { e0 = EID[(size_t)t2 * 128]; e1 = EID[(size_t)t2 * 128 + 64]; }
        pu_compute(rA, xa0, xa1, PART + (size_t)t * 128, j8, grp);
        if (t1 >= nrows) break;
        if (t2 < nrows) { PU_ISSUE(rA, e0, e1); xa0 = *(const u32x4*)(Hx + (size_t)t2 * 1024); xa1 = *(const u32x4*)(Hx + (size_t)t2 * 1024 + 8); }
        if (t3 < nrows) { e0 = EID[(size_t)t3 * 128]; e1 = EID[(size_t)t3 * 128 + 64]; }
        pu_compute(rB, xb0, xb1, PART + (size_t)t1 * 128, j8, grp);
        if (t2 >= nrows) break;
        t = t2;
    }
}
#undef PU_ISSUE
__device__ __forceinline__ void ph_peer_w(const Ctx& cx, int layer) {
    CParams& p = get_params();
    const int gt = cx.bid * NTHREADS + cx.tid, NGT = cx.nb * NTHREADS;
    const int n = (layer == 0 ? TA : TL) * 128;
    const float* PART = (const float*)(p.ws + WS_PART); float* EG = (float*)(p.ws + WS_EG);
    for (int i = gt; i < n; i += NGT) { float d = 0.f;
#pragma unroll
        for (int xs = 0; xs < 8; ++xs) d += PART[(size_t)xs * TA * 128 + i];
        EG[i] = EG[i] * gelu_tanh(d * (1.f / PEER_SU)); }
}
#define PV_ISSUE(vbuf, wbuf, e0_, e1_, w0_, w1_) do { _Pragma("unroll") for (int s = 0; s < 16; ++s) { const int src_ = (s & 7) * 8 + grp; \
        const int ee_ = __shfl(s < 8 ? e0_ : e1_, src_); wbuf[s] = __shfl(s < 8 ? w0_ : w1_, src_); vbuf[s] = __builtin_amdgcn_raw_buffer_load_b128(rv, (unsigned)(ee_ * 128 + j8 * 16), 0, 0); } } while (0)
__device__ __forceinline__ void pv_compute(const u32x4 (&row)[16], const float (&w)[16], float* o, const float* g2, int lane, float scale) {
    f32x2 acc[8];
#pragma unroll
    for (int j = 0; j < 8; ++j) acc[j] = (f32x2){0.f, 0.f};
#pragma unroll
    for (int s = 0; s < 16; ++s) { f32x2 f[8]; fp8x16_to_f32(row[s], f);
#pragma unroll
        for (int j = 0; j < 8; ++j) acc[j] += w[s] * f[j]; }
    f32x2 a4[4], a2[2];
    { const bool bt = lane & 32;
#pragma unroll
      for (int i = 0; i < 4; ++i) { const f32x2 sd = bt ? acc[i] : acc[i + 4], kp = bt ? acc[i + 4] : acc[i]; a4[i] = (f32x2){kp.x + __shfl_xor(sd.x, 32), kp.y + __shfl_xor(sd.y, 32)}; } }
    { const bool bt = lane & 16;
#pragma unroll
      for (int i = 0; i < 2; ++i) { const f32x2 sd = bt ? a4[i] : a4[i + 2], kp = bt ? a4[i + 2] : a4[i]; a2[i] = (f32x2){kp.x + __shfl_xor(sd.x, 16), kp.y + __shfl_xor(sd.y, 16)}; } }
    f32x2 r; { const bool bt = lane & 8; const f32x2 sd = bt ? a2[0] : a2[1], kp = bt ? a2[1] : a2[0]; r = (f32x2){kp.x + __shfl_xor(sd.x, 8), kp.y + __shfl_xor(sd.y, 8)}; }
    const int co = ((lane >> 5) & 1) * 8 + ((lane >> 4) & 1) * 4 + ((lane >> 3) & 1) * 2;
    const f32x2 gg = *(const f32x2*)(g2 + co); f32x2* xp = (f32x2*)(o + co); const f32x2 xv = *xp; *xp = (f32x2){xv.x + gg.x * r.x * scale, xv.y + gg.y * r.y * scale};
}
__device__ __forceinline__ void ph_peer_v(const Ctx& cx, int layer, float scale_) {
    CParams& p = get_params();
    const int lane = cx.tid & 63, wave = __builtin_amdgcn_readfirstlane(cx.tid >> 6);
    const int nrows = layer == 0 ? TA : TL;
    const int slice = cx.bid & 7, ws_ = (cx.bid >> 3) * NWAVES + wave, NWS = (cx.nb >> 3) * NWAVES;
    const __amdgpu_buffer_rsrc_t rv = __builtin_amdgcn_make_buffer_rsrc((void*)uni_ptr(p.ws + WS_PV + (size_t)slice * (16384 * 128)), (short)0, 16384 * 128, 0x00020000);
    const int j8 = lane & 7, grp = lane >> 3;
    const float* EG = (const float*)(p.ws + WS_EG) + lane; const int* EID = (const int*)(p.ws + WS_EID) + lane;
    float* OUT = (float*)(p.ws + WS_XCUR) + slice * 128 + j8 * 16;
    const float* G2 = (const float*)(p.ws + WS_MODV) + (size_t)layer * 5 * 6144 + 5120 + slice * 128 + j8 * 16; const float scale = scale_ / PEER_SV;
    int t = ws_;
    if (t >= nrows) return;
    u32x4 rA[16], rB[16]; float wA[16], wB[16];
    int e0 = EID[(size_t)t * 128], e1 = EID[(size_t)t * 128 + 64]; float w0 = EG[(size_t)t * 128], w1 = EG[(size_t)t * 128 + 64];
    PV_ISSUE(rA, wA, e0, e1, w0, w1);
    if (t + NWS < nrows) { e0 = EID[(size_t)(t + NWS) * 128]; e1 = EID[(size_t)(t + NWS) * 128 + 64]; w0 = EG[(size_t)(t + NWS) * 128]; w1 = EG[(size_t)(t + NWS) * 128 + 64]; }
    for (;;) {
        const int t1 = t + NWS, t2 = t + 2 * NWS, t3 = t + 3 * NWS;
        if (t1 < nrows) PV_ISSUE(rB, wB, e0, e1, w0, w1);
        if (t2 < nrows) { e0 = EID[(size_t)t2 * 128]; e1 = EID[(size_t)t2 * 128 + 64]; w0 = EG[(size_t)t2 * 128]; w1 = EG[(size_t)t2 * 128 + 64]; }
        pv_compute(rA, wA, OUT + (size_t)t * 1024, G2 + (size_t)row_mi(t) * 6144, lane, scale);
        if (t1 >= nrows) break;
        if (t2 < nrows) PV_ISSUE(rA, wA, e0, e1, w0, w1);
        if (t3 < nrows) { e0 = EID[(size_t)t3 * 128]; e1 = EID[(size_t)t3 * 128 + 64]; w0 = EG[(size_t)t3 * 128]; w1 = EG[(size_t)t3 * 128 + 64]; }
        pv_compute(rB, wB, OUT + (size_t)t1 * 1024, G2 + (size_t)row_mi(t1) * 6144, lane, scale);
        if (t2 >= nrows) break;
        t = t2;
    }
}
#undef PV_ISSUE
__device__ __forceinline__ void ph_peer_fin(const Ctx& cx, int layer) {
    CParams& p = get_params();
    const int lane = cx.tid & 63, wave = cx.tid >> 6;
    const int gw = cx.bid * NWAVES + wave, NGW = cx.nb * NWAVES;
    const int nrows = layer == 0 ? TA : TL;
    const float* X = (const float*)(p.ws + WS_XCUR);
    for (int r = gw; r < nrows; r += NGW) {
        f32x4 v[4]; float ss = 0.f;
#pragma unroll
        for (int j = 0; j < 4; ++j) { const int c = j * 256 + lane * 4; const f32x4 xv = *(const f32x4*)(X + (size_t)r * 1024 + c); v[j] = xv; ss += xv[0] * xv[0] + xv[1] * xv[1] + xv[2] * xv[2] + xv[3] * xv[3]; }
        const float rs = rsqrtf(wave_sum(ss) * (1.f / DM) + NORM_EPS);
        if (layer == DEPTH - 1) {
#pragma unroll
            for (int j = 0; j < 4; ++j) { const int c = j * 256 + lane * 4; *(f32x4*)(p.out + (size_t)r * 1024 + c) = v[j] * rs * *(const f32x4*)(p.in[I_FG] + c); }
        } else {
            const float* g = p.in[I_N1G] + (layer + 1) * DM; const float* mv = (const float*)(p.ws + WS_MODV) + ((size_t)(layer + 1) * 5 + row_mi(r)) * 6144;
#pragma unroll
            for (int j = 0; j < 4; ++j) { const int c = j * 256 + lane * 4;
                const f32x4 y = v[j] * rs * *(const f32x4*)(g + c); const f32x4 h = y * (1.f + *(const f32x4*)(mv + 1024 + c)) + *(const f32x4*)(mv + c);
                u32x2 w; w.x = pk2(h[0], h[1]); w.y = pk2(h[2], h[3]); *(u32x2*)((bf16*)(p.ws + WS_H) + (size_t)r * DM + c) = w; }
        }
    }
}

constexpr int NPL = 14, NPHASE = 1 + DEPTH * NPL;
#ifndef ONLY
#define ONLY -1
#endif
#ifndef NOT
#define NOT -1
#endif
#define ON(n) ((ONLY < 0 || ONLY == (n)) && NOT != (n))
#ifndef PROBE_HAS
#define PROBE_HAS(n) false
#endif
#ifndef PROBE_REPS
#define PROBE_REPS 2
#endif
#define REPN(n) (PROBE_HAS(n) ? PROBE_REPS : 1)
#define RUN(n, call) do { { MKCX(); if (ON(n)) { const int rep_ = 0; (void)rep_; call; } } if (REPN(n) > 1) { _Pragma("unroll 1") for (int rr_ = 1; rr_ < REPN(n); ++rr_) { __syncthreads(); { MKCX(); if (ON(n)) { const int rep_ = REPN(n) - rr_; (void)rep_; call; } } } __syncthreads(); } } while (0)
#define MKCX() Ctx cx; cx.tid = threadIdx.x; cx.bid = blockIdx.x; cx.nb = gridDim.x; asm volatile("" : "+v"(cx.tid), "+s"(cx.bid), "+s"(cx.nb))
#define IN(k) (lo <= (k) && (k) < hi)
#define SIDE(first, call) do { MKCX(); if (cx.bid >= (first)) { cx.bid -= (first); cx.nb -= (first); call; } } while (0)
#define SEAM(k) do { if (IN(k) && IN((k) + 1)) { XcdBarrier bar_; bar_.bar = (unsigned*)(get_params().ws + WS_CTL) + 4096; bar_.x = xb_xcc_id(); bar_.st = st; xcd_barrier(bar_); } } while (0)
template <int LAYER> __device__ __forceinline__ void layer_program(const int lo, const int hi, float* sm, PG8_LAS unsigned char* lds, volatile LAS unsigned* st) {
    constexpr int B = 1 + LAYER * NPL;
    if (LAYER == 0) { if (IN(B + 0)) { RUN(0, ph_norm(cx, LAYER, 0, 0)); RUN(102, ph_s5tables(cx, 0, sm)); } SEAM(B + 0); }
    if (IN(B + 1)) { RUN(1, ph_inproj(cx, LAYER, lds)); if (LAYER == 0) { __syncthreads(); SIDE(28, ph_filters(cx, 0, sm)); } } SEAM(B + 1);
    if (IN(B + 2)) { RUN(2, ph_attn(cx, LAYER, sm)); __syncthreads(); RUN(20, ph_hypre(cx, LAYER, sm)); __syncthreads(); RUN(21, ph_s5states(cx, LAYER, sm)); } SEAM(B + 2);
    if (IN(B + 3)) { RUN(3, ph_hyfft(cx, LAYER, sm, !(REPN(3) == 1 || rep_ == 1))); __syncthreads(); RUN(31, ph_hyconv_ctx(cx, LAYER, sm)); __syncthreads(); RUN(30, ph_s5out(cx, LAYER, sm)); } SEAM(B + 3);
    if (IN(B + 4)) { RUN(4, ph_glu(cx, LAYER, lds)); __syncthreads(); RUN(40, ph_hypost(cx, LAYER, sm)); } SEAM(B + 4);
    if (IN(B + 5)) { RUN(5, ph_merge(cx, LAYER, lds)); if (LAYER == 0) { __syncthreads(); SIDE(16, ph_filters(cx, 1, sm)); SIDE(16, ph_convert(cx, 1)); } } SEAM(B + 5);
    if (IN(B + 6)) { RUN(6, ph_outproj(cx, LAYER, lds, 1.f / REPN(6))); if (LAYER == 0) { SIDE(16, ph_peerconv(cx, 0)); } } SEAM(B + 6);
    if (IN(B + 7)) { RUN(7, ph_norm(cx, LAYER, 1, LAYER == DEPTH - 1)); if (LAYER + 1 < DEPTH) { RUN(70, ph_s5tables(cx, LAYER + 1, sm)); } if (LAYER != 0) { RUN(71, ph_peerconv(cx, LAYER)); } } SEAM(B + 7);
    if (IN(B + 8)) { RUN(8, ph_qp(cx, LAYER, lds)); } SEAM(B + 8);
    if (IN(B + 9)) { RUN(9, ph_select(cx, LAYER)); } SEAM(B + 9);
    if (IN(B + 10)) { RUN(10, ph_peer_u(cx, LAYER)); } SEAM(B + 10);
    if (IN(B + 11)) { RUN(13, ph_peer_w(cx, LAYER)); } SEAM(B + 11);
    if (IN(B + 12)) { RUN(11, ph_peer_v(cx, LAYER, 1.f / REPN(11))); } SEAM(B + 12);
    if (IN(B + 13)) { RUN(12, ph_peer_fin(cx, LAYER)); } SEAM(B + 13);
}
__global__ void __launch_bounds__(NTHREADS, 2) mk_fwd(Params p) {
    extern __shared__ __attribute__((aligned(16))) unsigned char lds_raw[];
    float* sm = (float*)lds_raw; PG8_LAS unsigned char* lds = (PG8_LAS unsigned char*)lds_raw;
    volatile LAS unsigned* st = (volatile LAS unsigned*)(lds + LDS_MISC);
    if (threadIdx.x < 4) st[threadIdx.x] = 0u;
    __syncthreads();
    const int lo = p.ph_lo, hi = p.ph_hi;
    if (hi - lo > 1) (void)xcd_barrier_post((unsigned*)(p.ws + WS_CTL) + 4096, st);
    if (IN(0)) { RUN(100, ph_prologue(cx, sm)); RUN(101, ph_convert(cx, 0)); } SEAM(0);
    layer_program<0>(lo, hi, sm, lds, st);
    layer_program<1>(lo, hi, sm, lds, st);
}
}

extern "C" void kernel_launch(void* const* d_in, const int* in_sizes, int n_in, void* d_out, int out_size, void* d_ws, size_t ws_size, hipStream_t stream) {
    static int grid = 0;
    if (grid == 0) {
        if (n_in != 40 || out_size != TL * DM || ws_size < WS_END) { fprintf(stderr, "kernel_launch: unexpected shapes (n_in %d out %d ws %zu)\n", n_in, out_size, ws_size); grid = -1; return; }
        int dev = 0, cus = 0;
        if (hipGetDevice(&dev) != hipSuccess || hipDeviceGetAttribute(&cus, hipDeviceAttributeMultiprocessorCount, dev) != hipSuccess) { grid = -1; return; }
        if (hipFuncSetAttribute((const void*)mk_fwd, hipFuncAttributeMaxDynamicSharedMemorySize, LDS_BYTES) != hipSuccess) { fprintf(stderr, "kernel_launch: hipFuncSetAttribute failed\n"); grid = -1; return; }
        grid = cus;
    }
    if (grid < 0) return;
    (void)hipMemsetAsync((char*)d_ws + WS_CTL, 0, 1 * MiB, stream);
    Params a{};
    for (int i = 0; i < 40; ++i) a.in[i] = (const float*)d_in[i];
    a.out = (float*)d_out; a.ws = (unsigned char*)d_ws;
#if PER_PHASE_LAUNCH
    for (int ph = 0; ph < NPHASE; ++ph) { a.ph_lo = ph; a.ph_hi = ph + 1; hipLaunchKernelGGL(mk_fwd, dim3(grid), dim3(NTHREADS), LDS_BYTES, stream, a); }
#else
    a.ph_lo = 0; a.ph_hi = NPHASE; hipLaunchKernelGGL(mk_fwd, dim3(grid), dim3(NTHREADS), LDS_BYTES, stream, a);
#endif
}
```

```cpp
#include <hip/hip_runtime.h>
#include <stdint.h>
#include <math.h>
#include <stdio.h>

#ifndef PER_PHASE_LAUNCH
#define PER_PHASE_LAUNCH 0
#endif

#ifndef PROBE_HAS
#define PROBE_HAS(n) false
#endif
namespace {
typedef unsigned short bf16;
typedef float f32x4 __attribute__((ext_vector_type(4)));
typedef unsigned u32x2 __attribute__((ext_vector_type(2)));
typedef unsigned u32x4 __attribute__((ext_vector_type(4)));
typedef short bf16x8 __attribute__((ext_vector_type(8)));
#define LAS __attribute__((address_space(3)))

constexpr int DM = 1024, NBATCH = 4, SEQ = 4096, CTXL = 256, DEPTH = 2;
constexpr int TL = NBATCH * SEQ, TC = NBATCH * CTXL, TA = TL + TC;
constexpr int INW = 5888, COL_K = 512, COL_V = 640, COL_S5 = 768, COL_HY = 1280, COL_GATE = 2816;
constexpr int NTHREADS = 512, NWAVES = 8;
constexpr float NORM_EPS = 1e-6f;
constexpr float HY_FAST = 15.350567286626973f, HY_SLOW = 3.0701134573253945f;

constexpr size_t MiB = 1u << 20;
constexpr size_t WS_CTL = 0;
constexpr size_t WS_XCUR = 1 * MiB;
constexpr size_t WS_MODV = 69 * MiB;
constexpr size_t WS_ROPE = WS_MODV + 512 * 1024;
constexpr size_t WS_S5A = 70 * MiB;
constexpr size_t WS_S5B = 70 * MiB + 256 * 1024;
constexpr size_t WS_FILT = 72 * MiB;
constexpr size_t FILT_CTX_OFF = 16 * MiB;
constexpr size_t WS_WTS = 89 * MiB;
constexpr size_t WT_IN = WS_WTS;
constexpr size_t WT_GLU = WT_IN + 23 * MiB;
constexpr size_t WT_BR = WT_GLU + 1 * MiB;
constexpr size_t WT_OUT = WT_BR + 6 * MiB;
constexpr size_t WT_WQ = WT_OUT + 4 * MiB;
constexpr size_t WT_KEYS = WT_WQ + 8 * MiB;
constexpr size_t WS_H = 132 * MiB;
constexpr size_t WS_VV = WS_H;
constexpr size_t WS_VVC = WS_H + 32 * MiB;
constexpr size_t WS_Q = 166 * MiB;
constexpr size_t WS_K = 183 * MiB;
constexpr size_t WS_V = WS_K + (size_t)TA * 128 * 2;
constexpr size_t WS_U = WS_V + (size_t)TA * 128 * 2;
constexpr size_t WS_Z = WS_U + (size_t)TA * 512 * 2;
constexpr size_t WS_QP = WS_Q;
constexpr size_t WS_G = 260 * MiB;
constexpr size_t WS_ATT = 362 * MiB;
constexpr size_t WS_HY = WS_ATT + 17 * MiB, WS_S5O = WS_HY + 17 * MiB, WS_S5Y = WS_S5O + 17 * MiB;
constexpr size_t WS_M = 430 * MiB;
constexpr size_t WS_S5TMP = WS_M;
constexpr size_t WS_S5E = WS_M;
constexpr size_t WS_S5P = WS_M + 16 * MiB;
constexpr size_t WS_S5K = WS_M + 32 * MiB;
constexpr size_t WS_S5A64 = WS_S5A + 64 * 1024;
constexpr size_t WS_S5C = WS_S5A + 128 * 1024;
constexpr size_t WS_X0C = 464 * MiB;
constexpr size_t WS_EID = 481 * MiB;
constexpr size_t WS_EG = WS_EID + (size_t)TA * 128 * 4;
constexpr size_t WS_PU = WS_G;
constexpr size_t WS_PV = WS_G + 16 * MiB;
constexpr float PEER_SU = 512.f, PEER_SV = 64.f;
constexpr size_t WS_PART = WS_QP;
constexpr size_t WS_POUT = WS_ATT;
constexpr size_t WS_HIN = WS_EID;
constexpr size_t WS_END = 498 * MiB;
constexpr int LDS_STAGE = 131072;
constexpr int LDS_MISC = LDS_STAGE;
constexpr int LDS_BYTES = 147456;

struct Params {
    const float* in[40];
    float* out;
    unsigned char* ws;
    int ph_lo, ph_hi;
};
enum { I_X = 0, I_C, I_CTX, I_CCTX, I_MODW, I_MODB, I_N1G, I_N2G, I_INW, I_GATEB, I_SINK, I_HSW, I_HSB, I_HW1, I_HB1, I_HF1, I_HW2, I_HB2, I_HF2, I_HW3,
       I_HBIAS, I_SARE, I_SAIM, I_SLDT, I_SBRE, I_SBIM, I_SCRE, I_SCIM, I_SD, I_GLUW, I_GLUB, I_BRA, I_BRH, I_BRS, I_OUTW, I_WQ, I_PKEYS, I_PU, I_PV, I_FG };

struct Ctx { int tid, bid, nb; };
typedef __attribute__((address_space(4))) const Params CParams;
__device__ __forceinline__ CParams& get_params() { CParams* q = (CParams*)__builtin_amdgcn_kernarg_segment_ptr(); asm volatile("" : "+s"(q)); return *q; }
__device__ __forceinline__ float bf2f(bf16 v) { return __uint_as_float((unsigned)v << 16); }
typedef float f32x2_ __attribute__((ext_vector_type(2))); typedef __bf16 bf16x2_ __attribute__((ext_vector_type(2)));
__device__ __forceinline__ unsigned pk2(float lo, float hi) { const f32x2_ v = {lo, hi}; return __builtin_bit_cast(unsigned, __builtin_convertvector(v, bf16x2_)); }
__device__ __forceinline__ bf16 f2bf(float f) { return (bf16)(pk2(f, 0.f) & 0xffffu); }
__device__ __forceinline__ float wave_sum(float v) {
#pragma unroll
    for (int o = 32; o > 0; o >>= 1) v += __shfl_xor(v, o);
    return v;
}
__device__ __forceinline__ float fsin_rev(float rev) { return __builtin_amdgcn_sinf(rev); }
__device__ __forceinline__ float fcos_rev(float rev) { return __builtin_amdgcn_cosf(rev); }
__device__ __forceinline__ float fsin(float x) { return __builtin_amdgcn_sinf(x * 0.15915494309189535f); }
__device__ __forceinline__ float fcos(float x) { return __builtin_amdgcn_cosf(x * 0.15915494309189535f); }
typedef unsigned u32x2v __attribute__((ext_vector_type(2)));
__device__ __forceinline__ float max_x16(float v) { const auto r = __builtin_amdgcn_permlane16_swap(__float_as_uint(v), __float_as_uint(v), false, false); return fmaxf(__uint_as_float(r[0]), __uint_as_float(r[1])); }
__device__ __forceinline__ float max_x32(float v) { const auto r = __builtin_amdgcn_permlane32_swap(__float_as_uint(v), __float_as_uint(v), false, false); return fmaxf(__uint_as_float(r[0]), __uint_as_float(r[1])); }
__device__ __forceinline__ float sum_x16(float v) { const auto r = __builtin_amdgcn_permlane16_swap(__float_as_uint(v), __float_as_uint(v), false, false); return __uint_as_float(r[0]) + __uint_as_float(r[1]); }
__device__ __forceinline__ float sum_x32(float v) { const auto r = __builtin_amdgcn_permlane32_swap(__float_as_uint(v), __float_as_uint(v), false, false); return __uint_as_float(r[0]) + __uint_as_float(r[1]); }
__device__ __forceinline__ unsigned get_x16(unsigned v, int lane) { const auto r = __builtin_amdgcn_permlane16_swap(v, v, false, false); return (lane & 16) ? r[0] : r[1]; }
__device__ __forceinline__ unsigned get_x32(unsigned v, int lane) { const auto r = __builtin_amdgcn_permlane32_swap(v, v, false, false); return (lane & 32) ? r[0] : r[1]; }
__device__ __forceinline__ float sigmoidf_(float x) { return 1.f / (1.f + __expf(-x)); }
__device__ __forceinline__ float gelu_tanh(float x) { const float u = 0.7978845608028654f * (x + 0.044715f * x * x * x); const float e = __expf(2.f * u); return 0.5f * x * (2.f - 2.f / (e + 1.f)); }
__device__ __forceinline__ int row_mi(int r) { return r < TL ? (r >> 12) : 4; }
__device__ __forceinline__ int row_b(int r) { return r < TL ? (r >> 12) : ((r - TL) >> 8); }

#define XB_TMO      128
#define XB_XCNT(j)  (256  + 64 * (j))
#define XB_XSUB(j)  (1280 + 64 * (j))
#define XB_XGEN(j)  (2304 + 64 * (j))
#define XB_TOP      3328
#define XB_TOPGEN   3392
#define XCD_BAR_WORDS 3456
#define XB_SPIN_CAP (1u << 27)
__device__ __forceinline__ unsigned xb_ld(unsigned* p)              { return __hip_atomic_load(p, __ATOMIC_RELAXED, __HIP_MEMORY_SCOPE_AGENT); }
__device__ __forceinline__ unsigned xb_add(unsigned* p, unsigned v) { return __hip_atomic_fetch_add(p, v, __ATOMIC_RELAXED, __HIP_MEMORY_SCOPE_AGENT); }
__device__ __forceinline__ unsigned xb_xcc_id() { return (unsigned)__builtin_amdgcn_s_getreg((3 << 11) | 20) & 0xFu; }
#define XB_SPIN(cond, bar) do { unsigned _sp = 0; while (cond) { __builtin_amdgcn_s_sleep(1); \
    if ((++_sp & 255u) == 0u) { if (xb_ld(&(bar)[XB_TMO])) break; if (_sp > XB_SPIN_CAP) { atomicAdd(&(bar)[XB_TMO], 1u); break; } } } } while (0)
struct XcdBarrier { unsigned* bar; unsigned x; volatile LAS unsigned* st; };
__device__ __forceinline__ XcdBarrier xcd_barrier_post(unsigned* bar, volatile LAS unsigned* st) {
    XcdBarrier b; b.bar = bar; b.x = xb_xcc_id(); b.st = st;
    if (threadIdx.x == 0) (void)xb_add(&bar[XB_XCNT(b.x)], 1u);
    return b;
}
__device__ __forceinline__ void xcd_barrier_complete(unsigned* bar, unsigned x, unsigned& nloc, unsigned& nx) {
    const unsigned G = gridDim.x * gridDim.y * gridDim.z;
    unsigned sum, cnt, mine, sp = 0u;
    for (;;) {
        sum = 0u; cnt = 0u; mine = 0u;
#pragma unroll
        for (unsigned j = 0; j < 16; ++j) { const unsigned c = xb_ld(&bar[XB_XCNT(j)]); sum += c; cnt += (c > 0u) ? 1u : 0u; mine = (j == x) ? c : mine; }
        if (sum == G) break;
        __builtin_amdgcn_s_sleep(1);
        if ((++sp & 255u) == 0u) { if (xb_ld(&bar[XB_TMO])) break; if (sp > XB_SPIN_CAP) { atomicAdd(&bar[XB_TMO], 1u); break; } }
    }
    nloc = mine > 0u ? mine : 1u; nx = cnt > 0u ? cnt : 1u;
}
__device__ __forceinline__ void xcd_barrier(const XcdBarrier& b) {
    asm volatile("s_waitcnt vmcnt(0)" ::: "memory");
    __syncthreads();
    if (threadIdx.x == 0) {
        unsigned* bar = b.bar; asm volatile("" : "+s"(bar));
        __builtin_amdgcn_s_waitcnt(0);
        unsigned nloc = b.st[0], nx = b.st[1];
        if (nloc == 0u) { xcd_barrier_complete(bar, b.x, nloc, nx); b.st[0] = nloc; b.st[1] = nx; }
        const unsigned old = xb_add(&bar[XB_XSUB(b.x)], 1u);
        const unsigned gen = old / nloc;
        if (old + 1u == (gen + 1u) * nloc) {
            __builtin_amdgcn_fence(__ATOMIC_RELEASE, "agent");
            asm volatile("s_waitcnt vmcnt(0)" ::: "memory");
            const unsigned og = xb_add(&bar[XB_TOP], 1u);
            const unsigned tg = og / nx;
            if (og + 1u == (tg + 1u) * nx) xb_add(&bar[XB_TOPGEN], 1u);
            else XB_SPIN(xb_ld(&bar[XB_TOPGEN]) == tg, bar);
            __builtin_amdgcn_fence(__ATOMIC_ACQUIRE, "agent");
            xb_add(&bar[XB_XGEN(b.x)], 1u);
            asm volatile("s_waitcnt vmcnt(0)" ::: "memory");
        } else {
            XB_SPIN(xb_ld(&bar[XB_XGEN(b.x)]) == gen, bar);
            __builtin_amdgcn_fence(__ATOMIC_ACQUIRE, "agent");
            asm volatile("s_waitcnt vmcnt(0)" ::: "memory");
        }
    }
    __syncthreads();
}

__device__ __forceinline__ void ph_prologue(const Ctx& cx0, float* sm) {
    { CParams& p = get_params(); Ctx cx = cx0;
    const int tid = cx.tid, lane = tid & 63, wave = tid >> 6;
    const int gt = cx.bid * NTHREADS + tid, NGT = cx.nb * NTHREADS;
    const int gw = cx.bid * NWAVES + wave, NGW = cx.nb * NWAVES;
    unsigned char* ws = p.ws;
    }
    { CParams& p = get_params(); Ctx cx; cx.tid = threadIdx.x; cx.bid = blockIdx.x; cx.nb = gridDim.x; asm volatile("" : "+v"(cx.tid), "+s"(cx.bid), "+s"(cx.nb));
      const int tid = cx.tid, lane = tid & 63, wave = tid >> 6; const int gt = cx.bid * NTHREADS + tid, NGT = cx.nb * NTHREADS; const int gw = cx.bid * NWAVES + wave, NGW = cx.nb * NWAVES; unsigned char* ws = p.ws; (void)lane; (void)gt; (void)NGT; (void)gw; (void)NGW; (void)ws;
    {
        float* sil = sm;
        float* red = sm + 5 * 1024;
        bool have = false;
        for (int it = cx.bid; it < 192; it += cx.nb) {
            if (!have) {
                for (int i = tid; i < 5 * 1024; i += NTHREADS) { const float v = i < 4096 ? p.in[I_C][i] : p.in[I_CCTX][i - 4096]; sil[i] = v / (1.f + __expf(-v)); }
                have = true; __syncthreads();
            }
            const int layer = it / 96, col = (it % 96) * 64 + lane, kp = wave;
            const float* W = p.in[I_MODW] + (size_t)layer * DM * 6144 + col;
            float a0 = 0, a1 = 0, a2 = 0, a3 = 0, a4 = 0;
#pragma unroll 1
            for (int k0 = kp * 128; k0 < kp * 128 + 128; k0 += 16) { float w[16];
#pragma unroll
                for (int q = 0; q < 16; ++q) w[q] = W[(size_t)(k0 + q) * 6144];
#pragma unroll
                for (int q = 0; q < 16; ++q) { const int k = k0 + q; a0 += sil[k] * w[q]; a1 += sil[1024 + k] * w[q]; a2 += sil[2048 + k] * w[q]; a3 += sil[3072 + k] * w[q]; a4 += sil[4096 + k] * w[q]; } }
            red[(kp * 5 + 0) * 64 + lane] = a0; red[(kp * 5 + 1) * 64 + lane] = a1; red[(kp * 5 + 2) * 64 + lane] = a2; red[(kp * 5 + 3) * 64 + lane] = a3; red[(kp * 5 + 4) * 64 + lane] = a4;
            __syncthreads();
            if (tid < 320) { const int j = tid >> 6; float s = 0; for (int q = 0; q < 8; ++q) s += red[(q * 5 + j) * 64 + lane];
                ((float*)(ws + WS_MODV))[((size_t)layer * 5 + j) * 6144 + col] = s + p.in[I_MODB][layer * 6144 + col]; }
            __syncthreads();
        }
    }
    }
    { CParams& p = get_params(); Ctx cx; cx.tid = threadIdx.x; cx.bid = blockIdx.x; cx.nb = gridDim.x; asm volatile("" : "+v"(cx.tid), "+s"(cx.bid), "+s"(cx.nb));
      const int tid = cx.tid, lane = tid & 63, wave = tid >> 6; const int gt = cx.bid * NTHREADS + tid, NGT = cx.nb * NTHREADS; const int gw = cx.bid * NWAVES + wave, NGW = cx.nb * NWAVES; unsigned char* ws = p.ws; (void)lane; (void)gt; (void)NGT; (void)gw; (void)NGW; (void)ws;
    for (int i = gt; i < 64 * 16; i += NGT) { const int pos = i >> 4, f = i & 15; const float ang = (float)pos * exp2f(-(float)f * (13.287712379549449f / 16.f));
        ((float*)(ws + WS_ROPE))[i * 2] = fcos(ang); ((float*)(ws + WS_ROPE))[i * 2 + 1] = fsin(ang); }
    }
}


__device__ __forceinline__ void ph_filters(const Ctx& cx, int layer, float* sm) {
    CParams& p = get_params();
    const int tid = cx.tid, lane = tid & 63, wave = __builtin_amdgcn_readfirstlane(tid >> 6), l15 = lane & 15, kg = lane >> 4;
    bf16* Hb = (bf16*)sm;
    float* W12 = sm + 64 * 72 / 2;
    const float* w1 = p.in[I_HW1] + layer * 33 * 64; const float* w2 = p.in[I_HW2] + layer * 64 * 64; const float* w3 = p.in[I_HW3] + layer * 64 * 1024;
    for (int it = cx.bid; it < 2 * 68; it += cx.nb) {
        const int tile = it >> 1, ch = it & 1, st = tile >= 64 ? 1 : 0, tb = st ? (tile - 64) * 64 : tile * 64, L = st ? CTXL : SEQ;
        __syncthreads();
        for (int i = tid; i < 97 * 64; i += NTHREADS) W12[i] = i < 33 * 64 ? w1[i] : w2[i - 33 * 64];
        bf16x8 bw[4][2];
#pragma unroll
        for (int nt = 0; nt < 4; ++nt)
#pragma unroll
            for (int ks = 0; ks < 2; ++ks) { const float* s = w3 + (size_t)(32 * ks + 8 * kg) * 1024 + ch * 512 + wave * 64 + 16 * nt + l15;
                u32x4 w; w.x = pk2(s[0], s[1024]); w.y = pk2(s[2048], s[3072]); w.z = pk2(s[4096], s[5120]); w.w = pk2(s[6144], s[7168]); bw[nt][ks] = __builtin_bit_cast(bf16x8, w); }
        __syncthreads();
        {
            float z[8], a[8], h1[8], a2[8];
            const float b1 = p.in[I_HB1][layer * 64 + lane], f1 = p.in[I_HF1][layer * 64 + lane], b2 = p.in[I_HB2][layer * 64 + lane], f2 = p.in[I_HF2][layer * 64 + lane];
#pragma unroll
            for (int q = 0; q < 8; ++q) { const float tn = (float)(tb + wave + 8 * q) / (float)L; z[q] = 0.f;
                if (lane == 0) z[q] = tn; else if (lane <= 16) z[q] = fcos_rev(tn * (float)lane); else if (lane <= 32) z[q] = fsin_rev(tn * (float)(lane - 16)); a[q] = b1; }
#pragma unroll 3
            for (int e = 0; e < 33; ++e) { const float w = W12[e * 64 + lane];
#pragma unroll
                for (int q = 0; q < 8; ++q) a[q] += __shfl(z[q], e) * w; }
#pragma unroll
            for (int q = 0; q < 8; ++q) { h1[q] = fsin(f1 * a[q]); a2[q] = b2; }
#pragma unroll 4
            for (int j = 0; j < 64; ++j) { const float w = W12[33 * 64 + j * 64 + lane];
#pragma unroll
                for (int q = 0; q < 8; ++q) a2[q] += __shfl(h1[q], j) * w; }
#pragma unroll
            for (int q = 0; q < 8; ++q) Hb[(wave + 8 * q) * 72 + lane] = f2bf(fsin(f2 * a2[q]));
        }
        __syncthreads();
        float* fbase = (float*)(p.ws + WS_FILT + (st ? FILT_CTX_OFF : 0));
#pragma unroll
        for (int mt = 0; mt < 4; ++mt) {
            bf16x8 af[2];
#pragma unroll
            for (int ks = 0; ks < 2; ++ks) af[ks] = *(const bf16x8*)(Hb + (16 * mt + l15) * 72 + 32 * ks + 8 * kg);
            const int t0 = tb + 16 * mt + 4 * kg;
            f32x4 tw;
#pragma unroll
            for (int r = 0; r < 4; ++r) tw[r] = (float)(t0 + r) / (float)(L - 1);
#pragma unroll
            for (int nt = 0; nt < 4; ++nt) {
                f32x4 acc = (f32x4){0.f, 0.f, 0.f, 0.f};
                acc = __builtin_amdgcn_mfma_f32_16x16x32_bf16(af[0], bw[nt][0], acc, 0, 0, 0); acc = __builtin_amdgcn_mfma_f32_16x16x32_bf16(af[1], bw[nt][1], acc, 0, 0, 0);
                const int c = wave * 64 + 16 * nt + l15;
                const float rate = HY_FAST + (HY_SLOW - HY_FAST) * ((float)c / 511.f);
                f32x4 o;
#pragma unroll
                for (int r = 0; r < 4; ++r) o[r] = acc[r] * __expf(-tw[r] * rate);
                *(f32x4*)(fbase + ((size_t)ch * 512 + c) * L + t0) = o;
            }
        }
    }
}
__device__ __forceinline__ void conv_T(const Ctx& cx, const float* W, int K, int N, bf16* dst, bool perm) {
    const int gt = cx.bid * NTHREADS + cx.tid, NGT = cx.nb * NTHREADS;
    for (int it = gt; it < N * (K / 8); it += NGT) {
        const int n = it % N, k0 = (it / N) * 8;
        const int sn = (perm && n < COL_V) ? ((n & ~63) + ((n & 63) >> 1) + 32 * (n & 1)) : n;
        const float* s = W + (size_t)k0 * N + sn;
        u32x4 w; w.x = pk2(s[0], s[N]); w.y = pk2(s[2 * (size_t)N], s[3 * (size_t)N]); w.z = pk2(s[4 * (size_t)N], s[5 * (size_t)N]); w.w = pk2(s[6 * (size_t)N], s[7 * (size_t)N]);
        *(u32x4*)(dst + (size_t)n * K + k0) = w;
    }
}
__device__ __forceinline__ void ph_convert(const Ctx& cx0, int layer) {
#define RELAUNDER() CParams& p = get_params(); Ctx cx; cx.tid = threadIdx.x; cx.bid = __builtin_amdgcn_readfirstlane(cx0.bid); cx.nb = __builtin_amdgcn_readfirstlane(cx0.nb); asm volatile("" : "+v"(cx.tid), "+s"(cx.bid), "+s"(cx.nb));
    { RELAUNDER(); conv_T(cx, p.in[I_INW] + (size_t)layer * DM * INW, DM, INW, (bf16*)(p.ws + WT_IN) + (size_t)layer * INW * DM, true); }
    { RELAUNDER(); conv_T(cx, p.in[I_GLUW] + (size_t)layer * 512 * 512, 512, 512, (bf16*)(p.ws + WT_GLU) + (size_t)layer * 512 * 512, false); }
    { RELAUNDER(); conv_T(cx, p.in[I_BRA] + (size_t)layer * 512 * 1024, 512, 1024, (bf16*)(p.ws + WT_BR) + (size_t)(layer * 3 + 0) * 1024 * 512, false); }
    { RELAUNDER(); conv_T(cx, p.in[I_BRH] + (size_t)layer * 512 * 1024, 512, 1024, (bf16*)(p.ws + WT_BR) + (size_t)(layer * 3 + 1) * 1024 * 512, false); }
    { RELAUNDER(); conv_T(cx, p.in[I_BRS] + (size_t)layer * 512 * 1024, 512, 1024, (bf16*)(p.ws + WT_BR) + (size_t)(layer * 3 + 2) * 1024 * 512, false); }
    { RELAUNDER(); conv_T(cx, p.in[I_OUTW] + (size_t)layer * 1024 * 1024, 1024, 1024, (bf16*)(p.ws + WT_OUT) + (size_t)layer * 1024 * 1024, false); }
    { RELAUNDER(); conv_T(cx, p.in[I_WQ] + (size_t)layer * 1024 * 2048, 1024, 2048, (bf16*)(p.ws + WT_WQ) + (size_t)layer * 2048 * 1024, false); }
    if (layer == 0) { RELAUNDER(); const int gt = cx.bid * NTHREADS + cx.tid, NGT = cx.nb * NTHREADS;
      for (int i = gt; i < 2 * 8 * 2 * 128 * 128 / 4; i += NGT) { const f32x4 v = ((const f32x4*)p.in[I_PKEYS])[i]; u32x2 w; w.x = pk2(v[0], v[1]); w.y = pk2(v[2], v[3]);
          const int k4 = i & 31, n = (i >> 5) & 127, lhs = i >> 12;
          ((u32x2*)(p.ws + WT_KEYS))[(((size_t)lhs * 8 + (k4 >> 2)) * 128 + n) * 4 + (k4 & 3)] = w; } }
#undef RELAUNDER
}

__device__ __forceinline__ void ph_norm(const Ctx& cx, int layer, int which, int nrows_lat_only) {
    CParams& p = get_params();
    const int lane = cx.tid & 63, wave = cx.tid >> 6;
    const int gw = cx.bid * NWAVES + wave, NGW = cx.nb * NWAVES;
    const float* g = p.in[which ? I_N2G : I_N1G] + layer * DM;
    const float* xc = (const float*)(p.ws + WS_XCUR);
    bf16* H = (bf16*)(p.ws + WS_H);
    const int nrows = nrows_lat_only ? TL : TA;
    for (int r = gw; r < nrows; r += NGW) {
        const float* mv = (const float*)(p.ws + WS_MODV) + ((size_t)layer * 5 + row_mi(r)) * 6144 + (which ? 3072 : 0);
        f32x4 v[4]; float s = 0.f;
        const float* xr = (which == 0 && layer == 0) ? (r < TL ? p.in[I_X] + (size_t)r * DM : p.in[I_CTX] + (size_t)(r - TL) * DM) : xc + (size_t)r * DM;
#pragma unroll
        for (int j = 0; j < 4; ++j) { v[j] = *(const f32x4*)(xr + j * 256 + lane * 4); s += v[j].x * v[j].x + v[j].y * v[j].y + v[j].z * v[j].z + v[j].w * v[j].w; }
        const float rs = rsqrtf(wave_sum(s) * (1.f / DM) + NORM_EPS);
#pragma unroll
        for (int j = 0; j < 4; ++j) { const int c = j * 256 + lane * 4;
            const f32x4 gg = *(const f32x4*)(g + c), sh = *(const f32x4*)(mv + c), sc = *(const f32x4*)(mv + 1024 + c);
            const f32x4 y = v[j] * rs * gg; const f32x4 h = y * (1.f + sc) + sh;
            u32x2 w; w.x = pk2(h.x, h.y); w.y = pk2(h.z, h.w); *(u32x2*)(H + (size_t)r * DM + c) = w; }
    }
}


namespace pg8 {
#define PG8_LAS __attribute__((address_space(3)))
typedef unsigned short bf16_t;
typedef short bf16x8 __attribute__((ext_vector_type(8)));
constexpr int BM = 256, BK = 64, HALF = 128, HTB = HALF * BK * 2, STAGE_BYTES = 8 * HTB, NXCD = 8, WGM = 8;
__host__ __device__ __forceinline__ int lds_byte(int r, int c) { const int st = (r >> 4) * 2 + (c >> 5), rr = r & 15, cc = c & 31, ob = rr * 64 + cc * 2; return st * 1024 + (ob ^ (((ob >> 9) & 1) << 5)); }
__host__ __device__ __forceinline__ void stage_rc(int b, int& R, int& C) { const int st = b / 1024, sb = b % 1024, swz = sb ^ (((sb >> 9) & 1) << 5); R = (st >> 1) * 16 + swz / 64; C = (st & 1) * 32 + (swz % 64) / 2; }
__host__ __device__ __forceinline__ int perm32(int rho) { const int n = rho >> 4, i = rho & 15; return 8 * (i >> 2) + 4 * n + (i & 3); }
struct Unit { int pm, pn, z; };
struct Gemm { const bf16_t* A; const bf16_t* Bt; size_t zsA, zsB; int K; };
__device__ __forceinline__ const bf16_t* selA(const Gemm& g, int z) { return g.A + (size_t)z * g.zsA; }
__device__ __forceinline__ const bf16_t* selB(const Gemm& g, int z) { return g.Bt + (size_t)z * g.zsB; }
struct TileOrder {
    int nM, nN, nwg, G, c, extra, exN, expn0, nz;
    __device__ __forceinline__ bool next(int i, Unit& u) const {
        const int ti = i / nz; u.z = i - ti * nz;
        const long L = (long)ti * G + c;
        if (L < nwg) {
            int wgid = (int)L; { const int q = nwg / NXCD, r = nwg % NXCD, xcd = wgid % NXCD, off = wgid / NXCD; wgid = (xcd < r ? xcd * (q + 1) : r * (q + 1) + (xcd - r) * q) + off; }
            const int nig = WGM * nN, gid = wgid / nig, fm = gid * WGM, gsz = (nM - fm) < WGM ? (nM - fm) : WGM;
            u.pm = fm + ((wgid % nig) % gsz); u.pn = (wgid % nig) / gsz; return true;
        }
        const int e = (int)(L - nwg); if (e >= extra) return false;
        u.pm = nM + e / exN; u.pn = expn0 + e % exN; return true;
    }
};
__device__ __forceinline__ unsigned cvt_pk_bf16(float lo, float hi) { unsigned r; asm volatile("v_cvt_pk_bf16_f32 %0, %1, %2" : "=v"(r) : "v"(lo), "v"(hi)); return r; }
template <class Epi, class Sched, bool ALIGN_EPI = true, bool SP2 = true>
__device__ __forceinline__ void gemm_phase(PG8_LAS unsigned char* lds, const Gemm g, const Sched& S, const Epi& E, const int tid_) {
    const int tid = tid_, wid = __builtin_amdgcn_readfirstlane(tid >> 6), lane = tid & 63, wr = wid >> 2, wc = wid & 3, fr = lane & 15, fq = lane >> 4;
    const int K = g.K, nt = K / BK;
    unsigned voffA[2], voffB[2];
#pragma unroll
    for (int i = 0; i < 2; ++i) { int R, C; stage_rc(tid * 16 + i * 8192, R, C); const int Rb = Epi::PERM ? ((R & ~31) + perm32(R & 31)) : R;
        voffA[i] = (unsigned)(R * K + C) * 2u; voffB[i] = (unsigned)(Rb * K + C) * 2u; }
    const size_t kstep = (size_t)(BK * 2);
    const size_t hstep = (size_t)HALF * K * 2;
    const size_t tstep = 2 * hstep;
    const unsigned ldsw = (unsigned)wid * 1024u;
    const int aoff = lds_byte(wr * 64 + fr, fq * 8), boff = lds_byte(wc * 32 + fr, fq * 8);
#define PG8_SA(b, h) (((b) * 2 + (h)) * HTB)
#define PG8_SB(b, h) ((4 + (b) * 2 + (h)) * HTB)
#define PG8_STAGE(bufoff, gbase, voff) do { _Pragma("unroll") for (int _i = 0; _i < 2; ++_i) \
        __builtin_amdgcn_global_load_lds((const unsigned*)((const char*)(gbase) + (voff)[_i]), (PG8_LAS unsigned*)(lds + (bufoff) + ldsw + _i * 8192), 16, 0, 0); } while (0)
#define PG8_LDA(dst, b, h) do { _Pragma("unroll") for (int m = 0; m < 4; ++m) _Pragma("unroll") for (int k = 0; k < 2; ++k) dst[m][k] = *(const PG8_LAS bf16x8*)(lds + PG8_SA(b, h) + aoff + m * 2048 + k * 1024); } while (0)
#define PG8_LDB(dst, b, h) do { _Pragma("unroll") for (int n = 0; n < 2; ++n) _Pragma("unroll") for (int k = 0; k < 2; ++k) dst[n][k] = *(const PG8_LAS bf16x8*)(lds + PG8_SB(b, h) + boff + n * 2048 + k * 1024); } while (0)
#define PG8_MMA(ai, bj, At, Bt) do { __builtin_amdgcn_s_setprio(1); _Pragma("unroll") for (int m = 0; m < 4; ++m) _Pragma("unroll") for (int n = 0; n < 2; ++n) _Pragma("unroll") for (int k = 0; k < 2; ++k) \
        acc[ai][bj][m][n] = __builtin_amdgcn_mfma_f32_16x16x32_bf16(Bt[n][k], At[m][k], acc[ai][bj][m][n], 0, 0, 0); __builtin_amdgcn_s_setprio(0); } while (0)
#define PG8_WAIT_V(n) asm volatile("s_waitcnt vmcnt(" #n ")" ::: "memory")
#define PG8_WAIT_L(n) asm volatile("s_waitcnt lgkmcnt(" #n ")" ::: "memory")
#define PG8_BAR __builtin_amdgcn_s_barrier()
#define PG8_SCHED __builtin_amdgcn_sched_barrier(0)
    Unit cur, nxt; int ui = 0;
    if (!S.next(0, cur)) return;
    f32x4 acc[2][2][4][2];
#pragma unroll
    for (int a = 0; a < 2; ++a)
#pragma unroll
        for (int b = 0; b < 2; ++b)
#pragma unroll
            for (int m = 0; m < 4; ++m)
#pragma unroll
                for (int n = 0; n < 2; ++n) acc[a][b][m][n] = (f32x4){0.f, 0.f, 0.f, 0.f};
    bf16x8 At[4][2], B0[2][2], B1[2][2];
    const char* cA = (const char*)selA(g, cur.z) + (size_t)cur.pm * tstep; const char* cB = (const char*)selB(g, cur.z) + (size_t)cur.pn * tstep;
    if constexpr (SP2) {
        PG8_STAGE(PG8_SB(0, 0), cB, voffB); PG8_STAGE(PG8_SB(0, 1), cB + hstep, voffB); PG8_STAGE(PG8_SA(0, 0), cA, voffA); PG8_STAGE(PG8_SA(0, 1), cA + hstep, voffA);
        if (wr == 1) PG8_BAR;
        PG8_WAIT_V(2); PG8_BAR;
        PG8_STAGE(PG8_SB(1, 0), cB + kstep, voffB); PG8_STAGE(PG8_SA(1, 0), cA + kstep, voffA); PG8_STAGE(PG8_SB(1, 1), cB + hstep + kstep, voffB);
        PG8_WAIT_V(6); PG8_BAR;
    } else {
        PG8_STAGE(PG8_SB(0, 0), cB, voffB); PG8_STAGE(PG8_SA(0, 0), cA, voffA); PG8_STAGE(PG8_SB(0, 1), cB + hstep, voffB); PG8_STAGE(PG8_SA(0, 1), cA + hstep, voffA);
        if (wr == 1) PG8_BAR;
        PG8_WAIT_V(4); PG8_BAR;
        PG8_STAGE(PG8_SB(1, 0), cB + kstep, voffB); PG8_STAGE(PG8_SA(1, 0), cA + kstep, voffA); PG8_STAGE(PG8_SB(1, 1), cB + hstep + kstep, voffB);
        PG8_WAIT_V(6); PG8_BAR;
    }
    for (;;) {
        const bool has_next = S.next(ui + 1, nxt);
        const char* nA = has_next ? (const char*)selA(g, nxt.z) + (size_t)nxt.pm * tstep : cA; const char* nB = has_next ? (const char*)selB(g, nxt.z) + (size_t)nxt.pn * tstep : cB;
        for (int t = 0; t < nt; t += 2) {
            const bool last = (t == nt - 2);
            const char* a1 = cA + (size_t)(t + 1) * kstep;
            const char* a2 = last ? nA : cA + (size_t)(t + 2) * kstep; const char* b2 = last ? nB : cB + (size_t)(t + 2) * kstep;
            const char* a3 = a2 + kstep; const char* b3 = b2 + kstep;
            if constexpr (SP2) {
            PG8_LDB(B0, 0, 0); PG8_LDB(B1, 0, 1); PG8_SCHED; PG8_LDA(At, 0, 0); PG8_STAGE(PG8_SA(1, 1), a1 + hstep, voffA);
            PG8_WAIT_V(8); PG8_WAIT_L(0); PG8_BAR; PG8_MMA(0, 0, At, B0); PG8_MMA(0, 1, At, B1); PG8_BAR; PG8_SCHED;
            PG8_LDA(At, 0, 1); PG8_STAGE(PG8_SB(0, 0), b2, voffB); PG8_STAGE(PG8_SB(0, 1), b2 + hstep, voffB); PG8_STAGE(PG8_SA(0, 0), a2, voffA);
            PG8_WAIT_V(8); PG8_WAIT_L(0); PG8_BAR; PG8_MMA(1, 0, At, B0); PG8_MMA(1, 1, At, B1); PG8_BAR; PG8_SCHED;
            PG8_LDB(B0, 1, 0); PG8_LDB(B1, 1, 1); PG8_SCHED; PG8_LDA(At, 1, 0); PG8_STAGE(PG8_SA(0, 1), a2 + hstep, voffA);
            PG8_WAIT_V(8); PG8_WAIT_L(0); PG8_BAR; PG8_MMA(0, 0, At, B0); PG8_MMA(0, 1, At, B1); PG8_BAR; PG8_SCHED;
            PG8_LDA(At, 1, 1); PG8_STAGE(PG8_SB(1, 0), b3, voffB); PG8_STAGE(PG8_SB(1, 1), b3 + hstep, voffB); PG8_STAGE(PG8_SA(1, 0), a3, voffA);
            PG8_WAIT_V(8); PG8_WAIT_L(0); PG8_BAR; PG8_MMA(1, 0, At, B0); PG8_MMA(1, 1, At, B1); PG8_BAR; PG8_SCHED;
            } else {
            PG8_LDB(B0, 0, 0); PG8_SCHED; PG8_LDA(At, 0, 0); PG8_STAGE(PG8_SA(1, 1), a1 + hstep, voffA);
            PG8_WAIT_L(8); PG8_BAR; PG8_WAIT_L(0); PG8_MMA(0, 0, At, B0); PG8_BAR; PG8_SCHED;
            PG8_LDB(B1, 0, 1); PG8_STAGE(PG8_SB(0, 0), b2, voffB);
            PG8_BAR; PG8_WAIT_L(0); PG8_MMA(0, 1, At, B1); PG8_BAR;
            PG8_LDA(At, 0, 1); PG8_STAGE(PG8_SA(0, 0), a2, voffA);
            PG8_BAR; PG8_WAIT_L(0); PG8_MMA(1, 0, At, B0); PG8_BAR; PG8_SCHED;
            PG8_STAGE(PG8_SB(0, 1), b2 + hstep, voffB);
            PG8_WAIT_V(6); PG8_BAR; PG8_MMA(1, 1, At, B1); PG8_BAR;
            PG8_LDB(B0, 1, 0); PG8_SCHED; PG8_LDA(At, 1, 0); PG8_STAGE(PG8_SA(0, 1), a2 + hstep, voffA);
            PG8_WAIT_L(8); PG8_BAR; PG8_WAIT_L(0); PG8_MMA(0, 0, At, B0); PG8_BAR; PG8_SCHED;
            PG8_LDB(B1, 1, 1); PG8_STAGE(PG8_SB(1, 0), b3, voffB);
            PG8_BAR; PG8_WAIT_L(0); PG8_MMA(0, 1, At, B1); PG8_BAR;
            PG8_LDA(At, 1, 1); PG8_STAGE(PG8_SA(1, 0), a3, voffA);
            PG8_BAR; PG8_WAIT_L(0); PG8_MMA(1, 0, At, B0); PG8_BAR; PG8_SCHED;
            PG8_STAGE(PG8_SB(1, 1), b3 + hstep, voffB);
            PG8_WAIT_V(6); PG8_BAR; PG8_MMA(1, 1, At, B1); PG8_BAR;
            }
        }
        if constexpr (ALIGN_EPI) { if (wr == 0) PG8_BAR; }
        const bool keep = E(acc, cur, wr, wc, fr, fq);
        if (!has_next) break;
        if (!keep) {
#pragma unroll
        for (int a = 0; a < 2; ++a)
#pragma unroll
            for (int b = 0; b < 2; ++b)
#pragma unroll
                for (int m = 0; m < 4; ++m)
#pragma unroll
                    for (int n = 0; n < 2; ++n) acc[a][b][m][n] = (f32x4){0.f, 0.f, 0.f, 0.f};
        }
        cur = nxt; cA = nA; cB = nB; ++ui;
        if constexpr (ALIGN_EPI) { if (wr == 1) PG8_BAR; }
    }
    PG8_WAIT_V(0);
    if constexpr (!ALIGN_EPI) { if (wr == 0) PG8_BAR; }
    PG8_BAR;
#undef PG8_SA
#undef PG8_SB
#undef PG8_STAGE
#undef PG8_LDA
#undef PG8_LDB
#undef PG8_MMA
#undef PG8_WAIT_V
#undef PG8_WAIT_L
#undef PG8_BAR
#undef PG8_SCHED
}
}

__device__ __forceinline__ f32x4 bf4lo(u32x4 w) { return (f32x4){__uint_as_float(w.x << 16), __uint_as_float(w.x & 0xffff0000u), __uint_as_float(w.y << 16), __uint_as_float(w.y & 0xffff0000u)}; }
__device__ __forceinline__ f32x4 bf4hi(u32x4 w) { return (f32x4){__uint_as_float(w.z << 16), __uint_as_float(w.z & 0xffff0000u), __uint_as_float(w.w << 16), __uint_as_float(w.w & 0xffff0000u)}; }
__device__ __forceinline__ u32x4 pack8(f32x4 a, f32x4 b) { u32x4 w; w.x = pg8::cvt_pk_bf16(a[0], a[1]); w.y = pg8::cvt_pk_bf16(a[2], a[3]); w.z = pg8::cvt_pk_bf16(b[0], b[1]); w.w = pg8::cvt_pk_bf16(b[2], b[3]); return w; }
__device__ __forceinline__ f32x4 sig4(f32x4 v) { return (f32x4){sigmoidf_(v[0]), sigmoidf_(v[1]), sigmoidf_(v[2]), sigmoidf_(v[3])}; }

__device__ __forceinline__ size_t s5_uidx(int g, int b, int n, int s) { return ((((size_t)(g * 4 + b) * 64 + s) * 68 + n) * 16); }
template <class T> __device__ __forceinline__ T* uni_ptr(T* q) { unsigned long long a = (unsigned long long)q; unsigned lo = __builtin_amdgcn_readfirstlane((unsigned)a), hi = __builtin_amdgcn_readfirstlane((unsigned)(a >> 32));
    asm volatile("" : "+s"(lo), "+s"(hi)); return (T*)(((unsigned long long)hi << 32) | lo); }
struct EpiInproj {
    static constexpr bool PERM = true;
    unsigned char* ws; const float* gate_b;
    __device__ __forceinline__ bool operator()(f32x4 (&acc)[2][2][4][2], const pg8::Unit& u, int wr, int wc, int fr_, int fq_) const {
        int fr = fr_, fq = fq_; asm volatile("" : "+v"(fr), "+v"(fq)); unsigned char* const ws = uni_ptr(this->ws);
        const int cl = wc * 32 + 8 * fq, rbase = u.pm * 256 + wr * 64 + fr;
#pragma unroll
        for (int bj = 0; bj < 2; ++bj) {
            const int c128 = u.pn * 256 + bj * 128;
            unsigned char* base; unsigned rstride, coff; int kind = 0;
            if (c128 < COL_K)         { base = ws + WS_Q; rstride = 1024; coff = (unsigned)(c128 + cl) * 2u; kind = 1; }
            else if (c128 < COL_V)    { base = ws + WS_K + (size_t)(cl >> 5) * TA * 64; rstride = 64; coff = (unsigned)(cl & 31) * 2u; kind = 1; }
            else if (c128 < COL_S5)   { base = ws + WS_V; rstride = 256;  coff = (unsigned)cl * 2u; }
            else if (c128 < COL_HY)   { base = ws + WS_U; rstride = 0; coff = 0; kind = 3; }
            else if (c128 < COL_GATE) { base = ws + WS_Z; rstride = 3072; coff = (unsigned)(c128 - COL_HY + cl) * 2u; }
            else                      { base = ws + WS_G; rstride = 6144; coff = (unsigned)(c128 - COL_GATE + cl) * 2u; kind = 2; }
            if (kind == 1) {
                const float* rope = (const float*)(ws + WS_ROPE) + 8 * fq;
#pragma unroll
                for (int ai = 0; ai < 2; ++ai)
#pragma unroll
                    for (int m = 0; m < 4; ++m) {
                        const int r = rbase + ai * 128 + m * 16;
                        f32x4 v0 = acc[ai][bj][m][0], v1 = acc[ai][bj][m][1];
                        if (r < TL) { const int l = r & 4095, pos = (wc & 1) ? (l & 63) : (l >> 6);
                            const f32x4 t0 = *(const f32x4*)(rope + pos * 32), t1 = *(const f32x4*)(rope + pos * 32 + 4);
                            v0 = (f32x4){v0[0] * t0[0] - v0[1] * t0[1], v0[0] * t0[1] + v0[1] * t0[0], v0[2] * t0[2] - v0[3] * t0[3], v0[2] * t0[3] + v0[3] * t0[2]};
                            v1 = (f32x4){v1[0] * t1[0] - v1[1] * t1[1], v1[0] * t1[1] + v1[1] * t1[0], v1[2] * t1[2] - v1[3] * t1[3], v1[2] * t1[3] + v1[3] * t1[2]}; }
                        *(u32x4*)(base + ((unsigned)r * rstride + coff)) = pack8(v0, v1);
                        asm volatile("" ::: "memory");
                    }
            } else if (kind == 2) {
                const float* gb = uni_ptr(gate_b) + (c128 - COL_GATE) + cl; const f32x4 b0 = *(const f32x4*)gb, b1 = *(const f32x4*)(gb + 4);
#pragma unroll
                for (int ai = 0; ai < 2; ++ai)
#pragma unroll
                    for (int m = 0; m < 4; ++m) {
                        const int r = rbase + ai * 128 + m * 16;
                        *(u32x4*)(base + ((unsigned)r * rstride + coff)) = pack8(sig4(acc[ai][bj][m][0] + b0), sig4(acc[ai][bj][m][1] + b1));
                        asm volatile("" ::: "memory");
                    }
            } else if (kind == 3) {
                const int ch = c128 - COL_S5 + cl, g = ch >> 4, i0 = ch & 15;
#pragma unroll
                for (int ai = 0; ai < 2; ++ai)
#pragma unroll
                    for (int m = 0; m < 4; ++m) {
                        const int r = rbase + ai * 128 + m * 16; int b, n, s;
                        if (r < TL) { b = r >> 12; n = 4 + ((r & 4095) >> 6); s = r & 63; } else { const int j = r - TL; b = j >> 8; n = (j & 255) >> 6; s = j & 63; }
                        *(u32x4*)((bf16*)base + s5_uidx(g, b, n, s) + i0) = pack8(acc[ai][bj][m][0], acc[ai][bj][m][1]);
                    }
            } else {
#pragma unroll
                for (int ai = 0; ai < 2; ++ai)
#pragma unroll
                    for (int m = 0; m < 4; ++m) {
                        const int r = rbase + ai * 128 + m * 16;
                        *(u32x4*)(base + ((unsigned)r * rstride + coff)) = pack8(acc[ai][bj][m][0], acc[ai][bj][m][1]);
                    }
            }
        }
        return false;
    }
};
struct EpiGlu {
    static constexpr bool PERM = true;
    unsigned char* ws; const float* bias;
    __device__ __forceinline__ bool operator()(f32x4 (&acc)[2][2][4][2], const pg8::Unit& u, int wr, int wc, int fr_, int fq_) const {
        int fr = fr_, fq = fq_; asm volatile("" : "+v"(fr), "+v"(fq)); unsigned char* const ws = uni_ptr(this->ws);
#pragma unroll
        for (int bj = 0; bj < 2; ++bj) { const int c = u.pn * 256 + bj * 128 + wc * 32 + 8 * fq; const f32x4 b0 = *(const f32x4*)(bias + c), b1 = *(const f32x4*)(bias + c + 4);
#pragma unroll
            for (int ai = 0; ai < 2; ++ai)
#pragma unroll
                for (int m = 0; m < 4; ++m) { const size_t o = (size_t)(u.pm * 256 + ai * 128 + wr * 64 + m * 16 + fr) * 512 + c;
                    const u32x4 yw = *(const u32x4*)((const bf16*)(ws + WS_S5Y) + o);
                    *(u32x4*)((bf16*)(ws + WS_S5O) + o) = pack8(bf4lo(yw) * sig4(acc[ai][bj][m][0] + b0), bf4hi(yw) * sig4(acc[ai][bj][m][1] + b1)); asm volatile("" ::: "memory"); } }
        return false;
    }
};
struct EpiMerge {
    static constexpr bool PERM = true;
    unsigned char* ws;
    __device__ __forceinline__ bool operator()(f32x4 (&acc)[2][2][4][2], const pg8::Unit& u, int wr, int wc, int fr_, int fq_) const {
        int fr = fr_, fq = fq_; asm volatile("" : "+v"(fr), "+v"(fq)); unsigned char* const ws = uni_ptr(this->ws);
#pragma unroll
        for (int bj = 0; bj < 2; ++bj) { const int c = u.pn * 256 + bj * 128 + wc * 32 + 8 * fq;
#pragma unroll
            for (int ai = 0; ai < 2; ++ai)
#pragma unroll
                for (int m = 0; m < 4; ++m) { const int r = u.pm * 256 + ai * 128 + wr * 64 + m * 16 + fr;
                    const bf16* gp = (const bf16*)(ws + WS_G) + (size_t)r * 3072 + u.z * 1024 + c;
                    const u32x4 g0 = *(const u32x4*)gp;
                    if (u.z < 2) { const u32x4 g1 = *(const u32x4*)(gp + 1024);
                        const f32x4 d0 = bf4lo(g1), d1 = bf4hi(g1), n0 = bf4lo(g0), n1 = bf4hi(g0);
                        acc[ai][bj][m][0] *= (f32x4){n0[0] / fmaxf(d0[0], 1e-30f), n0[1] / fmaxf(d0[1], 1e-30f), n0[2] / fmaxf(d0[2], 1e-30f), n0[3] / fmaxf(d0[3], 1e-30f)};
                        acc[ai][bj][m][1] *= (f32x4){n1[0] / fmaxf(d1[0], 1e-30f), n1[1] / fmaxf(d1[1], 1e-30f), n1[2] / fmaxf(d1[2], 1e-30f), n1[3] / fmaxf(d1[3], 1e-30f)};
                    } else *(u32x4*)((bf16*)(ws + WS_M) + (size_t)r * 1024 + c) = pack8(acc[ai][bj][m][0] * bf4lo(g0), acc[ai][bj][m][1] * bf4hi(g0));
                    asm volatile("" ::: "memory");
                } }
        return u.z < 2;
    }
};
struct EpiOut {
    static constexpr bool PERM = false;
    unsigned char* ws; int layer; float scale; const float* xin; const float* cin;
    __device__ __forceinline__ bool operator()(f32x4 (&acc)[2][2][4][2], const pg8::Unit& u, int wr, int wc, int fr_, int fq_) const {
        int fr = fr_, fq = fq_; asm volatile("" : "+v"(fr), "+v"(fq)); unsigned char* const ws = uni_ptr(this->ws);
        float* X = (float*)(ws + WS_XCUR); const float* xlat = uni_ptr(xin); const float* xctx = uni_ptr(cin);
#pragma unroll
        for (int ai = 0; ai < 2; ++ai)
#pragma unroll
            for (int m = 0; m < 4; ++m) { const int r = u.pm * 256 + ai * 128 + wr * 64 + m * 16 + fr;
                const float* g1 = (const float*)(ws + WS_MODV) + ((size_t)layer * 5 + row_mi(r)) * 6144 + 2048;
                const float* xs = (r < TL ? xlat : xctx) + (size_t)r * 1024;
#pragma unroll
                for (int bj = 0; bj < 2; ++bj)
#pragma unroll
                    for (int n = 0; n < 2; ++n) { const int c = u.pn * 256 + bj * 128 + wc * 32 + n * 16 + 4 * fq; f32x4* xp = (f32x4*)(X + (size_t)r * 1024 + c);
                        *xp = *(const f32x4*)(xs + c) + *(const f32x4*)(g1 + c) * acc[ai][bj][m][n] * scale; } asm volatile("" ::: "memory"); }
        return false;
    }
};
struct EpiQp {
    static constexpr bool PERM = true;
    unsigned char* ws;
    __device__ __forceinline__ bool operator()(f32x4 (&acc)[2][2][4][2], const pg8::Unit& u, int wr, int wc, int fr_, int fq_) const {
        int fr = fr_, fq = fq_; asm volatile("" : "+v"(fr), "+v"(fq)); unsigned char* const ws = uni_ptr(this->ws);
#pragma unroll
        for (int bj = 0; bj < 2; ++bj) { const int c = u.pn * 256 + bj * 128 + wc * 32 + 8 * fq;
#pragma unroll
            for (int ai = 0; ai < 2; ++ai)
#pragma unroll
                for (int m = 0; m < 4; ++m) *(u32x4*)((bf16*)(ws + WS_QP) + ((size_t)(c >> 4) * TA + (u.pm * 256 + ai * 128 + wr * 64 + m * 16 + fr)) * 16 + (c & 15)) = pack8(acc[ai][bj][m][0], acc[ai][bj][m][1]); }
        return false;
    }
};

__device__ __forceinline__ void ph_inproj(const Ctx& cx, int layer, PG8_LAS unsigned char* lds) {
    CParams& p = get_params();
    pg8::Gemm g; g.A = (const bf16*)(p.ws + WS_H); g.Bt = (const bf16*)(p.ws + WT_IN) + (size_t)layer * INW * DM; g.zsA = 0; g.zsB = 0; g.K = DM;
    pg8::TileOrder S; S.nM = TL / 256; S.nN = INW / 256; S.nwg = S.nM * S.nN; S.G = cx.nb; S.c = cx.bid; S.nz = 1;
    if (layer == DEPTH - 1) { S.exN = 3; S.expn0 = 2; S.extra = 4 * 3; } else { S.exN = INW / 256; S.expn0 = 0; S.extra = 4 * (INW / 256); }
    EpiInproj E; E.ws = p.ws; E.gate_b = p.in[I_GATEB] + layer * 3072;
    pg8::gemm_phase<EpiInproj, pg8::TileOrder>(lds, g, S, E, cx.tid);
}

__device__ __forceinline__ void ph_attn(const Ctx& cx, int layer, float* sm, int it_first, int it_count) {
    CParams& p = get_params();
    const int tid = cx.tid, lane = tid & 63, w = tid >> 6, l15 = lane & 15, kg = lane >> 4;
    const bf16* Q = (const bf16*)(p.ws + WS_Q); const bf16* Kb = (const bf16*)(p.ws + WS_K); const bf16* Vb = (const bf16*)(p.ws + WS_V);
    bf16* VT = (bf16*)sm;
    constexpr int VS = 648;
    for (int it = it_first + cx.bid; it < it_first + it_count; it += cx.nb) {
        int b, kvh, qbase, wbase; bool win;
        if (it < 256) { b = it >> 6; kvh = (it >> 5) & 1; const int blk = it & 31; qbase = b * SEQ + blk * 128; wbase = blk * 128 - 128; win = true; }
        else { const int j = it - 256; b = j >> 2; kvh = (j >> 1) & 1; qbase = TL + b * CTXL + (j & 1) * 128; wbase = 0; win = false; }
        __syncthreads();
        for (int i = tid; i < 640 * 8; i += NTHREADS) { const int kk = i >> 3, c8 = i & 7; int row = -1;
            if (kk < 256) row = TL + b * CTXL + kk; else if (win) { const int pos = wbase + kk - 256; if (pos >= 0 && pos < SEQ) row = b * SEQ + pos; }
            const u32x4 ld_ = *(const u32x4*)(Vb + (size_t)(row >= 0 ? row : 0) * 128 + kvh * 64 + c8 * 8); const u32x4 v = row >= 0 ? ld_ : (u32x4){0u, 0u, 0u, 0u};
            bf16* d = VT + (c8 * 8) * VS + kk;
            d[0] = (bf16)(v.x & 0xffffu); d[VS] = (bf16)(v.x >> 16); d[2 * VS] = (bf16)(v.y & 0xffffu); d[3 * VS] = (bf16)(v.y >> 16);
            d[4 * VS] = (bf16)(v.z & 0xffffu); d[5 * VS] = (bf16)(v.z >> 16); d[6 * VS] = (bf16)(v.w & 0xffffu); d[7 * VS] = (bf16)(v.w >> 16); }
        __syncthreads();
        {
        const int h = kvh * 4 + (w >> 1), tok0 = (w & 1) * 64;
        bf16x8 qf[4][2];
#pragma unroll
        for (int qt = 0; qt < 4; ++qt)
#pragma unroll
            for (int ks = 0; ks < 2; ++ks) qf[qt][ks] = *(const bf16x8*)(Q + (size_t)(qbase + tok0 + 16 * qt + l15) * 512 + h * 64 + 32 * ks + 8 * kg);
        float m[4], l[4]; f32x4 O[4][4];
        const float sink = p.in[I_SINK][layer * 8 + h];
#pragma unroll
        for (int qt = 0; qt < 4; ++qt) { m[qt] = sink; l[qt] = 1.f;
#pragma unroll
            for (int dt = 0; dt < 4; ++dt) O[qt][dt] = (f32x4){0.f, 0.f, 0.f, 0.f}; }
        const int nsteps = win ? 18 : 8;
        bf16x8 kf[2][2];
#define ATT_LOADK(KF, st_) do { const int kk0_ = (st_) < 8 ? (st_) * 32 : 256 + tok0 + ((st_) - 8) * 32; \
            _Pragma("unroll") for (int kt = 0; kt < 2; ++kt) { const int kk = kk0_ + 16 * kt + l15; int row; \
                if (kk < 256) row = TL + b * CTXL + kk; else { int pos = wbase + kk - 256; pos = pos < 0 ? 0 : (pos > SEQ - 1 ? SEQ - 1 : pos); row = b * SEQ + pos; } \
                _Pragma("unroll") for (int ks = 0; ks < 2; ++ks) KF[kt][ks] = *(const bf16x8*)(Kb + ((size_t)(kvh * 2 + ks) * TA + row) * 32 + 8 * kg); } } while (0)
        ATT_LOADK(kf, 0);
        for (int st = 0; st < nsteps; ++st) {
            const int kk0 = st < 8 ? st * 32 : 256 + tok0 + (st - 8) * 32;
            bf16x8 kfn[2][2];
            const int stn = st + 1 < nsteps ? st + 1 : st;
            ATT_LOADK(kfn, stn);
#pragma unroll
            for (int qt = 0; qt < 4; ++qt) {
                f32x4 s0 = (f32x4){0.f, 0.f, 0.f, 0.f}, s1 = s0;
                s0 = __builtin_amdgcn_mfma_f32_16x16x32_bf16(kf[0][0], qf[qt][0], s0, 0, 0, 0); s0 = __builtin_amdgcn_mfma_f32_16x16x32_bf16(kf[0][1], qf[qt][1], s0, 0, 0, 0);
                s1 = __builtin_amdgcn_mfma_f32_16x16x32_bf16(kf[1][0], qf[qt][0], s1, 0, 0, 0); s1 = __builtin_amdgcn_mfma_f32_16x16x32_bf16(kf[1][1], qf[qt][1], s1, 0, 0, 0);
                s0 *= 0.125f; s1 *= 0.125f;
                if (st >= 8) {
                    const int qpos = wbase + 128 + tok0 + 16 * qt + l15, lo = qpos - 128 < 0 ? 0 : qpos - 128, hi_ = qpos + 128 > SEQ - 1 ? SEQ - 1 : qpos + 128;
                    const unsigned span = (unsigned)(hi_ - lo); const int kp0 = wbase + kk0 - 256 + 4 * kg - lo;
#pragma unroll
                    for (int r = 0; r < 4; ++r) { s0[r] = (unsigned)(kp0 + r) <= span ? s0[r] : -1e30f; s1[r] = (unsigned)(kp0 + 16 + r) <= span ? s1[r] : -1e30f; }
                }
                float mx = fmaxf(fmaxf(fmaxf(s0[0], s0[1]), fmaxf(s0[2], s0[3])), fmaxf(fmaxf(s1[0], s1[1]), fmaxf(s1[2], s1[3])));
                mx = max_x16(mx); mx = max_x32(mx);
                const float mn = fmaxf(m[qt], mx), f = __expf(m[qt] - mn);
                f32x4 p0, p1;
#pragma unroll
                for (int r = 0; r < 4; ++r) { p0[r] = __expf(s0[r] - mn); p1[r] = __expf(s1[r] - mn); }
                float ps = (p0[0] + p0[1]) + (p0[2] + p0[3]) + (p1[0] + p1[1]) + (p1[2] + p1[3]);
                ps = sum_x16(ps); ps = sum_x32(ps);
                l[qt] = l[qt] * f + ps; m[qt] = mn;
                u32x4 pw; pw.x = pk2(p0[0], p0[1]); pw.y = pk2(p0[2], p0[3]); pw.z = pk2(p1[0], p1[1]); pw.w = pk2(p1[2], p1[3]);
                const bf16x8 pf = __builtin_bit_cast(bf16x8, pw);
#pragma unroll
                for (int dt = 0; dt < 4; ++dt) {
                    const bf16* vp = VT + (16 * dt + l15) * VS + kk0 + 4 * kg;
                    u32x4 vw; const u32x2 va = *(const u32x2*)vp, vb = *(const u32x2*)(vp + 16); vw.x = va.x; vw.y = va.y; vw.z = vb.x; vw.w = vb.y;
                    O[qt][dt] = __builtin_amdgcn_mfma_f32_16x16x32_bf16(__builtin_bit_cast(bf16x8, vw), pf, O[qt][dt] * f, 0, 0, 0);
                }
                __builtin_amdgcn_sched_barrier(0);
            }
#pragma unroll
            for (int kt = 0; kt < 2; ++kt)
#pragma unroll
                for (int ks = 0; ks < 2; ++ks) kf[kt][ks] = kfn[kt][ks];
        }
#undef ATT_LOADK
#pragma unroll
        for (int qt = 0; qt < 4; ++qt) { const float il = 1.f / l[qt]; bf16* op = (bf16*)(p.ws + WS_ATT) + (size_t)(qbase + tok0 + 16 * qt + l15) * 512 + h * 64 + 4 * kg;
#pragma unroll
            for (int dt = 0; dt < 4; ++dt) { const f32x4 o = O[qt][dt] * il; u32x2 ww; ww.x = pk2(o[0], o[1]); ww.y = pk2(o[2], o[3]); *(u32x2*)(op + 16 * dt) = ww; } }
        }
    }
}

__device__ __forceinline__ void ph_hypre(const Ctx& cx, int layer, float* sm, int it_first, int it_count) {
    CParams& p = get_params();
    const int lane = cx.tid & 63, wave = cx.tid >> 6, gw = cx.bid * NWAVES + wave, NGW = cx.nb * NWAVES;
    const bf16* Z = (const bf16*)(p.ws + WS_Z); const float* sw = p.in[I_HSW] + layer * 3 * 1536; const float* sb = p.in[I_HSB] + layer * 1536;
    float* tile = sm + wave * 4096;
    const int nlat = 4 * 64 * 8, nctx = layer == 0 ? 4 * 4 * 8 : 0;
    for (int it = it_first + gw; it < it_first + it_count; it += NGW) {
        int b, t0, L, c0, rbase; float* vvb;
        if (it < nlat) { b = it >> 9; t0 = ((it >> 3) & 63) * 64; c0 = (it & 7) * 64; L = SEQ; rbase = b * SEQ; vvb = (float*)(p.ws + WS_VV) + ((size_t)b * 512 + c0) * SEQ; }
        else { const int j = it - nlat; b = j >> 5; t0 = ((j >> 3) & 3) * 64; c0 = (j & 7) * 64; L = CTXL; rbase = TL + b * CTXL; vvb = (float*)(p.ws + WS_VVC) + ((size_t)b * 512 + c0) * CTXL; }
        const int c = c0 + lane;
        float w0[3], w1[3], w2[3], bb[3];
#pragma unroll
        for (int q = 0; q < 3; ++q) { const int col = q * 512 + c; w0[q] = sw[col]; w1[q] = sw[1536 + col]; w2[q] = sw[2 * 1536 + col]; bb[q] = sb[col]; }
        const bf16* zb = Z + (size_t)rbase * 1536 + c;
#pragma unroll 1
        for (int tb = 0; tb < 64; tb += 16) {
            bf16 zv[3][18];
#pragma unroll
            for (int k = 0; k < 18; ++k) { const int t = t0 + tb + k - 1; const bool ok = t >= 0 && t < L; const int tc = t < 0 ? 0 : (t >= L ? L - 1 : t);
#pragma unroll
                for (int q = 0; q < 3; ++q) { const bf16 ld_ = zb[(size_t)tc * 1536 + q * 512]; zv[q][k] = ok ? ld_ : (bf16)0; } }
#pragma unroll
            for (int k = 0; k < 16; ++k) { const int tt = tb + k, t = t0 + tt; float o[3];
#pragma unroll
                for (int q = 0; q < 3; ++q) o[q] = bb[q] + w0[q] * bf2f(zv[q][k]) + w1[q] * bf2f(zv[q][k + 1]) + w2[q] * bf2f(zv[q][k + 2]);
                ((bf16*)(p.ws + WS_X0C))[(size_t)(rbase + t) * 512 + c] = f2bf(o[0]);
                tile[lane * 64 + (tt ^ lane)] = o[2] * o[1]; }
        }
        __builtin_amdgcn_s_waitcnt(0xc07f);
        for (int cc = 0; cc < 64; ++cc) vvb[(size_t)cc * L + t0 + lane] = tile[cc * 64 + (lane ^ cc)];
        __builtin_amdgcn_s_waitcnt(0xc07f);
    }
}

__device__ __forceinline__ void ph_hyconv_ctx(const Ctx& cx, int layer, float* sm) {
    CParams& p = get_params();
    const int tid = cx.tid;
    if (layer != 0) return;
    constexpr int L = CTXL;
    float* Tl = sm; float* Vl = sm + 2 * L;
    for (int it = cx.bid; it < 2048; it += cx.nb) {
        const int bc = it, b = bc >> 9, c = bc & 511;
        const float* fb = (const float*)(p.ws + WS_FILT + FILT_CTX_OFF);
        const float* hf = fb + (size_t)c * L; const float* hb = fb + ((size_t)512 + c) * L;
        const float* vv = (const float*)(p.ws + WS_VVC) + (size_t)bc * CTXL;
        __syncthreads();
        if (tid < L) { Tl[L - 1 + tid] = hf[tid]; if (tid > 0) Tl[L - 1 - tid] = hb[tid]; Vl[tid] = vv[tid]; }
        __syncthreads();
        if (tid < L) { float a = 0.f; const float* tp = Tl + (tid + L - 1);
            for (int s = 0; s < L; ++s) a += Vl[s] * tp[-s];
            const size_t o = (size_t)(TL + b * CTXL + tid) * 512 + c;
            ((bf16*)(p.ws + WS_HY))[o] = f2bf((a + Vl[tid] * p.in[I_HBIAS][layer * 512 + c]) * bf2f(((const bf16*)(p.ws + WS_X0C))[o])); }
    }
}
typedef float f32x2 __attribute__((ext_vector_type(2)));
__device__ __forceinline__ f32x2 cmul(f32x2 a, f32x2 w) { return (f32x2){a.x * w.x - a.y * w.y, a.x * w.y + a.y * w.x}; }
__device__ __forceinline__ void fft_fwd_r4(f32x2* X, int tid) {
#pragma unroll 1
    for (int s = 0; s < 12; s += 2) {
        const int lq = 11 - s, Q = 1 << lq;
        __syncthreads();
#pragma unroll
        for (int q = 0; q < 4; ++q) { const int j = tid + 512 * q, pos = j & (Q - 1), i = ((j >> lq) << (lq + 2)) + pos;
            const float rev = (float)(pos << s) * (1.f / 8192.f); const f32x2 w1 = (f32x2){__builtin_amdgcn_cosf(rev), -__builtin_amdgcn_sinf(rev)}; const f32x2 w2 = cmul(w1, w1);
            const f32x2 a0 = X[i], a1 = X[i + Q], a2 = X[i + 2 * Q], a3 = X[i + 3 * Q];
            const f32x2 b0 = a0 + a2, b1 = a1 + a3, d02 = a0 - a2, d13 = a1 - a3;
            const f32x2 b2 = cmul(d02, w1), b3 = cmul((f32x2){d13.y, -d13.x}, w1);
            X[i] = b0 + b1; X[i + Q] = cmul(b0 - b1, w2); X[i + 2 * Q] = b2 + b3; X[i + 3 * Q] = cmul(b2 - b3, w2); }
    }
}
__device__ __forceinline__ void fft_inv_r4(f32x2* X, int tid) {
#pragma unroll 1
    for (int s = 1; s < 13; s += 2) {
        const int h = 1 << s;
        __syncthreads();
#pragma unroll
        for (int q = 0; q < 4; ++q) { const int j = tid + 512 * q, pos = j & (h - 1), i = ((j >> s) << (s + 2)) + pos;
            const float rev = (float)(pos << (11 - s)) * (1.f / 8192.f); const f32x2 v1 = (f32x2){__builtin_amdgcn_cosf(rev), __builtin_amdgcn_sinf(rev)}; const f32x2 v2 = cmul(v1, v1);
            const f32x2 a0 = X[i], a1 = cmul(X[i + h], v2), a2 = X[i + 2 * h], a3 = cmul(X[i + 3 * h], v2);
            const f32x2 b0 = a0 + a1, b1 = a0 - a1, b2 = cmul(a2 + a3, v1), t3 = cmul(a2 - a3, v1); const f32x2 b3 = (f32x2){-t3.y, t3.x};
            X[i] = b0 + b2; X[i + h] = b1 + b3; X[i + 2 * h] = b0 - b2; X[i + 3 * h] = b1 - b3; }
    }
}
__device__ __forceinline__ void ph_hyfft(const Ctx& cx, int layer, float* sm, bool dry) {
    CParams& p = get_params();
    const int tid = cx.tid;
    f32x2* A = (f32x2*)sm; f32x2* B = A + 8192;
    for (int c = cx.bid; c < 512; c += cx.nb) {
        const float* hf = (const float*)(p.ws + WS_FILT) + (size_t)c * SEQ; const float* hb = (const float*)(p.ws + WS_FILT) + ((size_t)512 + c) * SEQ;
        const float bias = p.in[I_HBIAS][layer * 512 + c];
        __syncthreads();
#pragma unroll
        for (int q = 0; q < 16; ++q) { const int i = tid + 512 * q; const float lf = hf[i & (SEQ - 1)], lb_ = hb[(2 * SEQ - i) & (SEQ - 1)]; A[i] = (f32x2){i < SEQ ? lf : (i > SEQ ? lb_ : 0.f), 0.f}; }
        fft_fwd_r4(A, tid);
        __syncthreads();
#pragma unroll
        for (int q = 0; q < 8; ++q) { const int i = 2 * (tid + 512 * q); const f32x2 a = A[i], b = A[i + 1]; A[i] = a + b; A[i + 1] = a - b; }
#pragma unroll 1
        for (int bp = 0; bp < 2; ++bp) {
            float* v0 = (float*)(p.ws + WS_VV) + ((size_t)(2 * bp) * 512 + c) * SEQ; float* v1 = v0 + (size_t)512 * SEQ;
            float xr[8], xi[8];
            __syncthreads();
#pragma unroll
            for (int q = 0; q < 8; ++q) { const int i = tid + 512 * q; xr[q] = v0[i]; xi[q] = v1[i]; B[i] = (f32x2){xr[q], xi[q]}; B[i + SEQ] = (f32x2){0.f, 0.f}; }
            fft_fwd_r4(B, tid);
            __syncthreads();
#pragma unroll
            for (int q = 0; q < 8; ++q) { const int i = 2 * (tid + 512 * q); const f32x2 a = B[i], b = B[i + 1];
                const f32x2 y0 = cmul(a + b, A[i]), y1 = cmul(a - b, A[i + 1]); B[i] = y0 + y1; B[i + 1] = y0 - y1; }
            fft_inv_r4(B, tid);
            __syncthreads();
#pragma unroll
            for (int q = 0; q < 8; ++q) { const int i = tid + 512 * q; const f32x2 y = B[i]; if (!dry) { v0[i] = y.x * (1.f / 8192.f) + xr[q] * bias; v1[i] = y.y * (1.f / 8192.f) + xi[q] * bias; } }
        }
    }
}
__device__ __forceinline__ void ph_hypost(const Ctx& cx, int layer, float* sm) {
    CParams& p = get_params();
    const int lane = cx.tid & 63, wave = cx.tid >> 6, gw = cx.bid * NWAVES + wave, NGW = cx.nb * NWAVES;
    float* tile = sm + wave * 4096;
    for (int it = gw; it < 4 * 64 * 8; it += NGW) {
        const int b = it >> 9, t0 = ((it >> 3) & 63) * 64, c0 = (it & 7) * 64;
        const float* yb = (const float*)(p.ws + WS_VV) + ((size_t)b * 512 + c0) * SEQ;
#pragma unroll 1
        for (int cb = 0; cb < 64; cb += 16) { float yv[16];
#pragma unroll
            for (int q = 0; q < 16; ++q) yv[q] = yb[(size_t)(cb + q) * SEQ + t0 + lane];
#pragma unroll
            for (int q = 0; q < 16; ++q) tile[(cb + q) * 64 + (lane ^ (cb + q))] = yv[q]; }
        __builtin_amdgcn_s_waitcnt(0xc07f);
#pragma unroll 1
        for (int tb = 0; tb < 64; tb += 16) { bf16 xv[16];
#pragma unroll
            for (int q = 0; q < 16; ++q) xv[q] = ((const bf16*)(p.ws + WS_X0C))[(size_t)(b * SEQ + t0 + tb + q) * 512 + c0 + lane];
#pragma unroll
            for (int q = 0; q < 16; ++q) { const int tt = tb + q; ((bf16*)(p.ws + WS_HY))[(size_t)(b * SEQ + t0 + tt) * 512 + c0 + lane] = f2bf(tile[lane * 64 + (tt ^ lane)] * bf2f(xv[q])); } }
        __builtin_amdgcn_s_waitcnt(0xc07f);
    }
    (void)layer;
}

__device__ __forceinline__ void s5_pow(const float decay, const float theta, int n, float& pr, float& pi) {
    const float m = __expf(decay * (float)n), rev = __builtin_amdgcn_fractf(theta * (float)n * 0.15915494309189535f);
    pr = m * __builtin_amdgcn_cosf(rev); pi = m * __builtin_amdgcn_sinf(rev);
}
__device__ __forceinline__ void s5_disc(CParams& p, int ldgp, float& decay, float& theta, float& cr, float& ci) {
    const float are = fminf(p.in[I_SARE][ldgp], -1e-4f), aim = p.in[I_SAIM][ldgp], dt = __expf(p.in[I_SLDT][ldgp >> 6]);
    decay = are * dt; theta = aim * dt;
    const float er = __expf(decay), abr = er * fcos(theta), abi = er * fsin(theta);
    const float nr = abr - 1.0f, ni = abi, den = are * are + aim * aim;
    cr = (nr * are + ni * aim) / den; ci = (ni * are - nr * aim) / den;
}
__device__ __forceinline__ void ph_s5tables(const Ctx& cx, int layer, float* sm) {
    const int gt = cx.bid * NTHREADS + cx.tid, NGT = cx.nb * NTHREADS;
    {
        CParams& p = get_params(); bf16* E = (bf16*)(p.ws + WS_S5E);
        for (int it = gt; it < 32 * 2 * 64 * 64; it += NGT) {
            const int pp = it & 63, s = (it >> 6) & 63, dir = (it >> 12) & 1, g = it >> 13;
            const int ldgp = ((layer * 2 + dir) * 32 + g) * 64 + pp;
            float decay, theta, cr, ci; s5_disc(p, ldgp, decay, theta, cr, ci);
            float pr, pi; s5_pow(decay, theta, dir == 0 ? 63 - s : s, pr, pi);
            const float qr = pr * cr - pi * ci, qi = pr * ci + pi * cr;
            const f32x4* bre = (const f32x4*)(p.in[I_SBRE] + (size_t)ldgp * 16); const f32x4* bim = (const f32x4*)(p.in[I_SBIM] + (size_t)ldgp * 16);
            bf16* er = E + (((size_t)(g * 2 + dir) * 128 + pp) * 1024 + s * 16); bf16* ei = er + (size_t)64 * 1024;
#pragma unroll
            for (int i4 = 0; i4 < 4; ++i4) { const f32x4 br = bre[i4], bi = bim[i4];
                *(unsigned*)(er + 4 * i4) = pk2(qr * br[0] - qi * bi[0], qr * br[1] - qi * bi[1]); *(unsigned*)(er + 4 * i4 + 2) = pk2(qr * br[2] - qi * bi[2], qr * br[3] - qi * bi[3]);
                *(unsigned*)(ei + 4 * i4) = pk2(qr * bi[0] + qi * br[0], qr * bi[1] + qi * br[1]); *(unsigned*)(ei + 4 * i4 + 2) = pk2(qr * bi[2] + qi * br[2], qr * bi[3] + qi * br[3]); }
            if (s == 0) { float ar, ai; s5_pow(decay, theta, 64, ar, ai); float* a64 = (float*)(p.ws + WS_S5A64) + (size_t)ldgp * 2; a64[0] = ar; a64[1] = ai; }
        }
    }
    {
        CParams& p = get_params(); bf16* P = (bf16*)(p.ws + WS_S5P);
        for (int it = gt; it < 32 * 2 * 64 * 64; it += NGT) {
            const int pp = it & 63, tau = (it >> 6) & 63, dir = (it >> 12) & 1, g = it >> 13;
            const int ldgp = ((layer * 2 + dir) * 32 + g) * 64 + pp;
            const float are = fminf(p.in[I_SARE][ldgp], -1e-4f), aim = p.in[I_SAIM][ldgp], dt = __expf(p.in[I_SLDT][ldgp >> 6]);
            float pr, pi; s5_pow(are * dt, aim * dt, dir == 0 ? tau + 1 : 64 - tau, pr, pi);
            const size_t cb = ((size_t)((layer * 2 + dir) * 32 + g) * 16) * 64 + pp;
            bf16* pb = P + (((size_t)(g * 2 + dir) * 64 + tau) * 16) * 128 + pp;
#pragma unroll
            for (int o = 0; o < 16; ++o) { const float cre = p.in[I_SCRE][cb + o * 64], cim = p.in[I_SCIM][cb + o * 64];
                pb[o * 128] = f2bf(cre * pr - cim * pi); pb[o * 128 + 64] = f2bf(-(cre * pi + cim * pr)); }
        }
    }
    {
        CParams& p = get_params(); bf16* K = (bf16*)(p.ws + WS_S5K);
        const int tid = cx.tid, lane = tid & 63, w = tid >> 6;
        float* Cs = sm;
        float* Xs = sm + 4096 + w * 2112;
        for (int it = cx.bid; it < 32 * 16; it += cx.nb) {
            const int g = it >> 4, dl = (it & 15) * 8 + w, d = dl - 63;
            __syncthreads();
            for (int i = tid; i < 2 * 16 * 64; i += NTHREADS) { const int dir = i >> 10, r = i & 1023; const size_t ci = (size_t)((layer * 2 + dir) * 32 + g) * 1024 + r;
                Cs[i * 2] = p.in[I_SCRE][ci]; Cs[i * 2 + 1] = p.in[I_SCIM][ci]; }
            __syncthreads();
            if (dl < 127) {
                float acc[4] = {0.f, 0.f, 0.f, 0.f};
#pragma unroll 1
                for (int dir = 0; dir < 2; ++dir) {
                    if ((dir == 0 && d < 0) || (dir == 1 && d > 0)) continue;
                    const int ldgp = ((layer * 2 + dir) * 32 + g) * 64 + lane;
                    float decay, theta, cr, ci; s5_disc(p, ldgp, decay, theta, cr, ci);
                    float pr, pi; s5_pow(decay, theta, d < 0 ? -d : d, pr, pi);
                    const float qr = pr * cr - pi * ci, qi = pr * ci + pi * cr;
                    const f32x4* bre = (const f32x4*)(p.in[I_SBRE] + (size_t)ldgp * 16); const f32x4* bim = (const f32x4*)(p.in[I_SBIM] + (size_t)ldgp * 16);
#pragma unroll
                    for (int i4 = 0; i4 < 4; ++i4) { const f32x4 br = bre[i4], bi = bim[i4];
#pragma unroll
                        for (int q = 0; q < 4; ++q) { Xs[lane * 33 + 4 * i4 + q] = qr * br[q] - qi * bi[q]; Xs[lane * 33 + 16 + 4 * i4 + q] = qr * bi[q] + qi * br[q]; } }
                    __builtin_amdgcn_s_waitcnt(0xc07f);
                    const int i = lane & 15, oq = lane >> 4;
                    for (int pp = 0; pp < 64; ++pp) { const float xr = Xs[pp * 33 + i], xi = Xs[pp * 33 + 16 + i];
#pragma unroll
                        for (int jj = 0; jj < 4; ++jj) { const f32x2 c = *(const f32x2*)(Cs + ((dir * 16 + oq + 4 * jj) * 64 + pp) * 2); acc[jj] += c.x * xr - c.y * xi; } }
                    __builtin_amdgcn_s_waitcnt(0xc07f);
                }
                const int i = lane & 15, oq = lane >> 4;
#pragma unroll
                for (int jj = 0; jj < 4; ++jj) { const int o = oq + 4 * jj; float v = acc[jj]; if (d == 0 && o == i) v += p.in[I_SD][layer * 512 + g * 16 + o];
                    K[((size_t)g * 127 + dl) * 256 + o * 16 + i] = f2bf(v); }
            }
        }
    }
}
__device__ __forceinline__ int s5_row(int b, int n, int s) { return n < 4 ? TL + b * CTXL + n * 64 + s : b * SEQ + (n - 4) * 64 + s; }
__device__ __forceinline__ void ph_s5states(const Ctx& cx, int layer, float* sm) {
    CParams& p = get_params();
    const int tid = cx.tid, lane = tid & 63, w = tid >> 6, l15 = lane & 15, kg = lane >> 4;
    const bf16* E = (const bf16*)(p.ws + WS_S5E); const bf16* U = (const bf16*)(p.ws + WS_U);
    float* S = sm;
    for (int it = cx.bid; it < 128; it += cx.nb) {
        const int g = it & 31, b = it >> 5;
        f32x4 acc[2][5];
#pragma unroll
        for (int mt = 0; mt < 2; ++mt)
#pragma unroll
            for (int nt = 0; nt < 5; ++nt) acc[mt][nt] = (f32x4){0.f, 0.f, 0.f, 0.f};
        const bf16* ea = E + ((size_t)g * 256 + 32 * w + l15) * 1024 + 8 * kg;
        const int i0 = 8 * (kg & 1);
        bf16x8 af[2], bfr[5];
#define S5S_LOAD(AF, BF, ks_) do { const int s_ = 2 * (ks_) + (kg >> 1); \
            _Pragma("unroll") for (int mt = 0; mt < 2; ++mt) AF[mt] = *(const bf16x8*)(ea + (size_t)mt * 16 * 1024 + (ks_) * 32); \
            _Pragma("unroll") for (int nt = 0; nt < 5; ++nt) { const int n = 16 * nt + l15, nc = n < 68 ? n : 67; \
                const bf16x8 ld_ = *(const bf16x8*)(U + s5_uidx(g, b, nc, s_) + i0); BF[nt] = n < 68 ? ld_ : (bf16x8){0, 0, 0, 0, 0, 0, 0, 0}; } } while (0)
        S5S_LOAD(af, bfr, 0);
        for (int ks = 0; ks < 32; ++ks) {
            bf16x8 afn[2], bfn[5];
            const int kn = ks < 31 ? ks + 1 : 31;
            S5S_LOAD(afn, bfn, kn);
#pragma unroll
            for (int mt = 0; mt < 2; ++mt)
#pragma unroll
                for (int nt = 0; nt < 5; ++nt) acc[mt][nt] = __builtin_amdgcn_mfma_f32_16x16x32_bf16(af[mt], bfr[nt], acc[mt][nt], 0, 0, 0);
#pragma unroll
            for (int mt = 0; mt < 2; ++mt) af[mt] = afn[mt];
#pragma unroll
            for (int nt = 0; nt < 5; ++nt) bfr[nt] = bfn[nt];
        }
#undef S5S_LOAD
        __syncthreads();
#pragma unroll
        for (int mt = 0; mt < 2; ++mt)
#pragma unroll
            for (int nt = 0; nt < 5; ++nt)
#pragma unroll
                for (int r = 0; r < 4; ++r) S[(32 * w + 16 * mt + kg * 4 + r) * 81 + 16 * nt + l15] = acc[mt][nt][r];
        __syncthreads();
        if (tid < 128) {
            const int dir = tid >> 6, pp = tid & 63;
            const float* a64 = (const float*)(p.ws + WS_S5A64) + ((size_t)((layer * 2 + dir) * 32 + g) * 64 + pp) * 2;
            const float ar = a64[0], ai = a64[1]; float hr = 0.f, hi = 0.f;
            bf16* hin = (bf16*)(p.ws + WS_HIN) + ((size_t)g * 272 + b * 68) * 256 + dir * 128 + pp;
            for (int k = 0; k < 68; ++k) {
                const int n = dir == 0 ? k : (k < 4 ? 3 - k : 71 - k);
                hin[(size_t)n * 256] = f2bf(hr); hin[(size_t)n * 256 + 64] = f2bf(hi);
                const float sr = S[(dir * 128 + pp) * 81 + n], si = S[(dir * 128 + 64 + pp) * 81 + n];
                const float nr = ar * hr - ai * hi + sr, ni = ar * hi + ai * hr + si; hr = nr; hi = ni;
            }
        }
    }
}
__device__ __forceinline__ void ph_s5out(const Ctx& cx, int layer, float* sm) {
    CParams& p = get_params();
    const int tid = cx.tid, lane = tid & 63, w = tid >> 6, l15 = lane & 15, kg = lane >> 4;
    const bf16* U = (const bf16*)(p.ws + WS_U); const bf16* P = (const bf16*)(p.ws + WS_S5P); const bf16* HIN = (const bf16*)(p.ws + WS_HIN);
    bf16* Kl = (bf16*)sm;
    for (int it = cx.bid; it < 256; it += cx.nb) {
        const int g = it & 31, b = (it >> 5) & 3, half = it >> 7;
        __syncthreads();
        { const u32x4* src = (const u32x4*)((const bf16*)(p.ws + WS_S5K) + (size_t)g * 127 * 256); u32x4* dst = (u32x4*)Kl;
          for (int i = tid; i < 127 * 256 / 8; i += NTHREADS) dst[i] = src[i]; }
        __syncthreads();
        f32x4 acc[4][5];
#pragma unroll
        for (int mt = 0; mt < 4; ++mt)
#pragma unroll
            for (int nt = 0; nt < 5; ++nt) acc[mt][nt] = (f32x4){0.f, 0.f, 0.f, 0.f};
        const int tau0 = 32 * half + 4 * w;
        const int i0 = 8 * (kg & 1);
        bf16x8 bfr[5];
#define S5O_LOADB(BF, ks_) do { const int s_ = 2 * (ks_) + (kg >> 1); \
            _Pragma("unroll") for (int nt = 0; nt < 5; ++nt) { const int n = 16 * nt + l15, nc = n < 68 ? n : 67; \
                const bf16x8 ld_ = *(const bf16x8*)(U + s5_uidx(g, b, nc, s_) + i0); BF[nt] = n < 68 ? ld_ : (bf16x8){0, 0, 0, 0, 0, 0, 0, 0}; } } while (0)
        S5O_LOADB(bfr, 0);
        for (int ks = 0; ks < 32; ++ks) {
            const int s = 2 * ks + (kg >> 1);
            bf16x8 bfn[5];
            const int kn = ks < 31 ? ks + 1 : 31;
            S5O_LOADB(bfn, kn);
#pragma unroll
            for (int mt = 0; mt < 4; ++mt) {
                const int lag = tau0 + mt - s;
                const bf16x8 af = *(const bf16x8*)(Kl + (lag + 63) * 256 + l15 * 16 + i0);
#pragma unroll
                for (int nt = 0; nt < 5; ++nt) acc[mt][nt] = __builtin_amdgcn_mfma_f32_16x16x32_bf16(af, bfr[nt], acc[mt][nt], 0, 0, 0);
            }
#pragma unroll
            for (int nt = 0; nt < 5; ++nt) bfr[nt] = bfn[nt];
        }
#undef S5O_LOADB
        bf16x8 pa[4];
#define S5O_LOAD2(AF, BF, dk_) do { const int dir_ = (dk_) >> 2, kk_ = (dk_) & 3; \
            _Pragma("unroll") for (int nt = 0; nt < 5; ++nt) { const int n = 16 * nt + l15, nc = n < 68 ? n : 67; \
                const bf16x8 ld_ = *(const bf16x8*)(HIN + ((size_t)g * 272 + b * 68 + nc) * 256 + dir_ * 128 + 32 * kk_ + 8 * kg); BF[nt] = n < 68 ? ld_ : (bf16x8){0, 0, 0, 0, 0, 0, 0, 0}; } \
            _Pragma("unroll") for (int mt = 0; mt < 4; ++mt) AF[mt] = *(const bf16x8*)(P + ((((size_t)(g * 2 + dir_) * 64 + tau0 + mt) * 16 + l15) * 128 + 32 * kk_ + 8 * kg)); } while (0)
        S5O_LOAD2(pa, bfr, 0);
#pragma unroll 1
        for (int dk = 0; dk < 8; ++dk) {
            bf16x8 pan[4], bfn[5];
            const int dn = dk < 7 ? dk + 1 : 7;
            S5O_LOAD2(pan, bfn, dn);
#pragma unroll
            for (int mt = 0; mt < 4; ++mt)
#pragma unroll
                for (int nt = 0; nt < 5; ++nt) acc[mt][nt] = __builtin_amdgcn_mfma_f32_16x16x32_bf16(pa[mt], bfr[nt], acc[mt][nt], 0, 0, 0);
#pragma unroll
            for (int mt = 0; mt < 4; ++mt) pa[mt] = pan[mt];
#pragma unroll
            for (int nt = 0; nt < 5; ++nt) bfr[nt] = bfn[nt];
        }
#undef S5O_LOAD2
#pragma unroll
        for (int mt = 0; mt < 4; ++mt)
#pragma unroll
            for (int nt = 0; nt < 5; ++nt) { const int n = 16 * nt + l15;
                if (n < 68 && (layer == 0 || n >= 4)) { const f32x4 y = acc[mt][nt]; u32x2 o; o.x = pk2(gelu_tanh(y[0]), gelu_tanh(y[1])); o.y = pk2(gelu_tanh(y[2]), gelu_tanh(y[3]));
                    *(u32x2*)((bf16*)(p.ws + WS_S5Y) + (size_t)s5_row(b, n, tau0 + mt) * 512 + g * 16 + 4 * kg) = o; } }
    }
}

__device__ __forceinline__ void ph_glu(const Ctx& cx, int layer, PG8_LAS unsigned char* lds) {
    CParams& p = get_params();
    pg8::Gemm g; g.A = (const bf16*)(p.ws + WS_S5Y); g.Bt = (const bf16*)(p.ws + WT_GLU) + (size_t)layer * 512 * 512; g.zsA = 0; g.zsB = 0; g.K = 512;
    pg8::TileOrder S; S.nM = TL / 256; S.nN = 2; S.nwg = S.nM * S.nN; S.G = cx.nb; S.c = cx.bid; S.nz = 1; S.exN = 2; S.expn0 = 0; S.extra = layer == 0 ? 4 * 2 : 0;
    EpiGlu E; E.ws = p.ws; E.bias = p.in[I_GLUB] + layer * 512;
    pg8::gemm_phase<EpiGlu, pg8::TileOrder>(lds, g, S, E, cx.tid);
}
__device__ __forceinline__ void ph_merge(const Ctx& cx, int layer, PG8_LAS unsigned char* lds) {
    CParams& p = get_params();
    pg8::Gemm g; g.A = (const bf16*)(p.ws + WS_ATT); g.zsA = (WS_HY - WS_ATT) / 2;
    g.Bt = (const bf16*)(p.ws + WT_BR) + (size_t)(layer * 3 + 0) * 1024 * 512; g.zsB = 1024 * 512; g.K = 512;
    pg8::TileOrder S; S.nM = TL / 256; S.nN = 4; S.nwg = S.nM * S.nN; S.G = cx.nb; S.c = cx.bid; S.nz = 3; S.exN = 4; S.expn0 = 0; S.extra = layer == 0 ? 4 * 4 : 0;
    EpiMerge E; E.ws = p.ws;
    pg8::gemm_phase<EpiMerge, pg8::TileOrder>(lds, g, S, E, cx.tid);
}
__device__ __forceinline__ void ph_outproj(const Ctx& cx, int layer, PG8_LAS unsigned char* lds, float scale) {
    CParams& p = get_params();
    pg8::Gemm g; g.A = (const bf16*)(p.ws + WS_M); g.Bt = (const bf16*)(p.ws + WT_OUT) + (size_t)layer * 1024 * 1024; g.zsA = 0; g.zsB = 0; g.K = 1024;
    pg8::TileOrder S; S.nM = TL / 256; S.nN = 4; S.nwg = S.nM * S.nN; S.G = cx.nb; S.c = cx.bid; S.nz = 1; S.exN = 4; S.expn0 = 0; S.extra = layer == 0 ? 4 * 4 : 0;
    EpiOut E; E.ws = p.ws; E.layer = layer; E.scale = scale; E.xin = layer == 0 ? p.in[I_X] : (const float*)(p.ws + WS_XCUR); E.cin = layer == 0 ? p.in[I_CTX] - (size_t)TL * 1024 : (const float*)(p.ws + WS_XCUR);
    pg8::gemm_phase<EpiOut, pg8::TileOrder>(lds, g, S, E, cx.tid);
}
__device__ __forceinline__ void ph_qp(const Ctx& cx, int layer, PG8_LAS unsigned char* lds) {
    CParams& p = get_params();
    pg8::Gemm g; g.A = (const bf16*)(p.ws + WS_H); g.Bt = (const bf16*)(p.ws + WT_WQ) + (size_t)layer * 2048 * 1024; g.zsA = 0; g.zsB = 0; g.K = 1024;
    pg8::TileOrder S; S.nM = TL / 256; S.nN = 8; S.nwg = S.nM * S.nN; S.G = cx.nb; S.c = cx.bid; S.nz = 1; S.exN = 8; S.expn0 = 0; S.extra = layer == 0 ? 4 * 8 : 0;
    EpiQp E; E.ws = p.ws;
    pg8::gemm_phase<EpiQp, pg8::TileOrder>(lds, g, S, E, cx.tid);
}

__device__ __forceinline__ void ph_peerconv(const Ctx& cx, int layer) {
    CParams& p = get_params();
    const int gt = cx.bid * NTHREADS + cx.tid, NGT = cx.nb * NTHREADS;
    const f32x4* su = (const f32x4*)(p.in[I_PU] + (size_t)layer * 16384 * 1024); const f32x4* sv = (const f32x4*)(p.in[I_PV] + (size_t)layer * 16384 * 1024);
    int* du = (int*)(p.ws + WS_PU); int* dv = (int*)(p.ws + WS_PV);
    for (int i0 = gt; i0 < 16384 * 1024 / 4; i0 += 4 * NGT) {
        f32x4 a[4], c[4];
#pragma unroll
        for (int q = 0; q < 4; ++q) { const int i = i0 + q * NGT < 16384 * 1024 / 4 ? i0 + q * NGT : i0; a[q] = __builtin_nontemporal_load(su + i); c[q] = __builtin_nontemporal_load(sv + i); }
#pragma unroll
        for (int q = 0; q < 4; ++q) { const int i = i0 + q * NGT; if (i >= 16384 * 1024 / 4) break; const f32x4 av = a[q] * PEER_SU, cv = c[q] * PEER_SV;
            int wa = 0, wc = 0; wa = __builtin_amdgcn_cvt_pk_fp8_f32(av[0], av[1], wa, false); wa = __builtin_amdgcn_cvt_pk_fp8_f32(av[2], av[3], wa, true);
            wc = __builtin_amdgcn_cvt_pk_fp8_f32(cv[0], cv[1], wc, false); wc = __builtin_amdgcn_cvt_pk_fp8_f32(cv[2], cv[3], wc, true);
            const int e = i >> 8, qq = i & 255, di = (((qq >> 5) * 16384 + e) << 5) + (qq & 31); du[di] = wa; dv[di] = wc; }
    }
}
__device__ __forceinline__ unsigned mono_key(float s, unsigned lowbits, unsigned mask) { const unsigned u = __float_as_uint(s); const unsigned k = (u & 0x80000000u) ? ~u : (u | 0x80000000u); return (k & ~mask) | lowbits; }
__device__ __forceinline__ float mono_val(unsigned key, unsigned mask) { const unsigned k = (key & ~mask) | ((mask + 1u) >> 1); return __uint_as_float((k & 0x80000000u) ? (k & 0x7fffffffu) : ~k); }
#define TOP16_INSERT(t, v_) do { unsigned v__ = (v_); _Pragma("unroll") for (int k_ = 0; k_ < 16; ++k_) { const unsigned hi__ = t[k_] > v__ ? t[k_] : v__; v__ = t[k_] > v__ ? v__ : t[k_]; t[k_] = hi__; } } while (0)
#define CE_DESC(x_, y_) do { const unsigned hi__ = (x_) > (y_) ? (x_) : (y_); const unsigned lo__ = (x_) > (y_) ? (y_) : (x_); (x_) = hi__; (y_) = lo__; } while (0)
__device__ __forceinline__ void sort16_desc(unsigned (&v)[16]) {
#pragma unroll
    for (int k = 2; k <= 16; k <<= 1)
#pragma unroll
        for (int j = k >> 1; j > 0; j >>= 1)
#pragma unroll
            for (int i = 0; i < 16; ++i) { const int l = i ^ j; if (l > i) { if ((i & k) == 0) CE_DESC(v[i], v[l]); else CE_DESC(v[l], v[i]); } }
}
__device__ __forceinline__ void merge16_desc(unsigned (&t)[16], const unsigned (&s)[16]) {
    unsigned c[16];
#pragma unroll
    for (int k = 0; k < 16; ++k) c[k] = t[k] > s[15 - k] ? t[k] : s[15 - k];
#pragma unroll
    for (int d = 8; d >= 1; d >>= 1)
#pragma unroll
        for (int k = 0; k < 16; ++k) if ((k & d) == 0) CE_DESC(c[k], c[k + d]);
#pragma unroll
    for (int k = 0; k < 16; ++k) t[k] = c[k];
}
__device__ __forceinline__ void top16_merge_pair(unsigned (&t)[16]) {
    unsigned c[16];
#pragma unroll
    for (int k = 0; k < 16; ++k) { const unsigned o = (unsigned)__shfl_xor((int)t[15 - k], 32); c[k] = t[k] > o ? t[k] : o; }
#pragma unroll
    for (int d = 8; d >= 1; d >>= 1)
#pragma unroll
        for (int k = 0; k < 16; ++k) if ((k & d) == 0) { const unsigned a = c[k], bb = c[k + d]; c[k] = a > bb ? a : bb; c[k + d] = a > bb ? bb : a; }
#pragma unroll
    for (int k = 0; k < 16; ++k) t[k] = c[k];
}
typedef float f32x16 __attribute__((ext_vector_type(16)));
__device__ __forceinline__ void ph_select(const Ctx& cx, int layer) {
    CParams& p = get_params();
    const int lane = cx.tid & 63, wave = cx.tid >> 6, l31 = lane & 31, hi = lane >> 5;
    const int gw = cx.bid * NWAVES + wave, NGW = cx.nb * NWAVES;
    const int nrows = layer == 0 ? TA : TL;
    const bf16* QP = (const bf16*)(p.ws + WS_QP); const bf16* KY = (const bf16*)(p.ws + WT_KEYS) + (size_t)layer * 8 * 2 * 128 * 128;
    for (int it = gw; it < (nrows / 32) * 8; it += NGW) {
        const int h = it & 7, r0 = (it >> 3) * 32;
        unsigned ab[2][16];
#pragma unroll
        for (int s = 0; s < 2; ++s) {
            const bf16* kp = KY + ((size_t)(h * 2 + s) * 8 * 128 + l31) * 16 + 8 * hi;
            const bf16* qp = QP + ((size_t)(h * 2 + s) * 8 * TA + (r0 + l31)) * 16 + 8 * hi;
            bf16x8 qf[8], kc[8];
#pragma unroll
            for (int ks = 0; ks < 8; ++ks) { qf[ks] = *(const bf16x8*)(qp + (size_t)ks * TA * 16); kc[ks] = *(const bf16x8*)(kp + ks * 2048); }
            unsigned t[16];
#pragma unroll
            for (int k = 0; k < 16; ++k) t[k] = 0u;
#pragma unroll 1
            for (int nt = 0; nt < 4; ++nt) {
                bf16x8 kn[8];
                const bf16* kpn = kp + (nt < 3 ? nt + 1 : nt) * 512;
#pragma unroll
                for (int ks = 0; ks < 8; ++ks) kn[ks] = *(const bf16x8*)(kpn + ks * 2048);
                f32x16 acc;
#pragma unroll
                for (int r = 0; r < 16; ++r) acc[r] = 0.f;
#pragma unroll
                for (int ks = 0; ks < 8; ++ks) acc = __builtin_amdgcn_mfma_f32_32x32x16_bf16(kc[ks], qf[ks], acc, 0, 0, 0);
                unsigned sk[16];
#pragma unroll
                for (int r = 0; r < 16; ++r) { const int n = 32 * nt + (r & 3) + 8 * (r >> 2) + 4 * hi; sk[r] = mono_key(acc[r], 127u - (unsigned)n, 127u); }
                sort16_desc(sk);
                merge16_desc(t, sk);
#pragma unroll
                for (int ks = 0; ks < 8; ++ks) kc[ks] = kn[ks];
            }
            top16_merge_pair(t);
#pragma unroll
            for (int k = 0; k < 16; ++k) ab[s][k] = t[k];
        }
        float av[16], bv[16];
#pragma unroll
        for (int k = 0; k < 16; ++k) { av[k] = mono_val(ab[0][k], 127u); bv[k] = mono_val(ab[1][k], 127u); }
        unsigned t2[16], u2[16];
#pragma unroll
        for (int k = 0; k < 16; ++k) { t2[k] = 0u; u2[k] = 0u; }
#define CELL(dst, i1, j1, i2, j2) do { const float sv_ = hi ? av[i2] + bv[j2] : av[i1] + bv[j1]; const unsigned lb_ = hi ? 255u - (unsigned)((i2) * 16 + (j2)) : 255u - (unsigned)((i1) * 16 + (j1)); dst = mono_key(sv_, lb_, 255u); } while (0)
        CELL(t2[0], 0, 0, 1, 1);   CELL(t2[1], 0, 1, 1, 2);   CELL(t2[2], 0, 2, 1, 3);   CELL(t2[3], 0, 3, 1, 4);   CELL(t2[4], 0, 4, 1, 5);   CELL(t2[5], 0, 5, 1, 6);   CELL(t2[6], 0, 6, 1, 7);   CELL(t2[7], 0, 7, 2, 0);
        CELL(t2[8], 0, 8, 2, 1);   CELL(t2[9], 0, 9, 2, 2);   CELL(t2[10], 0, 10, 2, 3); CELL(t2[11], 0, 11, 2, 4); CELL(t2[12], 0, 12, 3, 0); CELL(t2[13], 0, 13, 3, 1); CELL(t2[14], 0, 14, 3, 2); CELL(t2[15], 0, 15, 3, 3);
        CELL(u2[0], 1, 0, 4, 0);   CELL(u2[1], 4, 1, 4, 2);   CELL(u2[2], 5, 0, 5, 1);   CELL(u2[3], 6, 0, 6, 1);   CELL(u2[4], 7, 0, 7, 1);   CELL(u2[5], 8, 0, 9, 0);   CELL(u2[6], 10, 0, 11, 0); CELL(u2[7], 12, 0, 13, 0); CELL(u2[8], 14, 0, 15, 0);
#undef CELL
        sort16_desc(t2); sort16_desc(u2); merge16_desc(t2, u2);
        top16_merge_pair(t2);
        const float v0 = mono_val(t2[0], 255u); float e[16], esum = 0.f; int eid[16];
#pragma unroll
        for (int k = 0; k < 16; ++k) { e[k] = __expf(mono_val(t2[k], 255u) - v0); esum += e[k];
            const unsigned c = 255u - (t2[k] & 255u), ci = c >> 4, cj = c & 15u; unsigned ka = ab[0][0], kb = ab[1][0];
#pragma unroll
            for (int q = 1; q < 16; ++q) { ka = ci == (unsigned)q ? ab[0][q] : ka; kb = cj == (unsigned)q ? ab[1][q] : kb; }
            eid[k] = (int)((127u - (ka & 127u)) * 128u + (127u - (kb & 127u))); }
        const float inv = 1.f / esum;
        if (hi == 0) { int* dst = (int*)(p.ws + WS_EID) + (size_t)(r0 + l31) * 128 + h * 16;
#pragma unroll
            for (int k = 0; k < 16; k += 4) *(u32x4*)(dst + k) = (u32x4){(unsigned)eid[k], (unsigned)eid[k + 1], (unsigned)eid[k + 2], (unsigned)eid[k + 3]}; }
        else { float* dst = (float*)(p.ws + WS_EG) + (size_t)(r0 + l31) * 128 + h * 16;
#pragma unroll
            for (int k = 0; k < 16; k += 4) *(f32x4*)(dst + k) = (f32x4){e[k] * inv, e[k + 1] * inv, e[k + 2] * inv, e[k + 3] * inv}; }
    }
}
__device__ __forceinline__ void fp8x16_to_f32(const u32x4 w, f32x2 (&f)[8]) {
    f[0] = __builtin_amdgcn_cvt_pk_f32_fp8((int)w.x, false); f[1] = __builtin_amdgcn_cvt_pk_f32_fp8((int)w.x, true); f[2] = __builtin_amdgcn_cvt_pk_f32_fp8((int)w.y, false); f[3] = __builtin_amdgcn_cvt_pk_f32_fp8((int)w.y, true);
    f[4] = __builtin_amdgcn_cvt_pk_f32_fp8((int)w.z, false); f[5] = __builtin_amdgcn_cvt_pk_f32_fp8((int)w.z, true); f[6] = __builtin_amdgcn_cvt_pk_f32_fp8((int)w.w, false); f[7] = __builtin_amdgcn_cvt_pk_f32_fp8((int)w.w, true);
}
#define PU_ISSUE(rowbuf, e0_, e1_) do { _Pragma("unroll") for (int s = 0; s < 16; ++s) { const int e_ = __shfl(s < 8 ? e0_ : e1_, (s & 7) * 8 + grp); \
        rowbuf[s] = __builtin_amdgcn_raw_buffer_load_b128(ru, (unsigned)(e_ * 128 + j8 * 16), 0, 0); } } while (0)
__device__ __forceinline__ void pu_compute(const u32x4 (&row)[16], const u32x4 xw0, const u32x4 xw1, float* pt, int j8, int grp) {
    f32x2 x[8];
    { const f32x4 a = bf4lo(xw0), b = bf4hi(xw0), c = bf4lo(xw1), d = bf4hi(xw1);
      x[0] = (f32x2){a[0], a[1]}; x[1] = (f32x2){a[2], a[3]}; x[2] = (f32x2){b[0], b[1]}; x[3] = (f32x2){b[2], b[3]}; x[4] = (f32x2){c[0], c[1]}; x[5] = (f32x2){c[2], c[3]}; x[6] = (f32x2){d[0], d[1]}; x[7] = (f32x2){d[2], d[3]}; }
    float d[16];
#pragma unroll
    for (int s = 0; s < 16; ++s) { f32x2 f[8]; fp8x16_to_f32(row[s], f);
        f32x2 a = f[0] * x[0];
#pragma unroll
        for (int j = 1; j < 8; ++j) a += f[j] * x[j];
        d[s] = a.x + a.y; }
    float a8[8], a4[4];
    { const bool bt = j8 & 4;
#pragma unroll
      for (int i = 0; i < 4; ++i) {
          const float s0 = bt ? d[i] : d[i + 4], k0 = bt ? d[i + 4] : d[i]; a8[i] = k0 + __shfl_xor(s0, 4);
          const float s1 = bt ? d[i + 8] : d[i + 12], k1 = bt ? d[i + 12] : d[i + 8]; a8[i + 4] = k1 + __shfl_xor(s1, 4); } }
    { const bool bt = j8 & 2;
#pragma unroll
      for (int i = 0; i < 2; ++i) {
          const float s0 = bt ? a8[i] : a8[i + 2], k0 = bt ? a8[i + 2] : a8[i]; a4[i] = k0 + __shfl_xor(s0, 2);
          const float s1 = bt ? a8[i + 4] : a8[i + 6], k1 = bt ? a8[i + 6] : a8[i + 4]; a4[i + 2] = k1 + __shfl_xor(s1, 2); } }
    float r0, r1;
    { const bool bt = j8 & 1;
      const float s0 = bt ? a4[0] : a4[1], k0 = bt ? a4[1] : a4[0]; r0 = k0 + __shfl_xor(s0, 1);
      const float s1 = bt ? a4[2] : a4[3], k1 = bt ? a4[3] : a4[2]; r1 = k1 + __shfl_xor(s1, 1); }
    pt[0] = r0; pt[64] = r1;
}
__device__ __forceinline__ void ph_peer_u(const Ctx& cx, int layer) {
    CParams& p = get_params();
    const int lane = cx.tid & 63, wave = __builtin_amdgcn_readfirstlane(cx.tid >> 6);
    const int nrows = layer == 0 ? TA : TL;
    const int slice = cx.bid & 7, ws_ = (cx.bid >> 3) * NWAVES + wave, NWS = (cx.nb >> 3) * NWAVES;
    const __amdgpu_buffer_rsrc_t ru = __builtin_amdgcn_make_buffer_rsrc((void*)uni_ptr(p.ws + WS_PU + (size_t)slice * (16384 * 128)), (short)0, 16384 * 128, 0x00020000);
    const int j8 = lane & 7, grp = lane >> 3;
    float* PART = (float*)(p.ws + WS_PART) + (size_t)slice * TA * 128 + j8 * 8 + grp;
    const int* EID = (const int*)(p.ws + WS_EID) + lane; const bf16* Hx = (const bf16*)(p.ws + WS_H) + slice * 128 + j8 * 16;
    int t = ws_;
    if (t >= nrows) return;
    u32x4 rA[16], rB[16]; u32x4 xa0, xa1, xb0, xb1;
    int e0 = EID[(size_t)t * 128], e1 = EID[(size_t)t * 128 + 64];
    PU_ISSUE(rA, e0, e1); xa0 = *(const u32x4*)(Hx + (size_t)t * 1024); xa1 = *(const u32x4*)(Hx + (size_t)t * 1024 + 8);
    if (t + NWS < nrows) { e0 = EID[(size_t)(t + NWS) * 128]; e1 = EID[(size_t)(t + NWS) * 128 + 64]; }
    for (;;) {
        const int t1 = t + NWS, t2 = t + 2 * NWS, t3 = t + 3 * NWS;
        if (t1 < nrows) { PU_ISSUE(rB, e0, e1); xb0 = *(const u32x4*)(Hx + (size_t)t1 * 1024); xb1 = *(const u32x4*)(Hx + (size_t)t1 * 1024 + 8); }
        if (t2 < nrows) { e0 = EID[(size_t)t2 * 128]; e1 = EID[(size_t)t2 * 128 + 64]; }
        pu_compute(rA, xa0, xa1, PART + (size_t)t * 128, j8, grp);
        if (t1 >= nrows) break;
        if (t2 < nrows) { PU_ISSUE(rA, e0, e1); xa0 = *(const u32x4*)(Hx + (size_t)t2 * 1024); xa1 = *(const u32x4*)(Hx + (size_t)t2 * 1024 + 8); }
        if (t3 < nrows) { e0 = EID[(size_t)t3 * 128]; e1 = EID[(size_t)t3 * 128 + 64]; }
        pu_compute(rB, xb0, xb1, PART + (size_t)t1 * 128, j8, grp);
        if (t2 >= nrows) break;
        t = t2;
    }
}
#undef PU_ISSUE
__device__ __forceinline__ void ph_peer_w(const Ctx& cx, int layer) {
    CParams& p = get_params();
    const int gt = cx.bid * NTHREADS + cx.tid, NGT = cx.nb * NTHREADS;
    const int n = (layer == 0 ? TA : TL) * 128;
    const float* PART = (const float*)(p.ws + WS_PART); float* EG = (float*)(p.ws + WS_EG);
    for (int i = gt; i < n; i += 2 * NGT) { const int i2 = i + NGT < n ? i + NGT : i; float pa[8], pb[8];
#pragma unroll
        for (int xs = 0; xs < 8; ++xs) { pa[xs] = PART[(size_t)xs * TA * 128 + i]; pb[xs] = PART[(size_t)xs * TA * 128 + i2]; }
        const float ga = EG[i], gb = EG[i2]; float da = 0.f, db = 0.f;
#pragma unroll
        for (int xs = 0; xs < 8; ++xs) { da += pa[xs]; db += pb[xs]; }
        EG[i] = ga * gelu_tanh(da * (1.f / PEER_SU)); if (i2 != i) EG[i2] = gb * gelu_tanh(db * (1.f / PEER_SU)); }
}
#define PV_ISSUE(vbuf, wbuf, e0_, e1_, w0_, w1_) do { _Pragma("unroll") for (int s = 0; s < 16; ++s) { const int src_ = (s & 7) * 8 + grp; \
        const int ee_ = __shfl(s < 8 ? e0_ : e1_, src_); wbuf[s] = __shfl(s < 8 ? w0_ : w1_, src_); vbuf[s] = __builtin_amdgcn_raw_buffer_load_b128(rv, (unsigned)(ee_ * 128 + j8 * 16), 0, 0); } } while (0)
__device__ __forceinline__ void pv_compute(const u32x4 (&row)[16], const float (&w)[16], float* o, const float* g2, int lane, float scale) {
    f32x2 acc[8];
#pragma unroll
    for (int j = 0; j < 8; ++j) acc[j] = (f32x2){0.f, 0.f};
#pragma unroll
    for (int s = 0; s < 16; ++s) { f32x2 f[8]; fp8x16_to_f32(row[s], f);
#pragma unroll
        for (int j = 0; j < 8; ++j) acc[j] += w[s] * f[j]; }
    f32x2 a4[4], a2[2];
    { const bool bt = lane & 32;
#pragma unroll
      for (int i = 0; i < 4; ++i) { const f32x2 sd = bt ? acc[i] : acc[i + 4], kp = bt ? acc[i + 4] : acc[i]; a4[i] = (f32x2){kp.x + __shfl_xor(sd.x, 32), kp.y + __shfl_xor(sd.y, 32)}; } }
    { const bool bt = lane & 16;
#pragma unroll
      for (int i = 0; i < 2; ++i) { const f32x2 sd = bt ? a4[i] : a4[i + 2], kp = bt ? a4[i + 2] : a4[i]; a2[i] = (f32x2){kp.x + __shfl_xor(sd.x, 16), kp.y + __shfl_xor(sd.y, 16)}; } }
    f32x2 r; { const bool bt = lane & 8; const f32x2 sd = bt ? a2[0] : a2[1], kp = bt ? a2[1] : a2[0]; r = (f32x2){kp.x + __shfl_xor(sd.x, 8), kp.y + __shfl_xor(sd.y, 8)}; }
    const int co = ((lane >> 5) & 1) * 8 + ((lane >> 4) & 1) * 4 + ((lane >> 3) & 1) * 2;
    const f32x2 gg = *(const f32x2*)(g2 + co); f32x2* xp = (f32x2*)(o + co); const f32x2 xv = *xp; *xp = (f32x2){xv.x + gg.x * r.x * scale, xv.y + gg.y * r.y * scale};
}
__device__ __forceinline__ void ph_peer_v(const Ctx& cx, int layer, float scale_) {
    CParams& p = get_params();
    const int lane = cx.tid & 63, wave = __builtin_amdgcn_readfirstlane(cx.tid >> 6);
    const int nrows = layer == 0 ? TA : TL;
    const int slice = cx.bid & 7, ws_ = (cx.bid >> 3) * NWAVES + wave, NWS = (cx.nb >> 3) * NWAVES;
    const __amdgpu_buffer_rsrc_t rv = __builtin_amdgcn_make_buffer_rsrc((void*)uni_ptr(p.ws + WS_PV + (size_t)slice * (16384 * 128)), (short)0, 16384 * 128, 0x00020000);
    const int j8 = lane & 7, grp = lane >> 3;
    const float* EG = (const float*)(p.ws + WS_EG) + lane; const int* EID = (const int*)(p.ws + WS_EID) + lane;
    float* OUT = (float*)(p.ws + WS_XCUR) + slice * 128 + j8 * 16;
    const float* G2 = (const float*)(p.ws + WS_MODV) + (size_t)layer * 5 * 6144 + 5120 + slice * 128 + j8 * 16; const float scale = scale_ / PEER_SV;
    int t = ws_;
    if (t >= nrows) return;
    u32x4 rA[16], rB[16]; float wA[16], wB[16];
    int e0 = EID[(size_t)t * 128], e1 = EID[(size_t)t * 128 + 64]; float w0 = EG[(size_t)t * 128], w1 = EG[(size_t)t * 128 + 64];
    PV_ISSUE(rA, wA, e0, e1, w0, w1);
    if (t + NWS < nrows) { e0 = EID[(size_t)(t + NWS) * 128]; e1 = EID[(size_t)(t + NWS) * 128 + 64]; w0 = EG[(size_t)(t + NWS) * 128]; w1 = EG[(size_t)(t + NWS) * 128 + 64]; }
    for (;;) {
        const int t1 = t + NWS, t2 = t + 2 * NWS, t3 = t + 3 * NWS;
        if (t1 < nrows) PV_ISSUE(rB, wB, e0, e1, w0, w1);
        if (t2 < nrows) { e0 = EID[(size_t)t2 * 128]; e1 = EID[(size_t)t2 * 128 + 64]; w0 = EG[(size_t)t2 * 128]; w1 = EG[(size_t)t2 * 128 + 64]; }
        pv_compute(rA, wA, OUT + (size_t)t * 1024, G2 + (size_t)row_mi(t) * 6144, lane, scale);
        if (t1 >= nrows) break;
        if (t2 < nrows) PV_ISSUE(rA, wA, e0, e1, w0, w1);
        if (t3 < nrows) { e0 = EID[(size_t)t3 * 128]; e1 = EID[(size_t)t3 * 128 + 64]; w0 = EG[(size_t)t3 * 128]; w1 = EG[(size_t)t3 * 128 + 64]; }
        pv_compute(rB, wB, OUT + (size_t)t1 * 1024, G2 + (size_t)row_mi(t1) * 6144, lane, scale);
        if (t2 >= nrows) break;
        t = t2;
    }
}
#undef PV_ISSUE
__device__ __forceinline__ void ph_peer_fin(const Ctx& cx, int layer) {
    CParams& p = get_params();
    const int lane = cx.tid & 63, wave = cx.tid >> 6;
    const int gw = cx.bid * NWAVES + wave, NGW = cx.nb * NWAVES;
    const int nrows = layer == 0 ? TA : TL;
    const float* X = (const float*)(p.ws + WS_XCUR);
    for (int r = gw; r < nrows; r += NGW) {
        f32x4 v[4]; float ss = 0.f;
#pragma unroll
        for (int j = 0; j < 4; ++j) { const int c = j * 256 + lane * 4; const f32x4 xv = *(const f32x4*)(X + (size_t)r * 1024 + c); v[j] = xv; ss += xv[0] * xv[0] + xv[1] * xv[1] + xv[2] * xv[2] + xv[3] * xv[3]; }
        const float rs = rsqrtf(wave_sum(ss) * (1.f / DM) + NORM_EPS);
        if (layer == DEPTH - 1) {
#pragma unroll
            for (int j = 0; j < 4; ++j) { const int c = j * 256 + lane * 4; *(f32x4*)(p.out + (size_t)r * 1024 + c) = v[j] * rs * *(const f32x4*)(p.in[I_FG] + c); }
        } else {
            const float* g = p.in[I_N1G] + (layer + 1) * DM; const float* mv = (const float*)(p.ws + WS_MODV) + ((size_t)(layer + 1) * 5 + row_mi(r)) * 6144;
#pragma unroll
            for (int j = 0; j < 4; ++j) { const int c = j * 256 + lane * 4;
                const f32x4 y = v[j] * rs * *(const f32x4*)(g + c); const f32x4 h = y * (1.f + *(const f32x4*)(mv + 1024 + c)) + *(const f32x4*)(mv + c);
                u32x2 w; w.x = pk2(h[0], h[1]); w.y = pk2(h[2], h[3]); *(u32x2*)((bf16*)(p.ws + WS_H) + (size_t)r * DM + c) = w; }
        }
    }
}

constexpr int NPL = 14, NPHASE = 1 + DEPTH * NPL;
#ifndef ONLY
#define ONLY -1
#endif
#ifndef NOT
#define NOT -1
#endif
#define ON(n) ((ONLY < 0 || ONLY == (n)) && NOT != (n))
#ifndef PROBE_REPS
#define PROBE_REPS 2
#endif
#define REPN(n) (PROBE_HAS(n) ? PROBE_REPS : 1)
#define RUN(n, call) do { { MKCX(); if (ON(n)) { const int rep_ = 0; (void)rep_; call; } } if (REPN(n) > 1) { _Pragma("unroll 1") for (int rr_ = 1; rr_ < REPN(n); ++rr_) { __syncthreads(); { MKCX(); if (ON(n)) { const int rep_ = REPN(n) - rr_; (void)rep_; call; } } } __syncthreads(); } } while (0)
#define MKCX() Ctx cx; cx.tid = threadIdx.x; cx.bid = blockIdx.x; cx.nb = gridDim.x; asm volatile("" : "+v"(cx.tid), "+s"(cx.bid), "+s"(cx.nb))
#define IN(k) (lo <= (k) && (k) < hi)
#define SUBSET(first, count, call) do { MKCX(); if (cx.bid >= (first) && cx.bid < (first) + (count)) { cx.bid -= (first); cx.nb = (count); call; } } while (0)
#define SIDE(first, call) do { MKCX(); if (cx.bid >= (first)) { cx.bid -= (first); cx.nb -= (first); call; } } while (0)
#define SEAM(k) do { if (IN(k) && IN((k) + 1)) { XcdBarrier bar_; bar_.bar = (unsigned*)(get_params().ws + WS_CTL) + 4096; bar_.x = xb_xcc_id(); bar_.st = st; xcd_barrier(bar_); } } while (0)
template <int LAYER> __device__ __forceinline__ void layer_program(const int lo, const int hi, float* sm, PG8_LAS unsigned char* lds, volatile LAS unsigned* st) {
    constexpr int B = 1 + LAYER * NPL;
    if (LAYER == 0) { if (IN(B + 0)) { RUN(0, ph_norm(cx, LAYER, 0, 0)); } SEAM(B + 0); }
    if (IN(B + 1)) { RUN(1, ph_inproj(cx, LAYER, lds)); if (LAYER == 0) { __syncthreads(); SIDE(28, ph_filters(cx, 0, sm)); } } SEAM(B + 1);
    if (IN(B + 2)) { RUN(2, ph_attn(cx, LAYER, sm, 0, 256)); __syncthreads();
        SUBSET(0, 128, ph_s5states(cx, LAYER, sm)); SUBSET(128, 128, ph_hypre(cx, LAYER, sm, 0, 2048)); __syncthreads();
        if (LAYER == 0) { SUBSET(128, 16, ph_attn(cx, LAYER, sm, 256, 16)); SUBSET(144, 16, ph_hypre(cx, LAYER, sm, 2048, 128)); } } SEAM(B + 2);
    if (IN(B + 3)) { RUN(3, ph_hyfft(cx, LAYER, sm, !(REPN(3) == 1 || rep_ == 1))); __syncthreads(); RUN(31, ph_hyconv_ctx(cx, LAYER, sm)); __syncthreads(); RUN(30, ph_s5out(cx, LAYER, sm)); } SEAM(B + 3);
    if (IN(B + 4)) { RUN(4, ph_glu(cx, LAYER, lds)); __syncthreads(); RUN(40, ph_hypost(cx, LAYER, sm)); } SEAM(B + 4);
    if (IN(B + 5)) { RUN(5, ph_merge(cx, LAYER, lds)); if (LAYER == 0) { __syncthreads(); SIDE(16, ph_filters(cx, 1, sm)); SIDE(16, ph_convert(cx, 1)); } } SEAM(B + 5);
    if (IN(B + 6)) { RUN(6, ph_outproj(cx, LAYER, lds, 1.f / REPN(6))); if (LAYER == 0) { SIDE(16, ph_peerconv(cx, 0)); } } SEAM(B + 6);
    if (IN(B + 7)) { RUN(7, ph_norm(cx, LAYER, 1, LAYER == DEPTH - 1)); if (LAYER + 1 < DEPTH) { RUN(70, ph_s5tables(cx, LAYER + 1, sm)); } if (LAYER != 0) { RUN(71, ph_peerconv(cx, LAYER)); } } SEAM(B + 7);
    if (IN(B + 8)) { RUN(8, ph_qp(cx, LAYER, lds)); } SEAM(B + 8);
    if (IN(B + 9)) { RUN(9, ph_select(cx, LAYER)); } SEAM(B + 9);
    if (IN(B + 10)) { RUN(10, ph_peer_u(cx, LAYER)); } SEAM(B + 10);
    if (IN(B + 11)) { RUN(13, ph_peer_w(cx, LAYER)); } SEAM(B + 11);
    if (IN(B + 12)) { RUN(11, ph_peer_v(cx, LAYER, 1.f / REPN(11))); } SEAM(B + 12);
    if (IN(B + 13)) { RUN(12, ph_peer_fin(cx, LAYER)); } SEAM(B + 13);
}
__global__ void __launch_bounds__(NTHREADS, 2) mk_fwd(Params p) {
    extern __shared__ __attribute__((aligned(16))) unsigned char lds_raw[];
    float* sm = (float*)lds_raw; PG8_LAS unsigned char* lds = (PG8_LAS unsigned char*)lds_raw;
    volatile LAS unsigned* st = (volatile LAS unsigned*)(lds + LDS_MISC);
    if (threadIdx.x < 4) st[threadIdx.x] = 0u;
    __syncthreads();
    const int lo = p.ph_lo, hi = p.ph_hi;
    if (hi - lo > 1) (void)xcd_barrier_post((unsigned*)(p.ws + WS_CTL) + 4096, st);
    if (IN(0)) { RUN(100, ph_prologue(cx, sm)); RUN(101, ph_convert(cx, 0)); __syncthreads(); RUN(102, ph_s5tables(cx, 0, sm)); } SEAM(0);
    layer_program<0>(lo, hi, sm, lds, st);
    layer_program<1>(lo, hi, sm, lds, st);
}
}

extern "C" void kernel_launch(void* const* d_in, const int* in_sizes, int n_in, void* d_out, int out_size, void* d_ws, size_t ws_size, hipStream_t stream) {
    static int grid = 0;
    if (grid == 0) {
        if (n_in != 40 || out_size != TL * DM || ws_size < WS_END) { fprintf(stderr, "kernel_launch: unexpected shapes (n_in %d out %d ws %zu)\n", n_in, out_size, ws_size); grid = -1; return; }
        int dev = 0, cus = 0;
        if (hipGetDevice(&dev) != hipSuccess || hipDeviceGetAttribute(&cus, hipDeviceAttributeMultiprocessorCount, dev) != hipSuccess) { grid = -1; return; }
        if (hipFuncSetAttribute((const void*)mk_fwd, hipFuncAttributeMaxDynamicSharedMemorySize, LDS_BYTES) != hipSuccess) { fprintf(stderr, "kernel_launch: hipFuncSetAttribute failed\n"); grid = -1; return; }
        if (cus < 256) { fprintf(stderr, "kernel_launch: needs 256 compute units (one resident workgroup each), found %d\n", cus); grid = -1; return; }
        grid = 256;
    }
    if (grid < 0) return;
    (void)hipMemsetAsync((char*)d_ws + WS_CTL, 0, 1 * MiB, stream);
    Params a{};
    for (int i = 0; i < 40; ++i) a.in[i] = (const float*)d_in[i];
    a.out = (float*)d_out; a.ws = (unsigned char*)d_ws;
#if PER_PHASE_LAUNCH
    for (int ph = 0; ph < NPHASE; ++ph) { a.ph_lo = ph; a.ph_hi = ph + 1; hipLaunchKernelGGL(mk_fwd, dim3(grid), dim3(NTHREADS), LDS_BYTES, stream, a); }
#else
    a.ph_lo = 0; a.ph_hi = NPHASE; hipLaunchKernelGGL(mk_fwd, dim3(grid), dim3(NTHREADS), LDS_BYTES, stream, a);
#endif
}
```

```cpp
#include <hip/hip_runtime.h>
#include <stdint.h>
#include <math.h>
#include <stdio.h>

#ifndef PER_PHASE_LAUNCH
#define PER_PHASE_LAUNCH 0
#endif

#ifndef PROBE_HAS
#define PROBE_HAS(n) false
#endif
namespace {
typedef unsigned short bf16;
typedef float f32x4 __attribute__((ext_vector_type(4)));
typedef unsigned u32x2 __attribute__((ext_vector_type(2)));
typedef unsigned u32x4 __attribute__((ext_vector_type(4)));
typedef short bf16x8 __attribute__((ext_vector_type(8)));
typedef float f32x16 __attribute__((ext_vector_type(16)));
#define LAS __attribute__((address_space(3)))

constexpr int DM = 1024, NBATCH = 4, SEQ = 4096, CTXL = 256, DEPTH = 2;
constexpr int TL = NBATCH * SEQ, TC = NBATCH * CTXL, TA = TL + TC;
constexpr int INW = 5888, COL_K = 512, COL_V = 640, COL_S5 = 768, COL_HY = 1280, COL_GATE = 2816;
constexpr int NTHREADS = 512, NWAVES = 8;
constexpr float NORM_EPS = 1e-6f;
constexpr float HY_FAST = 15.350567286626973f, HY_SLOW = 3.0701134573253945f;

constexpr size_t MiB = 1u << 20;
constexpr size_t WS_CTL = 0;
constexpr size_t WS_XCUR = 1 * MiB;
constexpr size_t WS_MODV = 69 * MiB;
constexpr size_t WS_ROPE = WS_MODV + 512 * 1024;
constexpr size_t WS_S5A = 70 * MiB;
constexpr size_t WS_S5B = 70 * MiB + 256 * 1024;
constexpr size_t WS_FILT = 72 * MiB;
constexpr size_t FILT_CTX_OFF = 16 * MiB;
constexpr size_t WS_WTS = 89 * MiB;
constexpr size_t WT_IN = WS_WTS;
constexpr size_t WT_GLU = WT_IN + 23 * MiB;
constexpr size_t WT_BR = WT_GLU + 1 * MiB;
constexpr size_t WT_OUT = WT_BR + 6 * MiB;
constexpr size_t WT_WQ = WT_OUT + 4 * MiB;
constexpr size_t WT_KEYS = WT_WQ + 8 * MiB;
constexpr size_t WS_H = 132 * MiB;
constexpr size_t WS_VV = WS_H;
constexpr size_t WS_VVC = WS_H + 32 * MiB;
constexpr size_t WS_Q = 166 * MiB;
constexpr size_t WS_K = 183 * MiB;
constexpr size_t WS_V = WS_K + (size_t)TA * 128 * 2;
constexpr size_t WS_U = WS_V + (size_t)TA * 128 * 2;
constexpr size_t WS_Z = WS_U + (size_t)TA * 512 * 2;
constexpr size_t WS_QP = WS_Q;
constexpr size_t WS_G = 260 * MiB;
constexpr size_t WS_ATT = 362 * MiB;
constexpr size_t WS_HY = WS_ATT + 17 * MiB, WS_S5O = WS_HY + 17 * MiB, WS_S5Y = WS_S5O + 17 * MiB;
constexpr size_t WS_M = 430 * MiB;
constexpr size_t WS_S5TMP = WS_M;
constexpr size_t WS_S5E = WS_M;
constexpr size_t WS_S5P = WS_M + 16 * MiB;
constexpr size_t WS_S5K = WS_M + 32 * MiB;
constexpr size_t WS_S5A64 = WS_S5A + 64 * 1024;
constexpr size_t WS_S5C = WS_S5A + 128 * 1024;
constexpr size_t WS_X0C = 464 * MiB;
constexpr size_t WS_EID = 481 * MiB;
constexpr size_t WS_EG = WS_EID + (size_t)TA * 128 * 4;
constexpr size_t WS_PU = WS_G;
constexpr size_t WS_PV = WS_G + 16 * MiB;
constexpr float PEER_SU = 512.f, PEER_SV = 64.f;
constexpr size_t WS_PART = WS_QP;
constexpr size_t WS_POUT = WS_ATT;
constexpr size_t WS_HIN = WS_EID;
constexpr size_t WS_END = 498 * MiB;
constexpr int LDS_STAGE = 131072;
constexpr int LDS_MISC = LDS_STAGE;
constexpr int LDS_BYTES = 147456;

struct Params {
    const float* in[40];
    float* out;
    unsigned char* ws;
    int ph_lo, ph_hi;
};
enum { I_X = 0, I_C, I_CTX, I_CCTX, I_MODW, I_MODB, I_N1G, I_N2G, I_INW, I_GATEB, I_SINK, I_HSW, I_HSB, I_HW1, I_HB1, I_HF1, I_HW2, I_HB2, I_HF2, I_HW3,
       I_HBIAS, I_SARE, I_SAIM, I_SLDT, I_SBRE, I_SBIM, I_SCRE, I_SCIM, I_SD, I_GLUW, I_GLUB, I_BRA, I_BRH, I_BRS, I_OUTW, I_WQ, I_PKEYS, I_PU, I_PV, I_FG };

struct Ctx { int tid, bid, nb; };
typedef __attribute__((address_space(4))) const Params CParams;
__device__ __forceinline__ CParams& get_params() { CParams* q = (CParams*)__builtin_amdgcn_kernarg_segment_ptr(); asm volatile("" : "+s"(q)); return *q; }
__device__ __forceinline__ float bf2f(bf16 v) { return __uint_as_float((unsigned)v << 16); }
typedef float f32x2_ __attribute__((ext_vector_type(2))); typedef __bf16 bf16x2_ __attribute__((ext_vector_type(2)));
__device__ __forceinline__ unsigned pk2(float lo, float hi) { const f32x2_ v = {lo, hi}; return __builtin_bit_cast(unsigned, __builtin_convertvector(v, bf16x2_)); }
__device__ __forceinline__ bf16 f2bf(float f) { return (bf16)(pk2(f, 0.f) & 0xffffu); }
__device__ __forceinline__ float wave_sum(float v) {
#pragma unroll
    for (int o = 32; o > 0; o >>= 1) v += __shfl_xor(v, o);
    return v;
}
__device__ __forceinline__ float fsin_rev(float rev) { return __builtin_amdgcn_sinf(rev); }
__device__ __forceinline__ float fcos_rev(float rev) { return __builtin_amdgcn_cosf(rev); }
__device__ __forceinline__ float fsin(float x) { return __builtin_amdgcn_sinf(x * 0.15915494309189535f); }
__device__ __forceinline__ float fcos(float x) { return __builtin_amdgcn_cosf(x * 0.15915494309189535f); }
typedef unsigned u32x2v __attribute__((ext_vector_type(2)));
__device__ __forceinline__ float max_x16(float v) { const auto r = __builtin_amdgcn_permlane16_swap(__float_as_uint(v), __float_as_uint(v), false, false); return fmaxf(__uint_as_float(r[0]), __uint_as_float(r[1])); }
__device__ __forceinline__ float max_x32(float v) { const auto r = __builtin_amdgcn_permlane32_swap(__float_as_uint(v), __float_as_uint(v), false, false); return fmaxf(__uint_as_float(r[0]), __uint_as_float(r[1])); }
__device__ __forceinline__ float sum_x16(float v) { const auto r = __builtin_amdgcn_permlane16_swap(__float_as_uint(v), __float_as_uint(v), false, false); return __uint_as_float(r[0]) + __uint_as_float(r[1]); }
__device__ __forceinline__ float sum_x32(float v) { const auto r = __builtin_amdgcn_permlane32_swap(__float_as_uint(v), __float_as_uint(v), false, false); return __uint_as_float(r[0]) + __uint_as_float(r[1]); }
__device__ __forceinline__ unsigned get_x16(unsigned v, int lane) { const auto r = __builtin_amdgcn_permlane16_swap(v, v, false, false); return (lane & 16) ? r[0] : r[1]; }
__device__ __forceinline__ unsigned get_x32(unsigned v, int lane) { const auto r = __builtin_amdgcn_permlane32_swap(v, v, false, false); return (lane & 32) ? r[0] : r[1]; }
__device__ __forceinline__ float sigmoidf_(float x) { return 1.f / (1.f + __expf(-x)); }
__device__ __forceinline__ float gelu_tanh(float x) { const float u = 0.7978845608028654f * (x + 0.044715f * x * x * x); const float e = __expf(2.f * u); return 0.5f * x * (2.f - 2.f / (e + 1.f)); }
__device__ __forceinline__ int row_mi(int r) { return r < TL ? (r >> 12) : 4; }
__device__ __forceinline__ int row_b(int r) { return r < TL ? (r >> 12) : ((r - TL) >> 8); }

#define XB_TMO      128
#define XB_XCNT(j)  (256  + 64 * (j))
#define XB_XSUB(j)  (1280 + 64 * (j))
#define XB_XGEN(j)  (2304 + 64 * (j))
#define XB_TOP      3328
#define XB_TOPGEN   3392
#define XCD_BAR_WORDS 3456
#define XB_SPIN_CAP (1u << 27)
__device__ __forceinline__ unsigned xb_ld(unsigned* p)              { return __hip_atomic_load(p, __ATOMIC_RELAXED, __HIP_MEMORY_SCOPE_AGENT); }
__device__ __forceinline__ unsigned xb_add(unsigned* p, unsigned v) { return __hip_atomic_fetch_add(p, v, __ATOMIC_RELAXED, __HIP_MEMORY_SCOPE_AGENT); }
__device__ __forceinline__ unsigned xb_xcc_id() { return (unsigned)__builtin_amdgcn_s_getreg((3 << 11) | 20) & 0xFu; }
#define XB_SPIN(cond, bar) do { unsigned _sp = 0; while (cond) { __builtin_amdgcn_s_sleep(1); \
    if ((++_sp & 255u) == 0u) { if (xb_ld(&(bar)[XB_TMO])) break; if (_sp > XB_SPIN_CAP) { atomicAdd(&(bar)[XB_TMO], 1u); break; } } } } while (0)
struct XcdBarrier { unsigned* bar; unsigned x; volatile LAS unsigned* st; };
__device__ __forceinline__ XcdBarrier xcd_barrier_post(unsigned* bar, volatile LAS unsigned* st) {
    XcdBarrier b; b.bar = bar; b.x = xb_xcc_id(); b.st = st;
    if (threadIdx.x == 0) (void)xb_add(&bar[XB_XCNT(b.x)], 1u);
    return b;
}
__device__ __forceinline__ void xcd_barrier_complete(unsigned* bar, unsigned x, unsigned& nloc, unsigned& nx) {
    const unsigned G = gridDim.x * gridDim.y * gridDim.z;
    unsigned sum, cnt, mine, sp = 0u;
    for (;;) {
        sum = 0u; cnt = 0u; mine = 0u;
#pragma unroll
        for (unsigned j = 0; j < 16; ++j) { const unsigned c = xb_ld(&bar[XB_XCNT(j)]); sum += c; cnt += (c > 0u) ? 1u : 0u; mine = (j == x) ? c : mine; }
        if (sum == G) break;
        __builtin_amdgcn_s_sleep(1);
        if ((++sp & 255u) == 0u) { if (xb_ld(&bar[XB_TMO])) break; if (sp > XB_SPIN_CAP) { atomicAdd(&bar[XB_TMO], 1u); break; } }
    }
    nloc = mine > 0u ? mine : 1u; nx = cnt > 0u ? cnt : 1u;
}
__device__ __forceinline__ void xcd_barrier(const XcdBarrier& b) {
    asm volatile("s_waitcnt vmcnt(0)" ::: "memory");
    __syncthreads();
    if (threadIdx.x == 0) {
        unsigned* bar = b.bar; asm volatile("" : "+s"(bar));
        __builtin_amdgcn_s_waitcnt(0);
        unsigned nloc = b.st[0], nx = b.st[1];
        if (nloc == 0u) { xcd_barrier_complete(bar, b.x, nloc, nx); b.st[0] = nloc; b.st[1] = nx; }
        const unsigned old = xb_add(&bar[XB_XSUB(b.x)], 1u);
        const unsigned gen = old / nloc;
        if (old + 1u == (gen + 1u) * nloc) {
            __builtin_amdgcn_fence(__ATOMIC_RELEASE, "agent");
            asm volatile("s_waitcnt vmcnt(0)" ::: "memory");
            const unsigned og = xb_add(&bar[XB_TOP], 1u);
            const unsigned tg = og / nx;
            if (og + 1u == (tg + 1u) * nx) xb_add(&bar[XB_TOPGEN], 1u);
            else XB_SPIN(xb_ld(&bar[XB_TOPGEN]) == tg, bar);
            __builtin_amdgcn_fence(__ATOMIC_ACQUIRE, "agent");
            xb_add(&bar[XB_XGEN(b.x)], 1u);
            asm volatile("s_waitcnt vmcnt(0)" ::: "memory");
        } else {
            XB_SPIN(xb_ld(&bar[XB_XGEN(b.x)]) == gen, bar);
            __builtin_amdgcn_fence(__ATOMIC_ACQUIRE, "agent");
            asm volatile("s_waitcnt vmcnt(0)" ::: "memory");
        }
    }
    __syncthreads();
}

__device__ __forceinline__ void ph_prologue(const Ctx& cx0, float* sm) {
    { CParams& p = get_params(); Ctx cx = cx0;
    const int tid = cx.tid, lane = tid & 63, wave = tid >> 6;
    const int gt = cx.bid * NTHREADS + tid, NGT = cx.nb * NTHREADS;
    const int gw = cx.bid * NWAVES + wave, NGW = cx.nb * NWAVES;
    unsigned char* ws = p.ws;
    }
    { CParams& p = get_params(); Ctx cx; cx.tid = threadIdx.x; cx.bid = blockIdx.x; cx.nb = gridDim.x; asm volatile("" : "+v"(cx.tid), "+s"(cx.bid), "+s"(cx.nb));
      const int tid = cx.tid, lane = tid & 63, wave = tid >> 6; const int gt = cx.bid * NTHREADS + tid, NGT = cx.nb * NTHREADS; const int gw = cx.bid * NWAVES + wave, NGW = cx.nb * NWAVES; unsigned char* ws = p.ws; (void)lane; (void)gt; (void)NGT; (void)gw; (void)NGW; (void)ws;
    {
        float* sil = sm;
        float* red = sm + 5 * 1024;
        bool have = false;
        for (int it = cx.bid; it < 192; it += cx.nb) {
            if (!have) {
                for (int i = tid; i < 5 * 1024; i += NTHREADS) { const float v = i < 4096 ? p.in[I_C][i] : p.in[I_CCTX][i - 4096]; sil[i] = v / (1.f + __expf(-v)); }
                have = true; __syncthreads();
            }
            const int layer = it / 96, col = (it % 96) * 64 + lane, kp = wave;
            const float* W = p.in[I_MODW] + (size_t)layer * DM * 6144 + col;
            float a0 = 0, a1 = 0, a2 = 0, a3 = 0, a4 = 0;
#pragma unroll 1
            for (int k0 = kp * 128; k0 < kp * 128 + 128; k0 += 16) { float w[16];
#pragma unroll
                for (int q = 0; q < 16; ++q) w[q] = W[(size_t)(k0 + q) * 6144];
#pragma unroll
                for (int q = 0; q < 16; ++q) { const int k = k0 + q; a0 += sil[k] * w[q]; a1 += sil[1024 + k] * w[q]; a2 += sil[2048 + k] * w[q]; a3 += sil[3072 + k] * w[q]; a4 += sil[4096 + k] * w[q]; } }
            red[(kp * 5 + 0) * 64 + lane] = a0; red[(kp * 5 + 1) * 64 + lane] = a1; red[(kp * 5 + 2) * 64 + lane] = a2; red[(kp * 5 + 3) * 64 + lane] = a3; red[(kp * 5 + 4) * 64 + lane] = a4;
            __syncthreads();
            if (tid < 320) { const int j = tid >> 6; float s = 0; for (int q = 0; q < 8; ++q) s += red[(q * 5 + j) * 64 + lane];
                ((float*)(ws + WS_MODV))[((size_t)layer * 5 + j) * 6144 + col] = s + p.in[I_MODB][layer * 6144 + col]; }
            __syncthreads();
        }
    }
    }
    { CParams& p = get_params(); Ctx cx; cx.tid = threadIdx.x; cx.bid = blockIdx.x; cx.nb = gridDim.x; asm volatile("" : "+v"(cx.tid), "+s"(cx.bid), "+s"(cx.nb));
      const int tid = cx.tid, lane = tid & 63, wave = tid >> 6; const int gt = cx.bid * NTHREADS + tid, NGT = cx.nb * NTHREADS; const int gw = cx.bid * NWAVES + wave, NGW = cx.nb * NWAVES; unsigned char* ws = p.ws; (void)lane; (void)gt; (void)NGT; (void)gw; (void)NGW; (void)ws;
    for (int i = gt; i < 64 * 16; i += NGT) { const int pos = i >> 4, f = i & 15; const float ang = (float)pos * exp2f(-(float)f * (13.287712379549449f / 16.f));
        ((float*)(ws + WS_ROPE))[i * 2] = fcos(ang); ((float*)(ws + WS_ROPE))[i * 2 + 1] = fsin(ang); }
    }
}


__device__ __forceinline__ void ph_filters(const Ctx& cx, int layer, float* sm) {
    CParams& p = get_params();
    const int tid = cx.tid, lane = tid & 63, wave = __builtin_amdgcn_readfirstlane(tid >> 6), l15 = lane & 15, kg = lane >> 4;
    bf16* Hb = (bf16*)sm;
    float* W12 = sm + 64 * 72 / 2;
    const float* w1 = p.in[I_HW1] + layer * 33 * 64; const float* w2 = p.in[I_HW2] + layer * 64 * 64; const float* w3 = p.in[I_HW3] + layer * 64 * 1024;
    for (int it = cx.bid; it < 2 * 68; it += cx.nb) {
        const int tile = it >> 1, ch = it & 1, st = tile >= 64 ? 1 : 0, tb = st ? (tile - 64) * 64 : tile * 64, L = st ? CTXL : SEQ;
        __syncthreads();
        for (int i = tid; i < 97 * 64; i += NTHREADS) W12[i] = i < 33 * 64 ? w1[i] : w2[i - 33 * 64];
        bf16x8 bw[4][2];
#pragma unroll
        for (int nt = 0; nt < 4; ++nt)
#pragma unroll
            for (int ks = 0; ks < 2; ++ks) { const float* s = w3 + (size_t)(32 * ks + 8 * kg) * 1024 + ch * 512 + wave * 64 + 16 * nt + l15;
                u32x4 w; w.x = pk2(s[0], s[1024]); w.y = pk2(s[2048], s[3072]); w.z = pk2(s[4096], s[5120]); w.w = pk2(s[6144], s[7168]); bw[nt][ks] = __builtin_bit_cast(bf16x8, w); }
        __syncthreads();
        {
            float z[8], a[8], h1[8], a2[8];
            const float b1 = p.in[I_HB1][layer * 64 + lane], f1 = p.in[I_HF1][layer * 64 + lane], b2 = p.in[I_HB2][layer * 64 + lane], f2 = p.in[I_HF2][layer * 64 + lane];
#pragma unroll
            for (int q = 0; q < 8; ++q) { const float tn = (float)(tb + wave + 8 * q) / (float)L; z[q] = 0.f;
                if (lane == 0) z[q] = tn; else if (lane <= 16) z[q] = fcos_rev(tn * (float)lane); else if (lane <= 32) z[q] = fsin_rev(tn * (float)(lane - 16)); a[q] = b1; }
#pragma unroll 3
            for (int e = 0; e < 33; ++e) { const float w = W12[e * 64 + lane];
#pragma unroll
                for (int q = 0; q < 8; ++q) a[q] += __shfl(z[q], e) * w; }
#pragma unroll
            for (int q = 0; q < 8; ++q) { h1[q] = fsin(f1 * a[q]); a2[q] = b2; }
#pragma unroll 4
            for (int j = 0; j < 64; ++j) { const float w = W12[33 * 64 + j * 64 + lane];
#pragma unroll
                for (int q = 0; q < 8; ++q) a2[q] += __shfl(h1[q], j) * w; }
#pragma unroll
            for (int q = 0; q < 8; ++q) Hb[(wave + 8 * q) * 72 + lane] = f2bf(fsin(f2 * a2[q]));
        }
        __syncthreads();
        float* fbase = (float*)(p.ws + WS_FILT + (st ? FILT_CTX_OFF : 0));
#pragma unroll
        for (int mt = 0; mt < 4; ++mt) {
            bf16x8 af[2];
#pragma unroll
            for (int ks = 0; ks < 2; ++ks) af[ks] = *(const bf16x8*)(Hb + (16 * mt + l15) * 72 + 32 * ks + 8 * kg);
            const int t0 = tb + 16 * mt + 4 * kg;
            f32x4 tw;
#pragma unroll
            for (int r = 0; r < 4; ++r) tw[r] = (float)(t0 + r) / (float)(L - 1);
#pragma unroll
            for (int nt = 0; nt < 4; ++nt) {
                f32x4 acc = (f32x4){0.f, 0.f, 0.f, 0.f};
                acc = __builtin_amdgcn_mfma_f32_16x16x32_bf16(af[0], bw[nt][0], acc, 0, 0, 0); acc = __builtin_amdgcn_mfma_f32_16x16x32_bf16(af[1], bw[nt][1], acc, 0, 0, 0);
                const int c = wave * 64 + 16 * nt + l15;
                const float rate = HY_FAST + (HY_SLOW - HY_FAST) * ((float)c / 511.f);
                f32x4 o;
#pragma unroll
                for (int r = 0; r < 4; ++r) o[r] = acc[r] * __expf(-tw[r] * rate);
                *(f32x4*)(fbase + ((size_t)ch * 512 + c) * L + t0) = o;
            }
        }
    }
}
__device__ __forceinline__ void conv_T(const Ctx& cx, const float* W, int K, int N, bf16* dst, bool perm) {
    const int gt = cx.bid * NTHREADS + cx.tid, NGT = cx.nb * NTHREADS;
    for (int it = gt; it < N * (K / 8); it += NGT) {
        const int n = it % N, k0 = (it / N) * 8;
        const int sn = (perm && n < COL_V) ? ((n & ~63) + ((n & 63) >> 1) + 32 * (n & 1)) : n;
        const float* s = W + (size_t)k0 * N + sn;
        u32x4 w; w.x = pk2(s[0], s[N]); w.y = pk2(s[2 * (size_t)N], s[3 * (size_t)N]); w.z = pk2(s[4 * (size_t)N], s[5 * (size_t)N]); w.w = pk2(s[6 * (size_t)N], s[7 * (size_t)N]);
        *(u32x4*)(dst + (size_t)n * K + k0) = w;
    }
}
__device__ __forceinline__ void ph_convert(const Ctx& cx0, int layer) {
#define RELAUNDER() CParams& p = get_params(); Ctx cx; cx.tid = threadIdx.x; cx.bid = __builtin_amdgcn_readfirstlane(cx0.bid); cx.nb = __builtin_amdgcn_readfirstlane(cx0.nb); asm volatile("" : "+v"(cx.tid), "+s"(cx.bid), "+s"(cx.nb));
    { RELAUNDER(); conv_T(cx, p.in[I_INW] + (size_t)layer * DM * INW, DM, INW, (bf16*)(p.ws + WT_IN) + (size_t)layer * INW * DM, true); }
    { RELAUNDER(); conv_T(cx, p.in[I_GLUW] + (size_t)layer * 512 * 512, 512, 512, (bf16*)(p.ws + WT_GLU) + (size_t)layer * 512 * 512, false); }
    { RELAUNDER(); conv_T(cx, p.in[I_BRA] + (size_t)layer * 512 * 1024, 512, 1024, (bf16*)(p.ws + WT_BR) + (size_t)(layer * 3 + 0) * 1024 * 512, false); }
    { RELAUNDER(); conv_T(cx, p.in[I_BRH] + (size_t)layer * 512 * 1024, 512, 1024, (bf16*)(p.ws + WT_BR) + (size_t)(layer * 3 + 1) * 1024 * 512, false); }
    { RELAUNDER(); conv_T(cx, p.in[I_BRS] + (size_t)layer * 512 * 1024, 512, 1024, (bf16*)(p.ws + WT_BR) + (size_t)(layer * 3 + 2) * 1024 * 512, false); }
    { RELAUNDER(); conv_T(cx, p.in[I_OUTW] + (size_t)layer * 1024 * 1024, 1024, 1024, (bf16*)(p.ws + WT_OUT) + (size_t)layer * 1024 * 1024, false); }
    { RELAUNDER(); conv_T(cx, p.in[I_WQ] + (size_t)layer * 1024 * 2048, 1024, 2048, (bf16*)(p.ws + WT_WQ) + (size_t)layer * 2048 * 1024, false); }
    if (layer == 0) { RELAUNDER(); const int gt = cx.bid * NTHREADS + cx.tid, NGT = cx.nb * NTHREADS;
      for (int i = gt; i < 2 * 8 * 2 * 128 * 128 / 4; i += NGT) { const f32x4 v = ((const f32x4*)p.in[I_PKEYS])[i]; u32x2 w; w.x = pk2(v[0], v[1]); w.y = pk2(v[2], v[3]);
          const int k4 = i & 31, n = (i >> 5) & 127, lhs = i >> 12;
          ((u32x2*)(p.ws + WT_KEYS))[(((size_t)lhs * 8 + (k4 >> 2)) * 128 + n) * 4 + (k4 & 3)] = w; } }
#undef RELAUNDER
}

__device__ __forceinline__ void ph_norm(const Ctx& cx, int layer, int which, int nrows_lat_only) {
    CParams& p = get_params();
    const int lane = cx.tid & 63, wave = cx.tid >> 6;
    const int gw = cx.bid * NWAVES + wave, NGW = cx.nb * NWAVES;
    const float* g = p.in[which ? I_N2G : I_N1G] + layer * DM;
    const float* xc = (const float*)(p.ws + WS_XCUR);
    bf16* H = (bf16*)(p.ws + WS_H);
    const int nrows = nrows_lat_only ? TL : TA;
    for (int r = gw; r < nrows; r += NGW) {
        const float* mv = (const float*)(p.ws + WS_MODV) + ((size_t)layer * 5 + row_mi(r)) * 6144 + (which ? 3072 : 0);
        f32x4 v[4]; float s = 0.f;
        const float* xr = (which == 0 && layer == 0) ? (r < TL ? p.in[I_X] + (size_t)r * DM : p.in[I_CTX] + (size_t)(r - TL) * DM) : xc + (size_t)r * DM;
#pragma unroll
        for (int j = 0; j < 4; ++j) { v[j] = *(const f32x4*)(xr + j * 256 + lane * 4); s += v[j].x * v[j].x + v[j].y * v[j].y + v[j].z * v[j].z + v[j].w * v[j].w; }
        const float rs = rsqrtf(wave_sum(s) * (1.f / DM) + NORM_EPS);
#pragma unroll
        for (int j = 0; j < 4; ++j) { const int c = j * 256 + lane * 4;
            const f32x4 gg = *(const f32x4*)(g + c), sh = *(const f32x4*)(mv + c), sc = *(const f32x4*)(mv + 1024 + c);
            const f32x4 y = v[j] * rs * gg; const f32x4 h = y * (1.f + sc) + sh;
            u32x2 w; w.x = pk2(h.x, h.y); w.y = pk2(h.z, h.w); *(u32x2*)(H + (size_t)r * DM + c) = w; }
    }
}


namespace pg8 {
#define PG8_LAS __attribute__((address_space(3)))
typedef unsigned short bf16_t;
typedef short bf16x8 __attribute__((ext_vector_type(8)));
constexpr int BM = 256, BK = 64, HALF = 128, HTB = HALF * BK * 2, STAGE_BYTES = 8 * HTB, NXCD = 8, WGM = 8;
__host__ __device__ __forceinline__ int lds_byte(int r, int c) { const int st = (r >> 4) * 2 + (c >> 5), rr = r & 15, cc = c & 31, ob = rr * 64 + cc * 2; return st * 1024 + (ob ^ (((ob >> 9) & 1) << 5)); }
__host__ __device__ __forceinline__ void stage_rc(int b, int& R, int& C) { const int st = b / 1024, sb = b % 1024, swz = sb ^ (((sb >> 9) & 1) << 5); R = (st >> 1) * 16 + swz / 64; C = (st & 1) * 32 + (swz % 64) / 2; }
__host__ __device__ __forceinline__ int perm32(int rho) { const int n = rho >> 4, i = rho & 15; return 8 * (i >> 2) + 4 * n + (i & 3); }
struct Unit { int pm, pn, z; };
struct Gemm { const bf16_t* A; const bf16_t* Bt; size_t zsA, zsB; int K; };
__device__ __forceinline__ const bf16_t* selA(const Gemm& g, int z) { return g.A + (size_t)z * g.zsA; }
__device__ __forceinline__ const bf16_t* selB(const Gemm& g, int z) { return g.Bt + (size_t)z * g.zsB; }
struct TileOrder {
    int nM, nN, nwg, G, c, extra, exN, expn0, nz;
    __device__ __forceinline__ bool next(int i, Unit& u) const {
        const int ti = i / nz; u.z = i - ti * nz;
        const long L = (long)ti * G + c;
        if (L < nwg) {
            int wgid = (int)L; { const int q = nwg / NXCD, r = nwg % NXCD, xcd = wgid % NXCD, off = wgid / NXCD; wgid = (xcd < r ? xcd * (q + 1) : r * (q + 1) + (xcd - r) * q) + off; }
            const int nig = WGM * nN, gid = wgid / nig, fm = gid * WGM, gsz = (nM - fm) < WGM ? (nM - fm) : WGM;
            u.pm = fm + ((wgid % nig) % gsz); u.pn = (wgid % nig) / gsz; return true;
        }
        const int e = (int)(L - nwg); if (e >= extra) return false;
        u.pm = nM + e / exN; u.pn = expn0 + e % exN; return true;
    }
};
__device__ __forceinline__ unsigned cvt_pk_bf16(float lo, float hi) { unsigned r; asm volatile("v_cvt_pk_bf16_f32 %0, %1, %2" : "=v"(r) : "v"(lo), "v"(hi)); return r; }
template <class Epi, class Sched, bool ALIGN_EPI = true, bool SP2 = true>
__device__ __forceinline__ void gemm_phase(PG8_LAS unsigned char* lds, const Gemm g, const Sched& S, const Epi& E, const int tid_) {
    const int tid = tid_, wid = __builtin_amdgcn_readfirstlane(tid >> 6), lane = tid & 63, wr = wid >> 2, wc = wid & 3, fr = lane & 15, fq = lane >> 4;
    const int K = g.K, nt = K / BK;
    unsigned voffA[2], voffB[2];
#pragma unroll
    for (int i = 0; i < 2; ++i) { int R, C; stage_rc(tid * 16 + i * 8192, R, C); const int Rb = Epi::PERM ? ((R & ~31) + perm32(R & 31)) : R;
        voffA[i] = (unsigned)(R * K + C) * 2u; voffB[i] = (unsigned)(Rb * K + C) * 2u; }
    const size_t kstep = (size_t)(BK * 2);
    const size_t hstep = (size_t)HALF * K * 2;
    const size_t tstep = 2 * hstep;
    const unsigned ldsw = (unsigned)wid * 1024u;
    const int aoff = lds_byte(wr * 64 + fr, fq * 8), boff = lds_byte(wc * 32 + fr, fq * 8);
#define PG8_SA(b, h) (((b) * 2 + (h)) * HTB)
#define PG8_SB(b, h) ((4 + (b) * 2 + (h)) * HTB)
#define PG8_STAGE(bufoff, gbase, voff) do { _Pragma("unroll") for (int _i = 0; _i < 2; ++_i) \
        __builtin_amdgcn_global_load_lds((const unsigned*)((const char*)(gbase) + (voff)[_i]), (PG8_LAS unsigned*)(lds + (bufoff) + ldsw + _i * 8192), 16, 0, 0); } while (0)
#define PG8_LDA(dst, b, h) do { _Pragma("unroll") for (int m = 0; m < 4; ++m) _Pragma("unroll") for (int k = 0; k < 2; ++k) dst[m][k] = *(const PG8_LAS bf16x8*)(lds + PG8_SA(b, h) + aoff + m * 2048 + k * 1024); } while (0)
#define PG8_LDB(dst, b, h) do { _Pragma("unroll") for (int n = 0; n < 2; ++n) _Pragma("unroll") for (int k = 0; k < 2; ++k) dst[n][k] = *(const PG8_LAS bf16x8*)(lds + PG8_SB(b, h) + boff + n * 2048 + k * 1024); } while (0)
#define PG8_MMA(ai, bj, At, Bt) do { __builtin_amdgcn_s_setprio(1); _Pragma("unroll") for (int m = 0; m < 4; ++m) _Pragma("unroll") for (int n = 0; n < 2; ++n) _Pragma("unroll") for (int k = 0; k < 2; ++k) \
        acc[ai][bj][m][n] = __builtin_amdgcn_mfma_f32_16x16x32_bf16(Bt[n][k], At[m][k], acc[ai][bj][m][n], 0, 0, 0); __builtin_amdgcn_s_setprio(0); } while (0)
#define PG8_WAIT_V(n) asm volatile("s_waitcnt vmcnt(" #n ")" ::: "memory")
#define PG8_WAIT_L(n) asm volatile("s_waitcnt lgkmcnt(" #n ")" ::: "memory")
#define PG8_BAR __builtin_amdgcn_s_barrier()
#define PG8_SCHED __builtin_amdgcn_sched_barrier(0)
    Unit cur, nxt; int ui = 0;
    if (!S.next(0, cur)) return;
    f32x4 acc[2][2][4][2];
#pragma unroll
    for (int a = 0; a < 2; ++a)
#pragma unroll
        for (int b = 0; b < 2; ++b)
#pragma unroll
            for (int m = 0; m < 4; ++m)
#pragma unroll
                for (int n = 0; n < 2; ++n) acc[a][b][m][n] = (f32x4){0.f, 0.f, 0.f, 0.f};
    bf16x8 At[4][2], B0[2][2], B1[2][2];
    const char* cA = (const char*)selA(g, cur.z) + (size_t)cur.pm * tstep; const char* cB = (const char*)selB(g, cur.z) + (size_t)cur.pn * tstep;
    if constexpr (SP2) {
        PG8_STAGE(PG8_SB(0, 0), cB, voffB); PG8_STAGE(PG8_SB(0, 1), cB + hstep, voffB); PG8_STAGE(PG8_SA(0, 0), cA, voffA); PG8_STAGE(PG8_SA(0, 1), cA + hstep, voffA);
        if (wr == 1) PG8_BAR;
        PG8_WAIT_V(2); PG8_BAR;
        PG8_STAGE(PG8_SB(1, 0), cB + kstep, voffB); PG8_STAGE(PG8_SA(1, 0), cA + kstep, voffA); PG8_STAGE(PG8_SB(1, 1), cB + hstep + kstep, voffB);
        PG8_WAIT_V(6); PG8_BAR;
    } else {
        PG8_STAGE(PG8_SB(0, 0), cB, voffB); PG8_STAGE(PG8_SA(0, 0), cA, voffA); PG8_STAGE(PG8_SB(0, 1), cB + hstep, voffB); PG8_STAGE(PG8_SA(0, 1), cA + hstep, voffA);
        if (wr == 1) PG8_BAR;
        PG8_WAIT_V(4); PG8_BAR;
        PG8_STAGE(PG8_SB(1, 0), cB + kstep, voffB); PG8_STAGE(PG8_SA(1, 0), cA + kstep, voffA); PG8_STAGE(PG8_SB(1, 1), cB + hstep + kstep, voffB);
        PG8_WAIT_V(6); PG8_BAR;
    }
    for (;;) {
        const bool has_next = S.next(ui + 1, nxt);
        const char* nA = has_next ? (const char*)selA(g, nxt.z) + (size_t)nxt.pm * tstep : cA; const char* nB = has_next ? (const char*)selB(g, nxt.z) + (size_t)nxt.pn * tstep : cB;
        for (int t = 0; t < nt; t += 2) {
            const bool last = (t == nt - 2);
            const char* a1 = cA + (size_t)(t + 1) * kstep;
            const char* a2 = last ? nA : cA + (size_t)(t + 2) * kstep; const char* b2 = last ? nB : cB + (size_t)(t + 2) * kstep;
            const char* a3 = a2 + kstep; const char* b3 = b2 + kstep;
            if constexpr (SP2) {
            PG8_LDB(B0, 0, 0); PG8_LDB(B1, 0, 1); PG8_SCHED; PG8_LDA(At, 0, 0); PG8_STAGE(PG8_SA(1, 1), a1 + hstep, voffA);
            PG8_WAIT_V(8); PG8_WAIT_L(0); PG8_BAR; PG8_MMA(0, 0, At, B0); PG8_MMA(0, 1, At, B1); PG8_BAR; PG8_SCHED;
            PG8_LDA(At, 0, 1); PG8_STAGE(PG8_SB(0, 0), b2, voffB); PG8_STAGE(PG8_SB(0, 1), b2 + hstep, voffB); PG8_STAGE(PG8_SA(0, 0), a2, voffA);
            PG8_WAIT_V(8); PG8_WAIT_L(0); PG8_BAR; PG8_MMA(1, 0, At, B0); PG8_MMA(1, 1, At, B1); PG8_BAR; PG8_SCHED;
            PG8_LDB(B0, 1, 0); PG8_LDB(B1, 1, 1); PG8_SCHED; PG8_LDA(At, 1, 0); PG8_STAGE(PG8_SA(0, 1), a2 + hstep, voffA);
            PG8_WAIT_V(8); PG8_WAIT_L(0); PG8_BAR; PG8_MMA(0, 0, At, B0); PG8_MMA(0, 1, At, B1); PG8_BAR; PG8_SCHED;
            PG8_LDA(At, 1, 1); PG8_STAGE(PG8_SB(1, 0), b3, voffB); PG8_STAGE(PG8_SB(1, 1), b3 + hstep, voffB); PG8_STAGE(PG8_SA(1, 0), a3, voffA);
            PG8_WAIT_V(8); PG8_WAIT_L(0); PG8_BAR; PG8_MMA(1, 0, At, B0); PG8_MMA(1, 1, At, B1); PG8_BAR; PG8_SCHED;
            } else {
            PG8_LDB(B0, 0, 0); PG8_SCHED; PG8_LDA(At, 0, 0); PG8_STAGE(PG8_SA(1, 1), a1 + hstep, voffA);
            PG8_WAIT_L(8); PG8_BAR; PG8_WAIT_L(0); PG8_MMA(0, 0, At, B0); PG8_BAR; PG8_SCHED;
            PG8_LDB(B1, 0, 1); PG8_STAGE(PG8_SB(0, 0), b2, voffB);
            PG8_BAR; PG8_WAIT_L(0); PG8_MMA(0, 1, At, B1); PG8_BAR;
            PG8_LDA(At, 0, 1); PG8_STAGE(PG8_SA(0, 0), a2, voffA);
            PG8_BAR; PG8_WAIT_L(0); PG8_MMA(1, 0, At, B0); PG8_BAR; PG8_SCHED;
            PG8_STAGE(PG8_SB(0, 1), b2 + hstep, voffB);
            PG8_WAIT_V(6); PG8_BAR; PG8_MMA(1, 1, At, B1); PG8_BAR;
            PG8_LDB(B0, 1, 0); PG8_SCHED; PG8_LDA(At, 1, 0); PG8_STAGE(PG8_SA(0, 1), a2 + hstep, voffA);
            PG8_WAIT_L(8); PG8_BAR; PG8_WAIT_L(0); PG8_MMA(0, 0, At, B0); PG8_BAR; PG8_SCHED;
            PG8_LDB(B1, 1, 1); PG8_STAGE(PG8_SB(1, 0), b3, voffB);
            PG8_BAR; PG8_WAIT_L(0); PG8_MMA(0, 1, At, B1); PG8_BAR;
            PG8_LDA(At, 1, 1); PG8_STAGE(PG8_SA(1, 0), a3, voffA);
            PG8_BAR; PG8_WAIT_L(0); PG8_MMA(1, 0, At, B0); PG8_BAR; PG8_SCHED;
            PG8_STAGE(PG8_SB(1, 1), b3 + hstep, voffB);
            PG8_WAIT_V(6); PG8_BAR; PG8_MMA(1, 1, At, B1); PG8_BAR;
            }
        }
        if constexpr (ALIGN_EPI) { if (wr == 0) PG8_BAR; }
        const bool keep = E(acc, cur, wr, wc, fr, fq);
        if (!has_next) break;
        if (!keep) {
#pragma unroll
        for (int a = 0; a < 2; ++a)
#pragma unroll
            for (int b = 0; b < 2; ++b)
#pragma unroll
                for (int m = 0; m < 4; ++m)
#pragma unroll
                    for (int n = 0; n < 2; ++n) acc[a][b][m][n] = (f32x4){0.f, 0.f, 0.f, 0.f};
        }
        cur = nxt; cA = nA; cB = nB; ++ui;
        if constexpr (ALIGN_EPI) { if (wr == 1) PG8_BAR; }
    }
    PG8_WAIT_V(0);
    if constexpr (!ALIGN_EPI) { if (wr == 0) PG8_BAR; }
    PG8_BAR;
#undef PG8_SA
#undef PG8_SB
#undef PG8_STAGE
#undef PG8_LDA
#undef PG8_LDB
#undef PG8_MMA
#undef PG8_WAIT_V
#undef PG8_WAIT_L
#undef PG8_BAR
#undef PG8_SCHED
}
}

__device__ __forceinline__ f32x4 bf4lo(u32x4 w) { return (f32x4){__uint_as_float(w.x << 16), __uint_as_float(w.x & 0xffff0000u), __uint_as_float(w.y << 16), __uint_as_float(w.y & 0xffff0000u)}; }
__device__ __forceinline__ f32x4 bf4hi(u32x4 w) { return (f32x4){__uint_as_float(w.z << 16), __uint_as_float(w.z & 0xffff0000u), __uint_as_float(w.w << 16), __uint_as_float(w.w & 0xffff0000u)}; }
__device__ __forceinline__ u32x4 pack8(f32x4 a, f32x4 b) { u32x4 w; w.x = pg8::cvt_pk_bf16(a[0], a[1]); w.y = pg8::cvt_pk_bf16(a[2], a[3]); w.z = pg8::cvt_pk_bf16(b[0], b[1]); w.w = pg8::cvt_pk_bf16(b[2], b[3]); return w; }
__device__ __forceinline__ f32x4 sig4(f32x4 v) { return (f32x4){sigmoidf_(v[0]), sigmoidf_(v[1]), sigmoidf_(v[2]), sigmoidf_(v[3])}; }

__device__ __forceinline__ size_t s5_uidx(int g, int b, int n, int s) { return ((((size_t)(g * 4 + b) * 64 + s) * 68 + n) * 16); }
template <class T> __device__ __forceinline__ T* uni_ptr(T* q) { unsigned long long a = (unsigned long long)q; unsigned lo = __builtin_amdgcn_readfirstlane((unsigned)a), hi = __builtin_amdgcn_readfirstlane((unsigned)(a >> 32));
    asm volatile("" : "+s"(lo), "+s"(hi)); return (T*)(((unsigned long long)hi << 32) | lo); }
struct EpiInproj {
    static constexpr bool PERM = true;
    unsigned char* ws; const float* gate_b;
    __device__ __forceinline__ bool operator()(f32x4 (&acc)[2][2][4][2], const pg8::Unit& u, int wr, int wc, int fr_, int fq_) const {
        int fr = fr_, fq = fq_; asm volatile("" : "+v"(fr), "+v"(fq)); unsigned char* const ws = uni_ptr(this->ws);
        const int cl = wc * 32 + 8 * fq, rbase = u.pm * 256 + wr * 64 + fr;
#pragma unroll
        for (int bj = 0; bj < 2; ++bj) {
            const int c128 = u.pn * 256 + bj * 128;
            unsigned char* base; unsigned rstride, coff; int kind = 0;
            if (c128 < COL_K)         { base = ws + WS_Q; rstride = 1024; coff = (unsigned)(c128 + cl) * 2u; kind = 1; }
            else if (c128 < COL_V)    { base = ws + WS_K + (size_t)(cl >> 5) * TA * 64; rstride = 64; coff = (unsigned)(cl & 31) * 2u; kind = 1; }
            else if (c128 < COL_S5)   { base = ws + WS_V; rstride = 256;  coff = (unsigned)cl * 2u; }
            else if (c128 < COL_HY)   { base = ws + WS_U; rstride = 0; coff = 0; kind = 3; }
            else if (c128 < COL_GATE) { base = ws + WS_Z; rstride = 3072; coff = (unsigned)(c128 - COL_HY + cl) * 2u; }
            else                      { base = ws + WS_G; rstride = 6144; coff = (unsigned)(c128 - COL_GATE + cl) * 2u; kind = 2; }
            if (kind == 1) {
                const float* rope = (const float*)(ws + WS_ROPE) + 8 * fq;
#pragma unroll
                for (int ai = 0; ai < 2; ++ai)
#pragma unroll
                    for (int m = 0; m < 4; ++m) {
                        const int r = rbase + ai * 128 + m * 16;
                        f32x4 v0 = acc[ai][bj][m][0], v1 = acc[ai][bj][m][1];
                        if (r < TL) { const int l = r & 4095, pos = (wc & 1) ? (l & 63) : (l >> 6);
                            const f32x4 t0 = *(const f32x4*)(rope + pos * 32), t1 = *(const f32x4*)(rope + pos * 32 + 4);
                            v0 = (f32x4){v0[0] * t0[0] - v0[1] * t0[1], v0[0] * t0[1] + v0[1] * t0[0], v0[2] * t0[2] - v0[3] * t0[3], v0[2] * t0[3] + v0[3] * t0[2]};
                            v1 = (f32x4){v1[0] * t1[0] - v1[1] * t1[1], v1[0] * t1[1] + v1[1] * t1[0], v1[2] * t1[2] - v1[3] * t1[3], v1[2] * t1[3] + v1[3] * t1[2]}; }
                        *(u32x4*)(base + ((unsigned)r * rstride + coff)) = pack8(v0, v1);
                        asm volatile("" ::: "memory");
                    }
            } else if (kind == 2) {
                const float* gb = uni_ptr(gate_b) + (c128 - COL_GATE) + cl; const f32x4 b0 = *(const f32x4*)gb, b1 = *(const f32x4*)(gb + 4);
#pragma unroll
                for (int ai = 0; ai < 2; ++ai)
#pragma unroll
                    for (int m = 0; m < 4; ++m) {
                        const int r = rbase + ai * 128 + m * 16;
                        *(u32x4*)(base + ((unsigned)r * rstride + coff)) = pack8(sig4(acc[ai][bj][m][0] + b0), sig4(acc[ai][bj][m][1] + b1));
                        asm volatile("" ::: "memory");
                    }
            } else if (kind == 3) {
                const int ch = c128 - COL_S5 + cl, g = ch >> 4, i0 = ch & 15;
#pragma unroll
                for (int ai = 0; ai < 2; ++ai)
#pragma unroll
                    for (int m = 0; m < 4; ++m) {
                        const int r = rbase + ai * 128 + m * 16; int b, n, s;
                        if (r < TL) { b = r >> 12; n = 4 + ((r & 4095) >> 6); s = r & 63; } else { const int j = r - TL; b = j >> 8; n = (j & 255) >> 6; s = j & 63; }
                        *(u32x4*)((bf16*)base + s5_uidx(g, b, n, s) + i0) = pack8(acc[ai][bj][m][0], acc[ai][bj][m][1]);
                    }
            } else {
#pragma unroll
                for (int ai = 0; ai < 2; ++ai)
#pragma unroll
                    for (int m = 0; m < 4; ++m) {
                        const int r = rbase + ai * 128 + m * 16;
                        *(u32x4*)(base + ((unsigned)r * rstride + coff)) = pack8(acc[ai][bj][m][0], acc[ai][bj][m][1]);
                    }
            }
        }
        return false;
    }
};
struct EpiGlu {
    static constexpr bool PERM = true;
    unsigned char* ws; const float* bias;
    __device__ __forceinline__ bool operator()(f32x4 (&acc)[2][2][4][2], const pg8::Unit& u, int wr, int wc, int fr_, int fq_) const {
        int fr = fr_, fq = fq_; asm volatile("" : "+v"(fr), "+v"(fq)); unsigned char* const ws = uni_ptr(this->ws);
#pragma unroll
        for (int bj = 0; bj < 2; ++bj) { const int c = u.pn * 256 + bj * 128 + wc * 32 + 8 * fq; const f32x4 b0 = *(const f32x4*)(bias + c), b1 = *(const f32x4*)(bias + c + 4);
#pragma unroll
            for (int ai = 0; ai < 2; ++ai)
#pragma unroll
                for (int m = 0; m < 4; ++m) { const size_t o = (size_t)(u.pm * 256 + ai * 128 + wr * 64 + m * 16 + fr) * 512 + c;
                    const u32x4 yw = *(const u32x4*)((const bf16*)(ws + WS_S5Y) + o);
                    *(u32x4*)((bf16*)(ws + WS_S5O) + o) = pack8(bf4lo(yw) * sig4(acc[ai][bj][m][0] + b0), bf4hi(yw) * sig4(acc[ai][bj][m][1] + b1)); asm volatile("" ::: "memory"); } }
        return false;
    }
};
struct EpiMerge {
    static constexpr bool PERM = true;
    unsigned char* ws;
    __device__ __forceinline__ bool operator()(f32x4 (&acc)[2][2][4][2], const pg8::Unit& u, int wr, int wc, int fr_, int fq_) const {
        int fr = fr_, fq = fq_; asm volatile("" : "+v"(fr), "+v"(fq)); unsigned char* const ws = uni_ptr(this->ws);
#pragma unroll
        for (int bj = 0; bj < 2; ++bj) { const int c = u.pn * 256 + bj * 128 + wc * 32 + 8 * fq;
#pragma unroll
            for (int ai = 0; ai < 2; ++ai)
#pragma unroll
                for (int m = 0; m < 4; ++m) { const int r = u.pm * 256 + ai * 128 + wr * 64 + m * 16 + fr;
                    const bf16* gp = (const bf16*)(ws + WS_G) + (size_t)r * 3072 + u.z * 1024 + c;
                    const u32x4 g0 = *(const u32x4*)gp;
                    if (u.z < 2) { const u32x4 g1 = *(const u32x4*)(gp + 1024);
                        const f32x4 d0 = bf4lo(g1), d1 = bf4hi(g1), n0 = bf4lo(g0), n1 = bf4hi(g0);
                        acc[ai][bj][m][0] *= (f32x4){n0[0] / fmaxf(d0[0], 1e-30f), n0[1] / fmaxf(d0[1], 1e-30f), n0[2] / fmaxf(d0[2], 1e-30f), n0[3] / fmaxf(d0[3], 1e-30f)};
                        acc[ai][bj][m][1] *= (f32x4){n1[0] / fmaxf(d1[0], 1e-30f), n1[1] / fmaxf(d1[1], 1e-30f), n1[2] / fmaxf(d1[2], 1e-30f), n1[3] / fmaxf(d1[3], 1e-30f)};
                    } else *(u32x4*)((bf16*)(ws + WS_M) + (size_t)r * 1024 + c) = pack8(acc[ai][bj][m][0] * bf4lo(g0), acc[ai][bj][m][1] * bf4hi(g0));
                    asm volatile("" ::: "memory");
                } }
        return u.z < 2;
    }
};
struct EpiOut {
    static constexpr bool PERM = false;
    unsigned char* ws; int layer; float scale; const float* xin; const float* cin;
    __device__ __forceinline__ bool operator()(f32x4 (&acc)[2][2][4][2], const pg8::Unit& u, int wr, int wc, int fr_, int fq_) const {
        int fr = fr_, fq = fq_; asm volatile("" : "+v"(fr), "+v"(fq)); unsigned char* const ws = uni_ptr(this->ws);
        float* X = (float*)(ws + WS_XCUR); const float* xlat = uni_ptr(xin); const float* xctx = uni_ptr(cin);
#pragma unroll
        for (int ai = 0; ai < 2; ++ai)
#pragma unroll
            for (int m = 0; m < 4; ++m) { const int r = u.pm * 256 + ai * 128 + wr * 64 + m * 16 + fr;
                const float* g1 = (const float*)(ws + WS_MODV) + ((size_t)layer * 5 + row_mi(r)) * 6144 + 2048;
                const float* xs = (r < TL ? xlat : xctx) + (size_t)r * 1024;
#pragma unroll
                for (int bj = 0; bj < 2; ++bj)
#pragma unroll
                    for (int n = 0; n < 2; ++n) { const int c = u.pn * 256 + bj * 128 + wc * 32 + n * 16 + 4 * fq; f32x4* xp = (f32x4*)(X + (size_t)r * 1024 + c);
                        *xp = *(const f32x4*)(xs + c) + *(const f32x4*)(g1 + c) * acc[ai][bj][m][n] * scale; } asm volatile("" ::: "memory"); }
        return false;
    }
};
struct EpiQp {
    static constexpr bool PERM = true;
    unsigned char* ws;
    __device__ __forceinline__ bool operator()(f32x4 (&acc)[2][2][4][2], const pg8::Unit& u, int wr, int wc, int fr_, int fq_) const {
        int fr = fr_, fq = fq_; asm volatile("" : "+v"(fr), "+v"(fq)); unsigned char* const ws = uni_ptr(this->ws);
#pragma unroll
        for (int bj = 0; bj < 2; ++bj) { const int c = u.pn * 256 + bj * 128 + wc * 32 + 8 * fq;
#pragma unroll
            for (int ai = 0; ai < 2; ++ai)
#pragma unroll
                for (int m = 0; m < 4; ++m) *(u32x4*)((bf16*)(ws + WS_QP) + ((size_t)(c >> 4) * TA + (u.pm * 256 + ai * 128 + wr * 64 + m * 16 + fr)) * 16 + (c & 15)) = pack8(acc[ai][bj][m][0], acc[ai][bj][m][1]); }
        return false;
    }
};

__device__ __forceinline__ void ph_inproj(const Ctx& cx, int layer, PG8_LAS unsigned char* lds) {
    CParams& p = get_params();
    pg8::Gemm g; g.A = (const bf16*)(p.ws + WS_H); g.Bt = (const bf16*)(p.ws + WT_IN) + (size_t)layer * INW * DM; g.zsA = 0; g.zsB = 0; g.K = DM;
    pg8::TileOrder S; S.nM = TL / 256; S.nN = INW / 256; S.nwg = S.nM * S.nN; S.G = cx.nb; S.c = cx.bid; S.nz = 1;
    if (layer == DEPTH - 1) { S.exN = 3; S.expn0 = 2; S.extra = 4 * 3; } else { S.exN = INW / 256; S.expn0 = 0; S.extra = 4 * (INW / 256); }
    EpiInproj E; E.ws = p.ws; E.gate_b = p.in[I_GATEB] + layer * 3072;
    pg8::gemm_phase<EpiInproj, pg8::TileOrder>(lds, g, S, E, cx.tid);
}

__device__ __forceinline__ void ph_attn(const Ctx& cx, int layer, float* sm, int it_first, int it_count) {
    CParams& p = get_params();
    const int tid = cx.tid, lane = tid & 63, w = tid >> 6, l31 = lane & 31, hi = lane >> 5;
    const bf16* Q = (const bf16*)(p.ws + WS_Q); const bf16* Kb = (const bf16*)(p.ws + WS_K); const bf16* Vb = (const bf16*)(p.ws + WS_V);
    bf16* VT = (bf16*)sm;
    constexpr int VS = 644;
    constexpr float CS = 0.125f * 1.4426950408889634f;
    for (int it = it_first + cx.bid; it < it_first + it_count; it += cx.nb) {
        int b, kvh, qbase, wbase; bool win;
        if (it < 256) { b = it >> 6; kvh = (it >> 5) & 1; const int blk = it & 31; qbase = b * SEQ + blk * 128; wbase = blk * 128 - 128; win = true; }
        else { const int j = it - 256; b = j >> 2; kvh = (j >> 1) & 1; qbase = TL + b * CTXL + (j & 1) * 128; wbase = 0; win = false; }
        __syncthreads();
        for (int i = tid; i < 640 * 8; i += NTHREADS) { const int kk = i >> 3, c8 = i & 7; int row = -1;
            if (kk < 256) row = TL + b * CTXL + kk; else if (win) { const int pos = wbase + kk - 256; if (pos >= 0 && pos < SEQ) row = b * SEQ + pos; }
            const u32x4 ld_ = *(const u32x4*)(Vb + (size_t)(row >= 0 ? row : 0) * 128 + kvh * 64 + c8 * 8); const u32x4 v = row >= 0 ? ld_ : (u32x4){0u, 0u, 0u, 0u};
            bf16* d = VT + (c8 * 8) * VS + kk;
            d[0] = (bf16)(v.x & 0xffffu); d[VS] = (bf16)(v.x >> 16); d[2 * VS] = (bf16)(v.y & 0xffffu); d[3 * VS] = (bf16)(v.y >> 16);
            d[4 * VS] = (bf16)(v.z & 0xffffu); d[5 * VS] = (bf16)(v.z >> 16); d[6 * VS] = (bf16)(v.w & 0xffffu); d[7 * VS] = (bf16)(v.w >> 16); }
        __syncthreads();
        const int h = kvh * 4 + (w >> 1), tok0 = (w & 1) * 64;
        bf16x8 qf[2][4];
#pragma unroll
        for (int qt = 0; qt < 2; ++qt)
#pragma unroll
            for (int c = 0; c < 4; ++c) qf[qt][c] = *(const bf16x8*)(Q + (size_t)(qbase + tok0 + 32 * qt + l31) * 512 + h * 64 + 16 * c + 8 * hi);
        float m[2], l[2]; f32x16 O[2][2];
        const float sink = p.in[I_SINK][layer * 8 + h] * 1.4426950408889634f;
#pragma unroll
        for (int qt = 0; qt < 2; ++qt) { m[qt] = sink; l[qt] = 1.f;
#pragma unroll
            for (int dt = 0; dt < 2; ++dt)
#pragma unroll
                for (int r = 0; r < 16; ++r) O[qt][dt][r] = 0.f; }
        const int nsteps = win ? 18 : 8;
        bf16x8 kf[4];
#define ATT_LOADK(KF, st_) do { const int kk_ = ((st_) < 8 ? (st_) * 32 : 256 + tok0 + ((st_) - 8) * 32) + l31; int row; \
            if (kk_ < 256) row = TL + b * CTXL + kk_; else { int pos = wbase + kk_ - 256; pos = pos < 0 ? 0 : (pos > SEQ - 1 ? SEQ - 1 : pos); row = b * SEQ + pos; } \
            _Pragma("unroll") for (int c = 0; c < 4; ++c) KF[c] = *(const bf16x8*)(Kb + ((size_t)(kvh * 2 + (c >> 1)) * TA + row) * 32 + 16 * (c & 1) + 8 * hi); } while (0)
        ATT_LOADK(kf, 0);
        for (int st = 0; st < nsteps; ++st) {
            const int kk0 = st < 8 ? st * 32 : 256 + tok0 + (st - 8) * 32;
            bf16x8 kfn[4];
            const int stn = st + 1 < nsteps ? st + 1 : st;
            ATT_LOADK(kfn, stn);
            bf16x8 pf[2][2];
#pragma unroll
            for (int qt = 0; qt < 2; ++qt) {
                f32x16 s;
#pragma unroll
                for (int r = 0; r < 16; ++r) s[r] = 0.f;
#pragma unroll
                for (int c = 0; c < 4; ++c) s = __builtin_amdgcn_mfma_f32_32x32x16_bf16(kf[c], qf[qt][c], s, 0, 0, 0);
                if (st >= 8) {
                    const int qpos = wbase + 128 + tok0 + 32 * qt + l31, lo = qpos - 128 < 0 ? 0 : qpos - 128, hi_ = qpos + 128 > SEQ - 1 ? SEQ - 1 : qpos + 128;
                    const unsigned span = (unsigned)(hi_ - lo); const int kp0 = wbase + kk0 - 256 + 4 * hi - lo;
#pragma unroll
                    for (int r = 0; r < 16; ++r) s[r] = (unsigned)(kp0 + (r & 3) + 8 * (r >> 2)) <= span ? s[r] : -1e30f;
                }
                float mx = fmaxf(fmaxf(fmaxf(s[0], s[1]), fmaxf(s[2], s[3])), fmaxf(fmaxf(s[4], s[5]), fmaxf(s[6], s[7])));
                mx = fmaxf(mx, fmaxf(fmaxf(fmaxf(s[8], s[9]), fmaxf(s[10], s[11])), fmaxf(fmaxf(s[12], s[13]), fmaxf(s[14], s[15]))));
                mx = max_x32(mx);
                const float mn = fmaxf(m[qt], mx * CS), f = __builtin_amdgcn_exp2f(m[qt] - mn);
                float ps = 0.f;
#pragma unroll
                for (int r = 0; r < 16; ++r) { s[r] = __builtin_amdgcn_exp2f(fmaf(s[r], CS, -mn)); ps += s[r]; }
                ps = sum_x32(ps);
                l[qt] = l[qt] * f + ps; m[qt] = mn;
#pragma unroll
                for (int dt = 0; dt < 2; ++dt)
#pragma unroll
                    for (int r = 0; r < 16; ++r) O[qt][dt][r] *= f;
#pragma unroll
                for (int s2 = 0; s2 < 2; ++s2) { u32x4 pw; pw.x = pk2(s[8 * s2], s[8 * s2 + 1]); pw.y = pk2(s[8 * s2 + 2], s[8 * s2 + 3]); pw.z = pk2(s[8 * s2 + 4], s[8 * s2 + 5]); pw.w = pk2(s[8 * s2 + 6], s[8 * s2 + 7]);
                    pf[qt][s2] = __builtin_bit_cast(bf16x8, pw); }
            }
#pragma unroll
            for (int dt = 0; dt < 2; ++dt)
#pragma unroll
                for (int s2 = 0; s2 < 2; ++s2) {
                    const bf16* vp = VT + (32 * dt + l31) * VS + kk0 + 16 * s2 + 4 * hi;
                    u32x4 vw; const u32x2 va = *(const u32x2*)vp, vb = *(const u32x2*)(vp + 8); vw.x = va.x; vw.y = va.y; vw.z = vb.x; vw.w = vb.y;
                    const bf16x8 vf = __builtin_bit_cast(bf16x8, vw);
#pragma unroll
                    for (int qt = 0; qt < 2; ++qt) O[qt][dt] = __builtin_amdgcn_mfma_f32_32x32x16_bf16(vf, pf[qt][s2], O[qt][dt], 0, 0, 0);
                }
#pragma unroll
            for (int c = 0; c < 4; ++c) kf[c] = kfn[c];
        }
#undef ATT_LOADK
#pragma unroll
        for (int qt = 0; qt < 2; ++qt) { const float il = 1.f / l[qt]; bf16* op = (bf16*)(p.ws + WS_ATT) + (size_t)(qbase + tok0 + 32 * qt + l31) * 512 + h * 64 + 4 * hi;
#pragma unroll
            for (int dt = 0; dt < 2; ++dt)
#pragma unroll
                for (int g4 = 0; g4 < 4; ++g4) { u32x2 ww; ww.x = pk2(O[qt][dt][4 * g4] * il, O[qt][dt][4 * g4 + 1] * il); ww.y = pk2(O[qt][dt][4 * g4 + 2] * il, O[qt][dt][4 * g4 + 3] * il);
                    *(u32x2*)(op + 32 * dt + 8 * g4) = ww; } }
    }
}

__device__ __forceinline__ void ph_hypre(const Ctx& cx, int layer, float* sm, int it_first, int it_count) {
    CParams& p = get_params();
    const int lane = cx.tid & 63, wave = cx.tid >> 6, gw = cx.bid * NWAVES + wave, NGW = cx.nb * NWAVES;
    const bf16* Z = (const bf16*)(p.ws + WS_Z); const float* sw = p.in[I_HSW] + layer * 3 * 1536; const float* sb = p.in[I_HSB] + layer * 1536;
    float* tile = sm + wave * 4096;
    const int nlat = 4 * 64 * 8, nctx = layer == 0 ? 4 * 4 * 8 : 0;
    for (int it = it_first + gw; it < it_first + it_count; it += NGW) {
        int b, t0, L, c0, rbase; float* vvb;
        if (it < nlat) { b = it >> 9; t0 = ((it >> 3) & 63) * 64; c0 = (it & 7) * 64; L = SEQ; rbase = b * SEQ; vvb = (float*)(p.ws + WS_VV) + ((size_t)b * 512 + c0) * SEQ; }
        else { const int j = it - nlat; b = j >> 5; t0 = ((j >> 3) & 3) * 64; c0 = (j & 7) * 64; L = CTXL; rbase = TL + b * CTXL; vvb = (float*)(p.ws + WS_VVC) + ((size_t)b * 512 + c0) * CTXL; }
        const int c = c0 + lane;
        float w0[3], w1[3], w2[3], bb[3];
#pragma unroll
        for (int q = 0; q < 3; ++q) { const int col = q * 512 + c; w0[q] = sw[col]; w1[q] = sw[1536 + col]; w2[q] = sw[2 * 1536 + col]; bb[q] = sb[col]; }
        const bf16* zb = Z + (size_t)rbase * 1536 + c;
#pragma unroll 1
        for (int tb = 0; tb < 64; tb += 16) {
            bf16 zv[3][18];
#pragma unroll
            for (int k = 0; k < 18; ++k) { const int t = t0 + tb + k - 1; const bool ok = t >= 0 && t < L; const int tc = t < 0 ? 0 : (t >= L ? L - 1 : t);
#pragma unroll
                for (int q = 0; q < 3; ++q) { const bf16 ld_ = zb[(size_t)tc * 1536 + q * 512]; zv[q][k] = ok ? ld_ : (bf16)0; } }
#pragma unroll
            for (int k = 0; k < 16; ++k) { const int tt = tb + k, t = t0 + tt; float o[3];
#pragma unroll
                for (int q = 0; q < 3; ++q) o[q] = bb[q] + w0[q] * bf2f(zv[q][k]) + w1[q] * bf2f(zv[q][k + 1]) + w2[q] * bf2f(zv[q][k + 2]);
                ((bf16*)(p.ws + WS_X0C))[(size_t)(rbase + t) * 512 + c] = f2bf(o[0]);
                tile[lane * 64 + (tt ^ lane)] = o[2] * o[1]; }
        }
        __builtin_amdgcn_s_waitcnt(0xc07f);
        for (int cc = 0; cc < 64; ++cc) vvb[(size_t)cc * L + t0 + lane] = tile[cc * 64 + (lane ^ cc)];
        __builtin_amdgcn_s_waitcnt(0xc07f);
    }
}

__device__ __forceinline__ void ph_hyconv_ctx(const Ctx& cx, int layer, float* sm) {
    CParams& p = get_params();
    const int tid = cx.tid;
    if (layer != 0) return;
    constexpr int L = CTXL;
    float* Tl = sm; float* Vl = sm + 2 * L;
    for (int it = cx.bid; it < 2048; it += cx.nb) {
        const int bc = it, b = bc >> 9, c = bc & 511;
        const float* fb = (const float*)(p.ws + WS_FILT + FILT_CTX_OFF);
        const float* hf = fb + (size_t)c * L; const float* hb = fb + ((size_t)512 + c) * L;
        const float* vv = (const float*)(p.ws + WS_VVC) + (size_t)bc * CTXL;
        __syncthreads();
        if (tid < L) { Tl[L - 1 + tid] = hf[tid]; if (tid > 0) Tl[L - 1 - tid] = hb[tid]; Vl[tid] = vv[tid]; }
        __syncthreads();
        if (tid < L) { float a = 0.f; const float* tp = Tl + (tid + L - 1);
            for (int s = 0; s < L; ++s) a += Vl[s] * tp[-s];
            const size_t o = (size_t)(TL + b * CTXL + tid) * 512 + c;
            ((bf16*)(p.ws + WS_HY))[o] = f2bf((a + Vl[tid] * p.in[I_HBIAS][layer * 512 + c]) * bf2f(((const bf16*)(p.ws + WS_X0C))[o])); }
    }
}
typedef float f32x2 __attribute__((ext_vector_type(2)));
__device__ __forceinline__ f32x2 cmul(f32x2 a, f32x2 w) { return (f32x2){a.x * w.x - a.y * w.y, a.x * w.y + a.y * w.x}; }
__device__ __forceinline__ void fft_fwd_r4(f32x2* X, int tid) {
#pragma unroll 1
    for (int s = 0; s < 12; s += 2) {
        const int lq = 11 - s, Q = 1 << lq;
        __syncthreads();
#pragma unroll
        for (int q = 0; q < 4; ++q) { const int j = tid + 512 * q, pos = j & (Q - 1), i = ((j >> lq) << (lq + 2)) + pos;
            const float rev = (float)(pos << s) * (1.f / 8192.f); const f32x2 w1 = (f32x2){__builtin_amdgcn_cosf(rev), -__builtin_amdgcn_sinf(rev)}; const f32x2 w2 = cmul(w1, w1);
            const f32x2 a0 = X[i], a1 = X[i + Q], a2 = X[i + 2 * Q], a3 = X[i + 3 * Q];
            const f32x2 b0 = a0 + a2, b1 = a1 + a3, d02 = a0 - a2, d13 = a1 - a3;
            const f32x2 b2 = cmul(d02, w1), b3 = cmul((f32x2){d13.y, -d13.x}, w1);
            X[i] = b0 + b1; X[i + Q] = cmul(b0 - b1, w2); X[i + 2 * Q] = b2 + b3; X[i + 3 * Q] = cmul(b2 - b3, w2); }
    }
}
__device__ __forceinline__ void fft_inv_r4(f32x2* X, int tid) {
#pragma unroll 1
    for (int s = 1; s < 13; s += 2) {
        const int h = 1 << s;
        __syncthreads();
#pragma unroll
        for (int q = 0; q < 4; ++q) { const int j = tid + 512 * q, pos = j & (h - 1), i = ((j >> s) << (s + 2)) + pos;
            const float rev = (float)(pos << (11 - s)) * (1.f / 8192.f); const f32x2 v1 = (f32x2){__builtin_amdgcn_cosf(rev), __builtin_amdgcn_sinf(rev)}; const f32x2 v2 = cmul(v1, v1);
            const f32x2 a0 = X[i], a1 = cmul(X[i + h], v2), a2 = X[i + 2 * h], a3 = cmul(X[i + 3 * h], v2);
            const f32x2 b0 = a0 + a1, b1 = a0 - a1, b2 = cmul(a2 + a3, v1), t3 = cmul(a2 - a3, v1); const f32x2 b3 = (f32x2){-t3.y, t3.x};
            X[i] = b0 + b2; X[i + h] = b1 + b3; X[i + 2 * h] = b0 - b2; X[i + 3 * h] = b1 - b3; }
    }
}
__device__ __forceinline__ void ph_hyfft(const Ctx& cx, int layer, float* sm, bool dry) {
    CParams& p = get_params();
    const int tid = cx.tid;
    f32x2* A = (f32x2*)sm; f32x2* B = A + 8192;
    for (int c = cx.bid; c < 512; c += cx.nb) {
        const float* hf = (const float*)(p.ws + WS_FILT) + (size_t)c * SEQ; const float* hb = (const float*)(p.ws + WS_FILT) + ((size_t)512 + c) * SEQ;
        const float bias = p.in[I_HBIAS][layer * 512 + c];
        __syncthreads();
#pragma unroll
        for (int q = 0; q < 16; ++q) { const int i = tid + 512 * q; const float lf = hf[i & (SEQ - 1)], lb_ = hb[(2 * SEQ - i) & (SEQ - 1)]; A[i] = (f32x2){i < SEQ ? lf : (i > SEQ ? lb_ : 0.f), 0.f}; }
        fft_fwd_r4(A, tid);
        __syncthreads();
#pragma unroll
        for (int q = 0; q < 8; ++q) { const int i = 2 * (tid + 512 * q); const f32x2 a = A[i], b = A[i + 1]; A[i] = a + b; A[i + 1] = a - b; }
#pragma unroll 1
        for (int bp = 0; bp < 2; ++bp) {
            float* v0 = (float*)(p.ws + WS_VV) + ((size_t)(2 * bp) * 512 + c) * SEQ; float* v1 = v0 + (size_t)512 * SEQ;
            float xr[8], xi[8];
            __syncthreads();
#pragma unroll
            for (int q = 0; q < 8; ++q) { const int i = tid + 512 * q; xr[q] = v0[i]; xi[q] = v1[i]; B[i] = (f32x2){xr[q], xi[q]}; B[i + SEQ] = (f32x2){0.f, 0.f}; }
            fft_fwd_r4(B, tid);
            __syncthreads();
#pragma unroll
            for (int q = 0; q < 8; ++q) { const int i = 2 * (tid + 512 * q); const f32x2 a = B[i], b = B[i + 1];
                const f32x2 y0 = cmul(a + b, A[i]), y1 = cmul(a - b, A[i + 1]); B[i] = y0 + y1; B[i + 1] = y0 - y1; }
            fft_inv_r4(B, tid);
            __syncthreads();
#pragma unroll
            for (int q = 0; q < 8; ++q) { const int i = tid + 512 * q; const f32x2 y = B[i]; if (!dry) { v0[i] = y.x * (1.f / 8192.f) + xr[q] * bias; v1[i] = y.y * (1.f / 8192.f) + xi[q] * bias; } }
        }
    }
}
__device__ __forceinline__ void ph_hypost(const Ctx& cx, int layer, float* sm) {
    CParams& p = get_params();
    const int lane = cx.tid & 63, wave = cx.tid >> 6, gw = cx.bid * NWAVES + wave, NGW = cx.nb * NWAVES;
    float* tile = sm + wave * 4096;
    for (int it = gw; it < 4 * 64 * 8; it += NGW) {
        const int b = it >> 9, t0 = ((it >> 3) & 63) * 64, c0 = (it & 7) * 64;
        const float* yb = (const float*)(p.ws + WS_VV) + ((size_t)b * 512 + c0) * SEQ;
#pragma unroll 1
        for (int cb = 0; cb < 64; cb += 16) { float yv[16];
#pragma unroll
            for (int q = 0; q < 16; ++q) yv[q] = yb[(size_t)(cb + q) * SEQ + t0 + lane];
#pragma unroll
            for (int q = 0; q < 16; ++q) tile[(cb + q) * 64 + (lane ^ (cb + q))] = yv[q]; }
        __builtin_amdgcn_s_waitcnt(0xc07f);
#pragma unroll 1
        for (int tb = 0; tb < 64; tb += 16) { bf16 xv[16];
#pragma unroll
            for (int q = 0; q < 16; ++q) xv[q] = ((const bf16*)(p.ws + WS_X0C))[(size_t)(b * SEQ + t0 + tb + q) * 512 + c0 + lane];
#pragma unroll
            for (int q = 0; q < 16; ++q) { const int tt = tb + q; ((bf16*)(p.ws + WS_HY))[(size_t)(b * SEQ + t0 + tt) * 512 + c0 + lane] = f2bf(tile[lane * 64 + (tt ^ lane)] * bf2f(xv[q])); } }
        __builtin_amdgcn_s_waitcnt(0xc07f);
    }
    (void)layer;
}

__device__ __forceinline__ void s5_pow(const float decay, const float theta, int n, float& pr, float& pi) {
    const float m = __expf(decay * (float)n), rev = __builtin_amdgcn_fractf(theta * (float)n * 0.15915494309189535f);
    pr = m * __builtin_amdgcn_cosf(rev); pi = m * __builtin_amdgcn_sinf(rev);
}
__device__ __forceinline__ void s5_disc(CParams& p, int ldgp, float& decay, float& theta, float& cr, float& ci) {
    const float are = fminf(p.in[I_SARE][ldgp], -1e-4f), aim = p.in[I_SAIM][ldgp], dt = __expf(p.in[I_SLDT][ldgp >> 6]);
    decay = are * dt; theta = aim * dt;
    const float er = __expf(decay), abr = er * fcos(theta), abi = er * fsin(theta);
    const float nr = abr - 1.0f, ni = abi, den = are * are + aim * aim;
    cr = (nr * are + ni * aim) / den; ci = (ni * are - nr * aim) / den;
}
__device__ __forceinline__ void ph_s5tables(const Ctx& cx, int layer, float* sm) {
    const int gt = cx.bid * NTHREADS + cx.tid, NGT = cx.nb * NTHREADS;
    {
        CParams& p = get_params(); bf16* E = (bf16*)(p.ws + WS_S5E);
        for (int it = gt; it < 32 * 2 * 64 * 64; it += NGT) {
            const int pp = it & 63, s = (it >> 6) & 63, dir = (it >> 12) & 1, g = it >> 13;
            const int ldgp = ((layer * 2 + dir) * 32 + g) * 64 + pp;
            float decay, theta, cr, ci; s5_disc(p, ldgp, decay, theta, cr, ci);
            float pr, pi; s5_pow(decay, theta, dir == 0 ? 63 - s : s, pr, pi);
            const float qr = pr * cr - pi * ci, qi = pr * ci + pi * cr;
            const f32x4* bre = (const f32x4*)(p.in[I_SBRE] + (size_t)ldgp * 16); const f32x4* bim = (const f32x4*)(p.in[I_SBIM] + (size_t)ldgp * 16);
            bf16* er = E + (((size_t)(g * 2 + dir) * 128 + pp) * 1024 + s * 16); bf16* ei = er + (size_t)64 * 1024;
#pragma unroll
            for (int i4 = 0; i4 < 4; ++i4) { const f32x4 br = bre[i4], bi = bim[i4];
                *(unsigned*)(er + 4 * i4) = pk2(qr * br[0] - qi * bi[0], qr * br[1] - qi * bi[1]); *(unsigned*)(er + 4 * i4 + 2) = pk2(qr * br[2] - qi * bi[2], qr * br[3] - qi * bi[3]);
                *(unsigned*)(ei + 4 * i4) = pk2(qr * bi[0] + qi * br[0], qr * bi[1] + qi * br[1]); *(unsigned*)(ei + 4 * i4 + 2) = pk2(qr * bi[2] + qi * br[2], qr * bi[3] + qi * br[3]); }
            if (s == 0) { float ar, ai; s5_pow(decay, theta, 64, ar, ai); float* a64 = (float*)(p.ws + WS_S5A64) + (size_t)ldgp * 2; a64[0] = ar; a64[1] = ai; }
        }
    }
    {
        CParams& p = get_params(); bf16* P = (bf16*)(p.ws + WS_S5P);
        for (int it = gt; it < 32 * 2 * 64 * 64; it += NGT) {
            const int pp = it & 63, tau = (it >> 6) & 63, dir = (it >> 12) & 1, g = it >> 13;
            const int ldgp = ((layer * 2 + dir) * 32 + g) * 64 + pp;
            const float are = fminf(p.in[I_SARE][ldgp], -1e-4f), aim = p.in[I_SAIM][ldgp], dt = __expf(p.in[I_SLDT][ldgp >> 6]);
            float pr, pi; s5_pow(are * dt, aim * dt, dir == 0 ? tau + 1 : 64 - tau, pr, pi);
            const size_t cb = ((size_t)((layer * 2 + dir) * 32 + g) * 16) * 64 + pp;
            bf16* pb = P + (((size_t)(g * 2 + dir) * 64 + tau) * 16) * 128 + pp;
#pragma unroll
            for (int o = 0; o < 16; ++o) { const float cre = p.in[I_SCRE][cb + o * 64], cim = p.in[I_SCIM][cb + o * 64];
                pb[o * 128] = f2bf(cre * pr - cim * pi); pb[o * 128 + 64] = f2bf(-(cre * pi + cim * pr)); }
        }
    }
    {
        CParams& p = get_params(); bf16* K = (bf16*)(p.ws + WS_S5K);
        const int tid = cx.tid, lane = tid & 63, w = tid >> 6;
        float* Cs = sm;
        float* Xs = sm + 4096 + w * 2112;
        for (int it = cx.bid; it < 32 * 16; it += cx.nb) {
            const int g = it >> 4, dl = (it & 15) * 8 + w, d = dl - 63;
            __syncthreads();
            for (int i = tid; i < 2 * 16 * 64; i += NTHREADS) { const int dir = i >> 10, r = i & 1023; const size_t ci = (size_t)((layer * 2 + dir) * 32 + g) * 1024 + r;
                Cs[i * 2] = p.in[I_SCRE][ci]; Cs[i * 2 + 1] = p.in[I_SCIM][ci]; }
            __syncthreads();
            if (dl < 127) {
                float acc[4] = {0.f, 0.f, 0.f, 0.f};
#pragma unroll 1
                for (int dir = 0; dir < 2; ++dir) {
                    if ((dir == 0 && d < 0) || (dir == 1 && d > 0)) continue;
                    const int ldgp = ((layer * 2 + dir) * 32 + g) * 64 + lane;
                    float decay, theta, cr, ci; s5_disc(p, ldgp, decay, theta, cr, ci);
                    float pr, pi; s5_pow(decay, theta, d < 0 ? -d : d, pr, pi);
                    const float qr = pr * cr - pi * ci, qi = pr * ci + pi * cr;
                    const f32x4* bre = (const f32x4*)(p.in[I_SBRE] + (size_t)ldgp * 16); const f32x4* bim = (const f32x4*)(p.in[I_SBIM] + (size_t)ldgp * 16);
#pragma unroll
                    for (int i4 = 0; i4 < 4; ++i4) { const f32x4 br = bre[i4], bi = bim[i4];
#pragma unroll
                        for (int q = 0; q < 4; ++q) { Xs[lane * 33 + 4 * i4 + q] = qr * br[q] - qi * bi[q]; Xs[lane * 33 + 16 + 4 * i4 + q] = qr * bi[q] + qi * br[q]; } }
                    __builtin_amdgcn_s_waitcnt(0xc07f);
                    const int i = lane & 15, oq = lane >> 4;
                    for (int pp = 0; pp < 64; ++pp) { const float xr = Xs[pp * 33 + i], xi = Xs[pp * 33 + 16 + i];
#pragma unroll
                        for (int jj = 0; jj < 4; ++jj) { const f32x2 c = *(const f32x2*)(Cs + ((dir * 16 + oq + 4 * jj) * 64 + pp) * 2); acc[jj] += c.x * xr - c.y * xi; } }
                    __builtin_amdgcn_s_waitcnt(0xc07f);
                }
                const int i = lane & 15, oq = lane >> 4;
#pragma unroll
                for (int jj = 0; jj < 4; ++jj) { const int o = oq + 4 * jj; float v = acc[jj]; if (d == 0 && o == i) v += p.in[I_SD][layer * 512 + g * 16 + o];
                    K[((size_t)g * 127 + dl) * 256 + o * 16 + i] = f2bf(v); }
            }
        }
    }
}
__device__ __forceinline__ int s5_row(int b, int n, int s) { return n < 4 ? TL + b * CTXL + n * 64 + s : b * SEQ + (n - 4) * 64 + s; }
__device__ __forceinline__ void ph_s5states(const Ctx& cx, int layer, float* sm) {
    CParams& p = get_params();
    const int tid = cx.tid, lane = tid & 63, w = tid >> 6, l15 = lane & 15, kg = lane >> 4;
    const bf16* E = (const bf16*)(p.ws + WS_S5E); const bf16* U = (const bf16*)(p.ws + WS_U);
    float* S = sm;
    for (int it = cx.bid; it < 128; it += cx.nb) {
        const int g = it & 31, b = it >> 5;
        f32x4 acc[2][5];
#pragma unroll
        for (int mt = 0; mt < 2; ++mt)
#pragma unroll
            for (int nt = 0; nt < 5; ++nt) acc[mt][nt] = (f32x4){0.f, 0.f, 0.f, 0.f};
        const bf16* ea = E + ((size_t)g * 256 + 32 * w + l15) * 1024 + 8 * kg;
        const int i0 = 8 * (kg & 1);
        bf16x8 af[2], bfr[5];
#define S5S_LOAD(AF, BF, ks_) do { const int s_ = 2 * (ks_) + (kg >> 1); \
            _Pragma("unroll") for (int mt = 0; mt < 2; ++mt) AF[mt] = *(const bf16x8*)(ea + (size_t)mt * 16 * 1024 + (ks_) * 32); \
            _Pragma("unroll") for (int nt = 0; nt < 5; ++nt) { const int n = 16 * nt + l15, nc = n < 68 ? n : 67; \
                const bf16x8 ld_ = *(const bf16x8*)(U + s5_uidx(g, b, nc, s_) + i0); BF[nt] = n < 68 ? ld_ : (bf16x8){0, 0, 0, 0, 0, 0, 0, 0}; } } while (0)
        S5S_LOAD(af, bfr, 0);
        for (int ks = 0; ks < 32; ++ks) {
            bf16x8 afn[2], bfn[5];
            const int kn = ks < 31 ? ks + 1 : 31;
            S5S_LOAD(afn, bfn, kn);
#pragma unroll
            for (int mt = 0; mt < 2; ++mt)
#pragma unroll
                for (int nt = 0; nt < 5; ++nt) acc[mt][nt] = __builtin_amdgcn_mfma_f32_16x16x32_bf16(af[mt], bfr[nt], acc[mt][nt], 0, 0, 0);
#pragma unroll
            for (int mt = 0; mt < 2; ++mt) af[mt] = afn[mt];
#pragma unroll
            for (int nt = 0; nt < 5; ++nt) bfr[nt] = bfn[nt];
        }
#undef S5S_LOAD
        __syncthreads();
#pragma unroll
        for (int mt = 0; mt < 2; ++mt)
#pragma unroll
            for (int nt = 0; nt < 5; ++nt)
#pragma unroll
                for (int r = 0; r < 4; ++r) S[(32 * w + 16 * mt + kg * 4 + r) * 81 + 16 * nt + l15] = acc[mt][nt][r];
        __syncthreads();
        if (tid < 128) {
            const int dir = tid >> 6, pp = tid & 63;
            const float* a64 = (const float*)(p.ws + WS_S5A64) + ((size_t)((layer * 2 + dir) * 32 + g) * 64 + pp) * 2;
            const float ar = a64[0], ai = a64[1]; float hr = 0.f, hi = 0.f;
            bf16* hin = (bf16*)(p.ws + WS_HIN) + ((size_t)g * 272 + b * 68) * 256 + dir * 128 + pp;
            for (int k = 0; k < 68; ++k) {
                const int n = dir == 0 ? k : (k < 4 ? 3 - k : 71 - k);
                hin[(size_t)n * 256] = f2bf(hr); hin[(size_t)n * 256 + 64] = f2bf(hi);
                const float sr = S[(dir * 128 + pp) * 81 + n], si = S[(dir * 128 + 64 + pp) * 81 + n];
                const float nr = ar * hr - ai * hi + sr, ni = ar * hi + ai * hr + si; hr = nr; hi = ni;
            }
        }
    }
}
__device__ __forceinline__ void ph_s5out(const Ctx& cx, int layer, float* sm) {
    CParams& p = get_params();
    const int tid = cx.tid, lane = tid & 63, w = tid >> 6, l15 = lane & 15, kg = lane >> 4;
    const bf16* U = (const bf16*)(p.ws + WS_U); const bf16* P = (const bf16*)(p.ws + WS_S5P); const bf16* HIN = (const bf16*)(p.ws + WS_HIN);
    bf16* Kl = (bf16*)sm;
    for (int it = cx.bid; it < 256; it += cx.nb) {
        const int g = it & 31, b = (it >> 5) & 3, half = it >> 7;
        __syncthreads();
        { const u32x4* src = (const u32x4*)((const bf16*)(p.ws + WS_S5K) + (size_t)g * 127 * 256); u32x4* dst = (u32x4*)Kl;
          for (int i = tid; i < 127 * 256 / 8; i += NTHREADS) dst[i] = src[i]; }
        __syncthreads();
        f32x4 acc[4][5];
#pragma unroll
        for (int mt = 0; mt < 4; ++mt)
#pragma unroll
            for (int nt = 0; nt < 5; ++nt) acc[mt][nt] = (f32x4){0.f, 0.f, 0.f, 0.f};
        const int tau0 = 32 * half + 4 * w;
        const int i0 = 8 * (kg & 1);
        bf16x8 bfr[5];
#define S5O_LOADB(BF, ks_) do { const int s_ = 2 * (ks_) + (kg >> 1); \
            _Pragma("unroll") for (int nt = 0; nt < 5; ++nt) { const int n = 16 * nt + l15, nc = n < 68 ? n : 67; \
                const bf16x8 ld_ = *(const bf16x8*)(U + s5_uidx(g, b, nc, s_) + i0); BF[nt] = n < 68 ? ld_ : (bf16x8){0, 0, 0, 0, 0, 0, 0, 0}; } } while (0)
        S5O_LOADB(bfr, 0);
        for (int ks = 0; ks < 32; ++ks) {
            const int s = 2 * ks + (kg >> 1);
            bf16x8 bfn[5];
            const int kn = ks < 31 ? ks + 1 : 31;
            S5O_LOADB(bfn, kn);
#pragma unroll
            for (int mt = 0; mt < 4; ++mt) {
                const int lag = tau0 + mt - s;
                const bf16x8 af = *(const bf16x8*)(Kl + (lag + 63) * 256 + l15 * 16 + i0);
#pragma unroll
                for (int nt = 0; nt < 5; ++nt) acc[mt][nt] = __builtin_amdgcn_mfma_f32_16x16x32_bf16(af, bfr[nt], acc[mt][nt], 0, 0, 0);
            }
#pragma unroll
            for (int nt = 0; nt < 5; ++nt) bfr[nt] = bfn[nt];
        }
#undef S5O_LOADB
        bf16x8 pa[4];
#define S5O_LOAD2(AF, BF, dk_) do { const int dir_ = (dk_) >> 2, kk_ = (dk_) & 3; \
            _Pragma("unroll") for (int nt = 0; nt < 5; ++nt) { const int n = 16 * nt + l15, nc = n < 68 ? n : 67; \
                const bf16x8 ld_ = *(const bf16x8*)(HIN + ((size_t)g * 272 + b * 68 + nc) * 256 + dir_ * 128 + 32 * kk_ + 8 * kg); BF[nt] = n < 68 ? ld_ : (bf16x8){0, 0, 0, 0, 0, 0, 0, 0}; } \
            _Pragma("unroll") for (int mt = 0; mt < 4; ++mt) AF[mt] = *(const bf16x8*)(P + ((((size_t)(g * 2 + dir_) * 64 + tau0 + mt) * 16 + l15) * 128 + 32 * kk_ + 8 * kg)); } while (0)
        S5O_LOAD2(pa, bfr, 0);
#pragma unroll 1
        for (int dk = 0; dk < 8; ++dk) {
            bf16x8 pan[4], bfn[5];
            const int dn = dk < 7 ? dk + 1 : 7;
            S5O_LOAD2(pan, bfn, dn);
#pragma unroll
            for (int mt = 0; mt < 4; ++mt)
#pragma unroll
                for (int nt = 0; nt < 5; ++nt) acc[mt][nt] = __builtin_amdgcn_mfma_f32_16x16x32_bf16(pa[mt], bfr[nt], acc[mt][nt], 0, 0, 0);
#pragma unroll
            for (int mt = 0; mt < 4; ++mt) pa[mt] = pan[mt];
#pragma unroll
            for (int nt = 0; nt < 5; ++nt) bfr[nt] = bfn[nt];
        }
#undef S5O_LOAD2
#pragma unroll
        for (int mt = 0; mt < 4; ++mt)
#pragma unroll
            for (int nt = 0; nt < 5; ++nt) { const int n = 16 * nt + l15;
                if (n < 68 && (layer == 0 || n >= 4)) { const f32x4 y = acc[mt][nt]; u32x2 o; o.x = pk2(gelu_tanh(y[0]), gelu_tanh(y[1])); o.y = pk2(gelu_tanh(y[2]), gelu_tanh(y[3]));
                    *(u32x2*)((bf16*)(p.ws + WS_S5Y) + (size_t)s5_row(b, n, tau0 + mt) * 512 + g * 16 + 4 * kg) = o; } }
    }
}

__device__ __forceinline__ void ph_glu(const Ctx& cx, int layer, PG8_LAS unsigned char* lds) {
    CParams& p = get_params();
    pg8::Gemm g; g.A = (const bf16*)(p.ws + WS_S5Y); g.Bt = (const bf16*)(p.ws + WT_GLU) + (size_t)layer * 512 * 512; g.zsA = 0; g.zsB = 0; g.K = 512;
    pg8::TileOrder S; S.nM = TL / 256; S.nN = 2; S.nwg = S.nM * S.nN; S.G = cx.nb; S.c = cx.bid; S.nz = 1; S.exN = 2; S.expn0 = 0; S.extra = layer == 0 ? 4 * 2 : 0;
    EpiGlu E; E.ws = p.ws; E.bias = p.in[I_GLUB] + layer * 512;
    pg8::gemm_phase<EpiGlu, pg8::TileOrder>(lds, g, S, E, cx.tid);
}
__device__ __forceinline__ void ph_merge(const Ctx& cx, int layer, PG8_LAS unsigned char* lds) {
    CParams& p = get_params();
    pg8::Gemm g; g.A = (const bf16*)(p.ws + WS_ATT); g.zsA = (WS_HY - WS_ATT) / 2;
    g.Bt = (const bf16*)(p.ws + WT_BR) + (size_t)(layer * 3 + 0) * 1024 * 512; g.zsB = 1024 * 512; g.K = 512;
    pg8::TileOrder S; S.nM = TL / 256; S.nN = 4; S.nwg = S.nM * S.nN; S.G = cx.nb; S.c = cx.bid; S.nz = 3; S.exN = 4; S.expn0 = 0; S.extra = layer == 0 ? 4 * 4 : 0;
    EpiMerge E; E.ws = p.ws;
    pg8::gemm_phase<EpiMerge, pg8::TileOrder>(lds, g, S, E, cx.tid);
}
__device__ __forceinline__ void ph_outproj(const Ctx& cx, int layer, PG8_LAS unsigned char* lds, float scale) {
    CParams& p = get_params();
    pg8::Gemm g; g.A = (const bf16*)(p.ws + WS_M); g.Bt = (const bf16*)(p.ws + WT_OUT) + (size_t)layer * 1024 * 1024; g.zsA = 0; g.zsB = 0; g.K = 1024;
    pg8::TileOrder S; S.nM = TL / 256; S.nN = 4; S.nwg = S.nM * S.nN; S.G = cx.nb; S.c = cx.bid; S.nz = 1; S.exN = 4; S.expn0 = 0; S.extra = layer == 0 ? 4 * 4 : 0;
    EpiOut E; E.ws = p.ws; E.layer = layer; E.scale = scale; E.xin = layer == 0 ? p.in[I_X] : (const float*)(p.ws + WS_XCUR); E.cin = layer == 0 ? p.in[I_CTX] - (size_t)TL * 1024 : (const float*)(p.ws + WS_XCUR);
    pg8::gemm_phase<EpiOut, pg8::TileOrder>(lds, g, S, E, cx.tid);
}
__device__ __forceinline__ void ph_qp(const Ctx& cx, int layer, PG8_LAS unsigned char* lds) {
    CParams& p = get_params();
    pg8::Gemm g; g.A = (const bf16*)(p.ws + WS_H); g.Bt = (const bf16*)(p.ws + WT_WQ) + (size_t)layer * 2048 * 1024; g.zsA = 0; g.zsB = 0; g.K = 1024;
    pg8::TileOrder S; S.nM = TL / 256; S.nN = 8; S.nwg = S.nM * S.nN; S.G = cx.nb; S.c = cx.bid; S.nz = 1; S.exN = 8; S.expn0 = 0; S.extra = layer == 0 ? 4 * 8 : 0;
    EpiQp E; E.ws = p.ws;
    pg8::gemm_phase<EpiQp, pg8::TileOrder>(lds, g, S, E, cx.tid);
}

__device__ __forceinline__ void ph_peerconv(const Ctx& cx, int layer) {
    CParams& p = get_params();
    const int gt = cx.bid * NTHREADS + cx.tid, NGT = cx.nb * NTHREADS;
    const f32x4* su = (const f32x4*)(p.in[I_PU] + (size_t)layer * 16384 * 1024); const f32x4* sv = (const f32x4*)(p.in[I_PV] + (size_t)layer * 16384 * 1024);
    int* du = (int*)(p.ws + WS_PU); int* dv = (int*)(p.ws + WS_PV);
    for (int i0 = gt; i0 < 16384 * 1024 / 4; i0 += 4 * NGT) {
        f32x4 a[4], c[4];
#pragma unroll
        for (int q = 0; q < 4; ++q) { const int i = i0 + q * NGT < 16384 * 1024 / 4 ? i0 + q * NGT : i0; a[q] = __builtin_nontemporal_load(su + i); c[q] = __builtin_nontemporal_load(sv + i); }
#pragma unroll
        for (int q = 0; q < 4; ++q) { const int i = i0 + q * NGT; if (i >= 16384 * 1024 / 4) break; const f32x4 av = a[q] * PEER_SU, cv = c[q] * PEER_SV;
            int wa = 0, wc = 0; wa = __builtin_amdgcn_cvt_pk_fp8_f32(av[0], av[1], wa, false); wa = __builtin_amdgcn_cvt_pk_fp8_f32(av[2], av[3], wa, true);
            wc = __builtin_amdgcn_cvt_pk_fp8_f32(cv[0], cv[1], wc, false); wc = __builtin_amdgcn_cvt_pk_fp8_f32(cv[2], cv[3], wc, true);
            const int e = i >> 8, qq = i & 255, di = (((qq >> 5) * 16384 + e) << 5) + (qq & 31); du[di] = wa; dv[di] = wc; }
    }
}
__device__ __forceinline__ unsigned mono_key(float s, unsigned lowbits, unsigned mask) { const unsigned u = __float_as_uint(s); const unsigned k = (u & 0x80000000u) ? ~u : (u | 0x80000000u); return (k & ~mask) | lowbits; }
__device__ __forceinline__ float mono_val(unsigned key, unsigned mask) { const unsigned k = (key & ~mask) | ((mask + 1u) >> 1); return __uint_as_float((k & 0x80000000u) ? (k & 0x7fffffffu) : ~k); }
#define TOP16_INSERT(t, v_) do { unsigned v__ = (v_); _Pragma("unroll") for (int k_ = 0; k_ < 16; ++k_) { const unsigned hi__ = t[k_] > v__ ? t[k_] : v__; v__ = t[k_] > v__ ? v__ : t[k_]; t[k_] = hi__; } } while (0)
#define CE_DESC(x_, y_) do { const unsigned hi__ = (x_) > (y_) ? (x_) : (y_); const unsigned lo__ = (x_) > (y_) ? (y_) : (x_); (x_) = hi__; (y_) = lo__; } while (0)
__device__ __forceinline__ void sort16_desc(unsigned (&v)[16]) {
#pragma unroll
    for (int k = 2; k <= 16; k <<= 1)
#pragma unroll
        for (int j = k >> 1; j > 0; j >>= 1)
#pragma unroll
            for (int i = 0; i < 16; ++i) { const int l = i ^ j; if (l > i) { if ((i & k) == 0) CE_DESC(v[i], v[l]); else CE_DESC(v[l], v[i]); } }
}
__device__ __forceinline__ void merge16_desc(unsigned (&t)[16], const unsigned (&s)[16]) {
    unsigned c[16];
#pragma unroll
    for (int k = 0; k < 16; ++k) c[k] = t[k] > s[15 - k] ? t[k] : s[15 - k];
#pragma unroll
    for (int d = 8; d >= 1; d >>= 1)
#pragma unroll
        for (int k = 0; k < 16; ++k) if ((k & d) == 0) CE_DESC(c[k], c[k + d]);
#pragma unroll
    for (int k = 0; k < 16; ++k) t[k] = c[k];
}
__device__ __forceinline__ void top16_merge_pair(unsigned (&t)[16]) {
    unsigned c[16];
#pragma unroll
    for (int k = 0; k < 16; ++k) { const unsigned o = (unsigned)__shfl_xor((int)t[15 - k], 32); c[k] = t[k] > o ? t[k] : o; }
#pragma unroll
    for (int d = 8; d >= 1; d >>= 1)
#pragma unroll
        for (int k = 0; k < 16; ++k) if ((k & d) == 0) { const unsigned a = c[k], bb = c[k + d]; c[k] = a > bb ? a : bb; c[k + d] = a > bb ? bb : a; }
#pragma unroll
    for (int k = 0; k < 16; ++k) t[k] = c[k];
}
__device__ __forceinline__ void ph_select(const Ctx& cx, int layer) {
    CParams& p = get_params();
    const int lane = cx.tid & 63, wave = cx.tid >> 6, l31 = lane & 31, hi = lane >> 5;
    const int gw = cx.bid * NWAVES + wave, NGW = cx.nb * NWAVES;
    const int nrows = layer == 0 ? TA : TL;
    const bf16* QP = (const bf16*)(p.ws + WS_QP); const bf16* KY = (const bf16*)(p.ws + WT_KEYS) + (size_t)layer * 8 * 2 * 128 * 128;
    for (int it = gw; it < (nrows / 32) * 8; it += NGW) {
        const int h = it & 7, r0 = (it >> 3) * 32;
        unsigned ab[2][16];
#pragma unroll
        for (int s = 0; s < 2; ++s) {
            const bf16* kp = KY + ((size_t)(h * 2 + s) * 8 * 128 + l31) * 16 + 8 * hi;
            const bf16* qp = QP + ((size_t)(h * 2 + s) * 8 * TA + (r0 + l31)) * 16 + 8 * hi;
            bf16x8 qf[8], kc[8];
#pragma unroll
            for (int ks = 0; ks < 8; ++ks) { qf[ks] = *(const bf16x8*)(qp + (size_t)ks * TA * 16); kc[ks] = *(const bf16x8*)(kp + ks * 2048); }
            unsigned t[16];
#pragma unroll
            for (int k = 0; k < 16; ++k) t[k] = 0u;
#pragma unroll 1
            for (int nt = 0; nt < 4; ++nt) {
                bf16x8 kn[8];
                const bf16* kpn = kp + (nt < 3 ? nt + 1 : nt) * 512;
#pragma unroll
                for (int ks = 0; ks < 8; ++ks) kn[ks] = *(const bf16x8*)(kpn + ks * 2048);
                f32x16 acc;
#pragma unroll
                for (int r = 0; r < 16; ++r) acc[r] = 0.f;
#pragma unroll
                for (int ks = 0; ks < 8; ++ks) acc = __builtin_amdgcn_mfma_f32_32x32x16_bf16(kc[ks], qf[ks], acc, 0, 0, 0);
                unsigned sk[16];
#pragma unroll
                for (int r = 0; r < 16; ++r) { const int n = 32 * nt + (r & 3) + 8 * (r >> 2) + 4 * hi; sk[r] = mono_key(acc[r], 127u - (unsigned)n, 127u); }
                sort16_desc(sk);
                merge16_desc(t, sk);
#pragma unroll
                for (int ks = 0; ks < 8; ++ks) kc[ks] = kn[ks];
            }
            top16_merge_pair(t);
#pragma unroll
            for (int k = 0; k < 16; ++k) ab[s][k] = t[k];
        }
        float av[16], bv[16];
#pragma unroll
        for (int k = 0; k < 16; ++k) { av[k] = mono_val(ab[0][k], 127u); bv[k] = mono_val(ab[1][k], 127u); }
        unsigned t2[16], u2[16];
#pragma unroll
        for (int k = 0; k < 16; ++k) { t2[k] = 0u; u2[k] = 0u; }
#define CELL(dst, i1, j1, i2, j2) do { const float sv_ = hi ? av[i2] + bv[j2] : av[i1] + bv[j1]; const unsigned lb_ = hi ? 255u - (unsigned)((i2) * 16 + (j2)) : 255u - (unsigned)((i1) * 16 + (j1)); dst = mono_key(sv_, lb_, 255u); } while (0)
        CELL(t2[0], 0, 0, 1, 1);   CELL(t2[1], 0, 1, 1, 2);   CELL(t2[2], 0, 2, 1, 3);   CELL(t2[3], 0, 3, 1, 4);   CELL(t2[4], 0, 4, 1, 5);   CELL(t2[5], 0, 5, 1, 6);   CELL(t2[6], 0, 6, 1, 7);   CELL(t2[7], 0, 7, 2, 0);
        CELL(t2[8], 0, 8, 2, 1);   CELL(t2[9], 0, 9, 2, 2);   CELL(t2[10], 0, 10, 2, 3); CELL(t2[11], 0, 11, 2, 4); CELL(t2[12], 0, 12, 3, 0); CELL(t2[13], 0, 13, 3, 1); CELL(t2[14], 0, 14, 3, 2); CELL(t2[15], 0, 15, 3, 3);
        CELL(u2[0], 1, 0, 4, 0);   CELL(u2[1], 4, 1, 4, 2);   CELL(u2[2], 5, 0, 5, 1);   CELL(u2[3], 6, 0, 6, 1);   CELL(u2[4], 7, 0, 7, 1);   CELL(u2[5], 8, 0, 9, 0);   CELL(u2[6], 10, 0, 11, 0); CELL(u2[7], 12, 0, 13, 0); CELL(u2[8], 14, 0, 15, 0);
#undef CELL
        sort16_desc(t2); sort16_desc(u2); merge16_desc(t2, u2);
        top16_merge_pair(t2);
        const float v0 = mono_val(t2[0], 255u); float e[16], esum = 0.f; int eid[16];
#pragma unroll
        for (int k = 0; k < 16; ++k) { e[k] = __expf(mono_val(t2[k], 255u) - v0); esum += e[k];
            const unsigned c = 255u - (t2[k] & 255u), ci = c >> 4, cj = c & 15u; unsigned ka = ab[0][0], kb = ab[1][0];
#pragma unroll
            for (int q = 1; q < 16; ++q) { ka = ci == (unsigned)q ? ab[0][q] : ka; kb = cj == (unsigned)q ? ab[1][q] : kb; }
            eid[k] = (int)((127u - (ka & 127u)) * 128u + (127u - (kb & 127u))); }
        const float inv = 1.f / esum;
        if (hi == 0) { int* dst = (int*)(p.ws + WS_EID) + (size_t)(r0 + l31) * 128 + h * 16;
#pragma unroll
            for (int k = 0; k < 16; k += 4) *(u32x4*)(dst + k) = (u32x4){(unsigned)eid[k], (unsigned)eid[k + 1], (unsigned)eid[k + 2], (unsigned)eid[k + 3]}; }
        else { float* dst = (float*)(p.ws + WS_EG) + (size_t)(r0 + l31) * 128 + h * 16;
#pragma unroll
            for (int k = 0; k < 16; k += 4) *(f32x4*)(dst + k) = (f32x4){e[k] * inv, e[k + 1] * inv, e[k + 2] * inv, e[k + 3] * inv}; }
    }
}
__device__ __forceinline__ void fp8x16_to_f32(const u32x4 w, f32x2 (&f)[8]) {
    f[0] = __builtin_amdgcn_cvt_pk_f32_fp8((int)w.x, false); f[1] = __builtin_amdgcn_cvt_pk_f32_fp8((int)w.x, true); f[2] = __builtin_amdgcn_cvt_pk_f32_fp8((int)w.y, false); f[3] = __builtin_amdgcn_cvt_pk_f32_fp8((int)w.y, true);
    f[4] = __builtin_amdgcn_cvt_pk_f32_fp8((int)w.z, false); f[5] = __builtin_amdgcn_cvt_pk_f32_fp8((int)w.z, true); f[6] = __builtin_amdgcn_cvt_pk_f32_fp8((int)w.w, false); f[7] = __builtin_amdgcn_cvt_pk_f32_fp8((int)w.w, true);
}
#define PU_ISSUE(rowbuf, e0_, e1_) do { _Pragma("unroll") for (int s = 0; s < 16; ++s) { const int e_ = __shfl(s < 8 ? e0_ : e1_, (s & 7) * 8 + grp); \
        rowbuf[s] = __builtin_amdgcn_raw_buffer_load_b128(ru, (unsigned)(e_ * 128 + j8 * 16), 0, 0); } } while (0)
__device__ __forceinline__ void pu_compute(const u32x4 (&row)[16], const u32x4 xw0, const u32x4 xw1, float* pt, int j8, int grp) {
    f32x2 x[8];
    { const f32x4 a = bf4lo(xw0), b = bf4hi(xw0), c = bf4lo(xw1), d = bf4hi(xw1);
      x[0] = (f32x2){a[0], a[1]}; x[1] = (f32x2){a[2], a[3]}; x[2] = (f32x2){b[0], b[1]}; x[3] = (f32x2){b[2], b[3]}; x[4] = (f32x2){c[0], c[1]}; x[5] = (f32x2){c[2], c[3]}; x[6] = (f32x2){d[0], d[1]}; x[7] = (f32x2){d[2], d[3]}; }
    float d[16];
#pragma unroll
    for (int s = 0; s < 16; ++s) { f32x2 f[8]; fp8x16_to_f32(row[s], f);
        f32x2 a = f[0] * x[0];
#pragma unroll
        for (int j = 1; j < 8; ++j) a += f[j] * x[j];
        d[s] = a.x + a.y; }
    float a8[8], a4[4];
    { const bool bt = j8 & 4;
#pragma unroll
      for (int i = 0; i < 4; ++i) {
          const float s0 = bt ? d[i] : d[i + 4], k0 = bt ? d[i + 4] : d[i]; a8[i] = k0 + __shfl_xor(s0, 4);
          const float s1 = bt ? d[i + 8] : d[i + 12], k1 = bt ? d[i + 12] : d[i + 8]; a8[i + 4] = k1 + __shfl_xor(s1, 4); } }
    { const bool bt = j8 & 2;
#pragma unroll
      for (int i = 0; i < 2; ++i) {
          const float s0 = bt ? a8[i] : a8[i + 2], k0 = bt ? a8[i + 2] : a8[i]; a4[i] = k0 + __shfl_xor(s0, 2);
          const float s1 = bt ? a8[i + 4] : a8[i + 6], k1 = bt ? a8[i + 6] : a8[i + 4]; a4[i + 2] = k1 + __shfl_xor(s1, 2); } }
    float r0, r1;
    { const bool bt = j8 & 1;
      const float s0 = bt ? a4[0] : a4[1], k0 = bt ? a4[1] : a4[0]; r0 = k0 + __shfl_xor(s0, 1);
      const float s1 = bt ? a4[2] : a4[3], k1 = bt ? a4[3] : a4[2]; r1 = k1 + __shfl_xor(s1, 1); }
    pt[0] = r0; pt[64] = r1;
}
__device__ __forceinline__ void ph_peer_u(const Ctx& cx, int layer) {
    CParams& p = get_params();
    const int lane = cx.tid & 63, wave = __builtin_amdgcn_readfirstlane(cx.tid >> 6);
    const int nrows = layer == 0 ? TA : TL;
    const int slice = cx.bid & 7, ws_ = (cx.bid >> 3) * NWAVES + wave, NWS = (cx.nb >> 3) * NWAVES;
    const __amdgpu_buffer_rsrc_t ru = __builtin_amdgcn_make_buffer_rsrc((void*)uni_ptr(p.ws + WS_PU + (size_t)slice * (16384 * 128)), (short)0, 16384 * 128, 0x00020000);
    const int j8 = lane & 7, grp = lane >> 3;
    float* PART = (float*)(p.ws + WS_PART) + (size_t)slice * TA * 128 + j8 * 8 + grp;
    const int* EID = (const int*)(p.ws + WS_EID) + lane; const bf16* Hx = (const bf16*)(p.ws + WS_H) + slice * 128 + j8 * 16;
    int t = ws_;
    if (t >= nrows) return;
    u32x4 rA[16], rB[16]; u32x4 xa0, xa1, xb0, xb1;
    int e0 = EID[(size_t)t * 128], e1 = EID[(size_t)t * 128 + 64];
    PU_ISSUE(rA, e0, e1); xa0 = *(const u32x4*)(Hx + (size_t)t * 1024); xa1 = *(const u32x4*)(Hx + (size_t)t * 1024 + 8);
    if (t + NWS < nrows) { e0 = EID[(size_t)(t + NWS) * 128]; e1 = EID[(size_t)(t + NWS) * 128 + 64]; }
    for (;;) {
        const int t1 = t + NWS, t2 = t + 2 * NWS, t3 = t + 3 * NWS;
        if (t1 < nrows) { PU_ISSUE(rB, e0, e1); xb0 = *(const u32x4*)(Hx + (size_t)t1 * 1024); xb1 = *(const u32x4*)(Hx + (size_t)t1 * 1024 + 8); }
        if (t2 < nrows) { e0 = EID[(size_t)t2 * 128]; e1 = EID[(size_t)t2 * 128 + 64]; }
        pu_compute(rA, xa0, xa1, PART + (size_t)t * 128, j8, grp);
        if (t1 >= nrows) break;
        if (t2 < nrows) { PU_ISSUE(rA, e0, e1); xa0 = *(const u32x4*)(Hx + (size_t)t2 * 1024); xa1 = *(const u32x4*)(Hx + (size_t)t2 * 1024 + 8); }
        if (t3 < nrows) { e0 = EID[(size_t)t3 * 128]; e1 = EID[(size_t)t3 * 128 + 64]; }
        pu_compute(rB, xb0, xb1, PART + (size_t)t1 * 128, j8, grp);
        if (t2 >= nrows) break;
        t = t2;
    }
}
#undef PU_ISSUE
__device__ __forceinline__ void ph_peer_w(const Ctx& cx, int layer) {
    CParams& p = get_params();
    const int gt = cx.bid * NTHREADS + cx.tid, NGT = cx.nb * NTHREADS;
    const int n = (layer == 0 ? TA : TL) * 128;
    const float* PART = (const float*)(p.ws + WS_PART); float* EG = (float*)(p.ws + WS_EG);
    for (int i = gt; i < n; i += 2 * NGT) { const int i2 = i + NGT < n ? i + NGT : i; float pa[8], pb[8];
#pragma unroll
        for (int xs = 0; xs < 8; ++xs) { pa[xs] = PART[(size_t)xs * TA * 128 + i]; pb[xs] = PART[(size_t)xs * TA * 128 + i2]; }
        const float ga = EG[i], gb = EG[i2]; float da = 0.f, db = 0.f;
#pragma unroll
        for (int xs = 0; xs < 8; ++xs) { da += pa[xs]; db += pb[xs]; }
        EG[i] = ga * gelu_tanh(da * (1.f / PEER_SU)); if (i2 != i) EG[i2] = gb * gelu_tanh(db * (1.f / PEER_SU)); }
}
#define PV_ISSUE(vbuf, wbuf, e0_, e1_, w0_, w1_) do { _Pragma("unroll") for (int s = 0; s < 16; ++s) { const int src_ = (s & 7) * 8 + grp; \
        const int ee_ = __shfl(s < 8 ? e0_ : e1_, src_); wbuf[s] = __shfl(s < 8 ? w0_ : w1_, src_); vbuf[s] = __builtin_amdgcn_raw_buffer_load_b128(rv, (unsigned)(ee_ * 128 + j8 * 16), 0, 0); } } while (0)
__device__ __forceinline__ void pv_compute(const u32x4 (&row)[16], const float (&w)[16], float* o, const float* g2, int lane, float scale) {
    f32x2 acc[8];
#pragma unroll
    for (int j = 0; j < 8; ++j) acc[j] = (f32x2){0.f, 0.f};
#pragma unroll
    for (int s = 0; s < 16; ++s) { f32x2 f[8]; fp8x16_to_f32(row[s], f);
#pragma unroll
        for (int j = 0; j < 8; ++j) acc[j] += w[s] * f[j]; }
    f32x2 a4[4], a2[2];
    { const bool bt = lane & 32;
#pragma unroll
      for (int i = 0; i < 4; ++i) { const f32x2 sd = bt ? acc[i] : acc[i + 4], kp = bt ? acc[i + 4] : acc[i]; a4[i] = (f32x2){kp.x + __shfl_xor(sd.x, 32), kp.y + __shfl_xor(sd.y, 32)}; } }
    { const bool bt = lane & 16;
#pragma unroll
      for (int i = 0; i < 2; ++i) { const f32x2 sd = bt ? a4[i] : a4[i + 2], kp = bt ? a4[i + 2] : a4[i]; a2[i] = (f32x2){kp.x + __shfl_xor(sd.x, 16), kp.y + __shfl_xor(sd.y, 16)}; } }
    f32x2 r; { const bool bt = lane & 8; const f32x2 sd = bt ? a2[0] : a2[1], kp = bt ? a2[1] : a2[0]; r = (f32x2){kp.x + __shfl_xor(sd.x, 8), kp.y + __shfl_xor(sd.y, 8)}; }
    const int co = ((lane >> 5) & 1) * 8 + ((lane >> 4) & 1) * 4 + ((lane >> 3) & 1) * 2;
    const f32x2 gg = *(const f32x2*)(g2 + co); f32x2* xp = (f32x2*)(o + co); const f32x2 xv = *xp; *xp = (f32x2){xv.x + gg.x * r.x * scale, xv.y + gg.y * r.y * scale};
}
__device__ __forceinline__ void ph_peer_v(const Ctx& cx, int layer, float scale_) {
    CParams& p = get_params();
    const int lane = cx.tid & 63, wave = __builtin_amdgcn_readfirstlane(cx.tid >> 6);
    const int nrows = layer == 0 ? TA : TL;
    const int slice = cx.bid & 7, ws_ = (cx.bid >> 3) * NWAVES + wave, NWS = (cx.nb >> 3) * NWAVES;
    const __amdgpu_buffer_rsrc_t rv = __builtin_amdgcn_make_buffer_rsrc((void*)uni_ptr(p.ws + WS_PV + (size_t)slice * (16384 * 128)), (short)0, 16384 * 128, 0x00020000);
    const int j8 = lane & 7, grp = lane >> 3;
    const float* EG = (const float*)(p.ws + WS_EG) + lane; const int* EID = (const int*)(p.ws + WS_EID) + lane;
    float* OUT = (float*)(p.ws + WS_XCUR) + slice * 128 + j8 * 16;
    const float* G2 = (const float*)(p.ws + WS_MODV) + (size_t)layer * 5 * 6144 + 5120 + slice * 128 + j8 * 16; const float scale = scale_ / PEER_SV;
    int t = ws_;
    if (t >= nrows) return;
    u32x4 rA[16], rB[16]; float wA[16], wB[16];
    int e0 = EID[(size_t)t * 128], e1 = EID[(size_t)t * 128 + 64]; float w0 = EG[(size_t)t * 128], w1 = EG[(size_t)t * 128 + 64];
    PV_ISSUE(rA, wA, e0, e1, w0, w1);
    if (t + NWS < nrows) { e0 = EID[(size_t)(t + NWS) * 128]; e1 = EID[(size_t)(t + NWS) * 128 + 64]; w0 = EG[(size_t)(t + NWS) * 128]; w1 = EG[(size_t)(t + NWS) * 128 + 64]; }
    for (;;) {
        const int t1 = t + NWS, t2 = t + 2 * NWS, t3 = t + 3 * NWS;
        if (t1 < nrows) PV_ISSUE(rB, wB, e0, e1, w0, w1);
        if (t2 < nrows) { e0 = EID[(size_t)t2 * 128]; e1 = EID[(size_t)t2 * 128 + 64]; w0 = EG[(size_t)t2 * 128]; w1 = EG[(size_t)t2 * 128 + 64]; }
        pv_compute(rA, wA, OUT + (size_t)t * 1024, G2 + (size_t)row_mi(t) * 6144, lane, scale);
        if (t1 >= nrows) break;
        if (t2 < nrows) PV_ISSUE(rA, wA, e0, e1, w0, w1);
        if (t3 < nrows) { e0 = EID[(size_t)t3 * 128]; e1 = EID[(size_t)t3 * 128 + 64]; w0 = EG[(size_t)t3 * 128]; w1 = EG[(size_t)t3 * 128 + 64]; }
        pv_compute(rB, wB, OUT + (size_t)t1 * 1024, G2 + (size_t)row_mi(t1) * 6144, lane, scale);
        if (t2 >= nrows) break;
        t = t2;
    }
}
#undef PV_ISSUE
__device__ __forceinline__ void ph_peer_fin(const Ctx& cx, int layer) {
    CParams& p = get_params();
    const int lane = cx.tid & 63, wave = cx.tid >> 6;
    const int gw = cx.bid * NWAVES + wave, NGW = cx.nb * NWAVES;
    const int nrows = layer == 0 ? TA : TL;
    const float* X = (const float*)(p.ws + WS_XCUR);
    for (int r = gw; r < nrows; r += NGW) {
        f32x4 v[4]; float ss = 0.f;
#pragma unroll
        for (int j = 0; j < 4; ++j) { const int c = j * 256 + lane * 4; const f32x4 xv = *(const f32x4*)(X + (size_t)r * 1024 + c); v[j] = xv; ss += xv[0] * xv[0] + xv[1] * xv[1] + xv[2] * xv[2] + xv[3] * xv[3]; }
        const float rs = rsqrtf(wave_sum(ss) * (1.f / DM) + NORM_EPS);
        if (layer == DEPTH - 1) {
#pragma unroll
            for (int j = 0; j < 4; ++j) { const int c = j * 256 + lane * 4; *(f32x4*)(p.out + (size_t)r * 1024 + c) = v[j] * rs * *(const f32x4*)(p.in[I_FG] + c); }
        } else {
            const float* g = p.in[I_N1G] + (layer + 1) * DM; const float* mv = (const float*)(p.ws + WS_MODV) + ((size_t)(layer + 1) * 5 + row_mi(r)) * 6144;
#pragma unroll
            for (int j = 0; j < 4; ++j) { const int c = j * 256 + lane * 4;
                const f32x4 y = v[j] * rs * *(const f32x4*)(g + c); const f32x4 h = y * (1.f + *(const f32x4*)(mv + 1024 + c)) + *(const f32x4*)(mv + c);
                u32x2 w; w.x = pk2(h[0], h[1]); w.y = pk2(h[2], h[3]); *(u32x2*)((bf16*)(p.ws + WS_H) + (size_t)r * DM + c) = w; }
        }
    }
}

constexpr int NPL = 14, NPHASE = 1 + DEPTH * NPL;
#ifndef ONLY
#define ONLY -1
#endif
#ifndef NOT
#define NOT -1
#endif
#define ON(n) ((ONLY < 0 || ONLY == (n)) && NOT != (n))
#ifndef PROBE_REPS
#define PROBE_REPS 2
#endif
#define REPN(n) (PROBE_HAS(n) ? PROBE_REPS : 1)
#define RUN(n, call) do { { MKCX(); if (ON(n)) { const int rep_ = 0; (void)rep_; call; } } if (REPN(n) > 1) { _Pragma("unroll 1") for (int rr_ = 1; rr_ < REPN(n); ++rr_) { __syncthreads(); { MKCX(); if (ON(n)) { const int rep_ = REPN(n) - rr_; (void)rep_; call; } } } __syncthreads(); } } while (0)
#define MKCX() Ctx cx; cx.tid = threadIdx.x; cx.bid = blockIdx.x; cx.nb = gridDim.x; asm volatile("" : "+v"(cx.tid), "+s"(cx.bid), "+s"(cx.nb))
#define IN(k) (lo <= (k) && (k) < hi)
#define SUBSET(first, count, call) do { MKCX(); if (cx.bid >= (first) && cx.bid < (first) + (count)) { cx.bid -= (first); cx.nb = (count); call; } } while (0)
#define SIDE(first, call) do { MKCX(); if (cx.bid >= (first)) { cx.bid -= (first); cx.nb -= (first); call; } } while (0)
#define SEAM(k) do { if (IN(k) && IN((k) + 1)) { XcdBarrier bar_; bar_.bar = (unsigned*)(get_params().ws + WS_CTL) + 4096; bar_.x = xb_xcc_id(); bar_.st = st; xcd_barrier(bar_); } } while (0)
template <int LAYER> __device__ __forceinline__ void layer_program(const int lo, const int hi, float* sm, PG8_LAS unsigned char* lds, volatile LAS unsigned* st) {
    constexpr int B = 1 + LAYER * NPL;
    if (LAYER == 0) { if (IN(B + 0)) { RUN(0, ph_norm(cx, LAYER, 0, 0)); } SEAM(B + 0); }
    if (IN(B + 1)) { RUN(1, ph_inproj(cx, LAYER, lds)); if (LAYER == 0) { __syncthreads(); SIDE(28, ph_filters(cx, 0, sm)); } } SEAM(B + 1);
    if (IN(B + 2)) { RUN(2, ph_attn(cx, LAYER, sm, 0, 256)); __syncthreads();
        SUBSET(0, 128, ph_s5states(cx, LAYER, sm)); SUBSET(128, 128, ph_hypre(cx, LAYER, sm, 0, 2048)); __syncthreads();
        if (LAYER == 0) { SUBSET(128, 16, ph_attn(cx, LAYER, sm, 256, 16)); SUBSET(144, 16, ph_hypre(cx, LAYER, sm, 2048, 128)); } } SEAM(B + 2);
    if (IN(B + 3)) { RUN(3, ph_hyfft(cx, LAYER, sm, !(REPN(3) == 1 || rep_ == 1))); __syncthreads(); RUN(31, ph_hyconv_ctx(cx, LAYER, sm)); __syncthreads(); RUN(30, ph_s5out(cx, LAYER, sm)); } SEAM(B + 3);
    if (IN(B + 4)) { RUN(4, ph_glu(cx, LAYER, lds)); __syncthreads(); RUN(40, ph_hypost(cx, LAYER, sm)); } SEAM(B + 4);
    if (IN(B + 5)) { RUN(5, ph_merge(cx, LAYER, lds)); if (LAYER == 0) { __syncthreads(); SIDE(16, ph_filters(cx, 1, sm)); SIDE(16, ph_convert(cx, 1)); } } SEAM(B + 5);
    if (IN(B + 6)) { RUN(6, ph_outproj(cx, LAYER, lds, 1.f / REPN(6))); if (LAYER == 0) { SIDE(16, ph_peerconv(cx, 0)); } } SEAM(B + 6);
    if (IN(B + 7)) { RUN(7, ph_norm(cx, LAYER, 1, LAYER == DEPTH - 1)); if (LAYER + 1 < DEPTH) { RUN(70, ph_s5tables(cx, LAYER + 1, sm)); } if (LAYER != 0) { RUN(71, ph_peerconv(cx, LAYER)); } } SEAM(B + 7);
    if (IN(B + 8)) { RUN(8, ph_qp(cx, LAYER, lds)); } SEAM(B + 8);
    if (IN(B + 9)) { RUN(9, ph_select(cx, LAYER)); } SEAM(B + 9);
    if (IN(B + 10)) { RUN(10, ph_peer_u(cx, LAYER)); } SEAM(B + 10);
    if (IN(B + 11)) { RUN(13, ph_peer_w(cx, LAYER)); } SEAM(B + 11);
    if (IN(B + 12)) { RUN(11, ph_peer_v(cx, LAYER, 1.f / REPN(11))); } SEAM(B + 12);
    if (IN(B + 13)) { RUN(12, ph_peer_fin(cx, LAYER)); } SEAM(B + 13);
}
__global__ void __launch_bounds__(NTHREADS, 2) mk_fwd(Params p) {
    extern __shared__ __attribute__((aligned(16))) unsigned char lds_raw[];
    float* sm = (float*)lds_raw; PG8_LAS unsigned char* lds = (PG8_LAS unsigned char*)lds_raw;
    volatile LAS unsigned* st = (volatile LAS unsigned*)(lds + LDS_MISC);
    if (threadIdx.x < 4) st[threadIdx.x] = 0u;
    __syncthreads();
    const int lo = p.ph_lo, hi = p.ph_hi;
    if (hi - lo > 1) (void)xcd_barrier_post((unsigned*)(p.ws + WS_CTL) + 4096, st);
    if (IN(0)) { RUN(100, ph_prologue(cx, sm)); RUN(101, ph_convert(cx, 0)); __syncthreads(); RUN(102, ph_s5tables(cx, 0, sm)); } SEAM(0);
    layer_program<0>(lo, hi, sm, lds, st);
    layer_program<1>(lo, hi, sm, lds, st);
}
}

extern "C" void kernel_launch(void* const* d_in, const int* in_sizes, int n_in, void* d_out, int out_size, void* d_ws, size_t ws_size, hipStream_t stream) {
    static int grid = 0;
    if (grid == 0) {
        if (n_in != 40 || out_size != TL * DM || ws_size < WS_END) { fprintf(stderr, "kernel_launch: unexpected shapes (n_in %d out %d ws %zu)\n", n_in, out_size, ws_size); grid = -1; return; }
        int dev = 0, cus = 0;
        if (hipGetDevice(&dev) != hipSuccess || hipDeviceGetAttribute(&cus, hipDeviceAttributeMultiprocessorCount, dev) != hipSuccess) { grid = -1; return; }
        if (hipFuncSetAttribute((const void*)mk_fwd, hipFuncAttributeMaxDynamicSharedMemorySize, LDS_BYTES) != hipSuccess) { fprintf(stderr, "kernel_launch: hipFuncSetAttribute failed\n"); grid = -1; return; }
        if (cus < 256) { fprintf(stderr, "kernel_launch: needs 256 compute units (one resident workgroup each), found %d\n", cus); grid = -1; return; }
        grid = 256;
    }
    if (grid < 0) return;
    (void)hipMemsetAsync((char*)d_ws + WS_CTL, 0, 1 * MiB, stream);
    Params a{};
    for (int i = 0; i < 40; ++i) a.in[i] = (const float*)d_in[i];
    a.out = (float*)d_out; a.ws = (unsigned char*)d_ws;
#if PER_PHASE_LAUNCH
    for (int ph = 0; ph < NPHASE; ++ph) { a.ph_lo = ph; a.ph_hi = ph + 1; hipLaunchKernelGGL(mk_fwd, dim3(grid), dim3(NTHREADS), LDS_BYTES, stream, a); }
#else
    a.ph_lo = 0; a.ph_hi = NPHASE; hipLaunchKernelGGL(mk_fwd, dim3(grid), dim3(NTHREADS), LDS_BYTES, stream, a);
#endif
}
```

```cpp
#include <hip/hip_runtime.h>
#include <stdint.h>
#include <math.h>
#include <stdio.h>

#ifndef PER_PHASE_LAUNCH
#define PER_PHASE_LAUNCH 0
#endif

#ifndef PROBE_HAS
#define PROBE_HAS(n) false
#endif
namespace {
typedef unsigned short bf16;
typedef float f32x4 __attribute__((ext_vector_type(4)));
typedef unsigned u32x2 __attribute__((ext_vector_type(2)));
typedef unsigned u32x4 __attribute__((ext_vector_type(4)));
typedef short bf16x8 __attribute__((ext_vector_type(8)));
typedef float f32x16 __attribute__((ext_vector_type(16)));
#define LAS __attribute__((address_space(3)))

constexpr int DM = 1024, NBATCH = 4, SEQ = 4096, CTXL = 256, DEPTH = 2;
constexpr int TL = NBATCH * SEQ, TC = NBATCH * CTXL, TA = TL + TC;
constexpr int INW = 5888, COL_K = 512, COL_V = 640, COL_S5 = 768, COL_HY = 1280, COL_GATE = 2816;
constexpr int NTHREADS = 512, NWAVES = 8;
constexpr float NORM_EPS = 1e-6f;
constexpr float HY_FAST = 15.350567286626973f, HY_SLOW = 3.0701134573253945f;

constexpr size_t MiB = 1u << 20;
constexpr size_t WS_CTL = 0;
constexpr size_t WS_XCUR = 1 * MiB;
constexpr size_t WS_MODV = 69 * MiB;
constexpr size_t WS_ROPE = WS_MODV + 512 * 1024;
constexpr size_t WS_S5A = 70 * MiB;
constexpr size_t WS_S5B = 70 * MiB + 256 * 1024;
constexpr size_t WS_FILT = 72 * MiB;
constexpr size_t FILT_CTX_OFF = 16 * MiB;
constexpr size_t WS_WTS = 89 * MiB;
constexpr size_t WT_IN = WS_WTS;
constexpr size_t WT_GLU = WT_IN + 23 * MiB;
constexpr size_t WT_BR = WT_GLU + 1 * MiB;
constexpr size_t WT_OUT = WT_BR + 6 * MiB;
constexpr size_t WT_WQ = WT_OUT + 4 * MiB;
constexpr size_t WT_KEYS = WT_WQ + 8 * MiB;
constexpr size_t WS_H = 132 * MiB;
constexpr size_t WS_VV = WS_H;
constexpr size_t WS_VVC = WS_H + 32 * MiB;
constexpr size_t WS_Q = 166 * MiB;
constexpr size_t WS_K = 183 * MiB;
constexpr size_t WS_V = WS_K + (size_t)TA * 128 * 2;
constexpr size_t WS_U = WS_V + (size_t)TA * 128 * 2;
constexpr size_t WS_Z = WS_U + (size_t)TA * 512 * 2;
constexpr size_t WS_QP = WS_Q;
constexpr size_t WS_G = 260 * MiB;
constexpr size_t WS_ATT = 362 * MiB;
constexpr size_t WS_HY = WS_ATT + 17 * MiB, WS_S5O = WS_HY + 17 * MiB, WS_S5Y = WS_S5O + 17 * MiB;
constexpr size_t WS_M = 430 * MiB;
constexpr size_t WS_S5TMP = WS_M;
constexpr size_t WS_S5E = WS_M;
constexpr size_t WS_S5P = WS_M + 16 * MiB;
constexpr size_t WS_S5K = WS_M + 32 * MiB;
constexpr size_t WS_S5A64 = WS_S5A + 64 * 1024;
constexpr size_t WS_S5C = WS_S5A + 128 * 1024;
constexpr size_t WS_X0C = 464 * MiB;
constexpr size_t WS_EID = 481 * MiB;
constexpr size_t WS_EG = WS_EID + (size_t)TA * 128 * 4;
constexpr size_t WS_PU = WS_G;
constexpr size_t WS_PV = WS_G + 16 * MiB;
constexpr float PEER_SU = 512.f, PEER_SV = 64.f;
constexpr size_t WS_PART = WS_QP;
constexpr size_t WS_POUT = WS_ATT;
constexpr size_t WS_HIN = WS_EID;
constexpr size_t WS_END = 498 * MiB;
constexpr int LDS_STAGE = 131072;
constexpr int LDS_MISC = 143360;
constexpr int LDS_BYTES = 147456;

struct Params {
    const float* in[40];
    float* out;
    unsigned char* ws;
    int ph_lo, ph_hi;
};
enum { I_X = 0, I_C, I_CTX, I_CCTX, I_MODW, I_MODB, I_N1G, I_N2G, I_INW, I_GATEB, I_SINK, I_HSW, I_HSB, I_HW1, I_HB1, I_HF1, I_HW2, I_HB2, I_HF2, I_HW3,
       I_HBIAS, I_SARE, I_SAIM, I_SLDT, I_SBRE, I_SBIM, I_SCRE, I_SCIM, I_SD, I_GLUW, I_GLUB, I_BRA, I_BRH, I_BRS, I_OUTW, I_WQ, I_PKEYS, I_PU, I_PV, I_FG };

struct Ctx { int tid, bid, nb; };
typedef __attribute__((address_space(4))) const Params CParams;
__device__ __forceinline__ CParams& get_params() { CParams* q = (CParams*)__builtin_amdgcn_kernarg_segment_ptr(); asm volatile("" : "+s"(q)); return *q; }
__device__ __forceinline__ float bf2f(bf16 v) { return __uint_as_float((unsigned)v << 16); }
typedef float f32x2_ __attribute__((ext_vector_type(2))); typedef __bf16 bf16x2_ __attribute__((ext_vector_type(2)));
__device__ __forceinline__ unsigned pk2(float lo, float hi) { const f32x2_ v = {lo, hi}; return __builtin_bit_cast(unsigned, __builtin_convertvector(v, bf16x2_)); }
__device__ __forceinline__ bf16 f2bf(float f) { return (bf16)(pk2(f, 0.f) & 0xffffu); }
__device__ __forceinline__ float wave_sum(float v) {
#pragma unroll
    for (int o = 32; o > 0; o >>= 1) v += __shfl_xor(v, o);
    return v;
}
__device__ __forceinline__ float fsin_rev(float rev) { return __builtin_amdgcn_sinf(rev); }
__device__ __forceinline__ float fcos_rev(float rev) { return __builtin_amdgcn_cosf(rev); }
__device__ __forceinline__ float fsin(float x) { return __builtin_amdgcn_sinf(x * 0.15915494309189535f); }
__device__ __forceinline__ float fcos(float x) { return __builtin_amdgcn_cosf(x * 0.15915494309189535f); }
typedef unsigned u32x2v __attribute__((ext_vector_type(2)));
__device__ __forceinline__ float max_x16(float v) { const auto r = __builtin_amdgcn_permlane16_swap(__float_as_uint(v), __float_as_uint(v), false, false); return fmaxf(__uint_as_float(r[0]), __uint_as_float(r[1])); }
__device__ __forceinline__ float max_x32(float v) { const auto r = __builtin_amdgcn_permlane32_swap(__float_as_uint(v), __float_as_uint(v), false, false); return fmaxf(__uint_as_float(r[0]), __uint_as_float(r[1])); }
__device__ __forceinline__ float sum_x16(float v) { const auto r = __builtin_amdgcn_permlane16_swap(__float_as_uint(v), __float_as_uint(v), false, false); return __uint_as_float(r[0]) + __uint_as_float(r[1]); }
__device__ __forceinline__ float sum_x32(float v) { const auto r = __builtin_amdgcn_permlane32_swap(__float_as_uint(v), __float_as_uint(v), false, false); return __uint_as_float(r[0]) + __uint_as_float(r[1]); }
__device__ __forceinline__ unsigned get_x16(unsigned v, int lane) { const auto r = __builtin_amdgcn_permlane16_swap(v, v, false, false); return (lane & 16) ? r[0] : r[1]; }
__device__ __forceinline__ unsigned get_x32(unsigned v, int lane) { const auto r = __builtin_amdgcn_permlane32_swap(v, v, false, false); return (lane & 32) ? r[0] : r[1]; }
__device__ __forceinline__ float sigmoidf_(float x) { return 1.f / (1.f + __expf(-x)); }
__device__ __forceinline__ float gelu_tanh(float x) { const float u = 0.7978845608028654f * (x + 0.044715f * x * x * x); const float e = __expf(2.f * u); return 0.5f * x * (2.f - 2.f / (e + 1.f)); }
__device__ __forceinline__ int row_mi(int r) { return r < TL ? (r >> 12) : 4; }
__device__ __forceinline__ int row_b(int r) { return r < TL ? (r >> 12) : ((r - TL) >> 8); }

#define XB_TMO      128
#define XB_XCNT(j)  (256  + 64 * (j))
#define XB_XSUB(j)  (1280 + 64 * (j))
#define XB_XGEN(j)  (2304 + 64 * (j))
#define XB_TOP      3328
#define XB_TOPGEN   3392
#define XCD_BAR_WORDS 3456
#define XB_SPIN_CAP (1u << 27)
__device__ __forceinline__ unsigned xb_ld(unsigned* p)              { return __hip_atomic_load(p, __ATOMIC_RELAXED, __HIP_MEMORY_SCOPE_AGENT); }
__device__ __forceinline__ unsigned xb_add(unsigned* p, unsigned v) { return __hip_atomic_fetch_add(p, v, __ATOMIC_RELAXED, __HIP_MEMORY_SCOPE_AGENT); }
__device__ __forceinline__ unsigned xb_xcc_id() { return (unsigned)__builtin_amdgcn_s_getreg((3 << 11) | 20) & 0xFu; }
#define XB_SPIN(cond, bar) do { unsigned _sp = 0; while (cond) { __builtin_amdgcn_s_sleep(1); \
    if ((++_sp & 255u) == 0u) { if (xb_ld(&(bar)[XB_TMO])) break; if (_sp > XB_SPIN_CAP) { atomicAdd(&(bar)[XB_TMO], 1u); break; } } } } while (0)
struct XcdBarrier { unsigned* bar; unsigned x; volatile LAS unsigned* st; };
__device__ __forceinline__ XcdBarrier xcd_barrier_post(unsigned* bar, volatile LAS unsigned* st) {
    XcdBarrier b; b.bar = bar; b.x = xb_xcc_id(); b.st = st;
    if (threadIdx.x == 0) (void)xb_add(&bar[XB_XCNT(b.x)], 1u);
    return b;
}
__device__ __forceinline__ void xcd_barrier_complete(unsigned* bar, unsigned x, unsigned& nloc, unsigned& nx) {
    const unsigned G = gridDim.x * gridDim.y * gridDim.z;
    unsigned sum, cnt, mine, sp = 0u;
    for (;;) {
        sum = 0u; cnt = 0u; mine = 0u;
#pragma unroll
        for (unsigned j = 0; j < 16; ++j) { const unsigned c = xb_ld(&bar[XB_XCNT(j)]); sum += c; cnt += (c > 0u) ? 1u : 0u; mine = (j == x) ? c : mine; }
        if (sum == G) break;
        __builtin_amdgcn_s_sleep(1);
        if ((++sp & 255u) == 0u) { if (xb_ld(&bar[XB_TMO])) break; if (sp > XB_SPIN_CAP) { atomicAdd(&bar[XB_TMO], 1u); break; } }
    }
    nloc = mine > 0u ? mine : 1u; nx = cnt > 0u ? cnt : 1u;
}
__device__ __forceinline__ void xcd_barrier(const XcdBarrier& b) {
    asm volatile("s_waitcnt vmcnt(0)" ::: "memory");
    __syncthreads();
    if (threadIdx.x == 0) {
        unsigned* bar = b.bar; asm volatile("" : "+s"(bar));
        __builtin_amdgcn_s_waitcnt(0);
        unsigned nloc = b.st[0], nx = b.st[1];
        if (nloc == 0u) { xcd_barrier_complete(bar, b.x, nloc, nx); b.st[0] = nloc; b.st[1] = nx; }
        const unsigned old = xb_add(&bar[XB_XSUB(b.x)], 1u);
        const unsigned gen = old / nloc;
        if (old + 1u == (gen + 1u) * nloc) {
            __builtin_amdgcn_fence(__ATOMIC_RELEASE, "agent");
            asm volatile("s_waitcnt vmcnt(0)" ::: "memory");
            const unsigned og = xb_add(&bar[XB_TOP], 1u);
            const unsigned tg = og / nx;
            if (og + 1u == (tg + 1u) * nx) xb_add(&bar[XB_TOPGEN], 1u);
            else XB_SPIN(xb_ld(&bar[XB_TOPGEN]) == tg, bar);
            __builtin_amdgcn_fence(__ATOMIC_ACQUIRE, "agent");
            xb_add(&bar[XB_XGEN(b.x)], 1u);
            asm volatile("s_waitcnt vmcnt(0)" ::: "memory");
        } else {
            XB_SPIN(xb_ld(&bar[XB_XGEN(b.x)]) == gen, bar);
            __builtin_amdgcn_fence(__ATOMIC_ACQUIRE, "agent");
            asm volatile("s_waitcnt vmcnt(0)" ::: "memory");
        }
    }
    __syncthreads();
}

__device__ __forceinline__ void ph_prologue(const Ctx& cx0, float* sm) {
    { CParams& p = get_params(); Ctx cx = cx0;
    const int tid = cx.tid, lane = tid & 63, wave = tid >> 6;
    const int gt = cx.bid * NTHREADS + tid, NGT = cx.nb * NTHREADS;
    const int gw = cx.bid * NWAVES + wave, NGW = cx.nb * NWAVES;
    unsigned char* ws = p.ws;
    }
    { CParams& p = get_params(); Ctx cx; cx.tid = threadIdx.x; cx.bid = blockIdx.x; cx.nb = gridDim.x; asm volatile("" : "+v"(cx.tid), "+s"(cx.bid), "+s"(cx.nb));
      const int tid = cx.tid, lane = tid & 63, wave = tid >> 6; const int gt = cx.bid * NTHREADS + tid, NGT = cx.nb * NTHREADS; const int gw = cx.bid * NWAVES + wave, NGW = cx.nb * NWAVES; unsigned char* ws = p.ws; (void)lane; (void)gt; (void)NGT; (void)gw; (void)NGW; (void)ws;
    {
        float* sil = sm;
        float* red = sm + 5 * 1024;
        bool have = false;
        for (int it = cx.bid; it < 192; it += cx.nb) {
            if (!have) {
                for (int i = tid; i < 5 * 1024; i += NTHREADS) { const float v = i < 4096 ? p.in[I_C][i] : p.in[I_CCTX][i - 4096]; sil[i] = v / (1.f + __expf(-v)); }
                have = true; __syncthreads();
            }
            const int layer = it / 96, col = (it % 96) * 64 + lane, kp = wave;
            const float* W = p.in[I_MODW] + (size_t)layer * DM * 6144 + col;
            float a0 = 0, a1 = 0, a2 = 0, a3 = 0, a4 = 0;
#pragma unroll 1
            for (int k0 = kp * 128; k0 < kp * 128 + 128; k0 += 16) { float w[16];
#pragma unroll
                for (int q = 0; q < 16; ++q) w[q] = W[(size_t)(k0 + q) * 6144];
#pragma unroll
                for (int q = 0; q < 16; ++q) { const int k = k0 + q; a0 += sil[k] * w[q]; a1 += sil[1024 + k] * w[q]; a2 += sil[2048 + k] * w[q]; a3 += sil[3072 + k] * w[q]; a4 += sil[4096 + k] * w[q]; } }
            red[(kp * 5 + 0) * 64 + lane] = a0; red[(kp * 5 + 1) * 64 + lane] = a1; red[(kp * 5 + 2) * 64 + lane] = a2; red[(kp * 5 + 3) * 64 + lane] = a3; red[(kp * 5 + 4) * 64 + lane] = a4;
            __syncthreads();
            if (tid < 320) { const int j = tid >> 6; float s = 0; for (int q = 0; q < 8; ++q) s += red[(q * 5 + j) * 64 + lane];
                ((float*)(ws + WS_MODV))[((size_t)layer * 5 + j) * 6144 + col] = s + p.in[I_MODB][layer * 6144 + col]; }
            __syncthreads();
        }
    }
    }
    { CParams& p = get_params(); Ctx cx; cx.tid = threadIdx.x; cx.bid = blockIdx.x; cx.nb = gridDim.x; asm volatile("" : "+v"(cx.tid), "+s"(cx.bid), "+s"(cx.nb));
      const int tid = cx.tid, lane = tid & 63, wave = tid >> 6; const int gt = cx.bid * NTHREADS + tid, NGT = cx.nb * NTHREADS; const int gw = cx.bid * NWAVES + wave, NGW = cx.nb * NWAVES; unsigned char* ws = p.ws; (void)lane; (void)gt; (void)NGT; (void)gw; (void)NGW; (void)ws;
    for (int i = gt; i < 64 * 16; i += NGT) { const int pos = i >> 4, f = i & 15; const float ang = (float)pos * exp2f(-(float)f * (13.287712379549449f / 16.f));
        ((float*)(ws + WS_ROPE))[i * 2] = fcos(ang); ((float*)(ws + WS_ROPE))[i * 2 + 1] = fsin(ang); }
    }
}


__device__ __forceinline__ void ph_filters(const Ctx& cx, int layer, float* sm) {
    CParams& p = get_params();
    const int tid = cx.tid, lane = tid & 63, wave = __builtin_amdgcn_readfirstlane(tid >> 6), l15 = lane & 15, kg = lane >> 4;
    bf16* Hb = (bf16*)sm;
    float* W12 = sm + 64 * 72 / 2;
    const float* w1 = p.in[I_HW1] + layer * 33 * 64; const float* w2 = p.in[I_HW2] + layer * 64 * 64; const float* w3 = p.in[I_HW3] + layer * 64 * 1024;
    for (int it = cx.bid; it < 2 * 68; it += cx.nb) {
        const int tile = it >> 1, ch = it & 1, st = tile >= 64 ? 1 : 0, tb = st ? (tile - 64) * 64 : tile * 64, L = st ? CTXL : SEQ;
        __syncthreads();
        for (int i = tid; i < 97 * 64; i += NTHREADS) W12[i] = i < 33 * 64 ? w1[i] : w2[i - 33 * 64];
        bf16x8 bw[4][2];
#pragma unroll
        for (int nt = 0; nt < 4; ++nt)
#pragma unroll
            for (int ks = 0; ks < 2; ++ks) { const float* s = w3 + (size_t)(32 * ks + 8 * kg) * 1024 + ch * 512 + wave * 64 + 16 * nt + l15;
                u32x4 w; w.x = pk2(s[0], s[1024]); w.y = pk2(s[2048], s[3072]); w.z = pk2(s[4096], s[5120]); w.w = pk2(s[6144], s[7168]); bw[nt][ks] = __builtin_bit_cast(bf16x8, w); }
        __syncthreads();
        {
            float z[8], a[8], h1[8], a2[8];
            const float b1 = p.in[I_HB1][layer * 64 + lane], f1 = p.in[I_HF1][layer * 64 + lane], b2 = p.in[I_HB2][layer * 64 + lane], f2 = p.in[I_HF2][layer * 64 + lane];
#pragma unroll
            for (int q = 0; q < 8; ++q) { const float tn = (float)(tb + wave + 8 * q) / (float)L; z[q] = 0.f;
                if (lane == 0) z[q] = tn; else if (lane <= 16) z[q] = fcos_rev(tn * (float)lane); else if (lane <= 32) z[q] = fsin_rev(tn * (float)(lane - 16)); a[q] = b1; }
#pragma unroll 3
            for (int e = 0; e < 33; ++e) { const float w = W12[e * 64 + lane];
#pragma unroll
                for (int q = 0; q < 8; ++q) a[q] += __shfl(z[q], e) * w; }
#pragma unroll
            for (int q = 0; q < 8; ++q) { h1[q] = fsin(f1 * a[q]); a2[q] = b2; }
#pragma unroll 4
            for (int j = 0; j < 64; ++j) { const float w = W12[33 * 64 + j * 64 + lane];
#pragma unroll
                for (int q = 0; q < 8; ++q) a2[q] += __shfl(h1[q], j) * w; }
#pragma unroll
            for (int q = 0; q < 8; ++q) Hb[(wave + 8 * q) * 72 + lane] = f2bf(fsin(f2 * a2[q]));
        }
        __syncthreads();
        float* fbase = (float*)(p.ws + WS_FILT + (st ? FILT_CTX_OFF : 0));
#pragma unroll
        for (int mt = 0; mt < 4; ++mt) {
            bf16x8 af[2];
#pragma unroll
            for (int ks = 0; ks < 2; ++ks) af[ks] = *(const bf16x8*)(Hb + (16 * mt + l15) * 72 + 32 * ks + 8 * kg);
            const int t0 = tb + 16 * mt + 4 * kg;
            f32x4 tw;
#pragma unroll
            for (int r = 0; r < 4; ++r) tw[r] = (float)(t0 + r) / (float)(L - 1);
#pragma unroll
            for (int nt = 0; nt < 4; ++nt) {
                f32x4 acc = (f32x4){0.f, 0.f, 0.f, 0.f};
                acc = __builtin_amdgcn_mfma_f32_16x16x32_bf16(af[0], bw[nt][0], acc, 0, 0, 0); acc = __builtin_amdgcn_mfma_f32_16x16x32_bf16(af[1], bw[nt][1], acc, 0, 0, 0);
                const int c = wave * 64 + 16 * nt + l15;
                const float rate = HY_FAST + (HY_SLOW - HY_FAST) * ((float)c / 511.f);
                f32x4 o;
#pragma unroll
                for (int r = 0; r < 4; ++r) o[r] = acc[r] * __expf(-tw[r] * rate);
                *(f32x4*)(fbase + ((size_t)ch * 512 + c) * L + t0) = o;
            }
        }
    }
}
__device__ __forceinline__ void conv_T(const Ctx& cx, const float* W, int K, int N, bf16* dst, bool perm) {
    const int gt = cx.bid * NTHREADS + cx.tid, NGT = cx.nb * NTHREADS;
    for (int it = gt; it < N * (K / 8); it += NGT) {
        const int n = it % N, k0 = (it / N) * 8;
        const int sn = (perm && n < COL_V) ? ((n & ~63) + ((n & 63) >> 1) + 32 * (n & 1)) : n;
        const float* s = W + (size_t)k0 * N + sn;
        u32x4 w; w.x = pk2(s[0], s[N]); w.y = pk2(s[2 * (size_t)N], s[3 * (size_t)N]); w.z = pk2(s[4 * (size_t)N], s[5 * (size_t)N]); w.w = pk2(s[6 * (size_t)N], s[7 * (size_t)N]);
        *(u32x4*)(dst + (size_t)n * K + k0) = w;
    }
}
__device__ __forceinline__ void ph_convert(const Ctx& cx0, int layer) {
#define RELAUNDER() CParams& p = get_params(); Ctx cx; cx.tid = threadIdx.x; cx.bid = __builtin_amdgcn_readfirstlane(cx0.bid); cx.nb = __builtin_amdgcn_readfirstlane(cx0.nb); asm volatile("" : "+v"(cx.tid), "+s"(cx.bid), "+s"(cx.nb));
    { RELAUNDER(); conv_T(cx, p.in[I_INW] + (size_t)layer * DM * INW, DM, INW, (bf16*)(p.ws + WT_IN) + (size_t)layer * INW * DM, true); }
    { RELAUNDER(); conv_T(cx, p.in[I_GLUW] + (size_t)layer * 512 * 512, 512, 512, (bf16*)(p.ws + WT_GLU) + (size_t)layer * 512 * 512, false); }
    { RELAUNDER(); conv_T(cx, p.in[I_BRA] + (size_t)layer * 512 * 1024, 512, 1024, (bf16*)(p.ws + WT_BR) + (size_t)(layer * 3 + 0) * 1024 * 512, false); }
    { RELAUNDER(); conv_T(cx, p.in[I_BRH] + (size_t)layer * 512 * 1024, 512, 1024, (bf16*)(p.ws + WT_BR) + (size_t)(layer * 3 + 1) * 1024 * 512, false); }
    { RELAUNDER(); conv_T(cx, p.in[I_BRS] + (size_t)layer * 512 * 1024, 512, 1024, (bf16*)(p.ws + WT_BR) + (size_t)(layer * 3 + 2) * 1024 * 512, false); }
    { RELAUNDER(); conv_T(cx, p.in[I_OUTW] + (size_t)layer * 1024 * 1024, 1024, 1024, (bf16*)(p.ws + WT_OUT) + (size_t)layer * 1024 * 1024, false); }
    { RELAUNDER(); conv_T(cx, p.in[I_WQ] + (size_t)layer * 1024 * 2048, 1024, 2048, (bf16*)(p.ws + WT_WQ) + (size_t)layer * 2048 * 1024, false); }
    if (layer == 0) { RELAUNDER(); const int gt = cx.bid * NTHREADS + cx.tid, NGT = cx.nb * NTHREADS;
      for (int i = gt; i < 2 * 8 * 2 * 128 * 128 / 4; i += NGT) { const f32x4 v = ((const f32x4*)p.in[I_PKEYS])[i]; u32x2 w; w.x = pk2(v[0], v[1]); w.y = pk2(v[2], v[3]);
          const int k4 = i & 31, n = (i >> 5) & 127, lhs = i >> 12;
          ((u32x2*)(p.ws + WT_KEYS))[(((size_t)lhs * 8 + (k4 >> 2)) * 128 + n) * 4 + (k4 & 3)] = w; } }
#undef RELAUNDER
}

__device__ __forceinline__ void ph_norm(const Ctx& cx, int layer, int which, int nrows_lat_only) {
    CParams& p = get_params();
    const int lane = cx.tid & 63, wave = cx.tid >> 6;
    const int gw = cx.bid * NWAVES + wave, NGW = cx.nb * NWAVES;
    const float* g = p.in[which ? I_N2G : I_N1G] + layer * DM;
    const float* xc = (const float*)(p.ws + WS_XCUR);
    bf16* H = (bf16*)(p.ws + WS_H);
    const int nrows = nrows_lat_only ? TL : TA;
    for (int r = gw; r < nrows; r += NGW) {
        const float* mv = (const float*)(p.ws + WS_MODV) + ((size_t)layer * 5 + row_mi(r)) * 6144 + (which ? 3072 : 0);
        f32x4 v[4]; float s = 0.f;
        const float* xr = (which == 0 && layer == 0) ? (r < TL ? p.in[I_X] + (size_t)r * DM : p.in[I_CTX] + (size_t)(r - TL) * DM) : xc + (size_t)r * DM;
#pragma unroll
        for (int j = 0; j < 4; ++j) { v[j] = *(const f32x4*)(xr + j * 256 + lane * 4); s += v[j].x * v[j].x + v[j].y * v[j].y + v[j].z * v[j].z + v[j].w * v[j].w; }
        const float rs = rsqrtf(wave_sum(s) * (1.f / DM) + NORM_EPS);
#pragma unroll
        for (int j = 0; j < 4; ++j) { const int c = j * 256 + lane * 4;
            const f32x4 gg = *(const f32x4*)(g + c), sh = *(const f32x4*)(mv + c), sc = *(const f32x4*)(mv + 1024 + c);
            const f32x4 y = v[j] * rs * gg; const f32x4 h = y * (1.f + sc) + sh;
            u32x2 w; w.x = pk2(h.x, h.y); w.y = pk2(h.z, h.w); *(u32x2*)(H + (size_t)r * DM + c) = w; }
    }
}


namespace pg8 {
#define PG8_LAS __attribute__((address_space(3)))
typedef unsigned short bf16_t;
typedef short bf16x8 __attribute__((ext_vector_type(8)));
constexpr int BM = 256, BK = 64, HALF = 128, HTB = HALF * BK * 2, STAGE_BYTES = 8 * HTB, NXCD = 8, WGM = 8;
__host__ __device__ __forceinline__ int lds_byte(int r, int c) { const int st = (r >> 4) * 2 + (c >> 5), rr = r & 15, cc = c & 31, ob = rr * 64 + cc * 2; return st * 1024 + (ob ^ (((ob >> 9) & 1) << 5)); }
__host__ __device__ __forceinline__ void stage_rc(int b, int& R, int& C) { const int st = b / 1024, sb = b % 1024, swz = sb ^ (((sb >> 9) & 1) << 5); R = (st >> 1) * 16 + swz / 64; C = (st & 1) * 32 + (swz % 64) / 2; }
__host__ __device__ __forceinline__ int perm32(int rho) { const int n = rho >> 4, i = rho & 15; return 8 * (i >> 2) + 4 * n + (i & 3); }
struct Unit { int pm, pn, z; };
struct Gemm { const bf16_t* A; const bf16_t* Bt; size_t zsA, zsB; int K; };
__device__ __forceinline__ const bf16_t* selA(const Gemm& g, int z) { return g.A + (size_t)z * g.zsA; }
__device__ __forceinline__ const bf16_t* selB(const Gemm& g, int z) { return g.Bt + (size_t)z * g.zsB; }
struct TileOrder {
    int nM, nN, nwg, G, c, extra, exN, expn0, nz;
    __device__ __forceinline__ bool next(int i, Unit& u) const {
        const int ti = i / nz; u.z = i - ti * nz;
        const long L = (long)ti * G + c;
        if (L < nwg) {
            int wgid = (int)L; { const int q = nwg / NXCD, r = nwg % NXCD, xcd = wgid % NXCD, off = wgid / NXCD; wgid = (xcd < r ? xcd * (q + 1) : r * (q + 1) + (xcd - r) * q) + off; }
            const int nig = WGM * nN, gid = wgid / nig, fm = gid * WGM, gsz = (nM - fm) < WGM ? (nM - fm) : WGM;
            u.pm = fm + ((wgid % nig) % gsz); u.pn = (wgid % nig) / gsz; return true;
        }
        const int e = (int)(L - nwg); if (e >= extra) return false;
        u.pm = nM + e / exN; u.pn = expn0 + e % exN; return true;
    }
};
__device__ __forceinline__ unsigned cvt_pk_bf16(float lo, float hi) { unsigned r; asm volatile("v_cvt_pk_bf16_f32 %0, %1, %2" : "=v"(r) : "v"(lo), "v"(hi)); return r; }
template <class Epi, class Sched, bool ALIGN_EPI = true, bool SP2 = true>
__device__ __forceinline__ void gemm_phase(PG8_LAS unsigned char* lds, const Gemm g, const Sched& S, const Epi& E, const int tid_) {
    const int tid = tid_, wid = __builtin_amdgcn_readfirstlane(tid >> 6), lane = tid & 63, wr = wid >> 2, wc = wid & 3, fr = lane & 15, fq = lane >> 4;
    const int K = g.K, nt = K / BK;
    unsigned voffA[2], voffB[2];
#pragma unroll
    for (int i = 0; i < 2; ++i) { int R, C; stage_rc(tid * 16 + i * 8192, R, C); const int Rb = Epi::PERM ? ((R & ~31) + perm32(R & 31)) : R;
        voffA[i] = (unsigned)(R * K + C) * 2u; voffB[i] = (unsigned)(Rb * K + C) * 2u; }
    const size_t kstep = (size_t)(BK * 2);
    const size_t hstep = (size_t)HALF * K * 2;
    const size_t tstep = 2 * hstep;
    const unsigned ldsw = (unsigned)wid * 1024u;
    const int aoff = lds_byte(wr * 64 + fr, fq * 8), boff = lds_byte(wc * 32 + fr, fq * 8);
#define PG8_SA(b, h) (((b) * 2 + (h)) * HTB)
#define PG8_SB(b, h) ((4 + (b) * 2 + (h)) * HTB)
#define PG8_STAGE(bufoff, gbase, voff) do { _Pragma("unroll") for (int _i = 0; _i < 2; ++_i) \
        __builtin_amdgcn_global_load_lds((const unsigned*)((const char*)(gbase) + (voff)[_i]), (PG8_LAS unsigned*)(lds + (bufoff) + ldsw + _i * 8192), 16, 0, 0); } while (0)
#define PG8_LDA(dst, b, h) do { _Pragma("unroll") for (int m = 0; m < 4; ++m) _Pragma("unroll") for (int k = 0; k < 2; ++k) dst[m][k] = *(const PG8_LAS bf16x8*)(lds + PG8_SA(b, h) + aoff + m * 2048 + k * 1024); } while (0)
#define PG8_LDB(dst, b, h) do { _Pragma("unroll") for (int n = 0; n < 2; ++n) _Pragma("unroll") for (int k = 0; k < 2; ++k) dst[n][k] = *(const PG8_LAS bf16x8*)(lds + PG8_SB(b, h) + boff + n * 2048 + k * 1024); } while (0)
#define PG8_MMA(ai, bj, At, Bt) do { __builtin_amdgcn_s_setprio(1); _Pragma("unroll") for (int m = 0; m < 4; ++m) _Pragma("unroll") for (int n = 0; n < 2; ++n) _Pragma("unroll") for (int k = 0; k < 2; ++k) \
        acc[ai][bj][m][n] = __builtin_amdgcn_mfma_f32_16x16x32_bf16(Bt[n][k], At[m][k], acc[ai][bj][m][n], 0, 0, 0); __builtin_amdgcn_s_setprio(0); } while (0)
#define PG8_WAIT_V(n) asm volatile("s_waitcnt vmcnt(" #n ")" ::: "memory")
#define PG8_WAIT_L(n) asm volatile("s_waitcnt lgkmcnt(" #n ")" ::: "memory")
#define PG8_BAR __builtin_amdgcn_s_barrier()
#define PG8_SCHED __builtin_amdgcn_sched_barrier(0)
    Unit cur, nxt; int ui = 0;
    if (!S.next(0, cur)) return;
    f32x4 acc[2][2][4][2];
#pragma unroll
    for (int a = 0; a < 2; ++a)
#pragma unroll
        for (int b = 0; b < 2; ++b)
#pragma unroll
            for (int m = 0; m < 4; ++m)
#pragma unroll
                for (int n = 0; n < 2; ++n) acc[a][b][m][n] = (f32x4){0.f, 0.f, 0.f, 0.f};
    bf16x8 At[4][2], B0[2][2], B1[2][2];
    const char* cA = (const char*)selA(g, cur.z) + (size_t)cur.pm * tstep; const char* cB = (const char*)selB(g, cur.z) + (size_t)cur.pn * tstep;
    if constexpr (SP2) {
        PG8_STAGE(PG8_SB(0, 0), cB, voffB); PG8_STAGE(PG8_SB(0, 1), cB + hstep, voffB); PG8_STAGE(PG8_SA(0, 0), cA, voffA); PG8_STAGE(PG8_SA(0, 1), cA + hstep, voffA);
        if (wr == 1) PG8_BAR;
        PG8_WAIT_V(2); PG8_BAR;
        PG8_STAGE(PG8_SB(1, 0), cB + kstep, voffB); PG8_STAGE(PG8_SA(1, 0), cA + kstep, voffA); PG8_STAGE(PG8_SB(1, 1), cB + hstep + kstep, voffB);
        PG8_WAIT_V(6); PG8_BAR;
    } else {
        PG8_STAGE(PG8_SB(0, 0), cB, voffB); PG8_STAGE(PG8_SA(0, 0), cA, voffA); PG8_STAGE(PG8_SB(0, 1), cB + hstep, voffB); PG8_STAGE(PG8_SA(0, 1), cA + hstep, voffA);
        if (wr == 1) PG8_BAR;
        PG8_WAIT_V(4); PG8_BAR;
        PG8_STAGE(PG8_SB(1, 0), cB + kstep, voffB); PG8_STAGE(PG8_SA(1, 0), cA + kstep, voffA); PG8_STAGE(PG8_SB(1, 1), cB + hstep + kstep, voffB);
        PG8_WAIT_V(6); PG8_BAR;
    }
    for (;;) {
        const bool has_next = S.next(ui + 1, nxt);
        const char* nA = has_next ? (const char*)selA(g, nxt.z) + (size_t)nxt.pm * tstep : cA; const char* nB = has_next ? (const char*)selB(g, nxt.z) + (size_t)nxt.pn * tstep : cB;
        for (int t = 0; t < nt; t += 2) {
            const bool last = (t == nt - 2);
            const char* a1 = cA + (size_t)(t + 1) * kstep;
            const char* a2 = last ? nA : cA + (size_t)(t + 2) * kstep; const char* b2 = last ? nB : cB + (size_t)(t + 2) * kstep;
            const char* a3 = a2 + kstep; const char* b3 = b2 + kstep;
            if constexpr (SP2) {
            PG8_LDB(B0, 0, 0); PG8_LDB(B1, 0, 1); PG8_SCHED; PG8_LDA(At, 0, 0); PG8_STAGE(PG8_SA(1, 1), a1 + hstep, voffA);
            PG8_WAIT_V(8); PG8_WAIT_L(0); PG8_BAR; PG8_MMA(0, 0, At, B0); PG8_MMA(0, 1, At, B1); PG8_BAR; PG8_SCHED;
            PG8_LDA(At, 0, 1); PG8_STAGE(PG8_SB(0, 0), b2, voffB); PG8_STAGE(PG8_SB(0, 1), b2 + hstep, voffB); PG8_STAGE(PG8_SA(0, 0), a2, voffA);
            PG8_WAIT_V(8); PG8_WAIT_L(0); PG8_BAR; PG8_MMA(1, 0, At, B0); PG8_MMA(1, 1, At, B1); PG8_BAR; PG8_SCHED;
            PG8_LDB(B0, 1, 0); PG8_LDB(B1, 1, 1); PG8_SCHED; PG8_LDA(At, 1, 0); PG8_STAGE(PG8_SA(0, 1), a2 + hstep, voffA);
            PG8_WAIT_V(8); PG8_WAIT_L(0); PG8_BAR; PG8_MMA(0, 0, At, B0); PG8_MMA(0, 1, At, B1); PG8_BAR; PG8_SCHED;
            PG8_LDA(At, 1, 1); PG8_STAGE(PG8_SB(1, 0), b3, voffB); PG8_STAGE(PG8_SB(1, 1), b3 + hstep, voffB); PG8_STAGE(PG8_SA(1, 0), a3, voffA);
            PG8_WAIT_V(8); PG8_WAIT_L(0); PG8_BAR; PG8_MMA(1, 0, At, B0); PG8_MMA(1, 1, At, B1); PG8_BAR; PG8_SCHED;
            } else {
            PG8_LDB(B0, 0, 0); PG8_SCHED; PG8_LDA(At, 0, 0); PG8_STAGE(PG8_SA(1, 1), a1 + hstep, voffA);
            PG8_WAIT_L(8); PG8_BAR; PG8_WAIT_L(0); PG8_MMA(0, 0, At, B0); PG8_BAR; PG8_SCHED;
            PG8_LDB(B1, 0, 1); PG8_STAGE(PG8_SB(0, 0), b2, voffB);
            PG8_BAR; PG8_WAIT_L(0); PG8_MMA(0, 1, At, B1); PG8_BAR;
            PG8_LDA(At, 0, 1); PG8_STAGE(PG8_SA(0, 0), a2, voffA);
            PG8_BAR; PG8_WAIT_L(0); PG8_MMA(1, 0, At, B0); PG8_BAR; PG8_SCHED;
            PG8_STAGE(PG8_SB(0, 1), b2 + hstep, voffB);
            PG8_WAIT_V(6); PG8_BAR; PG8_MMA(1, 1, At, B1); PG8_BAR;
            PG8_LDB(B0, 1, 0); PG8_SCHED; PG8_LDA(At, 1, 0); PG8_STAGE(PG8_SA(0, 1), a2 + hstep, voffA);
            PG8_WAIT_L(8); PG8_BAR; PG8_WAIT_L(0); PG8_MMA(0, 0, At, B0); PG8_BAR; PG8_SCHED;
            PG8_LDB(B1, 1, 1); PG8_STAGE(PG8_SB(1, 0), b3, voffB);
            PG8_BAR; PG8_WAIT_L(0); PG8_MMA(0, 1, At, B1); PG8_BAR;
            PG8_LDA(At, 1, 1); PG8_STAGE(PG8_SA(1, 0), a3, voffA);
            PG8_BAR; PG8_WAIT_L(0); PG8_MMA(1, 0, At, B0); PG8_BAR; PG8_SCHED;
            PG8_STAGE(PG8_SB(1, 1), b3 + hstep, voffB);
            PG8_WAIT_V(6); PG8_BAR; PG8_MMA(1, 1, At, B1); PG8_BAR;
            }
        }
        if constexpr (ALIGN_EPI) { if (wr == 0) PG8_BAR; }
        const bool keep = E(acc, cur, wr, wc, fr, fq);
        if (!has_next) break;
        if (!keep) {
#pragma unroll
        for (int a = 0; a < 2; ++a)
#pragma unroll
            for (int b = 0; b < 2; ++b)
#pragma unroll
                for (int m = 0; m < 4; ++m)
#pragma unroll
                    for (int n = 0; n < 2; ++n) acc[a][b][m][n] = (f32x4){0.f, 0.f, 0.f, 0.f};
        }
        cur = nxt; cA = nA; cB = nB; ++ui;
        if constexpr (ALIGN_EPI) { if (wr == 1) PG8_BAR; }
    }
    PG8_WAIT_V(0);
    if constexpr (!ALIGN_EPI) { if (wr == 0) PG8_BAR; }
    PG8_BAR;
#undef PG8_SA
#undef PG8_SB
#undef PG8_STAGE
#undef PG8_LDA
#undef PG8_LDB
#undef PG8_MMA
#undef PG8_WAIT_V
#undef PG8_WAIT_L
#undef PG8_BAR
#undef PG8_SCHED
}
}

__device__ __forceinline__ f32x4 bf4lo(u32x4 w) { return (f32x4){__uint_as_float(w.x << 16), __uint_as_float(w.x & 0xffff0000u), __uint_as_float(w.y << 16), __uint_as_float(w.y & 0xffff0000u)}; }
__device__ __forceinline__ f32x4 bf4hi(u32x4 w) { return (f32x4){__uint_as_float(w.z << 16), __uint_as_float(w.z & 0xffff0000u), __uint_as_float(w.w << 16), __uint_as_float(w.w & 0xffff0000u)}; }
__device__ __forceinline__ u32x4 pack8(f32x4 a, f32x4 b) { u32x4 w; w.x = pg8::cvt_pk_bf16(a[0], a[1]); w.y = pg8::cvt_pk_bf16(a[2], a[3]); w.z = pg8::cvt_pk_bf16(b[0], b[1]); w.w = pg8::cvt_pk_bf16(b[2], b[3]); return w; }
__device__ __forceinline__ f32x4 sig4(f32x4 v) { return (f32x4){sigmoidf_(v[0]), sigmoidf_(v[1]), sigmoidf_(v[2]), sigmoidf_(v[3])}; }

__device__ __forceinline__ size_t s5_uidx(int g, int b, int n, int s) { return ((((size_t)(g * 4 + b) * 64 + s) * 68 + n) * 16); }
template <class T> __device__ __forceinline__ T* uni_ptr(T* q) { unsigned long long a = (unsigned long long)q; unsigned lo = __builtin_amdgcn_readfirstlane((unsigned)a), hi = __builtin_amdgcn_readfirstlane((unsigned)(a >> 32));
    asm volatile("" : "+s"(lo), "+s"(hi)); return (T*)(((unsigned long long)hi << 32) | lo); }
struct EpiInproj {
    static constexpr bool PERM = true;
    unsigned char* ws; const float* gate_b;
    __device__ __forceinline__ bool operator()(f32x4 (&acc)[2][2][4][2], const pg8::Unit& u, int wr, int wc, int fr_, int fq_) const {
        int fr = fr_, fq = fq_; asm volatile("" : "+v"(fr), "+v"(fq)); unsigned char* const ws = uni_ptr(this->ws);
        const int cl = wc * 32 + 8 * fq, rbase = u.pm * 256 + wr * 64 + fr;
#pragma unroll
        for (int bj = 0; bj < 2; ++bj) {
            const int c128 = u.pn * 256 + bj * 128;
            unsigned char* base; unsigned rstride, coff; int kind = 0;
            if (c128 < COL_K)         { base = ws + WS_Q; rstride = 1024; coff = (unsigned)(c128 + cl) * 2u; kind = 1; }
            else if (c128 < COL_V)    { base = ws + WS_K + (size_t)(cl >> 5) * TA * 64; rstride = 64; coff = (unsigned)(cl & 31) * 2u; kind = 1; }
            else if (c128 < COL_S5)   { base = ws + WS_V; rstride = 256;  coff = (unsigned)cl * 2u; }
            else if (c128 < COL_HY)   { base = ws + WS_U; rstride = 0; coff = 0; kind = 3; }
            else if (c128 < COL_GATE) { base = ws + WS_Z; rstride = 3072; coff = (unsigned)(c128 - COL_HY + cl) * 2u; }
            else                      { base = ws + WS_G; rstride = 6144; coff = (unsigned)(c128 - COL_GATE + cl) * 2u; kind = 2; }
            if (kind == 1) {
                const float* rope = (const float*)(ws + WS_ROPE) + 8 * fq;
#pragma unroll
                for (int ai = 0; ai < 2; ++ai)
#pragma unroll
                    for (int m = 0; m < 4; ++m) {
                        const int r = rbase + ai * 128 + m * 16;
                        f32x4 v0 = acc[ai][bj][m][0], v1 = acc[ai][bj][m][1];
                        if (r < TL) { const int l = r & 4095, pos = (wc & 1) ? (l & 63) : (l >> 6);
                            const f32x4 t0 = *(const f32x4*)(rope + pos * 32), t1 = *(const f32x4*)(rope + pos * 32 + 4);
                            v0 = (f32x4){v0[0] * t0[0] - v0[1] * t0[1], v0[0] * t0[1] + v0[1] * t0[0], v0[2] * t0[2] - v0[3] * t0[3], v0[2] * t0[3] + v0[3] * t0[2]};
                            v1 = (f32x4){v1[0] * t1[0] - v1[1] * t1[1], v1[0] * t1[1] + v1[1] * t1[0], v1[2] * t1[2] - v1[3] * t1[3], v1[2] * t1[3] + v1[3] * t1[2]}; }
                        *(u32x4*)(base + ((unsigned)r * rstride + coff)) = pack8(v0, v1);
                        asm volatile("" ::: "memory");
                    }
            } else if (kind == 2) {
                const float* gb = uni_ptr(gate_b) + (c128 - COL_GATE) + cl; const f32x4 b0 = *(const f32x4*)gb, b1 = *(const f32x4*)(gb + 4);
#pragma unroll
                for (int ai = 0; ai < 2; ++ai)
#pragma unroll
                    for (int m = 0; m < 4; ++m) {
                        const int r = rbase + ai * 128 + m * 16;
                        *(u32x4*)(base + ((unsigned)r * rstride + coff)) = pack8(sig4(acc[ai][bj][m][0] + b0), sig4(acc[ai][bj][m][1] + b1));
                        asm volatile("" ::: "memory");
                    }
            } else if (kind == 3) {
                const int ch = c128 - COL_S5 + cl, g = ch >> 4, i0 = ch & 15;
#pragma unroll
                for (int ai = 0; ai < 2; ++ai)
#pragma unroll
                    for (int m = 0; m < 4; ++m) {
                        const int r = rbase + ai * 128 + m * 16; int b, n, s;
                        if (r < TL) { b = r >> 12; n = 4 + ((r & 4095) >> 6); s = r & 63; } else { const int j = r - TL; b = j >> 8; n = (j & 255) >> 6; s = j & 63; }
                        *(u32x4*)((bf16*)base + s5_uidx(g, b, n, s) + i0) = pack8(acc[ai][bj][m][0], acc[ai][bj][m][1]);
                    }
            } else {
#pragma unroll
                for (int ai = 0; ai < 2; ++ai)
#pragma unroll
                    for (int m = 0; m < 4; ++m) {
                        const int r = rbase + ai * 128 + m * 16;
                        *(u32x4*)(base + ((unsigned)r * rstride + coff)) = pack8(acc[ai][bj][m][0], acc[ai][bj][m][1]);
                    }
            }
        }
        return false;
    }
};
struct EpiGlu {
    static constexpr bool PERM = true;
    unsigned char* ws; const float* bias;
    __device__ __forceinline__ bool operator()(f32x4 (&acc)[2][2][4][2], const pg8::Unit& u, int wr, int wc, int fr_, int fq_) const {
        int fr = fr_, fq = fq_; asm volatile("" : "+v"(fr), "+v"(fq)); unsigned char* const ws = uni_ptr(this->ws);
#pragma unroll
        for (int bj = 0; bj < 2; ++bj) { const int c = u.pn * 256 + bj * 128 + wc * 32 + 8 * fq; const f32x4 b0 = *(const f32x4*)(bias + c), b1 = *(const f32x4*)(bias + c + 4);
#pragma unroll
            for (int ai = 0; ai < 2; ++ai)
#pragma unroll
                for (int m = 0; m < 4; ++m) { const size_t o = (size_t)(u.pm * 256 + ai * 128 + wr * 64 + m * 16 + fr) * 512 + c;
                    const u32x4 yw = *(const u32x4*)((const bf16*)(ws + WS_S5Y) + o);
                    *(u32x4*)((bf16*)(ws + WS_S5O) + o) = pack8(bf4lo(yw) * sig4(acc[ai][bj][m][0] + b0), bf4hi(yw) * sig4(acc[ai][bj][m][1] + b1)); asm volatile("" ::: "memory"); } }
        return false;
    }
};
struct EpiMerge {
    static constexpr bool PERM = true;
    unsigned char* ws;
    __device__ __forceinline__ bool operator()(f32x4 (&acc)[2][2][4][2], const pg8::Unit& u, int wr, int wc, int fr_, int fq_) const {
        int fr = fr_, fq = fq_; asm volatile("" : "+v"(fr), "+v"(fq)); unsigned char* const ws = uni_ptr(this->ws);
#pragma unroll
        for (int bj = 0; bj < 2; ++bj) { const int c = u.pn * 256 + bj * 128 + wc * 32 + 8 * fq;
#pragma unroll
            for (int ai = 0; ai < 2; ++ai)
#pragma unroll
                for (int m = 0; m < 4; ++m) { const int r = u.pm * 256 + ai * 128 + wr * 64 + m * 16 + fr;
                    const bf16* gp = (const bf16*)(ws + WS_G) + (size_t)r * 3072 + u.z * 1024 + c;
                    const u32x4 g0 = *(const u32x4*)gp;
                    if (u.z < 2) { const u32x4 g1 = *(const u32x4*)(gp + 1024);
                        const f32x4 d0 = bf4lo(g1), d1 = bf4hi(g1), n0 = bf4lo(g0), n1 = bf4hi(g0);
                        acc[ai][bj][m][0] *= (f32x4){n0[0] / fmaxf(d0[0], 1e-30f), n0[1] / fmaxf(d0[1], 1e-30f), n0[2] / fmaxf(d0[2], 1e-30f), n0[3] / fmaxf(d0[3], 1e-30f)};
                        acc[ai][bj][m][1] *= (f32x4){n1[0] / fmaxf(d1[0], 1e-30f), n1[1] / fmaxf(d1[1], 1e-30f), n1[2] / fmaxf(d1[2], 1e-30f), n1[3] / fmaxf(d1[3], 1e-30f)};
                    } else *(u32x4*)((bf16*)(ws + WS_M) + (size_t)r * 1024 + c) = pack8(acc[ai][bj][m][0] * bf4lo(g0), acc[ai][bj][m][1] * bf4hi(g0));
                    asm volatile("" ::: "memory");
                } }
        return u.z < 2;
    }
};
struct EpiOut {
    static constexpr bool PERM = false;
    unsigned char* ws; int layer; float scale; const float* xin; const float* cin;
    __device__ __forceinline__ bool operator()(f32x4 (&acc)[2][2][4][2], const pg8::Unit& u, int wr, int wc, int fr_, int fq_) const {
        int fr = fr_, fq = fq_; asm volatile("" : "+v"(fr), "+v"(fq)); unsigned char* const ws = uni_ptr(this->ws);
        float* X = (float*)(ws + WS_XCUR); const float* xlat = uni_ptr(xin); const float* xctx = uni_ptr(cin);
#pragma unroll
        for (int ai = 0; ai < 2; ++ai)
#pragma unroll
            for (int m = 0; m < 4; ++m) { const int r = u.pm * 256 + ai * 128 + wr * 64 + m * 16 + fr;
                const float* g1 = (const float*)(ws + WS_MODV) + ((size_t)layer * 5 + row_mi(r)) * 6144 + 2048;
                const float* xs = (r < TL ? xlat : xctx) + (size_t)r * 1024;
#pragma unroll
                for (int bj = 0; bj < 2; ++bj)
#pragma unroll
                    for (int n = 0; n < 2; ++n) { const int c = u.pn * 256 + bj * 128 + wc * 32 + n * 16 + 4 * fq; f32x4* xp = (f32x4*)(X + (size_t)r * 1024 + c);
                        *xp = *(const f32x4*)(xs + c) + *(const f32x4*)(g1 + c) * acc[ai][bj][m][n] * scale; } asm volatile("" ::: "memory"); }
        return false;
    }
};
struct EpiQp {
    static constexpr bool PERM = true;
    unsigned char* ws;
    __device__ __forceinline__ bool operator()(f32x4 (&acc)[2][2][4][2], const pg8::Unit& u, int wr, int wc, int fr_, int fq_) const {
        int fr = fr_, fq = fq_; asm volatile("" : "+v"(fr), "+v"(fq)); unsigned char* const ws = uni_ptr(this->ws);
#pragma unroll
        for (int bj = 0; bj < 2; ++bj) { const int c = u.pn * 256 + bj * 128 + wc * 32 + 8 * fq;
#pragma unroll
            for (int ai = 0; ai < 2; ++ai)
#pragma unroll
                for (int m = 0; m < 4; ++m) *(u32x4*)((bf16*)(ws + WS_QP) + ((size_t)(c >> 4) * TA + (u.pm * 256 + ai * 128 + wr * 64 + m * 16 + fr)) * 16 + (c & 15)) = pack8(acc[ai][bj][m][0], acc[ai][bj][m][1]); }
        return false;
    }
};

__device__ __forceinline__ void ph_inproj(const Ctx& cx, int layer, PG8_LAS unsigned char* lds) {
    CParams& p = get_params();
    pg8::Gemm g; g.A = (const bf16*)(p.ws + WS_H); g.Bt = (const bf16*)(p.ws + WT_IN) + (size_t)layer * INW * DM; g.zsA = 0; g.zsB = 0; g.K = DM;
    pg8::TileOrder S; S.nM = TL / 256; S.nN = INW / 256; S.nwg = S.nM * S.nN; S.G = cx.nb; S.c = cx.bid; S.nz = 1;
    if (layer == DEPTH - 1) { S.exN = 3; S.expn0 = 2; S.extra = 4 * 3; } else { S.exN = INW / 256; S.expn0 = 0; S.extra = 4 * (INW / 256); }
    EpiInproj E; E.ws = p.ws; E.gate_b = p.in[I_GATEB] + layer * 3072;
    pg8::gemm_phase<EpiInproj, pg8::TileOrder>(lds, g, S, E, cx.tid);
}

__device__ __forceinline__ void ph_attn(const Ctx& cx, int layer, float* sm, int it_first, int it_count) {
    CParams& p = get_params();
    const int tid = cx.tid, lane = tid & 63, w = tid >> 6, l31 = lane & 31, hi = lane >> 5;
    const bf16* Q = (const bf16*)(p.ws + WS_Q); const bf16* Kb = (const bf16*)(p.ws + WS_K); const bf16* Vb = (const bf16*)(p.ws + WS_V);
    bf16* VT = (bf16*)sm;
    constexpr int VS = 644;
    constexpr float CS = 0.125f * 1.4426950408889634f;
    for (int it = it_first + cx.bid; it < it_first + it_count; it += cx.nb) {
        int b, kvh, qbase, wbase; bool win;
        if (it < 256) { b = it >> 6; kvh = (it >> 5) & 1; const int blk = it & 31; qbase = b * SEQ + blk * 128; wbase = blk * 128 - 128; win = true; }
        else { const int j = it - 256; b = j >> 2; kvh = (j >> 1) & 1; qbase = TL + b * CTXL + (j & 1) * 128; wbase = 0; win = false; }
        __syncthreads();
        for (int i = tid; i < 640 * 8; i += NTHREADS) { const int kk = i >> 3, c8 = i & 7; int row = -1;
            if (kk < 256) row = TL + b * CTXL + kk; else if (win) { const int pos = wbase + kk - 256; if (pos >= 0 && pos < SEQ) row = b * SEQ + pos; }
            const u32x4 ld_ = *(const u32x4*)(Vb + (size_t)(row >= 0 ? row : 0) * 128 + kvh * 64 + c8 * 8); const u32x4 v = row >= 0 ? ld_ : (u32x4){0u, 0u, 0u, 0u};
            bf16* d = VT + (c8 * 8) * VS + kk;
            d[0] = (bf16)(v.x & 0xffffu); d[VS] = (bf16)(v.x >> 16); d[2 * VS] = (bf16)(v.y & 0xffffu); d[3 * VS] = (bf16)(v.y >> 16);
            d[4 * VS] = (bf16)(v.z & 0xffffu); d[5 * VS] = (bf16)(v.z >> 16); d[6 * VS] = (bf16)(v.w & 0xffffu); d[7 * VS] = (bf16)(v.w >> 16); }
        __syncthreads();
        const int h = kvh * 4 + (w >> 1), tok0 = (w & 1) * 64;
        bf16x8 qf[2][4];
#pragma unroll
        for (int qt = 0; qt < 2; ++qt)
#pragma unroll
            for (int c = 0; c < 4; ++c) qf[qt][c] = *(const bf16x8*)(Q + (size_t)(qbase + tok0 + 32 * qt + l31) * 512 + h * 64 + 16 * c + 8 * hi);
        float m[2], l[2]; f32x16 O[2][2];
        const float sink = p.in[I_SINK][layer * 8 + h] * 1.4426950408889634f;
#pragma unroll
        for (int qt = 0; qt < 2; ++qt) { m[qt] = sink; l[qt] = 1.f;
#pragma unroll
            for (int dt = 0; dt < 2; ++dt)
#pragma unroll
                for (int r = 0; r < 16; ++r) O[qt][dt][r] = 0.f; }
        const int nsteps = win ? 18 : 8;
        bf16x8 kf[4];
#define ATT_LOADK(KF, st_) do { const int kk_ = ((st_) < 8 ? (st_) * 32 : 256 + tok0 + ((st_) - 8) * 32) + l31; int row; \
            if (kk_ < 256) row = TL + b * CTXL + kk_; else { int pos = wbase + kk_ - 256; pos = pos < 0 ? 0 : (pos > SEQ - 1 ? SEQ - 1 : pos); row = b * SEQ + pos; } \
            _Pragma("unroll") for (int c = 0; c < 4; ++c) KF[c] = *(const bf16x8*)(Kb + ((size_t)(kvh * 2 + (c >> 1)) * TA + row) * 32 + 16 * (c & 1) + 8 * hi); } while (0)
        ATT_LOADK(kf, 0);
        for (int st = 0; st < nsteps; ++st) {
            const int kk0 = st < 8 ? st * 32 : 256 + tok0 + (st - 8) * 32;
            bf16x8 kfn[4];
            const int stn = st + 1 < nsteps ? st + 1 : st;
            ATT_LOADK(kfn, stn);
            bf16x8 pf[2][2];
#pragma unroll
            for (int qt = 0; qt < 2; ++qt) {
                f32x16 s;
#pragma unroll
                for (int r = 0; r < 16; ++r) s[r] = 0.f;
#pragma unroll
                for (int c = 0; c < 4; ++c) s = __builtin_amdgcn_mfma_f32_32x32x16_bf16(kf[c], qf[qt][c], s, 0, 0, 0);
                if (st >= 8) {
                    const int qpos = wbase + 128 + tok0 + 32 * qt + l31, lo = qpos - 128 < 0 ? 0 : qpos - 128, hi_ = qpos + 128 > SEQ - 1 ? SEQ - 1 : qpos + 128;
                    const unsigned span = (unsigned)(hi_ - lo); const int kp0 = wbase + kk0 - 256 + 4 * hi - lo;
#pragma unroll
                    for (int r = 0; r < 16; ++r) s[r] = (unsigned)(kp0 + (r & 3) + 8 * (r >> 2)) <= span ? s[r] : -1e30f;
                }
                float mx = fmaxf(fmaxf(fmaxf(s[0], s[1]), fmaxf(s[2], s[3])), fmaxf(fmaxf(s[4], s[5]), fmaxf(s[6], s[7])));
                mx = fmaxf(mx, fmaxf(fmaxf(fmaxf(s[8], s[9]), fmaxf(s[10], s[11])), fmaxf(fmaxf(s[12], s[13]), fmaxf(s[14], s[15]))));
                mx = max_x32(mx);
                const float mn = fmaxf(m[qt], mx * CS), f = __builtin_amdgcn_exp2f(m[qt] - mn);
                float ps = 0.f;
#pragma unroll
                for (int r = 0; r < 16; ++r) { s[r] = __builtin_amdgcn_exp2f(fmaf(s[r], CS, -mn)); ps += s[r]; }
                ps = sum_x32(ps);
                l[qt] = l[qt] * f + ps; m[qt] = mn;
#pragma unroll
                for (int dt = 0; dt < 2; ++dt)
#pragma unroll
                    for (int r = 0; r < 16; ++r) O[qt][dt][r] *= f;
#pragma unroll
                for (int s2 = 0; s2 < 2; ++s2) { u32x4 pw; pw.x = pk2(s[8 * s2], s[8 * s2 + 1]); pw.y = pk2(s[8 * s2 + 2], s[8 * s2 + 3]); pw.z = pk2(s[8 * s2 + 4], s[8 * s2 + 5]); pw.w = pk2(s[8 * s2 + 6], s[8 * s2 + 7]);
                    pf[qt][s2] = __builtin_bit_cast(bf16x8, pw); }
            }
#pragma unroll
            for (int dt = 0; dt < 2; ++dt)
#pragma unroll
                for (int s2 = 0; s2 < 2; ++s2) {
                    const bf16* vp = VT + (32 * dt + l31) * VS + kk0 + 16 * s2 + 4 * hi;
                    u32x4 vw; const u32x2 va = *(const u32x2*)vp, vb = *(const u32x2*)(vp + 8); vw.x = va.x; vw.y = va.y; vw.z = vb.x; vw.w = vb.y;
                    const bf16x8 vf = __builtin_bit_cast(bf16x8, vw);
#pragma unroll
                    for (int qt = 0; qt < 2; ++qt) O[qt][dt] = __builtin_amdgcn_mfma_f32_32x32x16_bf16(vf, pf[qt][s2], O[qt][dt], 0, 0, 0);
                }
#pragma unroll
            for (int c = 0; c < 4; ++c) kf[c] = kfn[c];
        }
#undef ATT_LOADK
#pragma unroll
        for (int qt = 0; qt < 2; ++qt) { const float il = 1.f / l[qt]; bf16* op = (bf16*)(p.ws + WS_ATT) + (size_t)(qbase + tok0 + 32 * qt + l31) * 512 + h * 64 + 4 * hi;
#pragma unroll
            for (int dt = 0; dt < 2; ++dt)
#pragma unroll
                for (int g4 = 0; g4 < 4; ++g4) { u32x2 ww; ww.x = pk2(O[qt][dt][4 * g4] * il, O[qt][dt][4 * g4 + 1] * il); ww.y = pk2(O[qt][dt][4 * g4 + 2] * il, O[qt][dt][4 * g4 + 3] * il);
                    *(u32x2*)(op + 32 * dt + 8 * g4) = ww; } }
    }
}

__device__ __forceinline__ void ph_hypre(const Ctx& cx, int layer, float* sm, int it_first, int it_count) {
    CParams& p = get_params();
    const int lane = cx.tid & 63, wave = cx.tid >> 6, gw = cx.bid * NWAVES + wave, NGW = cx.nb * NWAVES;
    const bf16* Z = (const bf16*)(p.ws + WS_Z); const float* sw = p.in[I_HSW] + layer * 3 * 1536; const float* sb = p.in[I_HSB] + layer * 1536;
    float* tile = sm + wave * 4096;
    const int nlat = 4 * 64 * 8, nctx = layer == 0 ? 4 * 4 * 8 : 0;
    for (int it = it_first + gw; it < it_first + it_count; it += NGW) {
        int b, t0, L, c0, rbase; float* vvb;
        if (it < nlat) { b = it >> 9; t0 = ((it >> 3) & 63) * 64; c0 = (it & 7) * 64; L = SEQ; rbase = b * SEQ; vvb = (float*)(p.ws + WS_VV) + ((size_t)b * 512 + c0) * SEQ; }
        else { const int j = it - nlat; b = j >> 5; t0 = ((j >> 3) & 3) * 64; c0 = (j & 7) * 64; L = CTXL; rbase = TL + b * CTXL; vvb = (float*)(p.ws + WS_VVC) + ((size_t)b * 512 + c0) * CTXL; }
        const int c = c0 + lane;
        float w0[3], w1[3], w2[3], bb[3];
#pragma unroll
        for (int q = 0; q < 3; ++q) { const int col = q * 512 + c; w0[q] = sw[col]; w1[q] = sw[1536 + col]; w2[q] = sw[2 * 1536 + col]; bb[q] = sb[col]; }
        const bf16* zb = Z + (size_t)rbase * 1536 + c;
#pragma unroll 1
        for (int tb = 0; tb < 64; tb += 16) {
            bf16 zv[3][18];
#pragma unroll
            for (int k = 0; k < 18; ++k) { const int t = t0 + tb + k - 1; const bool ok = t >= 0 && t < L; const int tc = t < 0 ? 0 : (t >= L ? L - 1 : t);
#pragma unroll
                for (int q = 0; q < 3; ++q) { const bf16 ld_ = zb[(size_t)tc * 1536 + q * 512]; zv[q][k] = ok ? ld_ : (bf16)0; } }
#pragma unroll
            for (int k = 0; k < 16; ++k) { const int tt = tb + k, t = t0 + tt; float o[3];
#pragma unroll
                for (int q = 0; q < 3; ++q) o[q] = bb[q] + w0[q] * bf2f(zv[q][k]) + w1[q] * bf2f(zv[q][k + 1]) + w2[q] * bf2f(zv[q][k + 2]);
                ((bf16*)(p.ws + WS_X0C))[(size_t)(rbase + t) * 512 + c] = f2bf(o[0]);
                tile[lane * 64 + (tt ^ lane)] = o[2] * o[1]; }
        }
        __builtin_amdgcn_s_waitcnt(0xc07f);
        for (int cc = 0; cc < 64; ++cc) vvb[(size_t)cc * L + t0 + lane] = tile[cc * 64 + (lane ^ cc)];
        __builtin_amdgcn_s_waitcnt(0xc07f);
    }
}

__device__ __forceinline__ void ph_hyconv_ctx(const Ctx& cx, int layer, float* sm) {
    CParams& p = get_params();
    const int tid = cx.tid;
    if (layer != 0) return;
    constexpr int L = CTXL;
    float* Tl = sm; float* Vl = sm + 2 * L;
    for (int it = cx.bid; it < 2048; it += cx.nb) {
        const int bc = it, b = bc >> 9, c = bc & 511;
        const float* fb = (const float*)(p.ws + WS_FILT + FILT_CTX_OFF);
        const float* hf = fb + (size_t)c * L; const float* hb = fb + ((size_t)512 + c) * L;
        const float* vv = (const float*)(p.ws + WS_VVC) + (size_t)bc * CTXL;
        __syncthreads();
        if (tid < L) { Tl[L - 1 + tid] = hf[tid]; if (tid > 0) Tl[L - 1 - tid] = hb[tid]; Vl[tid] = vv[tid]; }
        __syncthreads();
        if (tid < L) { float a = 0.f; const float* tp = Tl + (tid + L - 1);
            for (int s = 0; s < L; ++s) a += Vl[s] * tp[-s];
            const size_t o = (size_t)(TL + b * CTXL + tid) * 512 + c;
            ((bf16*)(p.ws + WS_HY))[o] = f2bf((a + Vl[tid] * p.in[I_HBIAS][layer * 512 + c]) * bf2f(((const bf16*)(p.ws + WS_X0C))[o])); }
    }
}
typedef float f32x2 __attribute__((ext_vector_type(2)));
__device__ __forceinline__ f32x2 cmul(f32x2 a, f32x2 w) { return (f32x2){a.x * w.x - a.y * w.y, a.x * w.y + a.y * w.x}; }
struct Dft16 { bf16x8 fr, fi, ir, ii; };
__device__ __forceinline__ Dft16 make_dft16(int lane) {
    const int r = lane & 15, kg = lane >> 4; Dft16 d; float fr[8], fi[8], ir[8], ii[8];
#pragma unroll
    for (int j = 0; j < 8; ++j) { const int m = 4 * kg + (j >> 1), comp = j & 1; const float rev = (float)((r * m) & 15) * (1.f / 16.f); const float c = __builtin_amdgcn_cosf(rev), s = __builtin_amdgcn_sinf(rev);
        fr[j] = comp ? s : c; fi[j] = comp ? c : -s; ir[j] = comp ? -s : c; ii[j] = comp ? c : s; }
    u32x4 w;
    w.x = pk2(fr[0], fr[1]); w.y = pk2(fr[2], fr[3]); w.z = pk2(fr[4], fr[5]); w.w = pk2(fr[6], fr[7]); d.fr = __builtin_bit_cast(bf16x8, w);
    w.x = pk2(fi[0], fi[1]); w.y = pk2(fi[2], fi[3]); w.z = pk2(fi[4], fi[5]); w.w = pk2(fi[6], fi[7]); d.fi = __builtin_bit_cast(bf16x8, w);
    w.x = pk2(ir[0], ir[1]); w.y = pk2(ir[2], ir[3]); w.z = pk2(ir[4], ir[5]); w.w = pk2(ir[6], ir[7]); d.ir = __builtin_bit_cast(bf16x8, w);
    w.x = pk2(ii[0], ii[1]); w.y = pk2(ii[2], ii[3]); w.z = pk2(ii[4], ii[5]); w.w = pk2(ii[6], ii[7]); d.ii = __builtin_bit_cast(bf16x8, w);
    return d;
}
__device__ __forceinline__ int fpad(int i) { return i + (i >> 4); }
constexpr int FFT_LD = 8192 + 512;
template <bool FWD, int lE> __device__ __forceinline__ f32x2 fft_twiddle(int pos, int k, int idx) {
    if (FWD) { const float rev = (float)(pos * k) * (1.f / (float)(16 << lE)); return (f32x2){__builtin_amdgcn_cosf(rev), -__builtin_amdgcn_sinf(rev)}; }
    const int L = 16 << lE, posn = idx & (L - 1), kn = (idx >> (lE + 4)) & 15;
    const float rev = (float)(posn * kn) * (1.f / (float)(16 * L)); return (f32x2){__builtin_amdgcn_cosf(rev), __builtin_amdgcn_sinf(rev)};
}
template <bool FWD, int lE> __device__ __forceinline__ void fft_pass16(f32x2* X, int tid, const bf16x8 ar, const bf16x8 ai) {
    __syncthreads();
    int tl = tid; asm volatile("" : "+v"(tl));
    const int lane = tl & 63, w = __builtin_amdgcn_readfirstlane(tl >> 6), l15 = lane & 15, kg = lane >> 4;
    constexpr int E = 1 << lE;
    constexpr bool TW = FWD || lE < 9, PERQ = FWD ? (lE == 9) : (lE == 5);
    f32x2 tw[4];
    if (TW && !PERQ) { const int g = 16 * w + l15, blk = g >> lE, pos = g & (E - 1), base = (blk << (lE + 4)) + pos;
#pragma unroll
        for (int r = 0; r < 4; ++r) tw[r] = fft_twiddle<FWD, lE>(pos, 4 * kg + r, base + ((4 * kg + r) << lE)); }
#pragma unroll
    for (int q = 0; q < 4; ++q) {
        const int g = 16 * (w + 8 * q) + l15, blk = g >> lE, pos = g & (E - 1), base = (blk << (lE + 4)) + pos;
        u32x4 bw;
        { const f32x2 v0 = X[fpad(base + ((4 * kg + 0) << lE))], v1 = X[fpad(base + ((4 * kg + 1) << lE))], v2 = X[fpad(base + ((4 * kg + 2) << lE))], v3 = X[fpad(base + ((4 * kg + 3) << lE))];
          bw.x = pk2(v0.x, v0.y); bw.y = pk2(v1.x, v1.y); bw.z = pk2(v2.x, v2.y); bw.w = pk2(v3.x, v3.y); }
        const bf16x8 bf = __builtin_bit_cast(bf16x8, bw);
        const f32x4 z = (f32x4){0.f, 0.f, 0.f, 0.f};
        const f32x4 cr = __builtin_amdgcn_mfma_f32_16x16x32_bf16(ar, bf, z, 0, 0, 0), ci = __builtin_amdgcn_mfma_f32_16x16x32_bf16(ai, bf, z, 0, 0, 0);
#pragma unroll
        for (int r = 0; r < 4; ++r) { const int k = 4 * kg + r, idx = base + (k << lE); f32x2 y = (f32x2){cr[r], ci[r]};
            if (TW) { if (PERQ) tw[r] = fft_twiddle<FWD, lE>(pos, k, idx); y = cmul(y, tw[r]); }
            X[fpad(idx)] = y; }
    }
}
__device__ __forceinline__ void ph_hyfft(const Ctx& cx, int layer, float* sm, bool dry) {
    CParams& p = get_params();
    const int tid = cx.tid;
    f32x2* A = (f32x2*)sm; f32x2* B = A + FFT_LD;
    const Dft16 D = make_dft16(tid & 63);
    const float revm = (float)(tid & 15) * (1.f / 32.f); const f32x2 twm = (f32x2){__builtin_amdgcn_cosf(revm), __builtin_amdgcn_sinf(revm)};
    for (int c = cx.bid; c < 512; c += cx.nb) {
        const float* hf = (const float*)(p.ws + WS_FILT) + (size_t)c * SEQ; const float* hb = (const float*)(p.ws + WS_FILT) + ((size_t)512 + c) * SEQ;
        const float bias = p.in[I_HBIAS][layer * 512 + c];
        __syncthreads();
#pragma unroll
        for (int q = 0; q < 16; ++q) { const int i = tid + 512 * q; const float lf = hf[i & (SEQ - 1)], lb_ = hb[(2 * SEQ - i) & (SEQ - 1)]; A[fpad(i)] = (f32x2){i < SEQ ? lf : (i > SEQ ? lb_ : 0.f), 0.f}; }
        fft_pass16<true, 9>(A, tid, D.fr, D.fi); fft_pass16<true, 5>(A, tid, D.fr, D.fi); fft_pass16<true, 1>(A, tid, D.fr, D.fi);
        __syncthreads();
#pragma unroll
        for (int q = 0; q < 8; ++q) { const int i = fpad(2 * (tid + 512 * q)); const f32x2 a = A[i], b = A[i + 1]; A[i] = a + b; A[i + 1] = a - b; }
#pragma unroll 1
        for (int bp = 0; bp < 2; ++bp) {
            float* v0 = (float*)(p.ws + WS_VV) + ((size_t)(2 * bp) * 512 + c) * SEQ; float* v1 = v0 + (size_t)512 * SEQ;
            float xr[8], xi[8];
            __syncthreads();
#pragma unroll
            for (int q = 0; q < 8; ++q) { const int i = tid + 512 * q; xr[q] = v0[i]; xi[q] = v1[i]; B[fpad(i)] = (f32x2){xr[q], xi[q]}; B[fpad(i + SEQ)] = (f32x2){0.f, 0.f}; }
            fft_pass16<true, 9>(B, tid, D.fr, D.fi); fft_pass16<true, 5>(B, tid, D.fr, D.fi); fft_pass16<true, 1>(B, tid, D.fr, D.fi);
            __syncthreads();
#pragma unroll
            for (int q = 0; q < 8; ++q) { const int i = fpad(2 * (tid + 512 * q)); const f32x2 a = B[i], b = B[i + 1];
                const f32x2 y0 = cmul(a + b, A[i]), y1 = cmul(a - b, A[i + 1]);
                B[i] = y0 + y1; B[i + 1] = cmul(y0 - y1, twm); }
            fft_pass16<false, 1>(B, tid, D.ir, D.ii); fft_pass16<false, 5>(B, tid, D.ir, D.ii); fft_pass16<false, 9>(B, tid, D.ir, D.ii);
            __syncthreads();
#pragma unroll
            for (int q = 0; q < 8; ++q) { const int i = tid + 512 * q; const f32x2 y = B[fpad(i)]; if (!dry) { v0[i] = y.x * (1.f / 8192.f) + xr[q] * bias; v1[i] = y.y * (1.f / 8192.f) + xi[q] * bias; } }
        }
    }
}
__device__ __forceinline__ void ph_hypost(const Ctx& cx, int layer, float* sm) {
    CParams& p = get_params();
    const int lane = cx.tid & 63, wave = cx.tid >> 6, gw = cx.bid * NWAVES + wave, NGW = cx.nb * NWAVES;
    float* tile = sm + wave * 4096;
    for (int it = gw; it < 4 * 64 * 8; it += NGW) {
        const int b = it >> 9, t0 = ((it >> 3) & 63) * 64, c0 = (it & 7) * 64;
        const float* yb = (const float*)(p.ws + WS_VV) + ((size_t)b * 512 + c0) * SEQ;
#pragma unroll 1
        for (int cb = 0; cb < 64; cb += 16) { float yv[16];
#pragma unroll
            for (int q = 0; q < 16; ++q) yv[q] = yb[(size_t)(cb + q) * SEQ + t0 + lane];
#pragma unroll
            for (int q = 0; q < 16; ++q) tile[(cb + q) * 64 + (lane ^ (cb + q))] = yv[q]; }
        __builtin_amdgcn_s_waitcnt(0xc07f);
#pragma unroll 1
        for (int tb = 0; tb < 64; tb += 16) { bf16 xv[16];
#pragma unroll
            for (int q = 0; q < 16; ++q) xv[q] = ((const bf16*)(p.ws + WS_X0C))[(size_t)(b * SEQ + t0 + tb + q) * 512 + c0 + lane];
#pragma unroll
            for (int q = 0; q < 16; ++q) { const int tt = tb + q; ((bf16*)(p.ws + WS_HY))[(size_t)(b * SEQ + t0 + tt) * 512 + c0 + lane] = f2bf(tile[lane * 64 + (tt ^ lane)] * bf2f(xv[q])); } }
        __builtin_amdgcn_s_waitcnt(0xc07f);
    }
    (void)layer;
}

__device__ __forceinline__ void s5_pow(const float decay, const float theta, int n, float& pr, float& pi) {
    const float m = __expf(decay * (float)n), rev = __builtin_amdgcn_fractf(theta * (float)n * 0.15915494309189535f);
    pr = m * __builtin_amdgcn_cosf(rev); pi = m * __builtin_amdgcn_sinf(rev);
}
__device__ __forceinline__ void s5_disc(CParams& p, int ldgp, float& decay, float& theta, float& cr, float& ci) {
    const float are = fminf(p.in[I_SARE][ldgp], -1e-4f), aim = p.in[I_SAIM][ldgp], dt = __expf(p.in[I_SLDT][ldgp >> 6]);
    decay = are * dt; theta = aim * dt;
    const float er = __expf(decay), abr = er * fcos(theta), abi = er * fsin(theta);
    const float nr = abr - 1.0f, ni = abi, den = are * are + aim * aim;
    cr = (nr * are + ni * aim) / den; ci = (ni * are - nr * aim) / den;
}
__device__ __forceinline__ void ph_s5tables(const Ctx& cx, int layer, float* sm) {
    const int gt = cx.bid * NTHREADS + cx.tid, NGT = cx.nb * NTHREADS;
    {
        CParams& p = get_params(); bf16* E = (bf16*)(p.ws + WS_S5E);
        for (int it = gt; it < 32 * 2 * 64 * 64; it += NGT) {
            const int pp = it & 63, s = (it >> 6) & 63, dir = (it >> 12) & 1, g = it >> 13;
            const int ldgp = ((layer * 2 + dir) * 32 + g) * 64 + pp;
            float decay, theta, cr, ci; s5_disc(p, ldgp, decay, theta, cr, ci);
            float pr, pi; s5_pow(decay, theta, dir == 0 ? 63 - s : s, pr, pi);
            const float qr = pr * cr - pi * ci, qi = pr * ci + pi * cr;
            const f32x4* bre = (const f32x4*)(p.in[I_SBRE] + (size_t)ldgp * 16); const f32x4* bim = (const f32x4*)(p.in[I_SBIM] + (size_t)ldgp * 16);
            bf16* er = E + (((size_t)(g * 2 + dir) * 128 + pp) * 1024 + s * 16); bf16* ei = er + (size_t)64 * 1024;
#pragma unroll
            for (int i4 = 0; i4 < 4; ++i4) { const f32x4 br = bre[i4], bi = bim[i4];
                *(unsigned*)(er + 4 * i4) = pk2(qr * br[0] - qi * bi[0], qr * br[1] - qi * bi[1]); *(unsigned*)(er + 4 * i4 + 2) = pk2(qr * br[2] - qi * bi[2], qr * br[3] - qi * bi[3]);
                *(unsigned*)(ei + 4 * i4) = pk2(qr * bi[0] + qi * br[0], qr * bi[1] + qi * br[1]); *(unsigned*)(ei + 4 * i4 + 2) = pk2(qr * bi[2] + qi * br[2], qr * bi[3] + qi * br[3]); }
            if (s == 0) { float ar, ai; s5_pow(decay, theta, 64, ar, ai); float* a64 = (float*)(p.ws + WS_S5A64) + (size_t)ldgp * 2; a64[0] = ar; a64[1] = ai; }
        }
    }
    {
        CParams& p = get_params(); bf16* P = (bf16*)(p.ws + WS_S5P);
        for (int it = gt; it < 32 * 2 * 64 * 64; it += NGT) {
            const int pp = it & 63, tau = (it >> 6) & 63, dir = (it >> 12) & 1, g = it >> 13;
            const int ldgp = ((layer * 2 + dir) * 32 + g) * 64 + pp;
            const float are = fminf(p.in[I_SARE][ldgp], -1e-4f), aim = p.in[I_SAIM][ldgp], dt = __expf(p.in[I_SLDT][ldgp >> 6]);
            float pr, pi; s5_pow(are * dt, aim * dt, dir == 0 ? tau + 1 : 64 - tau, pr, pi);
            const size_t cb = ((size_t)((layer * 2 + dir) * 32 + g) * 16) * 64 + pp;
            bf16* pb = P + (((size_t)(g * 2 + dir) * 64 + tau) * 16) * 128 + pp;
#pragma unroll
            for (int o = 0; o < 16; ++o) { const float cre = p.in[I_SCRE][cb + o * 64], cim = p.in[I_SCIM][cb + o * 64];
                pb[o * 128] = f2bf(cre * pr - cim * pi); pb[o * 128 + 64] = f2bf(-(cre * pi + cim * pr)); }
        }
    }
    {
        CParams& p = get_params(); bf16* K = (bf16*)(p.ws + WS_S5K);
        const int tid = cx.tid, lane = tid & 63, w = tid >> 6;
        float* Cs = sm;
        float* Xs = sm + 4096 + w * 2112;
        for (int it = cx.bid; it < 32 * 16; it += cx.nb) {
            const int g = it >> 4, dl = (it & 15) * 8 + w, d = dl - 63;
            __syncthreads();
            for (int i = tid; i < 2 * 16 * 64; i += NTHREADS) { const int dir = i >> 10, r = i & 1023; const size_t ci = (size_t)((layer * 2 + dir) * 32 + g) * 1024 + r;
                Cs[i * 2] = p.in[I_SCRE][ci]; Cs[i * 2 + 1] = p.in[I_SCIM][ci]; }
            __syncthreads();
            if (dl < 127) {
                float acc[4] = {0.f, 0.f, 0.f, 0.f};
#pragma unroll 1
                for (int dir = 0; dir < 2; ++dir) {
                    if ((dir == 0 && d < 0) || (dir == 1 && d > 0)) continue;
                    const int ldgp = ((layer * 2 + dir) * 32 + g) * 64 + lane;
                    float decay, theta, cr, ci; s5_disc(p, ldgp, decay, theta, cr, ci);
                    float pr, pi; s5_pow(decay, theta, d < 0 ? -d : d, pr, pi);
                    const float qr = pr * cr - pi * ci, qi = pr * ci + pi * cr;
                    const f32x4* bre = (const f32x4*)(p.in[I_SBRE] + (size_t)ldgp * 16); const f32x4* bim = (const f32x4*)(p.in[I_SBIM] + (size_t)ldgp * 16);
#pragma unroll
                    for (int i4 = 0; i4 < 4; ++i4) { const f32x4 br = bre[i4], bi = bim[i4];
#pragma unroll
                        for (int q = 0; q < 4; ++q) { Xs[lane * 33 + 4 * i4 + q] = qr * br[q] - qi * bi[q]; Xs[lane * 33 + 16 + 4 * i4 + q] = qr * bi[q] + qi * br[q]; } }
                    __builtin_amdgcn_s_waitcnt(0xc07f);
                    const int i = lane & 15, oq = lane >> 4;
                    for (int pp = 0; pp < 64; ++pp) { const float xr = Xs[pp * 33 + i], xi = Xs[pp * 33 + 16 + i];
#pragma unroll
                        for (int jj = 0; jj < 4; ++jj) { const f32x2 c = *(const f32x2*)(Cs + ((dir * 16 + oq + 4 * jj) * 64 + pp) * 2); acc[jj] += c.x * xr - c.y * xi; } }
                    __builtin_amdgcn_s_waitcnt(0xc07f);
                }
                const int i = lane & 15, oq = lane >> 4;
#pragma unroll
                for (int jj = 0; jj < 4; ++jj) { const int o = oq + 4 * jj; float v = acc[jj]; if (d == 0 && o == i) v += p.in[I_SD][layer * 512 + g * 16 + o];
                    K[((size_t)g * 127 + dl) * 256 + o * 16 + i] = f2bf(v); }
            }
        }
    }
}
__device__ __forceinline__ int s5_row(int b, int n, int s) { return n < 4 ? TL + b * CTXL + n * 64 + s : b * SEQ + (n - 4) * 64 + s; }
__device__ __forceinline__ void ph_s5states(const Ctx& cx, int layer, float* sm) {
    CParams& p = get_params();
    const int tid = cx.tid, lane = tid & 63, w = tid >> 6, l15 = lane & 15, kg = lane >> 4;
    const bf16* E = (const bf16*)(p.ws + WS_S5E); const bf16* U = (const bf16*)(p.ws + WS_U);
    float* S = sm;
    for (int it = cx.bid; it < 128; it += cx.nb) {
        const int g = it & 31, b = it >> 5;
        f32x4 acc[2][5];
#pragma unroll
        for (int mt = 0; mt < 2; ++mt)
#pragma unroll
            for (int nt = 0; nt < 5; ++nt) acc[mt][nt] = (f32x4){0.f, 0.f, 0.f, 0.f};
        const bf16* ea = E + ((size_t)g * 256 + 32 * w + l15) * 1024 + 8 * kg;
        const int i0 = 8 * (kg & 1);
        bf16x8 af[2], bfr[5];
#define S5S_LOAD(AF, BF, ks_) do { const int s_ = 2 * (ks_) + (kg >> 1); \
            _Pragma("unroll") for (int mt = 0; mt < 2; ++mt) AF[mt] = *(const bf16x8*)(ea + (size_t)mt * 16 * 1024 + (ks_) * 32); \
            _Pragma("unroll") for (int nt = 0; nt < 5; ++nt) { const int n = 16 * nt + l15, nc = n < 68 ? n : 67; \
                const bf16x8 ld_ = *(const bf16x8*)(U + s5_uidx(g, b, nc, s_) + i0); BF[nt] = n < 68 ? ld_ : (bf16x8){0, 0, 0, 0, 0, 0, 0, 0}; } } while (0)
        S5S_LOAD(af, bfr, 0);
        for (int ks = 0; ks < 32; ++ks) {
            bf16x8 afn[2], bfn[5];
            const int kn = ks < 31 ? ks + 1 : 31;
            S5S_LOAD(afn, bfn, kn);
#pragma unroll
            for (int mt = 0; mt < 2; ++mt)
#pragma unroll
                for (int nt = 0; nt < 5; ++nt) acc[mt][nt] = __builtin_amdgcn_mfma_f32_16x16x32_bf16(af[mt], bfr[nt], acc[mt][nt], 0, 0, 0);
#pragma unroll
            for (int mt = 0; mt < 2; ++mt) af[mt] = afn[mt];
#pragma unroll
            for (int nt = 0; nt < 5; ++nt) bfr[nt] = bfn[nt];
        }
#undef S5S_LOAD
        __syncthreads();
#pragma unroll
        for (int mt = 0; mt < 2; ++mt)
#pragma unroll
            for (int nt = 0; nt < 5; ++nt)
#pragma unroll
                for (int r = 0; r < 4; ++r) S[(32 * w + 16 * mt + kg * 4 + r) * 81 + 16 * nt + l15] = acc[mt][nt][r];
        __syncthreads();
        if (tid < 128) {
            const int dir = tid >> 6, pp = tid & 63;
            const float* a64 = (const float*)(p.ws + WS_S5A64) + ((size_t)((layer * 2 + dir) * 32 + g) * 64 + pp) * 2;
            const float ar = a64[0], ai = a64[1]; float hr = 0.f, hi = 0.f;
            bf16* hin = (bf16*)(p.ws + WS_HIN) + ((size_t)g * 272 + b * 68) * 256 + dir * 128 + pp;
            for (int k = 0; k < 68; ++k) {
                const int n = dir == 0 ? k : (k < 4 ? 3 - k : 71 - k);
                hin[(size_t)n * 256] = f2bf(hr); hin[(size_t)n * 256 + 64] = f2bf(hi);
                const float sr = S[(dir * 128 + pp) * 81 + n], si = S[(dir * 128 + 64 + pp) * 81 + n];
                const float nr = ar * hr - ai * hi + sr, ni = ar * hi + ai * hr + si; hr = nr; hi = ni;
            }
        }
    }
}
__device__ __forceinline__ void ph_s5out(const Ctx& cx, int layer, float* sm) {
    CParams& p = get_params();
    const int tid = cx.tid, lane = tid & 63, w = tid >> 6, l15 = lane & 15, kg = lane >> 4;
    const bf16* U = (const bf16*)(p.ws + WS_U); const bf16* P = (const bf16*)(p.ws + WS_S5P); const bf16* HIN = (const bf16*)(p.ws + WS_HIN);
    bf16* Kl = (bf16*)sm;
    for (int it = cx.bid; it < 256; it += cx.nb) {
        const int g = it & 31, b = (it >> 5) & 3, half = it >> 7;
        __syncthreads();
        { const u32x4* src = (const u32x4*)((const bf16*)(p.ws + WS_S5K) + (size_t)g * 127 * 256); u32x4* dst = (u32x4*)Kl;
          for (int i = tid; i < 127 * 256 / 8; i += NTHREADS) dst[i] = src[i]; }
        __syncthreads();
        f32x4 acc[4][5];
#pragma unroll
        for (int mt = 0; mt < 4; ++mt)
#pragma unroll
            for (int nt = 0; nt < 5; ++nt) acc[mt][nt] = (f32x4){0.f, 0.f, 0.f, 0.f};
        const int tau0 = 32 * half + 4 * w;
        const int i0 = 8 * (kg & 1);
        bf16x8 bfr[5];
#define S5O_LOADB(BF, ks_) do { const int s_ = 2 * (ks_) + (kg >> 1); \
            _Pragma("unroll") for (int nt = 0; nt < 5; ++nt) { const int n = 16 * nt + l15, nc = n < 68 ? n : 67; \
                const bf16x8 ld_ = *(const bf16x8*)(U + s5_uidx(g, b, nc, s_) + i0); BF[nt] = n < 68 ? ld_ : (bf16x8){0, 0, 0, 0, 0, 0, 0, 0}; } } while (0)
        S5O_LOADB(bfr, 0);
        for (int ks = 0; ks < 32; ++ks) {
            const int s = 2 * ks + (kg >> 1);
            bf16x8 bfn[5];
            const int kn = ks < 31 ? ks + 1 : 31;
            S5O_LOADB(bfn, kn);
#pragma unroll
            for (int mt = 0; mt < 4; ++mt) {
                const int lag = tau0 + mt - s;
                const bf16x8 af = *(const bf16x8*)(Kl + (lag + 63) * 256 + l15 * 16 + i0);
#pragma unroll
                for (int nt = 0; nt < 5; ++nt) acc[mt][nt] = __builtin_amdgcn_mfma_f32_16x16x32_bf16(af, bfr[nt], acc[mt][nt], 0, 0, 0);
            }
#pragma unroll
            for (int nt = 0; nt < 5; ++nt) bfr[nt] = bfn[nt];
        }
#undef S5O_LOADB
        bf16x8 pa[4];
#define S5O_LOAD2(AF, BF, dk_) do { const int dir_ = (dk_) >> 2, kk_ = (dk_) & 3; \
            _Pragma("unroll") for (int nt = 0; nt < 5; ++nt) { const int n = 16 * nt + l15, nc = n < 68 ? n : 67; \
                const bf16x8 ld_ = *(const bf16x8*)(HIN + ((size_t)g * 272 + b * 68 + nc) * 256 + dir_ * 128 + 32 * kk_ + 8 * kg); BF[nt] = n < 68 ? ld_ : (bf16x8){0, 0, 0, 0, 0, 0, 0, 0}; } \
            _Pragma("unroll") for (int mt = 0; mt < 4; ++mt) AF[mt] = *(const bf16x8*)(P + ((((size_t)(g * 2 + dir_) * 64 + tau0 + mt) * 16 + l15) * 128 + 32 * kk_ + 8 * kg)); } while (0)
        S5O_LOAD2(pa, bfr, 0);
#pragma unroll 1
        for (int dk = 0; dk < 8; ++dk) {
            bf16x8 pan[4], bfn[5];
            const int dn = dk < 7 ? dk + 1 : 7;
            S5O_LOAD2(pan, bfn, dn);
#pragma unroll
            for (int mt = 0; mt < 4; ++mt)
#pragma unroll
                for (int nt = 0; nt < 5; ++nt) acc[mt][nt] = __builtin_amdgcn_mfma_f32_16x16x32_bf16(pa[mt], bfr[nt], acc[mt][nt], 0, 0, 0);
#pragma unroll
            for (int mt = 0; mt < 4; ++mt) pa[mt] = pan[mt];
#pragma unroll
            for (int nt = 0; nt < 5; ++nt) bfr[nt] = bfn[nt];
        }
#undef S5O_LOAD2
#pragma unroll
        for (int mt = 0; mt < 4; ++mt)
#pragma unroll
            for (int nt = 0; nt < 5; ++nt) { const int n = 16 * nt + l15;
                if (n < 68 && (layer == 0 || n >= 4)) { const f32x4 y = acc[mt][nt]; u32x2 o; o.x = pk2(gelu_tanh(y[0]), gelu_tanh(y[1])); o.y = pk2(gelu_tanh(y[2]), gelu_tanh(y[3]));
                    *(u32x2*)((bf16*)(p.ws + WS_S5Y) + (size_t)s5_row(b, n, tau0 + mt) * 512 + g * 16 + 4 * kg) = o; } }
    }
}

__device__ __forceinline__ void ph_glu(const Ctx& cx, int layer, PG8_LAS unsigned char* lds) {
    CParams& p = get_params();
    pg8::Gemm g; g.A = (const bf16*)(p.ws + WS_S5Y); g.Bt = (const bf16*)(p.ws + WT_GLU) + (size_t)layer * 512 * 512; g.zsA = 0; g.zsB = 0; g.K = 512;
    pg8::TileOrder S; S.nM = TL / 256; S.nN = 2; S.nwg = S.nM * S.nN; S.G = cx.nb; S.c = cx.bid; S.nz = 1; S.exN = 2; S.expn0 = 0; S.extra = layer == 0 ? 4 * 2 : 0;
    EpiGlu E; E.ws = p.ws; E.bias = p.in[I_GLUB] + layer * 512;
    pg8::gemm_phase<EpiGlu, pg8::TileOrder>(lds, g, S, E, cx.tid);
}
__device__ __forceinline__ void ph_merge(const Ctx& cx, int layer, PG8_LAS unsigned char* lds) {
    CParams& p = get_params();
    pg8::Gemm g; g.A = (const bf16*)(p.ws + WS_ATT); g.zsA = (WS_HY - WS_ATT) / 2;
    g.Bt = (const bf16*)(p.ws + WT_BR) + (size_t)(layer * 3 + 0) * 1024 * 512; g.zsB = 1024 * 512; g.K = 512;
    pg8::TileOrder S; S.nM = TL / 256; S.nN = 4; S.nwg = S.nM * S.nN; S.G = cx.nb; S.c = cx.bid; S.nz = 3; S.exN = 4; S.expn0 = 0; S.extra = layer == 0 ? 4 * 4 : 0;
    EpiMerge E; E.ws = p.ws;
    pg8::gemm_phase<EpiMerge, pg8::TileOrder>(lds, g, S, E, cx.tid);
}
__device__ __forceinline__ void ph_outproj(const Ctx& cx, int layer, PG8_LAS unsigned char* lds, float scale) {
    CParams& p = get_params();
    pg8::Gemm g; g.A = (const bf16*)(p.ws + WS_M); g.Bt = (const bf16*)(p.ws + WT_OUT) + (size_t)layer * 1024 * 1024; g.zsA = 0; g.zsB = 0; g.K = 1024;
    pg8::TileOrder S; S.nM = TL / 256; S.nN = 4; S.nwg = S.nM * S.nN; S.G = cx.nb; S.c = cx.bid; S.nz = 1; S.exN = 4; S.expn0 = 0; S.extra = layer == 0 ? 4 * 4 : 0;
    EpiOut E; E.ws = p.ws; E.layer = layer; E.scale = scale; E.xin = layer == 0 ? p.in[I_X] : (const float*)(p.ws + WS_XCUR); E.cin = layer == 0 ? p.in[I_CTX] - (size_t)TL * 1024 : (const float*)(p.ws + WS_XCUR);
    pg8::gemm_phase<EpiOut, pg8::TileOrder>(lds, g, S, E, cx.tid);
}
__device__ __forceinline__ void ph_qp(const Ctx& cx, int layer, PG8_LAS unsigned char* lds) {
    CParams& p = get_params();
    pg8::Gemm g; g.A = (const bf16*)(p.ws + WS_H); g.Bt = (const bf16*)(p.ws + WT_WQ) + (size_t)layer * 2048 * 1024; g.zsA = 0; g.zsB = 0; g.K = 1024;
    pg8::TileOrder S; S.nM = TL / 256; S.nN = 8; S.nwg = S.nM * S.nN; S.G = cx.nb; S.c = cx.bid; S.nz = 1; S.exN = 8; S.expn0 = 0; S.extra = layer == 0 ? 4 * 8 : 0;
    EpiQp E; E.ws = p.ws;
    pg8::gemm_phase<EpiQp, pg8::TileOrder>(lds, g, S, E, cx.tid);
}

__device__ __forceinline__ void ph_peerconv(const Ctx& cx, int layer) {
    CParams& p = get_params();
    const int gt = cx.bid * NTHREADS + cx.tid, NGT = cx.nb * NTHREADS;
    const f32x4* su = (const f32x4*)(p.in[I_PU] + (size_t)layer * 16384 * 1024); const f32x4* sv = (const f32x4*)(p.in[I_PV] + (size_t)layer * 16384 * 1024);
    int* du = (int*)(p.ws + WS_PU); int* dv = (int*)(p.ws + WS_PV);
    for (int i0 = gt; i0 < 16384 * 1024 / 4; i0 += 4 * NGT) {
        f32x4 a[4], c[4];
#pragma unroll
        for (int q = 0; q < 4; ++q) { const int i = i0 + q * NGT < 16384 * 1024 / 4 ? i0 + q * NGT : i0; a[q] = __builtin_nontemporal_load(su + i); c[q] = __builtin_nontemporal_load(sv + i); }
#pragma unroll
        for (int q = 0; q < 4; ++q) { const int i = i0 + q * NGT; if (i >= 16384 * 1024 / 4) break; const f32x4 av = a[q] * PEER_SU, cv = c[q] * PEER_SV;
            int wa = 0, wc = 0; wa = __builtin_amdgcn_cvt_pk_fp8_f32(av[0], av[1], wa, false); wa = __builtin_amdgcn_cvt_pk_fp8_f32(av[2], av[3], wa, true);
            wc = __builtin_amdgcn_cvt_pk_fp8_f32(cv[0], cv[1], wc, false); wc = __builtin_amdgcn_cvt_pk_fp8_f32(cv[2], cv[3], wc, true);
            const int e = i >> 8, qq = i & 255, di = (((qq >> 5) * 16384 + e) << 5) + (qq & 31); du[di] = wa; dv[di] = wc; }
    }
}
__device__ __forceinline__ unsigned mono_key(float s, unsigned lowbits, unsigned mask) { const unsigned u = __float_as_uint(s); const unsigned k = (u & 0x80000000u) ? ~u : (u | 0x80000000u); return (k & ~mask) | lowbits; }
__device__ __forceinline__ float mono_val(unsigned key, unsigned mask) { const unsigned k = (key & ~mask) | ((mask + 1u) >> 1); return __uint_as_float((k & 0x80000000u) ? (k & 0x7fffffffu) : ~k); }
#define TOP16_INSERT(t, v_) do { unsigned v__ = (v_); _Pragma("unroll") for (int k_ = 0; k_ < 16; ++k_) { const unsigned hi__ = t[k_] > v__ ? t[k_] : v__; v__ = t[k_] > v__ ? v__ : t[k_]; t[k_] = hi__; } } while (0)
#define CE_DESC(x_, y_) do { const unsigned hi__ = (x_) > (y_) ? (x_) : (y_); const unsigned lo__ = (x_) > (y_) ? (y_) : (x_); (x_) = hi__; (y_) = lo__; } while (0)
__device__ __forceinline__ void sort16_desc(unsigned (&v)[16]) {
#pragma unroll
    for (int k = 2; k <= 16; k <<= 1)
#pragma unroll
        for (int j = k >> 1; j > 0; j >>= 1)
#pragma unroll
            for (int i = 0; i < 16; ++i) { const int l = i ^ j; if (l > i) { if ((i & k) == 0) CE_DESC(v[i], v[l]); else CE_DESC(v[l], v[i]); } }
}
__device__ __forceinline__ void merge16_desc(unsigned (&t)[16], const unsigned (&s)[16]) {
    unsigned c[16];
#pragma unroll
    for (int k = 0; k < 16; ++k) c[k] = t[k] > s[15 - k] ? t[k] : s[15 - k];
#pragma unroll
    for (int d = 8; d >= 1; d >>= 1)
#pragma unroll
        for (int k = 0; k < 16; ++k) if ((k & d) == 0) CE_DESC(c[k], c[k + d]);
#pragma unroll
    for (int k = 0; k < 16; ++k) t[k] = c[k];
}
__device__ __forceinline__ void top16_merge_pair(unsigned (&t)[16]) {
    unsigned c[16];
#pragma unroll
    for (int k = 0; k < 16; ++k) { const unsigned o = (unsigned)__shfl_xor((int)t[15 - k], 32); c[k] = t[k] > o ? t[k] : o; }
#pragma unroll
    for (int d = 8; d >= 1; d >>= 1)
#pragma unroll
        for (int k = 0; k < 16; ++k) if ((k & d) == 0) { const unsigned a = c[k], bb = c[k + d]; c[k] = a > bb ? a : bb; c[k + d] = a > bb ? bb : a; }
#pragma unroll
    for (int k = 0; k < 16; ++k) t[k] = c[k];
}
__device__ __forceinline__ void ph_select(const Ctx& cx, int layer) {
    CParams& p = get_params();
    const int lane = cx.tid & 63, wave = cx.tid >> 6, l31 = lane & 31, hi = lane >> 5;
    const int gw = cx.bid * NWAVES + wave, NGW = cx.nb * NWAVES;
    const int nrows = layer == 0 ? TA : TL;
    const bf16* QP = (const bf16*)(p.ws + WS_QP); const bf16* KY = (const bf16*)(p.ws + WT_KEYS) + (size_t)layer * 8 * 2 * 128 * 128;
    for (int it = gw; it < (nrows / 32) * 8; it += NGW) {
        const int h = it & 7, r0 = (it >> 3) * 32;
        unsigned ab[2][16];
#pragma unroll
        for (int s = 0; s < 2; ++s) {
            const bf16* kp = KY + ((size_t)(h * 2 + s) * 8 * 128 + l31) * 16 + 8 * hi;
            const bf16* qp = QP + ((size_t)(h * 2 + s) * 8 * TA + (r0 + l31)) * 16 + 8 * hi;
            bf16x8 qf[8], kc[8];
#pragma unroll
            for (int ks = 0; ks < 8; ++ks) { qf[ks] = *(const bf16x8*)(qp + (size_t)ks * TA * 16); kc[ks] = *(const bf16x8*)(kp + ks * 2048); }
            unsigned t[16];
#pragma unroll
            for (int k = 0; k < 16; ++k) t[k] = 0u;
#pragma unroll 1
            for (int nt = 0; nt < 4; ++nt) {
                bf16x8 kn[8];
                const bf16* kpn = kp + (nt < 3 ? nt + 1 : nt) * 512;
#pragma unroll
                for (int ks = 0; ks < 8; ++ks) kn[ks] = *(const bf16x8*)(kpn + ks * 2048);
                f32x16 acc;
#pragma unroll
                for (int r = 0; r < 16; ++r) acc[r] = 0.f;
#pragma unroll
                for (int ks = 0; ks < 8; ++ks) acc = __builtin_amdgcn_mfma_f32_32x32x16_bf16(kc[ks], qf[ks], acc, 0, 0, 0);
                unsigned sk[16];
#pragma unroll
                for (int r = 0; r < 16; ++r) { const int n = 32 * nt + (r & 3) + 8 * (r >> 2) + 4 * hi; sk[r] = mono_key(acc[r], 127u - (unsigned)n, 127u); }
                sort16_desc(sk);
                merge16_desc(t, sk);
#pragma unroll
                for (int ks = 0; ks < 8; ++ks) kc[ks] = kn[ks];
            }
            top16_merge_pair(t);
#pragma unroll
            for (int k = 0; k < 16; ++k) ab[s][k] = t[k];
        }
        float av[16], bv[16];
#pragma unroll
        for (int k = 0; k < 16; ++k) { av[k] = mono_val(ab[0][k], 127u); bv[k] = mono_val(ab[1][k], 127u); }
        unsigned t2[16], u2[16];
#pragma unroll
        for (int k = 0; k < 16; ++k) { t2[k] = 0u; u2[k] = 0u; }
#define CELL(dst, i1, j1, i2, j2) do { const float sv_ = hi ? av[i2] + bv[j2] : av[i1] + bv[j1]; const unsigned lb_ = hi ? 255u - (unsigned)((i2) * 16 + (j2)) : 255u - (unsigned)((i1) * 16 + (j1)); dst = mono_key(sv_, lb_, 255u); } while (0)
        CELL(t2[0], 0, 0, 1, 1);   CELL(t2[1], 0, 1, 1, 2);   CELL(t2[2], 0, 2, 1, 3);   CELL(t2[3], 0, 3, 1, 4);   CELL(t2[4], 0, 4, 1, 5);   CELL(t2[5], 0, 5, 1, 6);   CELL(t2[6], 0, 6, 1, 7);   CELL(t2[7], 0, 7, 2, 0);
        CELL(t2[8], 0, 8, 2, 1);   CELL(t2[9], 0, 9, 2, 2);   CELL(t2[10], 0, 10, 2, 3); CELL(t2[11], 0, 11, 2, 4); CELL(t2[12], 0, 12, 3, 0); CELL(t2[13], 0, 13, 3, 1); CELL(t2[14], 0, 14, 3, 2); CELL(t2[15], 0, 15, 3, 3);
        CELL(u2[0], 1, 0, 4, 0);   CELL(u2[1], 4, 1, 4, 2);   CELL(u2[2], 5, 0, 5, 1);   CELL(u2[3], 6, 0, 6, 1);   CELL(u2[4], 7, 0, 7, 1);   CELL(u2[5], 8, 0, 9, 0);   CELL(u2[6], 10, 0, 11, 0); CELL(u2[7], 12, 0, 13, 0); CELL(u2[8], 14, 0, 15, 0);
#undef CELL
        sort16_desc(t2); sort16_desc(u2); merge16_desc(t2, u2);
        top16_merge_pair(t2);
        const float v0 = mono_val(t2[0], 255u); float e[16], esum = 0.f; int eid[16];
#pragma unroll
        for (int k = 0; k < 16; ++k) { e[k] = __expf(mono_val(t2[k], 255u) - v0); esum += e[k];
            const unsigned c = 255u - (t2[k] & 255u), ci = c >> 4, cj = c & 15u; unsigned ka = ab[0][0], kb = ab[1][0];
#pragma unroll
            for (int q = 1; q < 16; ++q) { ka = ci == (unsigned)q ? ab[0][q] : ka; kb = cj == (unsigned)q ? ab[1][q] : kb; }
            eid[k] = (int)((127u - (ka & 127u)) * 128u + (127u - (kb & 127u))); }
        const float inv = 1.f / esum;
        if (hi == 0) { int* dst = (int*)(p.ws + WS_EID) + (size_t)(r0 + l31) * 128 + h * 16;
#pragma unroll
            for (int k = 0; k < 16; k += 4) *(u32x4*)(dst + k) = (u32x4){(unsigned)eid[k], (unsigned)eid[k + 1], (unsigned)eid[k + 2], (unsigned)eid[k + 3]}; }
        else { float* dst = (float*)(p.ws + WS_EG) + (size_t)(r0 + l31) * 128 + h * 16;
#pragma unroll
            for (int k = 0; k < 16; k += 4) *(f32x4*)(dst + k) = (f32x4){e[k] * inv, e[k + 1] * inv, e[k + 2] * inv, e[k + 3] * inv}; }
    }
}
__device__ __forceinline__ void fp8x16_to_f32(const u32x4 w, f32x2 (&f)[8]) {
    f[0] = __builtin_amdgcn_cvt_pk_f32_fp8((int)w.x, false); f[1] = __builtin_amdgcn_cvt_pk_f32_fp8((int)w.x, true); f[2] = __builtin_amdgcn_cvt_pk_f32_fp8((int)w.y, false); f[3] = __builtin_amdgcn_cvt_pk_f32_fp8((int)w.y, true);
    f[4] = __builtin_amdgcn_cvt_pk_f32_fp8((int)w.z, false); f[5] = __builtin_amdgcn_cvt_pk_f32_fp8((int)w.z, true); f[6] = __builtin_amdgcn_cvt_pk_f32_fp8((int)w.w, false); f[7] = __builtin_amdgcn_cvt_pk_f32_fp8((int)w.w, true);
}
#define PU_ISSUE(rowbuf, e0_, e1_) do { _Pragma("unroll") for (int s = 0; s < 16; ++s) { const int e_ = __shfl(s < 8 ? e0_ : e1_, (s & 7) * 8 + grp); \
        rowbuf[s] = __builtin_amdgcn_raw_buffer_load_b128(ru, (unsigned)(e_ * 128 + j8 * 16), 0, 0); } } while (0)
__device__ __forceinline__ void pu_compute(const u32x4 (&row)[16], const u32x4 xw0, const u32x4 xw1, float* pt, int j8, int grp) {
    f32x2 x[8];
    { const f32x4 a = bf4lo(xw0), b = bf4hi(xw0), c = bf4lo(xw1), d = bf4hi(xw1);
      x[0] = (f32x2){a[0], a[1]}; x[1] = (f32x2){a[2], a[3]}; x[2] = (f32x2){b[0], b[1]}; x[3] = (f32x2){b[2], b[3]}; x[4] = (f32x2){c[0], c[1]}; x[5] = (f32x2){c[2], c[3]}; x[6] = (f32x2){d[0], d[1]}; x[7] = (f32x2){d[2], d[3]}; }
    float d[16];
#pragma unroll
    for (int s = 0; s < 16; ++s) { f32x2 f[8]; fp8x16_to_f32(row[s], f);
        f32x2 a = f[0] * x[0];
#pragma unroll
        for (int j = 1; j < 8; ++j) a += f[j] * x[j];
        d[s] = a.x + a.y; }
    float a8[8], a4[4];
    { const bool bt = j8 & 4;
#pragma unroll
      for (int i = 0; i < 4; ++i) {
          const float s0 = bt ? d[i] : d[i + 4], k0 = bt ? d[i + 4] : d[i]; a8[i] = k0 + __shfl_xor(s0, 4);
          const float s1 = bt ? d[i + 8] : d[i + 12], k1 = bt ? d[i + 12] : d[i + 8]; a8[i + 4] = k1 + __shfl_xor(s1, 4); } }
    { const bool bt = j8 & 2;
#pragma unroll
      for (int i = 0; i < 2; ++i) {
          const float s0 = bt ? a8[i] : a8[i + 2], k0 = bt ? a8[i + 2] : a8[i]; a4[i] = k0 + __shfl_xor(s0, 2);
          const float s1 = bt ? a8[i + 4] : a8[i + 6], k1 = bt ? a8[i + 6] : a8[i + 4]; a4[i + 2] = k1 + __shfl_xor(s1, 2); } }
    float r0, r1;
    { const bool bt = j8 & 1;
      const float s0 = bt ? a4[0] : a4[1], k0 = bt ? a4[1] : a4[0]; r0 = k0 + __shfl_xor(s0, 1);
      const float s1 = bt ? a4[2] : a4[3], k1 = bt ? a4[3] : a4[2]; r1 = k1 + __shfl_xor(s1, 1); }
    pt[0] = r0; pt[64] = r1;
}
__device__ __forceinline__ void ph_peer_u(const Ctx& cx, int layer) {
    CParams& p = get_params();
    const int lane = cx.tid & 63, wave = __builtin_amdgcn_readfirstlane(cx.tid >> 6);
    const int nrows = layer == 0 ? TA : TL;
    const int slice = cx.bid & 7, ws_ = (cx.bid >> 3) * NWAVES + wave, NWS = (cx.nb >> 3) * NWAVES;
    const __amdgpu_buffer_rsrc_t ru = __builtin_amdgcn_make_buffer_rsrc((void*)uni_ptr(p.ws + WS_PU + (size_t)slice * (16384 * 128)), (short)0, 16384 * 128, 0x00020000);
    const int j8 = lane & 7, grp = lane >> 3;
    float* PART = (float*)(p.ws + WS_PART) + (size_t)slice * TA * 128 + j8 * 8 + grp;
    const int* EID = (const int*)(p.ws + WS_EID) + lane; const bf16* Hx = (const bf16*)(p.ws + WS_H) + slice * 128 + j8 * 16;
    int t = ws_;
    if (t >= nrows) return;
    u32x4 rA[16], rB[16]; u32x4 xa0, xa1, xb0, xb1;
    int e0 = EID[(size_t)t * 128], e1 = EID[(size_t)t * 128 + 64];
    PU_ISSUE(rA, e0, e1); xa0 = *(const u32x4*)(Hx + (size_t)t * 1024); xa1 = *(const u32x4*)(Hx + (size_t)t * 1024 + 8);
    if (t + NWS < nrows) { e0 = EID[(size_t)(t + NWS) * 128]; e1 = EID[(size_t)(t + NWS) * 128 + 64]; }
    for (;;) {
        const int t1 = t + NWS, t2 = t + 2 * NWS, t3 = t + 3 * NWS;
        if (t1 < nrows) { PU_ISSUE(rB, e0, e1); xb0 = *(const u32x4*)(Hx + (size_t)t1 * 1024); xb1 = *(const u32x4*)(Hx + (size_t)t1 * 1024 + 8); }
        if (t2 < nrows) { e0 = EID[(size_t)t2 * 128]; e1 = EID[(size_t)t2 * 128 + 64]; }
        pu_compute(rA, xa0, xa1, PART + (size_t)t * 128, j8, grp);
        if (t1 >= nrows) break;
        if (t2 < nrows) { PU_ISSUE(rA, e0, e1); xa0 = *(const u32x4*)(Hx + (size_t)t2 * 1024); xa1 = *(const u32x4*)(Hx + (size_t)t2 * 1024 + 8); }
        if (t3 < nrows) { e0 = EID[(size_t)t3 * 128]; e1 = EID[(size_t)t3 * 128 + 64]; }
        pu_compute(rB, xb0, xb1, PART + (size_t)t1 * 128, j8, grp);
        if (t2 >= nrows) break;
        t = t2;
    }
}
#undef PU_ISSUE
__device__ __forceinline__ void ph_peer_w(const Ctx& cx, int layer) {
    CParams& p = get_params();
    const int gt = cx.bid * NTHREADS + cx.tid, NGT = cx.nb * NTHREADS;
    const int n = (layer == 0 ? TA : TL) * 128;
    const float* PART = (const float*)(p.ws + WS_PART); float* EG = (float*)(p.ws + WS_EG);
    for (int i = gt; i < n; i += 2 * NGT) { const int i2 = i + NGT < n ? i + NGT : i; float pa[8], pb[8];
#pragma unroll
        for (int xs = 0; xs < 8; ++xs) { pa[xs] = PART[(size_t)xs * TA * 128 + i]; pb[xs] = PART[(size_t)xs * TA * 128 + i2]; }
        const float ga = EG[i], gb = EG[i2]; float da = 0.f, db = 0.f;
#pragma unroll
        for (int xs = 0; xs < 8; ++xs) { da += pa[xs]; db += pb[xs]; }
        EG[i] = ga * gelu_tanh(da * (1.f / PEER_SU)); if (i2 != i) EG[i2] = gb * gelu_tanh(db * (1.f / PEER_SU)); }
}
#define PV_ISSUE(vbuf, wbuf, e0_, e1_, w0_, w1_) do { _Pragma("unroll") for (int s = 0; s < 16; ++s) { const int src_ = (s & 7) * 8 + grp; \
        const int ee_ = __shfl(s < 8 ? e0_ : e1_, src_); wbuf[s] = __shfl(s < 8 ? w0_ : w1_, src_); vbuf[s] = __builtin_amdgcn_raw_buffer_load_b128(rv, (unsigned)(ee_ * 128 + j8 * 16), 0, 0); } } while (0)
__device__ __forceinline__ void pv_compute(const u32x4 (&row)[16], const float (&w)[16], float* o, const float* g2, int lane, float scale) {
    f32x2 acc[8];
#pragma unroll
    for (int j = 0; j < 8; ++j) acc[j] = (f32x2){0.f, 0.f};
#pragma unroll
    for (int s = 0; s < 16; ++s) { f32x2 f[8]; fp8x16_to_f32(row[s], f);
#pragma unroll
        for (int j = 0; j < 8; ++j) acc[j] += w[s] * f[j]; }
    f32x2 a4[4], a2[2];
    { const bool bt = lane & 32;
#pragma unroll
      for (int i = 0; i < 4; ++i) { const f32x2 sd = bt ? acc[i] : acc[i + 4], kp = bt ? acc[i + 4] : acc[i]; a4[i] = (f32x2){kp.x + __shfl_xor(sd.x, 32), kp.y + __shfl_xor(sd.y, 32)}; } }
    { const bool bt = lane & 16;
#pragma unroll
      for (int i = 0; i < 2; ++i) { const f32x2 sd = bt ? a4[i] : a4[i + 2], kp = bt ? a4[i + 2] : a4[i]; a2[i] = (f32x2){kp.x + __shfl_xor(sd.x, 16), kp.y + __shfl_xor(sd.y, 16)}; } }
    f32x2 r; { const bool bt = lane & 8; const f32x2 sd = bt ? a2[0] : a2[1], kp = bt ? a2[1] : a2[0]; r = (f32x2){kp.x + __shfl_xor(sd.x, 8), kp.y + __shfl_xor(sd.y, 8)}; }
    const int co = ((lane >> 5) & 1) * 8 + ((lane >> 4) & 1) * 4 + ((lane >> 3) & 1) * 2;
    const f32x2 gg = *(const f32x2*)(g2 + co); f32x2* xp = (f32x2*)(o + co); const f32x2 xv = *xp; *xp = (f32x2){xv.x + gg.x * r.x * scale, xv.y + gg.y * r.y * scale};
}
__device__ __forceinline__ void ph_peer_v(const Ctx& cx, int layer, float scale_) {
    CParams& p = get_params();
    const int lane = cx.tid & 63, wave = __builtin_amdgcn_readfirstlane(cx.tid >> 6);
    const int nrows = layer == 0 ? TA : TL;
    const int slice = cx.bid & 7, ws_ = (cx.bid >> 3) * NWAVES + wave, NWS = (cx.nb >> 3) * NWAVES;
    const __amdgpu_buffer_rsrc_t rv = __builtin_amdgcn_make_buffer_rsrc((void*)uni_ptr(p.ws + WS_PV + (size_t)slice * (16384 * 128)), (short)0, 16384 * 128, 0x00020000);
    const int j8 = lane & 7, grp = lane >> 3;
    const float* EG = (const float*)(p.ws + WS_EG) + lane; const int* EID = (const int*)(p.ws + WS_EID) + lane;
    float* OUT = (float*)(p.ws + WS_XCUR) + slice * 128 + j8 * 16;
    const float* G2 = (const float*)(p.ws + WS_MODV) + (size_t)layer * 5 * 6144 + 5120 + slice * 128 + j8 * 16; const float scale = scale_ / PEER_SV;
    int t = ws_;
    if (t >= nrows) return;
    u32x4 rA[16], rB[16]; float wA[16], wB[16];
    int e0 = EID[(size_t)t * 128], e1 = EID[(size_t)t * 128 + 64]; float w0 = EG[(size_t)t * 128], w1 = EG[(size_t)t * 128 + 64];
    PV_ISSUE(rA, wA, e0, e1, w0, w1);
    if (t + NWS < nrows) { e0 = EID[(size_t)(t + NWS) * 128]; e1 = EID[(size_t)(t + NWS) * 128 + 64]; w0 = EG[(size_t)(t + NWS) * 128]; w1 = EG[(size_t)(t + NWS) * 128 + 64]; }
    for (;;) {
        const int t1 = t + NWS, t2 = t + 2 * NWS, t3 = t + 3 * NWS;
        if (t1 < nrows) PV_ISSUE(rB, wB, e0, e1, w0, w1);
        if (t2 < nrows) { e0 = EID[(size_t)t2 * 128]; e1 = EID[(size_t)t2 * 128 + 64]; w0 = EG[(size_t)t2 * 128]; w1 = EG[(size_t)t2 * 128 + 64]; }
        pv_compute(rA, wA, OUT + (size_t)t * 1024, G2 + (size_t)row_mi(t) * 6144, lane, scale);
        if (t1 >= nrows) break;
        if (t2 < nrows) PV_ISSUE(rA, wA, e0, e1, w0, w1);
        if (t3 < nrows) { e0 = EID[(size_t)t3 * 128]; e1 = EID[(size_t)t3 * 128 + 64]; w0 = EG[(size_t)t3 * 128]; w1 = EG[(size_t)t3 * 128 + 64]; }
        pv_compute(rB, wB, OUT + (size_t)t1 * 1024, G2 + (size_t)row_mi(t1) * 6144, lane, scale);
        if (t2 >= nrows) break;
        t = t2;
    }
}
#undef PV_ISSUE
__device__ __forceinline__ void ph_peer_fin(const Ctx& cx, int layer) {
    CParams& p = get_params();
    const int lane = cx.tid & 63, wave = cx.tid >> 6;
    const int gw = cx.bid * NWAVES + wave, NGW = cx.nb * NWAVES;
    const int nrows = layer == 0 ? TA : TL;
    const float* X = (const float*)(p.ws + WS_XCUR);
    for (int r = gw; r < nrows; r += NGW) {
        f32x4 v[4]; float ss = 0.f;
#pragma unroll
        for (int j = 0; j < 4; ++j) { const int c = j * 256 + lane * 4; const f32x4 xv = *(const f32x4*)(X + (size_t)r * 1024 + c); v[j] = xv; ss += xv[0] * xv[0] + xv[1] * xv[1] + xv[2] * xv[2] + xv[3] * xv[3]; }
        const float rs = rsqrtf(wave_sum(ss) * (1.f / DM) + NORM_EPS);
        if (layer == DEPTH - 1) {
#pragma unroll
            for (int j = 0; j < 4; ++j) { const int c = j * 256 + lane * 4; *(f32x4*)(p.out + (size_t)r * 1024 + c) = v[j] * rs * *(const f32x4*)(p.in[I_FG] + c); }
        } else {
            const float* g = p.in[I_N1G] + (layer + 1) * DM; const float* mv = (const float*)(p.ws + WS_MODV) + ((size_t)(layer + 1) * 5 + row_mi(r)) * 6144;
#pragma unroll
            for (int j = 0; j < 4; ++j) { const int c = j * 256 + lane * 4;
                const f32x4 y = v[j] * rs * *(const f32x4*)(g + c); const f32x4 h = y * (1.f + *(const f32x4*)(mv + 1024 + c)) + *(const f32x4*)(mv + c);
                u32x2 w; w.x = pk2(h[0], h[1]); w.y = pk2(h[2], h[3]); *(u32x2*)((bf16*)(p.ws + WS_H) + (size_t)r * DM + c) = w; }
        }
    }
}

constexpr int NPL = 14, NPHASE = 1 + DEPTH * NPL;
#ifndef ONLY
#define ONLY -1
#endif
#ifndef NOT
#define NOT -1
#endif
#define ON(n) ((ONLY < 0 || ONLY == (n)) && NOT != (n))
#ifndef PROBE_REPS
#define PROBE_REPS 2
#endif
#define REPN(n) (PROBE_HAS(n) ? PROBE_REPS : 1)
#define RUN(n, call) do { { MKCX(); if (ON(n)) { const int rep_ = 0; (void)rep_; call; } } if (REPN(n) > 1) { _Pragma("unroll 1") for (int rr_ = 1; rr_ < REPN(n); ++rr_) { __syncthreads(); { MKCX(); if (ON(n)) { const int rep_ = REPN(n) - rr_; (void)rep_; call; } } } __syncthreads(); } } while (0)
#define MKCX() Ctx cx; cx.tid = threadIdx.x; cx.bid = blockIdx.x; cx.nb = gridDim.x; asm volatile("" : "+v"(cx.tid), "+s"(cx.bid), "+s"(cx.nb))
#define IN(k) (lo <= (k) && (k) < hi)
#define SUBSET(first, count, call) do { MKCX(); if (cx.bid >= (first) && cx.bid < (first) + (count)) { cx.bid -= (first); cx.nb = (count); call; } } while (0)
#define SIDE(first, call) do { MKCX(); if (cx.bid >= (first)) { cx.bid -= (first); cx.nb -= (first); call; } } while (0)
#define SEAM(k) do { if (IN(k) && IN((k) + 1)) { XcdBarrier bar_; bar_.bar = (unsigned*)(get_params().ws + WS_CTL) + 4096; bar_.x = xb_xcc_id(); bar_.st = st; xcd_barrier(bar_); } } while (0)
template <int LAYER> __device__ __forceinline__ void layer_program(const int lo, const int hi, float* sm, PG8_LAS unsigned char* lds, volatile LAS unsigned* st) {
    constexpr int B = 1 + LAYER * NPL;
    if (LAYER == 0) { if (IN(B + 0)) { RUN(0, ph_norm(cx, LAYER, 0, 0)); } SEAM(B + 0); }
    if (IN(B + 1)) { RUN(1, ph_inproj(cx, LAYER, lds)); if (LAYER == 0) { __syncthreads(); SIDE(28, ph_filters(cx, 0, sm)); } } SEAM(B + 1);
    if (IN(B + 2)) { RUN(2, ph_attn(cx, LAYER, sm, 0, 256)); __syncthreads();
        SUBSET(0, 128, ph_s5states(cx, LAYER, sm)); SUBSET(128, 128, ph_hypre(cx, LAYER, sm, 0, 2048)); __syncthreads();
        if (LAYER == 0) { SUBSET(128, 16, ph_attn(cx, LAYER, sm, 256, 16)); SUBSET(144, 16, ph_hypre(cx, LAYER, sm, 2048, 128)); } } SEAM(B + 2);
    if (IN(B + 3)) { RUN(3, ph_hyfft(cx, LAYER, sm, !(REPN(3) == 1 || rep_ == 1))); __syncthreads(); RUN(31, ph_hyconv_ctx(cx, LAYER, sm)); __syncthreads(); RUN(30, ph_s5out(cx, LAYER, sm)); } SEAM(B + 3);
    if (IN(B + 4)) { RUN(4, ph_glu(cx, LAYER, lds)); __syncthreads(); RUN(40, ph_hypost(cx, LAYER, sm)); } SEAM(B + 4);
    if (IN(B + 5)) { RUN(5, ph_merge(cx, LAYER, lds)); if (LAYER == 0) { __syncthreads(); SIDE(16, ph_filters(cx, 1, sm)); SIDE(16, ph_convert(cx, 1)); } } SEAM(B + 5);
    if (IN(B + 6)) { RUN(6, ph_outproj(cx, LAYER, lds, 1.f / REPN(6))); if (LAYER == 0) { SIDE(16, ph_peerconv(cx, 0)); } } SEAM(B + 6);
    if (IN(B + 7)) { RUN(7, ph_norm(cx, LAYER, 1, LAYER == DEPTH - 1)); if (LAYER + 1 < DEPTH) { RUN(70, ph_s5tables(cx, LAYER + 1, sm)); } if (LAYER != 0) { RUN(71, ph_peerconv(cx, LAYER)); } } SEAM(B + 7);
    if (IN(B + 8)) { RUN(8, ph_qp(cx, LAYER, lds)); } SEAM(B + 8);
    if (IN(B + 9)) { RUN(9, ph_select(cx, LAYER)); } SEAM(B + 9);
    if (IN(B + 10)) { RUN(10, ph_peer_u(cx, LAYER)); } SEAM(B + 10);
    if (IN(B + 11)) { RUN(13, ph_peer_w(cx, LAYER)); } SEAM(B + 11);
    if (IN(B + 12)) { RUN(11, ph_peer_v(cx, LAYER, 1.f / REPN(11))); } SEAM(B + 12);
    if (IN(B + 13)) { RUN(12, ph_peer_fin(cx, LAYER)); } SEAM(B + 13);
}
__global__ void __launch_bounds__(NTHREADS, 2) mk_fwd(Params p) {
    extern __shared__ __attribute__((aligned(16))) unsigned char lds_raw[];
    float* sm = (float*)lds_raw; PG8_LAS unsigned char* lds = (PG8_LAS unsigned char*)lds_raw;
    volatile LAS unsigned* st = (volatile LAS unsigned*)(lds + LDS_MISC);
    if (threadIdx.x < 4) st[threadIdx.x] = 0u;
    __syncthreads();
    const int lo = p.ph_lo, hi = p.ph_hi;
    if (hi - lo > 1) (void)xcd_barrier_post((unsigned*)(p.ws + WS_CTL) + 4096, st);
    if (IN(0)) { RUN(100, ph_prologue(cx, sm)); RUN(101, ph_convert(cx, 0)); __syncthreads(); RUN(102, ph_s5tables(cx, 0, sm)); } SEAM(0);
    layer_program<0>(lo, hi, sm, lds, st);
    layer_program<1>(lo, hi, sm, lds, st);
}
}

extern "C" void kernel_launch(void* const* d_in, const int* in_sizes, int n_in, void* d_out, int out_size, void* d_ws, size_t ws_size, hipStream_t stream) {
    static int grid = 0;
    if (grid == 0) {
        if (n_in != 40 || out_size != TL * DM || ws_size < WS_END) { fprintf(stderr, "kernel_launch: unexpected shapes (n_in %d out %d ws %zu)\n", n_in, out_size, ws_size); grid = -1; return; }
        int dev = 0, cus = 0;
        if (hipGetDevice(&dev) != hipSuccess || hipDeviceGetAttribute(&cus, hipDeviceAttributeMultiprocessorCount, dev) != hipSuccess) { grid = -1; return; }
        if (hipFuncSetAttribute((const void*)mk_fwd, hipFuncAttributeMaxDynamicSharedMemorySize, LDS_BYTES) != hipSuccess) { fprintf(stderr, "kernel_launch: hipFuncSetAttribute failed\n"); grid = -1; return; }
        if (cus < 256) { fprintf(stderr, "kernel_launch: needs 256 compute units (one resident workgroup each), found %d\n", cus); grid = -1; return; }
        grid = 256;
    }
    if (grid < 0) return;
    (void)hipMemsetAsync((char*)d_ws + WS_CTL, 0, 1 * MiB, stream);
    Params a{};
    for (int i = 0; i < 40; ++i) a.in[i] = (const float*)d_in[i];
    a.out = (float*)d_out; a.ws = (unsigned char*)d_ws;
#if PER_PHASE_LAUNCH
    for (int ph = 0; ph < NPHASE; ++ph) { a.ph_lo = ph; a.ph_hi = ph + 1; hipLaunchKernelGGL(mk_fwd, dim3(grid), dim3(NTHREADS), LDS_BYTES, stream, a); }
#else
    a.ph_lo = 0; a.ph_hi = NPHASE; hipLaunchKernelGGL(mk_fwd, dim3(grid), dim3(NTHREADS), LDS_BYTES, stream, a);
#endif
}
```
